# Optimizing an MI355X kernel written in HIP

```python
import jax, jax.numpy as jnp
from jax import lax
import numpy as np

D_MODEL = 2048
BATCH = 8
SEQ = 2048
DEPTH = 1

CONV_WIDTH = D_MODEL // 2
CONV_K = 3
MLSTM_WIDTH = D_MODEL - CONV_WIDTH
MLSTM_HEADS = 4
MLSTM_V = MLSTM_WIDTH // MLSTM_HEADS
MLSTM_QK = MLSTM_V // 2
MLSTM_CHUNK = 64
N_GATE_COLS = 2 * 2 * MLSTM_HEADS
IN_SIZES = [CONV_WIDTH, CONV_WIDTH, CONV_WIDTH,
            MLSTM_HEADS * MLSTM_QK, MLSTM_HEADS * MLSTM_QK,
            MLSTM_WIDTH, MLSTM_WIDTH, N_GATE_COLS]
IN_COLS = sum(IN_SIZES)
PEER_HEADS = 8
N_KEYS = 128
N_EXPERTS = N_KEYS * N_KEYS
PEER_TOPK = 16
PEER_KEY_DIM = 256
PEER_BLOCK = 128
LN_EPS = 1e-5
ALPHA = (2 * DEPTH) ** 0.25
BETA = (8 * DEPTH) ** -0.25

kernel_name = 'hybrid_conv_mlstm_peer_deepnorm_adaln'


def _ln_stats(x):
    xf = x.astype(jnp.float32)
    mu = jnp.mean(xf, -1, keepdims=True)
    var = jnp.mean(jnp.square(xf - mu), -1, keepdims=True)
    return (xf - mu) * lax.rsqrt(var + LN_EPS)


def _modulate(x, shift, scale):
    return (_ln_stats(x) * (1.0 + scale[:, None, :].astype(jnp.float32))
            + shift[:, None, :].astype(jnp.float32)).astype(x.dtype)


def _post_norm(z, w, b):
    return (_ln_stats(z) * w.astype(jnp.float32) + b.astype(jnp.float32)).astype(z.dtype)


def _short_conv(z, w, b):
    ch = z.shape[-1]
    y = lax.conv_general_dilated(z, w[:, None, :].astype(z.dtype), window_strides=(1,),
                                 padding=[(CONV_K // 2, CONV_K // 2)],
                                 dimension_numbers=('NWC', 'WIO', 'NWC'),
                                 feature_group_count=ch)
    return y + b


def _mlstm_chunk_scan(q, k, v, log_f, log_i):
    G, S, H, dk = q.shape
    dv = v.shape[-1]
    L = MLSTM_CHUNK
    nc = S // L

    def chunks(t):
        t = t.reshape((G, nc, L, H) + t.shape[3:])
        return jnp.moveaxis(t, (1, 3), (0, 2))

    tril = jnp.tril(jnp.ones((L, L), dtype=bool))

    def body(carry, xs):
        C, n, m = carry
        qc, kc, vc, lf, ig = xs
        b = jnp.cumsum(lf, axis=-1)
        d = b[..., :, None] - b[..., None, :] + ig[..., None, :]
        d = jnp.where(tril, d, -jnp.inf)
        inter = b + m[..., None]
        m_t = jnp.maximum(inter, jnp.max(d, axis=-1))
        w_intra = jnp.exp(d - m_t[..., None])
        w_inter = jnp.exp(inter - m_t)
        s = jnp.einsum('ghtd,ghsd->ghts', qc, kc) * w_intra
        num = (jnp.einsum('ghts,ghsv->ghtv', s, vc)
               + w_inter[..., None] * jnp.einsum('ghtd,ghdv->ghtv', qc, C))
        den = jnp.sum(s, -1) + w_inter * jnp.einsum('ghtd,ghd->ght', qc, n)
        h = num / jnp.maximum(jnp.abs(den), jnp.exp(-m_t))[..., None]
        b_last = b[..., -1]
        a = b_last[..., None] - b + ig
        m_new = jnp.maximum(b_last + m, jnp.max(a, axis=-1))
        w_a = jnp.exp(a - m_new[..., None])
        decay = jnp.exp(b_last + m - m_new)
        C_new = decay[..., None, None] * C + jnp.einsum('ghs,ghsd,ghsv->ghdv', w_a, kc, vc)
        n_new = decay[..., None] * n + jnp.einsum('ghs,ghsd->ghd', w_a, kc)
        return (C_new, n_new, m_new), h

    init = (jnp.zeros((G, H, dk, dv), jnp.float32), jnp.zeros((G, H, dk), jnp.float32),
            jnp.zeros((G, H), jnp.float32))
    xs = (chunks(q), chunks(k), chunks(v), chunks(log_f), chunks(log_i))
    _, ys = lax.scan(body, init, xs)
    return jnp.moveaxis(ys, (0, 2), (1, 3)).reshape(G, S, H, dv)


def _mlstm_bidir(q, k, v, gates):
    B = q.shape[0]
    flip = lambda t: jnp.flip(t, axis=1)
    both = lambda t: jnp.concatenate([t, flip(t)], axis=0)
    log_i = jnp.concatenate([gates[:, :, 0, 0], flip(gates[:, :, 1, 0])], axis=0)
    log_f = jax.nn.log_sigmoid(
        jnp.concatenate([gates[:, :, 0, 1], flip(gates[:, :, 1, 1])], axis=0))
    h = _mlstm_chunk_scan(both(q), both(k), both(v), log_f, log_i)
    return h[:B] + flip(h[B:])


def _hybrid_mixer(u, w_in, b_in, conv_w, conv_b, norm_w, w_out):
    B, S, _ = u.shape
    proj = u @ w_in + b_in
    offsets = [int(o) for o in np.cumsum(IN_SIZES)[:-1]]
    gb, gc, hin, q, k, v, o, gates = jnp.split(proj, offsets, axis=-1)
    y_conv = gb * _short_conv(gc * hin, conv_w, conv_b)
    f32 = jnp.float32
    q = q.reshape(B, S, MLSTM_HEADS, MLSTM_QK).astype(f32) * (MLSTM_QK ** -0.5)
    k = k.reshape(B, S, MLSTM_HEADS, MLSTM_QK).astype(f32)
    v = v.reshape(B, S, MLSTM_HEADS, MLSTM_V).astype(f32)
    gates = gates.reshape(B, S, 2, 2, MLSTM_HEADS).astype(f32)
    h = _mlstm_bidir(q, k, v, gates)
    mu = jnp.mean(h, -1, keepdims=True)
    var = jnp.mean(jnp.square(h - mu), -1, keepdims=True)
    hn = (h - mu) * lax.rsqrt(var + LN_EPS) * norm_w.reshape(MLSTM_HEADS, MLSTM_V).astype(f32)
    og = jax.nn.sigmoid(o.astype(f32)).reshape(B, S, MLSTM_HEADS, MLSTM_V)
    y_m = (og * hn).reshape(B, S, MLSTM_WIDTH).astype(u.dtype)
    return jnp.concatenate([y_conv, y_m], axis=-1) @ w_out


def _peer(u, wq, subkeys, pu, pv):
    B, S, D = u.shape
    T = B * S
    ut = u.reshape(T, D)
    qh = (ut @ wq).reshape(T, PEER_HEADS, 2, PEER_KEY_DIM // 2)
    scores = jnp.einsum('thpd,hpnd->thpn', qh, subkeys)
    top_s, top_i = lax.top_k(scores, PEER_TOPK)
    cand = top_s[:, :, 0, :, None] + top_s[:, :, 1, None, :]
    best_s, best_c = lax.top_k(cand.reshape(T, PEER_HEADS, PEER_TOPK * PEER_TOPK), PEER_TOPK)
    i1 = jnp.take_along_axis(top_i[:, :, 0], best_c // PEER_TOPK, axis=-1)
    i2 = jnp.take_along_axis(top_i[:, :, 1], best_c % PEER_TOPK, axis=-1)
    expert = i1 * N_KEYS + i2
    gate = jax.nn.softmax(best_s.astype(jnp.float32), axis=-1).astype(u.dtype)
    nb = T // PEER_BLOCK

    def block(args):
        xb, eb, gbk = args
        act = jax.nn.gelu(jnp.einsum('pd,phkd->phk', xb, pu[eb]), approximate=False)
        return jnp.einsum('phk,phkd->pd', gbk * act, pv[eb])

    out = lax.map(block, (ut.reshape(nb, PEER_BLOCK, D),
                          expert.reshape(nb, PEER_BLOCK, PEER_HEADS, PEER_TOPK),
                          gate.reshape(nb, PEER_BLOCK, PEER_HEADS, PEER_TOPK)))
    return out.reshape(B, S, D)


def setup_inputs(seed: int = 0) -> dict:
    key = jax.random.key(seed)
    ks = jax.random.split(key, 20)
    D = D_MODEL
    nrm = lambda k, shape, std: jax.random.normal(k, shape, jnp.float32) * std
    f_bias = jnp.linspace(3.0, 6.0, MLSTM_HEADS)
    gate_offset = jnp.tile(jnp.stack([jnp.zeros(MLSTM_HEADS), f_bias])[None], (2, 1, 1)).reshape(N_GATE_COLS)
    b_in = nrm(ks[5], (DEPTH, IN_COLS), 0.02).at[:, -N_GATE_COLS:].add(gate_offset)
    return {
        'x': nrm(ks[0], (BATCH, SEQ, D), 1.0),
        'c': nrm(ks[1], (BATCH, D), 1.0),
        'w_ada': nrm(ks[2], (DEPTH, D, 6 * D), D ** -0.5),
        'b_ada': nrm(ks[3], (DEPTH, 6 * D), 0.02),
        'w_in': nrm(ks[4], (DEPTH, D, IN_COLS), D ** -0.5),
        'b_in': b_in,
        'conv_w': nrm(ks[6], (DEPTH, CONV_K, CONV_WIDTH), CONV_K ** -0.5),
        'conv_b': nrm(ks[7], (DEPTH, CONV_WIDTH), 0.02),
        'mlstm_norm_w': 1.0 + nrm(ks[8], (DEPTH, MLSTM_WIDTH), 0.02),
        'w_out': nrm(ks[9], (DEPTH, D, D), BETA * D ** -0.5),
        'ln1_w': 1.0 + nrm(ks[10], (DEPTH, D), 0.02),
        'ln1_b': nrm(ks[11], (DEPTH, D), 0.02),
        'peer_wq': nrm(ks[12], (DEPTH, D, PEER_HEADS * PEER_KEY_DIM), D ** -0.5),
        'peer_subkeys': nrm(ks[13], (DEPTH, PEER_HEADS, 2, N_KEYS, PEER_KEY_DIM // 2), (PEER_KEY_DIM // 2) ** -0.5),
        'peer_u': nrm(ks[14], (DEPTH, N_EXPERTS, D), D ** -0.5),
        'peer_v': nrm(ks[15], (DEPTH, N_EXPERTS, D), BETA),
        'ln2_w': 1.0 + nrm(ks[16], (DEPTH, D), 0.02),
        'ln2_b': nrm(ks[17], (DEPTH, D), 0.02),
    }


def reference(x, c, w_ada, b_ada, w_in, b_in, conv_w, conv_b, mlstm_norm_w, w_out,
              ln1_w, ln1_b, peer_wq, peer_subkeys, peer_u, peer_v, ln2_w, ln2_b):
    cond = jax.nn.silu(c)
    for l in range(DEPTH):
        mod = cond @ w_ada[l] + b_ada[l]
        sh1, sc1, g1, sh2, sc2, g2 = jnp.split(mod, 6, axis=-1)
        u = _modulate(x, sh1, sc1)
        y = _hybrid_mixer(u, w_in[l], b_in[l], conv_w[l], conv_b[l], mlstm_norm_w[l], w_out[l])
        x = _post_norm(ALPHA * x + g1[:, None, :] * y, ln1_w[l], ln1_b[l])
        u = _modulate(x, sh2, sc2)
        y = _peer(u, peer_wq[l], peer_subkeys[l], peer_u[l], peer_v[l])
        x = _post_norm(ALPHA * x + g2[:, None, :] * y, ln2_w[l], ln2_b[l])
    return x
```

```cpp
#define MK_N_LAUNCHES 0
#if defined(HOST_EMU)
#include <cmath>
#include <cstdint>
#include <cstring>
#include <cstddef>
#define HD inline
#define HDF inline
#else
#include <hip/hip_runtime.h>
#define HD __host__ __device__ __forceinline__
#define HDF __host__ __device__ __forceinline__
#endif

#ifndef CFG_D
#define CFG_D 2048
#define CFG_B 8
#define CFG_S 2048
#define CFG_PH 8
#define CFG_NK 128
#define CFG_TOPK 16
#define CFG_KD 256
#endif
constexpr int D = CFG_D, NB = CFG_B, S = CFG_S, T = NB * S;
constexpr int CW = D / 2, MW = D - CW, MH = 4, MV = MW / MH, QK = MV / 2, NG = 16, CHUNK = 64;
constexpr int INC = 3 * CW + 2 * MH * QK + 2 * MW + NG;
constexpr int INM = INC - NG;
constexpr int O_GB = 0, O_GC = CW, O_HIN = 2 * CW, O_Q = 3 * CW, O_K = O_Q + MH * QK, O_V = O_K + MH * QK, O_O = O_V + MW;
constexpr int PH = CFG_PH, NK = CFG_NK, TOPK = CFG_TOPK, KD = CFG_KD, KH = KD / 2, NE = NK * NK, NSLOT = PH * TOPK;
constexpr int NQ = PH * KD;
static_assert(PH * 2 * NK == NQ || true, "");
constexpr int NSC = PH * 2 * NK;
constexpr float LN_EPS = 1e-5f;
constexpr float ALPHA = 1.189207115002721f;
constexpr int D6 = 6 * D;

typedef unsigned short bf16_t;
HDF unsigned f_as_u(float f) { unsigned u; memcpy(&u, &f, 4); return u; }
HDF float u_as_f(unsigned u) { float f; memcpy(&f, &u, 4); return f; }
HDF bf16_t f2bf(float f) { unsigned u = f_as_u(f); return (bf16_t)((u + 0x7fffu + ((u >> 16) & 1u)) >> 16); }
HDF float bf2f(bf16_t h) { return u_as_f((unsigned)h << 16); }

constexpr size_t al(size_t x) { return (x + 1048575) & ~(size_t)1048575; }
constexpr size_t WS_CTL = 0;
constexpr size_t WS_MOD = al(1);
constexpr size_t WS_MODP = WS_MOD + al((size_t)NB * D6 * 4);
constexpr size_t WS_GATES = WS_MODP + al((size_t)16 * NB * D6 * 4);
constexpr size_t WS_DEN = WS_GATES + al((size_t)T * NG * 4);
constexpr size_t WS_FLR = WS_DEN + al((size_t)2 * T * MH * 4);
constexpr size_t WS_EIDX = WS_FLR + al((size_t)2 * T * MH * 4);
constexpr size_t WS_EW = WS_EIDX + al((size_t)T * NSLOT * 4);
constexpr size_t WS_WIN_T = WS_EW + al((size_t)T * NSLOT * 4);
constexpr size_t WS_WOUT_T = WS_WIN_T + al((size_t)INM * D * 2);
constexpr size_t WS_WQ_T = WS_WOUT_T + al((size_t)D * D * 2);
constexpr size_t WS_PU16 = WS_WQ_T + al((size_t)NQ * D * 2);
constexpr size_t WS_PV16 = WS_PU16 + al((size_t)NE * D * 2);
constexpr size_t WS_U = WS_PV16 + al((size_t)NE * D * 2);
constexpr size_t WS_Y = WS_U + al((size_t)T * D * 2);
constexpr size_t WS_P = WS_Y + al((size_t)T * D * 2);
constexpr size_t WS_SC = WS_P;
constexpr size_t WS_TS = WS_SC + al((size_t)T * NSC * 4);
constexpr size_t WS_TI = WS_TS + al((size_t)T * PH * 2 * TOPK * 4);
constexpr size_t WS_P_END = WS_P + al((size_t)T * INM * 2);
constexpr size_t WS_TI_END = WS_TI + al((size_t)T * PH * 2 * TOPK * 4);
constexpr size_t WS_END = WS_P_END > WS_TI_END ? WS_P_END : WS_TI_END;

struct Prm {
    const float *x, *c, *w_ada, *b_ada, *w_in, *b_in, *conv_w, *conv_b, *mnorm_w, *w_out, *ln1_w, *ln1_b, *wq, *subkeys, *peer_u, *peer_v, *ln2_w, *ln2_b;
    float* out;
    unsigned char* ws;
    HDF float* MOD() const { return (float*)(ws + WS_MOD); }
    HDF float* MODP() const { return (float*)(ws + WS_MODP); }
    HDF float* GATES() const { return (float*)(ws + WS_GATES); }
    HDF float* DEN() const { return (float*)(ws + WS_DEN); }
    HDF float* FLR() const { return (float*)(ws + WS_FLR); }
    HDF int* EIDX() const { return (int*)(ws + WS_EIDX); }
    HDF float* EW() const { return (float*)(ws + WS_EW); }
    HDF bf16_t* WIN_T() const { return (bf16_t*)(ws + WS_WIN_T); }
    HDF bf16_t* WOUT_T() const { return (bf16_t*)(ws + WS_WOUT_T); }
    HDF bf16_t* WQ_T() const { return (bf16_t*)(ws + WS_WQ_T); }
    HDF bf16_t* PU16() const { return (bf16_t*)(ws + WS_PU16); }
    HDF bf16_t* PV16() const { return (bf16_t*)(ws + WS_PV16); }
    HDF bf16_t* U() const { return (bf16_t*)(ws + WS_U); }
    HDF bf16_t* Y() const { return (bf16_t*)(ws + WS_Y); }
    HDF bf16_t* PJ() const { return (bf16_t*)(ws + WS_P); }
    HDF float* SC() const { return (float*)(ws + WS_SC); }
    HDF float* TS() const { return (float*)(ws + WS_TS); }
    HDF int* TI() const { return (int*)(ws + WS_TI); }
    HDF float* HF() const { return out; }
    HDF float* HB() const { return out + (size_t)T * MW; }
};

HDF float sigmoidf_(float x) { return 1.f / (1.f + expf(-x)); }
HDF float logsigmoidf_(float x) { return fminf(x, 0.f) - log1pf(expf(-fabsf(x))); }
HDF float gelu_exact(float x) { return 0.5f * x * (1.f + erff(x * 0.7071067811865476f)); }

HD void b_ada(const Prm& p, long n) {
    float acc[NB];
#pragma unroll
    for (int b = 0; b < NB; ++b) acc[b] = 0.f;
    for (int k = 0; k < D; ++k) {
        const float w = p.w_ada[(size_t)k * D6 + n];
#pragma unroll
        for (int b = 0; b < NB; ++b) { const float cv = p.c[b * D + k]; acc[b] += cv * sigmoidf_(cv) * w; }
    }
#pragma unroll
    for (int b = 0; b < NB; ++b) p.MOD()[(size_t)b * D6 + n] = acc[b] + p.b_ada[n];
}
HD void b_wt(const float* W, int ldw, int K, bf16_t* WT, long i) { const long n = i / K, k = i % K; WT[i] = f2bf(W[(size_t)k * ldw + n]); }
HD void b_tab(const float* src, bf16_t* dst, long i) { dst[i] = f2bf(src[i]); }
HD void b_ln_mod1(const Prm& p, long row) {
    const float* xr = p.x + (size_t)row * D; const int b = (int)(row / S);
    const float* sh = p.MOD() + (size_t)b * D6; const float* sc = sh + D;
    float s = 0.f; for (int d = 0; d < D; ++d) s += xr[d];
    const float mean = s / D; float q = 0.f; for (int d = 0; d < D; ++d) { const float t = xr[d] - mean; q += t * t; }
    const float rstd = 1.f / sqrtf(q / D + LN_EPS);
    for (int d = 0; d < D; ++d) p.U()[(size_t)row * D + d] = f2bf((xr[d] - mean) * rstd * (1.f + sc[d]) + sh[d]);
}
HD void b_gates(const Prm& p, long i) {
    const long row = i / NG; const int g = (int)(i % NG); float acc = 0.f;
    for (int d = 0; d < D; ++d) acc += bf2f(p.U()[(size_t)row * D + d]) * p.w_in[(size_t)d * INC + INM + g];
    p.GATES()[i] = acc + p.b_in[INM + g];
}
HD float b_dot16(const bf16_t* a, const bf16_t* b, int K) { float acc = 0.f; for (int k = 0; k < K; ++k) acc += bf2f(a[k]) * bf2f(b[k]); return acc; }
HD void b_gemm1(const Prm& p, long i) { const long row = i / INM; const int n = (int)(i % INM);
    p.PJ()[i] = f2bf(b_dot16(p.U() + (size_t)row * D, p.WIN_T() + (size_t)n * D, D) + p.b_in[n]); }
HD void b_conv(const Prm& p, long i) {
    const long row = i / CW; const int ch = (int)(i % CW); const int s = (int)(row % S);
    const bf16_t* pj = p.PJ(); float acc = p.conv_b[ch];
#pragma unroll
    for (int k = 0; k < 3; ++k) { const int s2 = s + k - 1; if (s2 >= 0 && s2 < S) { const size_t r2 = (size_t)(row + k - 1) * INM;
        acc += p.conv_w[k * CW + ch] * (bf2f(pj[r2 + O_GC + ch]) * bf2f(pj[r2 + O_HIN + ch])); } }
    p.Y()[(size_t)row * D + ch] = f2bf(bf2f(pj[(size_t)row * INM + O_GB + ch]) * acc);
}
HDF long ml_tok(int dir, int b, int pos) { return (long)b * S + (dir ? S - 1 - pos : pos); }
HD void b_mscan(const Prm& p, long i) {
    const int v = (int)(i % (MV + 1)), h = (int)((i / (MV + 1)) % MH), b = (int)((i / ((MV + 1) * MH)) % NB), dir = (int)(i / ((MV + 1) * MH * NB));
    float C[QK];
#pragma unroll
    for (int d = 0; d < QK; ++d) C[d] = 0.f;
    float m = 0.f; const float qs = 1.f / sqrtf((float)QK);
    float* H = dir ? p.HB() : p.HF();
    for (int pos = 0; pos < S; ++pos) {
        const long tok = ml_tok(dir, b, pos); const float* g = p.GATES() + tok * NG + dir * 8;
        const float ig = g[h], lf = logsigmoidf_(g[4 + h]);
        const float mn = fmaxf(lf + m, ig), dec = expf(lf + m - mn), wi = expf(ig - mn); m = mn;
        const bf16_t* pj = p.PJ() + (size_t)tok * INM; const float wv = wi * (v < MV ? bf2f(pj[O_V + h * MV + (v < MV ? v : 0)]) : 1.f); float num = 0.f;
#pragma unroll
        for (int d = 0; d < QK; ++d) { C[d] = dec * C[d] + wv * bf2f(pj[O_K + h * QK + d]); num += bf2f(pj[O_Q + h * QK + d]) * qs * C[d]; }
        if (v < MV) H[(size_t)tok * MW + h * MV + v] = num;
        else { p.DEN()[((size_t)dir * T + tok) * MH + h] = num; p.FLR()[((size_t)dir * T + tok) * MH + h] = expf(-mn); }
    }
}
HD void b_headnorm(const Prm& p, long i) {
    const long row = i / MH; const int h = (int)(i % MH);
    const float* hf = p.HF() + (size_t)row * MW + h * MV; const float* hb = p.HB() + (size_t)row * MW + h * MV;
    const float inf_ = 1.f / fmaxf(fabsf(p.DEN()[(size_t)row * MH + h]), p.FLR()[(size_t)row * MH + h]);
    const float inb_ = 1.f / fmaxf(fabsf(p.DEN()[((size_t)T + row) * MH + h]), p.FLR()[((size_t)T + row) * MH + h]);
    float s = 0.f; for (int v = 0; v < MV; ++v) s += hf[v] * inf_ + hb[v] * inb_;
    const float mean = s / MV; float q = 0.f; for (int v = 0; v < MV; ++v) { const float t = hf[v] * inf_ + hb[v] * inb_ - mean; q += t * t; }
    const float rstd = 1.f / sqrtf(q / MV + LN_EPS);
    for (int v = 0; v < MV; ++v) { const float hn = (hf[v] * inf_ + hb[v] * inb_ - mean) * rstd * p.mnorm_w[h * MV + v];
        const float og = sigmoidf_(bf2f(p.PJ()[(size_t)row * INM + O_O + h * MV + v]));
        p.Y()[(size_t)row * D + CW + h * MV + v] = f2bf(og * hn); }
}
HD void b_gemm2(const Prm& p, long i) { const long row = i / D; const int n = (int)(i % D); const int b = (int)(row / S);
    const float acc = b_dot16(p.Y() + (size_t)row * D, p.WOUT_T() + (size_t)n * D, D);
    p.out[i] = ALPHA * p.x[i] + p.MOD()[(size_t)b * D6 + 2 * D + n] * acc; }
HD void b_ln_mid(const Prm& p, long row) {
    float* zr = p.out + (size_t)row * D; const int b = (int)(row / S);
    const float* sh = p.MOD() + (size_t)b * D6 + 3 * D; const float* sc = sh + D;
    float s = 0.f; for (int d = 0; d < D; ++d) s += zr[d];
    float mean = s / D; float q = 0.f; for (int d = 0; d < D; ++d) { const float t = zr[d] - mean; q += t * t; }
    float rstd = 1.f / sqrtf(q / D + LN_EPS);
    s = 0.f; for (int d = 0; d < D; ++d) { const float x1 = (zr[d] - mean) * rstd * p.ln1_w[d] + p.ln1_b[d]; zr[d] = x1; s += x1; }
    mean = s / D; q = 0.f; for (int d = 0; d < D; ++d) { const float t = zr[d] - mean; q += t * t; }
    rstd = 1.f / sqrtf(q / D + LN_EPS);
    for (int d = 0; d < D; ++d) p.U()[(size_t)row * D + d] = f2bf((zr[d] - mean) * rstd * (1.f + sc[d]) + sh[d]);
}
HD void b_gemm3(const Prm& p, long i) { const long row = i / NQ; const int n = (int)(i % NQ);
    p.Y()[i] = f2bf(b_dot16(p.U() + (size_t)row * D, p.WQ_T() + (size_t)n * D, D)); }
HD void b_scores(const Prm& p, long i) { const long tok = i / NSC; const int c = (int)(i % NSC), grp = c / NK, n = c % NK;
    const bf16_t* q = p.Y() + (size_t)tok * NQ + grp * KH; const float* sk = p.subkeys + ((size_t)grp * NK + n) * KH; float acc = 0.f;
    for (int d = 0; d < KH; ++d) acc += bf2f(q[d]) * sk[d];
    p.SC()[i] = acc; }
HD void b_topk1(const Prm& p, long i) {
    const float* sc = p.SC() + (size_t)i * NK; float pv = INFINITY; int pi = -1;
    for (int r = 0; r < TOPK; ++r) { float best = -INFINITY; int bi = -1;
        for (int n = 0; n < NK; ++n) { const float v = sc[n]; const bool ok = (v < pv) || (v == pv && n > pi); if (ok && v > best) { best = v; bi = n; } }
        p.TS()[(size_t)i * TOPK + r] = best; p.TI()[(size_t)i * TOPK + r] = bi; pv = best; pi = bi; }
}
HD void b_topk2(const Prm& p, long i) {
    const float* s0 = p.TS() + (size_t)i * 2 * TOPK; const float* s1 = s0 + TOPK; const int* i0 = p.TI() + (size_t)i * 2 * TOPK; const int* i1 = i0 + TOPK;
    float pv = INFINITY; int pi = -1; float mx = 0.f, sum = 0.f;
    for (int r = 0; r < TOPK; ++r) { float best = -INFINITY; int bi = -1;
        for (int c = 0; c < TOPK * TOPK; ++c) { const float v = s0[c / TOPK] + s1[c % TOPK]; const bool ok = (v < pv) || (v == pv && c > pi); if (ok && v > best) { best = v; bi = c; } }
        if (r == 0) mx = best;
        const float e = expf(best - mx); sum += e;
        p.EIDX()[(size_t)i * TOPK + r] = i0[bi / TOPK] * NK + i1[bi % TOPK]; p.EW()[(size_t)i * TOPK + r] = e; pv = best; pi = bi; }
    for (int r = 0; r < TOPK; ++r) p.EW()[(size_t)i * TOPK + r] /= sum;
}
HD void b_up(const Prm& p, long i) { const long tok = i / NSLOT; const int e = p.EIDX()[i];
    p.EW()[i] *= gelu_exact(b_dot16(p.U() + (size_t)tok * D, p.PU16() + (size_t)e * D, D)); }
HD void b_down(const Prm& p, long i) { const long tok = i / D; const int d = (int)(i % D); const int b = (int)(tok / S); float y = 0.f;
    for (int sl = 0; sl < NSLOT; ++sl) y += p.EW()[tok * NSLOT + sl] * bf2f(p.PV16()[(size_t)p.EIDX()[tok * NSLOT + sl] * D + d]);
    p.out[i] = ALPHA * p.out[i] + p.MOD()[(size_t)b * D6 + 5 * D + d] * y; }
HD void b_ln2(const Prm& p, long row) {
    float* zr = p.out + (size_t)row * D;
    float s = 0.f; for (int d = 0; d < D; ++d) s += zr[d];
    const float mean = s / D; float q = 0.f; for (int d = 0; d < D; ++d) { const float t = zr[d] - mean; q += t * t; }
    const float rstd = 1.f / sqrtf(q / D + LN_EPS);
    for (int d = 0; d < D; ++d) zr[d] = (zr[d] - mean) * rstd * p.ln2_w[d] + p.ln2_b[d];
}
#include <cstdio>
#define LAS __attribute__((address_space(3)))
#define GAS __attribute__((address_space(1)))
namespace pg8 {
#define PG8_LAS __attribute__((address_space(3)))
typedef unsigned short bf16_t;
typedef short bf16x8 __attribute__((ext_vector_type(8)));
typedef float f32x4 __attribute__((ext_vector_type(4)));
typedef unsigned u32x4 __attribute__((ext_vector_type(4)));
constexpr int BM = 256, BK = 64, HALF = 128, HTB = HALF * BK * 2  , STAGE_BYTES = 8 * HTB, NXCD = 8, WGM = 8;

__host__ __device__ __forceinline__ int lds_byte(int r, int c) { const int st = (r >> 4) * 2 + (c >> 5), rr = r & 15, cc = c & 31, ob = rr * 64 + cc * 2; return st * 1024 + (ob ^ (((ob >> 9) & 1) << 5)); }
__host__ __device__ __forceinline__ void stage_rc(int b, int& R, int& C) { const int st = b / 1024, sb = b % 1024, swz = sb ^ (((sb >> 9) & 1) << 5); R = (st >> 1) * 16 + swz / 64; C = (st & 1) * 32 + (swz % 64) / 2; }
__host__ __device__ __forceinline__ int perm32(int rho) { const int n = rho >> 4, i = rho & 15; return 8 * (i >> 2) + 4 * n + (i & 3); }

struct Unit { int pm, pn; };
struct Gemm { const bf16_t* A; const bf16_t* Bt; int M, N, K; };

struct StaticOrder {
    int nM, nN, nwg, G, c;
    __host__ __device__ void init(int M, int N, int G_, int c_) { nM = M / BM; nN = N / BM; nwg = nM * nN; G = G_; c = c_; }
    __host__ __device__ bool next(int i, Unit& u) const {
        const long L = (long)i * G + c; if (L >= nwg) return false;
        int wgid = (int)L; { const int q = nwg / NXCD, r = nwg % NXCD, xcd = wgid % NXCD, off = wgid / NXCD; wgid = (xcd < r ? xcd * (q + 1) : r * (q + 1) + (xcd - r) * q) + off; }
        const int nig = WGM * nN, gid = wgid / nig, fm = gid * WGM, gsz = (nM - fm) < WGM ? (nM - fm) : WGM;
        u.pm = fm + ((wgid % nig) % gsz); u.pn = (wgid % nig) / gsz; return true;
    }
    __device__ __forceinline__ void a_ready(const Unit&) const {}
    __device__ __forceinline__ void done(const Unit&) const {}
};

__device__ __forceinline__ unsigned cvt_pk_bf16(float lo, float hi) { unsigned r; asm volatile("v_cvt_pk_bf16_f32 %0, %1, %2" : "=v"(r) : "v"(lo), "v"(hi)); return r; }
typedef float f32x2 __attribute__((ext_vector_type(2)));
__device__ __forceinline__ f32x2 gelu_pk(f32x2 v) {
    const f32x2 av = __builtin_elementwise_abs(v), d = av * 0.2316418882f + 1.0f;
    f32x2 t; t.x = __builtin_amdgcn_rcpf(d.x); t.y = __builtin_amdgcn_rcpf(d.y);
    f32x2 q = t * 0.5307027145f + (-0.7265760135f); q = q * t + 0.7107068705f; q = q * t + (-0.142248368f); q = q * t + 0.127414796f; q = q * t;
    const f32x2 s = (v * v) * (-0.72134752044f);
    f32x2 e; e.x = __builtin_amdgcn_exp2f(s.x); e.y = __builtin_amdgcn_exp2f(s.y);
    const f32x2 m = v * (q * e), r = v - m;
    f32x2 o; o.x = v.x < 0.f ? m.x : r.x; o.y = v.y < 0.f ? m.y : r.y; return o;
}

template <int ACT  > struct EpiBf16 {
    static constexpr bool PERM = true, AFTER_DRAIN = false; static_assert(ACT == 0 || ACT == 1, "EpiBf16: ACT is 0 (none) or 1 (gelu_pk)");
    bf16_t* O; int ldc; const float* bias; int split_cols; size_t split_stride; float scale0;
    __device__ __forceinline__ void operator()(const f32x4 (&acc)[2][2][4][2], const Unit& u, int wr, int wc, int fr, int fq) const {
        const int row0 = u.pm * BM + wr * 64 + fr; int colt = u.pn * BM; bf16_t* base = O;
        float sc = 1.f; if (split_cols) { const int t = colt / split_cols; base += (size_t)t * split_stride; colt -= t * split_cols; if (t == 0) sc = scale0; }
        const int col0 = colt + wc * 32 + 8 * fq, bcol0 = u.pn * BM + wc * 32 + 8 * fq;
        f32x4 bv[2][2];
#pragma unroll
        for (int bj = 0; bj < 2; ++bj)
#pragma unroll
            for (int n = 0; n < 2; ++n) bv[bj][n] = bias ? *(const f32x4*)(bias + bcol0 + bj * HALF + 4 * n) : (f32x4){0.f, 0.f, 0.f, 0.f};
#pragma unroll
        for (int ai = 0; ai < 2; ++ai)
#pragma unroll
            for (int m = 0; m < 4; ++m) { bf16_t* rowp = base + (size_t)(row0 + ai * HALF + m * 16) * ldc + col0;
#pragma unroll
                for (int bj = 0; bj < 2; ++bj) { f32x4 v0 = acc[ai][bj][m][0] + bv[bj][0], v1 = acc[ai][bj][m][1] + bv[bj][1];
                    if (ACT == 1) { f32x2 a = gelu_pk((f32x2){v0[0], v0[1]}), b = gelu_pk((f32x2){v0[2], v0[3]}), c = gelu_pk((f32x2){v1[0], v1[1]}), d = gelu_pk((f32x2){v1[2], v1[3]});
                        v0 = (f32x4){a.x, a.y, b.x, b.y}; v1 = (f32x4){c.x, c.y, d.x, d.y}; }
                    v0 = v0 * sc; v1 = v1 * sc; u32x4 w; w.x = cvt_pk_bf16(v0[0], v0[1]); w.y = cvt_pk_bf16(v0[2], v0[3]); w.z = cvt_pk_bf16(v1[0], v1[1]); w.w = cvt_pk_bf16(v1[2], v1[3]);
                    *(u32x4*)(rowp + bj * HALF) = w; } }
    }
};
template <class Epi, class Sched, bool ALIGN_EPI = false, bool SP2 = false>
__device__ __forceinline__ void gemm_phase(PG8_LAS unsigned char* lds, const Gemm g, const Sched& S, const Epi& E) {
    const int tid = threadIdx.x, wid = __builtin_amdgcn_readfirstlane(tid >> 6), lane = tid & 63, wr = wid >> 2, wc = wid & 3, fr = lane & 15, fq = lane >> 4;
    const int K = g.K, nt = K / BK;
    unsigned voffA[2], voffB[2];
#pragma unroll
    for (int i = 0; i < 2; ++i) { int R, C; stage_rc(tid * 16 + i * 8192, R, C); const int Rb = Epi::PERM ? ((R & ~31) + perm32(R & 31)) : R;
        voffA[i] = (unsigned)(R * K + C) * 2u; voffB[i] = (unsigned)(Rb * K + C) * 2u; }
    const size_t kstep = (size_t)(BK * 2);
    const size_t hstep = (size_t)HALF * K * 2;
    const size_t tstep = 2 * hstep;
    const unsigned ldsw = (unsigned)wid * 1024u;
    const int aoff = lds_byte(wr * 64 + fr, fq * 8), boff = lds_byte(wc * 32 + fr, fq * 8);
#define PG8_SA(b, h) (((b) * 2 + (h)) * HTB)
#define PG8_SB(b, h) ((4 + (b) * 2 + (h)) * HTB)
#define PG8_STAGE(bufoff, gbase, voff) do { _Pragma("unroll") for (int _i = 0; _i < 2; ++_i) \
        __builtin_amdgcn_global_load_lds((const unsigned*)((const char*)(gbase) + (voff)[_i]), (PG8_LAS unsigned*)(lds + (bufoff) + ldsw + _i * 8192), 16, 0, 0); } while (0)
#define PG8_LDA(dst, b, h) do { _Pragma("unroll") for (int m = 0; m < 4; ++m) _Pragma("unroll") for (int k = 0; k < 2; ++k) dst[m][k] = *(const PG8_LAS bf16x8*)(lds + PG8_SA(b, h) + aoff + m * 2048 + k * 1024); } while (0)
#define PG8_LDB(dst, b, h) do { _Pragma("unroll") for (int n = 0; n < 2; ++n) _Pragma("unroll") for (int k = 0; k < 2; ++k) dst[n][k] = *(const PG8_LAS bf16x8*)(lds + PG8_SB(b, h) + boff + n * 2048 + k * 1024); } while (0)
#define PG8_MMA(ai, bj, At, Bt) do { __builtin_amdgcn_s_setprio(1); _Pragma("unroll") for (int m = 0; m < 4; ++m) _Pragma("unroll") for (int n = 0; n < 2; ++n) _Pragma("unroll") for (int k = 0; k < 2; ++k) \
        acc[ai][bj][m][n] = __builtin_amdgcn_mfma_f32_16x16x32_bf16(Bt[n][k], At[m][k], acc[ai][bj][m][n], 0, 0, 0); __builtin_amdgcn_s_setprio(0); } while (0)
#define PG8_WAIT_V(n) asm volatile("s_waitcnt vmcnt(" #n ")" ::: "memory")
#define PG8_WAIT_L(n) asm volatile("s_waitcnt lgkmcnt(" #n ")" ::: "memory")
#define PG8_BAR __builtin_amdgcn_s_barrier()
#define PG8_SCHED __builtin_amdgcn_sched_barrier(0)
    Unit cur, nxt; int ui = 0;
    if (!S.next(0, cur)) return;
    f32x4 acc[2][2][4][2];
#pragma unroll
    for (int a = 0; a < 2; ++a)
#pragma unroll
        for (int b = 0; b < 2; ++b)
#pragma unroll
            for (int m = 0; m < 4; ++m)
#pragma unroll
                for (int n = 0; n < 2; ++n) acc[a][b][m][n] = (f32x4){0.f, 0.f, 0.f, 0.f};
    bf16x8 At[4][2], B0[2][2], B1[2][2];
    const char* cA = (const char*)g.A + (size_t)cur.pm * tstep; const char* cB = (const char*)g.Bt + (size_t)cur.pn * tstep;
    S.a_ready(cur);
    if constexpr (SP2) {
        PG8_STAGE(PG8_SB(0, 0), cB, voffB); PG8_STAGE(PG8_SB(0, 1), cB + hstep, voffB); PG8_STAGE(PG8_SA(0, 0), cA, voffA); PG8_STAGE(PG8_SA(0, 1), cA + hstep, voffA);
        if (wr == 1) PG8_BAR;
        PG8_WAIT_V(2); PG8_BAR;
        PG8_STAGE(PG8_SB(1, 0), cB + kstep, voffB); PG8_STAGE(PG8_SA(1, 0), cA + kstep, voffA); PG8_STAGE(PG8_SB(1, 1), cB + hstep + kstep, voffB);
        PG8_WAIT_V(6); PG8_BAR;
    } else {
        PG8_STAGE(PG8_SB(0, 0), cB, voffB); PG8_STAGE(PG8_SA(0, 0), cA, voffA); PG8_STAGE(PG8_SB(0, 1), cB + hstep, voffB); PG8_STAGE(PG8_SA(0, 1), cA + hstep, voffA);
        if (wr == 1) PG8_BAR;
        PG8_WAIT_V(4); PG8_BAR;
        PG8_STAGE(PG8_SB(1, 0), cB + kstep, voffB); PG8_STAGE(PG8_SA(1, 0), cA + kstep, voffA); PG8_STAGE(PG8_SB(1, 1), cB + hstep + kstep, voffB);
        PG8_WAIT_V(6); PG8_BAR;
    }
    for (;;) {
        const bool has_next = S.next(ui + 1, nxt);
        const char* nA = has_next ? (const char*)g.A + (size_t)nxt.pm * tstep : cA; const char* nB = has_next ? (const char*)g.Bt + (size_t)nxt.pn * tstep : cB;
        for (int t = 0; t < nt; t += 2) {
            const bool last = (t == nt - 2);
            const char* a1 = cA + (size_t)(t + 1) * kstep;
            const char* a2 = last ? nA : cA + (size_t)(t + 2) * kstep; const char* b2 = last ? nB : cB + (size_t)(t + 2) * kstep;
            const char* a3 = a2 + kstep; const char* b3 = b2 + kstep;
            if (last && has_next) S.a_ready(nxt);
            if constexpr (SP2) {
            PG8_LDB(B0, 0, 0); PG8_LDB(B1, 0, 1); PG8_SCHED; PG8_LDA(At, 0, 0); PG8_STAGE(PG8_SA(1, 1), a1 + hstep, voffA);
            PG8_WAIT_V(8); PG8_WAIT_L(0); PG8_BAR; PG8_MMA(0, 0, At, B0); PG8_MMA(0, 1, At, B1); PG8_BAR; PG8_SCHED;
            PG8_LDA(At, 0, 1); PG8_STAGE(PG8_SB(0, 0), b2, voffB); PG8_STAGE(PG8_SB(0, 1), b2 + hstep, voffB); PG8_STAGE(PG8_SA(0, 0), a2, voffA);
            PG8_WAIT_V(8); PG8_WAIT_L(0); PG8_BAR; PG8_MMA(1, 0, At, B0); PG8_MMA(1, 1, At, B1); PG8_BAR; PG8_SCHED;
            PG8_LDB(B0, 1, 0); PG8_LDB(B1, 1, 1); PG8_SCHED; PG8_LDA(At, 1, 0); PG8_STAGE(PG8_SA(0, 1), a2 + hstep, voffA);
            PG8_WAIT_V(8); PG8_WAIT_L(0); PG8_BAR; PG8_MMA(0, 0, At, B0); PG8_MMA(0, 1, At, B1); PG8_BAR; PG8_SCHED;
            PG8_LDA(At, 1, 1); PG8_STAGE(PG8_SB(1, 0), b3, voffB); PG8_STAGE(PG8_SB(1, 1), b3 + hstep, voffB); PG8_STAGE(PG8_SA(1, 0), a3, voffA);
            PG8_WAIT_V(8); PG8_WAIT_L(0); PG8_BAR; PG8_MMA(1, 0, At, B0); PG8_MMA(1, 1, At, B1); PG8_BAR; PG8_SCHED;
            } else {
            PG8_LDB(B0, 0, 0); PG8_SCHED; PG8_LDA(At, 0, 0); PG8_STAGE(PG8_SA(1, 1), a1 + hstep, voffA);
            PG8_WAIT_L(8); PG8_BAR; PG8_WAIT_L(0); PG8_MMA(0, 0, At, B0); PG8_BAR; PG8_SCHED;
            PG8_LDB(B1, 0, 1); PG8_STAGE(PG8_SB(0, 0), b2, voffB);
            PG8_BAR; PG8_WAIT_L(0); PG8_MMA(0, 1, At, B1); PG8_BAR;
            PG8_LDA(At, 0, 1); PG8_STAGE(PG8_SA(0, 0), a2, voffA);
            PG8_BAR; PG8_WAIT_L(0); PG8_MMA(1, 0, At, B0); PG8_BAR; PG8_SCHED;
            PG8_STAGE(PG8_SB(0, 1), b2 + hstep, voffB);
            PG8_WAIT_V(6); PG8_BAR; PG8_MMA(1, 1, At, B1); PG8_BAR;
            PG8_LDB(B0, 1, 0); PG8_SCHED; PG8_LDA(At, 1, 0); PG8_STAGE(PG8_SA(0, 1), a2 + hstep, voffA);
            PG8_WAIT_L(8); PG8_BAR; PG8_WAIT_L(0); PG8_MMA(0, 0, At, B0); PG8_BAR; PG8_SCHED;
            PG8_LDB(B1, 1, 1); PG8_STAGE(PG8_SB(1, 0), b3, voffB);
            PG8_BAR; PG8_WAIT_L(0); PG8_MMA(0, 1, At, B1); PG8_BAR;
            PG8_LDA(At, 1, 1); PG8_STAGE(PG8_SA(1, 0), a3, voffA);
            PG8_BAR; PG8_WAIT_L(0); PG8_MMA(1, 0, At, B0); PG8_BAR; PG8_SCHED;
            PG8_STAGE(PG8_SB(1, 1), b3 + hstep, voffB);
            PG8_WAIT_V(6); PG8_BAR; PG8_MMA(1, 1, At, B1); PG8_BAR;
            }
        }
        if constexpr (ALIGN_EPI) { if (wr == 0) PG8_BAR; }
        if constexpr (!Epi::AFTER_DRAIN) { E(acc, cur, wr, wc, fr, fq); S.done(cur); }
        if (!has_next) break;
#pragma unroll
        for (int a = 0; a < 2; ++a)
#pragma unroll
            for (int b = 0; b < 2; ++b)
#pragma unroll
                for (int m = 0; m < 4; ++m)
#pragma unroll
                    for (int n = 0; n < 2; ++n) acc[a][b][m][n] = (f32x4){0.f, 0.f, 0.f, 0.f};
        cur = nxt; cA = nA; cB = nB; ++ui;
        if constexpr (ALIGN_EPI) { if (wr == 1) PG8_BAR; }
    }
    PG8_WAIT_V(0);
    if constexpr (!ALIGN_EPI) { if (wr == 0) PG8_BAR; }
    PG8_BAR;
    if constexpr (Epi::AFTER_DRAIN) { E.fused(acc, cur, wr, wc, fr, fq, lds, wid, lane); S.done(cur); }
#undef PG8_SA
#undef PG8_SB
#undef PG8_STAGE
#undef PG8_LDA
#undef PG8_LDB
#undef PG8_MMA
#undef PG8_WAIT_V
#undef PG8_WAIT_L
#undef PG8_BAR
#undef PG8_SCHED
}
}
#define XB_TMO      128
#define XB_XCNT(j)  (256  + 64 * (j))
#define XB_XSUB(j)  (1280 + 64 * (j))
#define XB_XGEN(j)  (2304 + 64 * (j))
#define XB_TOP      3328
#define XB_TOPGEN   3392
#define XCD_BAR_WORDS 3456
#define XB_SPIN_CAP (1u << 18)

__device__ __forceinline__ unsigned xb_ld(unsigned* p)              { return __hip_atomic_load(p, __ATOMIC_RELAXED, __HIP_MEMORY_SCOPE_AGENT); }
__device__ __forceinline__ unsigned xb_add(unsigned* p, unsigned v) { return __hip_atomic_fetch_add(p, v, __ATOMIC_RELAXED, __HIP_MEMORY_SCOPE_AGENT); }
__device__ __forceinline__ unsigned xb_xcc_id() { return (unsigned)__builtin_amdgcn_s_getreg((3 << 11) | 20) & 0xFu; }
#define XB_SPIN(cond, bar) do { unsigned _sp = 0; while (cond) { __builtin_amdgcn_s_sleep(1); \
    if ((++_sp & 255u) == 0u) { if (xb_ld(&(bar)[XB_TMO])) break; if (_sp > XB_SPIN_CAP) { atomicAdd(&(bar)[XB_TMO], 1u); break; } } } } while (0)

struct XcdBarrier {
    unsigned* bar; unsigned x;
    volatile LAS unsigned* st;
};

__device__ __forceinline__ XcdBarrier xcd_barrier_post(unsigned* bar, volatile LAS unsigned* st) {
    XcdBarrier b; b.bar = bar; b.x = xb_xcc_id(); b.st = st;
    if (threadIdx.x == 0) (void)xb_add(&bar[XB_XCNT(b.x)], 1u);
    return b;
}
__device__ __forceinline__ void xcd_barrier_complete(unsigned* bar, unsigned x, unsigned& nloc, unsigned& nx) {
    const unsigned G = gridDim.x * gridDim.y * gridDim.z;
    unsigned sum, cnt, mine, sp = 0u;
    for (;;) {
        sum = 0u; cnt = 0u; mine = 0u;
#pragma unroll
        for (unsigned j = 0; j < 16; ++j) { const unsigned c = xb_ld(&bar[XB_XCNT(j)]); sum += c; cnt += (c > 0u) ? 1u : 0u; mine = (j == x) ? c : mine; }
        if (sum == G) break;
        __builtin_amdgcn_s_sleep(1);
        if ((++sp & 255u) == 0u) { if (xb_ld(&bar[XB_TMO])) break; if (sp > XB_SPIN_CAP) { atomicAdd(&bar[XB_TMO], 1u); break; } }
    }
    nloc = mine > 0u ? mine : 1u; nx = cnt > 0u ? cnt : 1u;
}

__device__ __forceinline__ void xcd_barrier(const XcdBarrier& b) {
    asm volatile("s_waitcnt vmcnt(0)" ::: "memory");
    __syncthreads();
    if (threadIdx.x == 0) {
        unsigned* bar = b.bar;
        __builtin_amdgcn_s_waitcnt(0);
        unsigned nloc = b.st[0], nx = b.st[1];
        if (nloc == 0u) { xcd_barrier_complete(bar, b.x, nloc, nx); b.st[0] = nloc; b.st[1] = nx; }
        const unsigned old = xb_add(&bar[XB_XSUB(b.x)], 1u);
        const unsigned gen = old / nloc;
        if (old + 1u == (gen + 1u) * nloc) {
            __builtin_amdgcn_fence(__ATOMIC_RELEASE, "agent");
            asm volatile("s_waitcnt vmcnt(0)" ::: "memory");
            const unsigned og = xb_add(&bar[XB_TOP], 1u);
            const unsigned tg = og / nx;
            if (og + 1u == (tg + 1u) * nx) xb_add(&bar[XB_TOPGEN], 1u);
            else XB_SPIN(xb_ld(&bar[XB_TOPGEN]) == tg, bar);
            __builtin_amdgcn_fence(__ATOMIC_ACQUIRE, "agent");
            xb_add(&bar[XB_XGEN(b.x)], 1u);
            asm volatile("s_waitcnt vmcnt(0)" ::: "memory");
        } else {
            XB_SPIN(xb_ld(&bar[XB_XGEN(b.x)]) == gen, bar);
            __builtin_amdgcn_fence(__ATOMIC_ACQUIRE, "agent");
            asm volatile("s_waitcnt vmcnt(0)" ::: "memory");
        }
    }
    __syncthreads();
}
constexpr int NWAVES = 8, NTHR = 512;
constexpr int RING_BYTES = 131072, LDSCTL_OFF = RING_BYTES, MISC_OFF = LDSCTL_OFF + 320, LDS_BYTES = 147456;
constexpr int CW_BAR = 4096;
#ifndef MK_N_LAUNCHES
#define MK_N_LAUNCHES 1
#endif
constexpr int NPHASE = 13;

typedef float f4v __attribute__((ext_vector_type(4)));
typedef unsigned u2v __attribute__((ext_vector_type(2)));
struct Frame { LAS unsigned char* lds; int tid, lane, wave, G, bid; };
__device__ __forceinline__ float wave_sum(float v) {
#pragma unroll
    for (int o = 1; o < 64; o <<= 1) v += __shfl_xor(v, o);
    return v;
}
__device__ __forceinline__ unsigned pk2(float lo, float hi) { return (unsigned)f2bf(lo) | ((unsigned)f2bf(hi) << 16); }
__device__ __forceinline__ float bflo(unsigned w) { return u_as_f(w << 16); }
__device__ __forceinline__ float bfhi(unsigned w) { return u_as_f(w & 0xffff0000u); }

__device__ __forceinline__ void p0_ada_item(const Prm& p, const Frame& F, int item) {
    LAS float* sl = (LAS float*)F.lds;
    const int ks = item / (D6 / 1024), cg = item % (D6 / 1024), k0 = ks * 128, n0 = cg * 1024 + 2 * F.tid;
    for (int i = F.tid; i < NB * 128; i += NTHR) { const int b = i / 128, k = i % 128; const float cv = p.c[b * D + k0 + k]; sl[i] = cv / (1.f + __expf(-cv)); }
    __syncthreads();
    float a0[NB], a1[NB];
#pragma unroll
    for (int b = 0; b < NB; ++b) { a0[b] = 0.f; a1[b] = 0.f; }
#pragma unroll 4
    for (int k = 0; k < 128; ++k) { const float2 w = *(const float2*)(p.w_ada + (size_t)(k0 + k) * D6 + n0);
#pragma unroll
        for (int b = 0; b < NB; ++b) { const float s = sl[b * 128 + k]; a0[b] += s * w.x; a1[b] += s * w.y; } }
#pragma unroll
    for (int b = 0; b < NB; ++b) *(float2*)(p.MODP() + ((size_t)ks * NB + b) * D6 + n0) = make_float2(a0[b], a1[b]);
    __syncthreads();
}
__device__ __forceinline__ void p0_transpose_item(const float* W, int ldw, int K, int N, bf16_t* WT, LAS float* scr, int item, int lane) {
    const int nblk = N / 32, kb = item / nblk, nb = item % nblk, k0 = 64 * kb, n0 = 32 * nb;
#pragma unroll 8
    for (int i = 0; i < 32; ++i) { const int kk = 2 * i + (lane >> 5); scr[kk * 33 + (lane & 31)] = W[(size_t)(k0 + kk) * ldw + n0 + (lane & 31)]; }
    asm volatile("s_waitcnt lgkmcnt(0)" ::: "memory");
    const int c = lane & 7;
#pragma unroll
    for (int j = 0; j < 4; ++j) { const int n = (lane >> 3) + 8 * j; const LAS float* s = scr + (8 * c) * 33 + n;
        uint4 o; o.x = pk2(s[0 * 33], s[1 * 33]); o.y = pk2(s[2 * 33], s[3 * 33]); o.z = pk2(s[4 * 33], s[5 * 33]); o.w = pk2(s[6 * 33], s[7 * 33]);
        *(uint4*)(WT + (size_t)(n0 + n) * K + k0 + 8 * c) = o; }
    asm volatile("s_waitcnt lgkmcnt(0)" ::: "memory");
}
__device__ __forceinline__ void phase0(const Prm& p, const Frame& F) {
    if (F.bid < 16 * (D6 / 1024)) p0_ada_item(p, F, F.bid);
    for (int it = F.bid + F.G; it < 16 * (D6 / 1024); it += F.G) p0_ada_item(p, F, it);
    LAS float* scr = (LAS float*)(F.lds + F.wave * 16384);
    const int gw = F.bid * NWAVES + F.wave, NGW = F.G * NWAVES;
    constexpr int I_IN = (D / 64) * (INM / 32), I_O = (D / 64) * (D / 32), I_Q = (D / 64) * (NQ / 32);
    for (int it = gw; it < I_IN + I_O + I_Q; it += NGW) {
        int r = it;
        if (r < I_IN) { p0_transpose_item(p.w_in, INC, D, INM, p.WIN_T(), scr, r, F.lane); continue; } r -= I_IN;
        if (r < I_O) { p0_transpose_item(p.w_out, D, D, D, p.WOUT_T(), scr, r, F.lane); continue; } r -= I_O;
        p0_transpose_item(p.wq, NQ, D, NQ, p.WQ_T(), scr, r, F.lane);
    }
    const size_t n8 = (size_t)NE * D / 8, gt = (size_t)F.bid * NTHR + F.tid, GT = (size_t)F.G * NTHR;
    for (size_t i = gt; i < 2 * n8; i += GT) { const bool second = i >= n8; const size_t j = second ? i - n8 : i;
        const float4* src = (const float4*)(second ? p.peer_v : p.peer_u) + 2 * j; const float4 a = src[0], b = src[1];
        uint4 o; o.x = pk2(a.x, a.y); o.y = pk2(a.z, a.w); o.z = pk2(b.x, b.y); o.w = pk2(b.z, b.w);
        ((uint4*)(second ? p.PV16() : p.PU16()))[j] = o; }
}
__device__ __forceinline__ void phase1(const Prm& p, const Frame& F) {
    LAS float* SH = (LAS float*)F.lds; LAS float* SC1 = SH + D;
    LAS bf16_t* WG = (LAS bf16_t*)(F.lds + 2 * D * 4);
    const int rows_per = T / F.G;
    for (int idx = F.bid * NTHR + F.tid; idx < NB * D6; idx += F.G * NTHR) {
        const int n = idx % D6, b = idx / D6; float s = 0.f;
        for (int ks = 0; ks < 16; ++ks) s += p.MODP()[((size_t)ks * NB + b) * D6 + n];
        p.MOD()[idx] = s + p.b_ada[n]; }
    for (int idx = F.tid; idx < NG * D; idx += NTHR) { const int d = idx / NG, g = idx % NG; WG[g * D + d] = f2bf(p.w_in[(size_t)d * INC + INM + g]); }
    int cur_b = -1;
    for (int r0 = F.bid * rows_per; r0 < (F.bid + 1) * rows_per; r0 += NWAVES) {
        const int b = r0 / S;
        if (b != cur_b) { __syncthreads();
            for (int n = F.tid; n < 2 * D; n += NTHR) { float s = 0.f; for (int ks = 0; ks < 16; ++ks) s += p.MODP()[((size_t)ks * NB + b) * D6 + n];
                s += p.b_ada[n]; SH[n] = n < D ? s : 1.f + s; }
            cur_b = b; __syncthreads(); }
        const int row = r0 + F.wave; const float4* xr = (const float4*)(p.x + (size_t)row * D) + F.lane;
        float4 v[8]; float s = 0.f;
#pragma unroll
        for (int j = 0; j < 8; ++j) { v[j] = xr[64 * j]; s += (v[j].x + v[j].y) + (v[j].z + v[j].w); }
        const float mean = wave_sum(s) * (1.f / D); float s2 = 0.f;
#pragma unroll
        for (int j = 0; j < 8; ++j) { v[j].x -= mean; v[j].y -= mean; v[j].z -= mean; v[j].w -= mean; s2 += (v[j].x * v[j].x + v[j].y * v[j].y) + (v[j].z * v[j].z + v[j].w * v[j].w); }
        const float rstd = 1.f / sqrtf(wave_sum(s2) * (1.f / D) + LN_EPS);
        uint2* o8 = (uint2*)(p.U() + (size_t)row * D) + F.lane;
#pragma unroll
        for (int j = 0; j < 8; ++j) { const int c0 = 4 * F.lane + 256 * j; const f4v sh = *(const LAS f4v*)(SH + c0), sc = *(const LAS f4v*)(SC1 + c0);
            v[j].x = v[j].x * rstd * sc.x + sh.x; v[j].y = v[j].y * rstd * sc.y + sh.y; v[j].z = v[j].z * rstd * sc.z + sh.z; v[j].w = v[j].w * rstd * sc.w + sh.w;
            o8[64 * j] = make_uint2(pk2(v[j].x, v[j].y), pk2(v[j].z, v[j].w)); }
        float gacc = 0.f;
#pragma unroll 1
        for (int g = 0; g < NG; ++g) { float a = 0.f;
#pragma unroll
            for (int j = 0; j < 8; ++j) { const u2v w = *(const LAS u2v*)(WG + g * D + 4 * F.lane + 256 * j); a += v[j].x * bflo(w.x) + v[j].y * bfhi(w.x) + v[j].z * bflo(w.y) + v[j].w * bfhi(w.y); }
            a = wave_sum(a); if (F.lane == g) gacc = a; }
        if (F.lane < NG) p.GATES()[(size_t)row * NG + F.lane] = gacc + p.b_in[INM + F.lane];
    }
}
__device__ __forceinline__ void phase3a(const Prm& p, const Frame& F) {
    const size_t gt = (size_t)F.bid * NTHR + F.tid, GT = (size_t)F.G * NTHR;
    for (size_t i = gt; i < (size_t)T * (CW / 8); i += GT) {
        const size_t row = i / (CW / 8); const int ch = (int)(i % (CW / 8)) * 8, s = (int)(row % S);
        float acc[8];
#pragma unroll
        for (int e = 0; e < 8; ++e) acc[e] = p.conv_b[ch + e];
#pragma unroll
        for (int k = 0; k < 3; ++k) { const int s2 = s + k - 1; if (s2 < 0 || s2 >= S) continue; const bf16_t* pr = p.PJ() + (size_t)(row + k - 1) * INM;
            const uint4 gc = *(const uint4*)(pr + O_GC + ch), hi = *(const uint4*)(pr + O_HIN + ch); const float* cw = p.conv_w + k * CW + ch;
            acc[0] += cw[0] * (bflo(gc.x) * bflo(hi.x)); acc[1] += cw[1] * (bfhi(gc.x) * bfhi(hi.x)); acc[2] += cw[2] * (bflo(gc.y) * bflo(hi.y)); acc[3] += cw[3] * (bfhi(gc.y) * bfhi(hi.y));
            acc[4] += cw[4] * (bflo(gc.z) * bflo(hi.z)); acc[5] += cw[5] * (bfhi(gc.z) * bfhi(hi.z)); acc[6] += cw[6] * (bflo(gc.w) * bflo(hi.w)); acc[7] += cw[7] * (bfhi(gc.w) * bfhi(hi.w)); }
        const uint4 gb = *(const uint4*)(p.PJ() + row * INM + O_GB + ch); uint4 o;
        o.x = pk2(bflo(gb.x) * acc[0], bfhi(gb.x) * acc[1]); o.y = pk2(bflo(gb.y) * acc[2], bfhi(gb.y) * acc[3]); o.z = pk2(bflo(gb.z) * acc[4], bfhi(gb.z) * acc[5]); o.w = pk2(bflo(gb.w) * acc[6], bfhi(gb.w) * acc[7]);
        *(uint4*)(p.Y() + row * D + ch) = o; }
}
__device__ __forceinline__ void phase4(const Prm& p, const Frame& F) {
    static_assert(MV == 256 && MH == 4, "head j = float4 slot j of the lane");
    const int gw = F.bid * NWAVES + F.wave, NGW = F.G * NWAVES;
    for (int row = gw; row < T; row += NGW) {
        const float4* hf = (const float4*)(p.HF() + (size_t)row * MW) + F.lane; const float4* hb = (const float4*)(p.HB() + (size_t)row * MW) + F.lane;
        const uint2* og = (const uint2*)(p.PJ() + (size_t)row * INM + O_O) + F.lane; uint2* yo = (uint2*)(p.Y() + (size_t)row * D + CW) + F.lane;
#pragma unroll
        for (int j = 0; j < MH; ++j) {
            const float i_f = 1.f / fmaxf(fabsf(p.DEN()[(size_t)row * MH + j]), p.FLR()[(size_t)row * MH + j]);
            const float i_b = 1.f / fmaxf(fabsf(p.DEN()[((size_t)T + row) * MH + j]), p.FLR()[((size_t)T + row) * MH + j]);
            const float4 a = hf[64 * j], b = hb[64 * j]; float4 h = make_float4(a.x * i_f + b.x * i_b, a.y * i_f + b.y * i_b, a.z * i_f + b.z * i_b, a.w * i_f + b.w * i_b);
            const float mean = wave_sum((h.x + h.y) + (h.z + h.w)) * (1.f / MV);
            h.x -= mean; h.y -= mean; h.z -= mean; h.w -= mean;
            const float rstd = 1.f / sqrtf(wave_sum((h.x * h.x + h.y * h.y) + (h.z * h.z + h.w * h.w)) * (1.f / MV) + LN_EPS);
            const float4 nw = *((const float4*)(p.mnorm_w + j * MV) + F.lane); const uint2 o = og[64 * j];
            yo[64 * j] = make_uint2(pk2(h.x * rstd * nw.x * sigmoidf_(bflo(o.x)), h.y * rstd * nw.y * sigmoidf_(bfhi(o.x))), pk2(h.z * rstd * nw.z * sigmoidf_(bflo(o.y)), h.w * rstd * nw.w * sigmoidf_(bfhi(o.y)))); }
    }
}
struct EpiZ {
    static constexpr bool PERM = false, AFTER_DRAIN = false;
    const float* x; const float* mod; float* out;
    __device__ __forceinline__ void operator()(const pg8::f32x4 (&acc)[2][2][4][2], const pg8::Unit& u, int wr, int wc, int fr, int fq) const {
        const int col0 = u.pn * 256 + wc * 32 + 4 * fq;
#pragma unroll
        for (int ai = 0; ai < 2; ++ai)
#pragma unroll
            for (int m = 0; m < 4; ++m) { const int row = u.pm * 256 + ai * 128 + wr * 64 + m * 16 + fr; const float* g1 = mod + (size_t)(row / S) * D6 + 2 * D; const size_t off = (size_t)row * D + col0;
#pragma unroll
                for (int bj = 0; bj < 2; ++bj)
#pragma unroll
                    for (int n = 0; n < 2; ++n) { const int c = bj * 128 + n * 16; const pg8::f32x4 xv = *(const pg8::f32x4*)(x + off + c), gv = *(const pg8::f32x4*)(g1 + col0 + c);
                        *(pg8::f32x4*)(out + off + c) = xv * ALPHA + gv * acc[ai][bj][m][n]; } }
    }
};
__device__ __forceinline__ void phase6(const Prm& p, const Frame& F) {
    const int gw = F.bid * NWAVES + F.wave, NGW = F.G * NWAVES;
    for (int row = gw; row < T; row += NGW) {
        float4* zr = (float4*)(p.out + (size_t)row * D) + F.lane; const float* mod = p.MOD() + (size_t)(row / S) * D6;
        float4 v[8]; float s = 0.f;
#pragma unroll
        for (int j = 0; j < 8; ++j) { v[j] = zr[64 * j]; s += (v[j].x + v[j].y) + (v[j].z + v[j].w); }
        float mean = wave_sum(s) * (1.f / D), s2 = 0.f;
#pragma unroll
        for (int j = 0; j < 8; ++j) { v[j].x -= mean; v[j].y -= mean; v[j].z -= mean; v[j].w -= mean; s2 += (v[j].x * v[j].x + v[j].y * v[j].y) + (v[j].z * v[j].z + v[j].w * v[j].w); }
        float rstd = 1.f / sqrtf(wave_sum(s2) * (1.f / D) + LN_EPS); s = 0.f;
#pragma unroll
        for (int j = 0; j < 8; ++j) { const float4 w = *((const float4*)p.ln1_w + F.lane + 64 * j), bb = *((const float4*)p.ln1_b + F.lane + 64 * j);
            v[j].x = v[j].x * rstd * w.x + bb.x; v[j].y = v[j].y * rstd * w.y + bb.y; v[j].z = v[j].z * rstd * w.z + bb.z; v[j].w = v[j].w * rstd * w.w + bb.w;
            zr[64 * j] = v[j]; s += (v[j].x + v[j].y) + (v[j].z + v[j].w); }
        mean = wave_sum(s) * (1.f / D); s2 = 0.f;
#pragma unroll
        for (int j = 0; j < 8; ++j) { v[j].x -= mean; v[j].y -= mean; v[j].z -= mean; v[j].w -= mean; s2 += (v[j].x * v[j].x + v[j].y * v[j].y) + (v[j].z * v[j].z + v[j].w * v[j].w); }
        rstd = 1.f / sqrtf(wave_sum(s2) * (1.f / D) + LN_EPS);
        uint2* o8 = (uint2*)(p.U() + (size_t)row * D) + F.lane;
#pragma unroll
        for (int j = 0; j < 8; ++j) { const float4 sh = *((const float4*)(mod + 3 * D) + F.lane + 64 * j), sc = *((const float4*)(mod + 4 * D) + F.lane + 64 * j);
            o8[64 * j] = make_uint2(pk2(v[j].x * rstd * (1.f + sc.x) + sh.x, v[j].y * rstd * (1.f + sc.y) + sh.y), pk2(v[j].z * rstd * (1.f + sc.z) + sh.z, v[j].w * rstd * (1.f + sc.w) + sh.w)); }
    }
}
__device__ __forceinline__ float dot8(const uint4 a, const float* u) {
    return (bflo(a.x) * u[0] + bfhi(a.x) * u[1]) + (bflo(a.y) * u[2] + bfhi(a.y) * u[3]) + (bflo(a.z) * u[4] + bfhi(a.z) * u[5]) + (bflo(a.w) * u[6] + bfhi(a.w) * u[7]);
}
__device__ __forceinline__ void phase9(const Prm& p, const Frame& F) {
    static_assert(NSLOT == 128 && D == 2048, "lane <-> slot map");
    const int gw = F.bid * NWAVES + F.wave, NGW = F.G * NWAVES;
    for (int tok = gw; tok < T; tok += NGW) {
        float u[32];
#pragma unroll
        for (int j = 0; j < 4; ++j) { const uint4 a = *((const uint4*)(p.U() + (size_t)tok * D) + F.lane + 64 * j);
            u[8 * j] = bflo(a.x); u[8 * j + 1] = bfhi(a.x); u[8 * j + 2] = bflo(a.y); u[8 * j + 3] = bfhi(a.y); u[8 * j + 4] = bflo(a.z); u[8 * j + 5] = bfhi(a.z); u[8 * j + 6] = bflo(a.w); u[8 * j + 7] = bfhi(a.w); }
        const int* ei = p.EIDX() + (size_t)tok * NSLOT; float r0 = 0.f, r1 = 0.f;
#pragma unroll 2
        for (int sl = 0; sl < 64; ++sl) {
            const int e0 = __builtin_amdgcn_readfirstlane(ei[sl]), e1 = __builtin_amdgcn_readfirstlane(ei[64 + sl]);
            const uint4* ra = (const uint4*)(p.PU16() + (size_t)e0 * D) + F.lane; const uint4* rb = (const uint4*)(p.PU16() + (size_t)e1 * D) + F.lane;
            float d0 = 0.f, d1 = 0.f;
#pragma unroll
            for (int j = 0; j < 4; ++j) { d0 += dot8(ra[64 * j], u + 8 * j); d1 += dot8(rb[64 * j], u + 8 * j); }
            d0 = wave_sum(d0); d1 = wave_sum(d1);
            if (F.lane == sl) { r0 = d0; r1 = d1; } }
        float* ew = p.EW() + (size_t)tok * NSLOT;
        ew[F.lane] *= gelu_exact(r0); ew[64 + F.lane] *= gelu_exact(r1);
    }
}
__device__ __forceinline__ void fma8(const uint4 a, float w, float* acc) {
    acc[0] += w * bflo(a.x); acc[1] += w * bfhi(a.x); acc[2] += w * bflo(a.y); acc[3] += w * bfhi(a.y); acc[4] += w * bflo(a.z); acc[5] += w * bfhi(a.z); acc[6] += w * bflo(a.w); acc[7] += w * bfhi(a.w);
}
__device__ __forceinline__ void phase10(const Prm& p, const Frame& F) {
    const int gw = F.bid * NWAVES + F.wave, NGW = F.G * NWAVES;
    for (int tok = gw; tok < T; tok += NGW) {
        float acc[32];
#pragma unroll
        for (int i = 0; i < 32; ++i) acc[i] = 0.f;
        const int* ei = p.EIDX() + (size_t)tok * NSLOT; const float* ew = p.EW() + (size_t)tok * NSLOT;
#pragma unroll 4
        for (int sl = 0; sl < NSLOT; ++sl) {
            const int e = __builtin_amdgcn_readfirstlane(ei[sl]); const float w = u_as_f(__builtin_amdgcn_readfirstlane(f_as_u(ew[sl])));
            const uint4* rv = (const uint4*)(p.PV16() + (size_t)e * D) + F.lane;
#pragma unroll
            for (int j = 0; j < 4; ++j) fma8(rv[64 * j], w, acc + 8 * j); }
        float* orow = p.out + (size_t)tok * D; const float* g2 = p.MOD() + (size_t)(tok / S) * D6 + 5 * D; float s = 0.f;
#pragma unroll
        for (int j = 0; j < 4; ++j)
#pragma unroll
            for (int h = 0; h < 2; ++h) { const int c0 = 8 * F.lane + 512 * j + 4 * h; const float4 x1 = *(const float4*)(orow + c0), g = *(const float4*)(g2 + c0); float* a = acc + 8 * j + 4 * h;
                a[0] = ALPHA * x1.x + g.x * a[0]; a[1] = ALPHA * x1.y + g.y * a[1]; a[2] = ALPHA * x1.z + g.z * a[2]; a[3] = ALPHA * x1.w + g.w * a[3]; s += (a[0] + a[1]) + (a[2] + a[3]); }
        const float mean = wave_sum(s) * (1.f / D); float s2 = 0.f;
#pragma unroll
        for (int i = 0; i < 32; ++i) { acc[i] -= mean; s2 += acc[i] * acc[i]; }
        const float rstd = 1.f / sqrtf(wave_sum(s2) * (1.f / D) + LN_EPS);
#pragma unroll
        for (int j = 0; j < 4; ++j)
#pragma unroll
            for (int h = 0; h < 2; ++h) { const int c0 = 8 * F.lane + 512 * j + 4 * h; const float4 w = *(const float4*)(p.ln2_w + c0), bb = *(const float4*)(p.ln2_b + c0); const float* a = acc + 8 * j + 4 * h;
                *(float4*)(orow + c0) = make_float4(a[0] * rstd * w.x + bb.x, a[1] * rstd * w.y + bb.y, a[2] * rstd * w.z + bb.z, a[3] * rstd * w.w + bb.w); }
    }
}

struct Args { const float* in[18]; float* out; unsigned char* ws; int ph_lo, ph_hi; };
__global__ void __launch_bounds__(NTHR, 2) mk_fwd(Args args) {
    extern __shared__ __attribute__((aligned(16))) unsigned char lds_raw[];
    Frame F; F.lds = (LAS unsigned char*)lds_raw; F.tid = threadIdx.x; F.lane = F.tid & 63; F.wave = __builtin_amdgcn_readfirstlane(F.tid >> 6); F.G = gridDim.x; F.bid = blockIdx.x;
    Prm p; p.x = args.in[0]; p.c = args.in[1]; p.w_ada = args.in[2]; p.b_ada = args.in[3]; p.w_in = args.in[4]; p.b_in = args.in[5]; p.conv_w = args.in[6]; p.conv_b = args.in[7]; p.mnorm_w = args.in[8];
    p.w_out = args.in[9]; p.ln1_w = args.in[10]; p.ln1_b = args.in[11]; p.wq = args.in[12]; p.subkeys = args.in[13]; p.peer_u = args.in[14]; p.peer_v = args.in[15]; p.ln2_w = args.in[16]; p.ln2_b = args.in[17];
    p.out = args.out; p.ws = args.ws;
    volatile LAS unsigned* MISC = (volatile LAS unsigned*)(F.lds + MISC_OFF);
    for (int u = F.tid; u < (LDS_BYTES - LDSCTL_OFF) / 4; u += NTHR) ((LAS unsigned*)(F.lds + LDSCTL_OFF))[u] = 0u;
    __syncthreads();
    const int lo = args.ph_lo, hi = args.ph_hi;
    XcdBarrier bar; bar.bar = (unsigned*)(p.ws + WS_CTL) + CW_BAR; bar.x = 0; bar.st = nullptr;
    if (hi - lo > 1) bar = xcd_barrier_post((unsigned*)(p.ws + WS_CTL) + CW_BAR, MISC + 8);
#define IN(k) (lo <= (k) && (k) < hi)
#define SEAM(k) do { if (IN(k) && IN((k) + 1)) xcd_barrier(bar); } while (0)
    const long gt = (long)F.bid * NTHR + F.tid, GT = (long)F.G * NTHR;
    if (IN(0)) { phase0(p, F); } SEAM(0);
    if (IN(1)) { phase1(p, F); } SEAM(1);
    if (IN(2)) { pg8::Gemm g{p.U(), p.WIN_T(), T, INM, D}; pg8::StaticOrder So; So.init(T, INM, F.G, F.bid);
        pg8::EpiBf16<0> E{p.PJ(), INM, p.b_in, 0, 0, 1.f};
        pg8::gemm_phase<pg8::EpiBf16<0>, pg8::StaticOrder, true, true>(F.lds, g, So, E); } SEAM(2);
    if (IN(3)) { phase3a(p, F); for (long i = gt; i < (long)2 * NB * MH * (MV + 1); i += GT) b_mscan(p, i); } SEAM(3);
    if (IN(4)) { phase4(p, F); } SEAM(4);
    if (IN(5)) { pg8::Gemm g{p.Y(), p.WOUT_T(), T, D, D}; pg8::StaticOrder So; So.init(T, D, F.G, F.bid);
        EpiZ E{p.x, p.MOD(), p.out};
        pg8::gemm_phase<EpiZ, pg8::StaticOrder, true, true>(F.lds, g, So, E); } SEAM(5);
    if (IN(6)) { phase6(p, F); } SEAM(6);
    if (IN(7)) { pg8::Gemm g{p.U(), p.WQ_T(), T, NQ, D}; pg8::StaticOrder So; So.init(T, NQ, F.G, F.bid);
        pg8::EpiBf16<0> E{p.Y(), NQ, nullptr, 0, 0, 1.f};
        pg8::gemm_phase<pg8::EpiBf16<0>, pg8::StaticOrder, true, true>(F.lds, g, So, E); } SEAM(7);
    if (IN(8)) { for (long i = gt; i < (long)T * NSC; i += GT) b_scores(p, i); } SEAM(8);
    if (IN(9)) { for (long i = gt; i < (long)T * PH * 2; i += GT) b_topk1(p, i); } SEAM(9);
    if (IN(10)) { for (long i = gt; i < (long)T * PH; i += GT) b_topk2(p, i); } SEAM(10);
    if (IN(11)) { phase9(p, F); } SEAM(11);
    if (IN(12)) { phase10(p, F); }
#undef IN
#undef SEAM
}

extern "C" void kernel_launch(void* const* d_in, const int* in_sizes, int n_in, void* d_out, int out_size, void* d_ws, size_t ws_size, hipStream_t stream) {
    static int grid = 0;
    if (grid == 0) {
        if (n_in != 18 || out_size != T * D || ws_size < WS_END) { fprintf(stderr, "kernel_launch: unexpected shapes (n_in %d out %d ws %zu, need %zu)\n", n_in, out_size, ws_size, (size_t)WS_END); grid = -1; return; }
        int dev = 0, cus = 0, per_cu = 0;
        if (hipGetDevice(&dev) != hipSuccess || hipDeviceGetAttribute(&cus, hipDeviceAttributeMultiprocessorCount, dev) != hipSuccess) { grid = -1; return; }
        if (hipFuncSetAttribute((const void*)mk_fwd, hipFuncAttributeMaxDynamicSharedMemorySize, LDS_BYTES) != hipSuccess) { fprintf(stderr, "kernel_launch: hipFuncSetAttribute failed\n"); grid = -1; return; }
        if (hipOccupancyMaxActiveBlocksPerMultiprocessor(&per_cu, (const void*)mk_fwd, NTHR, LDS_BYTES) != hipSuccess || per_cu < 1) { fprintf(stderr, "kernel_launch: occupancy query says %d\n", per_cu); }
        (void)hipGetLastError();
        grid = cus;
        if (T % grid != 0 || (T / grid) % NWAVES != 0) { fprintf(stderr, "kernel_launch: grid %d does not divide the rows\n", grid); grid = -1; return; }
    }
    if (grid < 0) return;
    (void)hipMemsetAsync((char*)d_ws + WS_CTL, 0, 1u << 20, stream);
    Args a{};
    for (int i = 0; i < 18; ++i) a.in[i] = (const float*)d_in[i];
    a.out = (float*)d_out; a.ws = (unsigned char*)d_ws;
#if MK_N_LAUNCHES == 1
    a.ph_lo = 0; a.ph_hi = NPHASE;
    hipLaunchKernelGGL(mk_fwd, dim3(grid), dim3(NTHR), LDS_BYTES, stream, a);
#else
    for (int k = 0; k < 13; ++k) { a.ph_lo = k; a.ph_hi = k + 1; hipLaunchKernelGGL(mk_fwd, dim3(grid), dim3(NTHR), LDS_BYTES, stream, a); }
#endif
}
```

```cpp
#define MK_N_LAUNCHES 1
#if defined(HOST_EMU)
#include <cmath>
#include <cstdint>
#include <cstring>
#include <cstddef>
#define HD inline
#define HDF inline
#else
#include <hip/hip_runtime.h>
#define HD __host__ __device__ __forceinline__
#define HDF __host__ __device__ __forceinline__
#endif

#ifndef CFG_D
#define CFG_D 2048
#define CFG_B 8
#define CFG_S 2048
#define CFG_PH 8
#define CFG_NK 128
#define CFG_TOPK 16
#define CFG_KD 256
#endif
constexpr int D = CFG_D, NB = CFG_B, S = CFG_S, T = NB * S;
constexpr int CW = D / 2, MW = D - CW, MH = 4, MV = MW / MH, QK = MV / 2, NG = 16, CHUNK = 64;
constexpr int INC = 3 * CW + 2 * MH * QK + 2 * MW + NG;
constexpr int INM = INC - NG;
constexpr int O_GB = 0, O_GC = CW, O_HIN = 2 * CW, O_Q = 3 * CW, O_K = O_Q + MH * QK, O_V = O_K + MH * QK, O_O = O_V + MW;
constexpr int PH = CFG_PH, NK = CFG_NK, TOPK = CFG_TOPK, KD = CFG_KD, KH = KD / 2, NE = NK * NK, NSLOT = PH * TOPK;
constexpr int NQ = PH * KD;
static_assert(PH * 2 * NK == NQ || true, "");
constexpr int NSC = PH * 2 * NK;
constexpr float LN_EPS = 1e-5f;
constexpr float ALPHA = 1.189207115002721f;
constexpr int D6 = 6 * D;

typedef unsigned short bf16_t;
HDF unsigned f_as_u(float f) { unsigned u; memcpy(&u, &f, 4); return u; }
HDF float u_as_f(unsigned u) { float f; memcpy(&f, &u, 4); return f; }
HDF bf16_t f2bf(float f) { unsigned u = f_as_u(f); return (bf16_t)((u + 0x7fffu + ((u >> 16) & 1u)) >> 16); }
HDF float bf2f(bf16_t h) { return u_as_f((unsigned)h << 16); }

constexpr size_t al(size_t x) { return (x + 1048575) & ~(size_t)1048575; }
constexpr size_t WS_CTL = 0;
constexpr size_t WS_MOD = al(1);
constexpr size_t WS_MODP = WS_MOD + al((size_t)NB * D6 * 4);
constexpr int NKS = 32;
constexpr size_t WS_GATES = WS_MODP + al((size_t)NKS * NB * D6 * 4);
constexpr size_t WS_DEN = WS_GATES + al((size_t)T * NG * 4);
constexpr size_t WS_FLR = WS_DEN + al((size_t)4 * T * MH * 4);
constexpr size_t WS_EIDX = WS_FLR + al((size_t)2 * T * MH * 4);
constexpr size_t WS_EW = WS_EIDX + al((size_t)T * NSLOT * 4);
constexpr size_t WS_WIN_T = WS_EW + al((size_t)T * NSLOT * 4);
constexpr size_t WS_WOUT_T = WS_WIN_T + al((size_t)INM * D * 2);
constexpr size_t WS_WQ_T = WS_WOUT_T + al((size_t)D * D * 2);
constexpr size_t WS_PU16 = WS_WQ_T + al((size_t)NQ * D * 2);
constexpr size_t WS_PV16 = WS_PU16 + al((size_t)NE * D * 2);
constexpr size_t WS_U = WS_PV16 + al((size_t)NE * D * 2);
constexpr size_t WS_Y = WS_U + al((size_t)T * D * 2);
constexpr size_t WS_P = WS_Y + al((size_t)T * D * 2);
constexpr size_t WS_SC = WS_P;
constexpr size_t WS_TS = WS_SC + al((size_t)T * NSC * 4);
constexpr size_t WS_TI = WS_TS + al((size_t)T * PH * 2 * TOPK * 4);
constexpr size_t WS_P_END = WS_P + al((size_t)T * INM * 2);
constexpr size_t WS_TI_END = WS_TI + al((size_t)T * PH * 2 * TOPK * 4);
constexpr size_t WS_END = WS_P_END > WS_TI_END ? WS_P_END : WS_TI_END;

struct Prm {
    const float *x, *c, *w_ada, *b_ada, *w_in, *b_in, *conv_w, *conv_b, *mnorm_w, *w_out, *ln1_w, *ln1_b, *wq, *subkeys, *peer_u, *peer_v, *ln2_w, *ln2_b;
    float* out;
    unsigned char* ws;
    HDF float* MOD() const { return (float*)(ws + WS_MOD); }
    HDF float* MODP() const { return (float*)(ws + WS_MODP); }
    HDF float* GATES() const { return (float*)(ws + WS_GATES); }
    HDF float* DEN() const { return (float*)(ws + WS_DEN); }
    HDF float* FLR() const { return (float*)(ws + WS_FLR); }
    HDF int* EIDX() const { return (int*)(ws + WS_EIDX); }
    HDF float* EW() const { return (float*)(ws + WS_EW); }
    HDF bf16_t* WIN_T() const { return (bf16_t*)(ws + WS_WIN_T); }
    HDF bf16_t* WOUT_T() const { return (bf16_t*)(ws + WS_WOUT_T); }
    HDF bf16_t* WQ_T() const { return (bf16_t*)(ws + WS_WQ_T); }
    HDF bf16_t* PU16() const { return (bf16_t*)(ws + WS_PU16); }
    HDF bf16_t* PV16() const { return (bf16_t*)(ws + WS_PV16); }
    HDF unsigned char* PU8() const { return ws + WS_PU16; }
    HDF unsigned char* PV8() const { return ws + WS_PV16; }
    HDF unsigned short* PVH() const { return (unsigned short*)(ws + WS_PV16); }
    HDF float* RSU() const { return (float*)(ws + WS_PU16 + (size_t)NE * D); }
    HDF float* RSV() const { return (float*)(ws + WS_PV16 + (size_t)NE * D); }
    HDF bf16_t* U() const { return (bf16_t*)(ws + WS_U); }
    HDF bf16_t* Y() const { return (bf16_t*)(ws + WS_Y); }
    HDF bf16_t* PJ() const { return (bf16_t*)(ws + WS_P); }
    HDF float* SC() const { return (float*)(ws + WS_SC); }
    HDF float* TS() const { return (float*)(ws + WS_TS); }
    HDF int* TI() const { return (int*)(ws + WS_TI); }
    HDF float* HF() const { return out; }
    HDF float* HB() const { return out + (size_t)T * MW; }
    HDF bf16_t* HF16() const { return (bf16_t*)out; }
    HDF bf16_t* HB16() const { return (bf16_t*)out + (size_t)T * MW; }
};

HDF float sigmoidf_(float x) { return 1.f / (1.f + expf(-x)); }
HDF float logsigmoidf_(float x) { return fminf(x, 0.f) - log1pf(expf(-fabsf(x))); }
HDF float gelu_exact(float x) { return 0.5f * x * (1.f + erff(x * 0.7071067811865476f)); }

HD void b_ada(const Prm& p, long n) {
    float acc[NB];
#pragma unroll
    for (int b = 0; b < NB; ++b) acc[b] = 0.f;
    for (int k = 0; k < D; ++k) {
        const float w = p.w_ada[(size_t)k * D6 + n];
#pragma unroll
        for (int b = 0; b < NB; ++b) { const float cv = p.c[b * D + k]; acc[b] += cv * sigmoidf_(cv) * w; }
    }
#pragma unroll
    for (int b = 0; b < NB; ++b) p.MOD()[(size_t)b * D6 + n] = acc[b] + p.b_ada[n];
}
HD void b_wt(const float* W, int ldw, int K, bf16_t* WT, long i) { const long n = i / K, k = i % K; WT[i] = f2bf(W[(size_t)k * ldw + n]); }
HD void b_tab(const float* src, bf16_t* dst, long i) { dst[i] = f2bf(src[i]); }
HD void b_ln_mod1(const Prm& p, long row) {
    const float* xr = p.x + (size_t)row * D; const int b = (int)(row / S);
    const float* sh = p.MOD() + (size_t)b * D6; const float* sc = sh + D;
    float s = 0.f; for (int d = 0; d < D; ++d) s += xr[d];
    const float mean = s / D; float q = 0.f; for (int d = 0; d < D; ++d) { const float t = xr[d] - mean; q += t * t; }
    const float rstd = 1.f / sqrtf(q / D + LN_EPS);
    for (int d = 0; d < D; ++d) p.U()[(size_t)row * D + d] = f2bf((xr[d] - mean) * rstd * (1.f + sc[d]) + sh[d]);
}
HD void b_gates(const Prm& p, long i) {
    const long row = i / NG; const int g = (int)(i % NG); float acc = 0.f;
    for (int d = 0; d < D; ++d) acc += bf2f(p.U()[(size_t)row * D + d]) * p.w_in[(size_t)d * INC + INM + g];
    p.GATES()[i] = acc + p.b_in[INM + g];
}
HD float b_dot16(const bf16_t* a, const bf16_t* b, int K) { float acc = 0.f; for (int k = 0; k < K; ++k) acc += bf2f(a[k]) * bf2f(b[k]); return acc; }
HD void b_gemm1(const Prm& p, long i) { const long row = i / INM; const int n = (int)(i % INM);
    p.PJ()[i] = f2bf(b_dot16(p.U() + (size_t)row * D, p.WIN_T() + (size_t)n * D, D) + p.b_in[n]); }
HD void b_conv(const Prm& p, long i) {
    const long row = i / CW; const int ch = (int)(i % CW); const int s = (int)(row % S);
    const bf16_t* pj = p.PJ(); float acc = p.conv_b[ch];
#pragma unroll
    for (int k = 0; k < 3; ++k) { const int s2 = s + k - 1; if (s2 >= 0 && s2 < S) { const size_t r2 = (size_t)(row + k - 1) * INM;
        acc += p.conv_w[k * CW + ch] * (bf2f(pj[r2 + O_GC + ch]) * bf2f(pj[r2 + O_HIN + ch])); } }
    p.Y()[(size_t)row * D + ch] = f2bf(bf2f(pj[(size_t)row * INM + O_GB + ch]) * acc);
}
HDF long ml_tok(int dir, int b, int pos) { return (long)b * S + (dir ? S - 1 - pos : pos); }
HD void b_mscan(const Prm& p, long i) {
    const int v = (int)(i % (MV + 1)), h = (int)((i / (MV + 1)) % MH), b = (int)((i / ((MV + 1) * MH)) % NB), dir = (int)(i / ((MV + 1) * MH * NB));
    float C[QK];
#pragma unroll
    for (int d = 0; d < QK; ++d) C[d] = 0.f;
    float m = 0.f; const float qs = 1.f / sqrtf((float)QK);
    float* H = dir ? p.HB() : p.HF();
    for (int pos = 0; pos < S; ++pos) {
        const long tok = ml_tok(dir, b, pos); const float* g = p.GATES() + tok * NG + dir * 8;
        const float ig = g[h], lf = logsigmoidf_(g[4 + h]);
        const float mn = fmaxf(lf + m, ig), dec = expf(lf + m - mn), wi = expf(ig - mn); m = mn;
        const bf16_t* pj = p.PJ() + (size_t)tok * INM; const float wv = wi * (v < MV ? bf2f(pj[O_V + h * MV + (v < MV ? v : 0)]) : 1.f); float num = 0.f;
#pragma unroll
        for (int d = 0; d < QK; ++d) { C[d] = dec * C[d] + wv * bf2f(pj[O_K + h * QK + d]); num += bf2f(pj[O_Q + h * QK + d]) * qs * C[d]; }
        if (v < MV) H[(size_t)tok * MW + h * MV + v] = num;
        else { p.DEN()[((size_t)dir * T + tok) * MH + h] = num; p.FLR()[((size_t)dir * T + tok) * MH + h] = expf(-mn); }
    }
}
HD void b_headnorm(const Prm& p, long i) {
    const long row = i / MH; const int h = (int)(i % MH);
    const float* hf = p.HF() + (size_t)row * MW + h * MV; const float* hb = p.HB() + (size_t)row * MW + h * MV;
    const float inf_ = 1.f / fmaxf(fabsf(p.DEN()[(size_t)row * MH + h]), p.FLR()[(size_t)row * MH + h]);
    const float inb_ = 1.f / fmaxf(fabsf(p.DEN()[((size_t)T + row) * MH + h]), p.FLR()[((size_t)T + row) * MH + h]);
    float s = 0.f; for (int v = 0; v < MV; ++v) s += hf[v] * inf_ + hb[v] * inb_;
    const float mean = s / MV; float q = 0.f; for (int v = 0; v < MV; ++v) { const float t = hf[v] * inf_ + hb[v] * inb_ - mean; q += t * t; }
    const float rstd = 1.f / sqrtf(q / MV + LN_EPS);
    for (int v = 0; v < MV; ++v) { const float hn = (hf[v] * inf_ + hb[v] * inb_ - mean) * rstd * p.mnorm_w[h * MV + v];
        const float og = sigmoidf_(bf2f(p.PJ()[(size_t)row * INM + O_O + h * MV + v]));
        p.Y()[(size_t)row * D + CW + h * MV + v] = f2bf(og * hn); }
}
HD void b_gemm2(const Prm& p, long i) { const long row = i / D; const int n = (int)(i % D); const int b = (int)(row / S);
    const float acc = b_dot16(p.Y() + (size_t)row * D, p.WOUT_T() + (size_t)n * D, D);
    p.out[i] = ALPHA * p.x[i] + p.MOD()[(size_t)b * D6 + 2 * D + n] * acc; }
HD void b_ln_mid(const Prm& p, long row) {
    float* zr = p.out + (size_t)row * D; const int b = (int)(row / S);
    const float* sh = p.MOD() + (size_t)b * D6 + 3 * D; const float* sc = sh + D;
    float s = 0.f; for (int d = 0; d < D; ++d) s += zr[d];
    float mean = s / D; float q = 0.f; for (int d = 0; d < D; ++d) { const float t = zr[d] - mean; q += t * t; }
    float rstd = 1.f / sqrtf(q / D + LN_EPS);
    s = 0.f; for (int d = 0; d < D; ++d) { const float x1 = (zr[d] - mean) * rstd * p.ln1_w[d] + p.ln1_b[d]; zr[d] = x1; s += x1; }
    mean = s / D; q = 0.f; for (int d = 0; d < D; ++d) { const float t = zr[d] - mean; q += t * t; }
    rstd = 1.f / sqrtf(q / D + LN_EPS);
    for (int d = 0; d < D; ++d) p.U()[(size_t)row * D + d] = f2bf((zr[d] - mean) * rstd * (1.f + sc[d]) + sh[d]);
}
HD void b_gemm3(const Prm& p, long i) { const long row = i / NQ; const int n = (int)(i % NQ);
    p.Y()[i] = f2bf(b_dot16(p.U() + (size_t)row * D, p.WQ_T() + (size_t)n * D, D)); }
HD void b_scores(const Prm& p, long i) { const long tok = i / NSC; const int c = (int)(i % NSC), grp = c / NK, n = c % NK;
    const bf16_t* q = p.Y() + (size_t)tok * NQ + grp * KH; const float* sk = p.subkeys + ((size_t)grp * NK + n) * KH; float acc = 0.f;
    for (int d = 0; d < KH; ++d) acc += bf2f(q[d]) * sk[d];
    p.SC()[i] = acc; }
HD void b_topk1(const Prm& p, long i) {
    const float* sc = p.SC() + (size_t)i * NK; float pv = INFINITY; int pi = -1;
    for (int r = 0; r < TOPK; ++r) { float best = -INFINITY; int bi = -1;
        for (int n = 0; n < NK; ++n) { const float v = sc[n]; const bool ok = (v < pv) || (v == pv && n > pi); if (ok && v > best) { best = v; bi = n; } }
        p.TS()[(size_t)i * TOPK + r] = best; p.TI()[(size_t)i * TOPK + r] = bi; pv = best; pi = bi; }
}
HD void b_topk2(const Prm& p, long i) {
    const float* s0 = p.TS() + (size_t)i * 2 * TOPK; const float* s1 = s0 + TOPK; const int* i0 = p.TI() + (size_t)i * 2 * TOPK; const int* i1 = i0 + TOPK;
    float pv = INFINITY; int pi = -1; float mx = 0.f, sum = 0.f;
    for (int r = 0; r < TOPK; ++r) { float best = -INFINITY; int bi = -1;
        for (int c = 0; c < TOPK * TOPK; ++c) { const float v = s0[c / TOPK] + s1[c % TOPK]; const bool ok = (v < pv) || (v == pv && c > pi); if (ok && v > best) { best = v; bi = c; } }
        if (r == 0) mx = best;
        const float e = expf(best - mx); sum += e;
        p.EIDX()[(size_t)i * TOPK + r] = i0[bi / TOPK] * NK + i1[bi % TOPK]; p.EW()[(size_t)i * TOPK + r] = e; pv = best; pi = bi; }
    for (int r = 0; r < TOPK; ++r) p.EW()[(size_t)i * TOPK + r] /= sum;
}
HD void b_up(const Prm& p, long i) { const long tok = i / NSLOT; const int e = p.EIDX()[i];
    p.EW()[i] *= gelu_exact(b_dot16(p.U() + (size_t)tok * D, p.PU16() + (size_t)e * D, D)); }
HD void b_down(const Prm& p, long i) { const long tok = i / D; const int d = (int)(i % D); const int b = (int)(tok / S); float y = 0.f;
    for (int sl = 0; sl < NSLOT; ++sl) y += p.EW()[tok * NSLOT + sl] * bf2f(p.PV16()[(size_t)p.EIDX()[tok * NSLOT + sl] * D + d]);
    p.out[i] = ALPHA * p.out[i] + p.MOD()[(size_t)b * D6 + 5 * D + d] * y; }
HD void b_ln2(const Prm& p, long row) {
    float* zr = p.out + (size_t)row * D;
    float s = 0.f; for (int d = 0; d < D; ++d) s += zr[d];
    const float mean = s / D; float q = 0.f; for (int d = 0; d < D; ++d) { const float t = zr[d] - mean; q += t * t; }
    const float rstd = 1.f / sqrtf(q / D + LN_EPS);
    for (int d = 0; d < D; ++d) zr[d] = (zr[d] - mean) * rstd * p.ln2_w[d] + p.ln2_b[d];
}
#include <cstdio>
#define LAS __attribute__((address_space(3)))
#define GAS __attribute__((address_space(1)))
namespace pg8 {
#define PG8_LAS __attribute__((address_space(3)))
typedef unsigned short bf16_t;
typedef short bf16x8 __attribute__((ext_vector_type(8)));
typedef float f32x4 __attribute__((ext_vector_type(4)));
typedef unsigned u32x4 __attribute__((ext_vector_type(4)));
constexpr int BM = 256, BK = 64, HALF = 128, HTB = HALF * BK * 2  , STAGE_BYTES = 8 * HTB, NXCD = 8, WGM = 8;

__host__ __device__ __forceinline__ int lds_byte(int r, int c) { const int st = (r >> 4) * 2 + (c >> 5), rr = r & 15, cc = c & 31, ob = rr * 64 + cc * 2; return st * 1024 + (ob ^ (((ob >> 9) & 1) << 5)); }
__host__ __device__ __forceinline__ void stage_rc(int b, int& R, int& C) { const int st = b / 1024, sb = b % 1024, swz = sb ^ (((sb >> 9) & 1) << 5); R = (st >> 1) * 16 + swz / 64; C = (st & 1) * 32 + (swz % 64) / 2; }
__host__ __device__ __forceinline__ int perm32(int rho) { const int n = rho >> 4, i = rho & 15; return 8 * (i >> 2) + 4 * n + (i & 3); }

struct Unit { int pm, pn; };
struct Gemm { const bf16_t* A; const bf16_t* Bt; int M, N, K; };

struct StaticOrder {
    int nM, nN, nwg, G, c;
    __host__ __device__ void init(int M, int N, int G_, int c_) { nM = M / BM; nN = N / BM; nwg = nM * nN; G = G_; c = c_; }
    __host__ __device__ bool next(int i, Unit& u) const {
        const long L = (long)i * G + c; if (L >= nwg) return false;
        int wgid = (int)L; { const int q = nwg / NXCD, r = nwg % NXCD, xcd = wgid % NXCD, off = wgid / NXCD; wgid = (xcd < r ? xcd * (q + 1) : r * (q + 1) + (xcd - r) * q) + off; }
        const int nig = WGM * nN, gid = wgid / nig, fm = gid * WGM, gsz = (nM - fm) < WGM ? (nM - fm) : WGM;
        u.pm = fm + ((wgid % nig) % gsz); u.pn = (wgid % nig) / gsz; return true;
    }
    __device__ __forceinline__ void a_ready(const Unit&) const {}
    __device__ __forceinline__ void done(const Unit&) const {}
};

__device__ __forceinline__ unsigned cvt_pk_bf16(float lo, float hi) { unsigned r; asm volatile("v_cvt_pk_bf16_f32 %0, %1, %2" : "=v"(r) : "v"(lo), "v"(hi)); return r; }
typedef float f32x2 __attribute__((ext_vector_type(2)));
__device__ __forceinline__ f32x2 gelu_pk(f32x2 v) {
    const f32x2 av = __builtin_elementwise_abs(v), d = av * 0.2316418882f + 1.0f;
    f32x2 t; t.x = __builtin_amdgcn_rcpf(d.x); t.y = __builtin_amdgcn_rcpf(d.y);
    f32x2 q = t * 0.5307027145f + (-0.7265760135f); q = q * t + 0.7107068705f; q = q * t + (-0.142248368f); q = q * t + 0.127414796f; q = q * t;
    const f32x2 s = (v * v) * (-0.72134752044f);
    f32x2 e; e.x = __builtin_amdgcn_exp2f(s.x); e.y = __builtin_amdgcn_exp2f(s.y);
    const f32x2 m = v * (q * e), r = v - m;
    f32x2 o; o.x = v.x < 0.f ? m.x : r.x; o.y = v.y < 0.f ? m.y : r.y; return o;
}

template <int ACT  > struct EpiBf16 {
    static constexpr bool PERM = true, AFTER_DRAIN = false; static_assert(ACT == 0 || ACT == 1, "EpiBf16: ACT is 0 (none) or 1 (gelu_pk)");
    bf16_t* O; int ldc; const float* bias; int split_cols; size_t split_stride; float scale0;
    __device__ __forceinline__ void operator()(const f32x4 (&acc)[2][2][4][2], const Unit& u, int wr, int wc, int fr, int fq) const {
        const int row0 = u.pm * BM + wr * 64 + fr; int colt = u.pn * BM; bf16_t* base = O;
        float sc = 1.f; if (split_cols) { const int t = colt / split_cols; base += (size_t)t * split_stride; colt -= t * split_cols; if (t == 0) sc = scale0; }
        const int col0 = colt + wc * 32 + 8 * fq, bcol0 = u.pn * BM + wc * 32 + 8 * fq;
        f32x4 bv[2][2];
#pragma unroll
        for (int bj = 0; bj < 2; ++bj)
#pragma unroll
            for (int n = 0; n < 2; ++n) bv[bj][n] = bias ? *(const f32x4*)(bias + bcol0 + bj * HALF + 4 * n) : (f32x4){0.f, 0.f, 0.f, 0.f};
#pragma unroll
        for (int ai = 0; ai < 2; ++ai)
#pragma unroll
            for (int m = 0; m < 4; ++m) { bf16_t* rowp = base + (size_t)(row0 + ai * HALF + m * 16) * ldc + col0;
#pragma unroll
                for (int bj = 0; bj < 2; ++bj) { f32x4 v0 = acc[ai][bj][m][0] + bv[bj][0], v1 = acc[ai][bj][m][1] + bv[bj][1];
                    if (ACT == 1) { f32x2 a = gelu_pk((f32x2){v0[0], v0[1]}), b = gelu_pk((f32x2){v0[2], v0[3]}), c = gelu_pk((f32x2){v1[0], v1[1]}), d = gelu_pk((f32x2){v1[2], v1[3]});
                        v0 = (f32x4){a.x, a.y, b.x, b.y}; v1 = (f32x4){c.x, c.y, d.x, d.y}; }
                    v0 = v0 * sc; v1 = v1 * sc; u32x4 w; w.x = cvt_pk_bf16(v0[0], v0[1]); w.y = cvt_pk_bf16(v0[2], v0[3]); w.z = cvt_pk_bf16(v1[0], v1[1]); w.w = cvt_pk_bf16(v1[2], v1[3]);
                    *(u32x4*)(rowp + bj * HALF) = w; } }
    }
};
template <class Epi, class Sched, bool ALIGN_EPI = false, bool SP2 = false>
__device__ __forceinline__ void gemm_phase(PG8_LAS unsigned char* lds, const Gemm g, const Sched& S, const Epi& E) {
    const int tid = threadIdx.x, wid = __builtin_amdgcn_readfirstlane(tid >> 6), lane = tid & 63, wr = wid >> 2, wc = wid & 3, fr = lane & 15, fq = lane >> 4;
    const int K = g.K, nt = K / BK;
    unsigned voffA[2], voffB[2];
#pragma unroll
    for (int i = 0; i < 2; ++i) { int R, C; stage_rc(tid * 16 + i * 8192, R, C); const int Rb = Epi::PERM ? ((R & ~31) + perm32(R & 31)) : R;
        voffA[i] = (unsigned)(R * K + C) * 2u; voffB[i] = (unsigned)(Rb * K + C) * 2u; }
    const size_t kstep = (size_t)(BK * 2);
    const size_t hstep = (size_t)HALF * K * 2;
    const size_t tstep = 2 * hstep;
    const unsigned ldsw = (unsigned)wid * 1024u;
    const int aoff = lds_byte(wr * 64 + fr, fq * 8), boff = lds_byte(wc * 32 + fr, fq * 8);
#define PG8_SA(b, h) (((b) * 2 + (h)) * HTB)
#define PG8_SB(b, h) ((4 + (b) * 2 + (h)) * HTB)
#define PG8_STAGE(bufoff, gbase, voff) do { _Pragma("unroll") for (int _i = 0; _i < 2; ++_i) \
        __builtin_amdgcn_global_load_lds((const unsigned*)((const char*)(gbase) + (voff)[_i]), (PG8_LAS unsigned*)(lds + (bufoff) + ldsw + _i * 8192), 16, 0, 0); } while (0)
#define PG8_LDA(dst, b, h) do { _Pragma("unroll") for (int m = 0; m < 4; ++m) _Pragma("unroll") for (int k = 0; k < 2; ++k) dst[m][k] = *(const PG8_LAS bf16x8*)(lds + PG8_SA(b, h) + aoff + m * 2048 + k * 1024); } while (0)
#define PG8_LDB(dst, b, h) do { _Pragma("unroll") for (int n = 0; n < 2; ++n) _Pragma("unroll") for (int k = 0; k < 2; ++k) dst[n][k] = *(const PG8_LAS bf16x8*)(lds + PG8_SB(b, h) + boff + n * 2048 + k * 1024); } while (0)
#define PG8_MMA(ai, bj, At, Bt) do { __builtin_amdgcn_s_setprio(1); _Pragma("unroll") for (int m = 0; m < 4; ++m) _Pragma("unroll") for (int n = 0; n < 2; ++n) _Pragma("unroll") for (int k = 0; k < 2; ++k) \
        acc[ai][bj][m][n] = __builtin_amdgcn_mfma_f32_16x16x32_bf16(Bt[n][k], At[m][k], acc[ai][bj][m][n], 0, 0, 0); __builtin_amdgcn_s_setprio(0); } while (0)
#define PG8_WAIT_V(n) asm volatile("s_waitcnt vmcnt(" #n ")" ::: "memory")
#define PG8_WAIT_L(n) asm volatile("s_waitcnt lgkmcnt(" #n ")" ::: "memory")
#define PG8_BAR __builtin_amdgcn_s_barrier()
#define PG8_SCHED __builtin_amdgcn_sched_barrier(0)
    Unit cur, nxt; int ui = 0;
    if (!S.next(0, cur)) return;
    f32x4 acc[2][2][4][2];
#pragma unroll
    for (int a = 0; a < 2; ++a)
#pragma unroll
        for (int b = 0; b < 2; ++b)
#pragma unroll
            for (int m = 0; m < 4; ++m)
#pragma unroll
                for (int n = 0; n < 2; ++n) acc[a][b][m][n] = (f32x4){0.f, 0.f, 0.f, 0.f};
    bf16x8 At[4][2], B0[2][2], B1[2][2];
    const char* cA = (const char*)g.A + (size_t)cur.pm * tstep; const char* cB = (const char*)g.Bt + (size_t)cur.pn * tstep;
    S.a_ready(cur);
    if constexpr (SP2) {
        PG8_STAGE(PG8_SB(0, 0), cB, voffB); PG8_STAGE(PG8_SB(0, 1), cB + hstep, voffB); PG8_STAGE(PG8_SA(0, 0), cA, voffA); PG8_STAGE(PG8_SA(0, 1), cA + hstep, voffA);
        if (wr == 1) PG8_BAR;
        PG8_WAIT_V(2); PG8_BAR;
        PG8_STAGE(PG8_SB(1, 0), cB + kstep, voffB); PG8_STAGE(PG8_SA(1, 0), cA + kstep, voffA); PG8_STAGE(PG8_SB(1, 1), cB + hstep + kstep, voffB);
        PG8_WAIT_V(6); PG8_BAR;
    } else {
        PG8_STAGE(PG8_SB(0, 0), cB, voffB); PG8_STAGE(PG8_SA(0, 0), cA, voffA); PG8_STAGE(PG8_SB(0, 1), cB + hstep, voffB); PG8_STAGE(PG8_SA(0, 1), cA + hstep, voffA);
        if (wr == 1) PG8_BAR;
        PG8_WAIT_V(4); PG8_BAR;
        PG8_STAGE(PG8_SB(1, 0), cB + kstep, voffB); PG8_STAGE(PG8_SA(1, 0), cA + kstep, voffA); PG8_STAGE(PG8_SB(1, 1), cB + hstep + kstep, voffB);
        PG8_WAIT_V(6); PG8_BAR;
    }
    for (;;) {
        const bool has_next = S.next(ui + 1, nxt);
        const char* nA = has_next ? (const char*)g.A + (size_t)nxt.pm * tstep : cA; const char* nB = has_next ? (const char*)g.Bt + (size_t)nxt.pn * tstep : cB;
        for (int t = 0; t < nt; t += 2) {
            const bool last = (t == nt - 2);
            const char* a1 = cA + (size_t)(t + 1) * kstep;
            const char* a2 = last ? nA : cA + (size_t)(t + 2) * kstep; const char* b2 = last ? nB : cB + (size_t)(t + 2) * kstep;
            const char* a3 = a2 + kstep; const char* b3 = b2 + kstep;
            if (last && has_next) S.a_ready(nxt);
            if constexpr (SP2) {
            PG8_LDB(B0, 0, 0); PG8_LDB(B1, 0, 1); PG8_SCHED; PG8_LDA(At, 0, 0); PG8_STAGE(PG8_SA(1, 1), a1 + hstep, voffA);
            PG8_WAIT_V(8); PG8_WAIT_L(0); PG8_BAR; PG8_MMA(0, 0, At, B0); PG8_MMA(0, 1, At, B1); PG8_BAR; PG8_SCHED;
            PG8_LDA(At, 0, 1); PG8_STAGE(PG8_SB(0, 0), b2, voffB); PG8_STAGE(PG8_SB(0, 1), b2 + hstep, voffB); PG8_STAGE(PG8_SA(0, 0), a2, voffA);
            PG8_WAIT_V(8); PG8_WAIT_L(0); PG8_BAR; PG8_MMA(1, 0, At, B0); PG8_MMA(1, 1, At, B1); PG8_BAR; PG8_SCHED;
            PG8_LDB(B0, 1, 0); PG8_LDB(B1, 1, 1); PG8_SCHED; PG8_LDA(At, 1, 0); PG8_STAGE(PG8_SA(0, 1), a2 + hstep, voffA);
            PG8_WAIT_V(8); PG8_WAIT_L(0); PG8_BAR; PG8_MMA(0, 0, At, B0); PG8_MMA(0, 1, At, B1); PG8_BAR; PG8_SCHED;
            PG8_LDA(At, 1, 1); PG8_STAGE(PG8_SB(1, 0), b3, voffB); PG8_STAGE(PG8_SB(1, 1), b3 + hstep, voffB); PG8_STAGE(PG8_SA(1, 0), a3, voffA);
            PG8_WAIT_V(8); PG8_WAIT_L(0); PG8_BAR; PG8_MMA(1, 0, At, B0); PG8_MMA(1, 1, At, B1); PG8_BAR; PG8_SCHED;
            } else {
            PG8_LDB(B0, 0, 0); PG8_SCHED; PG8_LDA(At, 0, 0); PG8_STAGE(PG8_SA(1, 1), a1 + hstep, voffA);
            PG8_WAIT_L(8); PG8_BAR; PG8_WAIT_L(0); PG8_MMA(0, 0, At, B0); PG8_BAR; PG8_SCHED;
            PG8_LDB(B1, 0, 1); PG8_STAGE(PG8_SB(0, 0), b2, voffB);
            PG8_BAR; PG8_WAIT_L(0); PG8_MMA(0, 1, At, B1); PG8_BAR;
            PG8_LDA(At, 0, 1); PG8_STAGE(PG8_SA(0, 0), a2, voffA);
            PG8_BAR; PG8_WAIT_L(0); PG8_MMA(1, 0, At, B0); PG8_BAR; PG8_SCHED;
            PG8_STAGE(PG8_SB(0, 1), b2 + hstep, voffB);
            PG8_WAIT_V(6); PG8_BAR; PG8_MMA(1, 1, At, B1); PG8_BAR;
            PG8_LDB(B0, 1, 0); PG8_SCHED; PG8_LDA(At, 1, 0); PG8_STAGE(PG8_SA(0, 1), a2 + hstep, voffA);
            PG8_WAIT_L(8); PG8_BAR; PG8_WAIT_L(0); PG8_MMA(0, 0, At, B0); PG8_BAR; PG8_SCHED;
            PG8_LDB(B1, 1, 1); PG8_STAGE(PG8_SB(1, 0), b3, voffB);
            PG8_BAR; PG8_WAIT_L(0); PG8_MMA(0, 1, At, B1); PG8_BAR;
            PG8_LDA(At, 1, 1); PG8_STAGE(PG8_SA(1, 0), a3, voffA);
            PG8_BAR; PG8_WAIT_L(0); PG8_MMA(1, 0, At, B0); PG8_BAR; PG8_SCHED;
            PG8_STAGE(PG8_SB(1, 1), b3 + hstep, voffB);
            PG8_WAIT_V(6); PG8_BAR; PG8_MMA(1, 1, At, B1); PG8_BAR;
            }
        }
        if constexpr (ALIGN_EPI) { if (wr == 0) PG8_BAR; }
        if constexpr (!Epi::AFTER_DRAIN) { E(acc, cur, wr, wc, fr, fq); S.done(cur); }
        if (!has_next) break;
#pragma unroll
        for (int a = 0; a < 2; ++a)
#pragma unroll
            for (int b = 0; b < 2; ++b)
#pragma unroll
                for (int m = 0; m < 4; ++m)
#pragma unroll
                    for (int n = 0; n < 2; ++n) acc[a][b][m][n] = (f32x4){0.f, 0.f, 0.f, 0.f};
        cur = nxt; cA = nA; cB = nB; ++ui;
        if constexpr (ALIGN_EPI) { if (wr == 1) PG8_BAR; }
    }
    PG8_WAIT_V(0);
    if constexpr (!ALIGN_EPI) { if (wr == 0) PG8_BAR; }
    PG8_BAR;
    if constexpr (Epi::AFTER_DRAIN) { E.fused(acc, cur, wr, wc, fr, fq, lds, wid, lane); S.done(cur); }
#undef PG8_SA
#undef PG8_SB
#undef PG8_STAGE
#undef PG8_LDA
#undef PG8_LDB
#undef PG8_MMA
#undef PG8_WAIT_V
#undef PG8_WAIT_L
#undef PG8_BAR
#undef PG8_SCHED
}
}
#define XB_TMO      128
#define XB_XCNT(j)  (256  + 64 * (j))
#define XB_XSUB(j)  (1280 + 64 * (j))
#define XB_XGEN(j)  (2304 + 64 * (j))
#define XB_TOP      3328
#define XB_TOPGEN   3392
#define XCD_BAR_WORDS 3456
#define XB_SPIN_CAP (1u << 18)

__device__ __forceinline__ unsigned xb_ld(unsigned* p)              { return __hip_atomic_load(p, __ATOMIC_RELAXED, __HIP_MEMORY_SCOPE_AGENT); }
__device__ __forceinline__ unsigned xb_add(unsigned* p, unsigned v) { return __hip_atomic_fetch_add(p, v, __ATOMIC_RELAXED, __HIP_MEMORY_SCOPE_AGENT); }
__device__ __forceinline__ unsigned xb_xcc_id() { return (unsigned)__builtin_amdgcn_s_getreg((3 << 11) | 20) & 0xFu; }
#define XB_SPIN(cond, bar) do { unsigned _sp = 0; while (cond) { __builtin_amdgcn_s_sleep(1); \
    if ((++_sp & 255u) == 0u) { if (xb_ld(&(bar)[XB_TMO])) break; if (_sp > XB_SPIN_CAP) { atomicAdd(&(bar)[XB_TMO], 1u); break; } } } } while (0)

struct XcdBarrier {
    unsigned* bar; unsigned x;
    volatile LAS unsigned* st;
};

__device__ __forceinline__ XcdBarrier xcd_barrier_post(unsigned* bar, volatile LAS unsigned* st) {
    XcdBarrier b; b.bar = bar; b.x = xb_xcc_id(); b.st = st;
    if (threadIdx.x == 0) st[2] = xb_add(&bar[XB_XCNT(b.x)], 1u) + 1u;
    return b;
}
__device__ __forceinline__ void xcd_barrier_complete(unsigned* bar, unsigned x, unsigned& nloc, unsigned& nx) {
    const unsigned G = gridDim.x * gridDim.y * gridDim.z;
    unsigned sum, cnt, mine, sp = 0u;
    for (;;) {
        sum = 0u; cnt = 0u; mine = 0u;
#pragma unroll
        for (unsigned j = 0; j < 16; ++j) { const unsigned c = xb_ld(&bar[XB_XCNT(j)]); sum += c; cnt += (c > 0u) ? 1u : 0u; mine = (j == x) ? c : mine; }
        if (sum == G) break;
        __builtin_amdgcn_s_sleep(1);
        if ((++sp & 255u) == 0u) { if (xb_ld(&bar[XB_TMO])) break; if (sp > XB_SPIN_CAP) { atomicAdd(&bar[XB_TMO], 1u); break; } }
    }
    nloc = mine > 0u ? mine : 1u; nx = cnt > 0u ? cnt : 1u;
}

__device__ __forceinline__ void xcd_barrier(const XcdBarrier& b) {
    asm volatile("s_waitcnt vmcnt(0)" ::: "memory");
    __syncthreads();
    if (threadIdx.x == 0) {
        unsigned* bar = b.bar;
        __builtin_amdgcn_s_waitcnt(0);
        unsigned nloc = b.st[0], nx = b.st[1];
        if (nloc == 0u) { xcd_barrier_complete(bar, b.x, nloc, nx); b.st[0] = nloc; b.st[1] = nx; }
        const unsigned old = xb_add(&bar[XB_XSUB(b.x)], 1u);
        const unsigned gen = old / nloc;
        if (old + 1u == (gen + 1u) * nloc) {
            __builtin_amdgcn_fence(__ATOMIC_RELEASE, "agent");
            asm volatile("s_waitcnt vmcnt(0)" ::: "memory");
            const unsigned og = xb_add(&bar[XB_TOP], 1u);
            const unsigned tg = og / nx;
            if (og + 1u == (tg + 1u) * nx) xb_add(&bar[XB_TOPGEN], 1u);
            else XB_SPIN(xb_ld(&bar[XB_TOPGEN]) == tg, bar);
            __builtin_amdgcn_fence(__ATOMIC_ACQUIRE, "agent");
            xb_add(&bar[XB_XGEN(b.x)], 1u);
            asm volatile("s_waitcnt vmcnt(0)" ::: "memory");
        } else {
            XB_SPIN(xb_ld(&bar[XB_XGEN(b.x)]) == gen, bar);
            __builtin_amdgcn_fence(__ATOMIC_ACQUIRE, "agent");
            asm volatile("s_waitcnt vmcnt(0)" ::: "memory");
        }
    }
    __syncthreads();
}
constexpr int NWAVES = 8, NTHR = 512;
constexpr int RING_BYTES = 131072, LDSCTL_OFF = RING_BYTES, MISC_OFF = LDSCTL_OFF + 320, LDS_BYTES = 163840;
constexpr int CW_BAR = 4096;
#ifndef MK_N_LAUNCHES
#define MK_N_LAUNCHES 1
#endif
constexpr int NPHASE = 13;

typedef float f4v __attribute__((ext_vector_type(4)));
typedef unsigned u2v __attribute__((ext_vector_type(2)));
typedef unsigned u32x4_t __attribute__((ext_vector_type(4)));
struct Frame { LAS unsigned char* lds; int tid, lane, wave, G, bid; };
template <int CTRL, int ROWMASK> __device__ __forceinline__ float dppf(float old, float src) {
    return __builtin_bit_cast(float, __builtin_amdgcn_update_dpp(__builtin_bit_cast(int, old), __builtin_bit_cast(int, src), CTRL, ROWMASK, 0xf, false)); }
__device__ __forceinline__ float wave_scan_add(float v) {
    v += dppf<0x111, 0xf>(0.f, v); v += dppf<0x112, 0xf>(0.f, v); v += dppf<0x114, 0xf>(0.f, v); v += dppf<0x118, 0xf>(0.f, v);
    v += dppf<0x142, 0xa>(0.f, v); v += dppf<0x143, 0xc>(0.f, v); return v; }
__device__ __forceinline__ float wave_scan_max(float v) {
    const float NI = -INFINITY;
    v = fmaxf(v, dppf<0x111, 0xf>(NI, v)); v = fmaxf(v, dppf<0x112, 0xf>(NI, v)); v = fmaxf(v, dppf<0x114, 0xf>(NI, v)); v = fmaxf(v, dppf<0x118, 0xf>(NI, v));
    v = fmaxf(v, dppf<0x142, 0xa>(NI, v)); v = fmaxf(v, dppf<0x143, 0xc>(NI, v)); return v; }
__device__ __forceinline__ float lane_bcast(float v, int l) { return __builtin_bit_cast(float, __builtin_amdgcn_readlane(__builtin_bit_cast(int, v), l)); }
__device__ __forceinline__ float wave_sum(float v) { return lane_bcast(wave_scan_add(v), 63); }
__device__ __forceinline__ unsigned pk2(float lo, float hi) { return (unsigned)f2bf(lo) | ((unsigned)f2bf(hi) << 16); }
__device__ __forceinline__ float bflo(unsigned w) { return u_as_f(w << 16); }
__device__ __forceinline__ float bfhi(unsigned w) { return u_as_f(w & 0xffff0000u); }

__device__ __forceinline__ void p0_ada_item(const Prm& p, const Frame& F, int item) {
    static_assert(D6 % 2048 == 0 && D % NKS == 0 && D / NKS == 64, "ada item shape");
    LAS float* sl = (LAS float*)F.lds;
    const int ks = item / (D6 / 2048), cg = item % (D6 / 2048), k0 = ks * 64, n0 = cg * 2048 + 4 * F.tid;
    { const int b = F.tid / 64, k = F.tid % 64; const float cv = p.c[b * D + k0 + k]; sl[F.tid] = cv / (1.f + __expf(-cv)); }
    __syncthreads();
    f4v acc[NB];
#pragma unroll
    for (int b = 0; b < NB; ++b) acc[b] = (f4v){0.f, 0.f, 0.f, 0.f};
    const float* wp = p.w_ada + (size_t)k0 * D6 + n0;
#pragma unroll 8
    for (int k = 0; k < 64; ++k) { const f4v w = *(const f4v*)(wp + (size_t)k * D6);
#pragma unroll
        for (int b = 0; b < NB; ++b) acc[b] += w * sl[b * 64 + k]; }
#pragma unroll
    for (int b = 0; b < NB; ++b) *(f4v*)(p.MODP() + ((size_t)ks * NB + b) * D6 + n0) = acc[b];
    __syncthreads();
}
__device__ __forceinline__ void p0_transpose_item(const float* W, int ldw, int K, int N, bf16_t* WT, LAS float* scr, int item, int lane) {
    const int nblk = N / 32, kb = item / nblk, nb = item % nblk, k0 = 64 * kb, n0 = 32 * nb;
#pragma unroll
    for (int i = 0; i < 32; ++i) { const int kk = 2 * i + (lane >> 5); scr[kk * 33 + (lane & 31)] = W[(size_t)(k0 + kk) * ldw + n0 + (lane & 31)]; }
    asm volatile("s_waitcnt lgkmcnt(0)" ::: "memory");
    const int c = lane & 7;
#pragma unroll
    for (int j = 0; j < 4; ++j) { const int n = (lane >> 3) + 8 * j; const LAS float* s = scr + (8 * c) * 33 + n;
        uint4 o; o.x = pk2(s[0 * 33], s[1 * 33]); o.y = pk2(s[2 * 33], s[3 * 33]); o.z = pk2(s[4 * 33], s[5 * 33]); o.w = pk2(s[6 * 33], s[7 * 33]);
        *(uint4*)(WT + (size_t)(n0 + n) * K + k0 + 8 * c) = o; }
    asm volatile("s_waitcnt lgkmcnt(0)" ::: "memory");
}

__device__ __forceinline__ void p0_fold_item(const Prm& p, int item, int lane) {
    static_assert(NK == 128 && KH == 128 && NQ == 2048, "fold item decomposition");
    const int ks = item & 31, nt = (item >> 5) & 7, g = item >> 8;
    const int r = lane & 15, q = lane >> 4;
    const float* arow = p.subkeys + ((size_t)g * NK + nt * 16 + r) * KH + 4 * q;
    const float* brow = p.wq + (size_t)(ks * 64 + r) * NQ + g * KH + 4 * q;
    pg8::f32x4 acc[4];
#pragma unroll
    for (int c = 0; c < 4; ++c) acc[c] = (pg8::f32x4){0.f, 0.f, 0.f, 0.f};
#pragma unroll 2
    for (int s16 = 0; s16 < KH; s16 += 16) {
        const pg8::f32x4 a = *(const pg8::f32x4*)(arow + s16); pg8::f32x4 bv[4];
#pragma unroll
        for (int c = 0; c < 4; ++c) bv[c] = *(const pg8::f32x4*)(brow + (size_t)(c * 16) * NQ + s16);
#pragma unroll
        for (int i = 0; i < 4; ++i)
#pragma unroll
            for (int c = 0; c < 4; ++c) acc[c] = __builtin_amdgcn_mfma_f32_16x16x4f32(a[i], bv[c][i], acc[c], 0, 0, 0);
    }
#pragma unroll
    for (int c = 0; c < 4; ++c)
#pragma unroll
        for (int i = 0; i < 4; ++i) p.WQ_T()[(size_t)(g * NK + nt * 16 + 4 * q + i) * D + ks * 64 + c * 16 + r] = f2bf(acc[c][i]);
}
__device__ __forceinline__ void phase0(const Prm& p, const Frame& F) {
#ifndef P0_REP_ADA
#define P0_REP_ADA 1
#define P0_REP_TR 1
#define P0_REP_FOLD 1
#define P0_REP_FP8 1
#endif
    for (int rep_ = 0; rep_ < P0_REP_ADA; ++rep_)
    for (int it = F.bid; it < NKS * (D6 / 2048); it += F.G) p0_ada_item(p, F, it);
    LAS float* scr = (LAS float*)(F.lds + F.wave * 16384);
    const int gw = F.bid * NWAVES + F.wave, NGW = F.G * NWAVES;
    constexpr int I_IN = (D / 64) * (INM / 32), I_O = (D / 64) * (D / 32), I_Q = 32 * 8 * 16;
    for (int rep_ = 0; rep_ < (P0_REP_TR > P0_REP_FOLD ? P0_REP_TR : P0_REP_FOLD); ++rep_)
    for (int it = gw; it < I_IN + I_O + I_Q; it += NGW) {
        int r = it; if (rep_ >= P0_REP_TR && r < I_IN + I_O) continue; if (rep_ >= P0_REP_FOLD && r >= I_IN + I_O) continue;
        if (r < I_IN) { p0_transpose_item(p.w_in, INC, D, INM, p.WIN_T(), scr, r, F.lane); continue; } r -= I_IN;
        if (r < I_O) { p0_transpose_item(p.w_out, D, D, D, p.WOUT_T(), scr, r, F.lane); continue; } r -= I_O;
        p0_fold_item(p, r, F.lane);
    }
    for (int rep_ = 0; rep_ < P0_REP_FP8; ++rep_)
    {
        float4 v[8], vn[8]; int rr = gw;
#define P0_ROWSRC(rr_) ((const float4*)(p.peer_u + (size_t)(rr_) * D) + F.lane)
        if (rr < NE) { const float4* src = P0_ROWSRC(rr);
#pragma unroll
            for (int j = 0; j < 8; ++j) v[j] = src[64 * j]; }
        for (; rr < NE; rr += NGW) {
            const int rn = rr + NGW;
            if (rn < NE) { const float4* src = P0_ROWSRC(rn);
#pragma unroll
                for (int j = 0; j < 8; ++j) vn[j] = src[64 * j]; }
            const int e = rr; float am = 0.f;
#pragma unroll
            for (int j = 0; j < 8; ++j) am = fmaxf(am, fmaxf(fmaxf(fabsf(v[j].x), fabsf(v[j].y)), fmaxf(fabsf(v[j].z), fabsf(v[j].w))));
#pragma unroll
            for (int o = 1; o < 64; o <<= 1) am = fmaxf(am, __shfl_xor(am, o));
            const float sc = am > 0.f ? 384.f / am : 1.f;
            unsigned* dst = (unsigned*)(p.PU8() + (size_t)e * D) + F.lane;
#pragma unroll
            for (int j = 0; j < 8; ++j) { unsigned w = 0u; w = __builtin_amdgcn_cvt_pk_fp8_f32(v[j].x * sc, v[j].y * sc, w, false); w = __builtin_amdgcn_cvt_pk_fp8_f32(v[j].z * sc, v[j].w * sc, w, true); dst[64 * j] = w; }
            if (F.lane == 0) p.RSU()[e] = am > 0.f ? am / 384.f : 1.f;
#pragma unroll
            for (int j = 0; j < 8; ++j) v[j] = vn[j];
        }
#undef P0_ROWSRC
    }
    { typedef _Float16 h4v __attribute__((ext_vector_type(4)));
      LAS u2v* tl = (LAS u2v*)F.lds;
      for (int tile = F.bid; tile < (NE / 64) * (D / 512); tile += F.G) { const int eb = tile / (D / 512), cb = tile % (D / 512);
        __syncthreads();
#pragma unroll 4
        for (int k = 0; k < 16; ++k) { const int idx = F.tid + NTHR * k, row = idx >> 7, c4 = idx & 127;
            const f4v x = *(const f4v*)(p.peer_v + (size_t)(eb * 64 + row) * D + cb * 512 + 4 * c4);
            const h4v hx = {(_Float16)x[0], (_Float16)x[1], (_Float16)x[2], (_Float16)x[3]}; tl[row * 129 + c4] = __builtin_bit_cast(u2v, hx); }
        __syncthreads();
#pragma unroll 4
        for (int k = 0; k < 16; ++k) { const int j = F.tid + NTHR * k, sl = j >> 6, row = j & 63;
            *(u2v*)(p.PVH() + ((size_t)(cb * 128 + sl) * NE + eb * 64 + row) * 4) = tl[row * 129 + sl]; }
      } }
}
__device__ __forceinline__ void phase1(const Prm& p, const Frame& F) {
    LAS float* SH = (LAS float*)F.lds; LAS float* SC1 = SH + D;
    LAS bf16_t* WG = (LAS bf16_t*)(F.lds + 2 * D * 4);
    const int rows_per = T / F.G;
    for (int idx = F.bid * NTHR + F.tid; idx < NB * D6; idx += F.G * NTHR) {
        const int n = idx % D6, b = idx / D6; float s = 0.f;
        for (int ks = 0; ks < NKS; ++ks) s += p.MODP()[((size_t)ks * NB + b) * D6 + n];
        p.MOD()[idx] = s + p.b_ada[n]; }
    for (int idx = F.tid; idx < NG * D; idx += NTHR) { const int d = idx / NG, g = idx % NG; WG[g * D + d] = f2bf(p.w_in[(size_t)d * INC + INM + g]); }
    int cur_b = -1;
    float4 xpre[8];
    { const float4* x0 = (const float4*)(p.x + (size_t)(F.bid * rows_per + F.wave) * D) + F.lane;
#pragma unroll
      for (int j = 0; j < 8; ++j) xpre[j] = x0[64 * j]; }
    for (int r0 = F.bid * rows_per; r0 < (F.bid + 1) * rows_per; r0 += NWAVES) {
        const int b = r0 / S;
        if (b != cur_b) { __syncthreads();
            for (int n = F.tid; n < 2 * D; n += NTHR) { float s = 0.f; for (int ks = 0; ks < NKS; ++ks) s += p.MODP()[((size_t)ks * NB + b) * D6 + n];
                s += p.b_ada[n]; SH[n] = n < D ? s : 1.f + s; }
            cur_b = b; __syncthreads(); }
        const int row = r0 + F.wave;
        float4 v[8]; float s = 0.f;
#pragma unroll
        for (int j = 0; j < 8; ++j) v[j] = xpre[j];
        if (r0 + NWAVES < (F.bid + 1) * rows_per) { const float4* xn = (const float4*)(p.x + (size_t)(row + NWAVES) * D) + F.lane;
#pragma unroll
            for (int j = 0; j < 8; ++j) xpre[j] = xn[64 * j]; }
#pragma unroll
        for (int j = 0; j < 8; ++j) s += (v[j].x + v[j].y) + (v[j].z + v[j].w);
        const float mean = wave_sum(s) * (1.f / D); float s2 = 0.f;
#pragma unroll
        for (int j = 0; j < 8; ++j) { v[j].x -= mean; v[j].y -= mean; v[j].z -= mean; v[j].w -= mean; s2 += (v[j].x * v[j].x + v[j].y * v[j].y) + (v[j].z * v[j].z + v[j].w * v[j].w); }
        const float rstd = 1.f / sqrtf(wave_sum(s2) * (1.f / D) + LN_EPS);
        uint2* o8 = (uint2*)(p.U() + (size_t)row * D) + F.lane;
#pragma unroll
        for (int j = 0; j < 8; ++j) { const int c0 = 4 * F.lane + 256 * j; const f4v sh = *(const LAS f4v*)(SH + c0), sc = *(const LAS f4v*)(SC1 + c0);
            v[j].x = v[j].x * rstd * sc.x + sh.x; v[j].y = v[j].y * rstd * sc.y + sh.y; v[j].z = v[j].z * rstd * sc.z + sh.z; v[j].w = v[j].w * rstd * sc.w + sh.w;
            o8[64 * j] = make_uint2(pk2(v[j].x, v[j].y), pk2(v[j].z, v[j].w)); }
        float ga[NG];
#pragma unroll
        for (int g = 0; g < NG; ++g) { float a = 0.f;
#pragma unroll
            for (int j = 0; j < 8; ++j) { const u2v w = *(const LAS u2v*)(WG + g * D + 4 * F.lane + 256 * j); a += v[j].x * bflo(w.x) + v[j].y * bfhi(w.x) + v[j].z * bflo(w.y) + v[j].w * bfhi(w.y); }
            ga[g] = a; }
        float r8[8], r4[4], r2[2]; const bool l0 = F.lane & 1, l1 = F.lane & 2, l2 = F.lane & 4, l3 = F.lane & 8;
#pragma unroll
        for (int i = 0; i < 8; ++i) { const float keep = l0 ? ga[8 + i] : ga[i], send = l0 ? ga[i] : ga[8 + i]; r8[i] = keep + __shfl_xor(send, 1); }
#pragma unroll
        for (int i = 0; i < 4; ++i) { const float keep = l1 ? r8[4 + i] : r8[i], send = l1 ? r8[i] : r8[4 + i]; r4[i] = keep + __shfl_xor(send, 2); }
#pragma unroll
        for (int i = 0; i < 2; ++i) { const float keep = l2 ? r4[2 + i] : r4[i], send = l2 ? r4[i] : r4[2 + i]; r2[i] = keep + __shfl_xor(send, 4); }
        float gacc = (l3 ? r2[1] : r2[0]) + __shfl_xor(l3 ? r2[0] : r2[1], 8);
        gacc += __shfl_xor(gacc, 16); gacc += __shfl_xor(gacc, 32);
        const int gi = (l0 ? 8 : 0) + (l1 ? 4 : 0) + (l2 ? 2 : 0) + (l3 ? 1 : 0);
        if (F.lane < NG) p.GATES()[(size_t)row * NG + gi] = gacc + p.b_in[INM + gi];
    }
}
__device__ __forceinline__ void phase3a(const Prm& p, const Frame& F, int b0, int nb) {
    const size_t gt = (size_t)(F.bid - b0) * NTHR + F.tid, GT = (size_t)nb * NTHR;
    for (size_t i = gt; i < (size_t)T * (CW / 8); i += GT) {
        const size_t row = i / (CW / 8); const int ch = (int)(i % (CW / 8)) * 8, s = (int)(row % S);
        float acc[8];
#pragma unroll
        for (int e = 0; e < 8; ++e) acc[e] = p.conv_b[ch + e];
#pragma unroll
        for (int k = 0; k < 3; ++k) { const int s2 = s + k - 1; if (s2 < 0 || s2 >= S) continue; const bf16_t* pr = p.PJ() + (size_t)(row + k - 1) * INM;
            const uint4 gc = *(const uint4*)(pr + O_GC + ch), hi = *(const uint4*)(pr + O_HIN + ch); const float* cw = p.conv_w + k * CW + ch;
            acc[0] += cw[0] * (bflo(gc.x) * bflo(hi.x)); acc[1] += cw[1] * (bfhi(gc.x) * bfhi(hi.x)); acc[2] += cw[2] * (bflo(gc.y) * bflo(hi.y)); acc[3] += cw[3] * (bfhi(gc.y) * bfhi(hi.y));
            acc[4] += cw[4] * (bflo(gc.z) * bflo(hi.z)); acc[5] += cw[5] * (bfhi(gc.z) * bfhi(hi.z)); acc[6] += cw[6] * (bflo(gc.w) * bflo(hi.w)); acc[7] += cw[7] * (bfhi(gc.w) * bfhi(hi.w)); }
        const uint4 gb = *(const uint4*)(p.PJ() + row * INM + O_GB + ch); uint4 o;
        o.x = pk2(bflo(gb.x) * acc[0], bfhi(gb.x) * acc[1]); o.y = pk2(bflo(gb.y) * acc[2], bfhi(gb.y) * acc[3]); o.z = pk2(bflo(gb.z) * acc[4], bfhi(gb.z) * acc[5]); o.w = pk2(bflo(gb.w) * acc[6], bfhi(gb.w) * acc[7]);
        *(uint4*)(p.Y() + row * D + ch) = o; }
}
namespace ml {
typedef short bf16x8 __attribute__((ext_vector_type(8)));
typedef short s16x4 __attribute__((ext_vector_type(4)));
typedef float f32x4 __attribute__((ext_vector_type(4)));
typedef float f32x2_t __attribute__((ext_vector_type(2)));
typedef __bf16 bf16x2_t __attribute__((ext_vector_type(2)));
typedef unsigned u32x4 __attribute__((ext_vector_type(4)));
typedef unsigned u32x2 __attribute__((ext_vector_type(2)));
constexpr unsigned IMG = 16384u, BUF = 3u * IMG, PT_OFF = 2u * BUF, PT_BYTES = 8192u, N_OFF = PT_OFF + 2u * PT_BYTES;
constexpr unsigned SCT_OFF = 149504u, SCT_BYTES = 1024u;
constexpr unsigned HT_OFF = 133120u;
static_assert(N_OFF + 1024u <= 131072u && HT_OFF + 16384u <= SCT_OFF && SCT_OFF + 3u * SCT_BYTES <= 163840u, "mLSTM LDS map");
__device__ __forceinline__ unsigned cvtpk(float lo, float hi) { f32x2_t v = {lo, hi}; bf16x2_t b = __builtin_convertvector(v, bf16x2_t); return __builtin_bit_cast(unsigned, b); }
__device__ __forceinline__ unsigned off_a(unsigned row, unsigned ch) { return 2048u * (row >> 3) + 512u * (ch >> 2) + 64u * (row & 7u) + 16u * ((ch & 3u) ^ ((row >> 2) & 3u)); }
__device__ __forceinline__ unsigned off_p(unsigned row, unsigned ch) { return 128u * row + 16u * (ch ^ (row & 7u)); }
typedef short v4i16_t __attribute__((ext_vector_type(4)));
__device__ __forceinline__ s16x4 trr(LAS unsigned char* p) { return __builtin_bit_cast(s16x4, __builtin_amdgcn_ds_read_tr16_b64_v4i16((LAS v4i16_t*)p)); }
__device__ __forceinline__ bf16x8 cat8(s16x4 a, s16x4 b) { return (bf16x8){a[0], a[1], a[2], a[3], b[0], b[1], b[2], b[3]}; }
struct CS { float decay, m_next; };
__device__ __forceinline__ CS chunk_scalars(float ig, float fg, float m, LAS float* tab, bool writer, unsigned lane) {
    const float lf = logsigmoidf_(fg);
    const float bc = wave_scan_add(lf), gg = ig - bc, cm = wave_scan_max(gg);
    const float G = fmaxf(m, cm), G63 = lane_bcast(G, 63), b63 = lane_bcast(bc, 63), qs = 0.08838834764831845f;
    if (writer) { tab[lane] = __expf(fminf(G63 - G, 80.f)) * qs; tab[64 + lane] = __expf(m - G) * qs; tab[128 + lane] = __expf(-(bc + G)); tab[192 + lane] = __expf(gg - G63); }
    CS r; r.decay = __expf(m - G63); r.m_next = b63 + G63;
    return r;
}
__device__ __forceinline__ void unit(const Prm& p, const Frame& F, int u) {
    static_assert(QK == 128 && MV == 256 && CHUNK == 64 && S % 64 == 0, "mLSTM unit is specialised");
    const int vhalf = u & 1, h = (u >> 1) & 3, b = (u >> 3) & 7, dir = u >> 6;
    const unsigned lane = F.lane, tid = F.tid; const int wave = F.wave; const unsigned q = lane >> 4, r = lane & 15u;
    LAS unsigned char* L = F.lds;
    const unsigned rx = (r >> 2) & 3u, rlo = 2048u * (r >> 3) + 64u * (r & 7u);
    const unsigned RA = rlo + 16u * (q ^ rx), PB1 = rlo + 16u * ((q >> 1) ^ rx) + 8u * (q & 1u), PB2 = rlo + 16u * ((2u + (q >> 1)) ^ rx) + 8u * (q & 1u);
    const unsigned pp = lane & 3u, tlo = 2048u * q + 64u * rx + 8u * (pp & 1u);
    const unsigned tb00 = tlo + 16u * ((pp >> 1) ^ ((2u * q) & 3u)), tb01 = tlo + 256u + 16u * ((pp >> 1) ^ ((2u * q + 1u) & 3u));
    const unsigned tb10 = tlo + 16u * ((2u + (pp >> 1)) ^ ((2u * q) & 3u)), tb11 = tlo + 256u + 16u * ((2u + (pp >> 1)) ^ ((2u * q + 1u) & 3u));
    const unsigned PP0 = 128u * r + 16u * (q ^ (r & 7u)), PP1 = 128u * r + 16u * ((4u + q) ^ (r & 7u));
#define ML_TRA(c, ks, t) ((((c) & 1) ? ((t) ? tb11 : tb10) : ((t) ? tb01 : tb00)) + 8192u * (ks) + 512u * ((unsigned)(c) >> 1))
    __syncthreads();
    for (unsigned i = tid; i < (2u * PT_BYTES + 1024u) / 16u; i += NTHR) *(LAS u32x4*)(L + PT_OFF + 16u * i) = (u32x4){0u, 0u, 0u, 0u};
    f32x4 C[8];
#pragma unroll
    for (int i = 0; i < 8; ++i) C[i] = (f32x4){0.f, 0.f, 0.f, 0.f};
    float m = 0.f;
    const bf16_t* pj = p.PJ(); bf16_t* H = dir ? p.HB16() : p.HF16();
    const int colq = O_Q + h * QK, colk = O_K + h * QK, colv = O_V + h * MV + vhalf * 128;
    const unsigned srow0 = tid >> 4, sch = tid & 15u;
    u32x4 rq[2], rk[2], rv[2];
    const float* gbase = p.GATES() + dir * 8 + h;
#define ML_GATES(c, ig_, fg_) do { const float* g_ = gbase + (size_t)ml_tok(dir, b, (c) * 64 + (int)lane) * NG; ig_ = g_[0]; fg_ = g_[4]; } while (0)
    float ig0, fg0, ign = 0.f, fgn = 0.f; ML_GATES(0, ig0, fg0); if (S / 64 > 1) ML_GATES(1, ign, fgn);
#define ML_TAB(c) ((LAS float*)(L + SCT_OFF + (unsigned)((c) % 3) * SCT_BYTES))
    CS cs = chunk_scalars(ig0, fg0, m, ML_TAB(0), wave == 0, lane), csn = cs;
    const long sMW = dir ? -(long)MW : (long)MW;
#define ML_LOAD(c) do { _Pragma("unroll") for (int i_ = 0; i_ < 2; ++i_) { const bf16_t* rp = pj + (size_t)ml_tok(dir, b, (c) * 64 + srow0 + 32 * i_) * INM + 8 * sch; \
        rq[i_] = *(const u32x4*)(rp + colq); rk[i_] = *(const u32x4*)(rp + colk); rv[i_] = *(const u32x4*)(rp + colv); } } while (0)
#define ML_STORE(buf, S_) do { _Pragma("unroll") for (int i_ = 0; i_ < 2; ++i_) { const unsigned row = srow0 + 32u * i_, o = (buf) * BUF + off_a(row, sch); const float w = (S_)[192 + row]; \
        *(LAS u32x4*)(L + o) = rq[i_]; *(LAS u32x4*)(L + IMG + o) = rk[i_]; u32x4 v = rv[i_]; \
        v.x = cvtpk(bflo(v.x) * w, bfhi(v.x) * w); v.y = cvtpk(bflo(v.y) * w, bfhi(v.y) * w); v.z = cvtpk(bflo(v.z) * w, bfhi(v.z) * w); v.w = cvtpk(bflo(v.w) * w, bfhi(v.w) * w); \
        *(LAS u32x4*)(L + 2u * IMG + o) = v; } } while (0)
    __syncthreads();
    ML_LOAD(0); ML_STORE(0u, ML_TAB(0)); if (S / 64 > 1) ML_LOAD(1);
    constexpr int NC = S / 64;
    for (int c = 0; c < NC; ++c) {
        const unsigned cur = (unsigned)(c & 1);
        LAS unsigned char* Qi = L + cur * BUF; LAS unsigned char* Ki = Qi + IMG; LAS unsigned char* Vi = Qi + 2u * IMG; LAS unsigned char* Pt = L + PT_OFF + cur * PT_BYTES;
        float ig2 = 0.f, fg2 = 0.f;
        if (c + 1 < NC) { csn = chunk_scalars(ign, fgn, cs.m_next, ML_TAB(c + 1), wave == 0, lane); if (c + 2 < NC) ML_GATES(c + 2, ig2, fg2); }
        __syncthreads();
#define ML_FLUSH(cprev) do { _Pragma("unroll") for (int i_ = 0; i_ < 2; ++i_) { const unsigned n_ = tid + 512u * i_, row_ = n_ >> 4, ch_ = n_ & 15u;     \
            const u32x4 v_ = *(const LAS u32x4*)(L + HT_OFF + 256u * row_ + 16u * (ch_ ^ (row_ & 15u))); \
            *(u32x4*)(H + (size_t)ml_tok(dir, b, (cprev) * 64 + (int)row_) * MW + h * MV + vhalf * 128 + 8 * (int)ch_) = v_; } } while (0)
        const LAS float* sct = ML_TAB(c);
        if (c > 0) ML_FLUSH(c - 1);
#ifndef ML_REP_3B
#define ML_REP_3B 1
#define ML_REP_S 1
#define ML_REP_ST 1
#define ML_REP_3A 1
#define ML_REP_DEN 1
#endif
        f32x4 acc2[4];
#pragma unroll
        for (int tt = 0; tt < 4; ++tt) acc2[tt] = (f32x4){0.f, 0.f, 0.f, 0.f};
#pragma unroll
        for (int ks = 0; ks < 4; ++ks) {
            bf16x8 qa[4];
#pragma unroll
            for (int tt = 0; tt < 4; ++tt) {
                const u32x2 lo = *(const LAS u32x2*)(Qi + PB1 + 4096u * tt + 512u * ks), hi = *(const LAS u32x2*)(Qi + PB2 + 4096u * tt + 512u * ks);
                const u32x4 aw = {lo.x, lo.y, hi.x, hi.y}; qa[tt] = __builtin_bit_cast(bf16x8, aw); }
            const f32x4 c0 = C[2 * ks], c1 = C[2 * ks + 1];
            const u32x4 bw = {cvtpk(c0[0], c0[1]), cvtpk(c0[2], c0[3]), cvtpk(c1[0], c1[1]), cvtpk(c1[2], c1[3])}; const bf16x8 bfr = __builtin_bit_cast(bf16x8, bw);
#pragma unroll
            for (int tt = 0; tt < 4; ++tt) acc2[tt] = __builtin_amdgcn_mfma_f32_16x16x32_bf16(qa[tt], bfr, acc2[tt], 0, 0, 0);
        }
        bf16x8 vB[2];
#pragma unroll
        for (int ks = 0; ks < 2; ++ks) vB[ks] = cat8(trr(Vi + ML_TRA(wave, ks, 0)), trr(Vi + ML_TRA(wave, ks, 1)));
#pragma unroll
        for (int dt = 0; dt < 8; ++dt) C[dt] = C[dt] * cs.decay;
#pragma unroll
        for (int ks = 0; ks < 2; ++ks)
#pragma unroll
            for (int dh = 0; dh < 2; ++dh) { bf16x8 kA[4];
#pragma unroll
                for (int d4 = 0; d4 < 4; ++d4) kA[d4] = cat8(trr(Ki + ML_TRA(4 * dh + d4, ks, 0)), trr(Ki + ML_TRA(4 * dh + d4, ks, 1)));
#pragma unroll
                for (int d4 = 0; d4 < 4; ++d4) C[4 * dh + d4] = __builtin_amdgcn_mfma_f32_16x16x32_bf16(kA[d4], vB[ks], C[4 * dh + d4], 0, 0, 0); }
#pragma unroll
        for (int rep = 0; rep < 2; ++rep) { const int idx = wave + (rep ? 2 : 0);
            if (rep == 0 || wave >= 6) { const int tt = idx >= 6 ? 3 : (idx >= 3 ? 2 : (idx >= 1 ? 1 : 0)), st = idx - tt * (tt + 1) / 2;
                f32x4 sa = (f32x4){0.f, 0.f, 0.f, 0.f};
#pragma unroll
                for (int kh = 0; kh < 2; ++kh) { bf16x8 af[2], bfk[2];
#pragma unroll
                    for (int k2 = 0; k2 < 2; ++k2) { af[k2] = *(const LAS bf16x8*)(Qi + RA + 4096u * tt + 512u * (2 * kh + k2)); bfk[k2] = *(const LAS bf16x8*)(Ki + RA + 4096u * st + 512u * (2 * kh + k2)); }
#pragma unroll
                    for (int k2 = 0; k2 < 2; ++k2) sa = __builtin_amdgcn_mfma_f32_16x16x32_bf16(af[k2], bfk[k2], sa, 0, 0, 0); }
                const unsigned scol = 16u * st + r;
#pragma unroll
                for (int i = 0; i < 4; ++i) { const unsigned trow = 16u * tt + 4u * q + i; const float v = scol <= trow ? sa[i] : 0.f;
                    *(LAS bf16_t*)(Pt + off_p(trow, scol >> 3) + 2u * (scol & 7u)) = (bf16_t)cvtpk(v, 0.f); } } }
        if (c + 1 < NC) { ML_STORE(cur ^ 1u, ML_TAB(c + 1)); if (c + 2 < NC) ML_LOAD(c + 2); }
        __syncthreads();
        { bf16x8 pf[6];
#pragma unroll
          for (int tt = 0; tt < 4; ++tt) { pf[tt] = *(const LAS bf16x8*)(Pt + PP0 + 2048u * tt); if (tt >= 2) pf[2 + tt] = *(const LAS bf16x8*)(Pt + PP1 + 2048u * tt); }
#pragma unroll
          for (int tt = 0; tt < 4; ++tt) { const f32x4 av4 = *(const LAS f32x4*)(sct + 16 * tt + 4 * q), bv4 = *(const LAS f32x4*)(sct + 64 + 16 * tt + 4 * q); f32x4 a1 = __builtin_amdgcn_mfma_f32_16x16x32_bf16(pf[tt], vB[0], (f32x4){0.f, 0.f, 0.f, 0.f}, 0, 0, 0);
            if (tt >= 2) a1 = __builtin_amdgcn_mfma_f32_16x16x32_bf16(pf[2 + tt], vB[1], a1, 0, 0, 0);
#pragma unroll
            for (int i = 0; i < 4; ++i) { const unsigned t = 16u * tt + 4u * q + i, col = 16u * (unsigned)wave + r;
                *(LAS bf16_t*)(L + HT_OFF + 256u * t + 16u * ((col >> 3) ^ (t & 15u)) + 2u * (col & 7u)) = (bf16_t)cvtpk(av4[i] * a1[i] + bv4[i] * acc2[tt][i], 0.f); } } }
        if (vhalf == 0) {
            const LAS float* n_old = (const LAS float*)(L + N_OFF + cur * 512u); LAS float* n_new = (LAS float*)(L + N_OFF + (cur ^ 1u) * 512u);
            bf16x8 wB[2];
#pragma unroll
            for (int ks = 0; ks < 2; ++ks) { const f32x4 w0 = *(const LAS f32x4*)(sct + 192 + 32 * ks + 8 * q), w1 = *(const LAS f32x4*)(sct + 192 + 32 * ks + 8 * q + 4);
                u32x4 w = {cvtpk(w0[0], w0[1]), cvtpk(w0[2], w0[3]), cvtpk(w1[0], w1[1]), cvtpk(w1[2], w1[3])};
                if (r != 0u) w = (u32x4){0u, 0u, 0u, 0u}; wB[ks] = __builtin_bit_cast(bf16x8, w); }
            const size_t dbase = ((size_t)dir * T) * MH + h;
            if (wave < 4) { const int tt = wave; f32x4 d2 = (f32x4){0.f, 0.f, 0.f, 0.f};
#pragma unroll
                for (int ks = 0; ks < 4; ++ks) { const f32x4 n0 = *(const LAS f32x4*)(n_old + 32 * ks + 4 * q), n1 = *(const LAS f32x4*)(n_old + 32 * ks + 16 + 4 * q);
                    u32x4 bw = {cvtpk(n0[0], n0[1]), cvtpk(n0[2], n0[3]), cvtpk(n1[0], n1[1]), cvtpk(n1[2], n1[3])}; if (r != 0u) bw = (u32x4){0u, 0u, 0u, 0u};
                    const u32x2 lo = *(const LAS u32x2*)(Qi + PB1 + 4096u * tt + 512u * ks), hi = *(const LAS u32x2*)(Qi + PB2 + 4096u * tt + 512u * ks);
                    const u32x4 aw = {lo.x, lo.y, hi.x, hi.y};
                    d2 = __builtin_amdgcn_mfma_f32_16x16x32_bf16(__builtin_bit_cast(bf16x8, aw), __builtin_bit_cast(bf16x8, bw), d2, 0, 0, 0); }
#pragma unroll
                for (int i = 0; i < 4; ++i) { const int t = 16 * tt + 4 * (int)q + i; const float bv = sct[64 + t], fl = sct[128 + t];
                    if (r == 0u) { const size_t di = dbase + (size_t)ml_tok(dir, b, c * 64 + t) * MH; p.DEN()[(size_t)2 * T * MH + di] = bv * d2[i]; p.FLR()[di] = fl; } }
            } else { const int tt = wave - 4; f32x4 d1 = (f32x4){0.f, 0.f, 0.f, 0.f};
#pragma unroll
                for (int ks = 0; ks < 2; ++ks) if (ks == 0 || tt >= 2) { const bf16x8 pf = *(const LAS bf16x8*)(Pt + (ks ? PP1 : PP0) + 2048u * tt);
                    d1 = __builtin_amdgcn_mfma_f32_16x16x32_bf16(pf, wB[ks], d1, 0, 0, 0); }
#pragma unroll
                for (int i = 0; i < 4; ++i) { const int t = 16 * tt + 4 * (int)q + i; const float av = sct[t];
                    if (r == 0u) p.DEN()[dbase + (size_t)ml_tok(dir, b, c * 64 + t) * MH] = av * d1[i]; } }
            { const int dt = wave; f32x4 nn = *(const LAS f32x4*)(n_old + 16 * dt + 4 * q) * cs.decay; if (r != 0u) nn = (f32x4){0.f, 0.f, 0.f, 0.f};
#pragma unroll
                for (int ks = 0; ks < 2; ++ks) { const bf16x8 kA = cat8(trr(Ki + ML_TRA(dt, ks, 0)), trr(Ki + ML_TRA(dt, ks, 1)));
                    nn = __builtin_amdgcn_mfma_f32_16x16x32_bf16(kA, wB[ks], nn, 0, 0, 0); }
                if (r == 0u) *(LAS f32x4*)(n_new + 16 * dt + 4 * q) = nn; }
        }
        m = cs.m_next; cs = csn; ign = ig2; fgn = fg2;
    }
    __syncthreads(); ML_FLUSH(NC - 1);
#undef ML_FLUSH
#undef ML_TRA
#undef ML_TABLE
#undef ML_LOAD
#undef ML_GATES
#undef ML_STORE
}
}
__device__ __forceinline__ void phase4(const Prm& p, const Frame& F) {
    static_assert(MV == 256 && MH == 4, "head j = float4 slot j of the lane");
    const int gw = F.bid * NWAVES + F.wave, NGW = F.G * NWAVES;
    for (int row = gw; row < T; row += NGW) {
        const uint2* hf = (const uint2*)(p.HF16() + (size_t)row * MW) + F.lane; const uint2* hb = (const uint2*)(p.HB16() + (size_t)row * MW) + F.lane;
        const uint2* og = (const uint2*)(p.PJ() + (size_t)row * INM + O_O) + F.lane; uint2* yo = (uint2*)(p.Y() + (size_t)row * D + CW) + F.lane;
#pragma unroll
        for (int j = 0; j < MH; ++j) {
            const float* d2 = p.DEN() + (size_t)2 * T * MH;
            const float i_f = 1.f / fmaxf(fabsf(p.DEN()[(size_t)row * MH + j] + d2[(size_t)row * MH + j]), p.FLR()[(size_t)row * MH + j]);
            const float i_b = 1.f / fmaxf(fabsf(p.DEN()[((size_t)T + row) * MH + j] + d2[((size_t)T + row) * MH + j]), p.FLR()[((size_t)T + row) * MH + j]);
            const uint2 a = hf[64 * j], b = hb[64 * j]; float4 h = make_float4(bflo(a.x) * i_f + bflo(b.x) * i_b, bfhi(a.x) * i_f + bfhi(b.x) * i_b, bflo(a.y) * i_f + bflo(b.y) * i_b, bfhi(a.y) * i_f + bfhi(b.y) * i_b);
            const float mean = wave_sum((h.x + h.y) + (h.z + h.w)) * (1.f / MV);
            h.x -= mean; h.y -= mean; h.z -= mean; h.w -= mean;
            const float rstd = 1.f / sqrtf(wave_sum((h.x * h.x + h.y * h.y) + (h.z * h.z + h.w * h.w)) * (1.f / MV) + LN_EPS);
            const float4 nw = *((const float4*)(p.mnorm_w + j * MV) + F.lane); const uint2 o = og[64 * j];
            yo[64 * j] = make_uint2(pk2(h.x * rstd * nw.x * sigmoidf_(bflo(o.x)), h.y * rstd * nw.y * sigmoidf_(bfhi(o.x))), pk2(h.z * rstd * nw.z * sigmoidf_(bflo(o.y)), h.w * rstd * nw.w * sigmoidf_(bfhi(o.y)))); }
    }
}
struct EpiZ {
    static constexpr bool PERM = false, AFTER_DRAIN = false;
    const float* x; const float* mod; float* out;
    __device__ __forceinline__ void operator()(const pg8::f32x4 (&acc)[2][2][4][2], const pg8::Unit& u, int wr, int wc, int fr, int fq) const {
        const int col0 = u.pn * 256 + wc * 32 + 4 * fq;
#pragma unroll
        for (int ai = 0; ai < 2; ++ai)
#pragma unroll
            for (int m = 0; m < 4; ++m) { const int row = u.pm * 256 + ai * 128 + wr * 64 + m * 16 + fr; const float* g1 = mod + (size_t)(row / S) * D6 + 2 * D; const size_t off = (size_t)row * D + col0;
#pragma unroll
                for (int bj = 0; bj < 2; ++bj)
#pragma unroll
                    for (int n = 0; n < 2; ++n) { const int c = bj * 128 + n * 16; const pg8::f32x4 xv = *(const pg8::f32x4*)(x + off + c), gv = *(const pg8::f32x4*)(g1 + col0 + c);
                        *(pg8::f32x4*)(out + off + c) = xv * ALPHA + gv * acc[ai][bj][m][n]; } }
    }
};

struct EpiF32 {
    static constexpr bool PERM = false, AFTER_DRAIN = false;
    float* out; int ldc;
    __device__ __forceinline__ void operator()(const pg8::f32x4 (&acc)[2][2][4][2], const pg8::Unit& u, int wr, int wc, int fr, int fq) const {
        const int col0 = u.pn * 256 + wc * 32 + 4 * fq;
#pragma unroll
        for (int ai = 0; ai < 2; ++ai)
#pragma unroll
            for (int m = 0; m < 4; ++m) { float* rowp = out + (size_t)(u.pm * 256 + ai * 128 + wr * 64 + m * 16 + fr) * ldc + col0;
#pragma unroll
                for (int bj = 0; bj < 2; ++bj)
#pragma unroll
                    for (int n = 0; n < 2; ++n) *(pg8::f32x4*)(rowp + bj * 128 + n * 16) = acc[ai][bj][m][n]; }
    }
};
__device__ __forceinline__ unsigned skey(float f) { const unsigned u = f_as_u(f); return (u & 0x80000000u) ? ~u : (u | 0x80000000u); }
__device__ __forceinline__ float unskey(unsigned k) { return u_as_f((k & 0x80000000u) ? (k & 0x7fffffffu) : ~k); }
__device__ __forceinline__ void tk_insert(unsigned (&L)[16], unsigned k) {
    if (k > L[15]) { L[15] = k;
#pragma unroll
        for (int i = 14; i >= 0; --i) { const unsigned hi = L[i] > L[i + 1] ? L[i] : L[i + 1], lo = L[i] > L[i + 1] ? L[i + 1] : L[i]; L[i] = hi; L[i + 1] = lo; } }
}
__device__ __forceinline__ void tk_top16(const float* sc, unsigned (&L)[16]) {
#pragma unroll
    for (int i = 0; i < 16; ++i) L[i] = 0u;
#pragma unroll 2
    for (int n4 = 0; n4 < NK / 4; ++n4) { const float4 v = ((const float4*)sc)[n4]; const unsigned b = 127u - 4u * n4;
        tk_insert(L, (skey(v.x) & ~0x7fu) | b); tk_insert(L, (skey(v.y) & ~0x7fu) | (b - 1)); tk_insert(L, (skey(v.z) & ~0x7fu) | (b - 2)); tk_insert(L, (skey(v.w) & ~0x7fu) | (b - 3)); }
}
__device__ __forceinline__ void phase8(const Prm& p, const Frame& F) {
    static_assert(NK == 128 && TOPK == 16, "top-k phase is specialised");
    const long gt = (long)F.bid * NTHR + F.tid, GT = (long)F.G * NTHR;
    for (long i = gt; i < (long)T * PH; i += GT) {
        unsigned A[16], B[16];
        tk_top16(p.SC() + (size_t)i * 2 * NK, A); tk_top16(p.SC() + (size_t)i * 2 * NK + NK, B);
        float V[16]; int E[16];
#pragma unroll
        for (int r = 0; r < 16; ++r) { V[r] = -INFINITY; E[r] = 0; }
#pragma unroll
        for (int a = 0; a < 16; ++a)
#pragma unroll
            for (int b = 0; b < 16; ++b) if ((a + 1) * (b + 1) <= 16) {
                const float v = unskey(A[a] & ~0x7fu) + unskey(B[b] & ~0x7fu); const int e = (int)((127u - (A[a] & 0x7fu)) * NK + (127u - (B[b] & 0x7fu)));
                if (v > V[15]) { V[15] = v; E[15] = e;
#pragma unroll
                    for (int r = 14; r >= 0; --r) { const bool sw = V[r + 1] > V[r]; const float vh = sw ? V[r + 1] : V[r], vl = sw ? V[r] : V[r + 1]; const int eh = sw ? E[r + 1] : E[r], el = sw ? E[r] : E[r + 1];
                        V[r] = vh; V[r + 1] = vl; E[r] = eh; E[r + 1] = el; } } }
        float sum = 0.f; const float vmax = V[0];
#pragma unroll
        for (int r = 0; r < 16; ++r) { V[r] = __expf(V[r] - vmax); sum += V[r]; }
        const float inv = 1.f / sum;
#pragma unroll
        for (int r = 0; r < 16; r += 4) { *(int4*)(p.EIDX() + (size_t)i * TOPK + r) = make_int4(E[r], E[r + 1], E[r + 2], E[r + 3]);
            *(float4*)(p.EW() + (size_t)i * TOPK + r) = make_float4(V[r] * inv, V[r + 1] * inv, V[r + 2] * inv, V[r + 3] * inv); }
    }
}
__device__ __forceinline__ void phase6(const Prm& p, const Frame& F) {
    const int gw = F.bid * NWAVES + F.wave, NGW = F.G * NWAVES;
    float4 v[8], vn[8];
    if (gw < T) { const float4* z0 = (const float4*)(p.out + (size_t)gw * D) + F.lane;
#pragma unroll
        for (int j = 0; j < 8; ++j) v[j] = z0[64 * j]; }
    for (int row = gw; row < T; row += NGW) {
        float4* zr = (float4*)(p.out + (size_t)row * D) + F.lane; const float* mod = p.MOD() + (size_t)(row / S) * D6;
        float s = 0.f;
        if (row + NGW < T) { const float4* zn = (const float4*)(p.out + (size_t)(row + NGW) * D) + F.lane;
#pragma unroll
            for (int j = 0; j < 8; ++j) vn[j] = zn[64 * j]; }
#pragma unroll
        for (int j = 0; j < 8; ++j) s += (v[j].x + v[j].y) + (v[j].z + v[j].w);
        float mean = wave_sum(s) * (1.f / D), s2 = 0.f;
#pragma unroll
        for (int j = 0; j < 8; ++j) { v[j].x -= mean; v[j].y -= mean; v[j].z -= mean; v[j].w -= mean; s2 += (v[j].x * v[j].x + v[j].y * v[j].y) + (v[j].z * v[j].z + v[j].w * v[j].w); }
        float rstd = 1.f / sqrtf(wave_sum(s2) * (1.f / D) + LN_EPS); s = 0.f;
#pragma unroll
        for (int j = 0; j < 8; ++j) { const float4 w = *((const float4*)p.ln1_w + F.lane + 64 * j), bb = *((const float4*)p.ln1_b + F.lane + 64 * j);
            v[j].x = v[j].x * rstd * w.x + bb.x; v[j].y = v[j].y * rstd * w.y + bb.y; v[j].z = v[j].z * rstd * w.z + bb.z; v[j].w = v[j].w * rstd * w.w + bb.w;
            zr[64 * j] = v[j]; s += (v[j].x + v[j].y) + (v[j].z + v[j].w); }
        mean = wave_sum(s) * (1.f / D); s2 = 0.f;
#pragma unroll
        for (int j = 0; j < 8; ++j) { v[j].x -= mean; v[j].y -= mean; v[j].z -= mean; v[j].w -= mean; s2 += (v[j].x * v[j].x + v[j].y * v[j].y) + (v[j].z * v[j].z + v[j].w * v[j].w); }
        rstd = 1.f / sqrtf(wave_sum(s2) * (1.f / D) + LN_EPS);
        uint2* o8 = (uint2*)(p.U() + (size_t)row * D) + F.lane;
#pragma unroll
        for (int j = 0; j < 8; ++j) { const float4 sh = *((const float4*)(mod + 3 * D) + F.lane + 64 * j), sc = *((const float4*)(mod + 4 * D) + F.lane + 64 * j);
            o8[64 * j] = make_uint2(pk2(v[j].x * rstd * (1.f + sc.x) + sh.x, v[j].y * rstd * (1.f + sc.y) + sh.y), pk2(v[j].z * rstd * (1.f + sc.z) + sh.z, v[j].w * rstd * (1.f + sc.w) + sh.w)); }
#pragma unroll
        for (int j = 0; j < 8; ++j) v[j] = vn[j];
    }
}
struct XW { int vx, nx, rank, nloc; };
constexpr int NDS = 16, DSW = D / NDS;
typedef float f2v __attribute__((ext_vector_type(2)));
struct Row8 { uint4 r[8]; };
__device__ __forceinline__ void gather8(Row8& g, const unsigned char* tbu, unsigned loff, int ereg, int pg) {
#pragma unroll
    for (int k = 0; k < 8; ++k) { const unsigned e = (unsigned)__shfl(ereg, 8 * k + pg); g.r[k] = *(const uint4*)(tbu + (((size_t)e << 11) | loff)); }
}
#define PEER_CVT8(a) const f2v c0 = __builtin_amdgcn_cvt_pk_f32_fp8((a).x, false), c1 = __builtin_amdgcn_cvt_pk_f32_fp8((a).x, true), c2 = __builtin_amdgcn_cvt_pk_f32_fp8((a).y, false), c3 = __builtin_amdgcn_cvt_pk_f32_fp8((a).y, true), \
    c4 = __builtin_amdgcn_cvt_pk_f32_fp8((a).z, false), c5 = __builtin_amdgcn_cvt_pk_f32_fp8((a).z, true), c6 = __builtin_amdgcn_cvt_pk_f32_fp8((a).w, false), c7 = __builtin_amdgcn_cvt_pk_f32_fp8((a).w, true)
__device__ __forceinline__ f2v rscatter16(const float* v, bool b0, bool b1, bool b2, int m0, int m1, int m2) {
    float r8[8], r4[4]; f2v r2;
#pragma unroll
    for (int i = 0; i < 8; ++i) { const float keep = b0 ? v[8 + i] : v[i], send = b0 ? v[i] : v[8 + i]; r8[i] = keep + __shfl_xor(send, m0); }
#pragma unroll
    for (int i = 0; i < 4; ++i) { const float keep = b1 ? r8[4 + i] : r8[i], send = b1 ? r8[i] : r8[4 + i]; r4[i] = keep + __shfl_xor(send, m1); }
    { const float k0 = b2 ? r4[2] : r4[0], s0 = b2 ? r4[0] : r4[2], k1 = b2 ? r4[3] : r4[1], s1 = b2 ? r4[1] : r4[3]; r2.x = k0 + __shfl_xor(s0, m2); r2.y = k1 + __shfl_xor(s1, m2); }
    return r2;
}
__device__ __forceinline__ void phase9(const Prm& p, const Frame& F, const XW& xw) {
    static_assert(DSW == 128 && NSLOT == 128 && D == 2048, "slice row = 8 lanes x 16 bytes");
    const int pg = F.lane >> 3, part = F.lane & 7; const bool p0 = part & 1, p1 = part & 2, p2 = part & 4;
    const int tstep = xw.nloc * NWAVES, t0 = xw.rank * NWAVES + F.wave; const int nt = t0 < T ? (T - t0 + tstep - 1) / tstep : 0;
    const unsigned loff = (unsigned)part * 16u; const int k0 = (p0 ? 8 : 0) + (p1 ? 4 : 0) + (p2 ? 2 : 0);
    for (int ds = xw.vx; ds < NDS; ds += xw.nx) {
        if (nt == 0) continue;
        const unsigned char* tbu = p.PU8() + ds * DSW; float* part_out = p.SC() + (size_t)ds * T * NSLOT + pg + 8 * k0;
#define UP_TOK(i) (t0 + ((i) < nt ? (i) : nt - 1) * tstep)
#define UP_LOADE(i, ea, eb) do { const int* ep_ = p.EIDX() + (size_t)UP_TOK(i) * NSLOT + F.lane; ea = ep_[0]; eb = ep_[64]; } while (0)
#define UP_LOADU(i, ua_, ub_) do { const uint4* up_ = (const uint4*)(p.U() + (size_t)UP_TOK(i) * D + ds * DSW + part * 16); ua_ = up_[0]; ub_ = up_[1]; } while (0)
        int e0a, e0b, e1a, e1b, e2a, e2b; uint4 ua, ub, una, unb;
        UP_LOADE(0, e0a, e0b); UP_LOADE(1, e1a, e1b); UP_LOADE(2, e2a, e2b); UP_LOADU(0, ua, ub);
        Row8 G0, G1, G2, G3;
        gather8(G0, tbu, loff, e0a, pg); gather8(G1, tbu, loff, e0b, pg); gather8(G2, tbu, loff, e1a, pg);
#define UP_BODY(i, GA, GB, GC, GD) do { \
            gather8(GD, tbu, loff, e1b, pg); UP_LOADU((i) + 1, una, unb); int e3a, e3b; UP_LOADE((i) + 3, e3a, e3b); \
            f2v u[8]; u[0] = (f2v){bflo(ua.x), bfhi(ua.x)}; u[1] = (f2v){bflo(ua.y), bfhi(ua.y)}; u[2] = (f2v){bflo(ua.z), bfhi(ua.z)}; u[3] = (f2v){bflo(ua.w), bfhi(ua.w)}; \
            u[4] = (f2v){bflo(ub.x), bfhi(ub.x)}; u[5] = (f2v){bflo(ub.y), bfhi(ub.y)}; u[6] = (f2v){bflo(ub.z), bfhi(ub.z)}; u[7] = (f2v){bflo(ub.w), bfhi(ub.w)}; \
            float dv[16]; \
            _Pragma("unroll") for (int k = 0; k < 8; ++k) { PEER_CVT8(GA.r[k]); f2v t = c0 * u[0]; t += c1 * u[1]; t += c2 * u[2]; t += c3 * u[3]; t += c4 * u[4]; t += c5 * u[5]; t += c6 * u[6]; t += c7 * u[7]; dv[k] = t.x + t.y; } \
            gather8(GA, tbu, loff, e2a, pg); \
            _Pragma("unroll") for (int k = 0; k < 8; ++k) { PEER_CVT8(GB.r[k]); f2v t = c0 * u[0]; t += c1 * u[1]; t += c2 * u[2]; t += c3 * u[3]; t += c4 * u[4]; t += c5 * u[5]; t += c6 * u[6]; t += c7 * u[7]; dv[8 + k] = t.x + t.y; } \
            const f2v r2 = rscatter16(dv, p0, p1, p2, 1, 2, 4);                          \
            if ((i) < nt) { float* po = part_out + (size_t)UP_TOK(i) * NSLOT; po[0] = r2.x; po[8] = r2.y; } \
            e1a = e2a; e1b = e2b; e2a = e3a; e2b = e3b; ua = una; ub = unb; } while (0)
        for (int i = 0; i < nt; i += 2) { UP_BODY(i, G0, G1, G2, G3); UP_BODY(i + 1, G2, G3, G0, G1); }
#undef UP_BODY
#undef UP_LOADU
#undef UP_LOADE
#undef UP_TOK
    }
}
__device__ __forceinline__ void phase10(const Prm& p, const Frame& F) {
    static_assert(NE <= 16384 && NSLOT == 128 && T % 64 == 0, "14-bit expert id, 64-token groups");
    LAS unsigned* tile = (LAS unsigned*)F.lds;
    for (int tg = F.bid; tg < T / 64; tg += F.G) {
        __syncthreads();
#pragma unroll 4
        for (int k = 0; k < 16; ++k) { const int idx = F.tid + NTHR * k, tl = idx >> 7, sl = idx & 127; const size_t i = ((size_t)tg * 64 + tl) * NSLOT + sl; float s = 0.f;
#pragma unroll
            for (int ds = 0; ds < NDS; ++ds) s += p.SC()[(size_t)ds * T * NSLOT + i];
            const int e = p.EIDX()[i]; const _Float16 w = (_Float16)(p.EW()[i] * gelu_exact(s * p.RSU()[e]));
            tile[tl * 129 + sl] = ((unsigned)__builtin_bit_cast(unsigned short, w) << 16) | (unsigned)e; }
        __syncthreads();
        uint4* pk = (uint4*)p.EW() + (size_t)tg * 64 * (NSLOT / 4);
#pragma unroll
        for (int k = 0; k < 4; ++k) { const int j = F.tid + NTHR * k, sq = j >> 6, tl = j & 63; const LAS unsigned* tp = tile + tl * 129 + 4 * sq; pk[j] = make_uint4(tp[0], tp[1], tp[2], tp[3]); }
    }
}
__device__ __forceinline__ void phase11(const Prm& p, const Frame& F) {
    static_assert(NE * 8 <= RING_BYTES && D % 8 == 0 && NE <= 65536, "table slice fits the LDS ring");
    typedef _Float16 h2v __attribute__((ext_vector_type(2)));
    const int c0 = (F.G % 8 == 0) ? (F.bid % 8) * (F.G / 8) + F.bid / 8 : F.bid;
    for (int sidx = c0; sidx < D / 4; sidx += F.G) {
        __syncthreads();
        { const uint4* src = (const uint4*)(p.PVH() + (size_t)sidx * NE * 4);
          for (int i = F.tid; i < NE / 2; i += NTHR) *(LAS u32x4_t*)(F.lds + 16 * i) = __builtin_bit_cast(u32x4_t, src[i]); }
        __syncthreads();
        const int ntg = (T / 64 - F.wave + NWAVES - 1) / NWAVES, nb = 8 * ntg;
        uint4 b0[4], b1[4], b2[4], b3[4];
#define DN_PTR(bi) ((const uint4*)p.EW() + (size_t)(F.wave + ((bi) >> 3) * NWAVES) * 64 * (NSLOT / 4) + ((bi) & 7) * 4 * 64 + F.lane)
#define DN_LOAD(B, bi) do { const int bc_ = (bi) < nb ? (bi) : nb - 1; const uint4* pk_ = DN_PTR(bc_); _Pragma("unroll") for (int k = 0; k < 4; ++k) B[k] = pk_[k * 64]; } while (0)
#define DN_ONE(v_) do { const unsigned vv_ = (v_); const _Float16 w = __builtin_bit_cast(_Float16, (unsigned short)(vv_ >> 16)); const h2v w2 = {w, w}; \
                const u2v t = *(const LAS u2v*)(F.lds + ((vv_ & 0xFFFFu) << 3)); const unsigned tx_ = t.x, ty_ = t.y;     \
                a0 += __builtin_bit_cast(h2v, tx_) * w2; a1 += __builtin_bit_cast(h2v, ty_) * w2; } while (0)
#define DN_ACC(B) do { _Pragma("unroll") for (int k = 0; k < 4; ++k) { DN_ONE(B[k].x); DN_ONE(B[k].y); DN_ONE(B[k].z); DN_ONE(B[k].w); } asm volatile("" ::: "memory"); } while (0)
        DN_LOAD(b0, 0); DN_LOAD(b1, 1); DN_LOAD(b2, 2);
        for (int bi = 0; bi < nb; bi += 8) {
            h2v a0 = {0, 0}, a1 = {0, 0};
            DN_LOAD(b3, bi + 3); DN_ACC(b0);
            DN_LOAD(b0, bi + 4); DN_ACC(b1);
            DN_LOAD(b1, bi + 5); DN_ACC(b2);
            DN_LOAD(b2, bi + 6); DN_ACC(b3);
            DN_LOAD(b3, bi + 7); DN_ACC(b0);
            DN_LOAD(b0, bi + 8); DN_ACC(b1);
            DN_LOAD(b1, bi + 9); DN_ACC(b2);
            DN_LOAD(b2, bi + 10); DN_ACC(b3);
            const int tg = F.wave + (bi >> 3) * NWAVES;
            *(uint2*)(p.Y() + ((size_t)tg * 64 + F.lane) * D + 4 * sidx) = make_uint2(pk2((float)a0[0], (float)a0[1]), pk2((float)a1[0], (float)a1[1]));
        }
#undef DN_ACC
#undef DN_ONE
#undef DN_LOAD
#undef DN_PTR
    }
}
__device__ __forceinline__ void phase12(const Prm& p, const Frame& F) {
    const int gw = F.bid * NWAVES + F.wave, NGW = F.G * NWAVES;
    float4 v[8], vn[8];
    if (gw < T) { const float4* zr = (const float4*)(p.out + (size_t)gw * D) + F.lane;
#pragma unroll
        for (int j = 0; j < 8; ++j) v[j] = zr[64 * j]; }
    for (int row = gw; row < T; row += NGW) {
        float4* zr = (float4*)(p.out + (size_t)row * D) + F.lane; float s = 0.f;
        if (row + NGW < T) { const float4* zn = (const float4*)(p.out + (size_t)(row + NGW) * D) + F.lane;
#pragma unroll
            for (int j = 0; j < 8; ++j) vn[j] = zn[64 * j]; }
        const float* g2 = p.MOD() + (size_t)(row / S) * D6 + 5 * D;
#pragma unroll
        for (int j = 0; j < 8; ++j) { const uint2 y = *((const uint2*)(p.Y() + (size_t)row * D) + F.lane + 64 * j); const float4 g = *((const float4*)g2 + F.lane + 64 * j);
            v[j].x = ALPHA * v[j].x + g.x * bflo(y.x); v[j].y = ALPHA * v[j].y + g.y * bfhi(y.x); v[j].z = ALPHA * v[j].z + g.z * bflo(y.y); v[j].w = ALPHA * v[j].w + g.w * bfhi(y.y);
            s += (v[j].x + v[j].y) + (v[j].z + v[j].w); }
        const float mean = wave_sum(s) * (1.f / D); float s2 = 0.f;
#pragma unroll
        for (int j = 0; j < 8; ++j) { v[j].x -= mean; v[j].y -= mean; v[j].z -= mean; v[j].w -= mean; s2 += (v[j].x * v[j].x + v[j].y * v[j].y) + (v[j].z * v[j].z + v[j].w * v[j].w); }
        const float rstd = 1.f / sqrtf(wave_sum(s2) * (1.f / D) + LN_EPS);
#pragma unroll
        for (int j = 0; j < 8; ++j) { const float4 w = *((const float4*)p.ln2_w + F.lane + 64 * j), bb = *((const float4*)p.ln2_b + F.lane + 64 * j);
            zr[64 * j] = make_float4(v[j].x * rstd * w.x + bb.x, v[j].y * rstd * w.y + bb.y, v[j].z * rstd * w.z + bb.z, v[j].w * rstd * w.w + bb.w); }
#pragma unroll
        for (int j = 0; j < 8; ++j) v[j] = vn[j];
    }
}

struct Args { const float* in[18]; float* out; unsigned char* ws; int ph_lo, ph_hi, li, pad; };
__global__ void __launch_bounds__(NTHR, 2) mk_fwd(Args args) {
    extern __shared__ __attribute__((aligned(16))) unsigned char lds_raw[];
    Frame F; F.lds = (LAS unsigned char*)lds_raw; F.tid = threadIdx.x; F.lane = F.tid & 63; F.wave = __builtin_amdgcn_readfirstlane(F.tid >> 6); F.G = gridDim.x; F.bid = blockIdx.x;
    Prm p; p.x = args.in[0]; p.c = args.in[1]; p.w_ada = args.in[2]; p.b_ada = args.in[3]; p.w_in = args.in[4]; p.b_in = args.in[5]; p.conv_w = args.in[6]; p.conv_b = args.in[7]; p.mnorm_w = args.in[8];
    p.w_out = args.in[9]; p.ln1_w = args.in[10]; p.ln1_b = args.in[11]; p.wq = args.in[12]; p.subkeys = args.in[13]; p.peer_u = args.in[14]; p.peer_v = args.in[15]; p.ln2_w = args.in[16]; p.ln2_b = args.in[17];
    p.out = args.out; p.ws = args.ws;
    volatile LAS unsigned* MISC = (volatile LAS unsigned*)(F.lds + MISC_OFF);
    for (int u = F.tid; u < (LDS_BYTES - LDSCTL_OFF) / 4; u += NTHR) ((LAS unsigned*)(F.lds + LDSCTL_OFF))[u] = 0u;
    __syncthreads();
    const int lo = args.ph_lo, hi = args.ph_hi;
    XcdBarrier bar; bar.bar = (unsigned*)(p.ws + WS_CTL) + CW_BAR + args.li * XCD_BAR_WORDS; bar.x = 0; bar.st = nullptr;
    if (hi - lo > 1) bar = xcd_barrier_post((unsigned*)(p.ws + WS_CTL) + CW_BAR + args.li * XCD_BAR_WORDS, MISC + 8);
#define IN(k) (lo <= (k) && (k) < hi)
#define SEAM(k) do { if (IN(k) && IN((k) + 1)) xcd_barrier(bar); } while (0)
    XW xw; xw.nx = (F.G % 8 == 0) ? 8 : 1; xw.vx = F.bid % xw.nx; xw.rank = F.bid / xw.nx; xw.nloc = F.G / xw.nx;
#define XW_FROM_CENSUS() do { if (hi - lo > 1) { if (F.tid == 0) { unsigned vx_ = 0u; for (unsigned j = 0; j < bar.x; ++j) vx_ += xb_ld(&bar.bar[XB_XCNT(j)]) > 0u ? 1u : 0u; MISC[11] = vx_; } __syncthreads(); \
        xw.vx = (int)MISC[11]; xw.nx = (int)MISC[9]; xw.rank = (int)MISC[10] - 1; xw.nloc = (int)MISC[8]; } } while (0)
    if (IN(0)) { phase0(p, F); } SEAM(0);
    if (IN(1)) { phase1(p, F); } SEAM(1);
    if (IN(2)) { pg8::Gemm g{p.U(), p.WIN_T(), T, INM, D}; pg8::StaticOrder So; So.init(T, INM, F.G, F.bid);
        pg8::EpiBf16<0> E{p.PJ(), INM, p.b_in, 0, 0, 1.f};
        pg8::gemm_phase<pg8::EpiBf16<0>, pg8::StaticOrder, true, true>(F.lds, g, So, E); } SEAM(2);
    if (IN(3)) { const int nmb = F.G >= 2 ? F.G / 2 : 1;
#ifndef P3_REP_ML
#define P3_REP_ML 1
#define P3_REP_CONV 1
#endif
        if (F.bid < nmb) { for (int rep_ = 0; rep_ < P3_REP_ML; ++rep_) for (int u = F.bid; u < 2 * NB * MH * 2; u += nmb) ml::unit(p, F, u); if (F.G < 2) phase3a(p, F, 0, 1); }
        else for (int rep_ = 0; rep_ < P3_REP_CONV; ++rep_) phase3a(p, F, nmb, F.G - nmb); } SEAM(3);
    if (IN(4)) { phase4(p, F); } SEAM(4);
    if (IN(5)) { pg8::Gemm g{p.Y(), p.WOUT_T(), T, D, D}; pg8::StaticOrder So; So.init(T, D, F.G, F.bid);
        EpiZ E{p.x, p.MOD(), p.out};
        pg8::gemm_phase<EpiZ, pg8::StaticOrder, true, true>(F.lds, g, So, E); } SEAM(5);
    if (IN(6)) { phase6(p, F); } SEAM(6);
    if (IN(7)) { pg8::Gemm g{p.U(), p.WQ_T(), T, NQ, D}; pg8::StaticOrder So; So.init(T, NQ, F.G, F.bid);
        EpiF32 E{p.SC(), NSC};
        pg8::gemm_phase<EpiF32, pg8::StaticOrder, true, true>(F.lds, g, So, E); } SEAM(7);
    if (IN(8)) { phase8(p, F); } SEAM(8);
    if (IN(9)) { if (lo < 9) XW_FROM_CENSUS(); phase9(p, F, xw); } SEAM(9);
    if (IN(10)) { phase10(p, F); } SEAM(10);
    if (IN(11)) { phase11(p, F); } SEAM(11);
    if (IN(12)) { phase12(p, F); }
#undef IN
#undef SEAM
}

extern "C" void kernel_launch(void* const* d_in, const int* in_sizes, int n_in, void* d_out, int out_size, void* d_ws, size_t ws_size, hipStream_t stream) {
    static int grid = 0;
    if (grid == 0) {
        if (n_in != 18 || out_size != T * D || ws_size < WS_END) { fprintf(stderr, "kernel_launch: unexpected shapes (n_in %d out %d ws %zu, need %zu)\n", n_in, out_size, ws_size, (size_t)WS_END); grid = -1; return; }
        int dev = 0, cus = 0, per_cu = 0;
        if (hipGetDevice(&dev) != hipSuccess || hipDeviceGetAttribute(&cus, hipDeviceAttributeMultiprocessorCount, dev) != hipSuccess) { grid = -1; return; }
        if (hipFuncSetAttribute((const void*)mk_fwd, hipFuncAttributeMaxDynamicSharedMemorySize, LDS_BYTES) != hipSuccess) { fprintf(stderr, "kernel_launch: hipFuncSetAttribute failed\n"); grid = -1; return; }
        if (hipOccupancyMaxActiveBlocksPerMultiprocessor(&per_cu, (const void*)mk_fwd, NTHR, LDS_BYTES) != hipSuccess || per_cu < 1) { fprintf(stderr, "kernel_launch: occupancy query says %d\n", per_cu); }
        (void)hipGetLastError();
        grid = cus;
        if (T % grid != 0 || (T / grid) % NWAVES != 0) { fprintf(stderr, "kernel_launch: grid %d does not divide the rows\n", grid); grid = -1; return; }
    }
    if (grid < 0) return;
    (void)hipMemsetAsync((char*)d_ws + WS_CTL, 0, 1u << 20, stream);
    Args a{};
    for (int i = 0; i < 18; ++i) a.in[i] = (const float*)d_in[i];
    a.out = (float*)d_out; a.ws = (unsigned char*)d_ws;
#if defined(PROBE_A)
    a.ph_lo = 0; a.ph_hi = PROBE_B + 1; a.li = 0; hipLaunchKernelGGL(mk_fwd, dim3(grid), dim3(NTHR), LDS_BYTES, stream, a);
    a.ph_lo = PROBE_A; a.ph_hi = NPHASE; a.li = 1; hipLaunchKernelGGL(mk_fwd, dim3(grid), dim3(NTHR), LDS_BYTES, stream, a);
#elif MK_N_LAUNCHES == 1
    a.ph_lo = 0; a.ph_hi = NPHASE;
    hipLaunchKernelGGL(mk_fwd, dim3(grid), dim3(NTHR), LDS_BYTES, stream, a);
#else
    for (int k = 0; k < NPHASE; ++k) { a.ph_lo = k; a.ph_hi = k + 1; hipLaunchKernelGGL(mk_fwd, dim3(grid), dim3(NTHR), LDS_BYTES, stream, a); }
#endif
}
```

```cpp
#define MK_N_LAUNCHES 1
#if defined(HOST_EMU)
#include <cmath>
#include <cstdint>
#include <cstring>
#include <cstddef>
#define HD inline
#define HDF inline
#else
#include <hip/hip_runtime.h>
#define HD __host__ __device__ __forceinline__
#define HDF __host__ __device__ __forceinline__
#endif

#ifndef CFG_D
#define CFG_D 2048
#define CFG_B 8
#define CFG_S 2048
#define CFG_PH 8
#define CFG_NK 128
#define CFG_TOPK 16
#define CFG_KD 256
#endif
constexpr int D = CFG_D, NB = CFG_B, S = CFG_S, T = NB * S;
constexpr int CW = D / 2, MW = D - CW, MH = 4, MV = MW / MH, QK = MV / 2, NG = 16, CHUNK = 64;
constexpr int INC = 3 * CW + 2 * MH * QK + 2 * MW + NG;
constexpr int INM = INC - NG;
constexpr int O_GB = 0, O_GC = CW, O_HIN = 2 * CW, O_Q = 3 * CW, O_K = O_Q + MH * QK, O_V = O_K + MH * QK, O_O = O_V + MW;
constexpr int PH = CFG_PH, NK = CFG_NK, TOPK = CFG_TOPK, KD = CFG_KD, KH = KD / 2, NE = NK * NK, NSLOT = PH * TOPK;
constexpr int NQ = PH * KD;
static_assert(PH * 2 * NK == NQ || true, "");
constexpr int NSC = PH * 2 * NK;
constexpr float LN_EPS = 1e-5f;
constexpr float ALPHA = 1.189207115002721f;
constexpr int D6 = 6 * D;

typedef unsigned short bf16_t;
HDF unsigned f_as_u(float f) { unsigned u; memcpy(&u, &f, 4); return u; }
HDF float u_as_f(unsigned u) { float f; memcpy(&f, &u, 4); return f; }
HDF bf16_t f2bf(float f) { unsigned u = f_as_u(f); return (bf16_t)((u + 0x7fffu + ((u >> 16) & 1u)) >> 16); }
HDF float bf2f(bf16_t h) { return u_as_f((unsigned)h << 16); }

constexpr size_t al(size_t x) { return (x + 1048575) & ~(size_t)1048575; }
constexpr size_t WS_CTL = 0;
constexpr size_t WS_MOD = al(1);
constexpr size_t WS_MODP = WS_MOD + al((size_t)NB * D6 * 4);
constexpr int NKS = 32;
constexpr size_t WS_GATES = WS_MODP + al((size_t)NKS * NB * D6 * 4);
constexpr size_t WS_DEN = WS_GATES + al((size_t)T * NG * 4);
constexpr size_t WS_FLR = WS_DEN + al((size_t)4 * T * MH * 4);
constexpr size_t WS_EIDX = WS_FLR + al((size_t)2 * T * MH * 4);
constexpr size_t WS_EW = WS_EIDX + al((size_t)T * NSLOT * 4);
constexpr size_t WS_WIN_T = WS_EW + al((size_t)T * NSLOT * 4);
constexpr size_t WS_WOUT_T = WS_WIN_T + al((size_t)INM * D * 2);
constexpr size_t WS_WQ_T = WS_WOUT_T + al((size_t)D * D * 2);
constexpr size_t WS_PU16 = WS_WQ_T + al((size_t)NQ * D * 2);
constexpr size_t WS_PV16 = WS_PU16 + al((size_t)NE * D * 2);
constexpr size_t WS_U = WS_PV16 + al((size_t)NE * D * 2);
constexpr size_t WS_Y = WS_U + al((size_t)T * D * 2);
constexpr size_t WS_P = WS_Y + al((size_t)T * D * 2);
constexpr size_t WS_SC = WS_P;
constexpr size_t WS_TS = WS_SC + al((size_t)T * NSC * 4);
constexpr size_t WS_TI = WS_TS + al((size_t)T * PH * 2 * TOPK * 4);
constexpr size_t WS_P_END = WS_P + al((size_t)T * INM * 2);
constexpr size_t WS_TI_END = WS_TI + al((size_t)T * PH * 2 * TOPK * 4);
constexpr size_t WS_END = WS_P_END > WS_TI_END ? WS_P_END : WS_TI_END;

struct Prm {
    const float *x, *c, *w_ada, *b_ada, *w_in, *b_in, *conv_w, *conv_b, *mnorm_w, *w_out, *ln1_w, *ln1_b, *wq, *subkeys, *peer_u, *peer_v, *ln2_w, *ln2_b;
    float* out;
    unsigned char* ws;
    HDF float* MOD() const { return (float*)(ws + WS_MOD); }
    HDF float* MODP() const { return (float*)(ws + WS_MODP); }
    HDF float* GATES() const { return (float*)(ws + WS_GATES); }
    HDF float* DEN() const { return (float*)(ws + WS_DEN); }
    HDF float* FLR() const { return (float*)(ws + WS_FLR); }
    HDF int* EIDX() const { return (int*)(ws + WS_EIDX); }
    HDF float* EW() const { return (float*)(ws + WS_EW); }
    HDF bf16_t* WIN_T() const { return (bf16_t*)(ws + WS_WIN_T); }
    HDF bf16_t* WOUT_T() const { return (bf16_t*)(ws + WS_WOUT_T); }
    HDF bf16_t* WQ_T() const { return (bf16_t*)(ws + WS_WQ_T); }
    HDF bf16_t* PU16() const { return (bf16_t*)(ws + WS_PU16); }
    HDF bf16_t* PV16() const { return (bf16_t*)(ws + WS_PV16); }
    HDF unsigned char* PU8() const { return ws + WS_PU16; }
    HDF unsigned char* PV8() const { return ws + WS_PV16; }
    HDF unsigned short* PVH() const { return (unsigned short*)(ws + WS_PV16); }
    HDF float* RSU() const { return (float*)(ws + WS_PU16 + (size_t)NE * D); }
    HDF float* RSV() const { return (float*)(ws + WS_PV16 + (size_t)NE * D); }
    HDF bf16_t* U() const { return (bf16_t*)(ws + WS_U); }
    HDF bf16_t* Y() const { return (bf16_t*)(ws + WS_Y); }
    HDF bf16_t* PJ() const { return (bf16_t*)(ws + WS_P); }
    HDF float* SC() const { return (float*)(ws + WS_SC); }
    HDF bf16_t* X1B() const { return (bf16_t*)(ws + WS_TS); }
    HDF float* TS() const { return (float*)(ws + WS_TS); }
    HDF int* TI() const { return (int*)(ws + WS_TI); }
    HDF float* HF() const { return out; }
    HDF float* HB() const { return out + (size_t)T * MW; }
    HDF bf16_t* HF16() const { return (bf16_t*)out; }
    HDF bf16_t* HB16() const { return (bf16_t*)out + (size_t)T * MW; }
};

HDF float sigmoidf_(float x) { return 1.f / (1.f + expf(-x)); }
HDF float logsigmoidf_(float x) { return fminf(x, 0.f) - log1pf(expf(-fabsf(x))); }
HDF float gelu_exact(float x) { return 0.5f * x * (1.f + erff(x * 0.7071067811865476f)); }

HD void b_ada(const Prm& p, long n) {
    float acc[NB];
#pragma unroll
    for (int b = 0; b < NB; ++b) acc[b] = 0.f;
    for (int k = 0; k < D; ++k) {
        const float w = p.w_ada[(size_t)k * D6 + n];
#pragma unroll
        for (int b = 0; b < NB; ++b) { const float cv = p.c[b * D + k]; acc[b] += cv * sigmoidf_(cv) * w; }
    }
#pragma unroll
    for (int b = 0; b < NB; ++b) p.MOD()[(size_t)b * D6 + n] = acc[b] + p.b_ada[n];
}
HD void b_wt(const float* W, int ldw, int K, bf16_t* WT, long i) { const long n = i / K, k = i % K; WT[i] = f2bf(W[(size_t)k * ldw + n]); }
HD void b_tab(const float* src, bf16_t* dst, long i) { dst[i] = f2bf(src[i]); }
HD void b_ln_mod1(const Prm& p, long row) {
    const float* xr = p.x + (size_t)row * D; const int b = (int)(row / S);
    const float* sh = p.MOD() + (size_t)b * D6; const float* sc = sh + D;
    float s = 0.f; for (int d = 0; d < D; ++d) s += xr[d];
    const float mean = s / D; float q = 0.f; for (int d = 0; d < D; ++d) { const float t = xr[d] - mean; q += t * t; }
    const float rstd = 1.f / sqrtf(q / D + LN_EPS);
    for (int d = 0; d < D; ++d) p.U()[(size_t)row * D + d] = f2bf((xr[d] - mean) * rstd * (1.f + sc[d]) + sh[d]);
}
HD void b_gates(const Prm& p, long i) {
    const long row = i / NG; const int g = (int)(i % NG); float acc = 0.f;
    for (int d = 0; d < D; ++d) acc += bf2f(p.U()[(size_t)row * D + d]) * p.w_in[(size_t)d * INC + INM + g];
    p.GATES()[i] = acc + p.b_in[INM + g];
}
HD float b_dot16(const bf16_t* a, const bf16_t* b, int K) { float acc = 0.f; for (int k = 0; k < K; ++k) acc += bf2f(a[k]) * bf2f(b[k]); return acc; }
HD void b_gemm1(const Prm& p, long i) { const long row = i / INM; const int n = (int)(i % INM);
    p.PJ()[i] = f2bf(b_dot16(p.U() + (size_t)row * D, p.WIN_T() + (size_t)n * D, D) + p.b_in[n]); }
HD void b_conv(const Prm& p, long i) {
    const long row = i / CW; const int ch = (int)(i % CW); const int s = (int)(row % S);
    const bf16_t* pj = p.PJ(); float acc = p.conv_b[ch];
#pragma unroll
    for (int k = 0; k < 3; ++k) { const int s2 = s + k - 1; if (s2 >= 0 && s2 < S) { const size_t r2 = (size_t)(row + k - 1) * INM;
        acc += p.conv_w[k * CW + ch] * (bf2f(pj[r2 + O_GC + ch]) * bf2f(pj[r2 + O_HIN + ch])); } }
    p.Y()[(size_t)row * D + ch] = f2bf(bf2f(pj[(size_t)row * INM + O_GB + ch]) * acc);
}
HDF long ml_tok(int dir, int b, int pos) { return (long)b * S + (dir ? S - 1 - pos : pos); }
HD void b_mscan(const Prm& p, long i) {
    const int v = (int)(i % (MV + 1)), h = (int)((i / (MV + 1)) % MH), b = (int)((i / ((MV + 1) * MH)) % NB), dir = (int)(i / ((MV + 1) * MH * NB));
    float C[QK];
#pragma unroll
    for (int d = 0; d < QK; ++d) C[d] = 0.f;
    float m = 0.f; const float qs = 1.f / sqrtf((float)QK);
    float* H = dir ? p.HB() : p.HF();
    for (int pos = 0; pos < S; ++pos) {
        const long tok = ml_tok(dir, b, pos); const float* g = p.GATES() + tok * NG + dir * 8;
        const float ig = g[h], lf = logsigmoidf_(g[4 + h]);
        const float mn = fmaxf(lf + m, ig), dec = expf(lf + m - mn), wi = expf(ig - mn); m = mn;
        const bf16_t* pj = p.PJ() + (size_t)tok * INM; const float wv = wi * (v < MV ? bf2f(pj[O_V + h * MV + (v < MV ? v : 0)]) : 1.f); float num = 0.f;
#pragma unroll
        for (int d = 0; d < QK; ++d) { C[d] = dec * C[d] + wv * bf2f(pj[O_K + h * QK + d]); num += bf2f(pj[O_Q + h * QK + d]) * qs * C[d]; }
        if (v < MV) H[(size_t)tok * MW + h * MV + v] = num;
        else { p.DEN()[((size_t)dir * T + tok) * MH + h] = num; p.FLR()[((size_t)dir * T + tok) * MH + h] = expf(-mn); }
    }
}
HD void b_headnorm(const Prm& p, long i) {
    const long row = i / MH; const int h = (int)(i % MH);
    const float* hf = p.HF() + (size_t)row * MW + h * MV; const float* hb = p.HB() + (size_t)row * MW + h * MV;
    const float inf_ = 1.f / fmaxf(fabsf(p.DEN()[(size_t)row * MH + h]), p.FLR()[(size_t)row * MH + h]);
    const float inb_ = 1.f / fmaxf(fabsf(p.DEN()[((size_t)T + row) * MH + h]), p.FLR()[((size_t)T + row) * MH + h]);
    float s = 0.f; for (int v = 0; v < MV; ++v) s += hf[v] * inf_ + hb[v] * inb_;
    const float mean = s / MV; float q = 0.f; for (int v = 0; v < MV; ++v) { const float t = hf[v] * inf_ + hb[v] * inb_ - mean; q += t * t; }
    const float rstd = 1.f / sqrtf(q / MV + LN_EPS);
    for (int v = 0; v < MV; ++v) { const float hn = (hf[v] * inf_ + hb[v] * inb_ - mean) * rstd * p.mnorm_w[h * MV + v];
        const float og = sigmoidf_(bf2f(p.PJ()[(size_t)row * INM + O_O + h * MV + v]));
        p.Y()[(size_t)row * D + CW + h * MV + v] = f2bf(og * hn); }
}
HD void b_gemm2(const Prm& p, long i) { const long row = i / D; const int n = (int)(i % D); const int b = (int)(row / S);
    const float acc = b_dot16(p.Y() + (size_t)row * D, p.WOUT_T() + (size_t)n * D, D);
    p.out[i] = ALPHA * p.x[i] + p.MOD()[(size_t)b * D6 + 2 * D + n] * acc; }
HD void b_ln_mid(const Prm& p, long row) {
    float* zr = p.out + (size_t)row * D; const int b = (int)(row / S);
    const float* sh = p.MOD() + (size_t)b * D6 + 3 * D; const float* sc = sh + D;
    float s = 0.f; for (int d = 0; d < D; ++d) s += zr[d];
    float mean = s / D; float q = 0.f; for (int d = 0; d < D; ++d) { const float t = zr[d] - mean; q += t * t; }
    float rstd = 1.f / sqrtf(q / D + LN_EPS);
    s = 0.f; for (int d = 0; d < D; ++d) { const float x1 = (zr[d] - mean) * rstd * p.ln1_w[d] + p.ln1_b[d]; zr[d] = x1; s += x1; }
    mean = s / D; q = 0.f; for (int d = 0; d < D; ++d) { const float t = zr[d] - mean; q += t * t; }
    rstd = 1.f / sqrtf(q / D + LN_EPS);
    for (int d = 0; d < D; ++d) p.U()[(size_t)row * D + d] = f2bf((zr[d] - mean) * rstd * (1.f + sc[d]) + sh[d]);
}
HD void b_gemm3(const Prm& p, long i) { const long row = i / NQ; const int n = (int)(i % NQ);
    p.Y()[i] = f2bf(b_dot16(p.U() + (size_t)row * D, p.WQ_T() + (size_t)n * D, D)); }
HD void b_scores(const Prm& p, long i) { const long tok = i / NSC; const int c = (int)(i % NSC), grp = c / NK, n = c % NK;
    const bf16_t* q = p.Y() + (size_t)tok * NQ + grp * KH; const float* sk = p.subkeys + ((size_t)grp * NK + n) * KH; float acc = 0.f;
    for (int d = 0; d < KH; ++d) acc += bf2f(q[d]) * sk[d];
    p.SC()[i] = acc; }
HD void b_topk1(const Prm& p, long i) {
    const float* sc = p.SC() + (size_t)i * NK; float pv = INFINITY; int pi = -1;
    for (int r = 0; r < TOPK; ++r) { float best = -INFINITY; int bi = -1;
        for (int n = 0; n < NK; ++n) { const float v = sc[n]; const bool ok = (v < pv) || (v == pv && n > pi); if (ok && v > best) { best = v; bi = n; } }
        p.TS()[(size_t)i * TOPK + r] = best; p.TI()[(size_t)i * TOPK + r] = bi; pv = best; pi = bi; }
}
HD void b_topk2(const Prm& p, long i) {
    const float* s0 = p.TS() + (size_t)i * 2 * TOPK; const float* s1 = s0 + TOPK; const int* i0 = p.TI() + (size_t)i * 2 * TOPK; const int* i1 = i0 + TOPK;
    float pv = INFINITY; int pi = -1; float mx = 0.f, sum = 0.f;
    for (int r = 0; r < TOPK; ++r) { float best = -INFINITY; int bi = -1;
        for (int c = 0; c < TOPK * TOPK; ++c) { const float v = s0[c / TOPK] + s1[c % TOPK]; const bool ok = (v < pv) || (v == pv && c > pi); if (ok && v > best) { best = v; bi = c; } }
        if (r == 0) mx = best;
        const float e = expf(best - mx); sum += e;
        p.EIDX()[(size_t)i * TOPK + r] = i0[bi / TOPK] * NK + i1[bi % TOPK]; p.EW()[(size_t)i * TOPK + r] = e; pv = best; pi = bi; }
    for (int r = 0; r < TOPK; ++r) p.EW()[(size_t)i * TOPK + r] /= sum;
}
HD void b_up(const Prm& p, long i) { const long tok = i / NSLOT; const int e = p.EIDX()[i];
    p.EW()[i] *= gelu_exact(b_dot16(p.U() + (size_t)tok * D, p.PU16() + (size_t)e * D, D)); }
HD void b_down(const Prm& p, long i) { const long tok = i / D; const int d = (int)(i % D); const int b = (int)(tok / S); float y = 0.f;
    for (int sl = 0; sl < NSLOT; ++sl) y += p.EW()[tok * NSLOT + sl] * bf2f(p.PV16()[(size_t)p.EIDX()[tok * NSLOT + sl] * D + d]);
    p.out[i] = ALPHA * p.out[i] + p.MOD()[(size_t)b * D6 + 5 * D + d] * y; }
HD void b_ln2(const Prm& p, long row) {
    float* zr = p.out + (size_t)row * D;
    float s = 0.f; for (int d = 0; d < D; ++d) s += zr[d];
    const float mean = s / D; float q = 0.f; for (int d = 0; d < D; ++d) { const float t = zr[d] - mean; q += t * t; }
    const float rstd = 1.f / sqrtf(q / D + LN_EPS);
    for (int d = 0; d < D; ++d) zr[d] = (zr[d] - mean) * rstd * p.ln2_w[d] + p.ln2_b[d];
}
#include <cstdio>
#define LAS __attribute__((address_space(3)))
#define GAS __attribute__((address_space(1)))
namespace pg8 {
#define PG8_LAS __attribute__((address_space(3)))
typedef unsigned short bf16_t;
typedef short bf16x8 __attribute__((ext_vector_type(8)));
typedef float f32x4 __attribute__((ext_vector_type(4)));
typedef unsigned u32x4 __attribute__((ext_vector_type(4)));
constexpr int BM = 256, BK = 64, HALF = 128, HTB = HALF * BK * 2  , STAGE_BYTES = 8 * HTB, NXCD = 8, WGM = 8;

__host__ __device__ __forceinline__ int lds_byte(int r, int c) { const int st = (r >> 4) * 2 + (c >> 5), rr = r & 15, cc = c & 31, ob = rr * 64 + cc * 2; return st * 1024 + (ob ^ (((ob >> 9) & 1) << 5)); }
__host__ __device__ __forceinline__ void stage_rc(int b, int& R, int& C) { const int st = b / 1024, sb = b % 1024, swz = sb ^ (((sb >> 9) & 1) << 5); R = (st >> 1) * 16 + swz / 64; C = (st & 1) * 32 + (swz % 64) / 2; }
__host__ __device__ __forceinline__ int perm32(int rho) { const int n = rho >> 4, i = rho & 15; return 8 * (i >> 2) + 4 * n + (i & 3); }

struct Unit { int pm, pn; };
struct Gemm { const bf16_t* A; const bf16_t* Bt; int M, N, K; };

struct StaticOrder {
    int nM, nN, nwg, G, c;
    __host__ __device__ void init(int M, int N, int G_, int c_) { nM = M / BM; nN = N / BM; nwg = nM * nN; G = G_; c = c_; }
    __host__ __device__ bool next(int i, Unit& u) const {
        const long L = (long)i * G + c; if (L >= nwg) return false;
        int wgid = (int)L; { const int q = nwg / NXCD, r = nwg % NXCD, xcd = wgid % NXCD, off = wgid / NXCD; wgid = (xcd < r ? xcd * (q + 1) : r * (q + 1) + (xcd - r) * q) + off; }
        const int nig = WGM * nN, gid = wgid / nig, fm = gid * WGM, gsz = (nM - fm) < WGM ? (nM - fm) : WGM;
        u.pm = fm + ((wgid % nig) % gsz); u.pn = (wgid % nig) / gsz; return true;
    }
    __device__ __forceinline__ void a_ready(const Unit&) const {}
    __device__ __forceinline__ void done(const Unit&) const {}
};

__device__ __forceinline__ unsigned cvt_pk_bf16(float lo, float hi) { unsigned r; asm volatile("v_cvt_pk_bf16_f32 %0, %1, %2" : "=v"(r) : "v"(lo), "v"(hi)); return r; }
typedef float f32x2 __attribute__((ext_vector_type(2)));
__device__ __forceinline__ f32x2 gelu_pk(f32x2 v) {
    const f32x2 av = __builtin_elementwise_abs(v), d = av * 0.2316418882f + 1.0f;
    f32x2 t; t.x = __builtin_amdgcn_rcpf(d.x); t.y = __builtin_amdgcn_rcpf(d.y);
    f32x2 q = t * 0.5307027145f + (-0.7265760135f); q = q * t + 0.7107068705f; q = q * t + (-0.142248368f); q = q * t + 0.127414796f; q = q * t;
    const f32x2 s = (v * v) * (-0.72134752044f);
    f32x2 e; e.x = __builtin_amdgcn_exp2f(s.x); e.y = __builtin_amdgcn_exp2f(s.y);
    const f32x2 m = v * (q * e), r = v - m;
    f32x2 o; o.x = v.x < 0.f ? m.x : r.x; o.y = v.y < 0.f ? m.y : r.y; return o;
}

template <int ACT  > struct EpiBf16 {
    static constexpr bool PERM = true, AFTER_DRAIN = false; static_assert(ACT == 0 || ACT == 1, "EpiBf16: ACT is 0 (none) or 1 (gelu_pk)");
    bf16_t* O; int ldc; const float* bias; int split_cols; size_t split_stride; float scale0;
    __device__ __forceinline__ void operator()(const f32x4 (&acc)[2][2][4][2], const Unit& u, int wr, int wc, int fr, int fq) const {
        const int row0 = u.pm * BM + wr * 64 + fr; int colt = u.pn * BM; bf16_t* base = O;
        float sc = 1.f; if (split_cols) { const int t = colt / split_cols; base += (size_t)t * split_stride; colt -= t * split_cols; if (t == 0) sc = scale0; }
        const int col0 = colt + wc * 32 + 8 * fq, bcol0 = u.pn * BM + wc * 32 + 8 * fq;
        f32x4 bv[2][2];
#pragma unroll
        for (int bj = 0; bj < 2; ++bj)
#pragma unroll
            for (int n = 0; n < 2; ++n) bv[bj][n] = bias ? *(const f32x4*)(bias + bcol0 + bj * HALF + 4 * n) : (f32x4){0.f, 0.f, 0.f, 0.f};
#pragma unroll
        for (int ai = 0; ai < 2; ++ai)
#pragma unroll
            for (int m = 0; m < 4; ++m) { bf16_t* rowp = base + (size_t)(row0 + ai * HALF + m * 16) * ldc + col0;
#pragma unroll
                for (int bj = 0; bj < 2; ++bj) { f32x4 v0 = acc[ai][bj][m][0] + bv[bj][0], v1 = acc[ai][bj][m][1] + bv[bj][1];
                    if (ACT == 1) { f32x2 a = gelu_pk((f32x2){v0[0], v0[1]}), b = gelu_pk((f32x2){v0[2], v0[3]}), c = gelu_pk((f32x2){v1[0], v1[1]}), d = gelu_pk((f32x2){v1[2], v1[3]});
                        v0 = (f32x4){a.x, a.y, b.x, b.y}; v1 = (f32x4){c.x, c.y, d.x, d.y}; }
                    v0 = v0 * sc; v1 = v1 * sc; u32x4 w; w.x = cvt_pk_bf16(v0[0], v0[1]); w.y = cvt_pk_bf16(v0[2], v0[3]); w.z = cvt_pk_bf16(v1[0], v1[1]); w.w = cvt_pk_bf16(v1[2], v1[3]);
                    *(u32x4*)(rowp + bj * HALF) = w; } }
    }
};
template <class Epi, class Sched, bool ALIGN_EPI = false, bool SP2 = false>
__device__ __forceinline__ void gemm_phase(PG8_LAS unsigned char* lds, const Gemm g, const Sched& S, const Epi& E) {
    const int tid = threadIdx.x, wid = __builtin_amdgcn_readfirstlane(tid >> 6), lane = tid & 63, wr = wid >> 2, wc = wid & 3, fr = lane & 15, fq = lane >> 4;
    const int K = g.K, nt = K / BK;
    unsigned voffA[2], voffB[2];
#pragma unroll
    for (int i = 0; i < 2; ++i) { int R, C; stage_rc(tid * 16 + i * 8192, R, C); const int Rb = Epi::PERM ? ((R & ~31) + perm32(R & 31)) : R;
        voffA[i] = (unsigned)(R * K + C) * 2u; voffB[i] = (unsigned)(Rb * K + C) * 2u; }
    const size_t kstep = (size_t)(BK * 2);
    const size_t hstep = (size_t)HALF * K * 2;
    const size_t tstep = 2 * hstep;
    const unsigned ldsw = (unsigned)wid * 1024u;
    const int aoff = lds_byte(wr * 64 + fr, fq * 8), boff = lds_byte(wc * 32 + fr, fq * 8);
#define PG8_SA(b, h) (((b) * 2 + (h)) * HTB)
#define PG8_SB(b, h) ((4 + (b) * 2 + (h)) * HTB)
#define PG8_STAGE(bufoff, gbase, voff) do { _Pragma("unroll") for (int _i = 0; _i < 2; ++_i) \
        __builtin_amdgcn_global_load_lds((const unsigned*)((const char*)(gbase) + (voff)[_i]), (PG8_LAS unsigned*)(lds + (bufoff) + ldsw + _i * 8192), 16, 0, 0); } while (0)
#define PG8_LDA(dst, b, h) do { _Pragma("unroll") for (int m = 0; m < 4; ++m) _Pragma("unroll") for (int k = 0; k < 2; ++k) dst[m][k] = *(const PG8_LAS bf16x8*)(lds + PG8_SA(b, h) + aoff + m * 2048 + k * 1024); } while (0)
#define PG8_LDB(dst, b, h) do { _Pragma("unroll") for (int n = 0; n < 2; ++n) _Pragma("unroll") for (int k = 0; k < 2; ++k) dst[n][k] = *(const PG8_LAS bf16x8*)(lds + PG8_SB(b, h) + boff + n * 2048 + k * 1024); } while (0)
#define PG8_MMA(ai, bj, At, Bt) do { __builtin_amdgcn_s_setprio(1); _Pragma("unroll") for (int m = 0; m < 4; ++m) _Pragma("unroll") for (int n = 0; n < 2; ++n) _Pragma("unroll") for (int k = 0; k < 2; ++k) \
        acc[ai][bj][m][n] = __builtin_amdgcn_mfma_f32_16x16x32_bf16(Bt[n][k], At[m][k], acc[ai][bj][m][n], 0, 0, 0); __builtin_amdgcn_s_setprio(0); } while (0)
#define PG8_WAIT_V(n) asm volatile("s_waitcnt vmcnt(" #n ")" ::: "memory")
#define PG8_WAIT_L(n) asm volatile("s_waitcnt lgkmcnt(" #n ")" ::: "memory")
#define PG8_BAR __builtin_amdgcn_s_barrier()
#define PG8_SCHED __builtin_amdgcn_sched_barrier(0)
    Unit cur, nxt; int ui = 0;
    if (!S.next(0, cur)) return;
    f32x4 acc[2][2][4][2];
#pragma unroll
    for (int a = 0; a < 2; ++a)
#pragma unroll
        for (int b = 0; b < 2; ++b)
#pragma unroll
            for (int m = 0; m < 4; ++m)
#pragma unroll
                for (int n = 0; n < 2; ++n) acc[a][b][m][n] = (f32x4){0.f, 0.f, 0.f, 0.f};
    bf16x8 At[4][2], B0[2][2], B1[2][2];
    const char* cA = (const char*)g.A + (size_t)cur.pm * tstep; const char* cB = (const char*)g.Bt + (size_t)cur.pn * tstep;
    S.a_ready(cur);
    if constexpr (SP2) {
        PG8_STAGE(PG8_SB(0, 0), cB, voffB); PG8_STAGE(PG8_SB(0, 1), cB + hstep, voffB); PG8_STAGE(PG8_SA(0, 0), cA, voffA); PG8_STAGE(PG8_SA(0, 1), cA + hstep, voffA);
        if (wr == 1) PG8_BAR;
        PG8_WAIT_V(2); PG8_BAR;
        PG8_STAGE(PG8_SB(1, 0), cB + kstep, voffB); PG8_STAGE(PG8_SA(1, 0), cA + kstep, voffA); PG8_STAGE(PG8_SB(1, 1), cB + hstep + kstep, voffB);
        PG8_WAIT_V(6); PG8_BAR;
    } else {
        PG8_STAGE(PG8_SB(0, 0), cB, voffB); PG8_STAGE(PG8_SA(0, 0), cA, voffA); PG8_STAGE(PG8_SB(0, 1), cB + hstep, voffB); PG8_STAGE(PG8_SA(0, 1), cA + hstep, voffA);
        if (wr == 1) PG8_BAR;
        PG8_WAIT_V(4); PG8_BAR;
        PG8_STAGE(PG8_SB(1, 0), cB + kstep, voffB); PG8_STAGE(PG8_SA(1, 0), cA + kstep, voffA); PG8_STAGE(PG8_SB(1, 1), cB + hstep + kstep, voffB);
        PG8_WAIT_V(6); PG8_BAR;
    }
    for (;;) {
        const bool has_next = S.next(ui + 1, nxt);
        const char* nA = has_next ? (const char*)g.A + (size_t)nxt.pm * tstep : cA; const char* nB = has_next ? (const char*)g.Bt + (size_t)nxt.pn * tstep : cB;
        for (int t = 0; t < nt; t += 2) {
            const bool last = (t == nt - 2);
            const char* a1 = cA + (size_t)(t + 1) * kstep;
            const char* a2 = last ? nA : cA + (size_t)(t + 2) * kstep; const char* b2 = last ? nB : cB + (size_t)(t + 2) * kstep;
            const char* a3 = a2 + kstep; const char* b3 = b2 + kstep;
            if (last && has_next) S.a_ready(nxt);
            if constexpr (SP2) {
            PG8_LDB(B0, 0, 0); PG8_LDB(B1, 0, 1); PG8_SCHED; PG8_LDA(At, 0, 0); PG8_STAGE(PG8_SA(1, 1), a1 + hstep, voffA);
            PG8_WAIT_V(8); PG8_WAIT_L(0); PG8_BAR; PG8_MMA(0, 0, At, B0); PG8_MMA(0, 1, At, B1); PG8_BAR; PG8_SCHED;
            PG8_LDA(At, 0, 1); PG8_STAGE(PG8_SB(0, 0), b2, voffB); PG8_STAGE(PG8_SB(0, 1), b2 + hstep, voffB); PG8_STAGE(PG8_SA(0, 0), a2, voffA);
            PG8_WAIT_V(8); PG8_WAIT_L(0); PG8_BAR; PG8_MMA(1, 0, At, B0); PG8_MMA(1, 1, At, B1); PG8_BAR; PG8_SCHED;
            PG8_LDB(B0, 1, 0); PG8_LDB(B1, 1, 1); PG8_SCHED; PG8_LDA(At, 1, 0); PG8_STAGE(PG8_SA(0, 1), a2 + hstep, voffA);
            PG8_WAIT_V(8); PG8_WAIT_L(0); PG8_BAR; PG8_MMA(0, 0, At, B0); PG8_MMA(0, 1, At, B1); PG8_BAR; PG8_SCHED;
            PG8_LDA(At, 1, 1); PG8_STAGE(PG8_SB(1, 0), b3, voffB); PG8_STAGE(PG8_SB(1, 1), b3 + hstep, voffB); PG8_STAGE(PG8_SA(1, 0), a3, voffA);
            PG8_WAIT_V(8); PG8_WAIT_L(0); PG8_BAR; PG8_MMA(1, 0, At, B0); PG8_MMA(1, 1, At, B1); PG8_BAR; PG8_SCHED;
            } else {
            PG8_LDB(B0, 0, 0); PG8_SCHED; PG8_LDA(At, 0, 0); PG8_STAGE(PG8_SA(1, 1), a1 + hstep, voffA);
            PG8_WAIT_L(8); PG8_BAR; PG8_WAIT_L(0); PG8_MMA(0, 0, At, B0); PG8_BAR; PG8_SCHED;
            PG8_LDB(B1, 0, 1); PG8_STAGE(PG8_SB(0, 0), b2, voffB);
            PG8_BAR; PG8_WAIT_L(0); PG8_MMA(0, 1, At, B1); PG8_BAR;
            PG8_LDA(At, 0, 1); PG8_STAGE(PG8_SA(0, 0), a2, voffA);
            PG8_BAR; PG8_WAIT_L(0); PG8_MMA(1, 0, At, B0); PG8_BAR; PG8_SCHED;
            PG8_STAGE(PG8_SB(0, 1), b2 + hstep, voffB);
            PG8_WAIT_V(6); PG8_BAR; PG8_MMA(1, 1, At, B1); PG8_BAR;
            PG8_LDB(B0, 1, 0); PG8_SCHED; PG8_LDA(At, 1, 0); PG8_STAGE(PG8_SA(0, 1), a2 + hstep, voffA);
            PG8_WAIT_L(8); PG8_BAR; PG8_WAIT_L(0); PG8_MMA(0, 0, At, B0); PG8_BAR; PG8_SCHED;
            PG8_LDB(B1, 1, 1); PG8_STAGE(PG8_SB(1, 0), b3, voffB);
            PG8_BAR; PG8_WAIT_L(0); PG8_MMA(0, 1, At, B1); PG8_BAR;
            PG8_LDA(At, 1, 1); PG8_STAGE(PG8_SA(1, 0), a3, voffA);
            PG8_BAR; PG8_WAIT_L(0); PG8_MMA(1, 0, At, B0); PG8_BAR; PG8_SCHED;
            PG8_STAGE(PG8_SB(1, 1), b3 + hstep, voffB);
            PG8_WAIT_V(6); PG8_BAR; PG8_MMA(1, 1, At, B1); PG8_BAR;
            }
        }
        if constexpr (ALIGN_EPI) { if (wr == 0) PG8_BAR; }
        if constexpr (!Epi::AFTER_DRAIN) { E(acc, cur, wr, wc, fr, fq); S.done(cur); }
        if (!has_next) break;
#pragma unroll
        for (int a = 0; a < 2; ++a)
#pragma unroll
            for (int b = 0; b < 2; ++b)
#pragma unroll
                for (int m = 0; m < 4; ++m)
#pragma unroll
                    for (int n = 0; n < 2; ++n) acc[a][b][m][n] = (f32x4){0.f, 0.f, 0.f, 0.f};
        cur = nxt; cA = nA; cB = nB; ++ui;
        if constexpr (ALIGN_EPI) { if (wr == 1) PG8_BAR; }
    }
    PG8_WAIT_V(0);
    if constexpr (!ALIGN_EPI) { if (wr == 0) PG8_BAR; }
    PG8_BAR;
    if constexpr (Epi::AFTER_DRAIN) { E.fused(acc, cur, wr, wc, fr, fq, lds, wid, lane); S.done(cur); }
#undef PG8_SA
#undef PG8_SB
#undef PG8_STAGE
#undef PG8_LDA
#undef PG8_LDB
#undef PG8_MMA
#undef PG8_WAIT_V
#undef PG8_WAIT_L
#undef PG8_BAR
#undef PG8_SCHED
}
}
#define XB_TMO      128
#define XB_XCNT(j)  (256  + 64 * (j))
#define XB_XSUB(j)  (1280 + 64 * (j))
#define XB_XGEN(j)  (2304 + 64 * (j))
#define XB_TOP      3328
#define XB_TOPGEN   3392
#define XCD_BAR_WORDS 3456
#define XB_SPIN_CAP (1u << 18)

__device__ __forceinline__ unsigned xb_ld(unsigned* p)              { return __hip_atomic_load(p, __ATOMIC_RELAXED, __HIP_MEMORY_SCOPE_AGENT); }
__device__ __forceinline__ unsigned xb_add(unsigned* p, unsigned v) { return __hip_atomic_fetch_add(p, v, __ATOMIC_RELAXED, __HIP_MEMORY_SCOPE_AGENT); }
__device__ __forceinline__ unsigned xb_xcc_id() { return (unsigned)__builtin_amdgcn_s_getreg((3 << 11) | 20) & 0xFu; }
#define XB_SPIN(cond, bar) do { unsigned _sp = 0; while (cond) { __builtin_amdgcn_s_sleep(1); \
    if ((++_sp & 255u) == 0u) { if (xb_ld(&(bar)[XB_TMO])) break; if (_sp > XB_SPIN_CAP) { atomicAdd(&(bar)[XB_TMO], 1u); break; } } } } while (0)

struct XcdBarrier {
    unsigned* bar; unsigned x;
    volatile LAS unsigned* st;
};

__device__ __forceinline__ XcdBarrier xcd_barrier_post(unsigned* bar, volatile LAS unsigned* st) {
    XcdBarrier b; b.bar = bar; b.x = xb_xcc_id(); b.st = st;
    if (threadIdx.x == 0) st[2] = xb_add(&bar[XB_XCNT(b.x)], 1u) + 1u;
    return b;
}
__device__ __forceinline__ void xcd_barrier_complete(unsigned* bar, unsigned x, unsigned& nloc, unsigned& nx) {
    const unsigned G = gridDim.x * gridDim.y * gridDim.z;
    unsigned sum, cnt, mine, sp = 0u;
    for (;;) {
        sum = 0u; cnt = 0u; mine = 0u;
#pragma unroll
        for (unsigned j = 0; j < 16; ++j) { const unsigned c = xb_ld(&bar[XB_XCNT(j)]); sum += c; cnt += (c > 0u) ? 1u : 0u; mine = (j == x) ? c : mine; }
        if (sum == G) break;
        __builtin_amdgcn_s_sleep(1);
        if ((++sp & 255u) == 0u) { if (xb_ld(&bar[XB_TMO])) break; if (sp > XB_SPIN_CAP) { atomicAdd(&bar[XB_TMO], 1u); break; } }
    }
    nloc = mine > 0u ? mine : 1u; nx = cnt > 0u ? cnt : 1u;
}

__device__ __forceinline__ void xcd_barrier(const XcdBarrier& b) {
    asm volatile("s_waitcnt vmcnt(0)" ::: "memory");
    __syncthreads();
    if (threadIdx.x == 0) {
        unsigned* bar = b.bar;
        __builtin_amdgcn_s_waitcnt(0);
        unsigned nloc = b.st[0], nx = b.st[1];
        if (nloc == 0u) { xcd_barrier_complete(bar, b.x, nloc, nx); b.st[0] = nloc; b.st[1] = nx; }
        const unsigned old = xb_add(&bar[XB_XSUB(b.x)], 1u);
        const unsigned gen = old / nloc;
        if (old + 1u == (gen + 1u) * nloc) {
            __builtin_amdgcn_fence(__ATOMIC_RELEASE, "agent");
            asm volatile("s_waitcnt vmcnt(0)" ::: "memory");
            const unsigned og = xb_add(&bar[XB_TOP], 1u);
            const unsigned tg = og / nx;
            if (og + 1u == (tg + 1u) * nx) xb_add(&bar[XB_TOPGEN], 1u);
            else XB_SPIN(xb_ld(&bar[XB_TOPGEN]) == tg, bar);
            __builtin_amdgcn_fence(__ATOMIC_ACQUIRE, "agent");
            xb_add(&bar[XB_XGEN(b.x)], 1u);
            asm volatile("s_waitcnt vmcnt(0)" ::: "memory");
        } else {
            XB_SPIN(xb_ld(&bar[XB_XGEN(b.x)]) == gen, bar);
            __builtin_amdgcn_fence(__ATOMIC_ACQUIRE, "agent");
            asm volatile("s_waitcnt vmcnt(0)" ::: "memory");
        }
    }
    __syncthreads();
}
constexpr int NWAVES = 8, NTHR = 512;
constexpr int RING_BYTES = 131072, LDSCTL_OFF = RING_BYTES, MISC_OFF = LDSCTL_OFF + 320, LDS_BYTES = 163840;
constexpr int CW_BAR = 4096;
#ifndef MK_N_LAUNCHES
#define MK_N_LAUNCHES 1
#endif
constexpr int NPHASE = 13;

typedef float f4v __attribute__((ext_vector_type(4)));
typedef unsigned u2v __attribute__((ext_vector_type(2)));
typedef unsigned u32x4_t __attribute__((ext_vector_type(4)));
struct Frame { LAS unsigned char* lds; int tid, lane, wave, G, bid; };
template <int CTRL, int ROWMASK> __device__ __forceinline__ float dppf(float old, float src) {
    return __builtin_bit_cast(float, __builtin_amdgcn_update_dpp(__builtin_bit_cast(int, old), __builtin_bit_cast(int, src), CTRL, ROWMASK, 0xf, false)); }
__device__ __forceinline__ float wave_scan_add(float v) {
    v += dppf<0x111, 0xf>(0.f, v); v += dppf<0x112, 0xf>(0.f, v); v += dppf<0x114, 0xf>(0.f, v); v += dppf<0x118, 0xf>(0.f, v);
    v += dppf<0x142, 0xa>(0.f, v); v += dppf<0x143, 0xc>(0.f, v); return v; }
__device__ __forceinline__ float wave_scan_max(float v) {
    const float NI = -INFINITY;
    v = fmaxf(v, dppf<0x111, 0xf>(NI, v)); v = fmaxf(v, dppf<0x112, 0xf>(NI, v)); v = fmaxf(v, dppf<0x114, 0xf>(NI, v)); v = fmaxf(v, dppf<0x118, 0xf>(NI, v));
    v = fmaxf(v, dppf<0x142, 0xa>(NI, v)); v = fmaxf(v, dppf<0x143, 0xc>(NI, v)); return v; }
__device__ __forceinline__ float lane_bcast(float v, int l) { return __builtin_bit_cast(float, __builtin_amdgcn_readlane(__builtin_bit_cast(int, v), l)); }
__device__ __forceinline__ float wave_sum(float v) { return lane_bcast(wave_scan_add(v), 63); }
__device__ __forceinline__ unsigned pk2(float lo, float hi) { return (unsigned)f2bf(lo) | ((unsigned)f2bf(hi) << 16); }
__device__ __forceinline__ float bflo(unsigned w) { return u_as_f(w << 16); }
__device__ __forceinline__ float bfhi(unsigned w) { return u_as_f(w & 0xffff0000u); }

__device__ __forceinline__ void p0_ada_item(const Prm& p, const Frame& F, int item) {
    static_assert(D6 % 2048 == 0 && D % NKS == 0 && D / NKS == 64, "ada item shape");
    LAS float* sl = (LAS float*)F.lds;
    const int ks = item / (D6 / 2048), cg = item % (D6 / 2048), k0 = ks * 64, n0 = cg * 2048 + 4 * F.tid;
    { const int b = F.tid / 64, k = F.tid % 64; const float cv = p.c[b * D + k0 + k]; sl[F.tid] = cv / (1.f + __expf(-cv)); }
    __syncthreads();
    f4v acc[NB];
#pragma unroll
    for (int b = 0; b < NB; ++b) acc[b] = (f4v){0.f, 0.f, 0.f, 0.f};
    const float* wp = p.w_ada + (size_t)k0 * D6 + n0;
#pragma unroll 8
    for (int k = 0; k < 64; ++k) { const f4v w = *(const f4v*)(wp + (size_t)k * D6);
#pragma unroll
        for (int b = 0; b < NB; ++b) acc[b] += w * sl[b * 64 + k]; }
#pragma unroll
    for (int b = 0; b < NB; ++b) *(f4v*)(p.MODP() + ((size_t)ks * NB + b) * D6 + n0) = acc[b];
    __syncthreads();
}
__device__ __forceinline__ void p0_transpose_item(const float* W, int ldw, int K, int N, bf16_t* WT, LAS float* scr, int item, int lane) {
    const int nblk = N / 32, kb = item / nblk, nb = item % nblk, k0 = 64 * kb, n0 = 32 * nb;
#pragma unroll
    for (int i = 0; i < 32; ++i) { const int kk = 2 * i + (lane >> 5); scr[kk * 33 + (lane & 31)] = W[(size_t)(k0 + kk) * ldw + n0 + (lane & 31)]; }
    asm volatile("s_waitcnt lgkmcnt(0)" ::: "memory");
    const int c = lane & 7;
#pragma unroll
    for (int j = 0; j < 4; ++j) { const int n = (lane >> 3) + 8 * j; const LAS float* s = scr + (8 * c) * 33 + n;
        uint4 o; o.x = pk2(s[0 * 33], s[1 * 33]); o.y = pk2(s[2 * 33], s[3 * 33]); o.z = pk2(s[4 * 33], s[5 * 33]); o.w = pk2(s[6 * 33], s[7 * 33]);
        *(uint4*)(WT + (size_t)(n0 + n) * K + k0 + 8 * c) = o; }
    asm volatile("s_waitcnt lgkmcnt(0)" ::: "memory");
}

__device__ __forceinline__ void p0_fold_item(const Prm& p, int item, int lane) {
    static_assert(NK == 128 && KH == 128 && NQ == 2048, "fold item decomposition");
    const int ks = item & 31, nt = (item >> 5) & 7, g = item >> 8;
    const int r = lane & 15, q = lane >> 4;
    const float* arow = p.subkeys + ((size_t)g * NK + nt * 16 + r) * KH + 4 * q;
    const float* brow = p.wq + (size_t)(ks * 64 + r) * NQ + g * KH + 4 * q;
    pg8::f32x4 acc[4];
#pragma unroll
    for (int c = 0; c < 4; ++c) acc[c] = (pg8::f32x4){0.f, 0.f, 0.f, 0.f};
#pragma unroll 2
    for (int s16 = 0; s16 < KH; s16 += 16) {
        const pg8::f32x4 a = *(const pg8::f32x4*)(arow + s16); pg8::f32x4 bv[4];
#pragma unroll
        for (int c = 0; c < 4; ++c) bv[c] = *(const pg8::f32x4*)(brow + (size_t)(c * 16) * NQ + s16);
#pragma unroll
        for (int i = 0; i < 4; ++i)
#pragma unroll
            for (int c = 0; c < 4; ++c) acc[c] = __builtin_amdgcn_mfma_f32_16x16x4f32(a[i], bv[c][i], acc[c], 0, 0, 0);
    }
#pragma unroll
    for (int c = 0; c < 4; ++c)
#pragma unroll
        for (int i = 0; i < 4; ++i) p.WQ_T()[(size_t)(g * NK + nt * 16 + 4 * q + i) * D + ks * 64 + c * 16 + r] = f2bf(acc[c][i]);
}
__device__ __forceinline__ void phase0(const Prm& p, const Frame& F) {
#ifndef P0_REP_ADA
#define P0_REP_ADA 1
#define P0_REP_TR 1
#define P0_REP_FOLD 1
#define P0_REP_FP8 1
#endif
    for (int rep_ = 0; rep_ < P0_REP_ADA; ++rep_)
    for (int it = F.bid; it < NKS * (D6 / 2048); it += F.G) p0_ada_item(p, F, it);
    LAS float* scr = (LAS float*)(F.lds + F.wave * 16384);
    const int gw = F.bid * NWAVES + F.wave, NGW = F.G * NWAVES;
    constexpr int I_IN = (D / 64) * (INM / 32), I_O = (D / 64) * (D / 32), I_Q = 32 * 8 * 16;
    for (int rep_ = 0; rep_ < (P0_REP_TR > P0_REP_FOLD ? P0_REP_TR : P0_REP_FOLD); ++rep_)
    for (int it = gw; it < I_IN + I_O + I_Q; it += NGW) {
        int r = it; if (rep_ >= P0_REP_TR && r < I_IN + I_O) continue; if (rep_ >= P0_REP_FOLD && r >= I_IN + I_O) continue;
        if (r < I_IN) { p0_transpose_item(p.w_in, INC, D, INM, p.WIN_T(), scr, r, F.lane); continue; } r -= I_IN;
        if (r < I_O) { p0_transpose_item(p.w_out, D, D, D, p.WOUT_T(), scr, r, F.lane); continue; } r -= I_O;
        p0_fold_item(p, r, F.lane);
    }
    for (int rep_ = 0; rep_ < P0_REP_FP8; ++rep_)
    {
        float4 v[8], vn[8]; int rr = gw;
#define P0_ROWSRC(rr_) ((const float4*)(p.peer_u + (size_t)(rr_) * D) + F.lane)
        if (rr < NE) { const float4* src = P0_ROWSRC(rr);
#pragma unroll
            for (int j = 0; j < 8; ++j) v[j] = src[64 * j]; }
        for (; rr < NE; rr += NGW) {
            const int rn = rr + NGW;
            if (rn < NE) { const float4* src = P0_ROWSRC(rn);
#pragma unroll
                for (int j = 0; j < 8; ++j) vn[j] = src[64 * j]; }
            const int e = rr; float am = 0.f;
#pragma unroll
            for (int j = 0; j < 8; ++j) am = fmaxf(am, fmaxf(fmaxf(fabsf(v[j].x), fabsf(v[j].y)), fmaxf(fabsf(v[j].z), fabsf(v[j].w))));
#pragma unroll
            for (int o = 1; o < 64; o <<= 1) am = fmaxf(am, __shfl_xor(am, o));
            const float sc = am > 0.f ? 384.f / am : 1.f;
            unsigned* dst = (unsigned*)(p.PU8() + (size_t)e * D) + F.lane;
#pragma unroll
            for (int j = 0; j < 8; ++j) { unsigned w = 0u; w = __builtin_amdgcn_cvt_pk_fp8_f32(v[j].x * sc, v[j].y * sc, w, false); w = __builtin_amdgcn_cvt_pk_fp8_f32(v[j].z * sc, v[j].w * sc, w, true); dst[64 * j] = w; }
            if (F.lane == 0) p.RSU()[e] = am > 0.f ? am / 384.f : 1.f;
#pragma unroll
            for (int j = 0; j < 8; ++j) v[j] = vn[j];
        }
#undef P0_ROWSRC
    }
    { typedef _Float16 h4v __attribute__((ext_vector_type(4)));
      LAS u2v* tl = (LAS u2v*)F.lds;
      for (int tile = F.bid; tile < (NE / 64) * (D / 512); tile += F.G) { const int eb = tile / (D / 512), cb = tile % (D / 512);
        __syncthreads();
#pragma unroll 4
        for (int k = 0; k < 16; ++k) { const int idx = F.tid + NTHR * k, row = idx >> 7, c4 = idx & 127;
            const f4v x = *(const f4v*)(p.peer_v + (size_t)(eb * 64 + row) * D + cb * 512 + 4 * c4);
            const h4v hx = {(_Float16)x[0], (_Float16)x[1], (_Float16)x[2], (_Float16)x[3]}; tl[row * 129 + c4] = __builtin_bit_cast(u2v, hx); }
        __syncthreads();
#pragma unroll 4
        for (int k = 0; k < 16; ++k) { const int j = F.tid + NTHR * k, sl = j >> 6, row = j & 63;
            *(u2v*)(p.PVH() + ((size_t)(cb * 128 + sl) * NE + eb * 64 + row) * 4) = tl[row * 129 + sl]; }
      } }
}
__device__ __forceinline__ void phase1(const Prm& p, const Frame& F) {
    LAS float* SH = (LAS float*)F.lds; LAS float* SC1 = SH + D;
    LAS bf16_t* WG = (LAS bf16_t*)(F.lds + 2 * D * 4);
    const int rows_per = T / F.G;
    for (int idx = F.bid * NTHR + F.tid; idx < NB * D6; idx += F.G * NTHR) {
        const int n = idx % D6, b = idx / D6; float s = 0.f;
        for (int ks = 0; ks < NKS; ++ks) s += p.MODP()[((size_t)ks * NB + b) * D6 + n];
        p.MOD()[idx] = s + p.b_ada[n]; }
    for (int idx = F.tid; idx < NG * D; idx += NTHR) { const int d = idx / NG, g = idx % NG; WG[g * D + d] = f2bf(p.w_in[(size_t)d * INC + INM + g]); }
    int cur_b = -1;
    float4 xpre[8];
    { const float4* x0 = (const float4*)(p.x + (size_t)(F.bid * rows_per + F.wave) * D) + F.lane;
#pragma unroll
      for (int j = 0; j < 8; ++j) xpre[j] = x0[64 * j]; }
    for (int r0 = F.bid * rows_per; r0 < (F.bid + 1) * rows_per; r0 += NWAVES) {
        const int b = r0 / S;
        if (b != cur_b) { __syncthreads();
            for (int n = F.tid; n < 2 * D; n += NTHR) { float s = 0.f; for (int ks = 0; ks < NKS; ++ks) s += p.MODP()[((size_t)ks * NB + b) * D6 + n];
                s += p.b_ada[n]; SH[n] = n < D ? s : 1.f + s; }
            cur_b = b; __syncthreads(); }
        const int row = r0 + F.wave;
        float4 v[8]; float s = 0.f;
#pragma unroll
        for (int j = 0; j < 8; ++j) v[j] = xpre[j];
        if (r0 + NWAVES < (F.bid + 1) * rows_per) { const float4* xn = (const float4*)(p.x + (size_t)(row + NWAVES) * D) + F.lane;
#pragma unroll
            for (int j = 0; j < 8; ++j) xpre[j] = xn[64 * j]; }
#pragma unroll
        for (int j = 0; j < 8; ++j) s += (v[j].x + v[j].y) + (v[j].z + v[j].w);
        const float mean = wave_sum(s) * (1.f / D); float s2 = 0.f;
#pragma unroll
        for (int j = 0; j < 8; ++j) { v[j].x -= mean; v[j].y -= mean; v[j].z -= mean; v[j].w -= mean; s2 += (v[j].x * v[j].x + v[j].y * v[j].y) + (v[j].z * v[j].z + v[j].w * v[j].w); }
        const float rstd = 1.f / sqrtf(wave_sum(s2) * (1.f / D) + LN_EPS);
        uint2* o8 = (uint2*)(p.U() + (size_t)row * D) + F.lane;
#pragma unroll
        for (int j = 0; j < 8; ++j) { const int c0 = 4 * F.lane + 256 * j; const f4v sh = *(const LAS f4v*)(SH + c0), sc = *(const LAS f4v*)(SC1 + c0);
            v[j].x = v[j].x * rstd * sc.x + sh.x; v[j].y = v[j].y * rstd * sc.y + sh.y; v[j].z = v[j].z * rstd * sc.z + sh.z; v[j].w = v[j].w * rstd * sc.w + sh.w;
            o8[64 * j] = make_uint2(pk2(v[j].x, v[j].y), pk2(v[j].z, v[j].w)); }
        float ga[NG];
#pragma unroll
        for (int g = 0; g < NG; ++g) { float a = 0.f;
#pragma unroll
            for (int j = 0; j < 8; ++j) { const u2v w = *(const LAS u2v*)(WG + g * D + 4 * F.lane + 256 * j); a += v[j].x * bflo(w.x) + v[j].y * bfhi(w.x) + v[j].z * bflo(w.y) + v[j].w * bfhi(w.y); }
            ga[g] = a; }
        float r8[8], r4[4], r2[2]; const bool l0 = F.lane & 1, l1 = F.lane & 2, l2 = F.lane & 4, l3 = F.lane & 8;
#pragma unroll
        for (int i = 0; i < 8; ++i) { const float keep = l0 ? ga[8 + i] : ga[i], send = l0 ? ga[i] : ga[8 + i]; r8[i] = keep + __shfl_xor(send, 1); }
#pragma unroll
        for (int i = 0; i < 4; ++i) { const float keep = l1 ? r8[4 + i] : r8[i], send = l1 ? r8[i] : r8[4 + i]; r4[i] = keep + __shfl_xor(send, 2); }
#pragma unroll
        for (int i = 0; i < 2; ++i) { const float keep = l2 ? r4[2 + i] : r4[i], send = l2 ? r4[i] : r4[2 + i]; r2[i] = keep + __shfl_xor(send, 4); }
        float gacc = (l3 ? r2[1] : r2[0]) + __shfl_xor(l3 ? r2[0] : r2[1], 8);
        gacc += __shfl_xor(gacc, 16); gacc += __shfl_xor(gacc, 32);
        const int gi = (l0 ? 8 : 0) + (l1 ? 4 : 0) + (l2 ? 2 : 0) + (l3 ? 1 : 0);
        if (F.lane < NG) p.GATES()[(size_t)row * NG + gi] = gacc + p.b_in[INM + gi];
    }
}
__device__ __forceinline__ void phase3a(const Prm& p, const Frame& F, int b0, int nb) {
    const size_t gt = (size_t)(F.bid - b0) * NTHR + F.tid, GT = (size_t)nb * NTHR;
    for (size_t i = gt; i < (size_t)T * (CW / 8); i += GT) {
        const size_t row = i / (CW / 8); const int ch = (int)(i % (CW / 8)) * 8, s = (int)(row % S);
        float acc[8];
#pragma unroll
        for (int e = 0; e < 8; ++e) acc[e] = p.conv_b[ch + e];
#pragma unroll
        for (int k = 0; k < 3; ++k) { const int s2 = s + k - 1; if (s2 < 0 || s2 >= S) continue; const bf16_t* pr = p.PJ() + (size_t)(row + k - 1) * INM;
            const uint4 gc = *(const uint4*)(pr + O_GC + ch), hi = *(const uint4*)(pr + O_HIN + ch); const float* cw = p.conv_w + k * CW + ch;
            acc[0] += cw[0] * (bflo(gc.x) * bflo(hi.x)); acc[1] += cw[1] * (bfhi(gc.x) * bfhi(hi.x)); acc[2] += cw[2] * (bflo(gc.y) * bflo(hi.y)); acc[3] += cw[3] * (bfhi(gc.y) * bfhi(hi.y));
            acc[4] += cw[4] * (bflo(gc.z) * bflo(hi.z)); acc[5] += cw[5] * (bfhi(gc.z) * bfhi(hi.z)); acc[6] += cw[6] * (bflo(gc.w) * bflo(hi.w)); acc[7] += cw[7] * (bfhi(gc.w) * bfhi(hi.w)); }
        const uint4 gb = *(const uint4*)(p.PJ() + row * INM + O_GB + ch); uint4 o;
        o.x = pk2(bflo(gb.x) * acc[0], bfhi(gb.x) * acc[1]); o.y = pk2(bflo(gb.y) * acc[2], bfhi(gb.y) * acc[3]); o.z = pk2(bflo(gb.z) * acc[4], bfhi(gb.z) * acc[5]); o.w = pk2(bflo(gb.w) * acc[6], bfhi(gb.w) * acc[7]);
        *(uint4*)(p.Y() + row * D + ch) = o; }
}
namespace ml {
typedef short bf16x8 __attribute__((ext_vector_type(8)));
typedef short s16x4 __attribute__((ext_vector_type(4)));
typedef float f32x4 __attribute__((ext_vector_type(4)));
typedef float f32x2_t __attribute__((ext_vector_type(2)));
typedef __bf16 bf16x2_t __attribute__((ext_vector_type(2)));
typedef unsigned u32x4 __attribute__((ext_vector_type(4)));
typedef unsigned u32x2 __attribute__((ext_vector_type(2)));
constexpr unsigned IMG = 16384u, BUF = 3u * IMG, PT_OFF = 2u * BUF, PT_BYTES = 8192u, N_OFF = PT_OFF + 2u * PT_BYTES;
constexpr unsigned SCT_OFF = 149504u, SCT_BYTES = 1024u;
constexpr unsigned HT_OFF = 133120u;
static_assert(N_OFF + 1024u <= 131072u && HT_OFF + 16384u <= SCT_OFF && SCT_OFF + 3u * SCT_BYTES <= 163840u, "mLSTM LDS map");
__device__ __forceinline__ unsigned cvtpk(float lo, float hi) { f32x2_t v = {lo, hi}; bf16x2_t b = __builtin_convertvector(v, bf16x2_t); return __builtin_bit_cast(unsigned, b); }
__device__ __forceinline__ unsigned off_a(unsigned row, unsigned ch) { return 2048u * (row >> 3) + 512u * (ch >> 2) + 64u * (row & 7u) + 16u * ((ch & 3u) ^ ((row >> 2) & 3u)); }
__device__ __forceinline__ unsigned off_p(unsigned row, unsigned ch) { return 128u * row + 16u * (ch ^ (row & 7u)); }
typedef short v4i16_t __attribute__((ext_vector_type(4)));
__device__ __forceinline__ s16x4 trr(LAS unsigned char* p) { return __builtin_bit_cast(s16x4, __builtin_amdgcn_ds_read_tr16_b64_v4i16((LAS v4i16_t*)p)); }
__device__ __forceinline__ bf16x8 cat8(s16x4 a, s16x4 b) { return (bf16x8){a[0], a[1], a[2], a[3], b[0], b[1], b[2], b[3]}; }
struct CS { float decay, m_next; };
__device__ __forceinline__ CS chunk_scalars(float ig, float fg, float m, LAS float* tab, bool writer, unsigned lane) {
    const float lf = logsigmoidf_(fg);
    const float bc = wave_scan_add(lf), gg = ig - bc, cm = wave_scan_max(gg);
    const float G = fmaxf(m, cm), G63 = lane_bcast(G, 63), b63 = lane_bcast(bc, 63), qs = 0.08838834764831845f;
    if (writer) { tab[lane] = __expf(fminf(G63 - G, 80.f)) * qs; tab[64 + lane] = __expf(m - G) * qs; tab[128 + lane] = __expf(-(bc + G)); tab[192 + lane] = __expf(gg - G63); }
    CS r; r.decay = __expf(m - G63); r.m_next = b63 + G63;
    return r;
}
__device__ __forceinline__ void unit(const Prm& p, const Frame& F, int u) {
    static_assert(QK == 128 && MV == 256 && CHUNK == 64 && S % 64 == 0, "mLSTM unit is specialised");
    const int vhalf = u & 1, h = (u >> 1) & 3, b = (u >> 3) & 7, dir = u >> 6;
    const unsigned lane = F.lane, tid = F.tid; const int wave = F.wave; const unsigned q = lane >> 4, r = lane & 15u;
    LAS unsigned char* L = F.lds;
    const unsigned rx = (r >> 2) & 3u, rlo = 2048u * (r >> 3) + 64u * (r & 7u);
    const unsigned RA = rlo + 16u * (q ^ rx), PB1 = rlo + 16u * ((q >> 1) ^ rx) + 8u * (q & 1u), PB2 = rlo + 16u * ((2u + (q >> 1)) ^ rx) + 8u * (q & 1u);
    const unsigned pp = lane & 3u, tlo = 2048u * q + 64u * rx + 8u * (pp & 1u);
    const unsigned tb00 = tlo + 16u * ((pp >> 1) ^ ((2u * q) & 3u)), tb01 = tlo + 256u + 16u * ((pp >> 1) ^ ((2u * q + 1u) & 3u));
    const unsigned tb10 = tlo + 16u * ((2u + (pp >> 1)) ^ ((2u * q) & 3u)), tb11 = tlo + 256u + 16u * ((2u + (pp >> 1)) ^ ((2u * q + 1u) & 3u));
    const unsigned PP0 = 128u * r + 16u * (q ^ (r & 7u)), PP1 = 128u * r + 16u * ((4u + q) ^ (r & 7u));
#define ML_TRA(c, ks, t) ((((c) & 1) ? ((t) ? tb11 : tb10) : ((t) ? tb01 : tb00)) + 8192u * (ks) + 512u * ((unsigned)(c) >> 1))
    __syncthreads();
    for (unsigned i = tid; i < (2u * PT_BYTES + 1024u) / 16u; i += NTHR) *(LAS u32x4*)(L + PT_OFF + 16u * i) = (u32x4){0u, 0u, 0u, 0u};
    f32x4 C[8];
#pragma unroll
    for (int i = 0; i < 8; ++i) C[i] = (f32x4){0.f, 0.f, 0.f, 0.f};
    float m = 0.f;
    const bf16_t* pj = p.PJ(); bf16_t* H = dir ? p.HB16() : p.HF16();
    const int colq = O_Q + h * QK, colk = O_K + h * QK, colv = O_V + h * MV + vhalf * 128;
    const unsigned srow0 = tid >> 4, sch = tid & 15u;
    u32x4 rq[2], rk[2], rv[2];
    const float* gbase = p.GATES() + dir * 8 + h;
#define ML_GATES(c, ig_, fg_) do { const float* g_ = gbase + (size_t)ml_tok(dir, b, (c) * 64 + (int)lane) * NG; ig_ = g_[0]; fg_ = g_[4]; } while (0)
    float ig0, fg0, ign = 0.f, fgn = 0.f; ML_GATES(0, ig0, fg0); if (S / 64 > 1) ML_GATES(1, ign, fgn);
#define ML_TAB(c) ((LAS float*)(L + SCT_OFF + (unsigned)((c) % 3) * SCT_BYTES))
    CS cs = chunk_scalars(ig0, fg0, m, ML_TAB(0), wave == 0, lane), csn = cs;
    const long sMW = dir ? -(long)MW : (long)MW;
#define ML_LOAD(c) do { _Pragma("unroll") for (int i_ = 0; i_ < 2; ++i_) { const bf16_t* rp = pj + (size_t)ml_tok(dir, b, (c) * 64 + srow0 + 32 * i_) * INM + 8 * sch; \
        rq[i_] = *(const u32x4*)(rp + colq); rk[i_] = *(const u32x4*)(rp + colk); rv[i_] = *(const u32x4*)(rp + colv); } } while (0)
#define ML_STORE(buf, S_) do { _Pragma("unroll") for (int i_ = 0; i_ < 2; ++i_) { const unsigned row = srow0 + 32u * i_, o = (buf) * BUF + off_a(row, sch); const float w = (S_)[192 + row]; \
        *(LAS u32x4*)(L + o) = rq[i_]; *(LAS u32x4*)(L + IMG + o) = rk[i_]; u32x4 v = rv[i_]; \
        v.x = cvtpk(bflo(v.x) * w, bfhi(v.x) * w); v.y = cvtpk(bflo(v.y) * w, bfhi(v.y) * w); v.z = cvtpk(bflo(v.z) * w, bfhi(v.z) * w); v.w = cvtpk(bflo(v.w) * w, bfhi(v.w) * w); \
        *(LAS u32x4*)(L + 2u * IMG + o) = v; } } while (0)
    __syncthreads();
    ML_LOAD(0); ML_STORE(0u, ML_TAB(0)); if (S / 64 > 1) ML_LOAD(1);
    constexpr int NC = S / 64;
    for (int c = 0; c < NC; ++c) {
        const unsigned cur = (unsigned)(c & 1);
        LAS unsigned char* Qi = L + cur * BUF; LAS unsigned char* Ki = Qi + IMG; LAS unsigned char* Vi = Qi + 2u * IMG; LAS unsigned char* Pt = L + PT_OFF + cur * PT_BYTES;
        float ig2 = 0.f, fg2 = 0.f;
        if (c + 1 < NC) { csn = chunk_scalars(ign, fgn, cs.m_next, ML_TAB(c + 1), wave == 0, lane); if (c + 2 < NC) ML_GATES(c + 2, ig2, fg2); }
        __syncthreads();
#define ML_FLUSH(cprev) do { _Pragma("unroll") for (int i_ = 0; i_ < 2; ++i_) { const unsigned n_ = tid + 512u * i_, row_ = n_ >> 4, ch_ = n_ & 15u;     \
            const u32x4 v_ = *(const LAS u32x4*)(L + HT_OFF + 256u * row_ + 16u * (ch_ ^ (row_ & 15u))); \
            *(u32x4*)(H + (size_t)ml_tok(dir, b, (cprev) * 64 + (int)row_) * MW + h * MV + vhalf * 128 + 8 * (int)ch_) = v_; } } while (0)
        const LAS float* sct = ML_TAB(c);
        if (c > 0) ML_FLUSH(c - 1);
#ifndef ML_REP_3B
#define ML_REP_3B 1
#define ML_REP_S 1
#define ML_REP_ST 1
#define ML_REP_3A 1
#define ML_REP_DEN 1
#endif
        f32x4 acc2[4];
#pragma unroll
        for (int tt = 0; tt < 4; ++tt) acc2[tt] = (f32x4){0.f, 0.f, 0.f, 0.f};
#pragma unroll
        for (int ks = 0; ks < 4; ++ks) {
            bf16x8 qa[4];
#pragma unroll
            for (int tt = 0; tt < 4; ++tt) {
                const u32x2 lo = *(const LAS u32x2*)(Qi + PB1 + 4096u * tt + 512u * ks), hi = *(const LAS u32x2*)(Qi + PB2 + 4096u * tt + 512u * ks);
                const u32x4 aw = {lo.x, lo.y, hi.x, hi.y}; qa[tt] = __builtin_bit_cast(bf16x8, aw); }
            const f32x4 c0 = C[2 * ks], c1 = C[2 * ks + 1];
            const u32x4 bw = {cvtpk(c0[0], c0[1]), cvtpk(c0[2], c0[3]), cvtpk(c1[0], c1[1]), cvtpk(c1[2], c1[3])}; const bf16x8 bfr = __builtin_bit_cast(bf16x8, bw);
#pragma unroll
            for (int tt = 0; tt < 4; ++tt) acc2[tt] = __builtin_amdgcn_mfma_f32_16x16x32_bf16(qa[tt], bfr, acc2[tt], 0, 0, 0);
        }
        bf16x8 vB[2];
#pragma unroll
        for (int ks = 0; ks < 2; ++ks) vB[ks] = cat8(trr(Vi + ML_TRA(wave, ks, 0)), trr(Vi + ML_TRA(wave, ks, 1)));
#pragma unroll
        for (int dt = 0; dt < 8; ++dt) C[dt] = C[dt] * cs.decay;
#pragma unroll
        for (int ks = 0; ks < 2; ++ks)
#pragma unroll
            for (int dh = 0; dh < 2; ++dh) { bf16x8 kA[4];
#pragma unroll
                for (int d4 = 0; d4 < 4; ++d4) kA[d4] = cat8(trr(Ki + ML_TRA(4 * dh + d4, ks, 0)), trr(Ki + ML_TRA(4 * dh + d4, ks, 1)));
#pragma unroll
                for (int d4 = 0; d4 < 4; ++d4) C[4 * dh + d4] = __builtin_amdgcn_mfma_f32_16x16x32_bf16(kA[d4], vB[ks], C[4 * dh + d4], 0, 0, 0); }
#pragma unroll
        for (int rep = 0; rep < 2; ++rep) { const int idx = wave + (rep ? 2 : 0);
            if (rep == 0 || wave >= 6) { const int tt = idx >= 6 ? 3 : (idx >= 3 ? 2 : (idx >= 1 ? 1 : 0)), st = idx - tt * (tt + 1) / 2;
                f32x4 sa = (f32x4){0.f, 0.f, 0.f, 0.f};
#pragma unroll
                for (int kh = 0; kh < 2; ++kh) { bf16x8 af[2], bfk[2];
#pragma unroll
                    for (int k2 = 0; k2 < 2; ++k2) { af[k2] = *(const LAS bf16x8*)(Qi + RA + 4096u * tt + 512u * (2 * kh + k2)); bfk[k2] = *(const LAS bf16x8*)(Ki + RA + 4096u * st + 512u * (2 * kh + k2)); }
#pragma unroll
                    for (int k2 = 0; k2 < 2; ++k2) sa = __builtin_amdgcn_mfma_f32_16x16x32_bf16(af[k2], bfk[k2], sa, 0, 0, 0); }
                const unsigned scol = 16u * st + r;
#pragma unroll
                for (int i = 0; i < 4; ++i) { const unsigned trow = 16u * tt + 4u * q + i; const float v = scol <= trow ? sa[i] : 0.f;
                    *(LAS bf16_t*)(Pt + off_p(trow, scol >> 3) + 2u * (scol & 7u)) = (bf16_t)cvtpk(v, 0.f); } } }
        if (c + 1 < NC) { ML_STORE(cur ^ 1u, ML_TAB(c + 1)); if (c + 2 < NC) ML_LOAD(c + 2); }
        __syncthreads();
        { bf16x8 pf[6];
#pragma unroll
          for (int tt = 0; tt < 4; ++tt) { pf[tt] = *(const LAS bf16x8*)(Pt + PP0 + 2048u * tt); if (tt >= 2) pf[2 + tt] = *(const LAS bf16x8*)(Pt + PP1 + 2048u * tt); }
#pragma unroll
          for (int tt = 0; tt < 4; ++tt) { const f32x4 av4 = *(const LAS f32x4*)(sct + 16 * tt + 4 * q), bv4 = *(const LAS f32x4*)(sct + 64 + 16 * tt + 4 * q); f32x4 a1 = __builtin_amdgcn_mfma_f32_16x16x32_bf16(pf[tt], vB[0], (f32x4){0.f, 0.f, 0.f, 0.f}, 0, 0, 0);
            if (tt >= 2) a1 = __builtin_amdgcn_mfma_f32_16x16x32_bf16(pf[2 + tt], vB[1], a1, 0, 0, 0);
#pragma unroll
            for (int i = 0; i < 4; ++i) { const unsigned t = 16u * tt + 4u * q + i, col = 16u * (unsigned)wave + r;
                *(LAS bf16_t*)(L + HT_OFF + 256u * t + 16u * ((col >> 3) ^ (t & 15u)) + 2u * (col & 7u)) = (bf16_t)cvtpk(av4[i] * a1[i] + bv4[i] * acc2[tt][i], 0.f); } } }
        if (vhalf == 0) {
            const LAS float* n_old = (const LAS float*)(L + N_OFF + cur * 512u); LAS float* n_new = (LAS float*)(L + N_OFF + (cur ^ 1u) * 512u);
            bf16x8 wB[2];
#pragma unroll
            for (int ks = 0; ks < 2; ++ks) { const f32x4 w0 = *(const LAS f32x4*)(sct + 192 + 32 * ks + 8 * q), w1 = *(const LAS f32x4*)(sct + 192 + 32 * ks + 8 * q + 4);
                u32x4 w = {cvtpk(w0[0], w0[1]), cvtpk(w0[2], w0[3]), cvtpk(w1[0], w1[1]), cvtpk(w1[2], w1[3])};
                if (r != 0u) w = (u32x4){0u, 0u, 0u, 0u}; wB[ks] = __builtin_bit_cast(bf16x8, w); }
            const size_t dbase = ((size_t)dir * T) * MH + h;
            if (wave < 4) { const int tt = wave; f32x4 d2 = (f32x4){0.f, 0.f, 0.f, 0.f};
#pragma unroll
                for (int ks = 0; ks < 4; ++ks) { const f32x4 n0 = *(const LAS f32x4*)(n_old + 32 * ks + 4 * q), n1 = *(const LAS f32x4*)(n_old + 32 * ks + 16 + 4 * q);
                    u32x4 bw = {cvtpk(n0[0], n0[1]), cvtpk(n0[2], n0[3]), cvtpk(n1[0], n1[1]), cvtpk(n1[2], n1[3])}; if (r != 0u) bw = (u32x4){0u, 0u, 0u, 0u};
                    const u32x2 lo = *(const LAS u32x2*)(Qi + PB1 + 4096u * tt + 512u * ks), hi = *(const LAS u32x2*)(Qi + PB2 + 4096u * tt + 512u * ks);
                    const u32x4 aw = {lo.x, lo.y, hi.x, hi.y};
                    d2 = __builtin_amdgcn_mfma_f32_16x16x32_bf16(__builtin_bit_cast(bf16x8, aw), __builtin_bit_cast(bf16x8, bw), d2, 0, 0, 0); }
#pragma unroll
                for (int i = 0; i < 4; ++i) { const int t = 16 * tt + 4 * (int)q + i; const float bv = sct[64 + t], fl = sct[128 + t];
                    if (r == 0u) { const size_t di = dbase + (size_t)ml_tok(dir, b, c * 64 + t) * MH; p.DEN()[(size_t)2 * T * MH + di] = bv * d2[i]; p.FLR()[di] = fl; } }
            } else { const int tt = wave - 4; f32x4 d1 = (f32x4){0.f, 0.f, 0.f, 0.f};
#pragma unroll
                for (int ks = 0; ks < 2; ++ks) if (ks == 0 || tt >= 2) { const bf16x8 pf = *(const LAS bf16x8*)(Pt + (ks ? PP1 : PP0) + 2048u * tt);
                    d1 = __builtin_amdgcn_mfma_f32_16x16x32_bf16(pf, wB[ks], d1, 0, 0, 0); }
#pragma unroll
                for (int i = 0; i < 4; ++i) { const int t = 16 * tt + 4 * (int)q + i; const float av = sct[t];
                    if (r == 0u) p.DEN()[dbase + (size_t)ml_tok(dir, b, c * 64 + t) * MH] = av * d1[i]; } }
            { const int dt = wave; f32x4 nn = *(const LAS f32x4*)(n_old + 16 * dt + 4 * q) * cs.decay; if (r != 0u) nn = (f32x4){0.f, 0.f, 0.f, 0.f};
#pragma unroll
                for (int ks = 0; ks < 2; ++ks) { const bf16x8 kA = cat8(trr(Ki + ML_TRA(dt, ks, 0)), trr(Ki + ML_TRA(dt, ks, 1)));
                    nn = __builtin_amdgcn_mfma_f32_16x16x32_bf16(kA, wB[ks], nn, 0, 0, 0); }
                if (r == 0u) *(LAS f32x4*)(n_new + 16 * dt + 4 * q) = nn; }
        }
        m = cs.m_next; cs = csn; ign = ig2; fgn = fg2;
    }
    __syncthreads(); ML_FLUSH(NC - 1);
#undef ML_FLUSH
#undef ML_TRA
#undef ML_TABLE
#undef ML_LOAD
#undef ML_GATES
#undef ML_STORE
}
}
__device__ __forceinline__ void phase4(const Prm& p, const Frame& F) {
    static_assert(MV == 256 && MH == 4, "head j = float4 slot j of the lane");
    const int gw = F.bid * NWAVES + F.wave, NGW = F.G * NWAVES;
    for (int row = gw; row < T; row += NGW) {
        const uint2* hf = (const uint2*)(p.HF16() + (size_t)row * MW) + F.lane; const uint2* hb = (const uint2*)(p.HB16() + (size_t)row * MW) + F.lane;
        const uint2* og = (const uint2*)(p.PJ() + (size_t)row * INM + O_O) + F.lane; uint2* yo = (uint2*)(p.Y() + (size_t)row * D + CW) + F.lane;
#pragma unroll
        for (int j = 0; j < MH; ++j) {
            const float* d2 = p.DEN() + (size_t)2 * T * MH;
            const float i_f = 1.f / fmaxf(fabsf(p.DEN()[(size_t)row * MH + j] + d2[(size_t)row * MH + j]), p.FLR()[(size_t)row * MH + j]);
            const float i_b = 1.f / fmaxf(fabsf(p.DEN()[((size_t)T + row) * MH + j] + d2[((size_t)T + row) * MH + j]), p.FLR()[((size_t)T + row) * MH + j]);
            const uint2 a = hf[64 * j], b = hb[64 * j]; float4 h = make_float4(bflo(a.x) * i_f + bflo(b.x) * i_b, bfhi(a.x) * i_f + bfhi(b.x) * i_b, bflo(a.y) * i_f + bflo(b.y) * i_b, bfhi(a.y) * i_f + bfhi(b.y) * i_b);
            const float mean = wave_sum((h.x + h.y) + (h.z + h.w)) * (1.f / MV);
            h.x -= mean; h.y -= mean; h.z -= mean; h.w -= mean;
            const float rstd = 1.f / sqrtf(wave_sum((h.x * h.x + h.y * h.y) + (h.z * h.z + h.w * h.w)) * (1.f / MV) + LN_EPS);
            const float4 nw = *((const float4*)(p.mnorm_w + j * MV) + F.lane); const uint2 o = og[64 * j];
            yo[64 * j] = make_uint2(pk2(h.x * rstd * nw.x * sigmoidf_(bflo(o.x)), h.y * rstd * nw.y * sigmoidf_(bfhi(o.x))), pk2(h.z * rstd * nw.z * sigmoidf_(bflo(o.y)), h.w * rstd * nw.w * sigmoidf_(bfhi(o.y)))); }
    }
}
struct EpiZ {
    static constexpr bool PERM = false, AFTER_DRAIN = false;
    const float* x; const float* mod; bf16_t* out;
    __device__ __forceinline__ void operator()(const pg8::f32x4 (&acc)[2][2][4][2], const pg8::Unit& u, int wr, int wc, int fr, int fq) const {
        const int col0 = u.pn * 256 + wc * 32 + 4 * fq;
#pragma unroll
        for (int ai = 0; ai < 2; ++ai)
#pragma unroll
            for (int m = 0; m < 4; ++m) { const int row = u.pm * 256 + ai * 128 + wr * 64 + m * 16 + fr; const float* g1 = mod + (size_t)(row / S) * D6 + 2 * D; const size_t off = (size_t)row * D + col0;
#pragma unroll
                for (int bj = 0; bj < 2; ++bj)
#pragma unroll
                    for (int n = 0; n < 2; ++n) { const int c = bj * 128 + n * 16; const pg8::f32x4 xv = *(const pg8::f32x4*)(x + off + c), gv = *(const pg8::f32x4*)(g1 + col0 + c);
                        const pg8::f32x4 z = xv * ALPHA + gv * acc[ai][bj][m][n]; *(uint2*)(out + off + c) = make_uint2(pk2(z[0], z[1]), pk2(z[2], z[3])); } }
    }
};

struct EpiF32 {
    static constexpr bool PERM = false, AFTER_DRAIN = false;
    float* out; int ldc;
    __device__ __forceinline__ void operator()(const pg8::f32x4 (&acc)[2][2][4][2], const pg8::Unit& u, int wr, int wc, int fr, int fq) const {
        const int col0 = u.pn * 256 + wc * 32 + 4 * fq;
#pragma unroll
        for (int ai = 0; ai < 2; ++ai)
#pragma unroll
            for (int m = 0; m < 4; ++m) { float* rowp = out + (size_t)(u.pm * 256 + ai * 128 + wr * 64 + m * 16 + fr) * ldc + col0;
#pragma unroll
                for (int bj = 0; bj < 2; ++bj)
#pragma unroll
                    for (int n = 0; n < 2; ++n) *(pg8::f32x4*)(rowp + bj * 128 + n * 16) = acc[ai][bj][m][n]; }
    }
};
__device__ __forceinline__ unsigned skey(float f) { const unsigned u = f_as_u(f); return (u & 0x80000000u) ? ~u : (u | 0x80000000u); }
__device__ __forceinline__ float unskey(unsigned k) { return u_as_f((k & 0x80000000u) ? (k & 0x7fffffffu) : ~k); }
__device__ __forceinline__ void tk_insert(unsigned (&L)[16], unsigned k) {
    if (k > L[15]) { L[15] = k;
#pragma unroll
        for (int i = 14; i >= 0; --i) { const unsigned hi = L[i] > L[i + 1] ? L[i] : L[i + 1], lo = L[i] > L[i + 1] ? L[i + 1] : L[i]; L[i] = hi; L[i + 1] = lo; } }
}
__device__ __forceinline__ void tk_top16(const float* sc, unsigned (&L)[16]) {
#pragma unroll
    for (int i = 0; i < 16; ++i) L[i] = 0u;
#pragma unroll 2
    for (int n4 = 0; n4 < NK / 4; ++n4) { const float4 v = ((const float4*)sc)[n4]; const unsigned b = 127u - 4u * n4;
        tk_insert(L, (skey(v.x) & ~0x7fu) | b); tk_insert(L, (skey(v.y) & ~0x7fu) | (b - 1)); tk_insert(L, (skey(v.z) & ~0x7fu) | (b - 2)); tk_insert(L, (skey(v.w) & ~0x7fu) | (b - 3)); }
}
__device__ __forceinline__ void phase8(const Prm& p, const Frame& F) {
    static_assert(NK == 128 && TOPK == 16, "top-k phase is specialised");
    const long gt = (long)F.bid * NTHR + F.tid, GT = (long)F.G * NTHR;
    for (long i = gt; i < (long)T * PH; i += GT) {
        unsigned A[16], B[16];
        tk_top16(p.SC() + (size_t)i * 2 * NK, A); tk_top16(p.SC() + (size_t)i * 2 * NK + NK, B);
        float V[16]; int E[16];
#pragma unroll
        for (int r = 0; r < 16; ++r) { V[r] = -INFINITY; E[r] = 0; }
#pragma unroll
        for (int a = 0; a < 16; ++a)
#pragma unroll
            for (int b = 0; b < 16; ++b) if ((a + 1) * (b + 1) <= 16) {
                const float v = unskey(A[a] & ~0x7fu) + unskey(B[b] & ~0x7fu); const int e = (int)((127u - (A[a] & 0x7fu)) * NK + (127u - (B[b] & 0x7fu)));
                if (v > V[15]) { V[15] = v; E[15] = e;
#pragma unroll
                    for (int r = 14; r >= 0; --r) { const bool sw = V[r + 1] > V[r]; const float vh = sw ? V[r + 1] : V[r], vl = sw ? V[r] : V[r + 1]; const int eh = sw ? E[r + 1] : E[r], el = sw ? E[r] : E[r + 1];
                        V[r] = vh; V[r + 1] = vl; E[r] = eh; E[r + 1] = el; } } }
        float sum = 0.f; const float vmax = V[0];
#pragma unroll
        for (int r = 0; r < 16; ++r) { V[r] = __expf(V[r] - vmax); sum += V[r]; }
        const float inv = 1.f / sum;
#pragma unroll
        for (int r = 0; r < 16; r += 4) { *(int4*)(p.EIDX() + (size_t)i * TOPK + r) = make_int4(E[r], E[r + 1], E[r + 2], E[r + 3]);
            *(float4*)(p.EW() + (size_t)i * TOPK + r) = make_float4(V[r] * inv, V[r + 1] * inv, V[r + 2] * inv, V[r + 3] * inv); }
    }
}
__device__ __forceinline__ void phase6(const Prm& p, const Frame& F) {
    const int gw = F.bid * NWAVES + F.wave, NGW = F.G * NWAVES;
    float4 v[8]; uint2 zb[8], zn[8];
    if (gw < T) { const uint2* z0 = (const uint2*)((const bf16_t*)p.out + (size_t)gw * D) + F.lane;
#pragma unroll
        for (int j = 0; j < 8; ++j) zb[j] = z0[64 * j]; }
    for (int row = gw; row < T; row += NGW) {
        uint2* x1r = (uint2*)(p.X1B() + (size_t)row * D) + F.lane; const float* mod = p.MOD() + (size_t)(row / S) * D6;
        float s = 0.f;
        if (row + NGW < T) { const uint2* zp = (const uint2*)((const bf16_t*)p.out + (size_t)(row + NGW) * D) + F.lane;
#pragma unroll
            for (int j = 0; j < 8; ++j) zn[j] = zp[64 * j]; }
#pragma unroll
        for (int j = 0; j < 8; ++j) { v[j] = make_float4(bflo(zb[j].x), bfhi(zb[j].x), bflo(zb[j].y), bfhi(zb[j].y)); s += (v[j].x + v[j].y) + (v[j].z + v[j].w); }
        float mean = wave_sum(s) * (1.f / D), s2 = 0.f;
#pragma unroll
        for (int j = 0; j < 8; ++j) { v[j].x -= mean; v[j].y -= mean; v[j].z -= mean; v[j].w -= mean; s2 += (v[j].x * v[j].x + v[j].y * v[j].y) + (v[j].z * v[j].z + v[j].w * v[j].w); }
        float rstd = 1.f / sqrtf(wave_sum(s2) * (1.f / D) + LN_EPS); s = 0.f;
#pragma unroll
        for (int j = 0; j < 8; ++j) { const float4 w = *((const float4*)p.ln1_w + F.lane + 64 * j), bb = *((const float4*)p.ln1_b + F.lane + 64 * j);
            v[j].x = v[j].x * rstd * w.x + bb.x; v[j].y = v[j].y * rstd * w.y + bb.y; v[j].z = v[j].z * rstd * w.z + bb.z; v[j].w = v[j].w * rstd * w.w + bb.w;
            x1r[64 * j] = make_uint2(pk2(v[j].x, v[j].y), pk2(v[j].z, v[j].w)); s += (v[j].x + v[j].y) + (v[j].z + v[j].w); }
        mean = wave_sum(s) * (1.f / D); s2 = 0.f;
#pragma unroll
        for (int j = 0; j < 8; ++j) { v[j].x -= mean; v[j].y -= mean; v[j].z -= mean; v[j].w -= mean; s2 += (v[j].x * v[j].x + v[j].y * v[j].y) + (v[j].z * v[j].z + v[j].w * v[j].w); }
        rstd = 1.f / sqrtf(wave_sum(s2) * (1.f / D) + LN_EPS);
        uint2* o8 = (uint2*)(p.U() + (size_t)row * D) + F.lane;
#pragma unroll
        for (int j = 0; j < 8; ++j) { const float4 sh = *((const float4*)(mod + 3 * D) + F.lane + 64 * j), sc = *((const float4*)(mod + 4 * D) + F.lane + 64 * j);
            o8[64 * j] = make_uint2(pk2(v[j].x * rstd * (1.f + sc.x) + sh.x, v[j].y * rstd * (1.f + sc.y) + sh.y), pk2(v[j].z * rstd * (1.f + sc.z) + sh.z, v[j].w * rstd * (1.f + sc.w) + sh.w)); }
#pragma unroll
        for (int j = 0; j < 8; ++j) zb[j] = zn[j];
    }
}
struct XW { int vx, nx, rank, nloc; };
constexpr int NDS = 16, DSW = D / NDS;
typedef float f2v __attribute__((ext_vector_type(2)));
struct Row8 { uint4 r[8]; };
__device__ __forceinline__ void gather8(Row8& g, const unsigned char* tbu, unsigned loff, int ereg, int pg) {
#pragma unroll
    for (int k = 0; k < 8; ++k) { const unsigned e = (unsigned)__shfl(ereg, 8 * k + pg); g.r[k] = *(const uint4*)(tbu + (((size_t)e << 11) | loff)); }
}
#define PEER_CVT8(a) const f2v c0 = __builtin_amdgcn_cvt_pk_f32_fp8((a).x, false), c1 = __builtin_amdgcn_cvt_pk_f32_fp8((a).x, true), c2 = __builtin_amdgcn_cvt_pk_f32_fp8((a).y, false), c3 = __builtin_amdgcn_cvt_pk_f32_fp8((a).y, true), \
    c4 = __builtin_amdgcn_cvt_pk_f32_fp8((a).z, false), c5 = __builtin_amdgcn_cvt_pk_f32_fp8((a).z, true), c6 = __builtin_amdgcn_cvt_pk_f32_fp8((a).w, false), c7 = __builtin_amdgcn_cvt_pk_f32_fp8((a).w, true)
typedef _Float16 h2t __attribute__((ext_vector_type(2)));
__device__ __forceinline__ float peer_dot16h(const uint4 a, const h2t* u) {
    float acc = __builtin_amdgcn_fdot2(__builtin_amdgcn_cvt_scalef32_pk_f16_fp8(a.x, 1.0f, false), u[0], 0.f, false);
    acc = __builtin_amdgcn_fdot2(__builtin_amdgcn_cvt_scalef32_pk_f16_fp8(a.x, 1.0f, true), u[1], acc, false);
    acc = __builtin_amdgcn_fdot2(__builtin_amdgcn_cvt_scalef32_pk_f16_fp8(a.y, 1.0f, false), u[2], acc, false);
    acc = __builtin_amdgcn_fdot2(__builtin_amdgcn_cvt_scalef32_pk_f16_fp8(a.y, 1.0f, true), u[3], acc, false);
    acc = __builtin_amdgcn_fdot2(__builtin_amdgcn_cvt_scalef32_pk_f16_fp8(a.z, 1.0f, false), u[4], acc, false);
    acc = __builtin_amdgcn_fdot2(__builtin_amdgcn_cvt_scalef32_pk_f16_fp8(a.z, 1.0f, true), u[5], acc, false);
    acc = __builtin_amdgcn_fdot2(__builtin_amdgcn_cvt_scalef32_pk_f16_fp8(a.w, 1.0f, false), u[6], acc, false);
    acc = __builtin_amdgcn_fdot2(__builtin_amdgcn_cvt_scalef32_pk_f16_fp8(a.w, 1.0f, true), u[7], acc, false);
    return acc;
}
__device__ __forceinline__ f2v rscatter16(const float* v, bool b0, bool b1, bool b2, int m0, int m1, int m2) {
    float r8[8], r4[4]; f2v r2;
#pragma unroll
    for (int i = 0; i < 8; ++i) { const float keep = b0 ? v[8 + i] : v[i], send = b0 ? v[i] : v[8 + i]; r8[i] = keep + __shfl_xor(send, m0); }
#pragma unroll
    for (int i = 0; i < 4; ++i) { const float keep = b1 ? r8[4 + i] : r8[i], send = b1 ? r8[i] : r8[4 + i]; r4[i] = keep + __shfl_xor(send, m1); }
    { const float k0 = b2 ? r4[2] : r4[0], s0 = b2 ? r4[0] : r4[2], k1 = b2 ? r4[3] : r4[1], s1 = b2 ? r4[1] : r4[3]; r2.x = k0 + __shfl_xor(s0, m2); r2.y = k1 + __shfl_xor(s1, m2); }
    return r2;
}
__device__ __forceinline__ void phase9(const Prm& p, const Frame& F, const XW& xw) {
    static_assert(DSW == 128 && NSLOT == 128 && D == 2048, "slice row = 8 lanes x 16 bytes");
    const int pg = F.lane >> 3, part = F.lane & 7; const bool p0 = part & 1, p1 = part & 2, p2 = part & 4;
    const int tstep = xw.nloc * NWAVES, t0 = xw.rank * NWAVES + F.wave; const int nt = t0 < T ? (T - t0 + tstep - 1) / tstep : 0;
    const unsigned loff = (unsigned)part * 16u; const int k0 = (p0 ? 8 : 0) + (p1 ? 4 : 0) + (p2 ? 2 : 0);
    for (int ds = xw.vx; ds < NDS; ds += xw.nx) {
        if (nt == 0) continue;
        const unsigned char* tbu = p.PU8() + ds * DSW; float* part_out = p.SC() + (size_t)ds * T * NSLOT + pg + 8 * k0;
#define UP_TOK(i) (t0 + ((i) < nt ? (i) : nt - 1) * tstep)
#define UP_LOADE(i, ea, eb) do { const int* ep_ = p.EIDX() + (size_t)UP_TOK(i) * NSLOT + F.lane; ea = ep_[0]; eb = ep_[64]; } while (0)
#define UP_LOADU(i, ua_, ub_) do { const uint4* up_ = (const uint4*)(p.U() + (size_t)UP_TOK(i) * D + ds * DSW + part * 16); ua_ = up_[0]; ub_ = up_[1]; } while (0)
        int e0a, e0b, e1a, e1b, e2a, e2b; uint4 ua, ub, una, unb;
        UP_LOADE(0, e0a, e0b); UP_LOADE(1, e1a, e1b); UP_LOADE(2, e2a, e2b); UP_LOADU(0, ua, ub);
        Row8 G0, G1, G2, G3;
        gather8(G0, tbu, loff, e0a, pg); gather8(G1, tbu, loff, e0b, pg); gather8(G2, tbu, loff, e1a, pg);
#define UP_BODY(i, GA, GB, GC, GD) do { \
            gather8(GD, tbu, loff, e1b, pg); UP_LOADU((i) + 1, una, unb); int e3a, e3b; UP_LOADE((i) + 3, e3a, e3b); \
            h2t u[8]; u[0] = (h2t){(_Float16)bflo(ua.x), (_Float16)bfhi(ua.x)}; u[1] = (h2t){(_Float16)bflo(ua.y), (_Float16)bfhi(ua.y)}; u[2] = (h2t){(_Float16)bflo(ua.z), (_Float16)bfhi(ua.z)}; u[3] = (h2t){(_Float16)bflo(ua.w), (_Float16)bfhi(ua.w)}; \
            u[4] = (h2t){(_Float16)bflo(ub.x), (_Float16)bfhi(ub.x)}; u[5] = (h2t){(_Float16)bflo(ub.y), (_Float16)bfhi(ub.y)}; u[6] = (h2t){(_Float16)bflo(ub.z), (_Float16)bfhi(ub.z)}; u[7] = (h2t){(_Float16)bflo(ub.w), (_Float16)bfhi(ub.w)}; \
            float dv[16]; \
            _Pragma("unroll") for (int k = 0; k < 8; ++k) dv[k] = peer_dot16h(GA.r[k], u); \
            gather8(GA, tbu, loff, e2a, pg); \
            _Pragma("unroll") for (int k = 0; k < 8; ++k) dv[8 + k] = peer_dot16h(GB.r[k], u); \
            const f2v r2 = rscatter16(dv, p0, p1, p2, 1, 2, 4);                          \
            if ((i) < nt) { float* po = part_out + (size_t)UP_TOK(i) * NSLOT; po[0] = r2.x; po[8] = r2.y; } \
            e1a = e2a; e1b = e2b; e2a = e3a; e2b = e3b; ua = una; ub = unb; } while (0)
        for (int i = 0; i < nt; i += 2) { UP_BODY(i, G0, G1, G2, G3); UP_BODY(i + 1, G2, G3, G0, G1); }
#undef UP_BODY
#undef UP_LOADU
#undef UP_LOADE
#undef UP_TOK
    }
}
__device__ __forceinline__ void phase10(const Prm& p, const Frame& F) {
    static_assert(NE <= 16384 && NSLOT == 128 && T % 64 == 0, "14-bit expert id, 64-token groups");
    LAS unsigned* tile = (LAS unsigned*)F.lds;
    for (int tg = F.bid; tg < T / 64; tg += F.G) {
        __syncthreads();
#pragma unroll 4
        for (int k = 0; k < 16; ++k) { const int idx = F.tid + NTHR * k, tl = idx >> 7, sl = idx & 127; const size_t i = ((size_t)tg * 64 + tl) * NSLOT + sl; float s = 0.f;
#pragma unroll
            for (int ds = 0; ds < NDS; ++ds) s += p.SC()[(size_t)ds * T * NSLOT + i];
            const int e = p.EIDX()[i]; const _Float16 w = (_Float16)(p.EW()[i] * gelu_exact(s * p.RSU()[e]));
            tile[tl * 129 + sl] = ((unsigned)__builtin_bit_cast(unsigned short, w) << 16) | (unsigned)e; }
        __syncthreads();
        uint4* pk = (uint4*)p.EW() + (size_t)tg * 64 * (NSLOT / 4);
#pragma unroll
        for (int k = 0; k < 4; ++k) { const int j = F.tid + NTHR * k, sq = j >> 6, tl = j & 63; const LAS unsigned* tp = tile + tl * 129 + 4 * sq; pk[j] = make_uint4(tp[0], tp[1], tp[2], tp[3]); }
    }
}
__device__ __forceinline__ void phase11(const Prm& p, const Frame& F) {
    static_assert(NE * 8 <= RING_BYTES && D % 8 == 0 && NE <= 65536, "table slice fits the LDS ring");
    typedef _Float16 h2v __attribute__((ext_vector_type(2)));
    const int c0 = (F.G % 8 == 0) ? (F.bid % 8) * (F.G / 8) + F.bid / 8 : F.bid;
    for (int sidx = c0; sidx < D / 4; sidx += F.G) {
        __syncthreads();
        { const uint4* src = (const uint4*)(p.PVH() + (size_t)sidx * NE * 4);
          for (int i = F.tid; i < NE / 2; i += NTHR) *(LAS u32x4_t*)(F.lds + 16 * i) = __builtin_bit_cast(u32x4_t, src[i]); }
        __syncthreads();
        const int ntg = (T / 64 - F.wave + NWAVES - 1) / NWAVES, nb = 8 * ntg;
        uint4 b0[4], b1[4], b2[4], b3[4];
#define DN_PTR(bi) ((const uint4*)p.EW() + (size_t)(F.wave + ((bi) >> 3) * NWAVES) * 64 * (NSLOT / 4) + ((bi) & 7) * 4 * 64 + F.lane)
#define DN_LOAD(B, bi) do { const int bc_ = (bi) < nb ? (bi) : nb - 1; const uint4* pk_ = DN_PTR(bc_); _Pragma("unroll") for (int k = 0; k < 4; ++k) B[k] = pk_[k * 64]; } while (0)
#define DN_ONE(v_) do { const unsigned vv_ = (v_); const _Float16 w = __builtin_bit_cast(_Float16, (unsigned short)(vv_ >> 16)); const h2v w2 = {w, w}; \
                const u2v t = *(const LAS u2v*)(F.lds + ((vv_ & 0xFFFFu) << 3)); const unsigned tx_ = t.x, ty_ = t.y;     \
                a0 += __builtin_bit_cast(h2v, tx_) * w2; a1 += __builtin_bit_cast(h2v, ty_) * w2; } while (0)
#define DN_ACC(B) do { _Pragma("unroll") for (int k = 0; k < 4; ++k) { DN_ONE(B[k].x); DN_ONE(B[k].y); DN_ONE(B[k].z); DN_ONE(B[k].w); } asm volatile("" ::: "memory"); } while (0)
        DN_LOAD(b0, 0); DN_LOAD(b1, 1); DN_LOAD(b2, 2);
        for (int bi = 0; bi < nb; bi += 8) {
            h2v a0 = {0, 0}, a1 = {0, 0};
            DN_LOAD(b3, bi + 3); DN_ACC(b0);
            DN_LOAD(b0, bi + 4); DN_ACC(b1);
            DN_LOAD(b1, bi + 5); DN_ACC(b2);
            DN_LOAD(b2, bi + 6); DN_ACC(b3);
            DN_LOAD(b3, bi + 7); DN_ACC(b0);
            DN_LOAD(b0, bi + 8); DN_ACC(b1);
            DN_LOAD(b1, bi + 9); DN_ACC(b2);
            DN_LOAD(b2, bi + 10); DN_ACC(b3);
            const int tg = F.wave + (bi >> 3) * NWAVES;
            *(uint2*)(p.Y() + ((size_t)tg * 64 + F.lane) * D + 4 * sidx) = make_uint2(pk2((float)a0[0], (float)a0[1]), pk2((float)a1[0], (float)a1[1]));
        }
#undef DN_ACC
#undef DN_ONE
#undef DN_LOAD
#undef DN_PTR
    }
}
__device__ __forceinline__ void phase12(const Prm& p, const Frame& F) {
    const int gw = F.bid * NWAVES + F.wave, NGW = F.G * NWAVES;
    float4 v[8]; uint2 xb[8], xn[8];
    if (gw < T) { const uint2* xr = (const uint2*)(p.X1B() + (size_t)gw * D) + F.lane;
#pragma unroll
        for (int j = 0; j < 8; ++j) xb[j] = xr[64 * j]; }
    for (int row = gw; row < T; row += NGW) {
        float4* zr = (float4*)(p.out + (size_t)row * D) + F.lane; float s = 0.f;
        if (row + NGW < T) { const uint2* xp = (const uint2*)(p.X1B() + (size_t)(row + NGW) * D) + F.lane;
#pragma unroll
            for (int j = 0; j < 8; ++j) xn[j] = xp[64 * j]; }
        const float* g2 = p.MOD() + (size_t)(row / S) * D6 + 5 * D;
#pragma unroll
        for (int j = 0; j < 8; ++j) { const uint2 y = *((const uint2*)(p.Y() + (size_t)row * D) + F.lane + 64 * j); const float4 g = *((const float4*)g2 + F.lane + 64 * j);
            v[j].x = ALPHA * bflo(xb[j].x) + g.x * bflo(y.x); v[j].y = ALPHA * bfhi(xb[j].x) + g.y * bfhi(y.x); v[j].z = ALPHA * bflo(xb[j].y) + g.z * bflo(y.y); v[j].w = ALPHA * bfhi(xb[j].y) + g.w * bfhi(y.y);
            s += (v[j].x + v[j].y) + (v[j].z + v[j].w); }
        const float mean = wave_sum(s) * (1.f / D); float s2 = 0.f;
#pragma unroll
        for (int j = 0; j < 8; ++j) { v[j].x -= mean; v[j].y -= mean; v[j].z -= mean; v[j].w -= mean; s2 += (v[j].x * v[j].x + v[j].y * v[j].y) + (v[j].z * v[j].z + v[j].w * v[j].w); }
        const float rstd = 1.f / sqrtf(wave_sum(s2) * (1.f / D) + LN_EPS);
#pragma unroll
        for (int j = 0; j < 8; ++j) { const float4 w = *((const float4*)p.ln2_w + F.lane + 64 * j), bb = *((const float4*)p.ln2_b + F.lane + 64 * j);
            zr[64 * j] = make_float4(v[j].x * rstd * w.x + bb.x, v[j].y * rstd * w.y + bb.y, v[j].z * rstd * w.z + bb.z, v[j].w * rstd * w.w + bb.w); }
#pragma unroll
        for (int j = 0; j < 8; ++j) xb[j] = xn[j];
    }
}

struct Args { const float* in[18]; float* out; unsigned char* ws; int ph_lo, ph_hi, li, pad; };
__global__ void __launch_bounds__(NTHR, 2) mk_fwd(Args args) {
    extern __shared__ __attribute__((aligned(16))) unsigned char lds_raw[];
    Frame F; F.lds = (LAS unsigned char*)lds_raw; F.tid = threadIdx.x; F.lane = F.tid & 63; F.wave = __builtin_amdgcn_readfirstlane(F.tid >> 6); F.G = gridDim.x; F.bid = blockIdx.x;
    Prm p; p.x = args.in[0]; p.c = args.in[1]; p.w_ada = args.in[2]; p.b_ada = args.in[3]; p.w_in = args.in[4]; p.b_in = args.in[5]; p.conv_w = args.in[6]; p.conv_b = args.in[7]; p.mnorm_w = args.in[8];
    p.w_out = args.in[9]; p.ln1_w = args.in[10]; p.ln1_b = args.in[11]; p.wq = args.in[12]; p.subkeys = args.in[13]; p.peer_u = args.in[14]; p.peer_v = args.in[15]; p.ln2_w = args.in[16]; p.ln2_b = args.in[17];
    p.out = args.out; p.ws = args.ws;
    volatile LAS unsigned* MISC = (volatile LAS unsigned*)(F.lds + MISC_OFF);
    for (int u = F.tid; u < (LDS_BYTES - LDSCTL_OFF) / 4; u += NTHR) ((LAS unsigned*)(F.lds + LDSCTL_OFF))[u] = 0u;
    __syncthreads();
    const int lo = args.ph_lo, hi = args.ph_hi;
    XcdBarrier bar; bar.bar = (unsigned*)(p.ws + WS_CTL) + CW_BAR + args.li * XCD_BAR_WORDS; bar.x = 0; bar.st = nullptr;
    if (hi - lo > 1) bar = xcd_barrier_post((unsigned*)(p.ws + WS_CTL) + CW_BAR + args.li * XCD_BAR_WORDS, MISC + 8);
#define IN(k) (lo <= (k) && (k) < hi)
#define SEAM(k) do { if (IN(k) && IN((k) + 1)) xcd_barrier(bar); } while (0)
    XW xw; xw.nx = (F.G % 8 == 0) ? 8 : 1; xw.vx = F.bid % xw.nx; xw.rank = F.bid / xw.nx; xw.nloc = F.G / xw.nx;
#define XW_FROM_CENSUS() do { if (hi - lo > 1) { if (F.tid == 0) { unsigned vx_ = 0u; for (unsigned j = 0; j < bar.x; ++j) vx_ += xb_ld(&bar.bar[XB_XCNT(j)]) > 0u ? 1u : 0u; MISC[11] = vx_; } __syncthreads(); \
        xw.vx = (int)MISC[11]; xw.nx = (int)MISC[9]; xw.rank = (int)MISC[10] - 1; xw.nloc = (int)MISC[8]; } } while (0)
    if (IN(0)) { phase0(p, F); } SEAM(0);
    if (IN(1)) { phase1(p, F); } SEAM(1);
    if (IN(2)) { pg8::Gemm g{p.U(), p.WIN_T(), T, INM, D}; pg8::StaticOrder So; So.init(T, INM, F.G, F.bid);
        pg8::EpiBf16<0> E{p.PJ(), INM, p.b_in, 0, 0, 1.f};
        pg8::gemm_phase<pg8::EpiBf16<0>, pg8::StaticOrder, true, true>(F.lds, g, So, E); } SEAM(2);
    if (IN(3)) { const int nmb = F.G >= 2 ? F.G / 2 : 1;
#ifndef P3_REP_ML
#define P3_REP_ML 1
#define P3_REP_CONV 1
#endif
        if (F.bid < nmb) { for (int rep_ = 0; rep_ < P3_REP_ML; ++rep_) for (int u = F.bid; u < 2 * NB * MH * 2; u += nmb) ml::unit(p, F, u); if (F.G < 2) phase3a(p, F, 0, 1); }
        else for (int rep_ = 0; rep_ < P3_REP_CONV; ++rep_) phase3a(p, F, nmb, F.G - nmb); } SEAM(3);
    if (IN(4)) { phase4(p, F); } SEAM(4);
    if (IN(5)) { pg8::Gemm g{p.Y(), p.WOUT_T(), T, D, D}; pg8::StaticOrder So; So.init(T, D, F.G, F.bid);
        EpiZ E{p.x, p.MOD(), (bf16_t*)p.out};
        pg8::gemm_phase<EpiZ, pg8::StaticOrder, true, true>(F.lds, g, So, E); } SEAM(5);
    if (IN(6)) { phase6(p, F); } SEAM(6);
    if (IN(7)) { pg8::Gemm g{p.U(), p.WQ_T(), T, NQ, D}; pg8::StaticOrder So; So.init(T, NQ, F.G, F.bid);
        EpiF32 E{p.SC(), NSC};
        pg8::gemm_phase<EpiF32, pg8::StaticOrder, true, true>(F.lds, g, So, E); } SEAM(7);
    if (IN(8)) { phase8(p, F); } SEAM(8);
    if (IN(9)) { if (lo < 9) XW_FROM_CENSUS(); phase9(p, F, xw); } SEAM(9);
    if (IN(10)) { phase10(p, F); } SEAM(10);
    if (IN(11)) { phase11(p, F); } SEAM(11);
    if (IN(12)) { phase12(p, F); }
#undef IN
#undef SEAM
}

extern "C" void kernel_launch(void* const* d_in, const int* in_sizes, int n_in, void* d_out, int out_size, void* d_ws, size_t ws_size, hipStream_t stream) {
    static int grid = 0;
    if (grid == 0) {
        if (n_in != 18 || out_size != T * D || ws_size < WS_END) { fprintf(stderr, "kernel_launch: unexpected shapes (n_in %d out %d ws %zu, need %zu)\n", n_in, out_size, ws_size, (size_t)WS_END); grid = -1; return; }
        int dev = 0, cus = 0, per_cu = 0;
        if (hipGetDevice(&dev) != hipSuccess || hipDeviceGetAttribute(&cus, hipDeviceAttributeMultiprocessorCount, dev) != hipSuccess) { grid = -1; return; }
        if (hipFuncSetAttribute((const void*)mk_fwd, hipFuncAttributeMaxDynamicSharedMemorySize, LDS_BYTES) != hipSuccess) { fprintf(stderr, "kernel_launch: hipFuncSetAttribute failed\n"); grid = -1; return; }
        if (hipOccupancyMaxActiveBlocksPerMultiprocessor(&per_cu, (const void*)mk_fwd, NTHR, LDS_BYTES) != hipSuccess || per_cu < 1) { fprintf(stderr, "kernel_launch: occupancy query says %d\n", per_cu); }
        (void)hipGetLastError();
        grid = cus;
        if (T % grid != 0 || (T / grid) % NWAVES != 0) { fprintf(stderr, "kernel_launch: grid %d does not divide the rows\n", grid); grid = -1; return; }
    }
    if (grid < 0) return;
    (void)hipMemsetAsync((char*)d_ws + WS_CTL, 0, 1u << 20, stream);
    Args a{};
    for (int i = 0; i < 18; ++i) a.in[i] = (const float*)d_in[i];
    a.out = (float*)d_out; a.ws = (unsigned char*)d_ws;
#if defined(PROBE_A)
    a.ph_lo = 0; a.ph_hi = PROBE_B + 1; a.li = 0; hipLaunchKernelGGL(mk_fwd, dim3(grid), dim3(NTHR), LDS_BYTES, stream, a);
    a.ph_lo = PROBE_A; a.ph_hi = NPHASE; a.li = 1; hipLaunchKernelGGL(mk_fwd, dim3(grid), dim3(NTHR), LDS_BYTES, stream, a);
#elif MK_N_LAUNCHES == 1
    a.ph_lo = 0; a.ph_hi = NPHASE;
    hipLaunchKernelGGL(mk_fwd, dim3(grid), dim3(NTHR), LDS_BYTES, stream, a);
#else
    for (int k = 0; k < NPHASE; ++k) { a.ph_lo = k; a.ph_hi = k + 1; hipLaunchKernelGGL(mk_fwd, dim3(grid), dim3(NTHR), LDS_BYTES, stream, a); }
#endif
}
```

```cpp
#define MK_N_LAUNCHES 1
#if defined(HOST_EMU)
#include <cmath>
#include <cstdint>
#include <cstring>
#include <cstddef>
#define HD inline
#define HDF inline
#else
#include <hip/hip_runtime.h>
#define HD __host__ __device__ __forceinline__
#define HDF __host__ __device__ __forceinline__
#endif

#ifndef CFG_D
#define CFG_D 2048
#define CFG_B 8
#define CFG_S 2048
#define CFG_PH 8
#define CFG_NK 128
#define CFG_TOPK 16
#define CFG_KD 256
#endif
constexpr int D = CFG_D, NB = CFG_B, S = CFG_S, T = NB * S;
constexpr int CW = D / 2, MW = D - CW, MH = 4, MV = MW / MH, QK = MV / 2, NG = 16, CHUNK = 64;
constexpr int INC = 3 * CW + 2 * MH * QK + 2 * MW + NG;
constexpr int INM = INC - NG;
constexpr int O_GB = 0, O_GC = CW, O_HIN = 2 * CW, O_Q = 3 * CW, O_K = O_Q + MH * QK, O_V = O_K + MH * QK, O_O = O_V + MW;
constexpr int PH = CFG_PH, NK = CFG_NK, TOPK = CFG_TOPK, KD = CFG_KD, KH = KD / 2, NE = NK * NK, NSLOT = PH * TOPK;
constexpr int NQ = PH * KD;
static_assert(PH * 2 * NK == NQ || true, "");
constexpr int NSC = PH * 2 * NK;
constexpr float LN_EPS = 1e-5f;
constexpr float ALPHA = 1.189207115002721f;
constexpr int D6 = 6 * D;

typedef unsigned short bf16_t;
HDF unsigned f_as_u(float f) { unsigned u; memcpy(&u, &f, 4); return u; }
HDF float u_as_f(unsigned u) { float f; memcpy(&f, &u, 4); return f; }
HDF bf16_t f2bf(float f) { unsigned u = f_as_u(f); return (bf16_t)((u + 0x7fffu + ((u >> 16) & 1u)) >> 16); }
HDF float bf2f(bf16_t h) { return u_as_f((unsigned)h << 16); }

constexpr size_t al(size_t x) { return (x + 1048575) & ~(size_t)1048575; }
constexpr size_t WS_CTL = 0;
constexpr size_t WS_MOD = al(1);
constexpr size_t WS_MODP = WS_MOD + al((size_t)NB * D6 * 4);
constexpr int NKS = 32;
constexpr size_t WS_GATES = WS_MODP + al((size_t)NKS * NB * D6 * 4);
constexpr size_t WS_DEN = WS_GATES + al((size_t)T * NG * 4);
constexpr size_t WS_FLR = WS_DEN + al((size_t)4 * T * MH * 4);
constexpr size_t WS_EIDX = WS_FLR + al((size_t)2 * T * MH * 4);
constexpr size_t WS_EW = WS_EIDX + al((size_t)T * NSLOT * 4);
constexpr size_t WS_WIN_T = WS_EW + al((size_t)T * NSLOT * 4);
constexpr size_t WS_WOUT_T = WS_WIN_T + al((size_t)INM * D * 2);
constexpr size_t WS_WQ_T = WS_WOUT_T + al((size_t)D * D * 2);
constexpr size_t WS_PU16 = WS_WQ_T + al((size_t)NQ * D * 2);
constexpr size_t WS_PV16 = WS_PU16 + al((size_t)NE * D * 2);
constexpr size_t WS_U = WS_PV16 + al((size_t)NE * D * 2);
constexpr size_t WS_Y = WS_U + al((size_t)T * D * 2);
constexpr size_t WS_P = WS_Y + al((size_t)T * D * 2);
constexpr size_t WS_SC = WS_P;
constexpr size_t WS_TS = WS_SC + al((size_t)T * NSC * 4);
constexpr size_t WS_TI = WS_TS + al((size_t)T * PH * 2 * TOPK * 4);
constexpr size_t WS_P_END = WS_P + al((size_t)T * INM * 2);
constexpr size_t WS_TI_END = WS_TI + al((size_t)T * PH * 2 * TOPK * 4);
constexpr size_t WS_END = WS_P_END > WS_TI_END ? WS_P_END : WS_TI_END;

struct Prm {
    const float *x, *c, *w_ada, *b_ada, *w_in, *b_in, *conv_w, *conv_b, *mnorm_w, *w_out, *ln1_w, *ln1_b, *wq, *subkeys, *peer_u, *peer_v, *ln2_w, *ln2_b;
    float* out;
    unsigned char* ws;
    HDF float* MOD() const { return (float*)(ws + WS_MOD); }
    HDF float* MODP() const { return (float*)(ws + WS_MODP); }
    HDF float* GATES() const { return (float*)(ws + WS_GATES); }
    HDF float* DEN() const { return (float*)(ws + WS_DEN); }
    HDF float* FLR() const { return (float*)(ws + WS_FLR); }
    HDF int* EIDX() const { return (int*)(ws + WS_EIDX); }
    HDF float* EW() const { return (float*)(ws + WS_EW); }
    HDF bf16_t* WIN_T() const { return (bf16_t*)(ws + WS_WIN_T); }
    HDF bf16_t* WOUT_T() const { return (bf16_t*)(ws + WS_WOUT_T); }
    HDF bf16_t* WQ_T() const { return (bf16_t*)(ws + WS_WQ_T); }
    HDF bf16_t* PU16() const { return (bf16_t*)(ws + WS_PU16); }
    HDF bf16_t* PV16() const { return (bf16_t*)(ws + WS_PV16); }
    HDF unsigned char* PU8() const { return ws + WS_PU16; }
    HDF unsigned char* PV8() const { return ws + WS_PV16; }
    HDF unsigned char* PV8S() const { return ws + WS_PV16; }
    HDF float* RSU() const { return (float*)(ws + WS_PU16 + (size_t)NE * D); }
    HDF float* RSV() const { return (float*)(ws + WS_PU16 + (size_t)NE * D + (size_t)NE * 4); }
    HDF bf16_t* U() const { return (bf16_t*)(ws + WS_U); }
    HDF bf16_t* Y() const { return (bf16_t*)(ws + WS_Y); }
    HDF bf16_t* PJ() const { return (bf16_t*)(ws + WS_P); }
    HDF float* SC() const { return (float*)(ws + WS_SC); }
    HDF bf16_t* X1B() const { return (bf16_t*)(ws + WS_TS); }
    HDF float* TS() const { return (float*)(ws + WS_TS); }
    HDF int* TI() const { return (int*)(ws + WS_TI); }
    HDF float* HF() const { return out; }
    HDF float* HB() const { return out + (size_t)T * MW; }
    HDF bf16_t* HF16() const { return (bf16_t*)out; }
    HDF bf16_t* HB16() const { return (bf16_t*)out + (size_t)T * MW; }
};

HDF float sigmoidf_(float x) { return 1.f / (1.f + expf(-x)); }
HDF float logsigmoidf_(float x) { return fminf(x, 0.f) - log1pf(expf(-fabsf(x))); }
HDF float gelu_exact(float x) { return 0.5f * x * (1.f + erff(x * 0.7071067811865476f)); }

HD void b_ada(const Prm& p, long n) {
    float acc[NB];
#pragma unroll
    for (int b = 0; b < NB; ++b) acc[b] = 0.f;
    for (int k = 0; k < D; ++k) {
        const float w = p.w_ada[(size_t)k * D6 + n];
#pragma unroll
        for (int b = 0; b < NB; ++b) { const float cv = p.c[b * D + k]; acc[b] += cv * sigmoidf_(cv) * w; }
    }
#pragma unroll
    for (int b = 0; b < NB; ++b) p.MOD()[(size_t)b * D6 + n] = acc[b] + p.b_ada[n];
}
HD void b_wt(const float* W, int ldw, int K, bf16_t* WT, long i) { const long n = i / K, k = i % K; WT[i] = f2bf(W[(size_t)k * ldw + n]); }
HD void b_tab(const float* src, bf16_t* dst, long i) { dst[i] = f2bf(src[i]); }
HD void b_ln_mod1(const Prm& p, long row) {
    const float* xr = p.x + (size_t)row * D; const int b = (int)(row / S);
    const float* sh = p.MOD() + (size_t)b * D6; const float* sc = sh + D;
    float s = 0.f; for (int d = 0; d < D; ++d) s += xr[d];
    const float mean = s / D; float q = 0.f; for (int d = 0; d < D; ++d) { const float t = xr[d] - mean; q += t * t; }
    const float rstd = 1.f / sqrtf(q / D + LN_EPS);
    for (int d = 0; d < D; ++d) p.U()[(size_t)row * D + d] = f2bf((xr[d] - mean) * rstd * (1.f + sc[d]) + sh[d]);
}
HD void b_gates(const Prm& p, long i) {
    const long row = i / NG; const int g = (int)(i % NG); float acc = 0.f;
    for (int d = 0; d < D; ++d) acc += bf2f(p.U()[(size_t)row * D + d]) * p.w_in[(size_t)d * INC + INM + g];
    p.GATES()[i] = acc + p.b_in[INM + g];
}
HD float b_dot16(const bf16_t* a, const bf16_t* b, int K) { float acc = 0.f; for (int k = 0; k < K; ++k) acc += bf2f(a[k]) * bf2f(b[k]); return acc; }
HD void b_gemm1(const Prm& p, long i) { const long row = i / INM; const int n = (int)(i % INM);
    p.PJ()[i] = f2bf(b_dot16(p.U() + (size_t)row * D, p.WIN_T() + (size_t)n * D, D) + p.b_in[n]); }
HD void b_conv(const Prm& p, long i) {
    const long row = i / CW; const int ch = (int)(i % CW); const int s = (int)(row % S);
    const bf16_t* pj = p.PJ(); float acc = p.conv_b[ch];
#pragma unroll
    for (int k = 0; k < 3; ++k) { const int s2 = s + k - 1; if (s2 >= 0 && s2 < S) { const size_t r2 = (size_t)(row + k - 1) * INM;
        acc += p.conv_w[k * CW + ch] * (bf2f(pj[r2 + O_GC + ch]) * bf2f(pj[r2 + O_HIN + ch])); } }
    p.Y()[(size_t)row * D + ch] = f2bf(bf2f(pj[(size_t)row * INM + O_GB + ch]) * acc);
}
HDF long ml_tok(int dir, int b, int pos) { return (long)b * S + (dir ? S - 1 - pos : pos); }
HD void b_mscan(const Prm& p, long i) {
    const int v = (int)(i % (MV + 1)), h = (int)((i / (MV + 1)) % MH), b = (int)((i / ((MV + 1) * MH)) % NB), dir = (int)(i / ((MV + 1) * MH * NB));
    float C[QK];
#pragma unroll
    for (int d = 0; d < QK; ++d) C[d] = 0.f;
    float m = 0.f; const float qs = 1.f / sqrtf((float)QK);
    float* H = dir ? p.HB() : p.HF();
    for (int pos = 0; pos < S; ++pos) {
        const long tok = ml_tok(dir, b, pos); const float* g = p.GATES() + tok * NG + dir * 8;
        const float ig = g[h], lf = logsigmoidf_(g[4 + h]);
        const float mn = fmaxf(lf + m, ig), dec = expf(lf + m - mn), wi = expf(ig - mn); m = mn;
        const bf16_t* pj = p.PJ() + (size_t)tok * INM; const float wv = wi * (v < MV ? bf2f(pj[O_V + h * MV + (v < MV ? v : 0)]) : 1.f); float num = 0.f;
#pragma unroll
        for (int d = 0; d < QK; ++d) { C[d] = dec * C[d] + wv * bf2f(pj[O_K + h * QK + d]); num += bf2f(pj[O_Q + h * QK + d]) * qs * C[d]; }
        if (v < MV) H[(size_t)tok * MW + h * MV + v] = num;
        else { p.DEN()[((size_t)dir * T + tok) * MH + h] = num; p.FLR()[((size_t)dir * T + tok) * MH + h] = expf(-mn); }
    }
}
HD void b_headnorm(const Prm& p, long i) {
    const long row = i / MH; const int h = (int)(i % MH);
    const float* hf = p.HF() + (size_t)row * MW + h * MV; const float* hb = p.HB() + (size_t)row * MW + h * MV;
    const float inf_ = 1.f / fmaxf(fabsf(p.DEN()[(size_t)row * MH + h]), p.FLR()[(size_t)row * MH + h]);
    const float inb_ = 1.f / fmaxf(fabsf(p.DEN()[((size_t)T + row) * MH + h]), p.FLR()[((size_t)T + row) * MH + h]);
    float s = 0.f; for (int v = 0; v < MV; ++v) s += hf[v] * inf_ + hb[v] * inb_;
    const float mean = s / MV; float q = 0.f; for (int v = 0; v < MV; ++v) { const float t = hf[v] * inf_ + hb[v] * inb_ - mean; q += t * t; }
    const float rstd = 1.f / sqrtf(q / MV + LN_EPS);
    for (int v = 0; v < MV; ++v) { const float hn = (hf[v] * inf_ + hb[v] * inb_ - mean) * rstd * p.mnorm_w[h * MV + v];
        const float og = sigmoidf_(bf2f(p.PJ()[(size_t)row * INM + O_O + h * MV + v]));
        p.Y()[(size_t)row * D + CW + h * MV + v] = f2bf(og * hn); }
}
HD void b_gemm2(const Prm& p, long i) { const long row = i / D; const int n = (int)(i % D); const int b = (int)(row / S);
    const float acc = b_dot16(p.Y() + (size_t)row * D, p.WOUT_T() + (size_t)n * D, D);
    p.out[i] = ALPHA * p.x[i] + p.MOD()[(size_t)b * D6 + 2 * D + n] * acc; }
HD void b_ln_mid(const Prm& p, long row) {
    float* zr = p.out + (size_t)row * D; const int b = (int)(row / S);
    const float* sh = p.MOD() + (size_t)b * D6 + 3 * D; const float* sc = sh + D;
    float s = 0.f; for (int d = 0; d < D; ++d) s += zr[d];
    float mean = s / D; float q = 0.f; for (int d = 0; d < D; ++d) { const float t = zr[d] - mean; q += t * t; }
    float rstd = 1.f / sqrtf(q / D + LN_EPS);
    s = 0.f; for (int d = 0; d < D; ++d) { const float x1 = (zr[d] - mean) * rstd * p.ln1_w[d] + p.ln1_b[d]; zr[d] = x1; s += x1; }
    mean = s / D; q = 0.f; for (int d = 0; d < D; ++d) { const float t = zr[d] - mean; q += t * t; }
    rstd = 1.f / sqrtf(q / D + LN_EPS);
    for (int d = 0; d < D; ++d) p.U()[(size_t)row * D + d] = f2bf((zr[d] - mean) * rstd * (1.f + sc[d]) + sh[d]);
}
HD void b_gemm3(const Prm& p, long i) { const long row = i / NQ; const int n = (int)(i % NQ);
    p.Y()[i] = f2bf(b_dot16(p.U() + (size_t)row * D, p.WQ_T() + (size_t)n * D, D)); }
HD void b_scores(const Prm& p, long i) { const long tok = i / NSC; const int c = (int)(i % NSC), grp = c / NK, n = c % NK;
    const bf16_t* q = p.Y() + (size_t)tok * NQ + grp * KH; const float* sk = p.subkeys + ((size_t)grp * NK + n) * KH; float acc = 0.f;
    for (int d = 0; d < KH; ++d) acc += bf2f(q[d]) * sk[d];
    p.SC()[i] = acc; }
HD void b_topk1(const Prm& p, long i) {
    const float* sc = p.SC() + (size_t)i * NK; float pv = INFINITY; int pi = -1;
    for (int r = 0; r < TOPK; ++r) { float best = -INFINITY; int bi = -1;
        for (int n = 0; n < NK; ++n) { const float v = sc[n]; const bool ok = (v < pv) || (v == pv && n > pi); if (ok && v > best) { best = v; bi = n; } }
        p.TS()[(size_t)i * TOPK + r] = best; p.TI()[(size_t)i * TOPK + r] = bi; pv = best; pi = bi; }
}
HD void b_topk2(const Prm& p, long i) {
    const float* s0 = p.TS() + (size_t)i * 2 * TOPK; const float* s1 = s0 + TOPK; const int* i0 = p.TI() + (size_t)i * 2 * TOPK; const int* i1 = i0 + TOPK;
    float pv = INFINITY; int pi = -1; float mx = 0.f, sum = 0.f;
    for (int r = 0; r < TOPK; ++r) { float best = -INFINITY; int bi = -1;
        for (int c = 0; c < TOPK * TOPK; ++c) { const float v = s0[c / TOPK] + s1[c % TOPK]; const bool ok = (v < pv) || (v == pv && c > pi); if (ok && v > best) { best = v; bi = c; } }
        if (r == 0) mx = best;
        const float e = expf(best - mx); sum += e;
        p.EIDX()[(size_t)i * TOPK + r] = i0[bi / TOPK] * NK + i1[bi % TOPK]; p.EW()[(size_t)i * TOPK + r] = e; pv = best; pi = bi; }
    for (int r = 0; r < TOPK; ++r) p.EW()[(size_t)i * TOPK + r] /= sum;
}
HD void b_up(const Prm& p, long i) { const long tok = i / NSLOT; const int e = p.EIDX()[i];
    p.EW()[i] *= gelu_exact(b_dot16(p.U() + (size_t)tok * D, p.PU16() + (size_t)e * D, D)); }
HD void b_down(const Prm& p, long i) { const long tok = i / D; const int d = (int)(i % D); const int b = (int)(tok / S); float y = 0.f;
    for (int sl = 0; sl < NSLOT; ++sl) y += p.EW()[tok * NSLOT + sl] * bf2f(p.PV16()[(size_t)p.EIDX()[tok * NSLOT + sl] * D + d]);
    p.out[i] = ALPHA * p.out[i] + p.MOD()[(size_t)b * D6 + 5 * D + d] * y; }
HD void b_ln2(const Prm& p, long row) {
    float* zr = p.out + (size_t)row * D;
    float s = 0.f; for (int d = 0; d < D; ++d) s += zr[d];
    const float mean = s / D; float q = 0.f; for (int d = 0; d < D; ++d) { const float t = zr[d] - mean; q += t * t; }
    const float rstd = 1.f / sqrtf(q / D + LN_EPS);
    for (int d = 0; d < D; ++d) zr[d] = (zr[d] - mean) * rstd * p.ln2_w[d] + p.ln2_b[d];
}
#include <cstdio>
#define LAS __attribute__((address_space(3)))
#define GAS __attribute__((address_space(1)))
namespace pg8 {
#define PG8_LAS __attribute__((address_space(3)))
typedef unsigned short bf16_t;
typedef short bf16x8 __attribute__((ext_vector_type(8)));
typedef float f32x4 __attribute__((ext_vector_type(4)));
typedef unsigned u32x4 __attribute__((ext_vector_type(4)));
constexpr int BM = 256, BK = 64, HALF = 128, HTB = HALF * BK * 2  , STAGE_BYTES = 8 * HTB, NXCD = 8, WGM = 8;

__host__ __device__ __forceinline__ int lds_byte(int r, int c) { const int st = (r >> 4) * 2 + (c >> 5), rr = r & 15, cc = c & 31, ob = rr * 64 + cc * 2; return st * 1024 + (ob ^ (((ob >> 9) & 1) << 5)); }
__host__ __device__ __forceinline__ void stage_rc(int b, int& R, int& C) { const int st = b / 1024, sb = b % 1024, swz = sb ^ (((sb >> 9) & 1) << 5); R = (st >> 1) * 16 + swz / 64; C = (st & 1) * 32 + (swz % 64) / 2; }
__host__ __device__ __forceinline__ int perm32(int rho) { const int n = rho >> 4, i = rho & 15; return 8 * (i >> 2) + 4 * n + (i & 3); }

struct Unit { int pm, pn; };
struct Gemm { const bf16_t* A; const bf16_t* Bt; int M, N, K; };

struct StaticOrder {
    int nM, nN, nwg, G, c;
    __host__ __device__ void init(int M, int N, int G_, int c_) { nM = M / BM; nN = N / BM; nwg = nM * nN; G = G_; c = c_; }
    __host__ __device__ bool next(int i, Unit& u) const {
        const long L = (long)i * G + c; if (L >= nwg) return false;
        int wgid = (int)L; { const int q = nwg / NXCD, r = nwg % NXCD, xcd = wgid % NXCD, off = wgid / NXCD; wgid = (xcd < r ? xcd * (q + 1) : r * (q + 1) + (xcd - r) * q) + off; }
        const int nig = WGM * nN, gid = wgid / nig, fm = gid * WGM, gsz = (nM - fm) < WGM ? (nM - fm) : WGM;
        u.pm = fm + ((wgid % nig) % gsz); u.pn = (wgid % nig) / gsz; return true;
    }
    __device__ __forceinline__ void a_ready(const Unit&) const {}
    __device__ __forceinline__ void done(const Unit&) const {}
};

__device__ __forceinline__ unsigned cvt_pk_bf16(float lo, float hi) { unsigned r; asm volatile("v_cvt_pk_bf16_f32 %0, %1, %2" : "=v"(r) : "v"(lo), "v"(hi)); return r; }
typedef float f32x2 __attribute__((ext_vector_type(2)));
__device__ __forceinline__ f32x2 gelu_pk(f32x2 v) {
    const f32x2 av = __builtin_elementwise_abs(v), d = av * 0.2316418882f + 1.0f;
    f32x2 t; t.x = __builtin_amdgcn_rcpf(d.x); t.y = __builtin_amdgcn_rcpf(d.y);
    f32x2 q = t * 0.5307027145f + (-0.7265760135f); q = q * t + 0.7107068705f; q = q * t + (-0.142248368f); q = q * t + 0.127414796f; q = q * t;
    const f32x2 s = (v * v) * (-0.72134752044f);
    f32x2 e; e.x = __builtin_amdgcn_exp2f(s.x); e.y = __builtin_amdgcn_exp2f(s.y);
    const f32x2 m = v * (q * e), r = v - m;
    f32x2 o; o.x = v.x < 0.f ? m.x : r.x; o.y = v.y < 0.f ? m.y : r.y; return o;
}

template <int ACT  > struct EpiBf16 {
    static constexpr bool PERM = true, AFTER_DRAIN = false; static_assert(ACT == 0 || ACT == 1, "EpiBf16: ACT is 0 (none) or 1 (gelu_pk)");
    bf16_t* O; int ldc; const float* bias; int split_cols; size_t split_stride; float scale0;
    __device__ __forceinline__ void operator()(const f32x4 (&acc)[2][2][4][2], const Unit& u, int wr, int wc, int fr, int fq) const {
        const int row0 = u.pm * BM + wr * 64 + fr; int colt = u.pn * BM; bf16_t* base = O;
        float sc = 1.f; if (split_cols) { const int t = colt / split_cols; base += (size_t)t * split_stride; colt -= t * split_cols; if (t == 0) sc = scale0; }
        const int col0 = colt + wc * 32 + 8 * fq, bcol0 = u.pn * BM + wc * 32 + 8 * fq;
        f32x4 bv[2][2];
#pragma unroll
        for (int bj = 0; bj < 2; ++bj)
#pragma unroll
            for (int n = 0; n < 2; ++n) bv[bj][n] = bias ? *(const f32x4*)(bias + bcol0 + bj * HALF + 4 * n) : (f32x4){0.f, 0.f, 0.f, 0.f};
#pragma unroll
        for (int ai = 0; ai < 2; ++ai)
#pragma unroll
            for (int m = 0; m < 4; ++m) { bf16_t* rowp = base + (size_t)(row0 + ai * HALF + m * 16) * ldc + col0;
#pragma unroll
                for (int bj = 0; bj < 2; ++bj) { f32x4 v0 = acc[ai][bj][m][0] + bv[bj][0], v1 = acc[ai][bj][m][1] + bv[bj][1];
                    if (ACT == 1) { f32x2 a = gelu_pk((f32x2){v0[0], v0[1]}), b = gelu_pk((f32x2){v0[2], v0[3]}), c = gelu_pk((f32x2){v1[0], v1[1]}), d = gelu_pk((f32x2){v1[2], v1[3]});
                        v0 = (f32x4){a.x, a.y, b.x, b.y}; v1 = (f32x4){c.x, c.y, d.x, d.y}; }
                    v0 = v0 * sc; v1 = v1 * sc; u32x4 w; w.x = cvt_pk_bf16(v0[0], v0[1]); w.y = cvt_pk_bf16(v0[2], v0[3]); w.z = cvt_pk_bf16(v1[0], v1[1]); w.w = cvt_pk_bf16(v1[2], v1[3]);
                    *(u32x4*)(rowp + bj * HALF) = w; } }
    }
};
template <class Epi, class Sched, bool ALIGN_EPI = false, bool SP2 = false>
__device__ __forceinline__ void gemm_phase(PG8_LAS unsigned char* lds, const Gemm g, const Sched& S, const Epi& E) {
    const int tid = threadIdx.x, wid = __builtin_amdgcn_readfirstlane(tid >> 6), lane = tid & 63, wr = wid >> 2, wc = wid & 3, fr = lane & 15, fq = lane >> 4;
    const int K = g.K, nt = K / BK;
    unsigned voffA[2], voffB[2];
#pragma unroll
    for (int i = 0; i < 2; ++i) { int R, C; stage_rc(tid * 16 + i * 8192, R, C); const int Rb = Epi::PERM ? ((R & ~31) + perm32(R & 31)) : R;
        voffA[i] = (unsigned)(R * K + C) * 2u; voffB[i] = (unsigned)(Rb * K + C) * 2u; }
    const size_t kstep = (size_t)(BK * 2);
    const size_t hstep = (size_t)HALF * K * 2;
    const size_t tstep = 2 * hstep;
    const unsigned ldsw = (unsigned)wid * 1024u;
    const int aoff = lds_byte(wr * 64 + fr, fq * 8), boff = lds_byte(wc * 32 + fr, fq * 8);
#define PG8_SA(b, h) (((b) * 2 + (h)) * HTB)
#define PG8_SB(b, h) ((4 + (b) * 2 + (h)) * HTB)
#define PG8_STAGE(bufoff, gbase, voff) do { _Pragma("unroll") for (int _i = 0; _i < 2; ++_i) \
        __builtin_amdgcn_global_load_lds((const unsigned*)((const char*)(gbase) + (voff)[_i]), (PG8_LAS unsigned*)(lds + (bufoff) + ldsw + _i * 8192), 16, 0, 0); } while (0)
#define PG8_LDA(dst, b, h) do { _Pragma("unroll") for (int m = 0; m < 4; ++m) _Pragma("unroll") for (int k = 0; k < 2; ++k) dst[m][k] = *(const PG8_LAS bf16x8*)(lds + PG8_SA(b, h) + aoff + m * 2048 + k * 1024); } while (0)
#define PG8_LDB(dst, b, h) do { _Pragma("unroll") for (int n = 0; n < 2; ++n) _Pragma("unroll") for (int k = 0; k < 2; ++k) dst[n][k] = *(const PG8_LAS bf16x8*)(lds + PG8_SB(b, h) + boff + n * 2048 + k * 1024); } while (0)
#define PG8_MMA(ai, bj, At, Bt) do { __builtin_amdgcn_s_setprio(1); _Pragma("unroll") for (int m = 0; m < 4; ++m) _Pragma("unroll") for (int n = 0; n < 2; ++n) _Pragma("unroll") for (int k = 0; k < 2; ++k) \
        acc[ai][bj][m][n] = __builtin_amdgcn_mfma_f32_16x16x32_bf16(Bt[n][k], At[m][k], acc[ai][bj][m][n], 0, 0, 0); __builtin_amdgcn_s_setprio(0); } while (0)
#define PG8_WAIT_V(n) asm volatile("s_waitcnt vmcnt(" #n ")" ::: "memory")
#define PG8_WAIT_L(n) asm volatile("s_waitcnt lgkmcnt(" #n ")" ::: "memory")
#define PG8_BAR __builtin_amdgcn_s_barrier()
#define PG8_SCHED __builtin_amdgcn_sched_barrier(0)
    Unit cur, nxt; int ui = 0;
    if (!S.next(0, cur)) return;
    f32x4 acc[2][2][4][2];
#pragma unroll
    for (int a = 0; a < 2; ++a)
#pragma unroll
        for (int b = 0; b < 2; ++b)
#pragma unroll
            for (int m = 0; m < 4; ++m)
#pragma unroll
                for (int n = 0; n < 2; ++n) acc[a][b][m][n] = (f32x4){0.f, 0.f, 0.f, 0.f};
    bf16x8 At[4][2], B0[2][2], B1[2][2];
    const char* cA = (const char*)g.A + (size_t)cur.pm * tstep; const char* cB = (const char*)g.Bt + (size_t)cur.pn * tstep;
    S.a_ready(cur);
    if constexpr (SP2) {
        PG8_STAGE(PG8_SB(0, 0), cB, voffB); PG8_STAGE(PG8_SB(0, 1), cB + hstep, voffB); PG8_STAGE(PG8_SA(0, 0), cA, voffA); PG8_STAGE(PG8_SA(0, 1), cA + hstep, voffA);
        if (wr == 1) PG8_BAR;
        PG8_WAIT_V(2); PG8_BAR;
        PG8_STAGE(PG8_SB(1, 0), cB + kstep, voffB); PG8_STAGE(PG8_SA(1, 0), cA + kstep, voffA); PG8_STAGE(PG8_SB(1, 1), cB + hstep + kstep, voffB);
        PG8_WAIT_V(6); PG8_BAR;
    } else {
        PG8_STAGE(PG8_SB(0, 0), cB, voffB); PG8_STAGE(PG8_SA(0, 0), cA, voffA); PG8_STAGE(PG8_SB(0, 1), cB + hstep, voffB); PG8_STAGE(PG8_SA(0, 1), cA + hstep, voffA);
        if (wr == 1) PG8_BAR;
        PG8_WAIT_V(4); PG8_BAR;
        PG8_STAGE(PG8_SB(1, 0), cB + kstep, voffB); PG8_STAGE(PG8_SA(1, 0), cA + kstep, voffA); PG8_STAGE(PG8_SB(1, 1), cB + hstep + kstep, voffB);
        PG8_WAIT_V(6); PG8_BAR;
    }
    for (;;) {
        const bool has_next = S.next(ui + 1, nxt);
        const char* nA = has_next ? (const char*)g.A + (size_t)nxt.pm * tstep : cA; const char* nB = has_next ? (const char*)g.Bt + (size_t)nxt.pn * tstep : cB;
        for (int t = 0; t < nt; t += 2) {
            const bool last = (t == nt - 2);
            const char* a1 = cA + (size_t)(t + 1) * kstep;
            const char* a2 = last ? nA : cA + (size_t)(t + 2) * kstep; const char* b2 = last ? nB : cB + (size_t)(t + 2) * kstep;
            const char* a3 = a2 + kstep; const char* b3 = b2 + kstep;
            if (last && has_next) S.a_ready(nxt);
            if constexpr (SP2) {
            PG8_LDB(B0, 0, 0); PG8_LDB(B1, 0, 1); PG8_SCHED; PG8_LDA(At, 0, 0); PG8_STAGE(PG8_SA(1, 1), a1 + hstep, voffA);
            PG8_WAIT_V(8); PG8_WAIT_L(0); PG8_BAR; PG8_MMA(0, 0, At, B0); PG8_MMA(0, 1, At, B1); PG8_BAR; PG8_SCHED;
            PG8_LDA(At, 0, 1); PG8_STAGE(PG8_SB(0, 0), b2, voffB); PG8_STAGE(PG8_SB(0, 1), b2 + hstep, voffB); PG8_STAGE(PG8_SA(0, 0), a2, voffA);
            PG8_WAIT_V(8); PG8_WAIT_L(0); PG8_BAR; PG8_MMA(1, 0, At, B0); PG8_MMA(1, 1, At, B1); PG8_BAR; PG8_SCHED;
            PG8_LDB(B0, 1, 0); PG8_LDB(B1, 1, 1); PG8_SCHED; PG8_LDA(At, 1, 0); PG8_STAGE(PG8_SA(0, 1), a2 + hstep, voffA);
            PG8_WAIT_V(8); PG8_WAIT_L(0); PG8_BAR; PG8_MMA(0, 0, At, B0); PG8_MMA(0, 1, At, B1); PG8_BAR; PG8_SCHED;
            PG8_LDA(At, 1, 1); PG8_STAGE(PG8_SB(1, 0), b3, voffB); PG8_STAGE(PG8_SB(1, 1), b3 + hstep, voffB); PG8_STAGE(PG8_SA(1, 0), a3, voffA);
            PG8_WAIT_V(8); PG8_WAIT_L(0); PG8_BAR; PG8_MMA(1, 0, At, B0); PG8_MMA(1, 1, At, B1); PG8_BAR; PG8_SCHED;
            } else {
            PG8_LDB(B0, 0, 0); PG8_SCHED; PG8_LDA(At, 0, 0); PG8_STAGE(PG8_SA(1, 1), a1 + hstep, voffA);
            PG8_WAIT_L(8); PG8_BAR; PG8_WAIT_L(0); PG8_MMA(0, 0, At, B0); PG8_BAR; PG8_SCHED;
            PG8_LDB(B1, 0, 1); PG8_STAGE(PG8_SB(0, 0), b2, voffB);
            PG8_BAR; PG8_WAIT_L(0); PG8_MMA(0, 1, At, B1); PG8_BAR;
            PG8_LDA(At, 0, 1); PG8_STAGE(PG8_SA(0, 0), a2, voffA);
            PG8_BAR; PG8_WAIT_L(0); PG8_MMA(1, 0, At, B0); PG8_BAR; PG8_SCHED;
            PG8_STAGE(PG8_SB(0, 1), b2 + hstep, voffB);
            PG8_WAIT_V(6); PG8_BAR; PG8_MMA(1, 1, At, B1); PG8_BAR;
            PG8_LDB(B0, 1, 0); PG8_SCHED; PG8_LDA(At, 1, 0); PG8_STAGE(PG8_SA(0, 1), a2 + hstep, voffA);
            PG8_WAIT_L(8); PG8_BAR; PG8_WAIT_L(0); PG8_MMA(0, 0, At, B0); PG8_BAR; PG8_SCHED;
            PG8_LDB(B1, 1, 1); PG8_STAGE(PG8_SB(1, 0), b3, voffB);
            PG8_BAR; PG8_WAIT_L(0); PG8_MMA(0, 1, At, B1); PG8_BAR;
            PG8_LDA(At, 1, 1); PG8_STAGE(PG8_SA(1, 0), a3, voffA);
            PG8_BAR; PG8_WAIT_L(0); PG8_MMA(1, 0, At, B0); PG8_BAR; PG8_SCHED;
            PG8_STAGE(PG8_SB(1, 1), b3 + hstep, voffB);
            PG8_WAIT_V(6); PG8_BAR; PG8_MMA(1, 1, At, B1); PG8_BAR;
            }
        }
        if constexpr (ALIGN_EPI) { if (wr == 0) PG8_BAR; }
        if constexpr (!Epi::AFTER_DRAIN) { E(acc, cur, wr, wc, fr, fq); S.done(cur); }
        if (!has_next) break;
#pragma unroll
        for (int a = 0; a < 2; ++a)
#pragma unroll
            for (int b = 0; b < 2; ++b)
#pragma unroll
                for (int m = 0; m < 4; ++m)
#pragma unroll
                    for (int n = 0; n < 2; ++n) acc[a][b][m][n] = (f32x4){0.f, 0.f, 0.f, 0.f};
        cur = nxt; cA = nA; cB = nB; ++ui;
        if constexpr (ALIGN_EPI) { if (wr == 1) PG8_BAR; }
    }
    PG8_WAIT_V(0);
    if constexpr (!ALIGN_EPI) { if (wr == 0) PG8_BAR; }
    PG8_BAR;
    if constexpr (Epi::AFTER_DRAIN) { E.fused(acc, cur, wr, wc, fr, fq, lds, wid, lane); S.done(cur); }
#undef PG8_SA
#undef PG8_SB
#undef PG8_STAGE
#undef PG8_LDA
#undef PG8_LDB
#undef PG8_MMA
#undef PG8_WAIT_V
#undef PG8_WAIT_L
#undef PG8_BAR
#undef PG8_SCHED
}
}
#define XB_TMO      128
#define XB_XCNT(j)  (256  + 64 * (j))
#define XB_XSUB(j)  (1280 + 64 * (j))
#define XB_XGEN(j)  (2304 + 64 * (j))
#define XB_TOP      3328
#define XB_TOPGEN   3392
#define XCD_BAR_WORDS 3456
#define XB_SPIN_CAP (1u << 18)

__device__ __forceinline__ unsigned xb_ld(unsigned* p)              { return __hip_atomic_load(p, __ATOMIC_RELAXED, __HIP_MEMORY_SCOPE_AGENT); }
__device__ __forceinline__ unsigned xb_add(unsigned* p, unsigned v) { return __hip_atomic_fetch_add(p, v, __ATOMIC_RELAXED, __HIP_MEMORY_SCOPE_AGENT); }
__device__ __forceinline__ unsigned xb_xcc_id() { return (unsigned)__builtin_amdgcn_s_getreg((3 << 11) | 20) & 0xFu; }
#define XB_SPIN(cond, bar) do { unsigned _sp = 0; while (cond) { __builtin_amdgcn_s_sleep(1); \
    if ((++_sp & 255u) == 0u) { if (xb_ld(&(bar)[XB_TMO])) break; if (_sp > XB_SPIN_CAP) { atomicAdd(&(bar)[XB_TMO], 1u); break; } } } } while (0)

struct XcdBarrier {
    unsigned* bar; unsigned x;
    volatile LAS unsigned* st;
};

__device__ __forceinline__ XcdBarrier xcd_barrier_post(unsigned* bar, volatile LAS unsigned* st) {
    XcdBarrier b; b.bar = bar; b.x = xb_xcc_id(); b.st = st;
    if (threadIdx.x == 0) st[2] = xb_add(&bar[XB_XCNT(b.x)], 1u) + 1u;
    return b;
}
__device__ __forceinline__ void xcd_barrier_complete(unsigned* bar, unsigned x, unsigned& nloc, unsigned& nx) {
    const unsigned G = gridDim.x * gridDim.y * gridDim.z;
    unsigned sum, cnt, mine, sp = 0u;
    for (;;) {
        sum = 0u; cnt = 0u; mine = 0u;
#pragma unroll
        for (unsigned j = 0; j < 16; ++j) { const unsigned c = xb_ld(&bar[XB_XCNT(j)]); sum += c; cnt += (c > 0u) ? 1u : 0u; mine = (j == x) ? c : mine; }
        if (sum == G) break;
        __builtin_amdgcn_s_sleep(1);
        if ((++sp & 255u) == 0u) { if (xb_ld(&bar[XB_TMO])) break; if (sp > XB_SPIN_CAP) { atomicAdd(&bar[XB_TMO], 1u); break; } }
    }
    nloc = mine > 0u ? mine : 1u; nx = cnt > 0u ? cnt : 1u;
}

__device__ __forceinline__ void xcd_barrier(const XcdBarrier& b) {
    asm volatile("s_waitcnt vmcnt(0)" ::: "memory");
    __syncthreads();
    if (threadIdx.x == 0) {
        unsigned* bar = b.bar;
        __builtin_amdgcn_s_waitcnt(0);
        unsigned nloc = b.st[0], nx = b.st[1];
        if (nloc == 0u) { xcd_barrier_complete(bar, b.x, nloc, nx); b.st[0] = nloc; b.st[1] = nx; }
        const unsigned old = xb_add(&bar[XB_XSUB(b.x)], 1u);
        const unsigned gen = old / nloc;
        if (old + 1u == (gen + 1u) * nloc) {
            __builtin_amdgcn_fence(__ATOMIC_RELEASE, "agent");
            asm volatile("s_waitcnt vmcnt(0)" ::: "memory");
            const unsigned og = xb_add(&bar[XB_TOP], 1u);
            const unsigned tg = og / nx;
            if (og + 1u == (tg + 1u) * nx) xb_add(&bar[XB_TOPGEN], 1u);
            else XB_SPIN(xb_ld(&bar[XB_TOPGEN]) == tg, bar);
            __builtin_amdgcn_fence(__ATOMIC_ACQUIRE, "agent");
            xb_add(&bar[XB_XGEN(b.x)], 1u);
            asm volatile("s_waitcnt vmcnt(0)" ::: "memory");
        } else {
            XB_SPIN(xb_ld(&bar[XB_XGEN(b.x)]) == gen, bar);
            __builtin_amdgcn_fence(__ATOMIC_ACQUIRE, "agent");
            asm volatile("s_waitcnt vmcnt(0)" ::: "memory");
        }
    }
    __syncthreads();
}
constexpr int NWAVES = 8, NTHR = 512;
constexpr int RING_BYTES = 131072, LDSCTL_OFF = RING_BYTES, MISC_OFF = LDSCTL_OFF + 320, LDS_BYTES = 163840;
constexpr int CW_BAR = 4096;
#ifndef MK_N_LAUNCHES
#define MK_N_LAUNCHES 1
#endif
constexpr int NPHASE = 13;

typedef float f4v __attribute__((ext_vector_type(4)));
typedef unsigned u2v __attribute__((ext_vector_type(2)));
typedef unsigned u32x4_t __attribute__((ext_vector_type(4)));
struct Frame { LAS unsigned char* lds; int tid, lane, wave, G, bid; };
template <int CTRL, int ROWMASK> __device__ __forceinline__ float dppf(float old, float src) {
    return __builtin_bit_cast(float, __builtin_amdgcn_update_dpp(__builtin_bit_cast(int, old), __builtin_bit_cast(int, src), CTRL, ROWMASK, 0xf, false)); }
__device__ __forceinline__ float wave_scan_add(float v) {
    v += dppf<0x111, 0xf>(0.f, v); v += dppf<0x112, 0xf>(0.f, v); v += dppf<0x114, 0xf>(0.f, v); v += dppf<0x118, 0xf>(0.f, v);
    v += dppf<0x142, 0xa>(0.f, v); v += dppf<0x143, 0xc>(0.f, v); return v; }
__device__ __forceinline__ float wave_scan_max(float v) {
    const float NI = -INFINITY;
    v = fmaxf(v, dppf<0x111, 0xf>(NI, v)); v = fmaxf(v, dppf<0x112, 0xf>(NI, v)); v = fmaxf(v, dppf<0x114, 0xf>(NI, v)); v = fmaxf(v, dppf<0x118, 0xf>(NI, v));
    v = fmaxf(v, dppf<0x142, 0xa>(NI, v)); v = fmaxf(v, dppf<0x143, 0xc>(NI, v)); return v; }
__device__ __forceinline__ float lane_bcast(float v, int l) { return __builtin_bit_cast(float, __builtin_amdgcn_readlane(__builtin_bit_cast(int, v), l)); }
__device__ __forceinline__ float wave_sum(float v) { return lane_bcast(wave_scan_add(v), 63); }
__device__ __forceinline__ unsigned pk2(float lo, float hi) { return (unsigned)f2bf(lo) | ((unsigned)f2bf(hi) << 16); }
__device__ __forceinline__ float bflo(unsigned w) { return u_as_f(w << 16); }
__device__ __forceinline__ float bfhi(unsigned w) { return u_as_f(w & 0xffff0000u); }

__device__ __forceinline__ void p0_ada_item(const Prm& p, const Frame& F, int item) {
    static_assert(D6 % 2048 == 0 && D % NKS == 0 && D / NKS == 64, "ada item shape");
    LAS float* sl = (LAS float*)F.lds;
    const int ks = item / (D6 / 2048), cg = item % (D6 / 2048), k0 = ks * 64, n0 = cg * 2048 + 4 * F.tid;
    { const int b = F.tid / 64, k = F.tid % 64; const float cv = p.c[b * D + k0 + k]; sl[F.tid] = cv / (1.f + __expf(-cv)); }
    __syncthreads();
    f4v acc[NB];
#pragma unroll
    for (int b = 0; b < NB; ++b) acc[b] = (f4v){0.f, 0.f, 0.f, 0.f};
    const float* wp = p.w_ada + (size_t)k0 * D6 + n0;
#pragma unroll 8
    for (int k = 0; k < 64; ++k) { const f4v w = *(const f4v*)(wp + (size_t)k * D6);
#pragma unroll
        for (int b = 0; b < NB; ++b) acc[b] += w * sl[b * 64 + k]; }
#pragma unroll
    for (int b = 0; b < NB; ++b) *(f4v*)(p.MODP() + ((size_t)ks * NB + b) * D6 + n0) = acc[b];
    __syncthreads();
}
__device__ __forceinline__ void p0_transpose_item(const float* W, int ldw, int K, int N, bf16_t* WT, LAS float* scr, int item, int lane) {
    const int nblk = N / 32, kb = item / nblk, nb = item % nblk, k0 = 64 * kb, n0 = 32 * nb;
#pragma unroll
    for (int i = 0; i < 32; ++i) { const int kk = 2 * i + (lane >> 5); scr[kk * 33 + (lane & 31)] = W[(size_t)(k0 + kk) * ldw + n0 + (lane & 31)]; }
    asm volatile("s_waitcnt lgkmcnt(0)" ::: "memory");
    const int c = lane & 7;
#pragma unroll
    for (int j = 0; j < 4; ++j) { const int n = (lane >> 3) + 8 * j; const LAS float* s = scr + (8 * c) * 33 + n;
        uint4 o; o.x = pk2(s[0 * 33], s[1 * 33]); o.y = pk2(s[2 * 33], s[3 * 33]); o.z = pk2(s[4 * 33], s[5 * 33]); o.w = pk2(s[6 * 33], s[7 * 33]);
        *(uint4*)(WT + (size_t)(n0 + n) * K + k0 + 8 * c) = o; }
    asm volatile("s_waitcnt lgkmcnt(0)" ::: "memory");
}

__device__ __forceinline__ void p0_fold_item(const Prm& p, int item, int lane) {
    static_assert(NK == 128 && KH == 128 && NQ == 2048, "fold item decomposition");
    const int ks = item & 31, nt = (item >> 5) & 7, g = item >> 8;
    const int r = lane & 15, q = lane >> 4;
    const float* arow = p.subkeys + ((size_t)g * NK + nt * 16 + r) * KH + 4 * q;
    const float* brow = p.wq + (size_t)(ks * 64 + r) * NQ + g * KH + 4 * q;
    pg8::f32x4 acc[4];
#pragma unroll
    for (int c = 0; c < 4; ++c) acc[c] = (pg8::f32x4){0.f, 0.f, 0.f, 0.f};
#pragma unroll 2
    for (int s16 = 0; s16 < KH; s16 += 16) {
        const pg8::f32x4 a = *(const pg8::f32x4*)(arow + s16); pg8::f32x4 bv[4];
#pragma unroll
        for (int c = 0; c < 4; ++c) bv[c] = *(const pg8::f32x4*)(brow + (size_t)(c * 16) * NQ + s16);
#pragma unroll
        for (int i = 0; i < 4; ++i)
#pragma unroll
            for (int c = 0; c < 4; ++c) acc[c] = __builtin_amdgcn_mfma_f32_16x16x4f32(a[i], bv[c][i], acc[c], 0, 0, 0);
    }
#pragma unroll
    for (int c = 0; c < 4; ++c)
#pragma unroll
        for (int i = 0; i < 4; ++i) p.WQ_T()[(size_t)(g * NK + nt * 16 + 4 * q + i) * D + ks * 64 + c * 16 + r] = f2bf(acc[c][i]);
}
__device__ __forceinline__ void phase0(const Prm& p, const Frame& F) {
#ifndef P0_REP_ADA
#define P0_REP_ADA 1
#define P0_REP_TR 1
#define P0_REP_FOLD 1
#define P0_REP_FP8 1
#endif
    for (int rep_ = 0; rep_ < P0_REP_ADA; ++rep_)
    for (int it = F.bid; it < NKS * (D6 / 2048); it += F.G) p0_ada_item(p, F, it);
    LAS float* scr = (LAS float*)(F.lds + F.wave * 16384);
    const int gw = F.bid * NWAVES + F.wave, NGW = F.G * NWAVES;
    constexpr int I_IN = (D / 64) * (INM / 32), I_O = (D / 64) * (D / 32), I_Q = 32 * 8 * 16;
    for (int rep_ = 0; rep_ < (P0_REP_TR > P0_REP_FOLD ? P0_REP_TR : P0_REP_FOLD); ++rep_)
    for (int it = gw; it < I_IN + I_O + I_Q; it += NGW) {
        int r = it; if (rep_ >= P0_REP_TR && r < I_IN + I_O) continue; if (rep_ >= P0_REP_FOLD && r >= I_IN + I_O) continue;
        if (r < I_IN) { p0_transpose_item(p.w_in, INC, D, INM, p.WIN_T(), scr, r, F.lane); continue; } r -= I_IN;
        if (r < I_O) { p0_transpose_item(p.w_out, D, D, D, p.WOUT_T(), scr, r, F.lane); continue; } r -= I_O;
        p0_fold_item(p, r, F.lane);
    }
    for (int rep_ = 0; rep_ < P0_REP_FP8; ++rep_)
    {
        float4 v[8], vn[8]; int rr = gw;
#define P0_ROWSRC(rr_) ((const float4*)(p.peer_u + (size_t)(rr_) * D) + F.lane)
        if (rr < NE) { const float4* src = P0_ROWSRC(rr);
#pragma unroll
            for (int j = 0; j < 8; ++j) v[j] = src[64 * j]; }
        for (; rr < NE; rr += NGW) {
            const int rn = rr + NGW;
            if (rn < NE) { const float4* src = P0_ROWSRC(rn);
#pragma unroll
                for (int j = 0; j < 8; ++j) vn[j] = src[64 * j]; }
            const int e = rr; float am = 0.f;
#pragma unroll
            for (int j = 0; j < 8; ++j) am = fmaxf(am, fmaxf(fmaxf(fabsf(v[j].x), fabsf(v[j].y)), fmaxf(fabsf(v[j].z), fabsf(v[j].w))));
#pragma unroll
            for (int o = 1; o < 64; o <<= 1) am = fmaxf(am, __shfl_xor(am, o));
            const float sc = am > 0.f ? 384.f / am : 1.f;
            unsigned* dst = (unsigned*)(p.PU8() + (size_t)e * D) + F.lane;
#pragma unroll
            for (int j = 0; j < 8; ++j) { unsigned w = 0u; w = __builtin_amdgcn_cvt_pk_fp8_f32(v[j].x * sc, v[j].y * sc, w, false); w = __builtin_amdgcn_cvt_pk_fp8_f32(v[j].z * sc, v[j].w * sc, w, true); dst[64 * j] = w; }
            if (F.lane == 0) p.RSU()[e] = am > 0.f ? am / 384.f : 1.f;
#pragma unroll
            for (int j = 0; j < 8; ++j) v[j] = vn[j];
        }
#undef P0_ROWSRC
    }
    { LAS unsigned char* tl = F.lds; constexpr int RS_ = 2056;
      for (int tile = F.bid; tile < NE / 16; tile += F.G) { const int row = F.tid >> 5, l32 = F.tid & 31, e = tile * 16 + row;
        __syncthreads();
        const f4v* src = (const f4v*)(p.peer_v + (size_t)e * D) + l32; f4v x[16]; float am = 0.f;
#pragma unroll
        for (int j = 0; j < 16; ++j) { x[j] = src[32 * j]; am = fmaxf(am, fmaxf(fmaxf(fabsf(x[j][0]), fabsf(x[j][1])), fmaxf(fabsf(x[j][2]), fabsf(x[j][3])))); }
#pragma unroll
        for (int o = 1; o < 32; o <<= 1) am = fmaxf(am, __shfl_xor(am, o));
        const float sc = am > 0.f ? 384.f / am : 1.f;
#pragma unroll
        for (int j = 0; j < 16; ++j) { unsigned w = 0u; w = __builtin_amdgcn_cvt_pk_fp8_f32(x[j][0] * sc, x[j][1] * sc, w, false); w = __builtin_amdgcn_cvt_pk_fp8_f32(x[j][2] * sc, x[j][3] * sc, w, true);
            *(LAS unsigned*)(tl + row * RS_ + 4 * (l32 + 32 * j)) = w; }
        if (l32 == 0) p.RSV()[e] = am > 0.f ? am / 384.f : 1.f;
        __syncthreads();
#pragma unroll
        for (int k = 0; k < 8; ++k) { const int idx = F.tid + NTHR * k, r = idx & 15, sl = idx >> 4;
            *(u2v*)(p.PV8S() + ((size_t)sl * NE + tile * 16 + r) * 8) = *(const LAS u2v*)(tl + r * RS_ + 8 * sl); }
      } }
}
__device__ __forceinline__ void phase1(const Prm& p, const Frame& F) {
    LAS float* SH = (LAS float*)F.lds; LAS float* SC1 = SH + D;
    LAS bf16_t* WG = (LAS bf16_t*)(F.lds + 2 * D * 4);
    const int rows_per = T / F.G;
    for (int idx = F.bid * NTHR + F.tid; idx < NB * D6; idx += F.G * NTHR) {
        const int n = idx % D6, b = idx / D6; float s = 0.f;
        for (int ks = 0; ks < NKS; ++ks) s += p.MODP()[((size_t)ks * NB + b) * D6 + n];
        p.MOD()[idx] = s + p.b_ada[n]; }
    for (int idx = F.tid; idx < NG * D; idx += NTHR) { const int d = idx / NG, g = idx % NG; WG[g * D + d] = f2bf(p.w_in[(size_t)d * INC + INM + g]); }
    int cur_b = -1;
    float4 xpre[8];
    { const float4* x0 = (const float4*)(p.x + (size_t)(F.bid * rows_per + F.wave) * D) + F.lane;
#pragma unroll
      for (int j = 0; j < 8; ++j) xpre[j] = x0[64 * j]; }
    for (int r0 = F.bid * rows_per; r0 < (F.bid + 1) * rows_per; r0 += NWAVES) {
        const int b = r0 / S;
        if (b != cur_b) { __syncthreads();
            for (int n = F.tid; n < 2 * D; n += NTHR) { float s = 0.f; for (int ks = 0; ks < NKS; ++ks) s += p.MODP()[((size_t)ks * NB + b) * D6 + n];
                s += p.b_ada[n]; SH[n] = n < D ? s : 1.f + s; }
            cur_b = b; __syncthreads(); }
        const int row = r0 + F.wave;
        float4 v[8]; float s = 0.f;
#pragma unroll
        for (int j = 0; j < 8; ++j) v[j] = xpre[j];
        if (r0 + NWAVES < (F.bid + 1) * rows_per) { const float4* xn = (const float4*)(p.x + (size_t)(row + NWAVES) * D) + F.lane;
#pragma unroll
            for (int j = 0; j < 8; ++j) xpre[j] = xn[64 * j]; }
#pragma unroll
        for (int j = 0; j < 8; ++j) s += (v[j].x + v[j].y) + (v[j].z + v[j].w);
        const float mean = wave_sum(s) * (1.f / D); float s2 = 0.f;
#pragma unroll
        for (int j = 0; j < 8; ++j) { v[j].x -= mean; v[j].y -= mean; v[j].z -= mean; v[j].w -= mean; s2 += (v[j].x * v[j].x + v[j].y * v[j].y) + (v[j].z * v[j].z + v[j].w * v[j].w); }
        const float rstd = 1.f / sqrtf(wave_sum(s2) * (1.f / D) + LN_EPS);
        uint2* o8 = (uint2*)(p.U() + (size_t)row * D) + F.lane;
#pragma unroll
        for (int j = 0; j < 8; ++j) { const int c0 = 4 * F.lane + 256 * j; const f4v sh = *(const LAS f4v*)(SH + c0), sc = *(const LAS f4v*)(SC1 + c0);
            v[j].x = v[j].x * rstd * sc.x + sh.x; v[j].y = v[j].y * rstd * sc.y + sh.y; v[j].z = v[j].z * rstd * sc.z + sh.z; v[j].w = v[j].w * rstd * sc.w + sh.w;
            o8[64 * j] = make_uint2(pk2(v[j].x, v[j].y), pk2(v[j].z, v[j].w)); }
        float ga[NG];
#pragma unroll
        for (int g = 0; g < NG; ++g) { float a = 0.f;
#pragma unroll
            for (int j = 0; j < 8; ++j) { const u2v w = *(const LAS u2v*)(WG + g * D + 4 * F.lane + 256 * j); a += v[j].x * bflo(w.x) + v[j].y * bfhi(w.x) + v[j].z * bflo(w.y) + v[j].w * bfhi(w.y); }
            ga[g] = a; }
        float r8[8], r4[4], r2[2]; const bool l0 = F.lane & 1, l1 = F.lane & 2, l2 = F.lane & 4, l3 = F.lane & 8;
#pragma unroll
        for (int i = 0; i < 8; ++i) { const float keep = l0 ? ga[8 + i] : ga[i], send = l0 ? ga[i] : ga[8 + i]; r8[i] = keep + __shfl_xor(send, 1); }
#pragma unroll
        for (int i = 0; i < 4; ++i) { const float keep = l1 ? r8[4 + i] : r8[i], send = l1 ? r8[i] : r8[4 + i]; r4[i] = keep + __shfl_xor(send, 2); }
#pragma unroll
        for (int i = 0; i < 2; ++i) { const float keep = l2 ? r4[2 + i] : r4[i], send = l2 ? r4[i] : r4[2 + i]; r2[i] = keep + __shfl_xor(send, 4); }
        float gacc = (l3 ? r2[1] : r2[0]) + __shfl_xor(l3 ? r2[0] : r2[1], 8);
        gacc += __shfl_xor(gacc, 16); gacc += __shfl_xor(gacc, 32);
        const int gi = (l0 ? 8 : 0) + (l1 ? 4 : 0) + (l2 ? 2 : 0) + (l3 ? 1 : 0);
        if (F.lane < NG) p.GATES()[(size_t)row * NG + gi] = gacc + p.b_in[INM + gi];
    }
}
__device__ __forceinline__ void phase3a(const Prm& p, const Frame& F, int b0, int nb) {
    const size_t gt = (size_t)(F.bid - b0) * NTHR + F.tid, GT = (size_t)nb * NTHR;
    for (size_t i = gt; i < (size_t)T * (CW / 8); i += GT) {
        const size_t row = i / (CW / 8); const int ch = (int)(i % (CW / 8)) * 8, s = (int)(row % S);
        float acc[8];
#pragma unroll
        for (int e = 0; e < 8; ++e) acc[e] = p.conv_b[ch + e];
#pragma unroll
        for (int k = 0; k < 3; ++k) { const int s2 = s + k - 1; if (s2 < 0 || s2 >= S) continue; const bf16_t* pr = p.PJ() + (size_t)(row + k - 1) * INM;
            const uint4 gc = *(const uint4*)(pr + O_GC + ch), hi = *(const uint4*)(pr + O_HIN + ch); const float* cw = p.conv_w + k * CW + ch;
            acc[0] += cw[0] * (bflo(gc.x) * bflo(hi.x)); acc[1] += cw[1] * (bfhi(gc.x) * bfhi(hi.x)); acc[2] += cw[2] * (bflo(gc.y) * bflo(hi.y)); acc[3] += cw[3] * (bfhi(gc.y) * bfhi(hi.y));
            acc[4] += cw[4] * (bflo(gc.z) * bflo(hi.z)); acc[5] += cw[5] * (bfhi(gc.z) * bfhi(hi.z)); acc[6] += cw[6] * (bflo(gc.w) * bflo(hi.w)); acc[7] += cw[7] * (bfhi(gc.w) * bfhi(hi.w)); }
        const uint4 gb = *(const uint4*)(p.PJ() + row * INM + O_GB + ch); uint4 o;
        o.x = pk2(bflo(gb.x) * acc[0], bfhi(gb.x) * acc[1]); o.y = pk2(bflo(gb.y) * acc[2], bfhi(gb.y) * acc[3]); o.z = pk2(bflo(gb.z) * acc[4], bfhi(gb.z) * acc[5]); o.w = pk2(bflo(gb.w) * acc[6], bfhi(gb.w) * acc[7]);
        *(uint4*)(p.Y() + row * D + ch) = o; }
}
namespace ml {
typedef short bf16x8 __attribute__((ext_vector_type(8)));
typedef short s16x4 __attribute__((ext_vector_type(4)));
typedef float f32x4 __attribute__((ext_vector_type(4)));
typedef float f32x2_t __attribute__((ext_vector_type(2)));
typedef __bf16 bf16x2_t __attribute__((ext_vector_type(2)));
typedef unsigned u32x4 __attribute__((ext_vector_type(4)));
typedef unsigned u32x2 __attribute__((ext_vector_type(2)));
constexpr unsigned IMG = 16384u, BUF = 3u * IMG, PT_OFF = 2u * BUF, PT_BYTES = 8192u, N_OFF = PT_OFF + 2u * PT_BYTES;
constexpr unsigned SCT_OFF = 149504u, SCT_BYTES = 1024u;
constexpr unsigned HT_OFF = 133120u;
static_assert(N_OFF + 1024u <= 131072u && HT_OFF + 16384u <= SCT_OFF && SCT_OFF + 3u * SCT_BYTES <= 163840u, "mLSTM LDS map");
__device__ __forceinline__ unsigned cvtpk(float lo, float hi) { f32x2_t v = {lo, hi}; bf16x2_t b = __builtin_convertvector(v, bf16x2_t); return __builtin_bit_cast(unsigned, b); }
__device__ __forceinline__ unsigned off_a(unsigned row, unsigned ch) { return 2048u * (row >> 3) + 512u * (ch >> 2) + 64u * (row & 7u) + 16u * ((ch & 3u) ^ ((row >> 2) & 3u)); }
__device__ __forceinline__ unsigned off_p(unsigned row, unsigned ch) { return 128u * row + 16u * (ch ^ (row & 7u)); }
typedef short v4i16_t __attribute__((ext_vector_type(4)));
__device__ __forceinline__ s16x4 trr(LAS unsigned char* p) { return __builtin_bit_cast(s16x4, __builtin_amdgcn_ds_read_tr16_b64_v4i16((LAS v4i16_t*)p)); }
__device__ __forceinline__ bf16x8 cat8(s16x4 a, s16x4 b) { return (bf16x8){a[0], a[1], a[2], a[3], b[0], b[1], b[2], b[3]}; }
struct CS { float decay, m_next; };
__device__ __forceinline__ CS chunk_scalars(float ig, float fg, float m, LAS float* tab, bool writer, unsigned lane) {
    const float lf = logsigmoidf_(fg);
    const float bc = wave_scan_add(lf), gg = ig - bc, cm = wave_scan_max(gg);
    const float G = fmaxf(m, cm), G63 = lane_bcast(G, 63), b63 = lane_bcast(bc, 63), qs = 0.08838834764831845f;
    if (writer) { tab[lane] = __expf(fminf(G63 - G, 80.f)) * qs; tab[64 + lane] = __expf(m - G) * qs; tab[128 + lane] = __expf(-(bc + G)); tab[192 + lane] = __expf(gg - G63); }
    CS r; r.decay = __expf(m - G63); r.m_next = b63 + G63;
    return r;
}
__device__ __forceinline__ void unit(const Prm& p, const Frame& F, int u) {
    static_assert(QK == 128 && MV == 256 && CHUNK == 64 && S % 64 == 0, "mLSTM unit is specialised");
    const int vhalf = u & 1, h = (u >> 1) & 3, b = (u >> 3) & 7, dir = u >> 6;
    const unsigned lane = F.lane, tid = F.tid; const int wave = F.wave; const unsigned q = lane >> 4, r = lane & 15u;
    LAS unsigned char* L = F.lds;
    const unsigned rx = (r >> 2) & 3u, rlo = 2048u * (r >> 3) + 64u * (r & 7u);
    const unsigned RA = rlo + 16u * (q ^ rx), PB1 = rlo + 16u * ((q >> 1) ^ rx) + 8u * (q & 1u), PB2 = rlo + 16u * ((2u + (q >> 1)) ^ rx) + 8u * (q & 1u);
    const unsigned pp = lane & 3u, tlo = 2048u * q + 64u * rx + 8u * (pp & 1u);
    const unsigned tb00 = tlo + 16u * ((pp >> 1) ^ ((2u * q) & 3u)), tb01 = tlo + 256u + 16u * ((pp >> 1) ^ ((2u * q + 1u) & 3u));
    const unsigned tb10 = tlo + 16u * ((2u + (pp >> 1)) ^ ((2u * q) & 3u)), tb11 = tlo + 256u + 16u * ((2u + (pp >> 1)) ^ ((2u * q + 1u) & 3u));
    const unsigned PP0 = 128u * r + 16u * (q ^ (r & 7u)), PP1 = 128u * r + 16u * ((4u + q) ^ (r & 7u));
#define ML_TRA(c, ks, t) ((((c) & 1) ? ((t) ? tb11 : tb10) : ((t) ? tb01 : tb00)) + 8192u * (ks) + 512u * ((unsigned)(c) >> 1))
    __syncthreads();
    for (unsigned i = tid; i < (2u * PT_BYTES + 1024u) / 16u; i += NTHR) *(LAS u32x4*)(L + PT_OFF + 16u * i) = (u32x4){0u, 0u, 0u, 0u};
    f32x4 C[8];
#pragma unroll
    for (int i = 0; i < 8; ++i) C[i] = (f32x4){0.f, 0.f, 0.f, 0.f};
    float m = 0.f;
    const bf16_t* pj = p.PJ(); bf16_t* H = dir ? p.HB16() : p.HF16();
    const int colq = O_Q + h * QK, colk = O_K + h * QK, colv = O_V + h * MV + vhalf * 128;
    const unsigned srow0 = tid >> 4, sch = tid & 15u;
    u32x4 rq[2], rk[2], rv[2];
    const float* gbase = p.GATES() + dir * 8 + h;
#define ML_GATES(c, ig_, fg_) do { const float* g_ = gbase + (size_t)ml_tok(dir, b, (c) * 64 + (int)lane) * NG; ig_ = g_[0]; fg_ = g_[4]; } while (0)
    float ig0, fg0, ign = 0.f, fgn = 0.f; ML_GATES(0, ig0, fg0); if (S / 64 > 1) ML_GATES(1, ign, fgn);
#define ML_TAB(c) ((LAS float*)(L + SCT_OFF + (unsigned)((c) % 3) * SCT_BYTES))
    CS cs = chunk_scalars(ig0, fg0, m, ML_TAB(0), wave == 0, lane), csn = cs;
    const long sMW = dir ? -(long)MW : (long)MW;
#define ML_LOAD(c) do { _Pragma("unroll") for (int i_ = 0; i_ < 2; ++i_) { const bf16_t* rp = pj + (size_t)ml_tok(dir, b, (c) * 64 + srow0 + 32 * i_) * INM + 8 * sch; \
        rq[i_] = *(const u32x4*)(rp + colq); rk[i_] = *(const u32x4*)(rp + colk); rv[i_] = *(const u32x4*)(rp + colv); } } while (0)
#define ML_STORE(buf, S_) do { _Pragma("unroll") for (int i_ = 0; i_ < 2; ++i_) { const unsigned row = srow0 + 32u * i_, o = (buf) * BUF + off_a(row, sch); const float w = (S_)[192 + row]; \
        *(LAS u32x4*)(L + o) = rq[i_]; *(LAS u32x4*)(L + IMG + o) = rk[i_]; u32x4 v = rv[i_]; \
        v.x = cvtpk(bflo(v.x) * w, bfhi(v.x) * w); v.y = cvtpk(bflo(v.y) * w, bfhi(v.y) * w); v.z = cvtpk(bflo(v.z) * w, bfhi(v.z) * w); v.w = cvtpk(bflo(v.w) * w, bfhi(v.w) * w); \
        *(LAS u32x4*)(L + 2u * IMG + o) = v; } } while (0)
    __syncthreads();
    ML_LOAD(0); ML_STORE(0u, ML_TAB(0)); if (S / 64 > 1) ML_LOAD(1);
    constexpr int NC = S / 64;
    for (int c = 0; c < NC; ++c) {
        const unsigned cur = (unsigned)(c & 1);
        LAS unsigned char* Qi = L + cur * BUF; LAS unsigned char* Ki = Qi + IMG; LAS unsigned char* Vi = Qi + 2u * IMG; LAS unsigned char* Pt = L + PT_OFF + cur * PT_BYTES;
        float ig2 = 0.f, fg2 = 0.f;
        if (c + 1 < NC) { csn = chunk_scalars(ign, fgn, cs.m_next, ML_TAB(c + 1), wave == 0, lane); if (c + 2 < NC) ML_GATES(c + 2, ig2, fg2); }
        __syncthreads();
#define ML_FLUSH(cprev) do { _Pragma("unroll") for (int i_ = 0; i_ < 2; ++i_) { const unsigned n_ = tid + 512u * i_, row_ = n_ >> 4, ch_ = n_ & 15u;     \
            const u32x4 v_ = *(const LAS u32x4*)(L + HT_OFF + 256u * row_ + 16u * (ch_ ^ (row_ & 15u))); \
            *(u32x4*)(H + (size_t)ml_tok(dir, b, (cprev) * 64 + (int)row_) * MW + h * MV + vhalf * 128 + 8 * (int)ch_) = v_; } } while (0)
        const LAS float* sct = ML_TAB(c);
        if (c > 0) ML_FLUSH(c - 1);
#ifndef ML_REP_3B
#define ML_REP_3B 1
#define ML_REP_S 1
#define ML_REP_ST 1
#define ML_REP_3A 1
#define ML_REP_DEN 1
#endif
        f32x4 acc2[4];
#pragma unroll
        for (int tt = 0; tt < 4; ++tt) acc2[tt] = (f32x4){0.f, 0.f, 0.f, 0.f};
#pragma unroll
        for (int ks = 0; ks < 4; ++ks) {
            bf16x8 qa[4];
#pragma unroll
            for (int tt = 0; tt < 4; ++tt) {
                const u32x2 lo = *(const LAS u32x2*)(Qi + PB1 + 4096u * tt + 512u * ks), hi = *(const LAS u32x2*)(Qi + PB2 + 4096u * tt + 512u * ks);
                const u32x4 aw = {lo.x, lo.y, hi.x, hi.y}; qa[tt] = __builtin_bit_cast(bf16x8, aw); }
            const f32x4 c0 = C[2 * ks], c1 = C[2 * ks + 1];
            const u32x4 bw = {cvtpk(c0[0], c0[1]), cvtpk(c0[2], c0[3]), cvtpk(c1[0], c1[1]), cvtpk(c1[2], c1[3])}; const bf16x8 bfr = __builtin_bit_cast(bf16x8, bw);
#pragma unroll
            for (int tt = 0; tt < 4; ++tt) acc2[tt] = __builtin_amdgcn_mfma_f32_16x16x32_bf16(qa[tt], bfr, acc2[tt], 0, 0, 0);
        }
        bf16x8 vB[2];
#pragma unroll
        for (int ks = 0; ks < 2; ++ks) vB[ks] = cat8(trr(Vi + ML_TRA(wave, ks, 0)), trr(Vi + ML_TRA(wave, ks, 1)));
#pragma unroll
        for (int dt = 0; dt < 8; ++dt) C[dt] = C[dt] * cs.decay;
#pragma unroll
        for (int ks = 0; ks < 2; ++ks)
#pragma unroll
            for (int dh = 0; dh < 2; ++dh) { bf16x8 kA[4];
#pragma unroll
                for (int d4 = 0; d4 < 4; ++d4) kA[d4] = cat8(trr(Ki + ML_TRA(4 * dh + d4, ks, 0)), trr(Ki + ML_TRA(4 * dh + d4, ks, 1)));
#pragma unroll
                for (int d4 = 0; d4 < 4; ++d4) C[4 * dh + d4] = __builtin_amdgcn_mfma_f32_16x16x32_bf16(kA[d4], vB[ks], C[4 * dh + d4], 0, 0, 0); }
#pragma unroll
        for (int rep = 0; rep < 2; ++rep) { const int idx = wave + (rep ? 2 : 0);
            if (rep == 0 || wave >= 6) { const int tt = idx >= 6 ? 3 : (idx >= 3 ? 2 : (idx >= 1 ? 1 : 0)), st = idx - tt * (tt + 1) / 2;
                f32x4 sa = (f32x4){0.f, 0.f, 0.f, 0.f};
#pragma unroll
                for (int kh = 0; kh < 2; ++kh) { bf16x8 af[2], bfk[2];
#pragma unroll
                    for (int k2 = 0; k2 < 2; ++k2) { af[k2] = *(const LAS bf16x8*)(Qi + RA + 4096u * tt + 512u * (2 * kh + k2)); bfk[k2] = *(const LAS bf16x8*)(Ki + RA + 4096u * st + 512u * (2 * kh + k2)); }
#pragma unroll
                    for (int k2 = 0; k2 < 2; ++k2) sa = __builtin_amdgcn_mfma_f32_16x16x32_bf16(af[k2], bfk[k2], sa, 0, 0, 0); }
                const unsigned scol = 16u * st + r;
#pragma unroll
                for (int i = 0; i < 4; ++i) { const unsigned trow = 16u * tt + 4u * q + i; const float v = scol <= trow ? sa[i] : 0.f;
                    *(LAS bf16_t*)(Pt + off_p(trow, scol >> 3) + 2u * (scol & 7u)) = (bf16_t)cvtpk(v, 0.f); } } }
        if (c + 1 < NC) { ML_STORE(cur ^ 1u, ML_TAB(c + 1)); if (c + 2 < NC) ML_LOAD(c + 2); }
        __syncthreads();
        { bf16x8 pf[6];
#pragma unroll
          for (int tt = 0; tt < 4; ++tt) { pf[tt] = *(const LAS bf16x8*)(Pt + PP0 + 2048u * tt); if (tt >= 2) pf[2 + tt] = *(const LAS bf16x8*)(Pt + PP1 + 2048u * tt); }
#pragma unroll
          for (int tt = 0; tt < 4; ++tt) { const f32x4 av4 = *(const LAS f32x4*)(sct + 16 * tt + 4 * q), bv4 = *(const LAS f32x4*)(sct + 64 + 16 * tt + 4 * q); f32x4 a1 = __builtin_amdgcn_mfma_f32_16x16x32_bf16(pf[tt], vB[0], (f32x4){0.f, 0.f, 0.f, 0.f}, 0, 0, 0);
            if (tt >= 2) a1 = __builtin_amdgcn_mfma_f32_16x16x32_bf16(pf[2 + tt], vB[1], a1, 0, 0, 0);
#pragma unroll
            for (int i = 0; i < 4; ++i) { const unsigned t = 16u * tt + 4u * q + i, col = 16u * (unsigned)wave + r;
                *(LAS bf16_t*)(L + HT_OFF + 256u * t + 16u * ((col >> 3) ^ (t & 15u)) + 2u * (col & 7u)) = (bf16_t)cvtpk(av4[i] * a1[i] + bv4[i] * acc2[tt][i], 0.f); } } }
        if (vhalf == 0) {
            const LAS float* n_old = (const LAS float*)(L + N_OFF + cur * 512u); LAS float* n_new = (LAS float*)(L + N_OFF + (cur ^ 1u) * 512u);
            bf16x8 wB[2];
#pragma unroll
            for (int ks = 0; ks < 2; ++ks) { const f32x4 w0 = *(const LAS f32x4*)(sct + 192 + 32 * ks + 8 * q), w1 = *(const LAS f32x4*)(sct + 192 + 32 * ks + 8 * q + 4);
                u32x4 w = {cvtpk(w0[0], w0[1]), cvtpk(w0[2], w0[3]), cvtpk(w1[0], w1[1]), cvtpk(w1[2], w1[3])};
                if (r != 0u) w = (u32x4){0u, 0u, 0u, 0u}; wB[ks] = __builtin_bit_cast(bf16x8, w); }
            const size_t dbase = ((size_t)dir * T) * MH + h;
            if (wave < 4) { const int tt = wave; f32x4 d2 = (f32x4){0.f, 0.f, 0.f, 0.f};
#pragma unroll
                for (int ks = 0; ks < 4; ++ks) { const f32x4 n0 = *(const LAS f32x4*)(n_old + 32 * ks + 4 * q), n1 = *(const LAS f32x4*)(n_old + 32 * ks + 16 + 4 * q);
                    u32x4 bw = {cvtpk(n0[0], n0[1]), cvtpk(n0[2], n0[3]), cvtpk(n1[0], n1[1]), cvtpk(n1[2], n1[3])}; if (r != 0u) bw = (u32x4){0u, 0u, 0u, 0u};
                    const u32x2 lo = *(const LAS u32x2*)(Qi + PB1 + 4096u * tt + 512u * ks), hi = *(const LAS u32x2*)(Qi + PB2 + 4096u * tt + 512u * ks);
                    const u32x4 aw = {lo.x, lo.y, hi.x, hi.y};
                    d2 = __builtin_amdgcn_mfma_f32_16x16x32_bf16(__builtin_bit_cast(bf16x8, aw), __builtin_bit_cast(bf16x8, bw), d2, 0, 0, 0); }
#pragma unroll
                for (int i = 0; i < 4; ++i) { const int t = 16 * tt + 4 * (int)q + i; const float bv = sct[64 + t], fl = sct[128 + t];
                    if (r == 0u) { const size_t di = dbase + (size_t)ml_tok(dir, b, c * 64 + t) * MH; p.DEN()[(size_t)2 * T * MH + di] = bv * d2[i]; p.FLR()[di] = fl; } }
            } else { const int tt = wave - 4; f32x4 d1 = (f32x4){0.f, 0.f, 0.f, 0.f};
#pragma unroll
                for (int ks = 0; ks < 2; ++ks) if (ks == 0 || tt >= 2) { const bf16x8 pf = *(const LAS bf16x8*)(Pt + (ks ? PP1 : PP0) + 2048u * tt);
                    d1 = __builtin_amdgcn_mfma_f32_16x16x32_bf16(pf, wB[ks], d1, 0, 0, 0); }
#pragma unroll
                for (int i = 0; i < 4; ++i) { const int t = 16 * tt + 4 * (int)q + i; const float av = sct[t];
                    if (r == 0u) p.DEN()[dbase + (size_t)ml_tok(dir, b, c * 64 + t) * MH] = av * d1[i]; } }
            { const int dt = wave; f32x4 nn = *(const LAS f32x4*)(n_old + 16 * dt + 4 * q) * cs.decay; if (r != 0u) nn = (f32x4){0.f, 0.f, 0.f, 0.f};
#pragma unroll
                for (int ks = 0; ks < 2; ++ks) { const bf16x8 kA = cat8(trr(Ki + ML_TRA(dt, ks, 0)), trr(Ki + ML_TRA(dt, ks, 1)));
                    nn = __builtin_amdgcn_mfma_f32_16x16x32_bf16(kA, wB[ks], nn, 0, 0, 0); }
                if (r == 0u) *(LAS f32x4*)(n_new + 16 * dt + 4 * q) = nn; }
        }
        m = cs.m_next; cs = csn; ign = ig2; fgn = fg2;
    }
    __syncthreads(); ML_FLUSH(NC - 1);
#undef ML_FLUSH
#undef ML_TRA
#undef ML_TABLE
#undef ML_LOAD
#undef ML_GATES
#undef ML_STORE
}
}
__device__ __forceinline__ void phase4(const Prm& p, const Frame& F) {
    static_assert(MV == 256 && MH == 4, "head j = float4 slot j of the lane");
    const int gw = F.bid * NWAVES + F.wave, NGW = F.G * NWAVES;
    for (int row = gw; row < T; row += NGW) {
        const uint2* hf = (const uint2*)(p.HF16() + (size_t)row * MW) + F.lane; const uint2* hb = (const uint2*)(p.HB16() + (size_t)row * MW) + F.lane;
        const uint2* og = (const uint2*)(p.PJ() + (size_t)row * INM + O_O) + F.lane; uint2* yo = (uint2*)(p.Y() + (size_t)row * D + CW) + F.lane;
#pragma unroll
        for (int j = 0; j < MH; ++j) {
            const float* d2 = p.DEN() + (size_t)2 * T * MH;
            const float i_f = 1.f / fmaxf(fabsf(p.DEN()[(size_t)row * MH + j] + d2[(size_t)row * MH + j]), p.FLR()[(size_t)row * MH + j]);
            const float i_b = 1.f / fmaxf(fabsf(p.DEN()[((size_t)T + row) * MH + j] + d2[((size_t)T + row) * MH + j]), p.FLR()[((size_t)T + row) * MH + j]);
            const uint2 a = hf[64 * j], b = hb[64 * j]; float4 h = make_float4(bflo(a.x) * i_f + bflo(b.x) * i_b, bfhi(a.x) * i_f + bfhi(b.x) * i_b, bflo(a.y) * i_f + bflo(b.y) * i_b, bfhi(a.y) * i_f + bfhi(b.y) * i_b);
            const float mean = wave_sum((h.x + h.y) + (h.z + h.w)) * (1.f / MV);
            h.x -= mean; h.y -= mean; h.z -= mean; h.w -= mean;
            const float rstd = 1.f / sqrtf(wave_sum((h.x * h.x + h.y * h.y) + (h.z * h.z + h.w * h.w)) * (1.f / MV) + LN_EPS);
            const float4 nw = *((const float4*)(p.mnorm_w + j * MV) + F.lane); const uint2 o = og[64 * j];
            yo[64 * j] = make_uint2(pk2(h.x * rstd * nw.x * sigmoidf_(bflo(o.x)), h.y * rstd * nw.y * sigmoidf_(bfhi(o.x))), pk2(h.z * rstd * nw.z * sigmoidf_(bflo(o.y)), h.w * rstd * nw.w * sigmoidf_(bfhi(o.y)))); }
    }
}
struct EpiZ {
    static constexpr bool PERM = false, AFTER_DRAIN = false;
    const float* x; const float* mod; bf16_t* out;
    __device__ __forceinline__ void operator()(const pg8::f32x4 (&acc)[2][2][4][2], const pg8::Unit& u, int wr, int wc, int fr, int fq) const {
        const int col0 = u.pn * 256 + wc * 32 + 4 * fq;
#pragma unroll
        for (int ai = 0; ai < 2; ++ai)
#pragma unroll
            for (int m = 0; m < 4; ++m) { const int row = u.pm * 256 + ai * 128 + wr * 64 + m * 16 + fr; const float* g1 = mod + (size_t)(row / S) * D6 + 2 * D; const size_t off = (size_t)row * D + col0;
#pragma unroll
                for (int bj = 0; bj < 2; ++bj)
#pragma unroll
                    for (int n = 0; n < 2; ++n) { const int c = bj * 128 + n * 16; const pg8::f32x4 xv = *(const pg8::f32x4*)(x + off + c), gv = *(const pg8::f32x4*)(g1 + col0 + c);
                        const pg8::f32x4 z = xv * ALPHA + gv * acc[ai][bj][m][n]; *(uint2*)(out + off + c) = make_uint2(pk2(z[0], z[1]), pk2(z[2], z[3])); } }
    }
};

struct EpiF32 {
    static constexpr bool PERM = false, AFTER_DRAIN = false;
    float* out; int ldc;
    __device__ __forceinline__ void operator()(const pg8::f32x4 (&acc)[2][2][4][2], const pg8::Unit& u, int wr, int wc, int fr, int fq) const {
        const int col0 = u.pn * 256 + wc * 32 + 4 * fq;
#pragma unroll
        for (int ai = 0; ai < 2; ++ai)
#pragma unroll
            for (int m = 0; m < 4; ++m) { float* rowp = out + (size_t)(u.pm * 256 + ai * 128 + wr * 64 + m * 16 + fr) * ldc + col0;
#pragma unroll
                for (int bj = 0; bj < 2; ++bj)
#pragma unroll
                    for (int n = 0; n < 2; ++n) *(pg8::f32x4*)(rowp + bj * 128 + n * 16) = acc[ai][bj][m][n]; }
    }
};
__device__ __forceinline__ unsigned skey(float f) { const unsigned u = f_as_u(f); return (u & 0x80000000u) ? ~u : (u | 0x80000000u); }
__device__ __forceinline__ float unskey(unsigned k) { return u_as_f((k & 0x80000000u) ? (k & 0x7fffffffu) : ~k); }
__device__ __forceinline__ void tk_insert(unsigned (&L)[16], unsigned k) {
    if (k > L[15]) { L[15] = k;
#pragma unroll
        for (int i = 14; i >= 0; --i) { const unsigned hi = L[i] > L[i + 1] ? L[i] : L[i + 1], lo = L[i] > L[i + 1] ? L[i + 1] : L[i]; L[i] = hi; L[i + 1] = lo; } }
}
__device__ __forceinline__ void tk_top16(const float* sc, unsigned (&L)[16]) {
#pragma unroll
    for (int i = 0; i < 16; ++i) L[i] = 0u;
#pragma unroll 2
    for (int n4 = 0; n4 < NK / 4; ++n4) { const float4 v = ((const float4*)sc)[n4]; const unsigned b = 127u - 4u * n4;
        tk_insert(L, (skey(v.x) & ~0x7fu) | b); tk_insert(L, (skey(v.y) & ~0x7fu) | (b - 1)); tk_insert(L, (skey(v.z) & ~0x7fu) | (b - 2)); tk_insert(L, (skey(v.w) & ~0x7fu) | (b - 3)); }
}
__device__ __forceinline__ void phase8(const Prm& p, const Frame& F) {
    static_assert(NK == 128 && TOPK == 16, "top-k phase is specialised");
    const long gt = (long)F.bid * NTHR + F.tid, GT = (long)F.G * NTHR;
    for (long i = gt; i < (long)T * PH; i += GT) {
        unsigned A[16], B[16];
        tk_top16(p.SC() + (size_t)i * 2 * NK, A); tk_top16(p.SC() + (size_t)i * 2 * NK + NK, B);
        float V[16]; int E[16];
#pragma unroll
        for (int r = 0; r < 16; ++r) { V[r] = -INFINITY; E[r] = 0; }
#pragma unroll
        for (int a = 0; a < 16; ++a)
#pragma unroll
            for (int b = 0; b < 16; ++b) if ((a + 1) * (b + 1) <= 16) {
                const float v = unskey(A[a] & ~0x7fu) + unskey(B[b] & ~0x7fu); const int e = (int)((127u - (A[a] & 0x7fu)) * NK + (127u - (B[b] & 0x7fu)));
                if (v > V[15]) { V[15] = v; E[15] = e;
#pragma unroll
                    for (int r = 14; r >= 0; --r) { const bool sw = V[r + 1] > V[r]; const float vh = sw ? V[r + 1] : V[r], vl = sw ? V[r] : V[r + 1]; const int eh = sw ? E[r + 1] : E[r], el = sw ? E[r] : E[r + 1];
                        V[r] = vh; V[r + 1] = vl; E[r] = eh; E[r + 1] = el; } } }
        float sum = 0.f; const float vmax = V[0];
#pragma unroll
        for (int r = 0; r < 16; ++r) { V[r] = __expf(V[r] - vmax); sum += V[r]; }
        const float inv = 1.f / sum;
#pragma unroll
        for (int r = 0; r < 16; r += 4) { *(int4*)(p.EIDX() + (size_t)i * TOPK + r) = make_int4(E[r], E[r + 1], E[r + 2], E[r + 3]);
            *(float4*)(p.EW() + (size_t)i * TOPK + r) = make_float4(V[r] * inv, V[r + 1] * inv, V[r + 2] * inv, V[r + 3] * inv); }
    }
}
__device__ __forceinline__ void phase6(const Prm& p, const Frame& F) {
    const int gw = F.bid * NWAVES + F.wave, NGW = F.G * NWAVES;
    float4 v[8]; uint2 zb[8], zn[8];
    if (gw < T) { const uint2* z0 = (const uint2*)((const bf16_t*)p.out + (size_t)gw * D) + F.lane;
#pragma unroll
        for (int j = 0; j < 8; ++j) zb[j] = z0[64 * j]; }
    for (int row = gw; row < T; row += NGW) {
        uint2* x1r = (uint2*)(p.X1B() + (size_t)row * D) + F.lane; const float* mod = p.MOD() + (size_t)(row / S) * D6;
        float s = 0.f;
        if (row + NGW < T) { const uint2* zp = (const uint2*)((const bf16_t*)p.out + (size_t)(row + NGW) * D) + F.lane;
#pragma unroll
            for (int j = 0; j < 8; ++j) zn[j] = zp[64 * j]; }
#pragma unroll
        for (int j = 0; j < 8; ++j) { v[j] = make_float4(bflo(zb[j].x), bfhi(zb[j].x), bflo(zb[j].y), bfhi(zb[j].y)); s += (v[j].x + v[j].y) + (v[j].z + v[j].w); }
        float mean = wave_sum(s) * (1.f / D), s2 = 0.f;
#pragma unroll
        for (int j = 0; j < 8; ++j) { v[j].x -= mean; v[j].y -= mean; v[j].z -= mean; v[j].w -= mean; s2 += (v[j].x * v[j].x + v[j].y * v[j].y) + (v[j].z * v[j].z + v[j].w * v[j].w); }
        float rstd = 1.f / sqrtf(wave_sum(s2) * (1.f / D) + LN_EPS); s = 0.f;
#pragma unroll
        for (int j = 0; j < 8; ++j) { const float4 w = *((const float4*)p.ln1_w + F.lane + 64 * j), bb = *((const float4*)p.ln1_b + F.lane + 64 * j);
            v[j].x = v[j].x * rstd * w.x + bb.x; v[j].y = v[j].y * rstd * w.y + bb.y; v[j].z = v[j].z * rstd * w.z + bb.z; v[j].w = v[j].w * rstd * w.w + bb.w;
            x1r[64 * j] = make_uint2(pk2(v[j].x, v[j].y), pk2(v[j].z, v[j].w)); s += (v[j].x + v[j].y) + (v[j].z + v[j].w); }
        mean = wave_sum(s) * (1.f / D); s2 = 0.f;
#pragma unroll
        for (int j = 0; j < 8; ++j) { v[j].x -= mean; v[j].y -= mean; v[j].z -= mean; v[j].w -= mean; s2 += (v[j].x * v[j].x + v[j].y * v[j].y) + (v[j].z * v[j].z + v[j].w * v[j].w); }
        rstd = 1.f / sqrtf(wave_sum(s2) * (1.f / D) + LN_EPS);
        uint2* o8 = (uint2*)(p.U() + (size_t)row * D) + F.lane;
#pragma unroll
        for (int j = 0; j < 8; ++j) { const float4 sh = *((const float4*)(mod + 3 * D) + F.lane + 64 * j), sc = *((const float4*)(mod + 4 * D) + F.lane + 64 * j);
            o8[64 * j] = make_uint2(pk2(v[j].x * rstd * (1.f + sc.x) + sh.x, v[j].y * rstd * (1.f + sc.y) + sh.y), pk2(v[j].z * rstd * (1.f + sc.z) + sh.z, v[j].w * rstd * (1.f + sc.w) + sh.w)); }
#pragma unroll
        for (int j = 0; j < 8; ++j) zb[j] = zn[j];
    }
}
struct XW { int vx, nx, rank, nloc; };
constexpr int NDS = 16, DSW = D / NDS;
typedef float f2v __attribute__((ext_vector_type(2)));
struct Row8 { uint4 r[8]; };
__device__ __forceinline__ void gather8(Row8& g, const unsigned char* tbu, unsigned loff, int ereg, int pg) {
#pragma unroll
    for (int k = 0; k < 8; ++k) { const unsigned e = (unsigned)__shfl(ereg, 8 * k + pg); g.r[k] = *(const uint4*)(tbu + (((size_t)e << 11) | loff)); }
}
#define PEER_CVT8(a) const f2v c0 = __builtin_amdgcn_cvt_pk_f32_fp8((a).x, false), c1 = __builtin_amdgcn_cvt_pk_f32_fp8((a).x, true), c2 = __builtin_amdgcn_cvt_pk_f32_fp8((a).y, false), c3 = __builtin_amdgcn_cvt_pk_f32_fp8((a).y, true), \
    c4 = __builtin_amdgcn_cvt_pk_f32_fp8((a).z, false), c5 = __builtin_amdgcn_cvt_pk_f32_fp8((a).z, true), c6 = __builtin_amdgcn_cvt_pk_f32_fp8((a).w, false), c7 = __builtin_amdgcn_cvt_pk_f32_fp8((a).w, true)
typedef _Float16 h2t __attribute__((ext_vector_type(2)));
__device__ __forceinline__ float peer_dot16h(const uint4 a, const h2t* u) {
    float acc = __builtin_amdgcn_fdot2(__builtin_amdgcn_cvt_scalef32_pk_f16_fp8(a.x, 1.0f, false), u[0], 0.f, false);
    acc = __builtin_amdgcn_fdot2(__builtin_amdgcn_cvt_scalef32_pk_f16_fp8(a.x, 1.0f, true), u[1], acc, false);
    acc = __builtin_amdgcn_fdot2(__builtin_amdgcn_cvt_scalef32_pk_f16_fp8(a.y, 1.0f, false), u[2], acc, false);
    acc = __builtin_amdgcn_fdot2(__builtin_amdgcn_cvt_scalef32_pk_f16_fp8(a.y, 1.0f, true), u[3], acc, false);
    acc = __builtin_amdgcn_fdot2(__builtin_amdgcn_cvt_scalef32_pk_f16_fp8(a.z, 1.0f, false), u[4], acc, false);
    acc = __builtin_amdgcn_fdot2(__builtin_amdgcn_cvt_scalef32_pk_f16_fp8(a.z, 1.0f, true), u[5], acc, false);
    acc = __builtin_amdgcn_fdot2(__builtin_amdgcn_cvt_scalef32_pk_f16_fp8(a.w, 1.0f, false), u[6], acc, false);
    acc = __builtin_amdgcn_fdot2(__builtin_amdgcn_cvt_scalef32_pk_f16_fp8(a.w, 1.0f, true), u[7], acc, false);
    return acc;
}
__device__ __forceinline__ f2v rscatter16(const float* v, bool b0, bool b1, bool b2, int m0, int m1, int m2) {
    float r8[8], r4[4]; f2v r2;
#pragma unroll
    for (int i = 0; i < 8; ++i) { const float keep = b0 ? v[8 + i] : v[i], send = b0 ? v[i] : v[8 + i]; r8[i] = keep + __shfl_xor(send, m0); }
#pragma unroll
    for (int i = 0; i < 4; ++i) { const float keep = b1 ? r8[4 + i] : r8[i], send = b1 ? r8[i] : r8[4 + i]; r4[i] = keep + __shfl_xor(send, m1); }
    { const float k0 = b2 ? r4[2] : r4[0], s0 = b2 ? r4[0] : r4[2], k1 = b2 ? r4[3] : r4[1], s1 = b2 ? r4[1] : r4[3]; r2.x = k0 + __shfl_xor(s0, m2); r2.y = k1 + __shfl_xor(s1, m2); }
    return r2;
}
__device__ __forceinline__ void phase9(const Prm& p, const Frame& F, const XW& xw) {
    static_assert(DSW == 128 && NSLOT == 128 && D == 2048, "slice row = 8 lanes x 16 bytes");
    const int pg = F.lane >> 3, part = F.lane & 7; const bool p0 = part & 1, p1 = part & 2, p2 = part & 4;
    const int tstep = xw.nloc * NWAVES, t0 = xw.rank * NWAVES + F.wave; const int nt = t0 < T ? (T - t0 + tstep - 1) / tstep : 0;
    const unsigned loff = (unsigned)part * 16u; const int k0 = (p0 ? 8 : 0) + (p1 ? 4 : 0) + (p2 ? 2 : 0);
    for (int ds = xw.vx; ds < NDS; ds += xw.nx) {
        if (nt == 0) continue;
        const unsigned char* tbu = p.PU8() + ds * DSW; float* part_out = p.SC() + (size_t)ds * T * NSLOT + pg + 8 * k0;
#define UP_TOK(i) (t0 + ((i) < nt ? (i) : nt - 1) * tstep)
#define UP_LOADE(i, ea, eb) do { const int* ep_ = p.EIDX() + (size_t)UP_TOK(i) * NSLOT + F.lane; ea = ep_[0]; eb = ep_[64]; } while (0)
#define UP_LOADU(i, ua_, ub_) do { const uint4* up_ = (const uint4*)(p.U() + (size_t)UP_TOK(i) * D + ds * DSW + part * 16); ua_ = up_[0]; ub_ = up_[1]; } while (0)
        int e0a, e0b, e1a, e1b, e2a, e2b; uint4 ua, ub, una, unb;
        UP_LOADE(0, e0a, e0b); UP_LOADE(1, e1a, e1b); UP_LOADE(2, e2a, e2b); UP_LOADU(0, ua, ub);
        Row8 G0, G1, G2, G3;
        gather8(G0, tbu, loff, e0a, pg); gather8(G1, tbu, loff, e0b, pg); gather8(G2, tbu, loff, e1a, pg);
#define UP_BODY(i, GA, GB, GC, GD) do { \
            gather8(GD, tbu, loff, e1b, pg); UP_LOADU((i) + 1, una, unb); int e3a, e3b; UP_LOADE((i) + 3, e3a, e3b); \
            h2t u[8]; u[0] = (h2t){(_Float16)bflo(ua.x), (_Float16)bfhi(ua.x)}; u[1] = (h2t){(_Float16)bflo(ua.y), (_Float16)bfhi(ua.y)}; u[2] = (h2t){(_Float16)bflo(ua.z), (_Float16)bfhi(ua.z)}; u[3] = (h2t){(_Float16)bflo(ua.w), (_Float16)bfhi(ua.w)}; \
            u[4] = (h2t){(_Float16)bflo(ub.x), (_Float16)bfhi(ub.x)}; u[5] = (h2t){(_Float16)bflo(ub.y), (_Float16)bfhi(ub.y)}; u[6] = (h2t){(_Float16)bflo(ub.z), (_Float16)bfhi(ub.z)}; u[7] = (h2t){(_Float16)bflo(ub.w), (_Float16)bfhi(ub.w)}; \
            float dv[16]; \
            _Pragma("unroll") for (int k = 0; k < 8; ++k) dv[k] = peer_dot16h(GA.r[k], u); \
            gather8(GA, tbu, loff, e2a, pg); \
            _Pragma("unroll") for (int k = 0; k < 8; ++k) dv[8 + k] = peer_dot16h(GB.r[k], u); \
            const f2v r2 = rscatter16(dv, p0, p1, p2, 1, 2, 4);                          \
            if ((i) < nt) { float* po = part_out + (size_t)UP_TOK(i) * NSLOT; po[0] = r2.x; po[8] = r2.y; } \
            e1a = e2a; e1b = e2b; e2a = e3a; e2b = e3b; ua = una; ub = unb; } while (0)
        for (int i = 0; i < nt; i += 2) { UP_BODY(i, G0, G1, G2, G3); UP_BODY(i + 1, G2, G3, G0, G1); }
#undef UP_BODY
#undef UP_LOADU
#undef UP_LOADE
#undef UP_TOK
    }
}
__device__ __forceinline__ void phase10(const Prm& p, const Frame& F) {
    static_assert(NE <= 16384 && NSLOT == 128 && T % 64 == 0, "14-bit expert id, 64-token groups");
    LAS unsigned* tile = (LAS unsigned*)F.lds;
    for (int tg = F.bid; tg < T / 64; tg += F.G) {
        __syncthreads();
#pragma unroll 4
        for (int k = 0; k < 16; ++k) { const int idx = F.tid + NTHR * k, tl = idx >> 7, sl = idx & 127; const size_t i = ((size_t)tg * 64 + tl) * NSLOT + sl; float s = 0.f;
#pragma unroll
            for (int ds = 0; ds < NDS; ++ds) s += p.SC()[(size_t)ds * T * NSLOT + i];
            const int e = p.EIDX()[i]; const _Float16 w = (_Float16)(p.EW()[i] * gelu_exact(s * p.RSU()[e]) * p.RSV()[e] * 256.f);
            tile[tl * 129 + sl] = ((unsigned)__builtin_bit_cast(unsigned short, w) << 16) | (unsigned)e; }
        __syncthreads();
        uint4* pk = (uint4*)p.EW() + (size_t)tg * 64 * (NSLOT / 4);
#pragma unroll
        for (int k = 0; k < 4; ++k) { const int j = F.tid + NTHR * k, sq = j >> 6, tl = j & 63; const LAS unsigned* tp = tile + tl * 129 + 4 * sq; pk[j] = make_uint4(tp[0], tp[1], tp[2], tp[3]); }
    }
}
__device__ __forceinline__ void phase11(const Prm& p, const Frame& F) {
    static_assert(NE * 8 <= RING_BYTES && D % 8 == 0 && NE <= 65536, "table slice fits the LDS ring");
    typedef _Float16 h2v __attribute__((ext_vector_type(2)));
    const int c0 = (F.G % 8 == 0) ? (F.bid % 8) * (F.G / 8) + F.bid / 8 : F.bid;
    for (int sidx = c0; sidx < D / 8; sidx += F.G) {
        __syncthreads();
        { const uint4* src = (const uint4*)(p.PV8S() + (size_t)sidx * NE * 8);
          for (int i = F.tid; i < NE / 2; i += NTHR) *(LAS u32x4_t*)(F.lds + 16 * i) = __builtin_bit_cast(u32x4_t, src[i]); }
        __syncthreads();
        const int ntg = (T / 64 - F.wave + NWAVES - 1) / NWAVES, nb = 8 * ntg;
        uint4 b0[4], b1[4], b2[4], b3[4];
        const int kx = (F.G % 8 == 0) ? F.bid >> 3 : F.bid, rot = kx & 3, rotb = (kx >> 2) & 7;
#define DN_TG(bi) (F.wave + ((((bi) >> 3) + rot) % ntg) * NWAVES)
#define DN_PTR(bi) ((const uint4*)p.EW() + (size_t)DN_TG(bi) * 64 * (NSLOT / 4) + ((((bi) & 7) + rotb) & 7) * 4 * 64 + F.lane)
#define DN_LOAD(B, bi) do { const int bc_ = (bi) < nb ? (bi) : nb - 1; const uint4* pk_ = DN_PTR(bc_); _Pragma("unroll") for (int k = 0; k < 4; ++k) B[k] = pk_[k * 64]; } while (0)
#define DN_ONE(v_) do { const unsigned vv_ = (v_); const _Float16 w = __builtin_bit_cast(_Float16, (unsigned short)(vv_ >> 16)); const h2v w2 = {w, w}; \
                const u2v t = *(const LAS u2v*)(F.lds + ((vv_ & 0xFFFFu) << 3)); const unsigned tx_ = t.x, ty_ = t.y; \
                a0 += __builtin_amdgcn_cvt_scalef32_pk_f16_fp8(tx_, 1.0f, false) * w2; a1 += __builtin_amdgcn_cvt_scalef32_pk_f16_fp8(tx_, 1.0f, true) * w2; \
                a2 += __builtin_amdgcn_cvt_scalef32_pk_f16_fp8(ty_, 1.0f, false) * w2; a3 += __builtin_amdgcn_cvt_scalef32_pk_f16_fp8(ty_, 1.0f, true) * w2; } while (0)
#ifndef DN_REP
#define DN_REP 0
#endif
#define DN_ACC(B) do { _Pragma("unroll") for (int k = 0; k < 4; ++k) { DN_ONE(B[k].x); DN_ONE(B[k].y); DN_ONE(B[k].z); DN_ONE(B[k].w); } asm volatile("" ::: "memory"); \
            if (DN_REP) { const h2v s0_ = a0, s1_ = a1, s2_ = a2, s3_ = a3; for (int rep_ = 0; rep_ < DN_REP; ++rep_) { _Pragma("unroll") for (int k = 0; k < 4; ++k) { DN_ONE(B[k].x); DN_ONE(B[k].y); DN_ONE(B[k].z); DN_ONE(B[k].w); } \
                asm volatile("" :: "v"(a0), "v"(a1), "v"(a2), "v"(a3) : "memory"); } a0 = s0_; a1 = s1_; a2 = s2_; a3 = s3_; } } while (0)
        DN_LOAD(b0, 0); DN_LOAD(b1, 1); DN_LOAD(b2, 2);
        for (int bi = 0; bi < nb; bi += 8) {
            h2v a0 = {0, 0}, a1 = {0, 0}, a2 = {0, 0}, a3 = {0, 0};
            DN_LOAD(b3, bi + 3); DN_ACC(b0);
            DN_LOAD(b0, bi + 4); DN_ACC(b1);
            DN_LOAD(b1, bi + 5); DN_ACC(b2);
            DN_LOAD(b2, bi + 6); DN_ACC(b3);
            DN_LOAD(b3, bi + 7); DN_ACC(b0);
            DN_LOAD(b0, bi + 8); DN_ACC(b1);
            DN_LOAD(b1, bi + 9); DN_ACC(b2);
            DN_LOAD(b2, bi + 10); DN_ACC(b3);
            const int tg = DN_TG(bi); const float us = 1.f / 256.f;
            const uint4 yv = make_uint4(pk2((float)a0[0] * us, (float)a0[1] * us), pk2((float)a1[0] * us, (float)a1[1] * us), pk2((float)a2[0] * us, (float)a2[1] * us), pk2((float)a3[0] * us, (float)a3[1] * us));
            *(uint4*)(p.Y() + ((size_t)tg * 64 + F.lane) * D + 8 * sidx) = yv;
#if defined(DN_STORE_REP)
            for (int rep_ = 0; rep_ < DN_STORE_REP; ++rep_) { asm volatile("" ::: "memory"); __builtin_nontemporal_store(__builtin_bit_cast(u32x4_t, yv), (u32x4_t*)(p.Y() + ((size_t)tg * 64 + F.lane) * D + 8 * sidx)); }
#endif
        }
#undef DN_ACC
#undef DN_ONE
#undef DN_LOAD
#undef DN_PTR
#undef DN_TG
    }
}
__device__ __forceinline__ void phase12(const Prm& p, const Frame& F) {
    const int gw = F.bid * NWAVES + F.wave, NGW = F.G * NWAVES;
    float4 v[8]; uint2 xb[8], xn[8];
    if (gw < T) { const uint2* xr = (const uint2*)(p.X1B() + (size_t)gw * D) + F.lane;
#pragma unroll
        for (int j = 0; j < 8; ++j) xb[j] = xr[64 * j]; }
    for (int row = gw; row < T; row += NGW) {
        float4* zr = (float4*)(p.out + (size_t)row * D) + F.lane; float s = 0.f;
        if (row + NGW < T) { const uint2* xp = (const uint2*)(p.X1B() + (size_t)(row + NGW) * D) + F.lane;
#pragma unroll
            for (int j = 0; j < 8; ++j) xn[j] = xp[64 * j]; }
        const float* g2 = p.MOD() + (size_t)(row / S) * D6 + 5 * D;
#pragma unroll
        for (int j = 0; j < 8; ++j) { const uint2 y = *((const uint2*)(p.Y() + (size_t)row * D) + F.lane + 64 * j); const float4 g = *((const float4*)g2 + F.lane + 64 * j);
            v[j].x = ALPHA * bflo(xb[j].x) + g.x * bflo(y.x); v[j].y = ALPHA * bfhi(xb[j].x) + g.y * bfhi(y.x); v[j].z = ALPHA * bflo(xb[j].y) + g.z * bflo(y.y); v[j].w = ALPHA * bfhi(xb[j].y) + g.w * bfhi(y.y);
            s += (v[j].x + v[j].y) + (v[j].z + v[j].w); }
        const float mean = wave_sum(s) * (1.f / D); float s2 = 0.f;
#pragma unroll
        for (int j = 0; j < 8; ++j) { v[j].x -= mean; v[j].y -= mean; v[j].z -= mean; v[j].w -= mean; s2 += (v[j].x * v[j].x + v[j].y * v[j].y) + (v[j].z * v[j].z + v[j].w * v[j].w); }
        const float rstd = 1.f / sqrtf(wave_sum(s2) * (1.f / D) + LN_EPS);
#pragma unroll
        for (int j = 0; j < 8; ++j) { const float4 w = *((const float4*)p.ln2_w + F.lane + 64 * j), bb = *((const float4*)p.ln2_b + F.lane + 64 * j);
            zr[64 * j] = make_float4(v[j].x * rstd * w.x + bb.x, v[j].y * rstd * w.y + bb.y, v[j].z * rstd * w.z + bb.z, v[j].w * rstd * w.w + bb.w); }
#pragma unroll
        for (int j = 0; j < 8; ++j) xb[j] = xn[j];
    }
}

struct Args { const float* in[18]; float* out; unsigned char* ws; int ph_lo, ph_hi, li, pad; };
__global__ void __launch_bounds__(NTHR, 2) mk_fwd(Args args) {
    extern __shared__ __attribute__((aligned(16))) unsigned char lds_raw[];
    Frame F; F.lds = (LAS unsigned char*)lds_raw; F.tid = threadIdx.x; F.lane = F.tid & 63; F.wave = __builtin_amdgcn_readfirstlane(F.tid >> 6); F.G = gridDim.x; F.bid = blockIdx.x;
    Prm p; p.x = args.in[0]; p.c = args.in[1]; p.w_ada = args.in[2]; p.b_ada = args.in[3]; p.w_in = args.in[4]; p.b_in = args.in[5]; p.conv_w = args.in[6]; p.conv_b = args.in[7]; p.mnorm_w = args.in[8];
    p.w_out = args.in[9]; p.ln1_w = args.in[10]; p.ln1_b = args.in[11]; p.wq = args.in[12]; p.subkeys = args.in[13]; p.peer_u = args.in[14]; p.peer_v = args.in[15]; p.ln2_w = args.in[16]; p.ln2_b = args.in[17];
    p.out = args.out; p.ws = args.ws;
    volatile LAS unsigned* MISC = (volatile LAS unsigned*)(F.lds + MISC_OFF);
    for (int u = F.tid; u < (LDS_BYTES - LDSCTL_OFF) / 4; u += NTHR) ((LAS unsigned*)(F.lds + LDSCTL_OFF))[u] = 0u;
    __syncthreads();
    const int lo = args.ph_lo, hi = args.ph_hi;
    XcdBarrier bar; bar.bar = (unsigned*)(p.ws + WS_CTL) + CW_BAR + args.li * XCD_BAR_WORDS; bar.x = 0; bar.st = nullptr;
    if (hi - lo > 1) bar = xcd_barrier_post((unsigned*)(p.ws + WS_CTL) + CW_BAR + args.li * XCD_BAR_WORDS, MISC + 8);
#define IN(k) (lo <= (k) && (k) < hi)
#define SEAM(k) do { if (IN(k) && IN((k) + 1)) xcd_barrier(bar); } while (0)
    XW xw; xw.nx = (F.G % 8 == 0) ? 8 : 1; xw.vx = F.bid % xw.nx; xw.rank = F.bid / xw.nx; xw.nloc = F.G / xw.nx;
#define XW_FROM_CENSUS() do { if (hi - lo > 1) { if (F.tid == 0) { unsigned vx_ = 0u; for (unsigned j = 0; j < bar.x; ++j) vx_ += xb_ld(&bar.bar[XB_XCNT(j)]) > 0u ? 1u : 0u; MISC[11] = vx_; } __syncthreads(); \
        xw.vx = (int)MISC[11]; xw.nx = (int)MISC[9]; xw.rank = (int)MISC[10] - 1; xw.nloc = (int)MISC[8]; } } while (0)
    if (IN(0)) { phase0(p, F); } SEAM(0);
    if (IN(1)) { phase1(p, F); } SEAM(1);
    if (IN(2)) { pg8::Gemm g{p.U(), p.WIN_T(), T, INM, D}; pg8::StaticOrder So; So.init(T, INM, F.G, F.bid);
        pg8::EpiBf16<0> E{p.PJ(), INM, p.b_in, 0, 0, 1.f};
        pg8::gemm_phase<pg8::EpiBf16<0>, pg8::StaticOrder, true, true>(F.lds, g, So, E); } SEAM(2);
    if (IN(3)) { const int nmb = F.G >= 2 ? F.G / 2 : 1;
#ifndef P3_REP_ML
#define P3_REP_ML 1
#define P3_REP_CONV 1
#endif
        if (F.bid < nmb) { for (int rep_ = 0; rep_ < P3_REP_ML; ++rep_) for (int u = F.bid; u < 2 * NB * MH * 2; u += nmb) ml::unit(p, F, u); if (F.G < 2) phase3a(p, F, 0, 1); }
        else for (int rep_ = 0; rep_ < P3_REP_CONV; ++rep_) phase3a(p, F, nmb, F.G - nmb); } SEAM(3);
    if (IN(4)) { phase4(p, F); } SEAM(4);
    if (IN(5)) { pg8::Gemm g{p.Y(), p.WOUT_T(), T, D, D}; pg8::StaticOrder So; So.init(T, D, F.G, F.bid);
        EpiZ E{p.x, p.MOD(), (bf16_t*)p.out};
        pg8::gemm_phase<EpiZ, pg8::StaticOrder, true, true>(F.lds, g, So, E); } SEAM(5);
    if (IN(6)) { phase6(p, F); } SEAM(6);
    if (IN(7)) { pg8::Gemm g{p.U(), p.WQ_T(), T, NQ, D}; pg8::StaticOrder So; So.init(T, NQ, F.G, F.bid);
        EpiF32 E{p.SC(), NSC};
        pg8::gemm_phase<EpiF32, pg8::StaticOrder, true, true>(F.lds, g, So, E); } SEAM(7);
    if (IN(8)) { phase8(p, F); } SEAM(8);
    if (IN(9)) { if (lo < 9) XW_FROM_CENSUS(); phase9(p, F, xw); } SEAM(9);
    if (IN(10)) { phase10(p, F); } SEAM(10);
    if (IN(11)) { phase11(p, F); } SEAM(11);
    if (IN(12)) { phase12(p, F); }
#undef IN
#undef SEAM
}

extern "C" void kernel_launch(void* const* d_in, const int* in_sizes, int n_in, void* d_out, int out_size, void* d_ws, size_t ws_size, hipStream_t stream) {
    static int grid = 0;
    if (grid == 0) {
        if (n_in != 18 || out_size != T * D || ws_size < WS_END) { fprintf(stderr, "kernel_launch: unexpected shapes (n_in %d out %d ws %zu, need %zu)\n", n_in, out_size, ws_size, (size_t)WS_END); grid = -1; return; }
        int dev = 0, cus = 0, per_cu = 0;
        if (hipGetDevice(&dev) != hipSuccess || hipDeviceGetAttribute(&cus, hipDeviceAttributeMultiprocessorCount, dev) != hipSuccess) { grid = -1; return; }
        if (hipFuncSetAttribute((const void*)mk_fwd, hipFuncAttributeMaxDynamicSharedMemorySize, LDS_BYTES) != hipSuccess) { fprintf(stderr, "kernel_launch: hipFuncSetAttribute failed\n"); grid = -1; return; }
        if (hipOccupancyMaxActiveBlocksPerMultiprocessor(&per_cu, (const void*)mk_fwd, NTHR, LDS_BYTES) != hipSuccess || per_cu < 1) { fprintf(stderr, "kernel_launch: occupancy query says %d\n", per_cu); }
        (void)hipGetLastError();
        grid = cus;
        if (T % grid != 0 || (T / grid) % NWAVES != 0) { fprintf(stderr, "kernel_launch: grid %d does not divide the rows\n", grid); grid = -1; return; }
    }
    if (grid < 0) return;
    (void)hipMemsetAsync((char*)d_ws + WS_CTL, 0, 1u << 20, stream);
    Args a{};
    for (int i = 0; i < 18; ++i) a.in[i] = (const float*)d_in[i];
    a.out = (float*)d_out; a.ws = (unsigned char*)d_ws;
#if defined(PROBE_A)
    a.ph_lo = 0; a.ph_hi = PROBE_B + 1; a.li = 0; hipLaunchKernelGGL(mk_fwd, dim3(grid), dim3(NTHR), LDS_BYTES, stream, a);
    a.ph_lo = PROBE_A; a.ph_hi = NPHASE; a.li = 1; hipLaunchKernelGGL(mk_fwd, dim3(grid), dim3(NTHR), LDS_BYTES, stream, a);
#elif MK_N_LAUNCHES == 1
    a.ph_lo = 0; a.ph_hi = NPHASE;
    hipLaunchKernelGGL(mk_fwd, dim3(grid), dim3(NTHR), LDS_BYTES, stream, a);
#else
    for (int k = 0; k < NPHASE; ++k) { a.ph_lo = k; a.ph_hi = k + 1; hipLaunchKernelGGL(mk_fwd, dim3(grid), dim3(NTHR), LDS_BYTES, stream, a); }
#endif
}
```

```cpp
#define MK_N_LAUNCHES 1
#if defined(HOST_EMU)
#include <cmath>
#include <cstdint>
#include <cstring>
#include <cstddef>
#define HD inline
#define HDF inline
#else
#include <hip/hip_runtime.h>
#define HD __host__ __device__ __forceinline__
#define HDF __host__ __device__ __forceinline__
#endif

#ifndef CFG_D
#define CFG_D 2048
#define CFG_B 8
#define CFG_S 2048
#define CFG_PH 8
#define CFG_NK 128
#define CFG_TOPK 16
#define CFG_KD 256
#endif
constexpr int D = CFG_D, NB = CFG_B, S = CFG_S, T = NB * S;
constexpr int CW = D / 2, MW = D - CW, MH = 4, MV = MW / MH, QK = MV / 2, NG = 16, CHUNK = 64;
constexpr int INC = 3 * CW + 2 * MH * QK + 2 * MW + NG;
constexpr int INM = INC - NG;
constexpr int O_GB = 0, O_GC = CW, O_HIN = 2 * CW, O_Q = 3 * CW, O_K = O_Q + MH * QK, O_V = O_K + MH * QK, O_O = O_V + MW;
constexpr int PH = CFG_PH, NK = CFG_NK, TOPK = CFG_TOPK, KD = CFG_KD, KH = KD / 2, NE = NK * NK, NSLOT = PH * TOPK;
constexpr int NQ = PH * KD;
static_assert(PH * 2 * NK == NQ || true, "");
constexpr int NSC = PH * 2 * NK;
constexpr float LN_EPS = 1e-5f;
constexpr float ALPHA = 1.189207115002721f;
constexpr int D6 = 6 * D;

typedef unsigned short bf16_t;
HDF unsigned f_as_u(float f) { unsigned u; memcpy(&u, &f, 4); return u; }
HDF float u_as_f(unsigned u) { float f; memcpy(&f, &u, 4); return f; }
HDF bf16_t f2bf(float f) { unsigned u = f_as_u(f); return (bf16_t)((u + 0x7fffu + ((u >> 16) & 1u)) >> 16); }
HDF float bf2f(bf16_t h) { return u_as_f((unsigned)h << 16); }

constexpr size_t al(size_t x) { return (x + 1048575) & ~(size_t)1048575; }
constexpr size_t WS_CTL = 0;
constexpr size_t WS_MOD = al(1);
constexpr size_t WS_MODP = WS_MOD + al((size_t)NB * D6 * 4);
constexpr int NKS = 32;
constexpr size_t WS_GATES = WS_MODP + al((size_t)NKS * NB * D6 * 4);
constexpr size_t WS_DEN = WS_GATES + al((size_t)T * NG * 4);
constexpr size_t WS_FLR = WS_DEN + al((size_t)4 * T * MH * 4);
constexpr size_t WS_EIDX = WS_FLR + al((size_t)2 * T * MH * 4);
constexpr size_t WS_EW = WS_EIDX + al((size_t)T * NSLOT * 4);
constexpr size_t WS_WIN_T = WS_EW + al((size_t)T * NSLOT * 4);
constexpr size_t WS_WOUT_T = WS_WIN_T + al((size_t)INM * D * 2);
constexpr size_t WS_WQ_T = WS_WOUT_T + al((size_t)D * D * 2);
constexpr size_t WS_PU16 = WS_WQ_T + al((size_t)NQ * D * 2);
constexpr size_t WS_PV16 = WS_PU16 + al((size_t)NE * D * 2);
constexpr size_t WS_U = WS_PV16 + al((size_t)NE * D * 2);
constexpr size_t WS_Y = WS_U + al((size_t)T * D * 2);
constexpr size_t WS_P = WS_Y + al((size_t)T * D * 2);
constexpr size_t WS_SC = WS_P;
constexpr size_t WS_TS = WS_SC + al((size_t)T * NSC * 4);
constexpr size_t WS_TI = WS_TS + al((size_t)T * PH * 2 * TOPK * 4);
constexpr size_t WS_P_END = WS_P + al((size_t)T * INM * 2);
constexpr size_t WS_TI_END = WS_TI + al((size_t)T * PH * 2 * TOPK * 4);
constexpr size_t WS_END = WS_P_END > WS_TI_END ? WS_P_END : WS_TI_END;

struct Prm {
    const float *x, *c, *w_ada, *b_ada, *w_in, *b_in, *conv_w, *conv_b, *mnorm_w, *w_out, *ln1_w, *ln1_b, *wq, *subkeys, *peer_u, *peer_v, *ln2_w, *ln2_b;
    float* out;
    unsigned char* ws;
    HDF float* MOD() const { return (float*)(ws + WS_MOD); }
    HDF float* MODP() const { return (float*)(ws + WS_MODP); }
    HDF float* GATES() const { return (float*)(ws + WS_GATES); }
    HDF float* DEN() const { return (float*)(ws + WS_DEN); }
    HDF float* FLR() const { return (float*)(ws + WS_FLR); }
    HDF int* EIDX() const { return (int*)(ws + WS_EIDX); }
    HDF float* EW() const { return (float*)(ws + WS_EW); }
    HDF bf16_t* WIN_T() const { return (bf16_t*)(ws + WS_WIN_T); }
    HDF bf16_t* WOUT_T() const { return (bf16_t*)(ws + WS_WOUT_T); }
    HDF bf16_t* WQ_T() const { return (bf16_t*)(ws + WS_WQ_T); }
    HDF bf16_t* PU16() const { return (bf16_t*)(ws + WS_PU16); }
    HDF bf16_t* PV16() const { return (bf16_t*)(ws + WS_PV16); }
    HDF unsigned char* PU8() const { return ws + WS_PU16; }
    HDF unsigned char* PV8() const { return ws + WS_PV16; }
    HDF unsigned char* PV8S() const { return ws + WS_PV16; }
    HDF float* RSU() const { return (float*)(ws + WS_PU16 + (size_t)NE * D); }
    HDF float* RSV() const { return (float*)(ws + WS_PU16 + (size_t)NE * D + (size_t)NE * 4); }
    HDF bf16_t* U() const { return (bf16_t*)(ws + WS_U); }
    HDF bf16_t* Y() const { return (bf16_t*)(ws + WS_Y); }
    HDF bf16_t* PJ() const { return (bf16_t*)(ws + WS_P); }
    HDF float* SC() const { return (float*)(ws + WS_SC); }
    HDF bf16_t* X1B() const { return (bf16_t*)(ws + WS_TS); }
    HDF float* TS() const { return (float*)(ws + WS_TS); }
    HDF int* TI() const { return (int*)(ws + WS_TI); }
    HDF float* HF() const { return out; }
    HDF float* HB() const { return out + (size_t)T * MW; }
    HDF bf16_t* HF16() const { return (bf16_t*)out; }
    HDF bf16_t* HB16() const { return (bf16_t*)out + (size_t)T * MW; }
};

HDF float sigmoidf_(float x) { return 1.f / (1.f + expf(-x)); }
HDF float logsigmoidf_(float x) { return fminf(x, 0.f) - log1pf(expf(-fabsf(x))); }
HDF float gelu_exact(float x) { return 0.5f * x * (1.f + erff(x * 0.7071067811865476f)); }

HD void b_ada(const Prm& p, long n) {
    float acc[NB];
#pragma unroll
    for (int b = 0; b < NB; ++b) acc[b] = 0.f;
    for (int k = 0; k < D; ++k) {
        const float w = p.w_ada[(size_t)k * D6 + n];
#pragma unroll
        for (int b = 0; b < NB; ++b) { const float cv = p.c[b * D + k]; acc[b] += cv * sigmoidf_(cv) * w; }
    }
#pragma unroll
    for (int b = 0; b < NB; ++b) p.MOD()[(size_t)b * D6 + n] = acc[b] + p.b_ada[n];
}
HD void b_wt(const float* W, int ldw, int K, bf16_t* WT, long i) { const long n = i / K, k = i % K; WT[i] = f2bf(W[(size_t)k * ldw + n]); }
HD void b_tab(const float* src, bf16_t* dst, long i) { dst[i] = f2bf(src[i]); }
HD void b_ln_mod1(const Prm& p, long row) {
    const float* xr = p.x + (size_t)row * D; const int b = (int)(row / S);
    const float* sh = p.MOD() + (size_t)b * D6; const float* sc = sh + D;
    float s = 0.f; for (int d = 0; d < D; ++d) s += xr[d];
    const float mean = s / D; float q = 0.f; for (int d = 0; d < D; ++d) { const float t = xr[d] - mean; q += t * t; }
    const float rstd = 1.f / sqrtf(q / D + LN_EPS);
    for (int d = 0; d < D; ++d) p.U()[(size_t)row * D + d] = f2bf((xr[d] - mean) * rstd * (1.f + sc[d]) + sh[d]);
}
HD void b_gates(const Prm& p, long i) {
    const long row = i / NG; const int g = (int)(i % NG); float acc = 0.f;
    for (int d = 0; d < D; ++d) acc += bf2f(p.U()[(size_t)row * D + d]) * p.w_in[(size_t)d * INC + INM + g];
    p.GATES()[i] = acc + p.b_in[INM + g];
}
HD float b_dot16(const bf16_t* a, const bf16_t* b, int K) { float acc = 0.f; for (int k = 0; k < K; ++k) acc += bf2f(a[k]) * bf2f(b[k]); return acc; }
HD void b_gemm1(const Prm& p, long i) { const long row = i / INM; const int n = (int)(i % INM);
    p.PJ()[i] = f2bf(b_dot16(p.U() + (size_t)row * D, p.WIN_T() + (size_t)n * D, D) + p.b_in[n]); }
HD void b_conv(const Prm& p, long i) {
    const long row = i / CW; const int ch = (int)(i % CW); const int s = (int)(row % S);
    const bf16_t* pj = p.PJ(); float acc = p.conv_b[ch];
#pragma unroll
    for (int k = 0; k < 3; ++k) { const int s2 = s + k - 1; if (s2 >= 0 && s2 < S) { const size_t r2 = (size_t)(row + k - 1) * INM;
        acc += p.conv_w[k * CW + ch] * (bf2f(pj[r2 + O_GC + ch]) * bf2f(pj[r2 + O_HIN + ch])); } }
    p.Y()[(size_t)row * D + ch] = f2bf(bf2f(pj[(size_t)row * INM + O_GB + ch]) * acc);
}
HDF long ml_tok(int dir, int b, int pos) { return (long)b * S + (dir ? S - 1 - pos : pos); }
HD void b_mscan(const Prm& p, long i) {
    const int v = (int)(i % (MV + 1)), h = (int)((i / (MV + 1)) % MH), b = (int)((i / ((MV + 1) * MH)) % NB), dir = (int)(i / ((MV + 1) * MH * NB));
    float C[QK];
#pragma unroll
    for (int d = 0; d < QK; ++d) C[d] = 0.f;
    float m = 0.f; const float qs = 1.f / sqrtf((float)QK);
    float* H = dir ? p.HB() : p.HF();
    for (int pos = 0; pos < S; ++pos) {
        const long tok = ml_tok(dir, b, pos); const float* g = p.GATES() + tok * NG + dir * 8;
        const float ig = g[h], lf = logsigmoidf_(g[4 + h]);
        const float mn = fmaxf(lf + m, ig), dec = expf(lf + m - mn), wi = expf(ig - mn); m = mn;
        const bf16_t* pj = p.PJ() + (size_t)tok * INM; const float wv = wi * (v < MV ? bf2f(pj[O_V + h * MV + (v < MV ? v : 0)]) : 1.f); float num = 0.f;
#pragma unroll
        for (int d = 0; d < QK; ++d) { C[d] = dec * C[d] + wv * bf2f(pj[O_K + h * QK + d]); num += bf2f(pj[O_Q + h * QK + d]) * qs * C[d]; }
        if (v < MV) H[(size_t)tok * MW + h * MV + v] = num;
        else { p.DEN()[((size_t)dir * T + tok) * MH + h] = num; p.FLR()[((size_t)dir * T + tok) * MH + h] = expf(-mn); }
    }
}
HD void b_headnorm(const Prm& p, long i) {
    const long row = i / MH; const int h = (int)(i % MH);
    const float* hf = p.HF() + (size_t)row * MW + h * MV; const float* hb = p.HB() + (size_t)row * MW + h * MV;
    const float inf_ = 1.f / fmaxf(fabsf(p.DEN()[(size_t)row * MH + h]), p.FLR()[(size_t)row * MH + h]);
    const float inb_ = 1.f / fmaxf(fabsf(p.DEN()[((size_t)T + row) * MH + h]), p.FLR()[((size_t)T + row) * MH + h]);
    float s = 0.f; for (int v = 0; v < MV; ++v) s += hf[v] * inf_ + hb[v] * inb_;
    const float mean = s / MV; float q = 0.f; for (int v = 0; v < MV; ++v) { const float t = hf[v] * inf_ + hb[v] * inb_ - mean; q += t * t; }
    const float rstd = 1.f / sqrtf(q / MV + LN_EPS);
    for (int v = 0; v < MV; ++v) { const float hn = (hf[v] * inf_ + hb[v] * inb_ - mean) * rstd * p.mnorm_w[h * MV + v];
        const float og = sigmoidf_(bf2f(p.PJ()[(size_t)row * INM + O_O + h * MV + v]));
        p.Y()[(size_t)row * D + CW + h * MV + v] = f2bf(og * hn); }
}
HD void b_gemm2(const Prm& p, long i) { const long row = i / D; const int n = (int)(i % D); const int b = (int)(row / S);
    const float acc = b_dot16(p.Y() + (size_t)row * D, p.WOUT_T() + (size_t)n * D, D);
    p.out[i] = ALPHA * p.x[i] + p.MOD()[(size_t)b * D6 + 2 * D + n] * acc; }
HD void b_ln_mid(const Prm& p, long row) {
    float* zr = p.out + (size_t)row * D; const int b = (int)(row / S);
    const float* sh = p.MOD() + (size_t)b * D6 + 3 * D; const float* sc = sh + D;
    float s = 0.f; for (int d = 0; d < D; ++d) s += zr[d];
    float mean = s / D; float q = 0.f; for (int d = 0; d < D; ++d) { const float t = zr[d] - mean; q += t * t; }
    float rstd = 1.f / sqrtf(q / D + LN_EPS);
    s = 0.f; for (int d = 0; d < D; ++d) { const float x1 = (zr[d] - mean) * rstd * p.ln1_w[d] + p.ln1_b[d]; zr[d] = x1; s += x1; }
    mean = s / D; q = 0.f; for (int d = 0; d < D; ++d) { const float t = zr[d] - mean; q += t * t; }
    rstd = 1.f / sqrtf(q / D + LN_EPS);
    for (int d = 0; d < D; ++d) p.U()[(size_t)row * D + d] = f2bf((zr[d] - mean) * rstd * (1.f + sc[d]) + sh[d]);
}
HD void b_gemm3(const Prm& p, long i) { const long row = i / NQ; const int n = (int)(i % NQ);
    p.Y()[i] = f2bf(b_dot16(p.U() + (size_t)row * D, p.WQ_T() + (size_t)n * D, D)); }
HD void b_scores(const Prm& p, long i) { const long tok = i / NSC; const int c = (int)(i % NSC), grp = c / NK, n = c % NK;
    const bf16_t* q = p.Y() + (size_t)tok * NQ + grp * KH; const float* sk = p.subkeys + ((size_t)grp * NK + n) * KH; float acc = 0.f;
    for (int d = 0; d < KH; ++d) acc += bf2f(q[d]) * sk[d];
    p.SC()[i] = acc; }
HD void b_topk1(const Prm& p, long i) {
    const float* sc = p.SC() + (size_t)i * NK; float pv = INFINITY; int pi = -1;
    for (int r = 0; r < TOPK; ++r) { float best = -INFINITY; int bi = -1;
        for (int n = 0; n < NK; ++n) { const float v = sc[n]; const bool ok = (v < pv) || (v == pv && n > pi); if (ok && v > best) { best = v; bi = n; } }
        p.TS()[(size_t)i * TOPK + r] = best; p.TI()[(size_t)i * TOPK + r] = bi; pv = best; pi = bi; }
}
HD void b_topk2(const Prm& p, long i) {
    const float* s0 = p.TS() + (size_t)i * 2 * TOPK; const float* s1 = s0 + TOPK; const int* i0 = p.TI() + (size_t)i * 2 * TOPK; const int* i1 = i0 + TOPK;
    float pv = INFINITY; int pi = -1; float mx = 0.f, sum = 0.f;
    for (int r = 0; r < TOPK; ++r) { float best = -INFINITY; int bi = -1;
        for (int c = 0; c < TOPK * TOPK; ++c) { const float v = s0[c / TOPK] + s1[c % TOPK]; const bool ok = (v < pv) || (v == pv && c > pi); if (ok && v > best) { best = v; bi = c; } }
        if (r == 0) mx = best;
        const float e = expf(best - mx); sum += e;
        p.EIDX()[(size_t)i * TOPK + r] = i0[bi / TOPK] * NK + i1[bi % TOPK]; p.EW()[(size_t)i * TOPK + r] = e; pv = best; pi = bi; }
    for (int r = 0; r < TOPK; ++r) p.EW()[(size_t)i * TOPK + r] /= sum;
}
HD void b_up(const Prm& p, long i) { const long tok = i / NSLOT; const int e = p.EIDX()[i];
    p.EW()[i] *= gelu_exact(b_dot16(p.U() + (size_t)tok * D, p.PU16() + (size_t)e * D, D)); }
HD void b_down(const Prm& p, long i) { const long tok = i / D; const int d = (int)(i % D); const int b = (int)(tok / S); float y = 0.f;
    for (int sl = 0; sl < NSLOT; ++sl) y += p.EW()[tok * NSLOT + sl] * bf2f(p.PV16()[(size_t)p.EIDX()[tok * NSLOT + sl] * D + d]);
    p.out[i] = ALPHA * p.out[i] + p.MOD()[(size_t)b * D6 + 5 * D + d] * y; }
HD void b_ln2(const Prm& p, long row) {
    float* zr = p.out + (size_t)row * D;
    float s = 0.f; for (int d = 0; d < D; ++d) s += zr[d];
    const float mean = s / D; float q = 0.f; for (int d = 0; d < D; ++d) { const float t = zr[d] - mean; q += t * t; }
    const float rstd = 1.f / sqrtf(q / D + LN_EPS);
    for (int d = 0; d < D; ++d) zr[d] = (zr[d] - mean) * rstd * p.ln2_w[d] + p.ln2_b[d];
}
#include <cstdio>
#define LAS __attribute__((address_space(3)))
#define GAS __attribute__((address_space(1)))
namespace pg8 {
#define PG8_LAS __attribute__((address_space(3)))
typedef unsigned short bf16_t;
typedef short bf16x8 __attribute__((ext_vector_type(8)));
typedef float f32x4 __attribute__((ext_vector_type(4)));
typedef unsigned u32x4 __attribute__((ext_vector_type(4)));
constexpr int BM = 256, BK = 64, HALF = 128, HTB = HALF * BK * 2  , STAGE_BYTES = 8 * HTB, NXCD = 8, WGM = 8;

__host__ __device__ __forceinline__ int lds_byte(int r, int c) { const int st = (r >> 4) * 2 + (c >> 5), rr = r & 15, cc = c & 31, ob = rr * 64 + cc * 2; return st * 1024 + (ob ^ (((ob >> 9) & 1) << 5)); }
__host__ __device__ __forceinline__ void stage_rc(int b, int& R, int& C) { const int st = b / 1024, sb = b % 1024, swz = sb ^ (((sb >> 9) & 1) << 5); R = (st >> 1) * 16 + swz / 64; C = (st & 1) * 32 + (swz % 64) / 2; }
__host__ __device__ __forceinline__ int perm32(int rho) { const int n = rho >> 4, i = rho & 15; return 8 * (i >> 2) + 4 * n + (i & 3); }

struct Unit { int pm, pn; };
struct Gemm { const bf16_t* A; const bf16_t* Bt; int M, N, K; };

struct StaticOrder {
    int nM, nN, nwg, G, c;
    __host__ __device__ void init(int M, int N, int G_, int c_) { nM = M / BM; nN = N / BM; nwg = nM * nN; G = G_; c = c_; }
    __host__ __device__ bool next(int i, Unit& u) const {
        const long L = (long)i * G + c; if (L >= nwg) return false;
        int wgid = (int)L; { const int q = nwg / NXCD, r = nwg % NXCD, xcd = wgid % NXCD, off = wgid / NXCD; wgid = (xcd < r ? xcd * (q + 1) : r * (q + 1) + (xcd - r) * q) + off; }
        const int nig = WGM * nN, gid = wgid / nig, fm = gid * WGM, gsz = (nM - fm) < WGM ? (nM - fm) : WGM;
        u.pm = fm + ((wgid % nig) % gsz); u.pn = (wgid % nig) / gsz; return true;
    }
    __device__ __forceinline__ void a_ready(const Unit&) const {}
    __device__ __forceinline__ void done(const Unit&) const {}
};

__device__ __forceinline__ unsigned cvt_pk_bf16(float lo, float hi) { unsigned r; asm volatile("v_cvt_pk_bf16_f32 %0, %1, %2" : "=v"(r) : "v"(lo), "v"(hi)); return r; }
typedef float f32x2 __attribute__((ext_vector_type(2)));
__device__ __forceinline__ f32x2 gelu_pk(f32x2 v) {
    const f32x2 av = __builtin_elementwise_abs(v), d = av * 0.2316418882f + 1.0f;
    f32x2 t; t.x = __builtin_amdgcn_rcpf(d.x); t.y = __builtin_amdgcn_rcpf(d.y);
    f32x2 q = t * 0.5307027145f + (-0.7265760135f); q = q * t + 0.7107068705f; q = q * t + (-0.142248368f); q = q * t + 0.127414796f; q = q * t;
    const f32x2 s = (v * v) * (-0.72134752044f);
    f32x2 e; e.x = __builtin_amdgcn_exp2f(s.x); e.y = __builtin_amdgcn_exp2f(s.y);
    const f32x2 m = v * (q * e), r = v - m;
    f32x2 o; o.x = v.x < 0.f ? m.x : r.x; o.y = v.y < 0.f ? m.y : r.y; return o;
}

template <int ACT  > struct EpiBf16 {
    static constexpr bool PERM = true, AFTER_DRAIN = false; static_assert(ACT == 0 || ACT == 1, "EpiBf16: ACT is 0 (none) or 1 (gelu_pk)");
    bf16_t* O; int ldc; const float* bias; int split_cols; size_t split_stride; float scale0;
    __device__ __forceinline__ void operator()(const f32x4 (&acc)[2][2][4][2], const Unit& u, int wr, int wc, int fr, int fq) const {
        const int row0 = u.pm * BM + wr * 64 + fr; int colt = u.pn * BM; bf16_t* base = O;
        float sc = 1.f; if (split_cols) { const int t = colt / split_cols; base += (size_t)t * split_stride; colt -= t * split_cols; if (t == 0) sc = scale0; }
        const int col0 = colt + wc * 32 + 8 * fq, bcol0 = u.pn * BM + wc * 32 + 8 * fq;
        f32x4 bv[2][2];
#pragma unroll
        for (int bj = 0; bj < 2; ++bj)
#pragma unroll
            for (int n = 0; n < 2; ++n) bv[bj][n] = bias ? *(const f32x4*)(bias + bcol0 + bj * HALF + 4 * n) : (f32x4){0.f, 0.f, 0.f, 0.f};
#pragma unroll
        for (int ai = 0; ai < 2; ++ai)
#pragma unroll
            for (int m = 0; m < 4; ++m) { bf16_t* rowp = base + (size_t)(row0 + ai * HALF + m * 16) * ldc + col0;
#pragma unroll
                for (int bj = 0; bj < 2; ++bj) { f32x4 v0 = acc[ai][bj][m][0] + bv[bj][0], v1 = acc[ai][bj][m][1] + bv[bj][1];
                    if (ACT == 1) { f32x2 a = gelu_pk((f32x2){v0[0], v0[1]}), b = gelu_pk((f32x2){v0[2], v0[3]}), c = gelu_pk((f32x2){v1[0], v1[1]}), d = gelu_pk((f32x2){v1[2], v1[3]});
                        v0 = (f32x4){a.x, a.y, b.x, b.y}; v1 = (f32x4){c.x, c.y, d.x, d.y}; }
                    v0 = v0 * sc; v1 = v1 * sc; u32x4 w; w.x = cvt_pk_bf16(v0[0], v0[1]); w.y = cvt_pk_bf16(v0[2], v0[3]); w.z = cvt_pk_bf16(v1[0], v1[1]); w.w = cvt_pk_bf16(v1[2], v1[3]);
                    *(u32x4*)(rowp + bj * HALF) = w; } }
    }
};
template <class Epi, class Sched, bool ALIGN_EPI = false, bool SP2 = false>
__device__ __forceinline__ void gemm_phase(PG8_LAS unsigned char* lds, const Gemm g, const Sched& S, const Epi& E) {
    const int tid = threadIdx.x, wid = __builtin_amdgcn_readfirstlane(tid >> 6), lane = tid & 63, wr = wid >> 2, wc = wid & 3, fr = lane & 15, fq = lane >> 4;
    const int K = g.K, nt = K / BK;
    unsigned voffA[2], voffB[2];
#pragma unroll
    for (int i = 0; i < 2; ++i) { int R, C; stage_rc(tid * 16 + i * 8192, R, C); const int Rb = Epi::PERM ? ((R & ~31) + perm32(R & 31)) : R;
        voffA[i] = (unsigned)(R * K + C) * 2u; voffB[i] = (unsigned)(Rb * K + C) * 2u; }
    const size_t kstep = (size_t)(BK * 2);
    const size_t hstep = (size_t)HALF * K * 2;
    const size_t tstep = 2 * hstep;
    const unsigned ldsw = (unsigned)wid * 1024u;
    const int aoff = lds_byte(wr * 64 + fr, fq * 8), boff = lds_byte(wc * 32 + fr, fq * 8);
#define PG8_SA(b, h) (((b) * 2 + (h)) * HTB)
#define PG8_SB(b, h) ((4 + (b) * 2 + (h)) * HTB)
#define PG8_STAGE(bufoff, gbase, voff) do { _Pragma("unroll") for (int _i = 0; _i < 2; ++_i) \
        __builtin_amdgcn_global_load_lds((const unsigned*)((const char*)(gbase) + (voff)[_i]), (PG8_LAS unsigned*)(lds + (bufoff) + ldsw + _i * 8192), 16, 0, 0); } while (0)
#define PG8_LDA(dst, b, h) do { _Pragma("unroll") for (int m = 0; m < 4; ++m) _Pragma("unroll") for (int k = 0; k < 2; ++k) dst[m][k] = *(const PG8_LAS bf16x8*)(lds + PG8_SA(b, h) + aoff + m * 2048 + k * 1024); } while (0)
#define PG8_LDB(dst, b, h) do { _Pragma("unroll") for (int n = 0; n < 2; ++n) _Pragma("unroll") for (int k = 0; k < 2; ++k) dst[n][k] = *(const PG8_LAS bf16x8*)(lds + PG8_SB(b, h) + boff + n * 2048 + k * 1024); } while (0)
#define PG8_MMA(ai, bj, At, Bt) do { __builtin_amdgcn_s_setprio(1); _Pragma("unroll") for (int m = 0; m < 4; ++m) _Pragma("unroll") for (int n = 0; n < 2; ++n) _Pragma("unroll") for (int k = 0; k < 2; ++k) \
        acc[ai][bj][m][n] = __builtin_amdgcn_mfma_f32_16x16x32_bf16(Bt[n][k], At[m][k], acc[ai][bj][m][n], 0, 0, 0); __builtin_amdgcn_s_setprio(0); } while (0)
#define PG8_WAIT_V(n) asm volatile("s_waitcnt vmcnt(" #n ")" ::: "memory")
#define PG8_WAIT_L(n) asm volatile("s_waitcnt lgkmcnt(" #n ")" ::: "memory")
#define PG8_BAR __builtin_amdgcn_s_barrier()
#define PG8_SCHED __builtin_amdgcn_sched_barrier(0)
    Unit cur, nxt; int ui = 0;
    if (!S.next(0, cur)) return;
    f32x4 acc[2][2][4][2];
#pragma unroll
    for (int a = 0; a < 2; ++a)
#pragma unroll
        for (int b = 0; b < 2; ++b)
#pragma unroll
            for (int m = 0; m < 4; ++m)
#pragma unroll
                for (int n = 0; n < 2; ++n) acc[a][b][m][n] = (f32x4){0.f, 0.f, 0.f, 0.f};
    bf16x8 At[4][2], B0[2][2], B1[2][2];
    const char* cA = (const char*)g.A + (size_t)cur.pm * tstep; const char* cB = (const char*)g.Bt + (size_t)cur.pn * tstep;
    S.a_ready(cur);
    if constexpr (SP2) {
        PG8_STAGE(PG8_SB(0, 0), cB, voffB); PG8_STAGE(PG8_SB(0, 1), cB + hstep, voffB); PG8_STAGE(PG8_SA(0, 0), cA, voffA); PG8_STAGE(PG8_SA(0, 1), cA + hstep, voffA);
        if (wr == 1) PG8_BAR;
        PG8_WAIT_V(2); PG8_BAR;
        PG8_STAGE(PG8_SB(1, 0), cB + kstep, voffB); PG8_STAGE(PG8_SA(1, 0), cA + kstep, voffA); PG8_STAGE(PG8_SB(1, 1), cB + hstep + kstep, voffB);
        PG8_WAIT_V(6); PG8_BAR;
    } else {
        PG8_STAGE(PG8_SB(0, 0), cB, voffB); PG8_STAGE(PG8_SA(0, 0), cA, voffA); PG8_STAGE(PG8_SB(0, 1), cB + hstep, voffB); PG8_STAGE(PG8_SA(0, 1), cA + hstep, voffA);
        if (wr == 1) PG8_BAR;
        PG8_WAIT_V(4); PG8_BAR;
        PG8_STAGE(PG8_SB(1, 0), cB + kstep, voffB); PG8_STAGE(PG8_SA(1, 0), cA + kstep, voffA); PG8_STAGE(PG8_SB(1, 1), cB + hstep + kstep, voffB);
        PG8_WAIT_V(6); PG8_BAR;
    }
    for (;;) {
        const bool has_next = S.next(ui + 1, nxt);
        const char* nA = has_next ? (const char*)g.A + (size_t)nxt.pm * tstep : cA; const char* nB = has_next ? (const char*)g.Bt + (size_t)nxt.pn * tstep : cB;
        for (int t = 0; t < nt; t += 2) {
            const bool last = (t == nt - 2);
            const char* a1 = cA + (size_t)(t + 1) * kstep;
            const char* a2 = last ? nA : cA + (size_t)(t + 2) * kstep; const char* b2 = last ? nB : cB + (size_t)(t + 2) * kstep;
            const char* a3 = a2 + kstep; const char* b3 = b2 + kstep;
            if (last && has_next) S.a_ready(nxt);
            if constexpr (SP2) {
            PG8_LDB(B0, 0, 0); PG8_LDB(B1, 0, 1); PG8_SCHED; PG8_LDA(At, 0, 0); PG8_STAGE(PG8_SA(1, 1), a1 + hstep, voffA);
            PG8_WAIT_V(8); PG8_WAIT_L(0); PG8_BAR; PG8_MMA(0, 0, At, B0); PG8_MMA(0, 1, At, B1); PG8_BAR; PG8_SCHED;
            PG8_LDA(At, 0, 1); PG8_STAGE(PG8_SB(0, 0), b2, voffB); PG8_STAGE(PG8_SB(0, 1), b2 + hstep, voffB); PG8_STAGE(PG8_SA(0, 0), a2, voffA);
            PG8_WAIT_V(8); PG8_WAIT_L(0); PG8_BAR; PG8_MMA(1, 0, At, B0); PG8_MMA(1, 1, At, B1); PG8_BAR; PG8_SCHED;
            PG8_LDB(B0, 1, 0); PG8_LDB(B1, 1, 1); PG8_SCHED; PG8_LDA(At, 1, 0); PG8_STAGE(PG8_SA(0, 1), a2 + hstep, voffA);
            PG8_WAIT_V(8); PG8_WAIT_L(0); PG8_BAR; PG8_MMA(0, 0, At, B0); PG8_MMA(0, 1, At, B1); PG8_BAR; PG8_SCHED;
            PG8_LDA(At, 1, 1); PG8_STAGE(PG8_SB(1, 0), b3, voffB); PG8_STAGE(PG8_SB(1, 1), b3 + hstep, voffB); PG8_STAGE(PG8_SA(1, 0), a3, voffA);
            PG8_WAIT_V(8); PG8_WAIT_L(0); PG8_BAR; PG8_MMA(1, 0, At, B0); PG8_MMA(1, 1, At, B1); PG8_BAR; PG8_SCHED;
            } else {
            PG8_LDB(B0, 0, 0); PG8_SCHED; PG8_LDA(At, 0, 0); PG8_STAGE(PG8_SA(1, 1), a1 + hstep, voffA);
            PG8_WAIT_L(8); PG8_BAR; PG8_WAIT_L(0); PG8_MMA(0, 0, At, B0); PG8_BAR; PG8_SCHED;
            PG8_LDB(B1, 0, 1); PG8_STAGE(PG8_SB(0, 0), b2, voffB);
            PG8_BAR; PG8_WAIT_L(0); PG8_MMA(0, 1, At, B1); PG8_BAR;
            PG8_LDA(At, 0, 1); PG8_STAGE(PG8_SA(0, 0), a2, voffA);
            PG8_BAR; PG8_WAIT_L(0); PG8_MMA(1, 0, At, B0); PG8_BAR; PG8_SCHED;
            PG8_STAGE(PG8_SB(0, 1), b2 + hstep, voffB);
            PG8_WAIT_V(6); PG8_BAR; PG8_MMA(1, 1, At, B1); PG8_BAR;
            PG8_LDB(B0, 1, 0); PG8_SCHED; PG8_LDA(At, 1, 0); PG8_STAGE(PG8_SA(0, 1), a2 + hstep, voffA);
            PG8_WAIT_L(8); PG8_BAR; PG8_WAIT_L(0); PG8_MMA(0, 0, At, B0); PG8_BAR; PG8_SCHED;
            PG8_LDB(B1, 1, 1); PG8_STAGE(PG8_SB(1, 0), b3, voffB);
            PG8_BAR; PG8_WAIT_L(0); PG8_MMA(0, 1, At, B1); PG8_BAR;
            PG8_LDA(At, 1, 1); PG8_STAGE(PG8_SA(1, 0), a3, voffA);
            PG8_BAR; PG8_WAIT_L(0); PG8_MMA(1, 0, At, B0); PG8_BAR; PG8_SCHED;
            PG8_STAGE(PG8_SB(1, 1), b3 + hstep, voffB);
            PG8_WAIT_V(6); PG8_BAR; PG8_MMA(1, 1, At, B1); PG8_BAR;
            }
        }
        if constexpr (ALIGN_EPI) { if (wr == 0) PG8_BAR; }
        if constexpr (!Epi::AFTER_DRAIN) { E(acc, cur, wr, wc, fr, fq); S.done(cur); }
        if (!has_next) break;
#pragma unroll
        for (int a = 0; a < 2; ++a)
#pragma unroll
            for (int b = 0; b < 2; ++b)
#pragma unroll
                for (int m = 0; m < 4; ++m)
#pragma unroll
                    for (int n = 0; n < 2; ++n) acc[a][b][m][n] = (f32x4){0.f, 0.f, 0.f, 0.f};
        cur = nxt; cA = nA; cB = nB; ++ui;
        if constexpr (ALIGN_EPI) { if (wr == 1) PG8_BAR; }
    }
    PG8_WAIT_V(0);
    if constexpr (!ALIGN_EPI) { if (wr == 0) PG8_BAR; }
    PG8_BAR;
    if constexpr (Epi::AFTER_DRAIN) { E.fused(acc, cur, wr, wc, fr, fq, lds, wid, lane); S.done(cur); }
#undef PG8_SA
#undef PG8_SB
#undef PG8_STAGE
#undef PG8_LDA
#undef PG8_LDB
#undef PG8_MMA
#undef PG8_WAIT_V
#undef PG8_WAIT_L
#undef PG8_BAR
#undef PG8_SCHED
}
}
#define XB_TMO      128
#define XB_XCNT(j)  (256  + 64 * (j))
#define XB_XSUB(j)  (1280 + 64 * (j))
#define XB_XGEN(j)  (2304 + 64 * (j))
#define XB_TOP      3328
#define XB_TOPGEN   3392
#define XCD_BAR_WORDS 3456
#define XB_SPIN_CAP (1u << 18)

__device__ __forceinline__ unsigned xb_ld(unsigned* p)              { return __hip_atomic_load(p, __ATOMIC_RELAXED, __HIP_MEMORY_SCOPE_AGENT); }
__device__ __forceinline__ unsigned xb_add(unsigned* p, unsigned v) { return __hip_atomic_fetch_add(p, v, __ATOMIC_RELAXED, __HIP_MEMORY_SCOPE_AGENT); }
__device__ __forceinline__ unsigned xb_xcc_id() { return (unsigned)__builtin_amdgcn_s_getreg((3 << 11) | 20) & 0xFu; }
#define XB_SPIN(cond, bar) do { unsigned _sp = 0; while (cond) { __builtin_amdgcn_s_sleep(1); \
    if ((++_sp & 255u) == 0u) { if (xb_ld(&(bar)[XB_TMO])) break; if (_sp > XB_SPIN_CAP) { atomicAdd(&(bar)[XB_TMO], 1u); break; } } } } while (0)

struct XcdBarrier {
    unsigned* bar; unsigned x;
    volatile LAS unsigned* st;
};

__device__ __forceinline__ XcdBarrier xcd_barrier_post(unsigned* bar, volatile LAS unsigned* st) {
    XcdBarrier b; b.bar = bar; b.x = xb_xcc_id(); b.st = st;
    if (threadIdx.x == 0) st[2] = xb_add(&bar[XB_XCNT(b.x)], 1u) + 1u;
    return b;
}
__device__ __forceinline__ void xcd_barrier_complete(unsigned* bar, unsigned x, unsigned& nloc, unsigned& nx) {
    const unsigned G = gridDim.x * gridDim.y * gridDim.z;
    unsigned sum, cnt, mine, sp = 0u;
    for (;;) {
        sum = 0u; cnt = 0u; mine = 0u;
#pragma unroll
        for (unsigned j = 0; j < 16; ++j) { const unsigned c = xb_ld(&bar[XB_XCNT(j)]); sum += c; cnt += (c > 0u) ? 1u : 0u; mine = (j == x) ? c : mine; }
        if (sum == G) break;
        __builtin_amdgcn_s_sleep(1);
        if ((++sp & 255u) == 0u) { if (xb_ld(&bar[XB_TMO])) break; if (sp > XB_SPIN_CAP) { atomicAdd(&bar[XB_TMO], 1u); break; } }
    }
    nloc = mine > 0u ? mine : 1u; nx = cnt > 0u ? cnt : 1u;
}

__device__ __forceinline__ void xcd_barrier(const XcdBarrier& b) {
    asm volatile("s_waitcnt vmcnt(0)" ::: "memory");
    __syncthreads();
    if (threadIdx.x == 0) {
        unsigned* bar = b.bar;
        __builtin_amdgcn_s_waitcnt(0);
        unsigned nloc = b.st[0], nx = b.st[1];
        if (nloc == 0u) { xcd_barrier_complete(bar, b.x, nloc, nx); b.st[0] = nloc; b.st[1] = nx; }
        const unsigned old = xb_add(&bar[XB_XSUB(b.x)], 1u);
        const unsigned gen = old / nloc;
        if (old + 1u == (gen + 1u) * nloc) {
            __builtin_amdgcn_fence(__ATOMIC_RELEASE, "agent");
            asm volatile("s_waitcnt vmcnt(0)" ::: "memory");
            const unsigned og = xb_add(&bar[XB_TOP], 1u);
            const unsigned tg = og / nx;
            if (og + 1u == (tg + 1u) * nx) xb_add(&bar[XB_TOPGEN], 1u);
            else XB_SPIN(xb_ld(&bar[XB_TOPGEN]) == tg, bar);
            __builtin_amdgcn_fence(__ATOMIC_ACQUIRE, "agent");
            xb_add(&bar[XB_XGEN(b.x)], 1u);
            asm volatile("s_waitcnt vmcnt(0)" ::: "memory");
        } else {
            XB_SPIN(xb_ld(&bar[XB_XGEN(b.x)]) == gen, bar);
            __builtin_amdgcn_fence(__ATOMIC_ACQUIRE, "agent");
            asm volatile("s_waitcnt vmcnt(0)" ::: "memory");
        }
    }
    __syncthreads();
}
constexpr int NWAVES = 8, NTHR = 512;
constexpr int RING_BYTES = 131072, LDSCTL_OFF = RING_BYTES, MISC_OFF = LDSCTL_OFF + 320, LDS_BYTES = 163840;
constexpr int CW_BAR = 4096;
#ifndef MK_N_LAUNCHES
#define MK_N_LAUNCHES 1
#endif
constexpr int NPHASE = 13;

typedef float f4v __attribute__((ext_vector_type(4)));
typedef unsigned u2v __attribute__((ext_vector_type(2)));
typedef unsigned u32x4_t __attribute__((ext_vector_type(4)));
struct Frame { LAS unsigned char* lds; int tid, lane, wave, G, bid; };
template <int CTRL, int ROWMASK> __device__ __forceinline__ float dppf(float old, float src) {
    return __builtin_bit_cast(float, __builtin_amdgcn_update_dpp(__builtin_bit_cast(int, old), __builtin_bit_cast(int, src), CTRL, ROWMASK, 0xf, false)); }
__device__ __forceinline__ float wave_scan_add(float v) {
    v += dppf<0x111, 0xf>(0.f, v); v += dppf<0x112, 0xf>(0.f, v); v += dppf<0x114, 0xf>(0.f, v); v += dppf<0x118, 0xf>(0.f, v);
    v += dppf<0x142, 0xa>(0.f, v); v += dppf<0x143, 0xc>(0.f, v); return v; }
__device__ __forceinline__ float wave_scan_max(float v) {
    const float NI = -INFINITY;
    v = fmaxf(v, dppf<0x111, 0xf>(NI, v)); v = fmaxf(v, dppf<0x112, 0xf>(NI, v)); v = fmaxf(v, dppf<0x114, 0xf>(NI, v)); v = fmaxf(v, dppf<0x118, 0xf>(NI, v));
    v = fmaxf(v, dppf<0x142, 0xa>(NI, v)); v = fmaxf(v, dppf<0x143, 0xc>(NI, v)); return v; }
__device__ __forceinline__ float lane_bcast(float v, int l) { return __builtin_bit_cast(float, __builtin_amdgcn_readlane(__builtin_bit_cast(int, v), l)); }
__device__ __forceinline__ float wave_sum(float v) { return lane_bcast(wave_scan_add(v), 63); }
__device__ __forceinline__ unsigned pk2(float lo, float hi) { return (unsigned)f2bf(lo) | ((unsigned)f2bf(hi) << 16); }
__device__ __forceinline__ float bflo(unsigned w) { return u_as_f(w << 16); }
__device__ __forceinline__ float bfhi(unsigned w) { return u_as_f(w & 0xffff0000u); }

__device__ __forceinline__ void p0_ada_item(const Prm& p, const Frame& F, int item) {
    static_assert(D6 % 2048 == 0 && D % NKS == 0 && D / NKS == 64, "ada item shape");
    LAS float* sl = (LAS float*)F.lds;
    const int ks = item / (D6 / 2048), cg = item % (D6 / 2048), k0 = ks * 64, n0 = cg * 2048 + 4 * F.tid;
    { const int b = F.tid / 64, k = F.tid % 64; const float cv = p.c[b * D + k0 + k]; sl[F.tid] = cv / (1.f + __expf(-cv)); }
    __syncthreads();
    f4v acc[NB];
#pragma unroll
    for (int b = 0; b < NB; ++b) acc[b] = (f4v){0.f, 0.f, 0.f, 0.f};
    const float* wp = p.w_ada + (size_t)k0 * D6 + n0;
#pragma unroll 8
    for (int k = 0; k < 64; ++k) { const f4v w = *(const f4v*)(wp + (size_t)k * D6);
#pragma unroll
        for (int b = 0; b < NB; ++b) acc[b] += w * sl[b * 64 + k]; }
#pragma unroll
    for (int b = 0; b < NB; ++b) *(f4v*)(p.MODP() + ((size_t)ks * NB + b) * D6 + n0) = acc[b];
    __syncthreads();
}
__device__ __forceinline__ void p0_transpose_item(const float* W, int ldw, int K, int N, bf16_t* WT, LAS float* scr, int item, int lane) {
    const int nblk = N / 32, kb = item / nblk, nb = item % nblk, k0 = 64 * kb, n0 = 32 * nb;
#pragma unroll
    for (int i = 0; i < 32; ++i) { const int kk = 2 * i + (lane >> 5); scr[kk * 33 + (lane & 31)] = W[(size_t)(k0 + kk) * ldw + n0 + (lane & 31)]; }
    asm volatile("s_waitcnt lgkmcnt(0)" ::: "memory");
    const int c = lane & 7;
#pragma unroll
    for (int j = 0; j < 4; ++j) { const int n = (lane >> 3) + 8 * j; const LAS float* s = scr + (8 * c) * 33 + n;
        uint4 o; o.x = pk2(s[0 * 33], s[1 * 33]); o.y = pk2(s[2 * 33], s[3 * 33]); o.z = pk2(s[4 * 33], s[5 * 33]); o.w = pk2(s[6 * 33], s[7 * 33]);
        *(uint4*)(WT + (size_t)(n0 + n) * K + k0 + 8 * c) = o; }
    asm volatile("s_waitcnt lgkmcnt(0)" ::: "memory");
}

__device__ __forceinline__ void p0_fold_item(const Prm& p, int item, int lane) {
    static_assert(NK == 128 && KH == 128 && NQ == 2048, "fold item decomposition");
    const int ks = item & 31, nt = (item >> 5) & 7, g = item >> 8;
    const int r = lane & 15, q = lane >> 4;
    const float* arow = p.subkeys + ((size_t)g * NK + nt * 16 + r) * KH + 4 * q;
    const float* brow = p.wq + (size_t)(ks * 64 + r) * NQ + g * KH + 4 * q;
    pg8::f32x4 acc[4];
#pragma unroll
    for (int c = 0; c < 4; ++c) acc[c] = (pg8::f32x4){0.f, 0.f, 0.f, 0.f};
#pragma unroll 2
    for (int s16 = 0; s16 < KH; s16 += 16) {
        const pg8::f32x4 a = *(const pg8::f32x4*)(arow + s16); pg8::f32x4 bv[4];
#pragma unroll
        for (int c = 0; c < 4; ++c) bv[c] = *(const pg8::f32x4*)(brow + (size_t)(c * 16) * NQ + s16);
#pragma unroll
        for (int i = 0; i < 4; ++i)
#pragma unroll
            for (int c = 0; c < 4; ++c) acc[c] = __builtin_amdgcn_mfma_f32_16x16x4f32(a[i], bv[c][i], acc[c], 0, 0, 0);
    }
#pragma unroll
    for (int c = 0; c < 4; ++c)
#pragma unroll
        for (int i = 0; i < 4; ++i) p.WQ_T()[(size_t)(g * NK + nt * 16 + 4 * q + i) * D + ks * 64 + c * 16 + r] = f2bf(acc[c][i]);
}
__device__ __forceinline__ void phase0(const Prm& p, const Frame& F) {
    for (int it = F.bid; it < NKS * (D6 / 2048); it += F.G) p0_ada_item(p, F, it);
    LAS float* scr = (LAS float*)(F.lds + F.wave * 16384);
    const int gw = F.bid * NWAVES + F.wave, NGW = F.G * NWAVES;
    constexpr int I_IN = (D / 64) * (INM / 32);
    for (int it = gw; it < I_IN; it += NGW) p0_transpose_item(p.w_in, INC, D, INM, p.WIN_T(), scr, it, F.lane);
}
template <bool PART_A, bool PART_B>
__device__ __forceinline__ void deferred_prep(const Prm& p, const Frame& F, int b0, int nb) {
    __syncthreads();
    LAS float* scr = (LAS float*)(F.lds + F.wave * 16384);
    const int gw = (F.bid - b0) * NWAVES + F.wave, NGW = nb * NWAVES;
    constexpr int I_O = (D / 64) * (D / 32), I_Q = 32 * 8 * 16;
    if (PART_A) for (int it = gw; it < I_O + I_Q; it += NGW) {
        if (it < I_O) { p0_transpose_item(p.w_out, D, D, D, p.WOUT_T(), scr, it, F.lane); continue; }
        p0_fold_item(p, it - I_O, F.lane);
    }
    if (PART_A) {
        float4 v[8], vn[8]; int rr = gw;
#define P0_ROWSRC(rr_) ((const float4*)(p.peer_u + (size_t)(rr_) * D) + F.lane)
        if (rr < NE) { const float4* src = P0_ROWSRC(rr);
#pragma unroll
            for (int j = 0; j < 8; ++j) v[j] = src[64 * j]; }
        for (; rr < NE; rr += NGW) {
            const int rn = rr + NGW;
            if (rn < NE) { const float4* src = P0_ROWSRC(rn);
#pragma unroll
                for (int j = 0; j < 8; ++j) vn[j] = src[64 * j]; }
            const int e = rr; float am = 0.f;
#pragma unroll
            for (int j = 0; j < 8; ++j) am = fmaxf(am, fmaxf(fmaxf(fabsf(v[j].x), fabsf(v[j].y)), fmaxf(fabsf(v[j].z), fabsf(v[j].w))));
#pragma unroll
            for (int o = 1; o < 64; o <<= 1) am = fmaxf(am, __shfl_xor(am, o));
            const float sc = am > 0.f ? 384.f / am : 1.f;
            unsigned* dst = (unsigned*)(p.PU8() + (size_t)e * D) + F.lane;
#pragma unroll
            for (int j = 0; j < 8; ++j) { unsigned w = 0u; w = __builtin_amdgcn_cvt_pk_fp8_f32(v[j].x * sc, v[j].y * sc, w, false); w = __builtin_amdgcn_cvt_pk_fp8_f32(v[j].z * sc, v[j].w * sc, w, true); dst[64 * j] = w; }
            if (F.lane == 0) p.RSU()[e] = am > 0.f ? am / 384.f : 1.f;
#pragma unroll
            for (int j = 0; j < 8; ++j) v[j] = vn[j];
        }
#undef P0_ROWSRC
    }
    if (PART_B) { LAS unsigned char* tl = F.lds; constexpr int RS_ = 2056;
      for (int tile = F.bid - b0; tile < NE / 16; tile += nb) { const int row = F.tid >> 5, l32 = F.tid & 31, e = tile * 16 + row;
        __syncthreads();
        const f4v* src = (const f4v*)(p.peer_v + (size_t)e * D) + l32; f4v x[16]; float am = 0.f;
#pragma unroll
        for (int j = 0; j < 16; ++j) { x[j] = src[32 * j]; am = fmaxf(am, fmaxf(fmaxf(fabsf(x[j][0]), fabsf(x[j][1])), fmaxf(fabsf(x[j][2]), fabsf(x[j][3])))); }
#pragma unroll
        for (int o = 1; o < 32; o <<= 1) am = fmaxf(am, __shfl_xor(am, o));
        const float sc = am > 0.f ? 384.f / am : 1.f;
#pragma unroll
        for (int j = 0; j < 16; ++j) { unsigned w = 0u; w = __builtin_amdgcn_cvt_pk_fp8_f32(x[j][0] * sc, x[j][1] * sc, w, false); w = __builtin_amdgcn_cvt_pk_fp8_f32(x[j][2] * sc, x[j][3] * sc, w, true);
            *(LAS unsigned*)(tl + row * RS_ + 4 * (l32 + 32 * j)) = w; }
        if (l32 == 0) p.RSV()[e] = am > 0.f ? am / 384.f : 1.f;
        __syncthreads();
#pragma unroll
        for (int k = 0; k < 8; ++k) { const int idx = F.tid + NTHR * k, r = idx & 15, sl = idx >> 4;
            *(u2v*)(p.PV8S() + ((size_t)sl * NE + tile * 16 + r) * 8) = *(const LAS u2v*)(tl + r * RS_ + 8 * sl); }
      } }
}
__device__ __forceinline__ void phase1(const Prm& p, const Frame& F) {
    LAS float* SH = (LAS float*)F.lds; LAS float* SC1 = SH + D;
    LAS bf16_t* WG = (LAS bf16_t*)(F.lds + 2 * D * 4);
    const int rows_per = T / F.G;
    for (int idx = F.bid * NTHR + F.tid; idx < NB * D6; idx += F.G * NTHR) {
        const int n = idx % D6, b = idx / D6; float s = 0.f;
        for (int ks = 0; ks < NKS; ++ks) s += p.MODP()[((size_t)ks * NB + b) * D6 + n];
        p.MOD()[idx] = s + p.b_ada[n]; }
    { const int st = (F.bid * 37) % (NG * D / NTHR);
      for (int k = 0; k < NG * D / NTHR; ++k) { const int idx = F.tid + NTHR * ((k + st) % (NG * D / NTHR)); const int d = idx / NG, g = idx % NG; WG[g * D + d] = f2bf(p.w_in[(size_t)d * INC + INM + g]); } }
    int cur_b = -1;
    float4 xpre[8];
    { const float4* x0 = (const float4*)(p.x + (size_t)(F.bid * rows_per + F.wave) * D) + F.lane;
#pragma unroll
      for (int j = 0; j < 8; ++j) xpre[j] = x0[64 * j]; }
    for (int r0 = F.bid * rows_per; r0 < (F.bid + 1) * rows_per; r0 += NWAVES) {
        const int b = r0 / S;
        if (b != cur_b) { __syncthreads();
            for (int n = F.tid; n < 2 * D; n += NTHR) { float s = 0.f; const int ks0 = F.bid % NKS; for (int kk = 0; kk < NKS; ++kk) { const int ks = (kk + ks0) % NKS; s += p.MODP()[((size_t)ks * NB + b) * D6 + n]; }
                s += p.b_ada[n]; SH[n] = n < D ? s : 1.f + s; }
            cur_b = b; __syncthreads(); }
        const int row = r0 + F.wave;
        float4 v[8]; float s = 0.f;
#pragma unroll
        for (int j = 0; j < 8; ++j) v[j] = xpre[j];
        if (r0 + NWAVES < (F.bid + 1) * rows_per) { const float4* xn = (const float4*)(p.x + (size_t)(row + NWAVES) * D) + F.lane;
#pragma unroll
            for (int j = 0; j < 8; ++j) xpre[j] = xn[64 * j]; }
#pragma unroll
        for (int j = 0; j < 8; ++j) s += (v[j].x + v[j].y) + (v[j].z + v[j].w);
        const float mean = wave_sum(s) * (1.f / D); float s2 = 0.f;
#pragma unroll
        for (int j = 0; j < 8; ++j) { v[j].x -= mean; v[j].y -= mean; v[j].z -= mean; v[j].w -= mean; s2 += (v[j].x * v[j].x + v[j].y * v[j].y) + (v[j].z * v[j].z + v[j].w * v[j].w); }
        const float rstd = 1.f / sqrtf(wave_sum(s2) * (1.f / D) + LN_EPS);
        uint2* o8 = (uint2*)(p.U() + (size_t)row * D) + F.lane;
#pragma unroll
        for (int j = 0; j < 8; ++j) { const int c0 = 4 * F.lane + 256 * j; const f4v sh = *(const LAS f4v*)(SH + c0), sc = *(const LAS f4v*)(SC1 + c0);
            v[j].x = v[j].x * rstd * sc.x + sh.x; v[j].y = v[j].y * rstd * sc.y + sh.y; v[j].z = v[j].z * rstd * sc.z + sh.z; v[j].w = v[j].w * rstd * sc.w + sh.w;
            o8[64 * j] = make_uint2(pk2(v[j].x, v[j].y), pk2(v[j].z, v[j].w)); }
        float ga[NG];
#pragma unroll
        for (int g = 0; g < NG; ++g) { float a = 0.f;
#pragma unroll
            for (int j = 0; j < 8; ++j) { const u2v w = *(const LAS u2v*)(WG + g * D + 4 * F.lane + 256 * j); a += v[j].x * bflo(w.x) + v[j].y * bfhi(w.x) + v[j].z * bflo(w.y) + v[j].w * bfhi(w.y); }
            ga[g] = a; }
        float r8[8], r4[4], r2[2]; const bool l0 = F.lane & 1, l1 = F.lane & 2, l2 = F.lane & 4, l3 = F.lane & 8;
#pragma unroll
        for (int i = 0; i < 8; ++i) { const float keep = l0 ? ga[8 + i] : ga[i], send = l0 ? ga[i] : ga[8 + i]; r8[i] = keep + __shfl_xor(send, 1); }
#pragma unroll
        for (int i = 0; i < 4; ++i) { const float keep = l1 ? r8[4 + i] : r8[i], send = l1 ? r8[i] : r8[4 + i]; r4[i] = keep + __shfl_xor(send, 2); }
#pragma unroll
        for (int i = 0; i < 2; ++i) { const float keep = l2 ? r4[2 + i] : r4[i], send = l2 ? r4[i] : r4[2 + i]; r2[i] = keep + __shfl_xor(send, 4); }
        float gacc = (l3 ? r2[1] : r2[0]) + __shfl_xor(l3 ? r2[0] : r2[1], 8);
        gacc += __shfl_xor(gacc, 16); gacc += __shfl_xor(gacc, 32);
        const int gi = (l0 ? 8 : 0) + (l1 ? 4 : 0) + (l2 ? 2 : 0) + (l3 ? 1 : 0);
        if (F.lane < NG) p.GATES()[(size_t)row * NG + gi] = gacc + p.b_in[INM + gi];
    }
}
__device__ __forceinline__ void phase3a(const Prm& p, const Frame& F, int b0, int nb) {
    const size_t gt = (size_t)(F.bid - b0) * NTHR + F.tid, GT = (size_t)nb * NTHR;
    for (size_t i = gt; i < (size_t)T * (CW / 8); i += GT) {
        const size_t row = i / (CW / 8); const int ch = (int)(i % (CW / 8)) * 8, s = (int)(row % S);
        float acc[8];
#pragma unroll
        for (int e = 0; e < 8; ++e) acc[e] = p.conv_b[ch + e];
#pragma unroll
        for (int k = 0; k < 3; ++k) { const int s2 = s + k - 1; if (s2 < 0 || s2 >= S) continue; const bf16_t* pr = p.PJ() + (size_t)(row + k - 1) * INM;
            const uint4 gc = *(const uint4*)(pr + O_GC + ch), hi = *(const uint4*)(pr + O_HIN + ch); const float* cw = p.conv_w + k * CW + ch;
            acc[0] += cw[0] * (bflo(gc.x) * bflo(hi.x)); acc[1] += cw[1] * (bfhi(gc.x) * bfhi(hi.x)); acc[2] += cw[2] * (bflo(gc.y) * bflo(hi.y)); acc[3] += cw[3] * (bfhi(gc.y) * bfhi(hi.y));
            acc[4] += cw[4] * (bflo(gc.z) * bflo(hi.z)); acc[5] += cw[5] * (bfhi(gc.z) * bfhi(hi.z)); acc[6] += cw[6] * (bflo(gc.w) * bflo(hi.w)); acc[7] += cw[7] * (bfhi(gc.w) * bfhi(hi.w)); }
        const uint4 gb = *(const uint4*)(p.PJ() + row * INM + O_GB + ch); uint4 o;
        o.x = pk2(bflo(gb.x) * acc[0], bfhi(gb.x) * acc[1]); o.y = pk2(bflo(gb.y) * acc[2], bfhi(gb.y) * acc[3]); o.z = pk2(bflo(gb.z) * acc[4], bfhi(gb.z) * acc[5]); o.w = pk2(bflo(gb.w) * acc[6], bfhi(gb.w) * acc[7]);
        *(uint4*)(p.Y() + row * D + ch) = o; }
}
namespace ml {
typedef short bf16x8 __attribute__((ext_vector_type(8)));
typedef short s16x4 __attribute__((ext_vector_type(4)));
typedef float f32x4 __attribute__((ext_vector_type(4)));
typedef float f32x2_t __attribute__((ext_vector_type(2)));
typedef __bf16 bf16x2_t __attribute__((ext_vector_type(2)));
typedef unsigned u32x4 __attribute__((ext_vector_type(4)));
typedef unsigned u32x2 __attribute__((ext_vector_type(2)));
constexpr unsigned IMG = 16384u, BUF = 3u * IMG, PT_OFF = 2u * BUF, PT_BYTES = 8192u, N_OFF = PT_OFF + 2u * PT_BYTES;
constexpr unsigned SCT_OFF = 149504u, SCT_BYTES = 1024u;
constexpr unsigned HT_OFF = 133120u;
static_assert(N_OFF + 1024u <= 131072u && HT_OFF + 16384u <= SCT_OFF && SCT_OFF + 3u * SCT_BYTES <= 163840u, "mLSTM LDS map");
__device__ __forceinline__ unsigned cvtpk(float lo, float hi) { f32x2_t v = {lo, hi}; bf16x2_t b = __builtin_convertvector(v, bf16x2_t); return __builtin_bit_cast(unsigned, b); }
__device__ __forceinline__ unsigned off_a(unsigned row, unsigned ch) { return 2048u * (row >> 3) + 512u * (ch >> 2) + 64u * (row & 7u) + 16u * ((ch & 3u) ^ ((row >> 2) & 3u)); }
__device__ __forceinline__ unsigned off_p(unsigned row, unsigned ch) { return 128u * row + 16u * (ch ^ (row & 7u)); }
typedef short v4i16_t __attribute__((ext_vector_type(4)));
__device__ __forceinline__ s16x4 trr(LAS unsigned char* p) { return __builtin_bit_cast(s16x4, __builtin_amdgcn_ds_read_tr16_b64_v4i16((LAS v4i16_t*)p)); }
__device__ __forceinline__ bf16x8 cat8(s16x4 a, s16x4 b) { return (bf16x8){a[0], a[1], a[2], a[3], b[0], b[1], b[2], b[3]}; }
struct CS { float decay, m_next; };
__device__ __forceinline__ CS chunk_scalars(float ig, float fg, float m, LAS float* tab, bool writer, unsigned lane) {
    const float lf = logsigmoidf_(fg);
    const float bc = wave_scan_add(lf), gg = ig - bc, cm = wave_scan_max(gg);
    const float G = fmaxf(m, cm), G63 = lane_bcast(G, 63), b63 = lane_bcast(bc, 63), qs = 0.08838834764831845f;
    if (writer) { tab[lane] = __expf(fminf(G63 - G, 80.f)) * qs; tab[64 + lane] = __expf(m - G) * qs; tab[128 + lane] = __expf(-(bc + G)); tab[192 + lane] = __expf(gg - G63); }
    CS r; r.decay = __expf(m - G63); r.m_next = b63 + G63;
    return r;
}
__device__ __forceinline__ void unit(const Prm& p, const Frame& F, int u) {
    static_assert(QK == 128 && MV == 256 && CHUNK == 64 && S % 64 == 0, "mLSTM unit is specialised");
    const int vhalf = u & 1, h = (u >> 1) & 3, b = (u >> 3) & 7, dir = u >> 6;
    const unsigned lane = F.lane, tid = F.tid; const int wave = F.wave; const unsigned q = lane >> 4, r = lane & 15u;
    LAS unsigned char* L = F.lds;
    const unsigned rx = (r >> 2) & 3u, rlo = 2048u * (r >> 3) + 64u * (r & 7u);
    const unsigned RA = rlo + 16u * (q ^ rx), PB1 = rlo + 16u * ((q >> 1) ^ rx) + 8u * (q & 1u), PB2 = rlo + 16u * ((2u + (q >> 1)) ^ rx) + 8u * (q & 1u);
    const unsigned pp = lane & 3u, tlo = 2048u * q + 64u * rx + 8u * (pp & 1u);
    const unsigned tb00 = tlo + 16u * ((pp >> 1) ^ ((2u * q) & 3u)), tb01 = tlo + 256u + 16u * ((pp >> 1) ^ ((2u * q + 1u) & 3u));
    const unsigned tb10 = tlo + 16u * ((2u + (pp >> 1)) ^ ((2u * q) & 3u)), tb11 = tlo + 256u + 16u * ((2u + (pp >> 1)) ^ ((2u * q + 1u) & 3u));
    const unsigned PP0 = 128u * r + 16u * (q ^ (r & 7u)), PP1 = 128u * r + 16u * ((4u + q) ^ (r & 7u));
#define ML_TRA(c, ks, t) ((((c) & 1) ? ((t) ? tb11 : tb10) : ((t) ? tb01 : tb00)) + 8192u * (ks) + 512u * ((unsigned)(c) >> 1))
    __syncthreads();
    for (unsigned i = tid; i < (2u * PT_BYTES + 1024u) / 16u; i += NTHR) *(LAS u32x4*)(L + PT_OFF + 16u * i) = (u32x4){0u, 0u, 0u, 0u};
    f32x4 C[8];
#pragma unroll
    for (int i = 0; i < 8; ++i) C[i] = (f32x4){0.f, 0.f, 0.f, 0.f};
    float m = 0.f;
    const bf16_t* pj = p.PJ(); bf16_t* H = dir ? p.HB16() : p.HF16();
    const int colq = O_Q + h * QK, colk = O_K + h * QK, colv = O_V + h * MV + vhalf * 128;
    const unsigned srow0 = tid >> 4, sch = tid & 15u;
    u32x4 rq[2], rk[2], rv[2];
    const float* gbase = p.GATES() + dir * 8 + h;
#define ML_GATES(c, ig_, fg_) do { const float* g_ = gbase + (size_t)ml_tok(dir, b, (c) * 64 + (int)lane) * NG; ig_ = g_[0]; fg_ = g_[4]; } while (0)
    float ig0, fg0, ign = 0.f, fgn = 0.f; ML_GATES(0, ig0, fg0); if (S / 64 > 1) ML_GATES(1, ign, fgn);
#define ML_TAB(c) ((LAS float*)(L + SCT_OFF + (unsigned)((c) % 3) * SCT_BYTES))
    CS cs = chunk_scalars(ig0, fg0, m, ML_TAB(0), wave == 0, lane), csn = cs;
    const long sMW = dir ? -(long)MW : (long)MW;
#define ML_LOAD(c) do { _Pragma("unroll") for (int i_ = 0; i_ < 2; ++i_) { const bf16_t* rp = pj + (size_t)ml_tok(dir, b, (c) * 64 + srow0 + 32 * i_) * INM + 8 * sch; \
        rq[i_] = *(const u32x4*)(rp + colq); rk[i_] = *(const u32x4*)(rp + colk); rv[i_] = *(const u32x4*)(rp + colv); } } while (0)
#define ML_STORE(buf, S_) do { _Pragma("unroll") for (int i_ = 0; i_ < 2; ++i_) { const unsigned row = srow0 + 32u * i_, o = (buf) * BUF + off_a(row, sch); const float w = (S_)[192 + row]; \
        *(LAS u32x4*)(L + o) = rq[i_]; *(LAS u32x4*)(L + IMG + o) = rk[i_]; u32x4 v = rv[i_]; \
        v.x = cvtpk(bflo(v.x) * w, bfhi(v.x) * w); v.y = cvtpk(bflo(v.y) * w, bfhi(v.y) * w); v.z = cvtpk(bflo(v.z) * w, bfhi(v.z) * w); v.w = cvtpk(bflo(v.w) * w, bfhi(v.w) * w); \
        *(LAS u32x4*)(L + 2u * IMG + o) = v; } } while (0)
    __syncthreads();
    ML_LOAD(0); ML_STORE(0u, ML_TAB(0)); if (S / 64 > 1) ML_LOAD(1);
    constexpr int NC = S / 64;
    for (int c = 0; c < NC; ++c) {
        const unsigned cur = (unsigned)(c & 1);
        LAS unsigned char* Qi = L + cur * BUF; LAS unsigned char* Ki = Qi + IMG; LAS unsigned char* Vi = Qi + 2u * IMG; LAS unsigned char* Pt = L + PT_OFF + cur * PT_BYTES;
        float ig2 = 0.f, fg2 = 0.f;
        if (c + 1 < NC) { csn = chunk_scalars(ign, fgn, cs.m_next, ML_TAB(c + 1), wave == 0, lane); if (c + 2 < NC) ML_GATES(c + 2, ig2, fg2); }
        __syncthreads();
#define ML_FLUSH(cprev) do { _Pragma("unroll") for (int i_ = 0; i_ < 2; ++i_) { const unsigned n_ = tid + 512u * i_, row_ = n_ >> 4, ch_ = n_ & 15u;     \
            const u32x4 v_ = *(const LAS u32x4*)(L + HT_OFF + 256u * row_ + 16u * (ch_ ^ (row_ & 15u))); \
            *(u32x4*)(H + (size_t)ml_tok(dir, b, (cprev) * 64 + (int)row_) * MW + h * MV + vhalf * 128 + 8 * (int)ch_) = v_; } } while (0)
        const LAS float* sct = ML_TAB(c);
        if (c > 0) ML_FLUSH(c - 1);
#ifndef ML_REP_3B
#define ML_REP_3B 1
#define ML_REP_S 1
#define ML_REP_ST 1
#define ML_REP_3A 1
#define ML_REP_DEN 1
#endif
        f32x4 acc2[4];
#pragma unroll
        for (int tt = 0; tt < 4; ++tt) acc2[tt] = (f32x4){0.f, 0.f, 0.f, 0.f};
#pragma unroll
        for (int ks = 0; ks < 4; ++ks) {
            bf16x8 qa[4];
#pragma unroll
            for (int tt = 0; tt < 4; ++tt) {
                const u32x2 lo = *(const LAS u32x2*)(Qi + PB1 + 4096u * tt + 512u * ks), hi = *(const LAS u32x2*)(Qi + PB2 + 4096u * tt + 512u * ks);
                const u32x4 aw = {lo.x, lo.y, hi.x, hi.y}; qa[tt] = __builtin_bit_cast(bf16x8, aw); }
            const f32x4 c0 = C[2 * ks], c1 = C[2 * ks + 1];
            const u32x4 bw = {cvtpk(c0[0], c0[1]), cvtpk(c0[2], c0[3]), cvtpk(c1[0], c1[1]), cvtpk(c1[2], c1[3])}; const bf16x8 bfr = __builtin_bit_cast(bf16x8, bw);
#pragma unroll
            for (int tt = 0; tt < 4; ++tt) acc2[tt] = __builtin_amdgcn_mfma_f32_16x16x32_bf16(qa[tt], bfr, acc2[tt], 0, 0, 0);
        }
        bf16x8 vB[2];
#pragma unroll
        for (int ks = 0; ks < 2; ++ks) vB[ks] = cat8(trr(Vi + ML_TRA(wave, ks, 0)), trr(Vi + ML_TRA(wave, ks, 1)));
#pragma unroll
        for (int dt = 0; dt < 8; ++dt) C[dt] = C[dt] * cs.decay;
#pragma unroll
        for (int ks = 0; ks < 2; ++ks)
#pragma unroll
            for (int dh = 0; dh < 2; ++dh) { bf16x8 kA[4];
#pragma unroll
                for (int d4 = 0; d4 < 4; ++d4) kA[d4] = cat8(trr(Ki + ML_TRA(4 * dh + d4, ks, 0)), trr(Ki + ML_TRA(4 * dh + d4, ks, 1)));
#pragma unroll
                for (int d4 = 0; d4 < 4; ++d4) C[4 * dh + d4] = __builtin_amdgcn_mfma_f32_16x16x32_bf16(kA[d4], vB[ks], C[4 * dh + d4], 0, 0, 0); }
#pragma unroll
        for (int rep = 0; rep < 2; ++rep) { const int idx = wave + (rep ? 2 : 0);
            if (rep == 0 || wave >= 6) { const int tt = idx >= 6 ? 3 : (idx >= 3 ? 2 : (idx >= 1 ? 1 : 0)), st = idx - tt * (tt + 1) / 2;
                f32x4 sa = (f32x4){0.f, 0.f, 0.f, 0.f};
#pragma unroll
                for (int kh = 0; kh < 2; ++kh) { bf16x8 af[2], bfk[2];
#pragma unroll
                    for (int k2 = 0; k2 < 2; ++k2) { af[k2] = *(const LAS bf16x8*)(Qi + RA + 4096u * tt + 512u * (2 * kh + k2)); bfk[k2] = *(const LAS bf16x8*)(Ki + RA + 4096u * st + 512u * (2 * kh + k2)); }
#pragma unroll
                    for (int k2 = 0; k2 < 2; ++k2) sa = __builtin_amdgcn_mfma_f32_16x16x32_bf16(af[k2], bfk[k2], sa, 0, 0, 0); }
                const unsigned scol = 16u * st + r;
#pragma unroll
                for (int i = 0; i < 4; ++i) { const unsigned trow = 16u * tt + 4u * q + i; const float v = scol <= trow ? sa[i] : 0.f;
                    *(LAS bf16_t*)(Pt + off_p(trow, scol >> 3) + 2u * (scol & 7u)) = (bf16_t)cvtpk(v, 0.f); } } }
        if (c + 1 < NC) { ML_STORE(cur ^ 1u, ML_TAB(c + 1)); if (c + 2 < NC) ML_LOAD(c + 2); }
        __syncthreads();
        { bf16x8 pf[6];
#pragma unroll
          for (int tt = 0; tt < 4; ++tt) { pf[tt] = *(const LAS bf16x8*)(Pt + PP0 + 2048u * tt); if (tt >= 2) pf[2 + tt] = *(const LAS bf16x8*)(Pt + PP1 + 2048u * tt); }
#pragma unroll
          for (int tt = 0; tt < 4; ++tt) { const f32x4 av4 = *(const LAS f32x4*)(sct + 16 * tt + 4 * q), bv4 = *(const LAS f32x4*)(sct + 64 + 16 * tt + 4 * q); f32x4 a1 = __builtin_amdgcn_mfma_f32_16x16x32_bf16(pf[tt], vB[0], (f32x4){0.f, 0.f, 0.f, 0.f}, 0, 0, 0);
            if (tt >= 2) a1 = __builtin_amdgcn_mfma_f32_16x16x32_bf16(pf[2 + tt], vB[1], a1, 0, 0, 0);
#pragma unroll
            for (int i = 0; i < 4; ++i) { const unsigned t = 16u * tt + 4u * q + i, col = 16u * (unsigned)wave + r;
                *(LAS bf16_t*)(L + HT_OFF + 256u * t + 16u * ((col >> 3) ^ (t & 15u)) + 2u * (col & 7u)) = (bf16_t)cvtpk(av4[i] * a1[i] + bv4[i] * acc2[tt][i], 0.f); } } }
        if (vhalf == 0) {
            const LAS float* n_old = (const LAS float*)(L + N_OFF + cur * 512u); LAS float* n_new = (LAS float*)(L + N_OFF + (cur ^ 1u) * 512u);
            bf16x8 wB[2];
#pragma unroll
            for (int ks = 0; ks < 2; ++ks) { const f32x4 w0 = *(const LAS f32x4*)(sct + 192 + 32 * ks + 8 * q), w1 = *(const LAS f32x4*)(sct + 192 + 32 * ks + 8 * q + 4);
                u32x4 w = {cvtpk(w0[0], w0[1]), cvtpk(w0[2], w0[3]), cvtpk(w1[0], w1[1]), cvtpk(w1[2], w1[3])};
                if (r != 0u) w = (u32x4){0u, 0u, 0u, 0u}; wB[ks] = __builtin_bit_cast(bf16x8, w); }
            const size_t dbase = ((size_t)dir * T) * MH + h;
            if (wave < 4) { const int tt = wave; f32x4 d2 = (f32x4){0.f, 0.f, 0.f, 0.f};
#pragma unroll
                for (int ks = 0; ks < 4; ++ks) { const f32x4 n0 = *(const LAS f32x4*)(n_old + 32 * ks + 4 * q), n1 = *(const LAS f32x4*)(n_old + 32 * ks + 16 + 4 * q);
                    u32x4 bw = {cvtpk(n0[0], n0[1]), cvtpk(n0[2], n0[3]), cvtpk(n1[0], n1[1]), cvtpk(n1[2], n1[3])}; if (r != 0u) bw = (u32x4){0u, 0u, 0u, 0u};
                    const u32x2 lo = *(const LAS u32x2*)(Qi + PB1 + 4096u * tt + 512u * ks), hi = *(const LAS u32x2*)(Qi + PB2 + 4096u * tt + 512u * ks);
                    const u32x4 aw = {lo.x, lo.y, hi.x, hi.y};
                    d2 = __builtin_amdgcn_mfma_f32_16x16x32_bf16(__builtin_bit_cast(bf16x8, aw), __builtin_bit_cast(bf16x8, bw), d2, 0, 0, 0); }
#pragma unroll
                for (int i = 0; i < 4; ++i) { const int t = 16 * tt + 4 * (int)q + i; const float bv = sct[64 + t], fl = sct[128 + t];
                    if (r == 0u) { const size_t di = dbase + (size_t)ml_tok(dir, b, c * 64 + t) * MH; p.DEN()[(size_t)2 * T * MH + di] = bv * d2[i]; p.FLR()[di] = fl; } }
            } else { const int tt = wave - 4; f32x4 d1 = (f32x4){0.f, 0.f, 0.f, 0.f};
#pragma unroll
                for (int ks = 0; ks < 2; ++ks) if (ks == 0 || tt >= 2) { const bf16x8 pf = *(const LAS bf16x8*)(Pt + (ks ? PP1 : PP0) + 2048u * tt);
                    d1 = __builtin_amdgcn_mfma_f32_16x16x32_bf16(pf, wB[ks], d1, 0, 0, 0); }
#pragma unroll
                for (int i = 0; i < 4; ++i) { const int t = 16 * tt + 4 * (int)q + i; const float av = sct[t];
                    if (r == 0u) p.DEN()[dbase + (size_t)ml_tok(dir, b, c * 64 + t) * MH] = av * d1[i]; } }
            { const int dt = wave; f32x4 nn = *(const LAS f32x4*)(n_old + 16 * dt + 4 * q) * cs.decay; if (r != 0u) nn = (f32x4){0.f, 0.f, 0.f, 0.f};
#pragma unroll
                for (int ks = 0; ks < 2; ++ks) { const bf16x8 kA = cat8(trr(Ki + ML_TRA(dt, ks, 0)), trr(Ki + ML_TRA(dt, ks, 1)));
                    nn = __builtin_amdgcn_mfma_f32_16x16x32_bf16(kA, wB[ks], nn, 0, 0, 0); }
                if (r == 0u) *(LAS f32x4*)(n_new + 16 * dt + 4 * q) = nn; }
        }
        m = cs.m_next; cs = csn; ign = ig2; fgn = fg2;
    }
    __syncthreads(); ML_FLUSH(NC - 1);
#undef ML_FLUSH
#undef ML_TRA
#undef ML_TABLE
#undef ML_LOAD
#undef ML_GATES
#undef ML_STORE
}
}
__device__ __forceinline__ void phase4(const Prm& p, const Frame& F) {
    static_assert(MV == 256 && MH == 4, "head j = float4 slot j of the lane");
    const int gw = F.bid * NWAVES + F.wave, NGW = F.G * NWAVES;
    for (int row = gw; row < T; row += NGW) {
        const uint2* hf = (const uint2*)(p.HF16() + (size_t)row * MW) + F.lane; const uint2* hb = (const uint2*)(p.HB16() + (size_t)row * MW) + F.lane;
        const uint2* og = (const uint2*)(p.PJ() + (size_t)row * INM + O_O) + F.lane; uint2* yo = (uint2*)(p.Y() + (size_t)row * D + CW) + F.lane;
#pragma unroll
        for (int j = 0; j < MH; ++j) {
            const float* d2 = p.DEN() + (size_t)2 * T * MH;
            const float i_f = 1.f / fmaxf(fabsf(p.DEN()[(size_t)row * MH + j] + d2[(size_t)row * MH + j]), p.FLR()[(size_t)row * MH + j]);
            const float i_b = 1.f / fmaxf(fabsf(p.DEN()[((size_t)T + row) * MH + j] + d2[((size_t)T + row) * MH + j]), p.FLR()[((size_t)T + row) * MH + j]);
            const uint2 a = hf[64 * j], b = hb[64 * j]; float4 h = make_float4(bflo(a.x) * i_f + bflo(b.x) * i_b, bfhi(a.x) * i_f + bfhi(b.x) * i_b, bflo(a.y) * i_f + bflo(b.y) * i_b, bfhi(a.y) * i_f + bfhi(b.y) * i_b);
            const float mean = wave_sum((h.x + h.y) + (h.z + h.w)) * (1.f / MV);
            h.x -= mean; h.y -= mean; h.z -= mean; h.w -= mean;
            const float rstd = 1.f / sqrtf(wave_sum((h.x * h.x + h.y * h.y) + (h.z * h.z + h.w * h.w)) * (1.f / MV) + LN_EPS);
            const float4 nw = *((const float4*)(p.mnorm_w + j * MV) + F.lane); const uint2 o = og[64 * j];
            yo[64 * j] = make_uint2(pk2(h.x * rstd * nw.x * sigmoidf_(bflo(o.x)), h.y * rstd * nw.y * sigmoidf_(bfhi(o.x))), pk2(h.z * rstd * nw.z * sigmoidf_(bflo(o.y)), h.w * rstd * nw.w * sigmoidf_(bfhi(o.y)))); }
    }
}
struct EpiZ {
    static constexpr bool PERM = false, AFTER_DRAIN = false;
    const float* x; const float* mod; bf16_t* out;
    __device__ __forceinline__ void operator()(const pg8::f32x4 (&acc)[2][2][4][2], const pg8::Unit& u, int wr, int wc, int fr, int fq) const {
        const int col0 = u.pn * 256 + wc * 32 + 4 * fq;
#pragma unroll
        for (int ai = 0; ai < 2; ++ai)
#pragma unroll
            for (int m = 0; m < 4; ++m) { const int row = u.pm * 256 + ai * 128 + wr * 64 + m * 16 + fr; const float* g1 = mod + (size_t)(row / S) * D6 + 2 * D; const size_t off = (size_t)row * D + col0;
#pragma unroll
                for (int bj = 0; bj < 2; ++bj)
#pragma unroll
                    for (int n = 0; n < 2; ++n) { const int c = bj * 128 + n * 16; const pg8::f32x4 xv = *(const pg8::f32x4*)(x + off + c), gv = *(const pg8::f32x4*)(g1 + col0 + c);
                        const pg8::f32x4 z = xv * ALPHA + gv * acc[ai][bj][m][n]; *(uint2*)(out + off + c) = make_uint2(pk2(z[0], z[1]), pk2(z[2], z[3])); } }
    }
};

struct EpiF32 {
    static constexpr bool PERM = false, AFTER_DRAIN = false;
    float* out; int ldc;
    __device__ __forceinline__ void operator()(const pg8::f32x4 (&acc)[2][2][4][2], const pg8::Unit& u, int wr, int wc, int fr, int fq) const {
        const int col0 = u.pn * 256 + wc * 32 + 4 * fq;
#pragma unroll
        for (int ai = 0; ai < 2; ++ai)
#pragma unroll
            for (int m = 0; m < 4; ++m) { float* rowp = out + (size_t)(u.pm * 256 + ai * 128 + wr * 64 + m * 16 + fr) * ldc + col0;
#pragma unroll
                for (int bj = 0; bj < 2; ++bj)
#pragma unroll
                    for (int n = 0; n < 2; ++n) *(pg8::f32x4*)(rowp + bj * 128 + n * 16) = acc[ai][bj][m][n]; }
    }
};
__device__ __forceinline__ unsigned skey(float f) { const unsigned u = f_as_u(f); return (u & 0x80000000u) ? ~u : (u | 0x80000000u); }
__device__ __forceinline__ float unskey(unsigned k) { return u_as_f((k & 0x80000000u) ? (k & 0x7fffffffu) : ~k); }
__device__ __forceinline__ void tk_insert(unsigned (&L)[16], unsigned k) {
    if (k > L[15]) { L[15] = k;
#pragma unroll
        for (int i = 14; i >= 0; --i) { const unsigned hi = L[i] > L[i + 1] ? L[i] : L[i + 1], lo = L[i] > L[i + 1] ? L[i + 1] : L[i]; L[i] = hi; L[i + 1] = lo; } }
}
__device__ __forceinline__ void tk_top16(const float* sc, unsigned (&L)[16]) {
#pragma unroll
    for (int i = 0; i < 16; ++i) L[i] = 0u;
#pragma unroll 2
    for (int n4 = 0; n4 < NK / 4; ++n4) { const float4 v = ((const float4*)sc)[n4]; const unsigned b = 127u - 4u * n4;
        tk_insert(L, (skey(v.x) & ~0x7fu) | b); tk_insert(L, (skey(v.y) & ~0x7fu) | (b - 1)); tk_insert(L, (skey(v.z) & ~0x7fu) | (b - 2)); tk_insert(L, (skey(v.w) & ~0x7fu) | (b - 3)); }
}
__device__ __forceinline__ void phase8(const Prm& p, const Frame& F) {
    static_assert(NK == 128 && TOPK == 16, "top-k phase is specialised");
    const long gt = (long)F.bid * NTHR + F.tid, GT = (long)F.G * NTHR;
    for (long i = gt; i < (long)T * PH; i += GT) {
        unsigned A[16], B[16];
        tk_top16(p.SC() + (size_t)i * 2 * NK, A); tk_top16(p.SC() + (size_t)i * 2 * NK + NK, B);
        float V[16]; int E[16];
#pragma unroll
        for (int r = 0; r < 16; ++r) { V[r] = -INFINITY; E[r] = 0; }
#pragma unroll
        for (int a = 0; a < 16; ++a)
#pragma unroll
            for (int b = 0; b < 16; ++b) if ((a + 1) * (b + 1) <= 16) {
                const float v = unskey(A[a] & ~0x7fu) + unskey(B[b] & ~0x7fu); const int e = (int)((127u - (A[a] & 0x7fu)) * NK + (127u - (B[b] & 0x7fu)));
                if (v > V[15]) { V[15] = v; E[15] = e;
#pragma unroll
                    for (int r = 14; r >= 0; --r) { const bool sw = V[r + 1] > V[r]; const float vh = sw ? V[r + 1] : V[r], vl = sw ? V[r] : V[r + 1]; const int eh = sw ? E[r + 1] : E[r], el = sw ? E[r] : E[r + 1];
                        V[r] = vh; V[r + 1] = vl; E[r] = eh; E[r + 1] = el; } } }
        float sum = 0.f; const float vmax = V[0];
#pragma unroll
        for (int r = 0; r < 16; ++r) { V[r] = __expf(V[r] - vmax); sum += V[r]; }
        const float inv = 1.f / sum;
#pragma unroll
        for (int r = 0; r < 16; r += 4) { *(int4*)(p.EIDX() + (size_t)i * TOPK + r) = make_int4(E[r], E[r + 1], E[r + 2], E[r + 3]);
            *(float4*)(p.EW() + (size_t)i * TOPK + r) = make_float4(V[r] * inv, V[r + 1] * inv, V[r + 2] * inv, V[r + 3] * inv); }
    }
}
__device__ __forceinline__ void phase6(const Prm& p, const Frame& F) {
    const int gw = F.bid * NWAVES + F.wave, NGW = F.G * NWAVES;
    float4 v[8]; uint2 zb[8], zn[8];
    if (gw < T) { const uint2* z0 = (const uint2*)((const bf16_t*)p.out + (size_t)gw * D) + F.lane;
#pragma unroll
        for (int j = 0; j < 8; ++j) zb[j] = z0[64 * j]; }
    for (int row = gw; row < T; row += NGW) {
        uint2* x1r = (uint2*)(p.X1B() + (size_t)row * D) + F.lane; const float* mod = p.MOD() + (size_t)(row / S) * D6;
        float s = 0.f;
        if (row + NGW < T) { const uint2* zp = (const uint2*)((const bf16_t*)p.out + (size_t)(row + NGW) * D) + F.lane;
#pragma unroll
            for (int j = 0; j < 8; ++j) zn[j] = zp[64 * j]; }
#pragma unroll
        for (int j = 0; j < 8; ++j) { v[j] = make_float4(bflo(zb[j].x), bfhi(zb[j].x), bflo(zb[j].y), bfhi(zb[j].y)); s += (v[j].x + v[j].y) + (v[j].z + v[j].w); }
        float mean = wave_sum(s) * (1.f / D), s2 = 0.f;
#pragma unroll
        for (int j = 0; j < 8; ++j) { v[j].x -= mean; v[j].y -= mean; v[j].z -= mean; v[j].w -= mean; s2 += (v[j].x * v[j].x + v[j].y * v[j].y) + (v[j].z * v[j].z + v[j].w * v[j].w); }
        float rstd = 1.f / sqrtf(wave_sum(s2) * (1.f / D) + LN_EPS); s = 0.f;
#pragma unroll
        for (int j = 0; j < 8; ++j) { const float4 w = *((const float4*)p.ln1_w + F.lane + 64 * j), bb = *((const float4*)p.ln1_b + F.lane + 64 * j);
            v[j].x = v[j].x * rstd * w.x + bb.x; v[j].y = v[j].y * rstd * w.y + bb.y; v[j].z = v[j].z * rstd * w.z + bb.z; v[j].w = v[j].w * rstd * w.w + bb.w;
            x1r[64 * j] = make_uint2(pk2(v[j].x, v[j].y), pk2(v[j].z, v[j].w)); s += (v[j].x + v[j].y) + (v[j].z + v[j].w); }
        mean = wave_sum(s) * (1.f / D); s2 = 0.f;
#pragma unroll
        for (int j = 0; j < 8; ++j) { v[j].x -= mean; v[j].y -= mean; v[j].z -= mean; v[j].w -= mean; s2 += (v[j].x * v[j].x + v[j].y * v[j].y) + (v[j].z * v[j].z + v[j].w * v[j].w); }
        rstd = 1.f / sqrtf(wave_sum(s2) * (1.f / D) + LN_EPS);
        uint2* o8 = (uint2*)(p.U() + (size_t)row * D) + F.lane;
#pragma unroll
        for (int j = 0; j < 8; ++j) { const float4 sh = *((const float4*)(mod + 3 * D) + F.lane + 64 * j), sc = *((const float4*)(mod + 4 * D) + F.lane + 64 * j);
            o8[64 * j] = make_uint2(pk2(v[j].x * rstd * (1.f + sc.x) + sh.x, v[j].y * rstd * (1.f + sc.y) + sh.y), pk2(v[j].z * rstd * (1.f + sc.z) + sh.z, v[j].w * rstd * (1.f + sc.w) + sh.w)); }
#pragma unroll
        for (int j = 0; j < 8; ++j) zb[j] = zn[j];
    }
}
struct XW { int vx, nx, rank, nloc; };
constexpr int NDS = 16, DSW = D / NDS;
typedef float f2v __attribute__((ext_vector_type(2)));
struct Row8 { uint4 r[8]; };
__device__ __forceinline__ void gather8(Row8& g, const unsigned char* tbu, unsigned loff, int ereg, int pg) {
#pragma unroll
    for (int k = 0; k < 8; ++k) { const unsigned e = (unsigned)__shfl(ereg, 8 * k + pg); g.r[k] = *(const uint4*)(tbu + (((size_t)e << 11) | loff)); }
}
#define PEER_CVT8(a) const f2v c0 = __builtin_amdgcn_cvt_pk_f32_fp8((a).x, false), c1 = __builtin_amdgcn_cvt_pk_f32_fp8((a).x, true), c2 = __builtin_amdgcn_cvt_pk_f32_fp8((a).y, false), c3 = __builtin_amdgcn_cvt_pk_f32_fp8((a).y, true), \
    c4 = __builtin_amdgcn_cvt_pk_f32_fp8((a).z, false), c5 = __builtin_amdgcn_cvt_pk_f32_fp8((a).z, true), c6 = __builtin_amdgcn_cvt_pk_f32_fp8((a).w, false), c7 = __builtin_amdgcn_cvt_pk_f32_fp8((a).w, true)
typedef _Float16 h2t __attribute__((ext_vector_type(2)));
__device__ __forceinline__ float peer_dot16h(const uint4 a, const h2t* u) {
    float acc = __builtin_amdgcn_fdot2(__builtin_amdgcn_cvt_scalef32_pk_f16_fp8(a.x, 1.0f, false), u[0], 0.f, false);
    acc = __builtin_amdgcn_fdot2(__builtin_amdgcn_cvt_scalef32_pk_f16_fp8(a.x, 1.0f, true), u[1], acc, false);
    acc = __builtin_amdgcn_fdot2(__builtin_amdgcn_cvt_scalef32_pk_f16_fp8(a.y, 1.0f, false), u[2], acc, false);
    acc = __builtin_amdgcn_fdot2(__builtin_amdgcn_cvt_scalef32_pk_f16_fp8(a.y, 1.0f, true), u[3], acc, false);
    acc = __builtin_amdgcn_fdot2(__builtin_amdgcn_cvt_scalef32_pk_f16_fp8(a.z, 1.0f, false), u[4], acc, false);
    acc = __builtin_amdgcn_fdot2(__builtin_amdgcn_cvt_scalef32_pk_f16_fp8(a.z, 1.0f, true), u[5], acc, false);
    acc = __builtin_amdgcn_fdot2(__builtin_amdgcn_cvt_scalef32_pk_f16_fp8(a.w, 1.0f, false), u[6], acc, false);
    acc = __builtin_amdgcn_fdot2(__builtin_amdgcn_cvt_scalef32_pk_f16_fp8(a.w, 1.0f, true), u[7], acc, false);
    return acc;
}
__device__ __forceinline__ f2v rscatter16(const float* v, bool b0, bool b1, bool b2, int m0, int m1, int m2) {
    float r8[8], r4[4]; f2v r2;
#pragma unroll
    for (int i = 0; i < 8; ++i) { const float keep = b0 ? v[8 + i] : v[i], send = b0 ? v[i] : v[8 + i]; r8[i] = keep + __shfl_xor(send, m0); }
#pragma unroll
    for (int i = 0; i < 4; ++i) { const float keep = b1 ? r8[4 + i] : r8[i], send = b1 ? r8[i] : r8[4 + i]; r4[i] = keep + __shfl_xor(send, m1); }
    { const float k0 = b2 ? r4[2] : r4[0], s0 = b2 ? r4[0] : r4[2], k1 = b2 ? r4[3] : r4[1], s1 = b2 ? r4[1] : r4[3]; r2.x = k0 + __shfl_xor(s0, m2); r2.y = k1 + __shfl_xor(s1, m2); }
    return r2;
}
__device__ __forceinline__ void phase9(const Prm& p, const Frame& F, const XW& xw) {
    static_assert(DSW == 128 && NSLOT == 128 && D == 2048, "slice row = 8 lanes x 16 bytes");
    const int pg = F.lane >> 3, part = F.lane & 7; const bool p0 = part & 1, p1 = part & 2, p2 = part & 4;
    const int tstep = xw.nloc * NWAVES, t0 = xw.rank * NWAVES + F.wave; const int nt = t0 < T ? (T - t0 + tstep - 1) / tstep : 0;
    const unsigned loff = (unsigned)part * 16u; const int k0 = (p0 ? 8 : 0) + (p1 ? 4 : 0) + (p2 ? 2 : 0);
    for (int ds = xw.vx; ds < NDS; ds += xw.nx) {
        if (nt == 0) continue;
        const unsigned char* tbu = p.PU8() + ds * DSW; _Float16* part_out = (_Float16*)p.SC() + (size_t)ds * T * NSLOT + pg + 8 * k0;
#define UP_TOK(i) (t0 + ((i) < nt ? (i) : nt - 1) * tstep)
#define UP_LOADE(i, ea, eb) do { const int* ep_ = p.EIDX() + (size_t)UP_TOK(i) * NSLOT + F.lane; ea = ep_[0]; eb = ep_[64]; } while (0)
#define UP_LOADU(i, ua_, ub_) do { const uint4* up_ = (const uint4*)(p.U() + (size_t)UP_TOK(i) * D + ds * DSW + part * 16); ua_ = up_[0]; ub_ = up_[1]; } while (0)
        int e0a, e0b, e1a, e1b, e2a, e2b; uint4 ua, ub, una, unb;
        UP_LOADE(0, e0a, e0b); UP_LOADE(1, e1a, e1b); UP_LOADE(2, e2a, e2b); UP_LOADU(0, ua, ub);
        Row8 G0, G1, G2, G3;
        gather8(G0, tbu, loff, e0a, pg); gather8(G1, tbu, loff, e0b, pg); gather8(G2, tbu, loff, e1a, pg);
#define UP_BODY(i, GA, GB, GC, GD) do { \
            gather8(GD, tbu, loff, e1b, pg); UP_LOADU((i) + 1, una, unb); int e3a, e3b; UP_LOADE((i) + 3, e3a, e3b); \
            h2t u[8]; u[0] = (h2t){(_Float16)bflo(ua.x), (_Float16)bfhi(ua.x)}; u[1] = (h2t){(_Float16)bflo(ua.y), (_Float16)bfhi(ua.y)}; u[2] = (h2t){(_Float16)bflo(ua.z), (_Float16)bfhi(ua.z)}; u[3] = (h2t){(_Float16)bflo(ua.w), (_Float16)bfhi(ua.w)}; \
            u[4] = (h2t){(_Float16)bflo(ub.x), (_Float16)bfhi(ub.x)}; u[5] = (h2t){(_Float16)bflo(ub.y), (_Float16)bfhi(ub.y)}; u[6] = (h2t){(_Float16)bflo(ub.z), (_Float16)bfhi(ub.z)}; u[7] = (h2t){(_Float16)bflo(ub.w), (_Float16)bfhi(ub.w)}; \
            float dv[16]; \
            _Pragma("unroll") for (int k = 0; k < 8; ++k) dv[k] = peer_dot16h(GA.r[k], u); \
            gather8(GA, tbu, loff, e2a, pg); \
            _Pragma("unroll") for (int k = 0; k < 8; ++k) dv[8 + k] = peer_dot16h(GB.r[k], u); \
            const f2v r2 = rscatter16(dv, p0, p1, p2, 1, 2, 4);                          \
            if ((i) < nt) { _Float16* po = part_out + (size_t)UP_TOK(i) * NSLOT; po[0] = (_Float16)(r2.x * 0.0625f); po[8] = (_Float16)(r2.y * 0.0625f); } \
            e1a = e2a; e1b = e2b; e2a = e3a; e2b = e3b; ua = una; ub = unb; } while (0)
        for (int i = 0; i < nt; i += 2) { UP_BODY(i, G0, G1, G2, G3); UP_BODY(i + 1, G2, G3, G0, G1); }
#undef UP_BODY
#undef UP_LOADU
#undef UP_LOADE
#undef UP_TOK
    }
}
__device__ __forceinline__ void phase10(const Prm& p, const Frame& F) {
    static_assert(NE <= 16384 && NSLOT == 128 && T % 64 == 0, "14-bit expert id, 64-token groups");
    LAS unsigned* tile = (LAS unsigned*)F.lds;
    for (int tg = F.bid; tg < T / 64; tg += F.G) {
        __syncthreads();
#pragma unroll 4
        for (int k = 0; k < 16; ++k) { const int idx = F.tid + NTHR * k, tl = idx >> 7, sl = idx & 127; const size_t i = ((size_t)tg * 64 + tl) * NSLOT + sl; float s = 0.f;
#pragma unroll
            for (int ds = 0; ds < NDS; ++ds) s += (float)((const _Float16*)p.SC())[(size_t)ds * T * NSLOT + i];
            s *= 16.f;
            const int e = p.EIDX()[i]; const _Float16 w = (_Float16)(p.EW()[i] * gelu_exact(s * p.RSU()[e]) * p.RSV()[e] * 256.f);
            tile[tl * 129 + sl] = (((unsigned)__builtin_bit_cast(unsigned short, w) << 16) & 0xFFFE0000u) | ((unsigned)e << 3); }
        __syncthreads();
        uint4* pk = (uint4*)p.EW() + (size_t)tg * 64 * (NSLOT / 4);
#pragma unroll
        for (int k = 0; k < 4; ++k) { const int j = F.tid + NTHR * k, sq = j >> 6, tl = j & 63; const LAS unsigned* tp = tile + tl * 129 + 4 * sq; pk[j] = make_uint4(tp[0], tp[1], tp[2], tp[3]); }
    }
}
__device__ __forceinline__ void phase11(const Prm& p, const Frame& F) {
    static_assert(NE * 8 <= RING_BYTES && D % 8 == 0 && NE <= 65536, "table slice fits the LDS ring");
    typedef _Float16 h2v __attribute__((ext_vector_type(2)));
    const int c0 = (F.G % 8 == 0) ? (F.bid % 8) * (F.G / 8) + F.bid / 8 : F.bid;
    for (int sidx = c0; sidx < D / 8; sidx += F.G) {
        __syncthreads();
        { const uint4* src = (const uint4*)(p.PV8S() + (size_t)sidx * NE * 8);
          for (int i = F.tid; i < NE / 2; i += NTHR) *(LAS u32x4_t*)(F.lds + 16 * i) = __builtin_bit_cast(u32x4_t, src[i]); }
        __syncthreads();
        const int ntg = (T / 64 - F.wave + NWAVES - 1) / NWAVES, nb = 8 * ntg;
        uint4 b0[4], b1[4], b2[4], b3[4];
        const int kx = (F.G % 8 == 0) ? F.bid >> 3 : F.bid, rot = kx & 3, rotb = (kx >> 2) & 7;
#define DN_TG(bi) (F.wave + ((((bi) >> 3) + rot) % ntg) * NWAVES)
#define DN_PTR(bi) ((const uint4*)p.EW() + (size_t)DN_TG(bi) * 64 * (NSLOT / 4) + ((((bi) & 7) + rotb) & 7) * 4 * 64 + F.lane)
#define DN_LOAD(B, bi) do { const int bc_ = (bi) < nb ? (bi) : nb - 1; const uint4* pk_ = DN_PTR(bc_); _Pragma("unroll") for (int k = 0; k < 4; ++k) B[k] = pk_[k * 64]; } while (0)
#define DN_ONE(v_) do { const unsigned vv_ = (v_); const _Float16 w = __builtin_bit_cast(_Float16, (unsigned short)(vv_ >> 16)); const h2v w2 = {w, w}; \
                const u2v t = *(const LAS u2v*)(F.lds + (vv_ & 0x1FFF8u)); const unsigned tx_ = t.x, ty_ = t.y; \
                a0 += __builtin_amdgcn_cvt_scalef32_pk_f16_fp8(tx_, 1.0f, false) * w2; a1 += __builtin_amdgcn_cvt_scalef32_pk_f16_fp8(tx_, 1.0f, true) * w2; \
                a2 += __builtin_amdgcn_cvt_scalef32_pk_f16_fp8(ty_, 1.0f, false) * w2; a3 += __builtin_amdgcn_cvt_scalef32_pk_f16_fp8(ty_, 1.0f, true) * w2; } while (0)
#ifndef DN_REP
#define DN_REP 0
#endif
#define DN_ACC(B) do { _Pragma("unroll") for (int k = 0; k < 4; ++k) { DN_ONE(B[k].x); DN_ONE(B[k].y); DN_ONE(B[k].z); DN_ONE(B[k].w); } asm volatile("" ::: "memory"); \
            if (DN_REP) { const h2v s0_ = a0, s1_ = a1, s2_ = a2, s3_ = a3; for (int rep_ = 0; rep_ < DN_REP; ++rep_) { _Pragma("unroll") for (int k = 0; k < 4; ++k) { DN_ONE(B[k].x); DN_ONE(B[k].y); DN_ONE(B[k].z); DN_ONE(B[k].w); } \
                asm volatile("" :: "v"(a0), "v"(a1), "v"(a2), "v"(a3) : "memory"); } a0 = s0_; a1 = s1_; a2 = s2_; a3 = s3_; } } while (0)
        DN_LOAD(b0, 0); DN_LOAD(b1, 1); DN_LOAD(b2, 2);
        for (int bi = 0; bi < nb; bi += 8) {
            h2v a0 = {0, 0}, a1 = {0, 0}, a2 = {0, 0}, a3 = {0, 0};
            DN_LOAD(b3, bi + 3); DN_ACC(b0);
            DN_LOAD(b0, bi + 4); DN_ACC(b1);
            DN_LOAD(b1, bi + 5); DN_ACC(b2);
            DN_LOAD(b2, bi + 6); DN_ACC(b3);
            DN_LOAD(b3, bi + 7); DN_ACC(b0);
            DN_LOAD(b0, bi + 8); DN_ACC(b1);
            DN_LOAD(b1, bi + 9); DN_ACC(b2);
            DN_LOAD(b2, bi + 10); DN_ACC(b3);
            const int tg = DN_TG(bi); const float us = 1.f / 256.f;
            const uint4 yv = make_uint4(pk2((float)a0[0] * us, (float)a0[1] * us), pk2((float)a1[0] * us, (float)a1[1] * us), pk2((float)a2[0] * us, (float)a2[1] * us), pk2((float)a3[0] * us, (float)a3[1] * us));
            *(uint4*)(p.Y() + ((size_t)tg * 64 + F.lane) * D + 8 * sidx) = yv;
#if defined(DN_STORE_REP)
            for (int rep_ = 0; rep_ < DN_STORE_REP; ++rep_) { asm volatile("" ::: "memory"); __builtin_nontemporal_store(__builtin_bit_cast(u32x4_t, yv), (u32x4_t*)(p.Y() + ((size_t)tg * 64 + F.lane) * D + 8 * sidx)); }
#endif
        }
#undef DN_ACC
#undef DN_ONE
#undef DN_LOAD
#undef DN_PTR
#undef DN_TG
    }
}
__device__ __forceinline__ void phase12(const Prm& p, const Frame& F) {
    const int gw = F.bid * NWAVES + F.wave, NGW = F.G * NWAVES;
    float4 v[8]; uint2 xb[8], xn[8];
    if (gw < T) { const uint2* xr = (const uint2*)(p.X1B() + (size_t)gw * D) + F.lane;
#pragma unroll
        for (int j = 0; j < 8; ++j) xb[j] = xr[64 * j]; }
    for (int row = gw; row < T; row += NGW) {
        float4* zr = (float4*)(p.out + (size_t)row * D) + F.lane; float s = 0.f;
        if (row + NGW < T) { const uint2* xp = (const uint2*)(p.X1B() + (size_t)(row + NGW) * D) + F.lane;
#pragma unroll
            for (int j = 0; j < 8; ++j) xn[j] = xp[64 * j]; }
        const float* g2 = p.MOD() + (size_t)(row / S) * D6 + 5 * D;
#pragma unroll
        for (int j = 0; j < 8; ++j) { const uint2 y = *((const uint2*)(p.Y() + (size_t)row * D) + F.lane + 64 * j); const float4 g = *((const float4*)g2 + F.lane + 64 * j);
            v[j].x = ALPHA * bflo(xb[j].x) + g.x * bflo(y.x); v[j].y = ALPHA * bfhi(xb[j].x) + g.y * bfhi(y.x); v[j].z = ALPHA * bflo(xb[j].y) + g.z * bflo(y.y); v[j].w = ALPHA * bfhi(xb[j].y) + g.w * bfhi(y.y);
            s += (v[j].x + v[j].y) + (v[j].z + v[j].w); }
        const float mean = wave_sum(s) * (1.f / D); float s2 = 0.f;
#pragma unroll
        for (int j = 0; j < 8; ++j) { v[j].x -= mean; v[j].y -= mean; v[j].z -= mean; v[j].w -= mean; s2 += (v[j].x * v[j].x + v[j].y * v[j].y) + (v[j].z * v[j].z + v[j].w * v[j].w); }
        const float rstd = 1.f / sqrtf(wave_sum(s2) * (1.f / D) + LN_EPS);
#pragma unroll
        for (int j = 0; j < 8; ++j) { const float4 w = *((const float4*)p.ln2_w + F.lane + 64 * j), bb = *((const float4*)p.ln2_b + F.lane + 64 * j);
            zr[64 * j] = make_float4(v[j].x * rstd * w.x + bb.x, v[j].y * rstd * w.y + bb.y, v[j].z * rstd * w.z + bb.z, v[j].w * rstd * w.w + bb.w); }
#pragma unroll
        for (int j = 0; j < 8; ++j) xb[j] = xn[j];
    }
}

struct Args { const float* in[18]; float* out; unsigned char* ws; int ph_lo, ph_hi, li, pad; };
__global__ void __launch_bounds__(NTHR, 2) mk_fwd(Args args) {
    extern __shared__ __attribute__((aligned(16))) unsigned char lds_raw[];
    Frame F; F.lds = (LAS unsigned char*)lds_raw; F.tid = threadIdx.x; F.lane = F.tid & 63; F.wave = __builtin_amdgcn_readfirstlane(F.tid >> 6); F.G = gridDim.x; F.bid = blockIdx.x;
    Prm p; p.x = args.in[0]; p.c = args.in[1]; p.w_ada = args.in[2]; p.b_ada = args.in[3]; p.w_in = args.in[4]; p.b_in = args.in[5]; p.conv_w = args.in[6]; p.conv_b = args.in[7]; p.mnorm_w = args.in[8];
    p.w_out = args.in[9]; p.ln1_w = args.in[10]; p.ln1_b = args.in[11]; p.wq = args.in[12]; p.subkeys = args.in[13]; p.peer_u = args.in[14]; p.peer_v = args.in[15]; p.ln2_w = args.in[16]; p.ln2_b = args.in[17];
    p.out = args.out; p.ws = args.ws;
    volatile LAS unsigned* MISC = (volatile LAS unsigned*)(F.lds + MISC_OFF);
    for (int u = F.tid; u < (LDS_BYTES - LDSCTL_OFF) / 4; u += NTHR) ((LAS unsigned*)(F.lds + LDSCTL_OFF))[u] = 0u;
    __syncthreads();
    const int lo = args.ph_lo, hi = args.ph_hi;
    XcdBarrier bar; bar.bar = (unsigned*)(p.ws + WS_CTL) + CW_BAR + args.li * XCD_BAR_WORDS; bar.x = 0; bar.st = nullptr;
    if (hi - lo > 1) bar = xcd_barrier_post((unsigned*)(p.ws + WS_CTL) + CW_BAR + args.li * XCD_BAR_WORDS, MISC + 8);
#define IN(k) (lo <= (k) && (k) < hi)
#define SEAM(k) do { if (IN(k) && IN((k) + 1)) xcd_barrier(bar); } while (0)
    XW xw; xw.nx = (F.G % 8 == 0) ? 8 : 1; xw.vx = F.bid % xw.nx; xw.rank = F.bid / xw.nx; xw.nloc = F.G / xw.nx;
#define XW_FROM_CENSUS() do { if (hi - lo > 1) { if (F.tid == 0) { unsigned vx_ = 0u; for (unsigned j = 0; j < bar.x; ++j) vx_ += xb_ld(&bar.bar[XB_XCNT(j)]) > 0u ? 1u : 0u; MISC[11] = vx_; } __syncthreads(); \
        xw.vx = (int)MISC[11]; xw.nx = (int)MISC[9]; xw.rank = (int)MISC[10] - 1; xw.nloc = (int)MISC[8]; } } while (0)
    if (IN(0)) { phase0(p, F); deferred_prep<false, true>(p, F, 0, F.G); } SEAM(0);
    if (IN(1)) { phase1(p, F); } SEAM(1);
    if (IN(2)) { pg8::Gemm g{p.U(), p.WIN_T(), T, INM, D}; pg8::StaticOrder So; So.init(T, INM, F.G, F.bid);
        pg8::EpiBf16<0> E{p.PJ(), INM, p.b_in, 0, 0, 1.f};
        pg8::gemm_phase<pg8::EpiBf16<0>, pg8::StaticOrder, true, true>(F.lds, g, So, E); } SEAM(2);
    if (IN(3)) { const int nmb = F.G >= 2 ? F.G / 2 : 1;
#ifndef P3_REP_ML
#define P3_REP_ML 1
#define P3_REP_CONV 1
#endif
        if (F.bid < nmb) { for (int rep_ = 0; rep_ < P3_REP_ML; ++rep_) for (int u = F.bid; u < 2 * NB * MH * 2; u += nmb) ml::unit(p, F, u); if (F.G < 2) phase3a(p, F, 0, 1); }
        else { phase3a(p, F, nmb, F.G - nmb); deferred_prep<true, false>(p, F, nmb, F.G - nmb); }
        if (F.G < 2) deferred_prep<true, false>(p, F, 0, 1); } SEAM(3);
    if (IN(4)) { phase4(p, F); } SEAM(4);
    if (IN(5)) { pg8::Gemm g{p.Y(), p.WOUT_T(), T, D, D}; pg8::StaticOrder So; So.init(T, D, F.G, F.bid);
        EpiZ E{p.x, p.MOD(), (bf16_t*)p.out};
        pg8::gemm_phase<EpiZ, pg8::StaticOrder, true, true>(F.lds, g, So, E); } SEAM(5);
    if (IN(6)) { phase6(p, F); } SEAM(6);
    if (IN(7)) { pg8::Gemm g{p.U(), p.WQ_T(), T, NQ, D}; pg8::StaticOrder So; So.init(T, NQ, F.G, F.bid);
        EpiF32 E{p.SC(), NSC};
        pg8::gemm_phase<EpiF32, pg8::StaticOrder, true, true>(F.lds, g, So, E); } SEAM(7);
    if (IN(8)) { phase8(p, F); } SEAM(8);
    if (IN(9)) { if (lo < 9) XW_FROM_CENSUS(); phase9(p, F, xw); } SEAM(9);
    if (IN(10)) { phase10(p, F); } SEAM(10);
    if (IN(11)) { phase11(p, F); } SEAM(11);
    if (IN(12)) { phase12(p, F); }
#undef IN
#undef SEAM
}

extern "C" void kernel_launch(void* const* d_in, const int* in_sizes, int n_in, void* d_out, int out_size, void* d_ws, size_t ws_size, hipStream_t stream) {
    static int grid = 0;
    if (grid == 0) {
        if (n_in != 18 || out_size != T * D || ws_size < WS_END) { fprintf(stderr, "kernel_launch: unexpected shapes (n_in %d out %d ws %zu, need %zu)\n", n_in, out_size, ws_size, (size_t)WS_END); grid = -1; return; }
        int dev = 0, cus = 0, per_cu = 0;
        if (hipGetDevice(&dev) != hipSuccess || hipDeviceGetAttribute(&cus, hipDeviceAttributeMultiprocessorCount, dev) != hipSuccess) { grid = -1; return; }
        if (hipFuncSetAttribute((const void*)mk_fwd, hipFuncAttributeMaxDynamicSharedMemorySize, LDS_BYTES) != hipSuccess) { fprintf(stderr, "kernel_launch: hipFuncSetAttribute failed\n"); grid = -1; return; }
        if (hipOccupancyMaxActiveBlocksPerMultiprocessor(&per_cu, (const void*)mk_fwd, NTHR, LDS_BYTES) != hipSuccess || per_cu < 1) { fprintf(stderr, "kernel_launch: occupancy query says %d\n", per_cu); }
        (void)hipGetLastError();
        grid = cus;
        if (T % grid != 0 || (T / grid) % NWAVES != 0) { fprintf(stderr, "kernel_launch: grid %d does not divide the rows\n", grid); grid = -1; return; }
    }
    if (grid < 0) return;
    (void)hipMemsetAsync((char*)d_ws + WS_CTL, 0, 1u << 20, stream);
    Args a{};
    for (int i = 0; i < 18; ++i) a.in[i] = (const float*)d_in[i];
    a.out = (float*)d_out; a.ws = (unsigned char*)d_ws;
#if defined(PROBE_A)
    a.ph_lo = 0; a.ph_hi = PROBE_B + 1; a.li = 0; hipLaunchKernelGGL(mk_fwd, dim3(grid), dim3(NTHR), LDS_BYTES, stream, a);
    a.ph_lo = PROBE_A; a.ph_hi = NPHASE; a.li = 1; hipLaunchKernelGGL(mk_fwd, dim3(grid), dim3(NTHR), LDS_BYTES, stream, a);
#elif MK_N_LAUNCHES == 1
    a.ph_lo = 0; a.ph_hi = NPHASE;
    hipLaunchKernelGGL(mk_fwd, dim3(grid), dim3(NTHR), LDS_BYTES, stream, a);
#else
    for (int k = 0; k < NPHASE; ++k) { a.ph_lo = k; a.ph_hi = k + 1; hipLaunchKernelGGL(mk_fwd, dim3(grid), dim3(NTHR), LDS_BYTES, stream, a); }
#endif
}
```

```cpp
#define MK_N_LAUNCHES 1
#if defined(HOST_EMU)
#include <cmath>
#include <cstdint>
#include <cstring>
#include <cstddef>
#define HD inline
#define HDF inline
#else
#include <hip/hip_runtime.h>
#define HD __host__ __device__ __forceinline__
#define HDF __host__ __device__ __forceinline__
#endif

#ifndef CFG_D
#define CFG_D 2048
#define CFG_B 8
#define CFG_S 2048
#define CFG_PH 8
#define CFG_NK 128
#define CFG_TOPK 16
#define CFG_KD 256
#endif
constexpr int D = CFG_D, NB = CFG_B, S = CFG_S, T = NB * S;
constexpr int CW = D / 2, MW = D - CW, MH = 4, MV = MW / MH, QK = MV / 2, NG = 16, CHUNK = 64;
constexpr int INC = 3 * CW + 2 * MH * QK + 2 * MW + NG;
constexpr int INM = INC - NG;
constexpr int O_GB = 0, O_GC = CW, O_HIN = 2 * CW, O_Q = 3 * CW, O_K = O_Q + MH * QK, O_V = O_K + MH * QK, O_O = O_V + MW;
constexpr int PH = CFG_PH, NK = CFG_NK, TOPK = CFG_TOPK, KD = CFG_KD, KH = KD / 2, NE = NK * NK, NSLOT = PH * TOPK;
constexpr int NQ = PH * KD;
static_assert(PH * 2 * NK == NQ || true, "");
constexpr int NSC = PH * 2 * NK;
constexpr float LN_EPS = 1e-5f;
constexpr float ALPHA = 1.189207115002721f;
constexpr int D6 = 6 * D;

typedef unsigned short bf16_t;
HDF unsigned f_as_u(float f) { unsigned u; memcpy(&u, &f, 4); return u; }
HDF float u_as_f(unsigned u) { float f; memcpy(&f, &u, 4); return f; }
HDF bf16_t f2bf(float f) { unsigned u = f_as_u(f); return (bf16_t)((u + 0x7fffu + ((u >> 16) & 1u)) >> 16); }
HDF float bf2f(bf16_t h) { return u_as_f((unsigned)h << 16); }

constexpr size_t al(size_t x) { return (x + 1048575) & ~(size_t)1048575; }
constexpr size_t WS_CTL = 0;
constexpr size_t WS_MOD = al(1);
constexpr size_t WS_MODP = WS_MOD + al((size_t)NB * D6 * 4);
constexpr int NKS = 32;
constexpr size_t WS_GATES = WS_MODP + al((size_t)NKS * NB * D6 * 4);
constexpr size_t WS_DEN = WS_GATES + al((size_t)T * NG * 4);
constexpr size_t WS_FLR = WS_DEN + al((size_t)4 * T * MH * 4);
constexpr size_t WS_EIDX = WS_FLR + al((size_t)2 * T * MH * 4);
constexpr size_t WS_EW = WS_EIDX + al((size_t)T * NSLOT * 4);
constexpr size_t WS_WIN_T = WS_EW + al((size_t)T * NSLOT * 4);
constexpr size_t WS_WOUT_T = WS_WIN_T + al((size_t)INM * D * 2);
constexpr size_t WS_WQ_T = WS_WOUT_T + al((size_t)D * D * 2);
constexpr size_t WS_PU16 = WS_WQ_T + al((size_t)NQ * D * 2);
constexpr size_t WS_PV16 = WS_PU16 + al((size_t)NE * D * 2);
constexpr size_t WS_U = WS_PV16 + al((size_t)NE * D * 2);
constexpr size_t WS_Y = WS_U + al((size_t)T * D * 2);
constexpr size_t WS_P = WS_Y + al((size_t)T * D * 2);
constexpr size_t WS_SC = WS_P;
constexpr size_t WS_TS = WS_SC + al((size_t)T * NSC * 4);
constexpr size_t WS_TI = WS_TS + al((size_t)T * PH * 2 * TOPK * 4);
constexpr size_t WS_P_END = WS_P + al((size_t)T * INM * 2);
constexpr size_t WS_TI_END = WS_TI + al((size_t)T * PH * 2 * TOPK * 4);
constexpr size_t WS_END = WS_P_END > WS_TI_END ? WS_P_END : WS_TI_END;

struct Prm {
    const float *x, *c, *w_ada, *b_ada, *w_in, *b_in, *conv_w, *conv_b, *mnorm_w, *w_out, *ln1_w, *ln1_b, *wq, *subkeys, *peer_u, *peer_v, *ln2_w, *ln2_b;
    float* out;
    unsigned char* ws;
    HDF float* MOD() const { return (float*)(ws + WS_MOD); }
    HDF float* MODP() const { return (float*)(ws + WS_MODP); }
    HDF float* GATES() const { return (float*)(ws + WS_GATES); }
    HDF float* DEN() const { return (float*)(ws + WS_DEN); }
    HDF float* FLR() const { return (float*)(ws + WS_FLR); }
    HDF int* EIDX() const { return (int*)(ws + WS_EIDX); }
    HDF float* EW() const { return (float*)(ws + WS_EW); }
    HDF bf16_t* WIN_T() const { return (bf16_t*)(ws + WS_WIN_T); }
    HDF bf16_t* WOUT_T() const { return (bf16_t*)(ws + WS_WOUT_T); }
    HDF bf16_t* WQ_T() const { return (bf16_t*)(ws + WS_WQ_T); }
    HDF bf16_t* PU16() const { return (bf16_t*)(ws + WS_PU16); }
    HDF bf16_t* PV16() const { return (bf16_t*)(ws + WS_PV16); }
    HDF unsigned char* PU8() const { return ws + WS_PU16; }
    HDF unsigned char* PV8() const { return ws + WS_PV16; }
    HDF unsigned char* PV8S() const { return ws + WS_PV16; }
    HDF float* RSU() const { return (float*)(ws + WS_PU16 + (size_t)NE * D); }
    HDF float* RSV() const { return (float*)(ws + WS_PU16 + (size_t)NE * D + (size_t)NE * 4); }
    HDF bf16_t* U() const { return (bf16_t*)(ws + WS_U); }
    HDF bf16_t* Y() const { return (bf16_t*)(ws + WS_Y); }
    HDF bf16_t* PJ() const { return (bf16_t*)(ws + WS_P); }
    HDF float* SC() const { return (float*)(ws + WS_SC); }
    HDF bf16_t* X1B() const { return (bf16_t*)(ws + WS_TS); }
    HDF float* TS() const { return (float*)(ws + WS_TS); }
    HDF int* TI() const { return (int*)(ws + WS_TI); }
    HDF float* HF() const { return out; }
    HDF float* HB() const { return out + (size_t)T * MW; }
    HDF bf16_t* HF16() const { return (bf16_t*)out; }
    HDF bf16_t* HB16() const { return (bf16_t*)out + (size_t)T * MW; }
};

HDF float sigmoidf_(float x) { return 1.f / (1.f + expf(-x)); }
HDF float logsigmoidf_(float x) { return fminf(x, 0.f) - log1pf(expf(-fabsf(x))); }
HDF float gelu_exact(float x) { return 0.5f * x * (1.f + erff(x * 0.7071067811865476f)); }

HD void b_ada(const Prm& p, long n) {
    float acc[NB];
#pragma unroll
    for (int b = 0; b < NB; ++b) acc[b] = 0.f;
    for (int k = 0; k < D; ++k) {
        const float w = p.w_ada[(size_t)k * D6 + n];
#pragma unroll
        for (int b = 0; b < NB; ++b) { const float cv = p.c[b * D + k]; acc[b] += cv * sigmoidf_(cv) * w; }
    }
#pragma unroll
    for (int b = 0; b < NB; ++b) p.MOD()[(size_t)b * D6 + n] = acc[b] + p.b_ada[n];
}
HD void b_wt(const float* W, int ldw, int K, bf16_t* WT, long i) { const long n = i / K, k = i % K; WT[i] = f2bf(W[(size_t)k * ldw + n]); }
HD void b_tab(const float* src, bf16_t* dst, long i) { dst[i] = f2bf(src[i]); }
HD void b_ln_mod1(const Prm& p, long row) {
    const float* xr = p.x + (size_t)row * D; const int b = (int)(row / S);
    const float* sh = p.MOD() + (size_t)b * D6; const float* sc = sh + D;
    float s = 0.f; for (int d = 0; d < D; ++d) s += xr[d];
    const float mean = s / D; float q = 0.f; for (int d = 0; d < D; ++d) { const float t = xr[d] - mean; q += t * t; }
    const float rstd = 1.f / sqrtf(q / D + LN_EPS);
    for (int d = 0; d < D; ++d) p.U()[(size_t)row * D + d] = f2bf((xr[d] - mean) * rstd * (1.f + sc[d]) + sh[d]);
}
HD void b_gates(const Prm& p, long i) {
    const long row = i / NG; const int g = (int)(i % NG); float acc = 0.f;
    for (int d = 0; d < D; ++d) acc += bf2f(p.U()[(size_t)row * D + d]) * p.w_in[(size_t)d * INC + INM + g];
    p.GATES()[i] = acc + p.b_in[INM + g];
}
HD float b_dot16(const bf16_t* a, const bf16_t* b, int K) { float acc = 0.f; for (int k = 0; k < K; ++k) acc += bf2f(a[k]) * bf2f(b[k]); return acc; }
HD void b_gemm1(const Prm& p, long i) { const long row = i / INM; const int n = (int)(i % INM);
    p.PJ()[i] = f2bf(b_dot16(p.U() + (size_t)row * D, p.WIN_T() + (size_t)n * D, D) + p.b_in[n]); }
HD void b_conv(const Prm& p, long i) {
    const long row = i / CW; const int ch = (int)(i % CW); const int s = (int)(row % S);
    const bf16_t* pj = p.PJ(); float acc = p.conv_b[ch];
#pragma unroll
    for (int k = 0; k < 3; ++k) { const int s2 = s + k - 1; if (s2 >= 0 && s2 < S) { const size_t r2 = (size_t)(row + k - 1) * INM;
        acc += p.conv_w[k * CW + ch] * (bf2f(pj[r2 + O_GC + ch]) * bf2f(pj[r2 + O_HIN + ch])); } }
    p.Y()[(size_t)row * D + ch] = f2bf(bf2f(pj[(size_t)row * INM + O_GB + ch]) * acc);
}
HDF long ml_tok(int dir, int b, int pos) { return (long)b * S + (dir ? S - 1 - pos : pos); }
HD void b_mscan(const Prm& p, long i) {
    const int v = (int)(i % (MV + 1)), h = (int)((i / (MV + 1)) % MH), b = (int)((i / ((MV + 1) * MH)) % NB), dir = (int)(i / ((MV + 1) * MH * NB));
    float C[QK];
#pragma unroll
    for (int d = 0; d < QK; ++d) C[d] = 0.f;
    float m = 0.f; const float qs = 1.f / sqrtf((float)QK);
    float* H = dir ? p.HB() : p.HF();
    for (int pos = 0; pos < S; ++pos) {
        const long tok = ml_tok(dir, b, pos); const float* g = p.GATES() + tok * NG + dir * 8;
        const float ig = g[h], lf = logsigmoidf_(g[4 + h]);
        const float mn = fmaxf(lf + m, ig), dec = expf(lf + m - mn), wi = expf(ig - mn); m = mn;
        const bf16_t* pj = p.PJ() + (size_t)tok * INM; const float wv = wi * (v < MV ? bf2f(pj[O_V + h * MV + (v < MV ? v : 0)]) : 1.f); float num = 0.f;
#pragma unroll
        for (int d = 0; d < QK; ++d) { C[d] = dec * C[d] + wv * bf2f(pj[O_K + h * QK + d]); num += bf2f(pj[O_Q + h * QK + d]) * qs * C[d]; }
        if (v < MV) H[(size_t)tok * MW + h * MV + v] = num;
        else { p.DEN()[((size_t)dir * T + tok) * MH + h] = num; p.FLR()[((size_t)dir * T + tok) * MH + h] = expf(-mn); }
    }
}
HD void b_headnorm(const Prm& p, long i) {
    const long row = i / MH; const int h = (int)(i % MH);
    const float* hf = p.HF() + (size_t)row * MW + h * MV; const float* hb = p.HB() + (size_t)row * MW + h * MV;
    const float inf_ = 1.f / fmaxf(fabsf(p.DEN()[(size_t)row * MH + h]), p.FLR()[(size_t)row * MH + h]);
    const float inb_ = 1.f / fmaxf(fabsf(p.DEN()[((size_t)T + row) * MH + h]), p.FLR()[((size_t)T + row) * MH + h]);
    float s = 0.f; for (int v = 0; v < MV; ++v) s += hf[v] * inf_ + hb[v] * inb_;
    const float mean = s / MV; float q = 0.f; for (int v = 0; v < MV; ++v) { const float t = hf[v] * inf_ + hb[v] * inb_ - mean; q += t * t; }
    const float rstd = 1.f / sqrtf(q / MV + LN_EPS);
    for (int v = 0; v < MV; ++v) { const float hn = (hf[v] * inf_ + hb[v] * inb_ - mean) * rstd * p.mnorm_w[h * MV + v];
        const float og = sigmoidf_(bf2f(p.PJ()[(size_t)row * INM + O_O + h * MV + v]));
        p.Y()[(size_t)row * D + CW + h * MV + v] = f2bf(og * hn); }
}
HD void b_gemm2(const Prm& p, long i) { const long row = i / D; const int n = (int)(i % D); const int b = (int)(row / S);
    const float acc = b_dot16(p.Y() + (size_t)row * D, p.WOUT_T() + (size_t)n * D, D);
    p.out[i] = ALPHA * p.x[i] + p.MOD()[(size_t)b * D6 + 2 * D + n] * acc; }
HD void b_ln_mid(const Prm& p, long row) {
    float* zr = p.out + (size_t)row * D; const int b = (int)(row / S);
    const float* sh = p.MOD() + (size_t)b * D6 + 3 * D; const float* sc = sh + D;
    float s = 0.f; for (int d = 0; d < D; ++d) s += zr[d];
    float mean = s / D; float q = 0.f; for (int d = 0; d < D; ++d) { const float t = zr[d] - mean; q += t * t; }
    float rstd = 1.f / sqrtf(q / D + LN_EPS);
    s = 0.f; for (int d = 0; d < D; ++d) { const float x1 = (zr[d] - mean) * rstd * p.ln1_w[d] + p.ln1_b[d]; zr[d] = x1; s += x1; }
    mean = s / D; q = 0.f; for (int d = 0; d < D; ++d) { const float t = zr[d] - mean; q += t * t; }
    rstd = 1.f / sqrtf(q / D + LN_EPS);
    for (int d = 0; d < D; ++d) p.U()[(size_t)row * D + d] = f2bf((zr[d] - mean) * rstd * (1.f + sc[d]) + sh[d]);
}
HD void b_gemm3(const Prm& p, long i) { const long row = i / NQ; const int n = (int)(i % NQ);
    p.Y()[i] = f2bf(b_dot16(p.U() + (size_t)row * D, p.WQ_T() + (size_t)n * D, D)); }
HD void b_scores(const Prm& p, long i) { const long tok = i / NSC; const int c = (int)(i % NSC), grp = c / NK, n = c % NK;
    const bf16_t* q = p.Y() + (size_t)tok * NQ + grp * KH; const float* sk = p.subkeys + ((size_t)grp * NK + n) * KH; float acc = 0.f;
    for (int d = 0; d < KH; ++d) acc += bf2f(q[d]) * sk[d];
    p.SC()[i] = acc; }
HD void b_topk1(const Prm& p, long i) {
    const float* sc = p.SC() + (size_t)i * NK; float pv = INFINITY; int pi = -1;
    for (int r = 0; r < TOPK; ++r) { float best = -INFINITY; int bi = -1;
        for (int n = 0; n < NK; ++n) { const float v = sc[n]; const bool ok = (v < pv) || (v == pv && n > pi); if (ok && v > best) { best = v; bi = n; } }
        p.TS()[(size_t)i * TOPK + r] = best; p.TI()[(size_t)i * TOPK + r] = bi; pv = best; pi = bi; }
}
HD void b_topk2(const Prm& p, long i) {
    const float* s0 = p.TS() + (size_t)i * 2 * TOPK; const float* s1 = s0 + TOPK; const int* i0 = p.TI() + (size_t)i * 2 * TOPK; const int* i1 = i0 + TOPK;
    float pv = INFINITY; int pi = -1; float mx = 0.f, sum = 0.f;
    for (int r = 0; r < TOPK; ++r) { float best = -INFINITY; int bi = -1;
        for (int c = 0; c < TOPK * TOPK; ++c) { const float v = s0[c / TOPK] + s1[c % TOPK]; const bool ok = (v < pv) || (v == pv && c > pi); if (ok && v > best) { best = v; bi = c; } }
        if (r == 0) mx = best;
        const float e = expf(best - mx); sum += e;
        p.EIDX()[(size_t)i * TOPK + r] = i0[bi / TOPK] * NK + i1[bi % TOPK]; p.EW()[(size_t)i * TOPK + r] = e; pv = best; pi = bi; }
    for (int r = 0; r < TOPK; ++r) p.EW()[(size_t)i * TOPK + r] /= sum;
}
HD void b_up(const Prm& p, long i) { const long tok = i / NSLOT; const int e = p.EIDX()[i];
    p.EW()[i] *= gelu_exact(b_dot16(p.U() + (size_t)tok * D, p.PU16() + (size_t)e * D, D)); }
HD void b_down(const Prm& p, long i) { const long tok = i / D; const int d = (int)(i % D); const int b = (int)(tok / S); float y = 0.f;
    for (int sl = 0; sl < NSLOT; ++sl) y += p.EW()[tok * NSLOT + sl] * bf2f(p.PV16()[(size_t)p.EIDX()[tok * NSLOT + sl] * D + d]);
    p.out[i] = ALPHA * p.out[i] + p.MOD()[(size_t)b * D6 + 5 * D + d] * y; }
HD void b_ln2(const Prm& p, long row) {
    float* zr = p.out + (size_t)row * D;
    float s = 0.f; for (int d = 0; d < D; ++d) s += zr[d];
    const float mean = s / D; float q = 0.f; for (int d = 0; d < D; ++d) { const float t = zr[d] - mean; q += t * t; }
    const float rstd = 1.f / sqrtf(q / D + LN_EPS);
    for (int d = 0; d < D; ++d) zr[d] = (zr[d] - mean) * rstd * p.ln2_w[d] + p.ln2_b[d];
}
#include <cstdio>
#define LAS __attribute__((address_space(3)))
#define GAS __attribute__((address_space(1)))
namespace pg8 {
#define PG8_LAS __attribute__((address_space(3)))
typedef unsigned short bf16_t;
typedef short bf16x8 __attribute__((ext_vector_type(8)));
typedef float f32x4 __attribute__((ext_vector_type(4)));
typedef unsigned u32x4 __attribute__((ext_vector_type(4)));
constexpr int BM = 256, BK = 64, HALF = 128, HTB = HALF * BK * 2  , STAGE_BYTES = 8 * HTB, NXCD = 8, WGM = 8;

__host__ __device__ __forceinline__ int lds_byte(int r, int c) { const int st = (r >> 4) * 2 + (c >> 5), rr = r & 15, cc = c & 31, ob = rr * 64 + cc * 2; return st * 1024 + (ob ^ (((ob >> 9) & 1) << 5)); }
__host__ __device__ __forceinline__ void stage_rc(int b, int& R, int& C) { const int st = b / 1024, sb = b % 1024, swz = sb ^ (((sb >> 9) & 1) << 5); R = (st >> 1) * 16 + swz / 64; C = (st & 1) * 32 + (swz % 64) / 2; }
__host__ __device__ __forceinline__ int perm32(int rho) { const int n = rho >> 4, i = rho & 15; return 8 * (i >> 2) + 4 * n + (i & 3); }

struct Unit { int pm, pn; };
struct Gemm { const bf16_t* A; const bf16_t* Bt; int M, N, K; };

struct StaticOrder {
    int nM, nN, nwg, G, c;
    __host__ __device__ void init(int M, int N, int G_, int c_) { nM = M / BM; nN = N / BM; nwg = nM * nN; G = G_; c = c_; }
    __host__ __device__ bool next(int i, Unit& u) const {
        const long L = (long)i * G + c; if (L >= nwg) return false;
        int wgid = (int)L; { const int q = nwg / NXCD, r = nwg % NXCD, xcd = wgid % NXCD, off = wgid / NXCD; wgid = (xcd < r ? xcd * (q + 1) : r * (q + 1) + (xcd - r) * q) + off; }
        const int nig = WGM * nN, gid = wgid / nig, fm = gid * WGM, gsz = (nM - fm) < WGM ? (nM - fm) : WGM;
        u.pm = fm + ((wgid % nig) % gsz); u.pn = (wgid % nig) / gsz; return true;
    }
    __device__ __forceinline__ void a_ready(const Unit&) const {}
    __device__ __forceinline__ void done(const Unit&) const {}
};

__device__ __forceinline__ unsigned cvt_pk_bf16(float lo, float hi) { unsigned r; asm volatile("v_cvt_pk_bf16_f32 %0, %1, %2" : "=v"(r) : "v"(lo), "v"(hi)); return r; }
typedef float f32x2 __attribute__((ext_vector_type(2)));
__device__ __forceinline__ f32x2 gelu_pk(f32x2 v) {
    const f32x2 av = __builtin_elementwise_abs(v), d = av * 0.2316418882f + 1.0f;
    f32x2 t; t.x = __builtin_amdgcn_rcpf(d.x); t.y = __builtin_amdgcn_rcpf(d.y);
    f32x2 q = t * 0.5307027145f + (-0.7265760135f); q = q * t + 0.7107068705f; q = q * t + (-0.142248368f); q = q * t + 0.127414796f; q = q * t;
    const f32x2 s = (v * v) * (-0.72134752044f);
    f32x2 e; e.x = __builtin_amdgcn_exp2f(s.x); e.y = __builtin_amdgcn_exp2f(s.y);
    const f32x2 m = v * (q * e), r = v - m;
    f32x2 o; o.x = v.x < 0.f ? m.x : r.x; o.y = v.y < 0.f ? m.y : r.y; return o;
}

template <int ACT  > struct EpiBf16 {
    static constexpr bool PERM = true, AFTER_DRAIN = false; static_assert(ACT == 0 || ACT == 1, "EpiBf16: ACT is 0 (none) or 1 (gelu_pk)");
    bf16_t* O; int ldc; const float* bias; int split_cols; size_t split_stride; float scale0;
    __device__ __forceinline__ void operator()(const f32x4 (&acc)[2][2][4][2], const Unit& u, int wr, int wc, int fr, int fq) const {
        const int row0 = u.pm * BM + wr * 64 + fr; int colt = u.pn * BM; bf16_t* base = O;
        float sc = 1.f; if (split_cols) { const int t = colt / split_cols; base += (size_t)t * split_stride; colt -= t * split_cols; if (t == 0) sc = scale0; }
        const int col0 = colt + wc * 32 + 8 * fq, bcol0 = u.pn * BM + wc * 32 + 8 * fq;
        f32x4 bv[2][2];
#pragma unroll
        for (int bj = 0; bj < 2; ++bj)
#pragma unroll
            for (int n = 0; n < 2; ++n) bv[bj][n] = bias ? *(const f32x4*)(bias + bcol0 + bj * HALF + 4 * n) : (f32x4){0.f, 0.f, 0.f, 0.f};
#pragma unroll
        for (int ai = 0; ai < 2; ++ai)
#pragma unroll
            for (int m = 0; m < 4; ++m) { bf16_t* rowp = base + (size_t)(row0 + ai * HALF + m * 16) * ldc + col0;
#pragma unroll
                for (int bj = 0; bj < 2; ++bj) { f32x4 v0 = acc[ai][bj][m][0] + bv[bj][0], v1 = acc[ai][bj][m][1] + bv[bj][1];
                    if (ACT == 1) { f32x2 a = gelu_pk((f32x2){v0[0], v0[1]}), b = gelu_pk((f32x2){v0[2], v0[3]}), c = gelu_pk((f32x2){v1[0], v1[1]}), d = gelu_pk((f32x2){v1[2], v1[3]});
                        v0 = (f32x4){a.x, a.y, b.x, b.y}; v1 = (f32x4){c.x, c.y, d.x, d.y}; }
                    v0 = v0 * sc; v1 = v1 * sc; u32x4 w; w.x = cvt_pk_bf16(v0[0], v0[1]); w.y = cvt_pk_bf16(v0[2], v0[3]); w.z = cvt_pk_bf16(v1[0], v1[1]); w.w = cvt_pk_bf16(v1[2], v1[3]);
                    *(u32x4*)(rowp + bj * HALF) = w; } }
    }
};
template <class Epi, class Sched, bool ALIGN_EPI = false, bool SP2 = false>
__device__ __forceinline__ void gemm_phase(PG8_LAS unsigned char* lds, const Gemm g, const Sched& S, const Epi& E) {
    const int tid = threadIdx.x, wid = __builtin_amdgcn_readfirstlane(tid >> 6), lane = tid & 63, wr = wid >> 2, wc = wid & 3, fr = lane & 15, fq = lane >> 4;
    const int K = g.K, nt = K / BK;
    unsigned voffA[2], voffB[2];
#pragma unroll
    for (int i = 0; i < 2; ++i) { int R, C; stage_rc(tid * 16 + i * 8192, R, C); const int Rb = Epi::PERM ? ((R & ~31) + perm32(R & 31)) : R;
        voffA[i] = (unsigned)(R * K + C) * 2u; voffB[i] = (unsigned)(Rb * K + C) * 2u; }
    const size_t kstep = (size_t)(BK * 2);
    const size_t hstep = (size_t)HALF * K * 2;
    const size_t tstep = 2 * hstep;
    const unsigned ldsw = (unsigned)wid * 1024u;
    const int aoff = lds_byte(wr * 64 + fr, fq * 8), boff = lds_byte(wc * 32 + fr, fq * 8);
#define PG8_SA(b, h) (((b) * 2 + (h)) * HTB)
#define PG8_SB(b, h) ((4 + (b) * 2 + (h)) * HTB)
#define PG8_STAGE(bufoff, gbase, voff) do { _Pragma("unroll") for (int _i = 0; _i < 2; ++_i) \
        __builtin_amdgcn_global_load_lds((const unsigned*)((const char*)(gbase) + (voff)[_i]), (PG8_LAS unsigned*)(lds + (bufoff) + ldsw + _i * 8192), 16, 0, 0); } while (0)
#define PG8_LDA(dst, b, h) do { _Pragma("unroll") for (int m = 0; m < 4; ++m) _Pragma("unroll") for (int k = 0; k < 2; ++k) dst[m][k] = *(const PG8_LAS bf16x8*)(lds + PG8_SA(b, h) + aoff + m * 2048 + k * 1024); } while (0)
#define PG8_LDB(dst, b, h) do { _Pragma("unroll") for (int n = 0; n < 2; ++n) _Pragma("unroll") for (int k = 0; k < 2; ++k) dst[n][k] = *(const PG8_LAS bf16x8*)(lds + PG8_SB(b, h) + boff + n * 2048 + k * 1024); } while (0)
#define PG8_MMA(ai, bj, At, Bt) do { __builtin_amdgcn_s_setprio(1); _Pragma("unroll") for (int m = 0; m < 4; ++m) _Pragma("unroll") for (int n = 0; n < 2; ++n) _Pragma("unroll") for (int k = 0; k < 2; ++k) \
        acc[ai][bj][m][n] = __builtin_amdgcn_mfma_f32_16x16x32_bf16(Bt[n][k], At[m][k], acc[ai][bj][m][n], 0, 0, 0); __builtin_amdgcn_s_setprio(0); } while (0)
#define PG8_WAIT_V(n) asm volatile("s_waitcnt vmcnt(" #n ")" ::: "memory")
#define PG8_WAIT_L(n) asm volatile("s_waitcnt lgkmcnt(" #n ")" ::: "memory")
#define PG8_BAR __builtin_amdgcn_s_barrier()
#define PG8_SCHED __builtin_amdgcn_sched_barrier(0)
    Unit cur, nxt; int ui = 0;
    if (!S.next(0, cur)) return;
    f32x4 acc[2][2][4][2];
#pragma unroll
    for (int a = 0; a < 2; ++a)
#pragma unroll
        for (int b = 0; b < 2; ++b)
#pragma unroll
            for (int m = 0; m < 4; ++m)
#pragma unroll
                for (int n = 0; n < 2; ++n) acc[a][b][m][n] = (f32x4){0.f, 0.f, 0.f, 0.f};
    bf16x8 At[4][2], B0[2][2], B1[2][2];
    const char* cA = (const char*)g.A + (size_t)cur.pm * tstep; const char* cB = (const char*)g.Bt + (size_t)cur.pn * tstep;
    S.a_ready(cur);
    if constexpr (SP2) {
        PG8_STAGE(PG8_SB(0, 0), cB, voffB); PG8_STAGE(PG8_SB(0, 1), cB + hstep, voffB); PG8_STAGE(PG8_SA(0, 0), cA, voffA); PG8_STAGE(PG8_SA(0, 1), cA + hstep, voffA);
        if (wr == 1) PG8_BAR;
        PG8_WAIT_V(2); PG8_BAR;
        PG8_STAGE(PG8_SB(1, 0), cB + kstep, voffB); PG8_STAGE(PG8_SA(1, 0), cA + kstep, voffA); PG8_STAGE(PG8_SB(1, 1), cB + hstep + kstep, voffB);
        PG8_WAIT_V(6); PG8_BAR;
    } else {
        PG8_STAGE(PG8_SB(0, 0), cB, voffB); PG8_STAGE(PG8_SA(0, 0), cA, voffA); PG8_STAGE(PG8_SB(0, 1), cB + hstep, voffB); PG8_STAGE(PG8_SA(0, 1), cA + hstep, voffA);
        if (wr == 1) PG8_BAR;
        PG8_WAIT_V(4); PG8_BAR;
        PG8_STAGE(PG8_SB(1, 0), cB + kstep, voffB); PG8_STAGE(PG8_SA(1, 0), cA + kstep, voffA); PG8_STAGE(PG8_SB(1, 1), cB + hstep + kstep, voffB);
        PG8_WAIT_V(6); PG8_BAR;
    }
    for (;;) {
        const bool has_next = S.next(ui + 1, nxt);
        const char* nA = has_next ? (const char*)g.A + (size_t)nxt.pm * tstep : cA; const char* nB = has_next ? (const char*)g.Bt + (size_t)nxt.pn * tstep : cB;
        for (int t = 0; t < nt; t += 2) {
            const bool last = (t == nt - 2);
            const char* a1 = cA + (size_t)(t + 1) * kstep;
            const char* a2 = last ? nA : cA + (size_t)(t + 2) * kstep; const char* b2 = last ? nB : cB + (size_t)(t + 2) * kstep;
            const char* a3 = a2 + kstep; const char* b3 = b2 + kstep;
            if (last && has_next) S.a_ready(nxt);
            if constexpr (SP2) {
            PG8_LDB(B0, 0, 0); PG8_LDB(B1, 0, 1); PG8_SCHED; PG8_LDA(At, 0, 0); PG8_STAGE(PG8_SA(1, 1), a1 + hstep, voffA);
            PG8_WAIT_V(8); PG8_WAIT_L(0); PG8_BAR; PG8_MMA(0, 0, At, B0); PG8_MMA(0, 1, At, B1); PG8_BAR; PG8_SCHED;
            PG8_LDA(At, 0, 1); PG8_STAGE(PG8_SB(0, 0), b2, voffB); PG8_STAGE(PG8_SB(0, 1), b2 + hstep, voffB); PG8_STAGE(PG8_SA(0, 0), a2, voffA);
            PG8_WAIT_V(8); PG8_WAIT_L(0); PG8_BAR; PG8_MMA(1, 0, At, B0); PG8_MMA(1, 1, At, B1); PG8_BAR; PG8_SCHED;
            PG8_LDB(B0, 1, 0); PG8_LDB(B1, 1, 1); PG8_SCHED; PG8_LDA(At, 1, 0); PG8_STAGE(PG8_SA(0, 1), a2 + hstep, voffA);
            PG8_WAIT_V(8); PG8_WAIT_L(0); PG8_BAR; PG8_MMA(0, 0, At, B0); PG8_MMA(0, 1, At, B1); PG8_BAR; PG8_SCHED;
            PG8_LDA(At, 1, 1); PG8_STAGE(PG8_SB(1, 0), b3, voffB); PG8_STAGE(PG8_SB(1, 1), b3 + hstep, voffB); PG8_STAGE(PG8_SA(1, 0), a3, voffA);
            PG8_WAIT_V(8); PG8_WAIT_L(0); PG8_BAR; PG8_MMA(1, 0, At, B0); PG8_MMA(1, 1, At, B1); PG8_BAR; PG8_SCHED;
            } else {
            PG8_LDB(B0, 0, 0); PG8_SCHED; PG8_LDA(At, 0, 0); PG8_STAGE(PG8_SA(1, 1), a1 + hstep, voffA);
            PG8_WAIT_L(8); PG8_BAR; PG8_WAIT_L(0); PG8_MMA(0, 0, At, B0); PG8_BAR; PG8_SCHED;
            PG8_LDB(B1, 0, 1); PG8_STAGE(PG8_SB(0, 0), b2, voffB);
            PG8_BAR; PG8_WAIT_L(0); PG8_MMA(0, 1, At, B1); PG8_BAR;
            PG8_LDA(At, 0, 1); PG8_STAGE(PG8_SA(0, 0), a2, voffA);
            PG8_BAR; PG8_WAIT_L(0); PG8_MMA(1, 0, At, B0); PG8_BAR; PG8_SCHED;
            PG8_STAGE(PG8_SB(0, 1), b2 + hstep, voffB);
            PG8_WAIT_V(6); PG8_BAR; PG8_MMA(1, 1, At, B1); PG8_BAR;
            PG8_LDB(B0, 1, 0); PG8_SCHED; PG8_LDA(At, 1, 0); PG8_STAGE(PG8_SA(0, 1), a2 + hstep, voffA);
            PG8_WAIT_L(8); PG8_BAR; PG8_WAIT_L(0); PG8_MMA(0, 0, At, B0); PG8_BAR; PG8_SCHED;
            PG8_LDB(B1, 1, 1); PG8_STAGE(PG8_SB(1, 0), b3, voffB);
            PG8_BAR; PG8_WAIT_L(0); PG8_MMA(0, 1, At, B1); PG8_BAR;
            PG8_LDA(At, 1, 1); PG8_STAGE(PG8_SA(1, 0), a3, voffA);
            PG8_BAR; PG8_WAIT_L(0); PG8_MMA(1, 0, At, B0); PG8_BAR; PG8_SCHED;
            PG8_STAGE(PG8_SB(1, 1), b3 + hstep, voffB);
            PG8_WAIT_V(6); PG8_BAR; PG8_MMA(1, 1, At, B1); PG8_BAR;
            }
        }
        if constexpr (ALIGN_EPI) { if (wr == 0) PG8_BAR; }
        if constexpr (!Epi::AFTER_DRAIN) { E(acc, cur, wr, wc, fr, fq); S.done(cur); }
        if (!has_next) break;
#pragma unroll
        for (int a = 0; a < 2; ++a)
#pragma unroll
            for (int b = 0; b < 2; ++b)
#pragma unroll
                for (int m = 0; m < 4; ++m)
#pragma unroll
                    for (int n = 0; n < 2; ++n) acc[a][b][m][n] = (f32x4){0.f, 0.f, 0.f, 0.f};
        cur = nxt; cA = nA; cB = nB; ++ui;
        if constexpr (ALIGN_EPI) { if (wr == 1) PG8_BAR; }
    }
    PG8_WAIT_V(0);
    if constexpr (!ALIGN_EPI) { if (wr == 0) PG8_BAR; }
    PG8_BAR;
    if constexpr (Epi::AFTER_DRAIN) { E.fused(acc, cur, wr, wc, fr, fq, lds, wid, lane); S.done(cur); }
#undef PG8_SA
#undef PG8_SB
#undef PG8_STAGE
#undef PG8_LDA
#undef PG8_LDB
#undef PG8_MMA
#undef PG8_WAIT_V
#undef PG8_WAIT_L
#undef PG8_BAR
#undef PG8_SCHED
}
}
#define XB_TMO      128
#define XB_XCNT(j)  (256  + 64 * (j))
#define XB_XSUB(j)  (1280 + 64 * (j))
#define XB_XGEN(j)  (2304 + 64 * (j))
#define XB_TOP      3328
#define XB_TOPGEN   3392
#define XCD_BAR_WORDS 3456
#define XB_SPIN_CAP (1u << 18)

__device__ __forceinline__ unsigned xb_ld(unsigned* p)              { return __hip_atomic_load(p, __ATOMIC_RELAXED, __HIP_MEMORY_SCOPE_AGENT); }
__device__ __forceinline__ unsigned xb_add(unsigned* p, unsigned v) { return __hip_atomic_fetch_add(p, v, __ATOMIC_RELAXED, __HIP_MEMORY_SCOPE_AGENT); }
__device__ __forceinline__ unsigned xb_xcc_id() { return (unsigned)__builtin_amdgcn_s_getreg((3 << 11) | 20) & 0xFu; }
#define XB_SPIN(cond, bar) do { unsigned _sp = 0; while (cond) { __builtin_amdgcn_s_sleep(1); \
    if ((++_sp & 255u) == 0u) { if (xb_ld(&(bar)[XB_TMO])) break; if (_sp > XB_SPIN_CAP) { atomicAdd(&(bar)[XB_TMO], 1u); break; } } } } while (0)

struct XcdBarrier {
    unsigned* bar; unsigned x;
    volatile LAS unsigned* st;
};

__device__ __forceinline__ XcdBarrier xcd_barrier_post(unsigned* bar, volatile LAS unsigned* st) {
    XcdBarrier b; b.bar = bar; b.x = xb_xcc_id(); b.st = st;
    if (threadIdx.x == 0) st[2] = xb_add(&bar[XB_XCNT(b.x)], 1u) + 1u;
    return b;
}
__device__ __forceinline__ void xcd_barrier_complete(unsigned* bar, unsigned x, unsigned& nloc, unsigned& nx) {
    const unsigned G = gridDim.x * gridDim.y * gridDim.z;
    unsigned sum, cnt, mine, sp = 0u;
    for (;;) {
        sum = 0u; cnt = 0u; mine = 0u;
#pragma unroll
        for (unsigned j = 0; j < 16; ++j) { const unsigned c = xb_ld(&bar[XB_XCNT(j)]); sum += c; cnt += (c > 0u) ? 1u : 0u; mine = (j == x) ? c : mine; }
        if (sum == G) break;
        __builtin_amdgcn_s_sleep(1);
        if ((++sp & 255u) == 0u) { if (xb_ld(&bar[XB_TMO])) break; if (sp > XB_SPIN_CAP) { atomicAdd(&bar[XB_TMO], 1u); break; } }
    }
    nloc = mine > 0u ? mine : 1u; nx = cnt > 0u ? cnt : 1u;
}

__device__ __forceinline__ void xcd_barrier(const XcdBarrier& b) {
    asm volatile("s_waitcnt vmcnt(0)" ::: "memory");
    __syncthreads();
    if (threadIdx.x == 0) {
        unsigned* bar = b.bar;
        __builtin_amdgcn_s_waitcnt(0);
        unsigned nloc = b.st[0], nx = b.st[1];
        if (nloc == 0u) { xcd_barrier_complete(bar, b.x, nloc, nx); b.st[0] = nloc; b.st[1] = nx; }
        const unsigned old = xb_add(&bar[XB_XSUB(b.x)], 1u);
        const unsigned gen = old / nloc;
        if (old + 1u == (gen + 1u) * nloc) {
            __builtin_amdgcn_fence(__ATOMIC_RELEASE, "agent");
            asm volatile("s_waitcnt vmcnt(0)" ::: "memory");
            const unsigned og = xb_add(&bar[XB_TOP], 1u);
            const unsigned tg = og / nx;
            if (og + 1u == (tg + 1u) * nx) xb_add(&bar[XB_TOPGEN], 1u);
            else XB_SPIN(xb_ld(&bar[XB_TOPGEN]) == tg, bar);
            __builtin_amdgcn_fence(__ATOMIC_ACQUIRE, "agent");
            xb_add(&bar[XB_XGEN(b.x)], 1u);
            asm volatile("s_waitcnt vmcnt(0)" ::: "memory");
        } else {
            XB_SPIN(xb_ld(&bar[XB_XGEN(b.x)]) == gen, bar);
            __builtin_amdgcn_fence(__ATOMIC_ACQUIRE, "agent");
            asm volatile("s_waitcnt vmcnt(0)" ::: "memory");
        }
    }
    __syncthreads();
}
constexpr int NWAVES = 8, NTHR = 512;
constexpr int RING_BYTES = 131072, LDSCTL_OFF = RING_BYTES, MISC_OFF = LDSCTL_OFF + 320, LDS_BYTES = 163840;
constexpr int CW_BAR = 4096;
#ifndef MK_N_LAUNCHES
#define MK_N_LAUNCHES 1
#endif
constexpr int NPHASE = 13;

typedef float f4v __attribute__((ext_vector_type(4)));
typedef unsigned u2v __attribute__((ext_vector_type(2)));
typedef unsigned u32x4_t __attribute__((ext_vector_type(4)));
struct Frame { LAS unsigned char* lds; int tid, lane, wave, G, bid; };
template <int CTRL, int ROWMASK> __device__ __forceinline__ float dppf(float old, float src) {
    return __builtin_bit_cast(float, __builtin_amdgcn_update_dpp(__builtin_bit_cast(int, old), __builtin_bit_cast(int, src), CTRL, ROWMASK, 0xf, false)); }
__device__ __forceinline__ float wave_scan_add(float v) {
    v += dppf<0x111, 0xf>(0.f, v); v += dppf<0x112, 0xf>(0.f, v); v += dppf<0x114, 0xf>(0.f, v); v += dppf<0x118, 0xf>(0.f, v);
    v += dppf<0x142, 0xa>(0.f, v); v += dppf<0x143, 0xc>(0.f, v); return v; }
__device__ __forceinline__ float wave_scan_max(float v) {
    const float NI = -INFINITY;
    v = fmaxf(v, dppf<0x111, 0xf>(NI, v)); v = fmaxf(v, dppf<0x112, 0xf>(NI, v)); v = fmaxf(v, dppf<0x114, 0xf>(NI, v)); v = fmaxf(v, dppf<0x118, 0xf>(NI, v));
    v = fmaxf(v, dppf<0x142, 0xa>(NI, v)); v = fmaxf(v, dppf<0x143, 0xc>(NI, v)); return v; }
__device__ __forceinline__ float lane_bcast(float v, int l) { return __builtin_bit_cast(float, __builtin_amdgcn_readlane(__builtin_bit_cast(int, v), l)); }
__device__ __forceinline__ float wave_sum(float v) { return lane_bcast(wave_scan_add(v), 63); }
__device__ __forceinline__ unsigned pk2(float lo, float hi) { return (unsigned)f2bf(lo) | ((unsigned)f2bf(hi) << 16); }
__device__ __forceinline__ float bflo(unsigned w) { return u_as_f(w << 16); }
__device__ __forceinline__ float bfhi(unsigned w) { return u_as_f(w & 0xffff0000u); }

__device__ __forceinline__ void p0_ada_item(const Prm& p, const Frame& F, int item) {
    static_assert(D6 % 2048 == 0 && D % NKS == 0 && D / NKS == 64, "ada item shape");
    LAS float* sl = (LAS float*)F.lds;
    const int ks = item / (D6 / 2048), cg = item % (D6 / 2048), k0 = ks * 64, n0 = cg * 2048 + 4 * F.tid;
    { const int b = F.tid / 64, k = F.tid % 64; const float cv = p.c[b * D + k0 + k]; sl[F.tid] = cv / (1.f + __expf(-cv)); }
    __syncthreads();
    f4v acc[NB];
#pragma unroll
    for (int b = 0; b < NB; ++b) acc[b] = (f4v){0.f, 0.f, 0.f, 0.f};
    const float* wp = p.w_ada + (size_t)k0 * D6 + n0;
#pragma unroll 8
    for (int k = 0; k < 64; ++k) { const f4v w = __builtin_nontemporal_load((const f4v*)(wp + (size_t)k * D6));
#pragma unroll
        for (int b = 0; b < NB; ++b) acc[b] += w * sl[b * 64 + k]; }
#pragma unroll
    for (int b = 0; b < NB; ++b) *(f4v*)(p.MODP() + ((size_t)ks * NB + b) * D6 + n0) = acc[b];
    __syncthreads();
}
__device__ __forceinline__ void p0_transpose_item(const float* W, int ldw, int K, int N, bf16_t* WT, LAS float* scr, int item, int lane) {
    const int nblk = N / 32, kb = item / nblk, nb = item % nblk, k0 = 64 * kb, n0 = 32 * nb;
#pragma unroll
    for (int i = 0; i < 32; ++i) { const int kk = 2 * i + (lane >> 5); scr[kk * 33 + (lane & 31)] = W[(size_t)(k0 + kk) * ldw + n0 + (lane & 31)]; }
    asm volatile("s_waitcnt lgkmcnt(0)" ::: "memory");
    const int c = lane & 7;
#pragma unroll
    for (int j = 0; j < 4; ++j) { const int n = (lane >> 3) + 8 * j; const LAS float* s = scr + (8 * c) * 33 + n;
        uint4 o; o.x = pk2(s[0 * 33], s[1 * 33]); o.y = pk2(s[2 * 33], s[3 * 33]); o.z = pk2(s[4 * 33], s[5 * 33]); o.w = pk2(s[6 * 33], s[7 * 33]);
        *(uint4*)(WT + (size_t)(n0 + n) * K + k0 + 8 * c) = o; }
    asm volatile("s_waitcnt lgkmcnt(0)" ::: "memory");
}

__device__ __forceinline__ void p0_fold_item(const Prm& p, int item, int lane) {
    static_assert(NK == 128 && KH == 128 && NQ == 2048, "fold item decomposition");
    const int ks = item & 31, nt = (item >> 5) & 7, g = item >> 8;
    const int r = lane & 15, q = lane >> 4;
    const float* arow = p.subkeys + ((size_t)g * NK + nt * 16 + r) * KH + 4 * q;
    const float* brow = p.wq + (size_t)(ks * 64 + r) * NQ + g * KH + 4 * q;
    pg8::f32x4 acc[4];
#pragma unroll
    for (int c = 0; c < 4; ++c) acc[c] = (pg8::f32x4){0.f, 0.f, 0.f, 0.f};
#pragma unroll 2
    for (int s16 = 0; s16 < KH; s16 += 16) {
        const pg8::f32x4 a = *(const pg8::f32x4*)(arow + s16); pg8::f32x4 bv[4];
#pragma unroll
        for (int c = 0; c < 4; ++c) bv[c] = *(const pg8::f32x4*)(brow + (size_t)(c * 16) * NQ + s16);
#pragma unroll
        for (int i = 0; i < 4; ++i)
#pragma unroll
            for (int c = 0; c < 4; ++c) acc[c] = __builtin_amdgcn_mfma_f32_16x16x4f32(a[i], bv[c][i], acc[c], 0, 0, 0);
    }
#pragma unroll
    for (int c = 0; c < 4; ++c)
#pragma unroll
        for (int i = 0; i < 4; ++i) p.WQ_T()[(size_t)(g * NK + nt * 16 + 4 * q + i) * D + ks * 64 + c * 16 + r] = f2bf(acc[c][i]);
}
__device__ __forceinline__ void phase0(const Prm& p, const Frame& F) {
    for (int it = F.bid; it < NKS * (D6 / 2048); it += F.G) p0_ada_item(p, F, it);
    LAS float* scr = (LAS float*)(F.lds + F.wave * 16384);
    const int gw = F.bid * NWAVES + F.wave, NGW = F.G * NWAVES;
    constexpr int I_IN = (D / 64) * (INM / 32);
    for (int it = gw; it < I_IN; it += NGW) p0_transpose_item(p.w_in, INC, D, INM, p.WIN_T(), scr, it, F.lane);
}
template <bool PART_A, bool PART_B, bool PART_F>
__device__ __forceinline__ void deferred_prep(const Prm& p, const Frame& F, int b0, int nb) {
    __syncthreads();
    LAS float* scr = (LAS float*)(F.lds + F.wave * 16384);
    const int gw = (F.bid - b0) * NWAVES + F.wave, NGW = nb * NWAVES;
    constexpr int I_O = (D / 64) * (D / 32), I_Q = 32 * 8 * 16;
    if (PART_A) for (int it = gw; it < I_O; it += NGW) p0_transpose_item(p.w_out, D, D, D, p.WOUT_T(), scr, it, F.lane);
    if (PART_F) for (int it = gw; it < I_Q; it += NGW) p0_fold_item(p, it, F.lane);
    if (PART_A) {
        float4 v[8], vn[8]; int rr = gw;
#define P0_ROWSRC(rr_) ((const float4*)(p.peer_u + (size_t)(rr_) * D) + F.lane)
        if (rr < NE) { const float4* src = P0_ROWSRC(rr);
#pragma unroll
            for (int j = 0; j < 8; ++j) { const f4v t_ = __builtin_nontemporal_load((const f4v*)(src + 64 * j)); v[j] = make_float4(t_[0], t_[1], t_[2], t_[3]); } }
        for (; rr < NE; rr += NGW) {
            const int rn = rr + NGW;
            if (rn < NE) { const float4* src = P0_ROWSRC(rn);
#pragma unroll
                for (int j = 0; j < 8; ++j) { const f4v t_ = __builtin_nontemporal_load((const f4v*)(src + 64 * j)); vn[j] = make_float4(t_[0], t_[1], t_[2], t_[3]); } }
            const int e = rr; float am = 0.f;
#pragma unroll
            for (int j = 0; j < 8; ++j) am = fmaxf(am, fmaxf(fmaxf(fabsf(v[j].x), fabsf(v[j].y)), fmaxf(fabsf(v[j].z), fabsf(v[j].w))));
#pragma unroll
            for (int o = 1; o < 64; o <<= 1) am = fmaxf(am, __shfl_xor(am, o));
            const float sc = am > 0.f ? 384.f / am : 1.f;
            unsigned* dst = (unsigned*)(p.PU8() + (size_t)e * D) + F.lane;
#pragma unroll
            for (int j = 0; j < 8; ++j) { unsigned w = 0u; w = __builtin_amdgcn_cvt_pk_fp8_f32(v[j].x * sc, v[j].y * sc, w, false); w = __builtin_amdgcn_cvt_pk_fp8_f32(v[j].z * sc, v[j].w * sc, w, true); dst[64 * j] = w; }
            if (F.lane == 0) p.RSU()[e] = am > 0.f ? am / 384.f : 1.f;
#pragma unroll
            for (int j = 0; j < 8; ++j) v[j] = vn[j];
        }
#undef P0_ROWSRC
    }
    if (PART_B) { LAS unsigned char* tl = F.lds; constexpr int RS_ = 2056;
      for (int tile = F.bid - b0; tile < NE / 16; tile += nb) { const int row = F.tid >> 5, l32 = F.tid & 31, e = tile * 16 + row;
        __syncthreads();
        const f4v* src = (const f4v*)(p.peer_v + (size_t)e * D) + l32; f4v x[16]; float am = 0.f;
#pragma unroll
        for (int j = 0; j < 16; ++j) { x[j] = __builtin_nontemporal_load(src + 32 * j); am = fmaxf(am, fmaxf(fmaxf(fabsf(x[j][0]), fabsf(x[j][1])), fmaxf(fabsf(x[j][2]), fabsf(x[j][3])))); }
#pragma unroll
        for (int o = 1; o < 32; o <<= 1) am = fmaxf(am, __shfl_xor(am, o));
        const float sc = am > 0.f ? 384.f / am : 1.f;
#pragma unroll
        for (int j = 0; j < 16; ++j) { unsigned w = 0u; w = __builtin_amdgcn_cvt_pk_fp8_f32(x[j][0] * sc, x[j][1] * sc, w, false); w = __builtin_amdgcn_cvt_pk_fp8_f32(x[j][2] * sc, x[j][3] * sc, w, true);
            *(LAS unsigned*)(tl + row * RS_ + 4 * (l32 + 32 * j)) = w; }
        if (l32 == 0) p.RSV()[e] = am > 0.f ? am / 384.f : 1.f;
        __syncthreads();
#pragma unroll
        for (int k = 0; k < 8; ++k) { const int idx = F.tid + NTHR * k, r = idx & 15, sl = idx >> 4;
            *(u2v*)(p.PV8S() + ((size_t)sl * NE + tile * 16 + r) * 8) = *(const LAS u2v*)(tl + r * RS_ + 8 * sl); }
      } }
}
__device__ __forceinline__ void phase1(const Prm& p, const Frame& F) {
    LAS float* SH = (LAS float*)F.lds; LAS float* SC1 = SH + D;
    LAS bf16_t* WG = (LAS bf16_t*)(F.lds + 2 * D * 4);
    const int rows_per = T / F.G;
    for (int idx = F.bid * NTHR + F.tid; idx < NB * D6; idx += F.G * NTHR) {
        const int n = idx % D6, b = idx / D6; float s = 0.f;
        for (int ks = 0; ks < NKS; ++ks) s += p.MODP()[((size_t)ks * NB + b) * D6 + n];
        p.MOD()[idx] = s + p.b_ada[n]; }
    { const int st = (F.bid * 37) % (NG * D / NTHR);
      for (int k = 0; k < NG * D / NTHR; ++k) { const int idx = F.tid + NTHR * ((k + st) % (NG * D / NTHR)); const int d = idx / NG, g = idx % NG; WG[g * D + d] = f2bf(p.w_in[(size_t)d * INC + INM + g]); } }
    int cur_b = -1;
    float4 xpre[8];
    { const float4* x0 = (const float4*)(p.x + (size_t)(F.bid * rows_per + F.wave) * D) + F.lane;
#pragma unroll
      for (int j = 0; j < 8; ++j) xpre[j] = x0[64 * j]; }
    for (int r0 = F.bid * rows_per; r0 < (F.bid + 1) * rows_per; r0 += NWAVES) {
        const int b = r0 / S;
        if (b != cur_b) { __syncthreads();
            for (int n = F.tid; n < 2 * D; n += NTHR) { float s = 0.f; const int ks0 = F.bid % NKS; for (int kk = 0; kk < NKS; ++kk) { const int ks = (kk + ks0) % NKS; s += p.MODP()[((size_t)ks * NB + b) * D6 + n]; }
                s += p.b_ada[n]; SH[n] = n < D ? s : 1.f + s; }
            cur_b = b; __syncthreads(); }
        const int row = r0 + F.wave;
        float4 v[8]; float s = 0.f;
#pragma unroll
        for (int j = 0; j < 8; ++j) v[j] = xpre[j];
        if (r0 + NWAVES < (F.bid + 1) * rows_per) { const float4* xn = (const float4*)(p.x + (size_t)(row + NWAVES) * D) + F.lane;
#pragma unroll
            for (int j = 0; j < 8; ++j) xpre[j] = xn[64 * j]; }
#pragma unroll
        for (int j = 0; j < 8; ++j) s += (v[j].x + v[j].y) + (v[j].z + v[j].w);
        const float mean = wave_sum(s) * (1.f / D); float s2 = 0.f;
#pragma unroll
        for (int j = 0; j < 8; ++j) { v[j].x -= mean; v[j].y -= mean; v[j].z -= mean; v[j].w -= mean; s2 += (v[j].x * v[j].x + v[j].y * v[j].y) + (v[j].z * v[j].z + v[j].w * v[j].w); }
        const float rstd = 1.f / sqrtf(wave_sum(s2) * (1.f / D) + LN_EPS);
        uint2* o8 = (uint2*)(p.U() + (size_t)row * D) + F.lane;
#pragma unroll
        for (int j = 0; j < 8; ++j) { const int c0 = 4 * F.lane + 256 * j; const f4v sh = *(const LAS f4v*)(SH + c0), sc = *(const LAS f4v*)(SC1 + c0);
            v[j].x = v[j].x * rstd * sc.x + sh.x; v[j].y = v[j].y * rstd * sc.y + sh.y; v[j].z = v[j].z * rstd * sc.z + sh.z; v[j].w = v[j].w * rstd * sc.w + sh.w;
            o8[64 * j] = make_uint2(pk2(v[j].x, v[j].y), pk2(v[j].z, v[j].w)); }
        float ga[NG];
#pragma unroll
        for (int g = 0; g < NG; ++g) { float a = 0.f;
#pragma unroll
            for (int j = 0; j < 8; ++j) { const u2v w = *(const LAS u2v*)(WG + g * D + 4 * F.lane + 256 * j); a += v[j].x * bflo(w.x) + v[j].y * bfhi(w.x) + v[j].z * bflo(w.y) + v[j].w * bfhi(w.y); }
            ga[g] = a; }
        float r8[8], r4[4], r2[2]; const bool l0 = F.lane & 1, l1 = F.lane & 2, l2 = F.lane & 4, l3 = F.lane & 8;
#pragma unroll
        for (int i = 0; i < 8; ++i) { const float keep = l0 ? ga[8 + i] : ga[i], send = l0 ? ga[i] : ga[8 + i]; r8[i] = keep + __shfl_xor(send, 1); }
#pragma unroll
        for (int i = 0; i < 4; ++i) { const float keep = l1 ? r8[4 + i] : r8[i], send = l1 ? r8[i] : r8[4 + i]; r4[i] = keep + __shfl_xor(send, 2); }
#pragma unroll
        for (int i = 0; i < 2; ++i) { const float keep = l2 ? r4[2 + i] : r4[i], send = l2 ? r4[i] : r4[2 + i]; r2[i] = keep + __shfl_xor(send, 4); }
        float gacc = (l3 ? r2[1] : r2[0]) + __shfl_xor(l3 ? r2[0] : r2[1], 8);
        gacc += __shfl_xor(gacc, 16); gacc += __shfl_xor(gacc, 32);
        const int gi = (l0 ? 8 : 0) + (l1 ? 4 : 0) + (l2 ? 2 : 0) + (l3 ? 1 : 0);
        if (F.lane < NG) { const float gv = gacc + p.b_in[INM + gi]; p.GATES()[(size_t)row * NG + gi] = (gi & 4) ? logsigmoidf_(gv) : gv; }
    }
}
__device__ __forceinline__ void phase3a(const Prm& p, const Frame& F, int b0, int nb) {
    const size_t gt = (size_t)(F.bid - b0) * NTHR + F.tid, GT = (size_t)nb * NTHR;
    for (size_t i = gt; i < (size_t)T * (CW / 8); i += GT) {
        const size_t row = i / (CW / 8); const int ch = (int)(i % (CW / 8)) * 8, s = (int)(row % S);
        float acc[8];
#pragma unroll
        for (int e = 0; e < 8; ++e) acc[e] = p.conv_b[ch + e];
#pragma unroll
        for (int k = 0; k < 3; ++k) { const int s2 = s + k - 1; if (s2 < 0 || s2 >= S) continue; const bf16_t* pr = p.PJ() + (size_t)(row + k - 1) * INM;
            const uint4 gc = *(const uint4*)(pr + O_GC + ch), hi = *(const uint4*)(pr + O_HIN + ch); const float* cw = p.conv_w + k * CW + ch;
            acc[0] += cw[0] * (bflo(gc.x) * bflo(hi.x)); acc[1] += cw[1] * (bfhi(gc.x) * bfhi(hi.x)); acc[2] += cw[2] * (bflo(gc.y) * bflo(hi.y)); acc[3] += cw[3] * (bfhi(gc.y) * bfhi(hi.y));
            acc[4] += cw[4] * (bflo(gc.z) * bflo(hi.z)); acc[5] += cw[5] * (bfhi(gc.z) * bfhi(hi.z)); acc[6] += cw[6] * (bflo(gc.w) * bflo(hi.w)); acc[7] += cw[7] * (bfhi(gc.w) * bfhi(hi.w)); }
        const uint4 gb = *(const uint4*)(p.PJ() + row * INM + O_GB + ch); uint4 o;
        o.x = pk2(bflo(gb.x) * acc[0], bfhi(gb.x) * acc[1]); o.y = pk2(bflo(gb.y) * acc[2], bfhi(gb.y) * acc[3]); o.z = pk2(bflo(gb.z) * acc[4], bfhi(gb.z) * acc[5]); o.w = pk2(bflo(gb.w) * acc[6], bfhi(gb.w) * acc[7]);
        *(uint4*)(p.Y() + row * D + ch) = o; }
}
namespace ml {
typedef short bf16x8 __attribute__((ext_vector_type(8)));
typedef short s16x4 __attribute__((ext_vector_type(4)));
typedef float f32x4 __attribute__((ext_vector_type(4)));
typedef float f32x2_t __attribute__((ext_vector_type(2)));
typedef __bf16 bf16x2_t __attribute__((ext_vector_type(2)));
typedef unsigned u32x4 __attribute__((ext_vector_type(4)));
typedef unsigned u32x2 __attribute__((ext_vector_type(2)));
constexpr unsigned IMG = 16384u, BUF = 3u * IMG, PT_OFF = 2u * BUF, PT_BYTES = 8192u, N_OFF = PT_OFF + 2u * PT_BYTES;
constexpr unsigned SCT_OFF = 149504u, SCT_BYTES = 1024u;
constexpr unsigned HT_OFF = 133120u;
static_assert(N_OFF + 1024u <= 131072u && HT_OFF + 16384u <= SCT_OFF && SCT_OFF + 3u * SCT_BYTES <= 163840u, "mLSTM LDS map");
__device__ __forceinline__ unsigned cvtpk(float lo, float hi) { f32x2_t v = {lo, hi}; bf16x2_t b = __builtin_convertvector(v, bf16x2_t); return __builtin_bit_cast(unsigned, b); }
__device__ __forceinline__ unsigned off_a(unsigned row, unsigned ch) { return 2048u * (row >> 3) + 512u * (ch >> 2) + 64u * (row & 7u) + 16u * ((ch & 3u) ^ ((row >> 2) & 3u)); }
__device__ __forceinline__ unsigned off_p(unsigned row, unsigned ch) { return 128u * row + 16u * (ch ^ (row & 7u)); }
typedef short v4i16_t __attribute__((ext_vector_type(4)));
__device__ __forceinline__ s16x4 trr(LAS unsigned char* p) { return __builtin_bit_cast(s16x4, __builtin_amdgcn_ds_read_tr16_b64_v4i16((LAS v4i16_t*)p)); }
__device__ __forceinline__ bf16x8 cat8(s16x4 a, s16x4 b) { return (bf16x8){a[0], a[1], a[2], a[3], b[0], b[1], b[2], b[3]}; }
struct CS { float decay, m_next; };
__device__ __forceinline__ CS chunk_scalars(float ig, float fg, float m, LAS float* tab, bool writer, unsigned lane) {
    const float lf = fg;
    const float bc = wave_scan_add(lf), gg = ig - bc, cm = wave_scan_max(gg);
    const float G = fmaxf(m, cm), G63 = lane_bcast(G, 63), b63 = lane_bcast(bc, 63), qs = 0.08838834764831845f;
    if (writer) { tab[lane] = __expf(fminf(G63 - G, 80.f)) * qs; tab[64 + lane] = __expf(m - G) * qs; tab[128 + lane] = __expf(-(bc + G)); tab[192 + lane] = __expf(gg - G63); }
    CS r; r.decay = __expf(m - G63); r.m_next = b63 + G63;
    return r;
}
__device__ __forceinline__ void unit(const Prm& p, const Frame& F, int u) {
    static_assert(QK == 128 && MV == 256 && CHUNK == 64 && S % 64 == 0, "mLSTM unit is specialised");
    const int vhalf = u & 1, h = (u >> 1) & 3, b = (u >> 3) & 7, dir = u >> 6;
    const unsigned lane = F.lane, tid = F.tid; const int wave = F.wave; const unsigned q = lane >> 4, r = lane & 15u;
    LAS unsigned char* L = F.lds;
    const unsigned rx = (r >> 2) & 3u, rlo = 2048u * (r >> 3) + 64u * (r & 7u);
    const unsigned RA = rlo + 16u * (q ^ rx), PB1 = rlo + 16u * ((q >> 1) ^ rx) + 8u * (q & 1u), PB2 = rlo + 16u * ((2u + (q >> 1)) ^ rx) + 8u * (q & 1u);
    const unsigned pp = lane & 3u, tlo = 2048u * q + 64u * rx + 8u * (pp & 1u);
    const unsigned tb00 = tlo + 16u * ((pp >> 1) ^ ((2u * q) & 3u)), tb01 = tlo + 256u + 16u * ((pp >> 1) ^ ((2u * q + 1u) & 3u));
    const unsigned tb10 = tlo + 16u * ((2u + (pp >> 1)) ^ ((2u * q) & 3u)), tb11 = tlo + 256u + 16u * ((2u + (pp >> 1)) ^ ((2u * q + 1u) & 3u));
    const unsigned PP0 = 128u * r + 16u * (q ^ (r & 7u)), PP1 = 128u * r + 16u * ((4u + q) ^ (r & 7u));
#define ML_TRA(c, ks, t) ((((c) & 1) ? ((t) ? tb11 : tb10) : ((t) ? tb01 : tb00)) + 8192u * (ks) + 512u * ((unsigned)(c) >> 1))
    __syncthreads();
    for (unsigned i = tid; i < (2u * PT_BYTES + 1024u) / 16u; i += NTHR) *(LAS u32x4*)(L + PT_OFF + 16u * i) = (u32x4){0u, 0u, 0u, 0u};
    f32x4 C[8];
#pragma unroll
    for (int i = 0; i < 8; ++i) C[i] = (f32x4){0.f, 0.f, 0.f, 0.f};
    float m = 0.f;
    const bf16_t* pj = p.PJ(); bf16_t* H = dir ? p.HB16() : p.HF16();
    const int colq = O_Q + h * QK, colk = O_K + h * QK, colv = O_V + h * MV + vhalf * 128;
    const unsigned srow0 = tid >> 4, sch = tid & 15u;
    u32x4 rq[2], rk[2], rv[2];
    const float* gbase = p.GATES() + dir * 8 + h;
#define ML_GATES(c, ig_, fg_) do { const float* g_ = gbase + (size_t)ml_tok(dir, b, (c) * 64 + (int)lane) * NG; ig_ = g_[0]; fg_ = g_[4]; } while (0)
    float ig0, fg0, ign = 0.f, fgn = 0.f; ML_GATES(0, ig0, fg0); if (S / 64 > 1) ML_GATES(1, ign, fgn);
#define ML_TAB(c) ((LAS float*)(L + SCT_OFF + (unsigned)((c) % 3) * SCT_BYTES))
    CS cs = chunk_scalars(ig0, fg0, m, ML_TAB(0), wave == 0, lane), csn = cs;
    const long sMW = dir ? -(long)MW : (long)MW;
#define ML_LOAD(c) do { _Pragma("unroll") for (int i_ = 0; i_ < 2; ++i_) { const bf16_t* rp = pj + (size_t)ml_tok(dir, b, (c) * 64 + srow0 + 32 * i_) * INM + 8 * sch; \
        rq[i_] = *(const u32x4*)(rp + colq); rk[i_] = *(const u32x4*)(rp + colk); rv[i_] = *(const u32x4*)(rp + colv); } } while (0)
#define ML_STORE(buf, S_) do { _Pragma("unroll") for (int i_ = 0; i_ < 2; ++i_) { const unsigned row = srow0 + 32u * i_, o = (buf) * BUF + off_a(row, sch); const float w = (S_)[192 + row]; \
        *(LAS u32x4*)(L + o) = rq[i_]; *(LAS u32x4*)(L + IMG + o) = rk[i_]; u32x4 v = rv[i_]; \
        v.x = cvtpk(bflo(v.x) * w, bfhi(v.x) * w); v.y = cvtpk(bflo(v.y) * w, bfhi(v.y) * w); v.z = cvtpk(bflo(v.z) * w, bfhi(v.z) * w); v.w = cvtpk(bflo(v.w) * w, bfhi(v.w) * w); \
        *(LAS u32x4*)(L + 2u * IMG + o) = v; } } while (0)
    __syncthreads();
    ML_LOAD(0); ML_STORE(0u, ML_TAB(0));
    constexpr int NC = S / 64;
    for (int c = 0; c < NC; ++c) {
        const unsigned cur = (unsigned)(c & 1);
        LAS unsigned char* Qi = L + cur * BUF; LAS unsigned char* Ki = Qi + IMG; LAS unsigned char* Vi = Qi + 2u * IMG; LAS unsigned char* Pt = L + PT_OFF + cur * PT_BYTES;
        float ig2 = 0.f, fg2 = 0.f;
        if (c + 1 < NC) { ML_LOAD(c + 1); csn = chunk_scalars(ign, fgn, cs.m_next, ML_TAB(c + 1), wave == 0, lane); if (c + 2 < NC) ML_GATES(c + 2, ig2, fg2); }
        __syncthreads();
#define ML_FLUSH(cprev) do { _Pragma("unroll") for (int i_ = 0; i_ < 2; ++i_) { const unsigned n_ = tid + 512u * i_, row_ = n_ >> 4, ch_ = n_ & 15u;     \
            const u32x4 v_ = *(const LAS u32x4*)(L + HT_OFF + 256u * row_ + 16u * (ch_ ^ (row_ & 15u))); \
            *(u32x4*)(H + (size_t)ml_tok(dir, b, (cprev) * 64 + (int)row_) * MW + h * MV + vhalf * 128 + 8 * (int)ch_) = v_; } } while (0)
        const LAS float* sct = ML_TAB(c);
        if (c > 0) ML_FLUSH(c - 1);
#ifndef ML_REP_3B
#define ML_REP_3B 1
#define ML_REP_S 1
#define ML_REP_ST 1
#define ML_REP_3A 1
#define ML_REP_DEN 1
#endif
        f32x4 acc2[4];
#pragma unroll
        for (int tt = 0; tt < 4; ++tt) acc2[tt] = (f32x4){0.f, 0.f, 0.f, 0.f};
#pragma unroll
        for (int ks = 0; ks < 4; ++ks) {
            bf16x8 qa[4];
#pragma unroll
            for (int tt = 0; tt < 4; ++tt) {
                const u32x2 lo = *(const LAS u32x2*)(Qi + PB1 + 4096u * tt + 512u * ks), hi = *(const LAS u32x2*)(Qi + PB2 + 4096u * tt + 512u * ks);
                const u32x4 aw = {lo.x, lo.y, hi.x, hi.y}; qa[tt] = __builtin_bit_cast(bf16x8, aw); }
            const f32x4 c0 = C[2 * ks], c1 = C[2 * ks + 1];
            const u32x4 bw = {cvtpk(c0[0], c0[1]), cvtpk(c0[2], c0[3]), cvtpk(c1[0], c1[1]), cvtpk(c1[2], c1[3])}; const bf16x8 bfr = __builtin_bit_cast(bf16x8, bw);
#pragma unroll
            for (int tt = 0; tt < 4; ++tt) acc2[tt] = __builtin_amdgcn_mfma_f32_16x16x32_bf16(qa[tt], bfr, acc2[tt], 0, 0, 0);
        }
        bf16x8 vB[2];
#pragma unroll
        for (int ks = 0; ks < 2; ++ks) vB[ks] = cat8(trr(Vi + ML_TRA(wave, ks, 0)), trr(Vi + ML_TRA(wave, ks, 1)));
#pragma unroll
        for (int dt = 0; dt < 8; ++dt) C[dt] = C[dt] * cs.decay;
#pragma unroll
        for (int ks = 0; ks < 2; ++ks)
#pragma unroll
            for (int dh = 0; dh < 2; ++dh) { bf16x8 kA[4];
#pragma unroll
                for (int d4 = 0; d4 < 4; ++d4) kA[d4] = cat8(trr(Ki + ML_TRA(4 * dh + d4, ks, 0)), trr(Ki + ML_TRA(4 * dh + d4, ks, 1)));
#pragma unroll
                for (int d4 = 0; d4 < 4; ++d4) C[4 * dh + d4] = __builtin_amdgcn_mfma_f32_16x16x32_bf16(kA[d4], vB[ks], C[4 * dh + d4], 0, 0, 0); }
#pragma unroll
        for (int rep = 0; rep < 2; ++rep) { const int idx = wave + (rep ? 2 : 0);
            if (rep == 0 || wave >= 6) { const int tt = idx >= 6 ? 3 : (idx >= 3 ? 2 : (idx >= 1 ? 1 : 0)), st = idx - tt * (tt + 1) / 2;
                f32x4 sa = (f32x4){0.f, 0.f, 0.f, 0.f};
#pragma unroll
                for (int kh = 0; kh < 2; ++kh) { bf16x8 af[2], bfk[2];
#pragma unroll
                    for (int k2 = 0; k2 < 2; ++k2) { af[k2] = *(const LAS bf16x8*)(Qi + RA + 4096u * tt + 512u * (2 * kh + k2)); bfk[k2] = *(const LAS bf16x8*)(Ki + RA + 4096u * st + 512u * (2 * kh + k2)); }
#pragma unroll
                    for (int k2 = 0; k2 < 2; ++k2) sa = __builtin_amdgcn_mfma_f32_16x16x32_bf16(af[k2], bfk[k2], sa, 0, 0, 0); }
                const unsigned scol = 16u * st + r;
#pragma unroll
                for (int i = 0; i < 4; ++i) { const unsigned trow = 16u * tt + 4u * q + i; const float v = scol <= trow ? sa[i] : 0.f;
                    *(LAS bf16_t*)(Pt + off_p(trow, scol >> 3) + 2u * (scol & 7u)) = (bf16_t)cvtpk(v, 0.f); } } }
        if (c + 1 < NC) ML_STORE(cur ^ 1u, ML_TAB(c + 1));
        __syncthreads();
        { bf16x8 pf[6];
#pragma unroll
          for (int tt = 0; tt < 4; ++tt) { pf[tt] = *(const LAS bf16x8*)(Pt + PP0 + 2048u * tt); if (tt >= 2) pf[2 + tt] = *(const LAS bf16x8*)(Pt + PP1 + 2048u * tt); }
#pragma unroll
          for (int tt = 0; tt < 4; ++tt) { const f32x4 av4 = *(const LAS f32x4*)(sct + 16 * tt + 4 * q), bv4 = *(const LAS f32x4*)(sct + 64 + 16 * tt + 4 * q); f32x4 a1 = __builtin_amdgcn_mfma_f32_16x16x32_bf16(pf[tt], vB[0], (f32x4){0.f, 0.f, 0.f, 0.f}, 0, 0, 0);
            if (tt >= 2) a1 = __builtin_amdgcn_mfma_f32_16x16x32_bf16(pf[2 + tt], vB[1], a1, 0, 0, 0);
#pragma unroll
            for (int i = 0; i < 4; ++i) { const unsigned t = 16u * tt + 4u * q + i, col = 16u * (unsigned)wave + r;
                *(LAS bf16_t*)(L + HT_OFF + 256u * t + 16u * ((col >> 3) ^ (t & 15u)) + 2u * (col & 7u)) = (bf16_t)cvtpk(av4[i] * a1[i] + bv4[i] * acc2[tt][i], 0.f); } } }
        if (vhalf == 0) {
            const LAS float* n_old = (const LAS float*)(L + N_OFF + cur * 512u); LAS float* n_new = (LAS float*)(L + N_OFF + (cur ^ 1u) * 512u);
            bf16x8 wB[2];
#pragma unroll
            for (int ks = 0; ks < 2; ++ks) { const f32x4 w0 = *(const LAS f32x4*)(sct + 192 + 32 * ks + 8 * q), w1 = *(const LAS f32x4*)(sct + 192 + 32 * ks + 8 * q + 4);
                u32x4 w = {cvtpk(w0[0], w0[1]), cvtpk(w0[2], w0[3]), cvtpk(w1[0], w1[1]), cvtpk(w1[2], w1[3])};
                if (r != 0u) w = (u32x4){0u, 0u, 0u, 0u}; wB[ks] = __builtin_bit_cast(bf16x8, w); }
            const size_t dbase = ((size_t)dir * T) * MH + h;
            if (wave < 4) { const int tt = wave; f32x4 d2 = (f32x4){0.f, 0.f, 0.f, 0.f};
#pragma unroll
                for (int ks = 0; ks < 4; ++ks) { const f32x4 n0 = *(const LAS f32x4*)(n_old + 32 * ks + 4 * q), n1 = *(const LAS f32x4*)(n_old + 32 * ks + 16 + 4 * q);
                    u32x4 bw = {cvtpk(n0[0], n0[1]), cvtpk(n0[2], n0[3]), cvtpk(n1[0], n1[1]), cvtpk(n1[2], n1[3])}; if (r != 0u) bw = (u32x4){0u, 0u, 0u, 0u};
                    const u32x2 lo = *(const LAS u32x2*)(Qi + PB1 + 4096u * tt + 512u * ks), hi = *(const LAS u32x2*)(Qi + PB2 + 4096u * tt + 512u * ks);
                    const u32x4 aw = {lo.x, lo.y, hi.x, hi.y};
                    d2 = __builtin_amdgcn_mfma_f32_16x16x32_bf16(__builtin_bit_cast(bf16x8, aw), __builtin_bit_cast(bf16x8, bw), d2, 0, 0, 0); }
#pragma unroll
                for (int i = 0; i < 4; ++i) { const int t = 16 * tt + 4 * (int)q + i; const float bv = sct[64 + t], fl = sct[128 + t];
                    if (r == 0u) { const size_t di = dbase + (size_t)ml_tok(dir, b, c * 64 + t) * MH; p.DEN()[(size_t)2 * T * MH + di] = bv * d2[i]; p.FLR()[di] = fl; } }
            } else { const int tt = wave - 4; f32x4 d1 = (f32x4){0.f, 0.f, 0.f, 0.f};
#pragma unroll
                for (int ks = 0; ks < 2; ++ks) if (ks == 0 || tt >= 2) { const bf16x8 pf = *(const LAS bf16x8*)(Pt + (ks ? PP1 : PP0) + 2048u * tt);
                    d1 = __builtin_amdgcn_mfma_f32_16x16x32_bf16(pf, wB[ks], d1, 0, 0, 0); }
#pragma unroll
                for (int i = 0; i < 4; ++i) { const int t = 16 * tt + 4 * (int)q + i; const float av = sct[t];
                    if (r == 0u) p.DEN()[dbase + (size_t)ml_tok(dir, b, c * 64 + t) * MH] = av * d1[i]; } }
            { const int dt = wave; f32x4 nn = *(const LAS f32x4*)(n_old + 16 * dt + 4 * q) * cs.decay; if (r != 0u) nn = (f32x4){0.f, 0.f, 0.f, 0.f};
#pragma unroll
                for (int ks = 0; ks < 2; ++ks) { const bf16x8 kA = cat8(trr(Ki + ML_TRA(dt, ks, 0)), trr(Ki + ML_TRA(dt, ks, 1)));
                    nn = __builtin_amdgcn_mfma_f32_16x16x32_bf16(kA, wB[ks], nn, 0, 0, 0); }
                if (r == 0u) *(LAS f32x4*)(n_new + 16 * dt + 4 * q) = nn; }
        }
        m = cs.m_next; cs = csn; ign = ig2; fgn = fg2;
    }
    __syncthreads(); ML_FLUSH(NC - 1);
#undef ML_FLUSH
#undef ML_TRA
#undef ML_TABLE
#undef ML_LOAD
#undef ML_GATES
#undef ML_STORE
}
}
__device__ __forceinline__ void phase4(const Prm& p, const Frame& F) {
    static_assert(MV == 256 && MH == 4, "head j = float4 slot j of the lane");
    const int gw = F.bid * NWAVES + F.wave, NGW = F.G * NWAVES;
    for (int row = gw; row < T; row += NGW) {
        const uint2* hf = (const uint2*)(p.HF16() + (size_t)row * MW) + F.lane; const uint2* hb = (const uint2*)(p.HB16() + (size_t)row * MW) + F.lane;
        const uint2* og = (const uint2*)(p.PJ() + (size_t)row * INM + O_O) + F.lane; uint2* yo = (uint2*)(p.Y() + (size_t)row * D + CW) + F.lane;
#pragma unroll
        for (int j = 0; j < MH; ++j) {
            const float* d2 = p.DEN() + (size_t)2 * T * MH;
            const float i_f = 1.f / fmaxf(fabsf(p.DEN()[(size_t)row * MH + j] + d2[(size_t)row * MH + j]), p.FLR()[(size_t)row * MH + j]);
            const float i_b = 1.f / fmaxf(fabsf(p.DEN()[((size_t)T + row) * MH + j] + d2[((size_t)T + row) * MH + j]), p.FLR()[((size_t)T + row) * MH + j]);
            const uint2 a = hf[64 * j], b = hb[64 * j]; float4 h = make_float4(bflo(a.x) * i_f + bflo(b.x) * i_b, bfhi(a.x) * i_f + bfhi(b.x) * i_b, bflo(a.y) * i_f + bflo(b.y) * i_b, bfhi(a.y) * i_f + bfhi(b.y) * i_b);
            const float mean = wave_sum((h.x + h.y) + (h.z + h.w)) * (1.f / MV);
            h.x -= mean; h.y -= mean; h.z -= mean; h.w -= mean;
            const float rstd = 1.f / sqrtf(wave_sum((h.x * h.x + h.y * h.y) + (h.z * h.z + h.w * h.w)) * (1.f / MV) + LN_EPS);
            const float4 nw = *((const float4*)(p.mnorm_w + j * MV) + F.lane); const uint2 o = og[64 * j];
            yo[64 * j] = make_uint2(pk2(h.x * rstd * nw.x * sigmoidf_(bflo(o.x)), h.y * rstd * nw.y * sigmoidf_(bfhi(o.x))), pk2(h.z * rstd * nw.z * sigmoidf_(bflo(o.y)), h.w * rstd * nw.w * sigmoidf_(bfhi(o.y)))); }
    }
}
struct EpiZ {
    static constexpr bool PERM = false, AFTER_DRAIN = false;
    const float* x; const float* mod; bf16_t* out;
    __device__ __forceinline__ void operator()(const pg8::f32x4 (&acc)[2][2][4][2], const pg8::Unit& u, int wr, int wc, int fr, int fq) const {
        const int col0 = u.pn * 256 + wc * 32 + 4 * fq;
#pragma unroll
        for (int ai = 0; ai < 2; ++ai)
#pragma unroll
            for (int m = 0; m < 4; ++m) { const int row = u.pm * 256 + ai * 128 + wr * 64 + m * 16 + fr; const float* g1 = mod + (size_t)(row / S) * D6 + 2 * D; const size_t off = (size_t)row * D + col0;
#pragma unroll
                for (int bj = 0; bj < 2; ++bj)
#pragma unroll
                    for (int n = 0; n < 2; ++n) { const int c = bj * 128 + n * 16; const pg8::f32x4 xv = *(const pg8::f32x4*)(x + off + c), gv = *(const pg8::f32x4*)(g1 + col0 + c);
                        const pg8::f32x4 z = xv * ALPHA + gv * acc[ai][bj][m][n]; *(uint2*)(out + off + c) = make_uint2(pk2(z[0], z[1]), pk2(z[2], z[3])); } }
    }
};

struct EpiF32 {
    static constexpr bool PERM = false, AFTER_DRAIN = false;
    float* out; int ldc;
    __device__ __forceinline__ void operator()(const pg8::f32x4 (&acc)[2][2][4][2], const pg8::Unit& u, int wr, int wc, int fr, int fq) const {
        const int col0 = u.pn * 256 + wc * 32 + 4 * fq;
#pragma unroll
        for (int ai = 0; ai < 2; ++ai)
#pragma unroll
            for (int m = 0; m < 4; ++m) { float* rowp = out + (size_t)(u.pm * 256 + ai * 128 + wr * 64 + m * 16 + fr) * ldc + col0;
#pragma unroll
                for (int bj = 0; bj < 2; ++bj)
#pragma unroll
                    for (int n = 0; n < 2; ++n) *(pg8::f32x4*)(rowp + bj * 128 + n * 16) = acc[ai][bj][m][n]; }
    }
};
__device__ __forceinline__ unsigned skey(float f) { const unsigned u = f_as_u(f); return (u & 0x80000000u) ? ~u : (u | 0x80000000u); }
__device__ __forceinline__ float unskey(unsigned k) { return u_as_f((k & 0x80000000u) ? (k & 0x7fffffffu) : ~k); }
__device__ __forceinline__ void tk_insert(unsigned (&L)[16], unsigned k) {
    if (k > L[15]) { L[15] = k;
#pragma unroll
        for (int i = 14; i >= 0; --i) { const unsigned hi = L[i] > L[i + 1] ? L[i] : L[i + 1], lo = L[i] > L[i + 1] ? L[i + 1] : L[i]; L[i] = hi; L[i + 1] = lo; } }
}
__device__ __forceinline__ void tk_top16(const float* sc, unsigned (&L)[16]) {
#pragma unroll
    for (int i = 0; i < 16; ++i) L[i] = 0u;
#pragma unroll 2
    for (int n4 = 0; n4 < NK / 4; ++n4) { const float4 v = ((const float4*)sc)[n4]; const unsigned b = 127u - 4u * n4;
        tk_insert(L, (skey(v.x) & ~0x7fu) | b); tk_insert(L, (skey(v.y) & ~0x7fu) | (b - 1)); tk_insert(L, (skey(v.z) & ~0x7fu) | (b - 2)); tk_insert(L, (skey(v.w) & ~0x7fu) | (b - 3)); }
}
__device__ __forceinline__ void phase8(const Prm& p, const Frame& F) {
    static_assert(NK == 128 && TOPK == 16, "top-k phase is specialised");
    const long gt = (long)F.bid * NTHR + F.tid, GT = (long)F.G * NTHR;
    for (long i = gt; i < (long)T * PH; i += GT) {
        unsigned A[16], B[16];
        tk_top16(p.SC() + (size_t)i * 2 * NK, A); tk_top16(p.SC() + (size_t)i * 2 * NK + NK, B);
        float V[16]; int E[16];
#pragma unroll
        for (int r = 0; r < 16; ++r) { V[r] = -INFINITY; E[r] = 0; }
#pragma unroll
        for (int a = 0; a < 16; ++a)
#pragma unroll
            for (int b = 0; b < 16; ++b) if ((a + 1) * (b + 1) <= 16) {
                const float v = unskey(A[a] & ~0x7fu) + unskey(B[b] & ~0x7fu); const int e = (int)((127u - (A[a] & 0x7fu)) * NK + (127u - (B[b] & 0x7fu)));
                if (v > V[15]) { V[15] = v; E[15] = e;
#pragma unroll
                    for (int r = 14; r >= 0; --r) { const bool sw = V[r + 1] > V[r]; const float vh = sw ? V[r + 1] : V[r], vl = sw ? V[r] : V[r + 1]; const int eh = sw ? E[r + 1] : E[r], el = sw ? E[r] : E[r + 1];
                        V[r] = vh; V[r + 1] = vl; E[r] = eh; E[r + 1] = el; } } }
        float sum = 0.f; const float vmax = V[0];
#pragma unroll
        for (int r = 0; r < 16; ++r) { V[r] = __expf(V[r] - vmax); sum += V[r]; }
        const float inv = 1.f / sum;
#pragma unroll
        for (int r = 0; r < 16; r += 4) { *(int4*)(p.EIDX() + (size_t)i * TOPK + r) = make_int4(E[r], E[r + 1], E[r + 2], E[r + 3]);
            *(float4*)(p.EW() + (size_t)i * TOPK + r) = make_float4(V[r] * inv, V[r + 1] * inv, V[r + 2] * inv, V[r + 3] * inv); }
    }
}
__device__ __forceinline__ void phase6(const Prm& p, const Frame& F) {
    const int gw = F.bid * NWAVES + F.wave, NGW = F.G * NWAVES;
    float4 v[8]; uint2 zb[8], zn[8];
    if (gw < T) { const uint2* z0 = (const uint2*)((const bf16_t*)p.out + (size_t)gw * D) + F.lane;
#pragma unroll
        for (int j = 0; j < 8; ++j) zb[j] = z0[64 * j]; }
    for (int row = gw; row < T; row += NGW) {
        uint2* x1r = (uint2*)(p.X1B() + (size_t)row * D) + F.lane; const float* mod = p.MOD() + (size_t)(row / S) * D6;
        float s = 0.f;
        if (row + NGW < T) { const uint2* zp = (const uint2*)((const bf16_t*)p.out + (size_t)(row + NGW) * D) + F.lane;
#pragma unroll
            for (int j = 0; j < 8; ++j) zn[j] = zp[64 * j]; }
#pragma unroll
        for (int j = 0; j < 8; ++j) { v[j] = make_float4(bflo(zb[j].x), bfhi(zb[j].x), bflo(zb[j].y), bfhi(zb[j].y)); s += (v[j].x + v[j].y) + (v[j].z + v[j].w); }
        float mean = wave_sum(s) * (1.f / D), s2 = 0.f;
#pragma unroll
        for (int j = 0; j < 8; ++j) { v[j].x -= mean; v[j].y -= mean; v[j].z -= mean; v[j].w -= mean; s2 += (v[j].x * v[j].x + v[j].y * v[j].y) + (v[j].z * v[j].z + v[j].w * v[j].w); }
        float rstd = 1.f / sqrtf(wave_sum(s2) * (1.f / D) + LN_EPS); s = 0.f;
#pragma unroll
        for (int j = 0; j < 8; ++j) { const float4 w = *((const float4*)p.ln1_w + F.lane + 64 * j), bb = *((const float4*)p.ln1_b + F.lane + 64 * j);
            v[j].x = v[j].x * rstd * w.x + bb.x; v[j].y = v[j].y * rstd * w.y + bb.y; v[j].z = v[j].z * rstd * w.z + bb.z; v[j].w = v[j].w * rstd * w.w + bb.w;
            x1r[64 * j] = make_uint2(pk2(v[j].x, v[j].y), pk2(v[j].z, v[j].w)); s += (v[j].x + v[j].y) + (v[j].z + v[j].w); }
        mean = wave_sum(s) * (1.f / D); s2 = 0.f;
#pragma unroll
        for (int j = 0; j < 8; ++j) { v[j].x -= mean; v[j].y -= mean; v[j].z -= mean; v[j].w -= mean; s2 += (v[j].x * v[j].x + v[j].y * v[j].y) + (v[j].z * v[j].z + v[j].w * v[j].w); }
        rstd = 1.f / sqrtf(wave_sum(s2) * (1.f / D) + LN_EPS);
        uint2* o8 = (uint2*)(p.U() + (size_t)row * D) + F.lane;
#pragma unroll
        for (int j = 0; j < 8; ++j) { const float4 sh = *((const float4*)(mod + 3 * D) + F.lane + 64 * j), sc = *((const float4*)(mod + 4 * D) + F.lane + 64 * j);
            o8[64 * j] = make_uint2(pk2(v[j].x * rstd * (1.f + sc.x) + sh.x, v[j].y * rstd * (1.f + sc.y) + sh.y), pk2(v[j].z * rstd * (1.f + sc.z) + sh.z, v[j].w * rstd * (1.f + sc.w) + sh.w)); }
#pragma unroll
        for (int j = 0; j < 8; ++j) zb[j] = zn[j];
    }
}
struct XW { int vx, nx, rank, nloc; };
constexpr int NDS = 16, DSW = D / NDS;
typedef float f2v __attribute__((ext_vector_type(2)));
struct Row8 { uint4 r[8]; };
__device__ __forceinline__ void gather8(Row8& g, const unsigned char* tbu, unsigned loff, int ereg, int pg) {
#pragma unroll
    for (int k = 0; k < 8; ++k) { const unsigned e = (unsigned)__shfl(ereg, 8 * k + pg); g.r[k] = *(const uint4*)(tbu + (((size_t)e << 11) | loff)); }
}
#define PEER_CVT8(a) const f2v c0 = __builtin_amdgcn_cvt_pk_f32_fp8((a).x, false), c1 = __builtin_amdgcn_cvt_pk_f32_fp8((a).x, true), c2 = __builtin_amdgcn_cvt_pk_f32_fp8((a).y, false), c3 = __builtin_amdgcn_cvt_pk_f32_fp8((a).y, true), \
    c4 = __builtin_amdgcn_cvt_pk_f32_fp8((a).z, false), c5 = __builtin_amdgcn_cvt_pk_f32_fp8((a).z, true), c6 = __builtin_amdgcn_cvt_pk_f32_fp8((a).w, false), c7 = __builtin_amdgcn_cvt_pk_f32_fp8((a).w, true)
typedef _Float16 h2t __attribute__((ext_vector_type(2)));
__device__ __forceinline__ float peer_dot16h(const uint4 a, const h2t* u) {
    float acc = __builtin_amdgcn_fdot2(__builtin_amdgcn_cvt_scalef32_pk_f16_fp8(a.x, 1.0f, false), u[0], 0.f, false);
    acc = __builtin_amdgcn_fdot2(__builtin_amdgcn_cvt_scalef32_pk_f16_fp8(a.x, 1.0f, true), u[1], acc, false);
    acc = __builtin_amdgcn_fdot2(__builtin_amdgcn_cvt_scalef32_pk_f16_fp8(a.y, 1.0f, false), u[2], acc, false);
    acc = __builtin_amdgcn_fdot2(__builtin_amdgcn_cvt_scalef32_pk_f16_fp8(a.y, 1.0f, true), u[3], acc, false);
    acc = __builtin_amdgcn_fdot2(__builtin_amdgcn_cvt_scalef32_pk_f16_fp8(a.z, 1.0f, false), u[4], acc, false);
    acc = __builtin_amdgcn_fdot2(__builtin_amdgcn_cvt_scalef32_pk_f16_fp8(a.z, 1.0f, true), u[5], acc, false);
    acc = __builtin_amdgcn_fdot2(__builtin_amdgcn_cvt_scalef32_pk_f16_fp8(a.w, 1.0f, false), u[6], acc, false);
    acc = __builtin_amdgcn_fdot2(__builtin_amdgcn_cvt_scalef32_pk_f16_fp8(a.w, 1.0f, true), u[7], acc, false);
    return acc;
}
__device__ __forceinline__ f2v rscatter16(const float* v, bool b0, bool b1, bool b2, int m0, int m1, int m2) {
    float r8[8], r4[4]; f2v r2;
#pragma unroll
    for (int i = 0; i < 8; ++i) { const float keep = b0 ? v[8 + i] : v[i], send = b0 ? v[i] : v[8 + i]; r8[i] = keep + __shfl_xor(send, m0); }
#pragma unroll
    for (int i = 0; i < 4; ++i) { const float keep = b1 ? r8[4 + i] : r8[i], send = b1 ? r8[i] : r8[4 + i]; r4[i] = keep + __shfl_xor(send, m1); }
    { const float k0 = b2 ? r4[2] : r4[0], s0 = b2 ? r4[0] : r4[2], k1 = b2 ? r4[3] : r4[1], s1 = b2 ? r4[1] : r4[3]; r2.x = k0 + __shfl_xor(s0, m2); r2.y = k1 + __shfl_xor(s1, m2); }
    return r2;
}
__device__ __forceinline__ void phase9(const Prm& p, const Frame& F, const XW& xw) {
    static_assert(DSW == 128 && NSLOT == 128 && D == 2048, "slice row = 8 lanes x 16 bytes");
    const int pg = F.lane >> 3, part = F.lane & 7; const bool p0 = part & 1, p1 = part & 2, p2 = part & 4;
    const int tstep = xw.nloc * NWAVES, t0 = xw.rank * NWAVES + F.wave; const int nt = t0 < T ? (T - t0 + tstep - 1) / tstep : 0;
    const unsigned loff = (unsigned)part * 16u; const int k0 = (p0 ? 8 : 0) + (p1 ? 4 : 0) + (p2 ? 2 : 0);
    for (int ds = xw.vx; ds < NDS; ds += xw.nx) {
        if (nt == 0) continue;
        const unsigned char* tbu = p.PU8() + ds * DSW; _Float16* part_out = (_Float16*)p.SC() + (size_t)ds * T * NSLOT + pg + 8 * k0;
#define UP_TOK(i) (t0 + ((i) < nt ? (i) : nt - 1) * tstep)
#define UP_LOADE(i, ea, eb) do { const int* ep_ = p.EIDX() + (size_t)UP_TOK(i) * NSLOT + F.lane; ea = ep_[0]; eb = ep_[64]; } while (0)
#define UP_LOADU(i, ua_, ub_) do { const uint4* up_ = (const uint4*)(p.U() + (size_t)UP_TOK(i) * D + ds * DSW + part * 16); ua_ = up_[0]; ub_ = up_[1]; } while (0)
        int e0a, e0b, e1a, e1b, e2a, e2b; uint4 ua, ub, una, unb;
        UP_LOADE(0, e0a, e0b); UP_LOADE(1, e1a, e1b); UP_LOADE(2, e2a, e2b); UP_LOADU(0, ua, ub);
        Row8 G0, G1, G2, G3;
        gather8(G0, tbu, loff, e0a, pg); gather8(G1, tbu, loff, e0b, pg); gather8(G2, tbu, loff, e1a, pg);
#define UP_BODY(i, GA, GB, GC, GD) do { \
            gather8(GD, tbu, loff, e1b, pg); UP_LOADU((i) + 1, una, unb); int e3a, e3b; UP_LOADE((i) + 3, e3a, e3b); \
            h2t u[8]; u[0] = (h2t){(_Float16)bflo(ua.x), (_Float16)bfhi(ua.x)}; u[1] = (h2t){(_Float16)bflo(ua.y), (_Float16)bfhi(ua.y)}; u[2] = (h2t){(_Float16)bflo(ua.z), (_Float16)bfhi(ua.z)}; u[3] = (h2t){(_Float16)bflo(ua.w), (_Float16)bfhi(ua.w)}; \
            u[4] = (h2t){(_Float16)bflo(ub.x), (_Float16)bfhi(ub.x)}; u[5] = (h2t){(_Float16)bflo(ub.y), (_Float16)bfhi(ub.y)}; u[6] = (h2t){(_Float16)bflo(ub.z), (_Float16)bfhi(ub.z)}; u[7] = (h2t){(_Float16)bflo(ub.w), (_Float16)bfhi(ub.w)}; \
            float dv[16]; \
            _Pragma("unroll") for (int k = 0; k < 8; ++k) dv[k] = peer_dot16h(GA.r[k], u); \
            gather8(GA, tbu, loff, e2a, pg); \
            _Pragma("unroll") for (int k = 0; k < 8; ++k) dv[8 + k] = peer_dot16h(GB.r[k], u); \
            const f2v r2 = rscatter16(dv, p0, p1, p2, 1, 2, 4);                          \
            if ((i) < nt) { _Float16* po = part_out + (size_t)UP_TOK(i) * NSLOT; po[0] = (_Float16)(r2.x * 0.0625f); po[8] = (_Float16)(r2.y * 0.0625f); } \
            e1a = e2a; e1b = e2b; e2a = e3a; e2b = e3b; ua = una; ub = unb; } while (0)
        for (int i = 0; i < nt; i += 2) { UP_BODY(i, G0, G1, G2, G3); UP_BODY(i + 1, G2, G3, G0, G1); }
#undef UP_BODY
#undef UP_LOADU
#undef UP_LOADE
#undef UP_TOK
    }
}
__device__ __forceinline__ void phase10(const Prm& p, const Frame& F) {
    static_assert(NE <= 16384 && NSLOT == 128 && T % 64 == 0, "14-bit expert id, 64-token groups");
    LAS unsigned* tile = (LAS unsigned*)F.lds;
    for (int tg = F.bid; tg < T / 64; tg += F.G) {
        __syncthreads();
#pragma unroll 4
        for (int k = 0; k < 16; ++k) { const int idx = F.tid + NTHR * k, tl = idx >> 7, sl = idx & 127; const size_t i = ((size_t)tg * 64 + tl) * NSLOT + sl; float s = 0.f;
#pragma unroll
            for (int ds = 0; ds < NDS; ++ds) s += (float)((const _Float16*)p.SC())[(size_t)ds * T * NSLOT + i];
            s *= 16.f;
            const int e = p.EIDX()[i]; const _Float16 w = (_Float16)(p.EW()[i] * gelu_exact(s * p.RSU()[e]) * p.RSV()[e] * 256.f);
            tile[tl * 129 + sl] = (((unsigned)__builtin_bit_cast(unsigned short, w) << 16) & 0xFFFE0000u) | ((unsigned)e << 3); }
        __syncthreads();
        uint4* pk = (uint4*)p.EW() + (size_t)tg * 64 * (NSLOT / 4);
#pragma unroll
        for (int k = 0; k < 4; ++k) { const int j = F.tid + NTHR * k, sq = j >> 6, tl = j & 63; const LAS unsigned* tp = tile + tl * 129 + 4 * sq; pk[j] = make_uint4(tp[0], tp[1], tp[2], tp[3]); }
    }
}
__device__ __forceinline__ void phase11(const Prm& p, const Frame& F) {
    static_assert(NE * 8 <= RING_BYTES && D % 8 == 0 && NE <= 65536, "table slice fits the LDS ring");
    typedef _Float16 h2v __attribute__((ext_vector_type(2)));
    const int c0 = (F.G % 8 == 0) ? (F.bid % 8) * (F.G / 8) + F.bid / 8 : F.bid;
    for (int sidx = c0; sidx < D / 8; sidx += F.G) {
        __syncthreads();
        { const uint4* src = (const uint4*)(p.PV8S() + (size_t)sidx * NE * 8);
          for (int i = F.tid; i < NE / 2; i += NTHR) *(LAS u32x4_t*)(F.lds + 16 * i) = __builtin_bit_cast(u32x4_t, src[i]); }
        __syncthreads();
        const int ntg = (T / 64 - F.wave + NWAVES - 1) / NWAVES, nb = 8 * ntg;
        uint4 b0[4], b1[4], b2[4], b3[4];
        const int kx = (F.G % 8 == 0) ? F.bid >> 3 : F.bid, rot = kx & 3, rotb = (kx >> 2) & 7;
#define DN_TG(bi) (F.wave + ((((bi) >> 3) + rot) % ntg) * NWAVES)
#define DN_PTR(bi) ((const uint4*)p.EW() + (size_t)DN_TG(bi) * 64 * (NSLOT / 4) + ((((bi) & 7) + rotb) & 7) * 4 * 64 + F.lane)
#define DN_LOAD(B, bi) do { const int bc_ = (bi) < nb ? (bi) : nb - 1; const uint4* pk_ = DN_PTR(bc_); _Pragma("unroll") for (int k = 0; k < 4; ++k) B[k] = pk_[k * 64]; } while (0)
#define DN_ONE(v_) do { const unsigned vv_ = (v_); const _Float16 w = __builtin_bit_cast(_Float16, (unsigned short)(vv_ >> 16)); const h2v w2 = {w, w}; \
                const u2v t = *(const LAS u2v*)(F.lds + (vv_ & 0x1FFF8u)); const unsigned tx_ = t.x, ty_ = t.y; \
                a0 += __builtin_amdgcn_cvt_scalef32_pk_f16_fp8(tx_, 1.0f, false) * w2; a1 += __builtin_amdgcn_cvt_scalef32_pk_f16_fp8(tx_, 1.0f, true) * w2; \
                a2 += __builtin_amdgcn_cvt_scalef32_pk_f16_fp8(ty_, 1.0f, false) * w2; a3 += __builtin_amdgcn_cvt_scalef32_pk_f16_fp8(ty_, 1.0f, true) * w2; } while (0)
#ifndef DN_REP
#define DN_REP 0
#endif
#define DN_ACC(B) do { _Pragma("unroll") for (int k = 0; k < 4; ++k) { DN_ONE(B[k].x); DN_ONE(B[k].y); DN_ONE(B[k].z); DN_ONE(B[k].w); } asm volatile("" ::: "memory"); \
            if (DN_REP) { const h2v s0_ = a0, s1_ = a1, s2_ = a2, s3_ = a3; for (int rep_ = 0; rep_ < DN_REP; ++rep_) { _Pragma("unroll") for (int k = 0; k < 4; ++k) { DN_ONE(B[k].x); DN_ONE(B[k].y); DN_ONE(B[k].z); DN_ONE(B[k].w); } \
                asm volatile("" :: "v"(a0), "v"(a1), "v"(a2), "v"(a3) : "memory"); } a0 = s0_; a1 = s1_; a2 = s2_; a3 = s3_; } } while (0)
        DN_LOAD(b0, 0); DN_LOAD(b1, 1); DN_LOAD(b2, 2);
        for (int bi = 0; bi < nb; bi += 8) {
            h2v a0 = {0, 0}, a1 = {0, 0}, a2 = {0, 0}, a3 = {0, 0};
            DN_LOAD(b3, bi + 3); DN_ACC(b0);
            DN_LOAD(b0, bi + 4); DN_ACC(b1);
            DN_LOAD(b1, bi + 5); DN_ACC(b2);
            DN_LOAD(b2, bi + 6); DN_ACC(b3);
            DN_LOAD(b3, bi + 7); DN_ACC(b0);
            DN_LOAD(b0, bi + 8); DN_ACC(b1);
            DN_LOAD(b1, bi + 9); DN_ACC(b2);
            DN_LOAD(b2, bi + 10); DN_ACC(b3);
            const int tg = DN_TG(bi); const float us = 1.f / 256.f;
            const uint4 yv = make_uint4(pk2((float)a0[0] * us, (float)a0[1] * us), pk2((float)a1[0] * us, (float)a1[1] * us), pk2((float)a2[0] * us, (float)a2[1] * us), pk2((float)a3[0] * us, (float)a3[1] * us));
            *(uint4*)(p.Y() + ((size_t)tg * 64 + F.lane) * D + 8 * sidx) = yv;
#if defined(DN_STORE_REP)
            for (int rep_ = 0; rep_ < DN_STORE_REP; ++rep_) { asm volatile("" ::: "memory"); __builtin_nontemporal_store(__builtin_bit_cast(u32x4_t, yv), (u32x4_t*)(p.Y() + ((size_t)tg * 64 + F.lane) * D + 8 * sidx)); }
#endif
        }
#undef DN_ACC
#undef DN_ONE
#undef DN_LOAD
#undef DN_PTR
#undef DN_TG
    }
}
__device__ __forceinline__ void phase12(const Prm& p, const Frame& F) {
    const int gw = F.bid * NWAVES + F.wave, NGW = F.G * NWAVES;
    float4 v[8]; uint2 xb[8], xn[8];
    if (gw < T) { const uint2* xr = (const uint2*)(p.X1B() + (size_t)gw * D) + F.lane;
#pragma unroll
        for (int j = 0; j < 8; ++j) xb[j] = xr[64 * j]; }
    for (int row = gw; row < T; row += NGW) {
        float4* zr = (float4*)(p.out + (size_t)row * D) + F.lane; float s = 0.f;
        if (row + NGW < T) { const uint2* xp = (const uint2*)(p.X1B() + (size_t)(row + NGW) * D) + F.lane;
#pragma unroll
            for (int j = 0; j < 8; ++j) xn[j] = xp[64 * j]; }
        const float* g2 = p.MOD() + (size_t)(row / S) * D6 + 5 * D;
#pragma unroll
        for (int j = 0; j < 8; ++j) { const uint2 y = *((const uint2*)(p.Y() + (size_t)row * D) + F.lane + 64 * j); const float4 g = *((const float4*)g2 + F.lane + 64 * j);
            v[j].x = ALPHA * bflo(xb[j].x) + g.x * bflo(y.x); v[j].y = ALPHA * bfhi(xb[j].x) + g.y * bfhi(y.x); v[j].z = ALPHA * bflo(xb[j].y) + g.z * bflo(y.y); v[j].w = ALPHA * bfhi(xb[j].y) + g.w * bfhi(y.y);
            s += (v[j].x + v[j].y) + (v[j].z + v[j].w); }
        const float mean = wave_sum(s) * (1.f / D); float s2 = 0.f;
#pragma unroll
        for (int j = 0; j < 8; ++j) { v[j].x -= mean; v[j].y -= mean; v[j].z -= mean; v[j].w -= mean; s2 += (v[j].x * v[j].x + v[j].y * v[j].y) + (v[j].z * v[j].z + v[j].w * v[j].w); }
        const float rstd = 1.f / sqrtf(wave_sum(s2) * (1.f / D) + LN_EPS);
#pragma unroll
        for (int j = 0; j < 8; ++j) { const float4 w = *((const float4*)p.ln2_w + F.lane + 64 * j), bb = *((const float4*)p.ln2_b + F.lane + 64 * j);
            zr[64 * j] = make_float4(v[j].x * rstd * w.x + bb.x, v[j].y * rstd * w.y + bb.y, v[j].z * rstd * w.z + bb.z, v[j].w * rstd * w.w + bb.w); }
#pragma unroll
        for (int j = 0; j < 8; ++j) xb[j] = xn[j];
    }
}

struct Args { const float* in[18]; float* out; unsigned char* ws; int ph_lo, ph_hi, li, pad; };
__global__ void __launch_bounds__(NTHR, 2) mk_fwd(Args args) {
    extern __shared__ __attribute__((aligned(16))) unsigned char lds_raw[];
    Frame F; F.lds = (LAS unsigned char*)lds_raw; F.tid = threadIdx.x; F.lane = F.tid & 63; F.wave = __builtin_amdgcn_readfirstlane(F.tid >> 6); F.G = gridDim.x; F.bid = blockIdx.x;
    Prm p; p.x = args.in[0]; p.c = args.in[1]; p.w_ada = args.in[2]; p.b_ada = args.in[3]; p.w_in = args.in[4]; p.b_in = args.in[5]; p.conv_w = args.in[6]; p.conv_b = args.in[7]; p.mnorm_w = args.in[8];
    p.w_out = args.in[9]; p.ln1_w = args.in[10]; p.ln1_b = args.in[11]; p.wq = args.in[12]; p.subkeys = args.in[13]; p.peer_u = args.in[14]; p.peer_v = args.in[15]; p.ln2_w = args.in[16]; p.ln2_b = args.in[17];
    p.out = args.out; p.ws = args.ws;
    volatile LAS unsigned* MISC = (volatile LAS unsigned*)(F.lds + MISC_OFF);
    for (int u = F.tid; u < (LDS_BYTES - LDSCTL_OFF) / 4; u += NTHR) ((LAS unsigned*)(F.lds + LDSCTL_OFF))[u] = 0u;
    __syncthreads();
    const int lo = args.ph_lo, hi = args.ph_hi;
    XcdBarrier bar; bar.bar = (unsigned*)(p.ws + WS_CTL) + CW_BAR + args.li * XCD_BAR_WORDS; bar.x = 0; bar.st = nullptr;
    if (hi - lo > 1) bar = xcd_barrier_post((unsigned*)(p.ws + WS_CTL) + CW_BAR + args.li * XCD_BAR_WORDS, MISC + 8);
#define IN(k) (lo <= (k) && (k) < hi)
#define SEAM(k) do { if (IN(k) && IN((k) + 1)) xcd_barrier(bar); } while (0)
    XW xw; xw.nx = (F.G % 8 == 0) ? 8 : 1; xw.vx = F.bid % xw.nx; xw.rank = F.bid / xw.nx; xw.nloc = F.G / xw.nx;
#define XW_FROM_CENSUS() do { if (hi - lo > 1) { if (F.tid == 0) { unsigned vx_ = 0u; for (unsigned j = 0; j < bar.x; ++j) vx_ += xb_ld(&bar.bar[XB_XCNT(j)]) > 0u ? 1u : 0u; MISC[11] = vx_; } __syncthreads(); \
        xw.vx = (int)MISC[11]; xw.nx = (int)MISC[9]; xw.rank = (int)MISC[10] - 1; xw.nloc = (int)MISC[8]; } } while (0)
    if (IN(0)) { phase0(p, F); deferred_prep<false, true, true>(p, F, 0, F.G); } SEAM(0);
    if (IN(1)) { phase1(p, F); } SEAM(1);
    if (IN(2)) { pg8::Gemm g{p.U(), p.WIN_T(), T, INM, D}; pg8::StaticOrder So; So.init(T, INM, F.G, F.bid);
        pg8::EpiBf16<0> E{p.PJ(), INM, p.b_in, 0, 0, 1.f};
        pg8::gemm_phase<pg8::EpiBf16<0>, pg8::StaticOrder, true, true>(F.lds, g, So, E); } SEAM(2);
    if (IN(3)) { const int nmb = F.G >= 2 ? F.G / 2 : 1;
#ifndef P3_REP_ML
#define P3_REP_ML 1
#define P3_REP_CONV 1
#endif
        if (F.bid < nmb) { for (int rep_ = 0; rep_ < P3_REP_ML; ++rep_) for (int u = F.bid; u < 2 * NB * MH * 2; u += nmb) ml::unit(p, F, u); if (F.G < 2) phase3a(p, F, 0, 1); }
        else { phase3a(p, F, nmb, F.G - nmb); deferred_prep<true, false, false>(p, F, nmb, F.G - nmb); }
        if (F.G < 2) deferred_prep<true, false, false>(p, F, 0, 1); } SEAM(3);
    if (IN(4)) { phase4(p, F); } SEAM(4);
    if (IN(5)) { pg8::Gemm g{p.Y(), p.WOUT_T(), T, D, D}; pg8::StaticOrder So; So.init(T, D, F.G, F.bid);
        EpiZ E{p.x, p.MOD(), (bf16_t*)p.out};
        pg8::gemm_phase<EpiZ, pg8::StaticOrder, true, true>(F.lds, g, So, E); } SEAM(5);
    if (IN(6)) { phase6(p, F); } SEAM(6);
    if (IN(7)) { pg8::Gemm g{p.U(), p.WQ_T(), T, NQ, D}; pg8::StaticOrder So; So.init(T, NQ, F.G, F.bid);
        EpiF32 E{p.SC(), NSC};
        pg8::gemm_phase<EpiF32, pg8::StaticOrder, true, true>(F.lds, g, So, E); } SEAM(7);
    if (IN(8)) { phase8(p, F); } SEAM(8);
    if (IN(9)) { if (lo < 9) XW_FROM_CENSUS(); phase9(p, F, xw); } SEAM(9);
    if (IN(10)) { phase10(p, F); } SEAM(10);
    if (IN(11)) { phase11(p, F); } SEAM(11);
    if (IN(12)) { phase12(p, F); }
#undef IN
#undef SEAM
}

extern "C" void kernel_launch(void* const* d_in, const int* in_sizes, int n_in, void* d_out, int out_size, void* d_ws, size_t ws_size, hipStream_t stream) {
    static int grid = 0;
    if (grid == 0) {
        if (n_in != 18 || out_size != T * D || ws_size < WS_END) { fprintf(stderr, "kernel_launch: unexpected shapes (n_in %d out %d ws %zu, need %zu)\n", n_in, out_size, ws_size, (size_t)WS_END); grid = -1; return; }
        int dev = 0, cus = 0, per_cu = 0;
        if (hipGetDevice(&dev) != hipSuccess || hipDeviceGetAttribute(&cus, hipDeviceAttributeMultiprocessorCount, dev) != hipSuccess) { grid = -1; return; }
        if (hipFuncSetAttribute((const void*)mk_fwd, hipFuncAttributeMaxDynamicSharedMemorySize, LDS_BYTES) != hipSuccess) { fprintf(stderr, "kernel_launch: hipFuncSetAttribute failed\n"); grid = -1; return; }
        if (hipOccupancyMaxActiveBlocksPerMultiprocessor(&per_cu, (const void*)mk_fwd, NTHR, LDS_BYTES) != hipSuccess || per_cu < 1) { fprintf(stderr, "kernel_launch: occupancy query says %d\n", per_cu); }
        (void)hipGetLastError();
        grid = cus;
        if (T % grid != 0 || (T / grid) % NWAVES != 0) { fprintf(stderr, "kernel_launch: grid %d does not divide the rows\n", grid); grid = -1; return; }
    }
    if (grid < 0) return;
    (void)hipMemsetAsync((char*)d_ws + WS_CTL, 0, 1u << 20, stream);
    Args a{};
    for (int i = 0; i < 18; ++i) a.in[i] = (const float*)d_in[i];
    a.out = (float*)d_out; a.ws = (unsigned char*)d_ws;
#if defined(PROBE_A)
    a.ph_lo = 0; a.ph_hi = PROBE_B + 1; a.li = 0; hipLaunchKernelGGL(mk_fwd, dim3(grid), dim3(NTHR), LDS_BYTES, stream, a);
    a.ph_lo = PROBE_A; a.ph_hi = NPHASE; a.li = 1; hipLaunchKernelGGL(mk_fwd, dim3(grid), dim3(NTHR), LDS_BYTES, stream, a);
#elif MK_N_LAUNCHES == 1
    a.ph_lo = 0; a.ph_hi = NPHASE;
    hipLaunchKernelGGL(mk_fwd, dim3(grid), dim3(NTHR), LDS_BYTES, stream, a);
#else
    for (int k = 0; k < NPHASE; ++k) { a.ph_lo = k; a.ph_hi = k + 1; hipLaunchKernelGGL(mk_fwd, dim3(grid), dim3(NTHR), LDS_BYTES, stream, a); }
#endif
}
```

```cpp
#define MK_N_LAUNCHES 1
#if defined(HOST_EMU)
#include <cmath>
#include <cstdint>
#include <cstring>
#include <cstddef>
#define HD inline
#define HDF inline
#else
#include <hip/hip_runtime.h>
#define HD __host__ __device__ __forceinline__
#define HDF __host__ __device__ __forceinline__
#endif

#ifndef CFG_D
#define CFG_D 2048
#define CFG_B 8
#define CFG_S 2048
#define CFG_PH 8
#define CFG_NK 128
#define CFG_TOPK 16
#define CFG_KD 256
#endif
constexpr int D = CFG_D, NB = CFG_B, S = CFG_S, T = NB * S;
constexpr int CW = D / 2, MW = D - CW, MH = 4, MV = MW / MH, QK = MV / 2, NG = 16, CHUNK = 64;
constexpr int INC = 3 * CW + 2 * MH * QK + 2 * MW + NG;
constexpr int INM = INC - NG;
constexpr int O_GB = 0, O_GC = CW, O_HIN = 2 * CW, O_Q = 3 * CW, O_K = O_Q + MH * QK, O_V = O_K + MH * QK, O_O = O_V + MW;
constexpr int PH = CFG_PH, NK = CFG_NK, TOPK = CFG_TOPK, KD = CFG_KD, KH = KD / 2, NE = NK * NK, NSLOT = PH * TOPK;
constexpr int NQ = PH * KD;
static_assert(PH * 2 * NK == NQ || true, "");
constexpr int NSC = PH * 2 * NK;
constexpr float LN_EPS = 1e-5f;
constexpr float ALPHA = 1.189207115002721f;
constexpr int D6 = 6 * D;

typedef unsigned short bf16_t;
HDF unsigned f_as_u(float f) { unsigned u; memcpy(&u, &f, 4); return u; }
HDF float u_as_f(unsigned u) { float f; memcpy(&f, &u, 4); return f; }
HDF bf16_t f2bf(float f) { unsigned u = f_as_u(f); return (bf16_t)((u + 0x7fffu + ((u >> 16) & 1u)) >> 16); }
HDF float bf2f(bf16_t h) { return u_as_f((unsigned)h << 16); }

constexpr size_t al(size_t x) { return (x + 1048575) & ~(size_t)1048575; }
constexpr size_t WS_CTL = 0;
constexpr size_t WS_MOD = al(1);
constexpr size_t WS_MODP = WS_MOD + al((size_t)NB * D6 * 4);
constexpr int NKS = 32;
constexpr size_t WS_GATES = WS_MODP + al((size_t)NKS * NB * D6 * 4);
constexpr size_t WS_DEN = WS_GATES + al((size_t)T * NG * 4);
constexpr size_t WS_FLR = WS_DEN + al((size_t)4 * T * MH * 4);
constexpr size_t WS_EIDX = WS_FLR + al((size_t)2 * T * MH * 4);
constexpr size_t WS_EW = WS_EIDX + al((size_t)T * NSLOT * 4);
constexpr size_t WS_WIN_T = WS_EW + al((size_t)T * NSLOT * 4);
constexpr size_t WS_WOUT_T = WS_WIN_T + al((size_t)INM * D * 2);
constexpr size_t WS_WQ_T = WS_WOUT_T + al((size_t)D * D * 2);
constexpr size_t WS_PU16 = WS_WQ_T + al((size_t)NQ * D * 2);
constexpr size_t WS_PV16 = WS_PU16 + al((size_t)NE * D * 2);
constexpr size_t WS_U = WS_PV16 + al((size_t)NE * D * 2);
constexpr size_t WS_Y = WS_U + al((size_t)T * D * 2);
constexpr size_t WS_P = WS_Y + al((size_t)T * D * 2);
constexpr size_t WS_SC = WS_P;
constexpr size_t WS_TS = WS_SC + al((size_t)T * NSC * 4);
constexpr size_t WS_TI = WS_TS + al((size_t)T * PH * 2 * TOPK * 4);
constexpr size_t WS_P_END = WS_P + al((size_t)T * INM * 2);
constexpr size_t WS_TI_END = WS_TI + al((size_t)T * PH * 2 * TOPK * 4);
constexpr size_t WS_END = WS_P_END > WS_TI_END ? WS_P_END : WS_TI_END;

struct Prm {
    const float *x, *c, *w_ada, *b_ada, *w_in, *b_in, *conv_w, *conv_b, *mnorm_w, *w_out, *ln1_w, *ln1_b, *wq, *subkeys, *peer_u, *peer_v, *ln2_w, *ln2_b;
    float* out;
    unsigned char* ws;
    HDF float* MOD() const { return (float*)(ws + WS_MOD); }
    HDF float* MODP() const { return (float*)(ws + WS_MODP); }
    HDF float* BIN256() const { return (float*)(ws + WS_MODP); }
    HDF float* GATES() const { return (float*)(ws + WS_GATES); }
    HDF float* DEN() const { return (float*)(ws + WS_DEN); }
    HDF float* FLR() const { return (float*)(ws + WS_FLR); }
    HDF int* EIDX() const { return (int*)(ws + WS_EIDX); }
    HDF float* EW() const { return (float*)(ws + WS_EW); }
    HDF bf16_t* WIN_T() const { return (bf16_t*)(ws + WS_WIN_T); }
    HDF unsigned char* WIN8() const { return ws + WS_WIN_T; }
    HDF unsigned char* U8() const { return ws + WS_U; }
    HDF bf16_t* WOUT_T() const { return (bf16_t*)(ws + WS_WOUT_T); }
    HDF bf16_t* WQ_T() const { return (bf16_t*)(ws + WS_WQ_T); }
    HDF bf16_t* PU16() const { return (bf16_t*)(ws + WS_PU16); }
    HDF bf16_t* PV16() const { return (bf16_t*)(ws + WS_PV16); }
    HDF unsigned char* PU8() const { return ws + WS_PU16; }
    HDF unsigned char* PV8() const { return ws + WS_PV16; }
    HDF unsigned char* PV8S() const { return ws + WS_PV16; }
    HDF float* RSU() const { return (float*)(ws + WS_PU16 + (size_t)NE * D); }
    HDF float* RSV() const { return (float*)(ws + WS_PU16 + (size_t)NE * D + (size_t)NE * 4); }
    HDF bf16_t* U() const { return (bf16_t*)(ws + WS_U); }
    HDF bf16_t* Y() const { return (bf16_t*)(ws + WS_Y); }
    HDF bf16_t* PJ() const { return (bf16_t*)(ws + WS_P); }
    HDF float* SC() const { return (float*)(ws + WS_SC); }
    HDF bf16_t* X1B() const { return (bf16_t*)(ws + WS_TS); }
    HDF float* TS() const { return (float*)(ws + WS_TS); }
    HDF int* TI() const { return (int*)(ws + WS_TI); }
    HDF float* HF() const { return out; }
    HDF float* HB() const { return out + (size_t)T * MW; }
    HDF bf16_t* HF16() const { return (bf16_t*)out; }
    HDF bf16_t* HB16() const { return (bf16_t*)out + (size_t)T * MW; }
};

HDF float sigmoidf_(float x) { return 1.f / (1.f + expf(-x)); }
HDF float logsigmoidf_(float x) { return fminf(x, 0.f) - log1pf(expf(-fabsf(x))); }
HDF float gelu_exact(float x) { return 0.5f * x * (1.f + erff(x * 0.7071067811865476f)); }

HD void b_ada(const Prm& p, long n) {
    float acc[NB];
#pragma unroll
    for (int b = 0; b < NB; ++b) acc[b] = 0.f;
    for (int k = 0; k < D; ++k) {
        const float w = p.w_ada[(size_t)k * D6 + n];
#pragma unroll
        for (int b = 0; b < NB; ++b) { const float cv = p.c[b * D + k]; acc[b] += cv * sigmoidf_(cv) * w; }
    }
#pragma unroll
    for (int b = 0; b < NB; ++b) p.MOD()[(size_t)b * D6 + n] = acc[b] + p.b_ada[n];
}
HD void b_wt(const float* W, int ldw, int K, bf16_t* WT, long i) { const long n = i / K, k = i % K; WT[i] = f2bf(W[(size_t)k * ldw + n]); }
HD void b_tab(const float* src, bf16_t* dst, long i) { dst[i] = f2bf(src[i]); }
HD void b_ln_mod1(const Prm& p, long row) {
    const float* xr = p.x + (size_t)row * D; const int b = (int)(row / S);
    const float* sh = p.MOD() + (size_t)b * D6; const float* sc = sh + D;
    float s = 0.f; for (int d = 0; d < D; ++d) s += xr[d];
    const float mean = s / D; float q = 0.f; for (int d = 0; d < D; ++d) { const float t = xr[d] - mean; q += t * t; }
    const float rstd = 1.f / sqrtf(q / D + LN_EPS);
    for (int d = 0; d < D; ++d) p.U()[(size_t)row * D + d] = f2bf((xr[d] - mean) * rstd * (1.f + sc[d]) + sh[d]);
}
HD void b_gates(const Prm& p, long i) {
    const long row = i / NG; const int g = (int)(i % NG); float acc = 0.f;
    for (int d = 0; d < D; ++d) acc += bf2f(p.U()[(size_t)row * D + d]) * p.w_in[(size_t)d * INC + INM + g];
    p.GATES()[i] = acc + p.b_in[INM + g];
}
HD float b_dot16(const bf16_t* a, const bf16_t* b, int K) { float acc = 0.f; for (int k = 0; k < K; ++k) acc += bf2f(a[k]) * bf2f(b[k]); return acc; }
HD void b_gemm1(const Prm& p, long i) { const long row = i / INM; const int n = (int)(i % INM);
    p.PJ()[i] = f2bf(b_dot16(p.U() + (size_t)row * D, p.WIN_T() + (size_t)n * D, D) + p.b_in[n]); }
HD void b_conv(const Prm& p, long i) {
    const long row = i / CW; const int ch = (int)(i % CW); const int s = (int)(row % S);
    const bf16_t* pj = p.PJ(); float acc = p.conv_b[ch];
#pragma unroll
    for (int k = 0; k < 3; ++k) { const int s2 = s + k - 1; if (s2 >= 0 && s2 < S) { const size_t r2 = (size_t)(row + k - 1) * INM;
        acc += p.conv_w[k * CW + ch] * (bf2f(pj[r2 + O_GC + ch]) * bf2f(pj[r2 + O_HIN + ch])); } }
    p.Y()[(size_t)row * D + ch] = f2bf(bf2f(pj[(size_t)row * INM + O_GB + ch]) * acc);
}
HDF long ml_tok(int dir, int b, int pos) { return (long)b * S + (dir ? S - 1 - pos : pos); }
HD void b_mscan(const Prm& p, long i) {
    const int v = (int)(i % (MV + 1)), h = (int)((i / (MV + 1)) % MH), b = (int)((i / ((MV + 1) * MH)) % NB), dir = (int)(i / ((MV + 1) * MH * NB));
    float C[QK];
#pragma unroll
    for (int d = 0; d < QK; ++d) C[d] = 0.f;
    float m = 0.f; const float qs = 1.f / sqrtf((float)QK);
    float* H = dir ? p.HB() : p.HF();
    for (int pos = 0; pos < S; ++pos) {
        const long tok = ml_tok(dir, b, pos); const float* g = p.GATES() + tok * NG + dir * 8;
        const float ig = g[h], lf = logsigmoidf_(g[4 + h]);
        const float mn = fmaxf(lf + m, ig), dec = expf(lf + m - mn), wi = expf(ig - mn); m = mn;
        const bf16_t* pj = p.PJ() + (size_t)tok * INM; const float wv = wi * (v < MV ? bf2f(pj[O_V + h * MV + (v < MV ? v : 0)]) : 1.f); float num = 0.f;
#pragma unroll
        for (int d = 0; d < QK; ++d) { C[d] = dec * C[d] + wv * bf2f(pj[O_K + h * QK + d]); num += bf2f(pj[O_Q + h * QK + d]) * qs * C[d]; }
        if (v < MV) H[(size_t)tok * MW + h * MV + v] = num;
        else { p.DEN()[((size_t)dir * T + tok) * MH + h] = num; p.FLR()[((size_t)dir * T + tok) * MH + h] = expf(-mn); }
    }
}
HD void b_headnorm(const Prm& p, long i) {
    const long row = i / MH; const int h = (int)(i % MH);
    const float* hf = p.HF() + (size_t)row * MW + h * MV; const float* hb = p.HB() + (size_t)row * MW + h * MV;
    const float inf_ = 1.f / fmaxf(fabsf(p.DEN()[(size_t)row * MH + h]), p.FLR()[(size_t)row * MH + h]);
    const float inb_ = 1.f / fmaxf(fabsf(p.DEN()[((size_t)T + row) * MH + h]), p.FLR()[((size_t)T + row) * MH + h]);
    float s = 0.f; for (int v = 0; v < MV; ++v) s += hf[v] * inf_ + hb[v] * inb_;
    const float mean = s / MV; float q = 0.f; for (int v = 0; v < MV; ++v) { const float t = hf[v] * inf_ + hb[v] * inb_ - mean; q += t * t; }
    const float rstd = 1.f / sqrtf(q / MV + LN_EPS);
    for (int v = 0; v < MV; ++v) { const float hn = (hf[v] * inf_ + hb[v] * inb_ - mean) * rstd * p.mnorm_w[h * MV + v];
        const float og = sigmoidf_(bf2f(p.PJ()[(size_t)row * INM + O_O + h * MV + v]));
        p.Y()[(size_t)row * D + CW + h * MV + v] = f2bf(og * hn); }
}
HD void b_gemm2(const Prm& p, long i) { const long row = i / D; const int n = (int)(i % D); const int b = (int)(row / S);
    const float acc = b_dot16(p.Y() + (size_t)row * D, p.WOUT_T() + (size_t)n * D, D);
    p.out[i] = ALPHA * p.x[i] + p.MOD()[(size_t)b * D6 + 2 * D + n] * acc; }
HD void b_ln_mid(const Prm& p, long row) {
    float* zr = p.out + (size_t)row * D; const int b = (int)(row / S);
    const float* sh = p.MOD() + (size_t)b * D6 + 3 * D; const float* sc = sh + D;
    float s = 0.f; for (int d = 0; d < D; ++d) s += zr[d];
    float mean = s / D; float q = 0.f; for (int d = 0; d < D; ++d) { const float t = zr[d] - mean; q += t * t; }
    float rstd = 1.f / sqrtf(q / D + LN_EPS);
    s = 0.f; for (int d = 0; d < D; ++d) { const float x1 = (zr[d] - mean) * rstd * p.ln1_w[d] + p.ln1_b[d]; zr[d] = x1; s += x1; }
    mean = s / D; q = 0.f; for (int d = 0; d < D; ++d) { const float t = zr[d] - mean; q += t * t; }
    rstd = 1.f / sqrtf(q / D + LN_EPS);
    for (int d = 0; d < D; ++d) p.U()[(size_t)row * D + d] = f2bf((zr[d] - mean) * rstd * (1.f + sc[d]) + sh[d]);
}
HD void b_gemm3(const Prm& p, long i) { const long row = i / NQ; const int n = (int)(i % NQ);
    p.Y()[i] = f2bf(b_dot16(p.U() + (size_t)row * D, p.WQ_T() + (size_t)n * D, D)); }
HD void b_scores(const Prm& p, long i) { const long tok = i / NSC; const int c = (int)(i % NSC), grp = c / NK, n = c % NK;
    const bf16_t* q = p.Y() + (size_t)tok * NQ + grp * KH; const float* sk = p.subkeys + ((size_t)grp * NK + n) * KH; float acc = 0.f;
    for (int d = 0; d < KH; ++d) acc += bf2f(q[d]) * sk[d];
    p.SC()[i] = acc; }
HD void b_topk1(const Prm& p, long i) {
    const float* sc = p.SC() + (size_t)i * NK; float pv = INFINITY; int pi = -1;
    for (int r = 0; r < TOPK; ++r) { float best = -INFINITY; int bi = -1;
        for (int n = 0; n < NK; ++n) { const float v = sc[n]; const bool ok = (v < pv) || (v == pv && n > pi); if (ok && v > best) { best = v; bi = n; } }
        p.TS()[(size_t)i * TOPK + r] = best; p.TI()[(size_t)i * TOPK + r] = bi; pv = best; pi = bi; }
}
HD void b_topk2(const Prm& p, long i) {
    const float* s0 = p.TS() + (size_t)i * 2 * TOPK; const float* s1 = s0 + TOPK; const int* i0 = p.TI() + (size_t)i * 2 * TOPK; const int* i1 = i0 + TOPK;
    float pv = INFINITY; int pi = -1; float mx = 0.f, sum = 0.f;
    for (int r = 0; r < TOPK; ++r) { float best = -INFINITY; int bi = -1;
        for (int c = 0; c < TOPK * TOPK; ++c) { const float v = s0[c / TOPK] + s1[c % TOPK]; const bool ok = (v < pv) || (v == pv && c > pi); if (ok && v > best) { best = v; bi = c; } }
        if (r == 0) mx = best;
        const float e = expf(best - mx); sum += e;
        p.EIDX()[(size_t)i * TOPK + r] = i0[bi / TOPK] * NK + i1[bi % TOPK]; p.EW()[(size_t)i * TOPK + r] = e; pv = best; pi = bi; }
    for (int r = 0; r < TOPK; ++r) p.EW()[(size_t)i * TOPK + r] /= sum;
}
HD void b_up(const Prm& p, long i) { const long tok = i / NSLOT; const int e = p.EIDX()[i];
    p.EW()[i] *= gelu_exact(b_dot16(p.U() + (size_t)tok * D, p.PU16() + (size_t)e * D, D)); }
HD void b_down(const Prm& p, long i) { const long tok = i / D; const int d = (int)(i % D); const int b = (int)(tok / S); float y = 0.f;
    for (int sl = 0; sl < NSLOT; ++sl) y += p.EW()[tok * NSLOT + sl] * bf2f(p.PV16()[(size_t)p.EIDX()[tok * NSLOT + sl] * D + d]);
    p.out[i] = ALPHA * p.out[i] + p.MOD()[(size_t)b * D6 + 5 * D + d] * y; }
HD void b_ln2(const Prm& p, long row) {
    float* zr = p.out + (size_t)row * D;
    float s = 0.f; for (int d = 0; d < D; ++d) s += zr[d];
    const float mean = s / D; float q = 0.f; for (int d = 0; d < D; ++d) { const float t = zr[d] - mean; q += t * t; }
    const float rstd = 1.f / sqrtf(q / D + LN_EPS);
    for (int d = 0; d < D; ++d) zr[d] = (zr[d] - mean) * rstd * p.ln2_w[d] + p.ln2_b[d];
}
#include <cstdio>
#define LAS __attribute__((address_space(3)))
#define GAS __attribute__((address_space(1)))
namespace pg8 {
#define PG8_LAS __attribute__((address_space(3)))
typedef unsigned short bf16_t;
typedef short bf16x8 __attribute__((ext_vector_type(8)));
typedef float f32x4 __attribute__((ext_vector_type(4)));
typedef unsigned u32x4 __attribute__((ext_vector_type(4)));
constexpr int BM = 256, BK = 64, HALF = 128, HTB = HALF * BK * 2  , STAGE_BYTES = 8 * HTB, NXCD = 8, WGM = 8;

__host__ __device__ __forceinline__ int lds_byte(int r, int c) { const int st = (r >> 4) * 2 + (c >> 5), rr = r & 15, cc = c & 31, ob = rr * 64 + cc * 2; return st * 1024 + (ob ^ (((ob >> 9) & 1) << 5)); }
__host__ __device__ __forceinline__ void stage_rc(int b, int& R, int& C) { const int st = b / 1024, sb = b % 1024, swz = sb ^ (((sb >> 9) & 1) << 5); R = (st >> 1) * 16 + swz / 64; C = (st & 1) * 32 + (swz % 64) / 2; }
__host__ __device__ __forceinline__ int perm32(int rho) { const int n = rho >> 4, i = rho & 15; return 8 * (i >> 2) + 4 * n + (i & 3); }

struct Unit { int pm, pn; };
struct Gemm { const bf16_t* A; const bf16_t* Bt; int M, N, K; };

struct StaticOrder {
    int nM, nN, nwg, G, c;
    __host__ __device__ void init(int M, int N, int G_, int c_) { nM = M / BM; nN = N / BM; nwg = nM * nN; G = G_; c = c_; }
    __host__ __device__ bool next(int i, Unit& u) const {
        const long L = (long)i * G + c; if (L >= nwg) return false;
        int wgid = (int)L; { const int q = nwg / NXCD, r = nwg % NXCD, xcd = wgid % NXCD, off = wgid / NXCD; wgid = (xcd < r ? xcd * (q + 1) : r * (q + 1) + (xcd - r) * q) + off; }
        const int nig = WGM * nN, gid = wgid / nig, fm = gid * WGM, gsz = (nM - fm) < WGM ? (nM - fm) : WGM;
        u.pm = fm + ((wgid % nig) % gsz); u.pn = (wgid % nig) / gsz; return true;
    }
    __device__ __forceinline__ void a_ready(const Unit&) const {}
    __device__ __forceinline__ void done(const Unit&) const {}
};

__device__ __forceinline__ unsigned cvt_pk_bf16(float lo, float hi) { unsigned r; asm volatile("v_cvt_pk_bf16_f32 %0, %1, %2" : "=v"(r) : "v"(lo), "v"(hi)); return r; }
typedef float f32x2 __attribute__((ext_vector_type(2)));
__device__ __forceinline__ f32x2 gelu_pk(f32x2 v) {
    const f32x2 av = __builtin_elementwise_abs(v), d = av * 0.2316418882f + 1.0f;
    f32x2 t; t.x = __builtin_amdgcn_rcpf(d.x); t.y = __builtin_amdgcn_rcpf(d.y);
    f32x2 q = t * 0.5307027145f + (-0.7265760135f); q = q * t + 0.7107068705f; q = q * t + (-0.142248368f); q = q * t + 0.127414796f; q = q * t;
    const f32x2 s = (v * v) * (-0.72134752044f);
    f32x2 e; e.x = __builtin_amdgcn_exp2f(s.x); e.y = __builtin_amdgcn_exp2f(s.y);
    const f32x2 m = v * (q * e), r = v - m;
    f32x2 o; o.x = v.x < 0.f ? m.x : r.x; o.y = v.y < 0.f ? m.y : r.y; return o;
}

template <int ACT  > struct EpiBf16 {
    static constexpr bool PERM = true, AFTER_DRAIN = false; static_assert(ACT == 0 || ACT == 1, "EpiBf16: ACT is 0 (none) or 1 (gelu_pk)");
    bf16_t* O; int ldc; const float* bias; int split_cols; size_t split_stride; float scale0;
    __device__ __forceinline__ void operator()(const f32x4 (&acc)[2][2][4][2], const Unit& u, int wr, int wc, int fr, int fq) const {
        const int row0 = u.pm * BM + wr * 64 + fr; int colt = u.pn * BM; bf16_t* base = O;
        float sc = 1.f; if (split_cols) { const int t = colt / split_cols; base += (size_t)t * split_stride; colt -= t * split_cols; if (t == 0) sc = scale0; }
        const int col0 = colt + wc * 32 + 8 * fq, bcol0 = u.pn * BM + wc * 32 + 8 * fq;
        f32x4 bv[2][2];
#pragma unroll
        for (int bj = 0; bj < 2; ++bj)
#pragma unroll
            for (int n = 0; n < 2; ++n) bv[bj][n] = bias ? *(const f32x4*)(bias + bcol0 + bj * HALF + 4 * n) : (f32x4){0.f, 0.f, 0.f, 0.f};
#pragma unroll
        for (int ai = 0; ai < 2; ++ai)
#pragma unroll
            for (int m = 0; m < 4; ++m) { bf16_t* rowp = base + (size_t)(row0 + ai * HALF + m * 16) * ldc + col0;
#pragma unroll
                for (int bj = 0; bj < 2; ++bj) { f32x4 v0 = acc[ai][bj][m][0] + bv[bj][0], v1 = acc[ai][bj][m][1] + bv[bj][1];
                    if (ACT == 1) { f32x2 a = gelu_pk((f32x2){v0[0], v0[1]}), b = gelu_pk((f32x2){v0[2], v0[3]}), c = gelu_pk((f32x2){v1[0], v1[1]}), d = gelu_pk((f32x2){v1[2], v1[3]});
                        v0 = (f32x4){a.x, a.y, b.x, b.y}; v1 = (f32x4){c.x, c.y, d.x, d.y}; }
                    v0 = v0 * sc; v1 = v1 * sc; u32x4 w; w.x = cvt_pk_bf16(v0[0], v0[1]); w.y = cvt_pk_bf16(v0[2], v0[3]); w.z = cvt_pk_bf16(v1[0], v1[1]); w.w = cvt_pk_bf16(v1[2], v1[3]);
                    *(u32x4*)(rowp + bj * HALF) = w; } }
    }
};
template <class Epi, class Sched, bool ALIGN_EPI = false, bool SP2 = false>
__device__ __forceinline__ void gemm_phase(PG8_LAS unsigned char* lds, const Gemm g, const Sched& S, const Epi& E) {
    const int tid = threadIdx.x, wid = __builtin_amdgcn_readfirstlane(tid >> 6), lane = tid & 63, wr = wid >> 2, wc = wid & 3, fr = lane & 15, fq = lane >> 4;
    const int K = g.K, nt = K / BK;
    unsigned voffA[2], voffB[2];
#pragma unroll
    for (int i = 0; i < 2; ++i) { int R, C; stage_rc(tid * 16 + i * 8192, R, C); const int Rb = Epi::PERM ? ((R & ~31) + perm32(R & 31)) : R;
        voffA[i] = (unsigned)(R * K + C) * 2u; voffB[i] = (unsigned)(Rb * K + C) * 2u; }
    const size_t kstep = (size_t)(BK * 2);
    const size_t hstep = (size_t)HALF * K * 2;
    const size_t tstep = 2 * hstep;
    const unsigned ldsw = (unsigned)wid * 1024u;
    const int aoff = lds_byte(wr * 64 + fr, fq * 8), boff = lds_byte(wc * 32 + fr, fq * 8);
#define PG8_SA(b, h) (((b) * 2 + (h)) * HTB)
#define PG8_SB(b, h) ((4 + (b) * 2 + (h)) * HTB)
#define PG8_STAGE(bufoff, gbase, voff) do { _Pragma("unroll") for (int _i = 0; _i < 2; ++_i) \
        __builtin_amdgcn_global_load_lds((const unsigned*)((const char*)(gbase) + (voff)[_i]), (PG8_LAS unsigned*)(lds + (bufoff) + ldsw + _i * 8192), 16, 0, 0); } while (0)
#define PG8_LDA(dst, b, h) do { _Pragma("unroll") for (int m = 0; m < 4; ++m) _Pragma("unroll") for (int k = 0; k < 2; ++k) dst[m][k] = *(const PG8_LAS bf16x8*)(lds + PG8_SA(b, h) + aoff + m * 2048 + k * 1024); } while (0)
#define PG8_LDB(dst, b, h) do { _Pragma("unroll") for (int n = 0; n < 2; ++n) _Pragma("unroll") for (int k = 0; k < 2; ++k) dst[n][k] = *(const PG8_LAS bf16x8*)(lds + PG8_SB(b, h) + boff + n * 2048 + k * 1024); } while (0)
#define PG8_MMA(ai, bj, At, Bt) do { __builtin_amdgcn_s_setprio(1); _Pragma("unroll") for (int m = 0; m < 4; ++m) _Pragma("unroll") for (int n = 0; n < 2; ++n) _Pragma("unroll") for (int k = 0; k < 2; ++k) \
        acc[ai][bj][m][n] = __builtin_amdgcn_mfma_f32_16x16x32_bf16(Bt[n][k], At[m][k], acc[ai][bj][m][n], 0, 0, 0); __builtin_amdgcn_s_setprio(0); } while (0)
#define PG8_WAIT_V(n) asm volatile("s_waitcnt vmcnt(" #n ")" ::: "memory")
#define PG8_WAIT_L(n) asm volatile("s_waitcnt lgkmcnt(" #n ")" ::: "memory")
#define PG8_BAR __builtin_amdgcn_s_barrier()
#define PG8_SCHED __builtin_amdgcn_sched_barrier(0)
    Unit cur, nxt; int ui = 0;
    if (!S.next(0, cur)) return;
    f32x4 acc[2][2][4][2];
#pragma unroll
    for (int a = 0; a < 2; ++a)
#pragma unroll
        for (int b = 0; b < 2; ++b)
#pragma unroll
            for (int m = 0; m < 4; ++m)
#pragma unroll
                for (int n = 0; n < 2; ++n) acc[a][b][m][n] = (f32x4){0.f, 0.f, 0.f, 0.f};
    bf16x8 At[4][2], B0[2][2], B1[2][2];
    const char* cA = (const char*)g.A + (size_t)cur.pm * tstep; const char* cB = (const char*)g.Bt + (size_t)cur.pn * tstep;
    S.a_ready(cur);
    if constexpr (SP2) {
        PG8_STAGE(PG8_SB(0, 0), cB, voffB); PG8_STAGE(PG8_SB(0, 1), cB + hstep, voffB); PG8_STAGE(PG8_SA(0, 0), cA, voffA); PG8_STAGE(PG8_SA(0, 1), cA + hstep, voffA);
        if (wr == 1) PG8_BAR;
        PG8_WAIT_V(2); PG8_BAR;
        PG8_STAGE(PG8_SB(1, 0), cB + kstep, voffB); PG8_STAGE(PG8_SA(1, 0), cA + kstep, voffA); PG8_STAGE(PG8_SB(1, 1), cB + hstep + kstep, voffB);
        PG8_WAIT_V(6); PG8_BAR;
    } else {
        PG8_STAGE(PG8_SB(0, 0), cB, voffB); PG8_STAGE(PG8_SA(0, 0), cA, voffA); PG8_STAGE(PG8_SB(0, 1), cB + hstep, voffB); PG8_STAGE(PG8_SA(0, 1), cA + hstep, voffA);
        if (wr == 1) PG8_BAR;
        PG8_WAIT_V(4); PG8_BAR;
        PG8_STAGE(PG8_SB(1, 0), cB + kstep, voffB); PG8_STAGE(PG8_SA(1, 0), cA + kstep, voffA); PG8_STAGE(PG8_SB(1, 1), cB + hstep + kstep, voffB);
        PG8_WAIT_V(6); PG8_BAR;
    }
    for (;;) {
        const bool has_next = S.next(ui + 1, nxt);
        const char* nA = has_next ? (const char*)g.A + (size_t)nxt.pm * tstep : cA; const char* nB = has_next ? (const char*)g.Bt + (size_t)nxt.pn * tstep : cB;
        for (int t = 0; t < nt; t += 2) {
            const bool last = (t == nt - 2);
            const char* a1 = cA + (size_t)(t + 1) * kstep;
            const char* a2 = last ? nA : cA + (size_t)(t + 2) * kstep; const char* b2 = last ? nB : cB + (size_t)(t + 2) * kstep;
            const char* a3 = a2 + kstep; const char* b3 = b2 + kstep;
            if (last && has_next) S.a_ready(nxt);
            if constexpr (SP2) {
            PG8_LDB(B0, 0, 0); PG8_LDB(B1, 0, 1); PG8_SCHED; PG8_LDA(At, 0, 0); PG8_STAGE(PG8_SA(1, 1), a1 + hstep, voffA);
            PG8_WAIT_V(8); PG8_WAIT_L(0); PG8_BAR; PG8_MMA(0, 0, At, B0); PG8_MMA(0, 1, At, B1); PG8_BAR; PG8_SCHED;
            PG8_LDA(At, 0, 1); PG8_STAGE(PG8_SB(0, 0), b2, voffB); PG8_STAGE(PG8_SB(0, 1), b2 + hstep, voffB); PG8_STAGE(PG8_SA(0, 0), a2, voffA);
            PG8_WAIT_V(8); PG8_WAIT_L(0); PG8_BAR; PG8_MMA(1, 0, At, B0); PG8_MMA(1, 1, At, B1); PG8_BAR; PG8_SCHED;
            PG8_LDB(B0, 1, 0); PG8_LDB(B1, 1, 1); PG8_SCHED; PG8_LDA(At, 1, 0); PG8_STAGE(PG8_SA(0, 1), a2 + hstep, voffA);
            PG8_WAIT_V(8); PG8_WAIT_L(0); PG8_BAR; PG8_MMA(0, 0, At, B0); PG8_MMA(0, 1, At, B1); PG8_BAR; PG8_SCHED;
            PG8_LDA(At, 1, 1); PG8_STAGE(PG8_SB(1, 0), b3, voffB); PG8_STAGE(PG8_SB(1, 1), b3 + hstep, voffB); PG8_STAGE(PG8_SA(1, 0), a3, voffA);
            PG8_WAIT_V(8); PG8_WAIT_L(0); PG8_BAR; PG8_MMA(1, 0, At, B0); PG8_MMA(1, 1, At, B1); PG8_BAR; PG8_SCHED;
            } else {
            PG8_LDB(B0, 0, 0); PG8_SCHED; PG8_LDA(At, 0, 0); PG8_STAGE(PG8_SA(1, 1), a1 + hstep, voffA);
            PG8_WAIT_L(8); PG8_BAR; PG8_WAIT_L(0); PG8_MMA(0, 0, At, B0); PG8_BAR; PG8_SCHED;
            PG8_LDB(B1, 0, 1); PG8_STAGE(PG8_SB(0, 0), b2, voffB);
            PG8_BAR; PG8_WAIT_L(0); PG8_MMA(0, 1, At, B1); PG8_BAR;
            PG8_LDA(At, 0, 1); PG8_STAGE(PG8_SA(0, 0), a2, voffA);
            PG8_BAR; PG8_WAIT_L(0); PG8_MMA(1, 0, At, B0); PG8_BAR; PG8_SCHED;
            PG8_STAGE(PG8_SB(0, 1), b2 + hstep, voffB);
            PG8_WAIT_V(6); PG8_BAR; PG8_MMA(1, 1, At, B1); PG8_BAR;
            PG8_LDB(B0, 1, 0); PG8_SCHED; PG8_LDA(At, 1, 0); PG8_STAGE(PG8_SA(0, 1), a2 + hstep, voffA);
            PG8_WAIT_L(8); PG8_BAR; PG8_WAIT_L(0); PG8_MMA(0, 0, At, B0); PG8_BAR; PG8_SCHED;
            PG8_LDB(B1, 1, 1); PG8_STAGE(PG8_SB(1, 0), b3, voffB);
            PG8_BAR; PG8_WAIT_L(0); PG8_MMA(0, 1, At, B1); PG8_BAR;
            PG8_LDA(At, 1, 1); PG8_STAGE(PG8_SA(1, 0), a3, voffA);
            PG8_BAR; PG8_WAIT_L(0); PG8_MMA(1, 0, At, B0); PG8_BAR; PG8_SCHED;
            PG8_STAGE(PG8_SB(1, 1), b3 + hstep, voffB);
            PG8_WAIT_V(6); PG8_BAR; PG8_MMA(1, 1, At, B1); PG8_BAR;
            }
        }
        if constexpr (ALIGN_EPI) { if (wr == 0) PG8_BAR; }
        if constexpr (!Epi::AFTER_DRAIN) { E(acc, cur, wr, wc, fr, fq); S.done(cur); }
        if (!has_next) break;
#pragma unroll
        for (int a = 0; a < 2; ++a)
#pragma unroll
            for (int b = 0; b < 2; ++b)
#pragma unroll
                for (int m = 0; m < 4; ++m)
#pragma unroll
                    for (int n = 0; n < 2; ++n) acc[a][b][m][n] = (f32x4){0.f, 0.f, 0.f, 0.f};
        cur = nxt; cA = nA; cB = nB; ++ui;
        if constexpr (ALIGN_EPI) { if (wr == 1) PG8_BAR; }
    }
    PG8_WAIT_V(0);
    if constexpr (!ALIGN_EPI) { if (wr == 0) PG8_BAR; }
    PG8_BAR;
    if constexpr (Epi::AFTER_DRAIN) { E.fused(acc, cur, wr, wc, fr, fq, lds, wid, lane); S.done(cur); }
#undef PG8_SA
#undef PG8_SB
#undef PG8_STAGE
#undef PG8_LDA
#undef PG8_LDB
#undef PG8_MMA
#undef PG8_WAIT_V
#undef PG8_WAIT_L
#undef PG8_BAR
#undef PG8_SCHED
}
}
#define XB_TMO      128
#define XB_XCNT(j)  (256  + 64 * (j))
#define XB_XSUB(j)  (1280 + 64 * (j))
#define XB_XGEN(j)  (2304 + 64 * (j))
#define XB_TOP      3328
#define XB_TOPGEN   3392
#define XCD_BAR_WORDS 3456
#define XB_SPIN_CAP (1u << 18)

__device__ __forceinline__ unsigned xb_ld(unsigned* p)              { return __hip_atomic_load(p, __ATOMIC_RELAXED, __HIP_MEMORY_SCOPE_AGENT); }
__device__ __forceinline__ unsigned xb_add(unsigned* p, unsigned v) { return __hip_atomic_fetch_add(p, v, __ATOMIC_RELAXED, __HIP_MEMORY_SCOPE_AGENT); }
__device__ __forceinline__ unsigned xb_xcc_id() { return (unsigned)__builtin_amdgcn_s_getreg((3 << 11) | 20) & 0xFu; }
#define XB_SPIN(cond, bar) do { unsigned _sp = 0; while (cond) { __builtin_amdgcn_s_sleep(1); \
    if ((++_sp & 255u) == 0u) { if (xb_ld(&(bar)[XB_TMO])) break; if (_sp > XB_SPIN_CAP) { atomicAdd(&(bar)[XB_TMO], 1u); break; } } } } while (0)

struct XcdBarrier {
    unsigned* bar; unsigned x;
    volatile LAS unsigned* st;
};

__device__ __forceinline__ XcdBarrier xcd_barrier_post(unsigned* bar, volatile LAS unsigned* st) {
    XcdBarrier b; b.bar = bar; b.x = xb_xcc_id(); b.st = st;
    if (threadIdx.x == 0) st[2] = xb_add(&bar[XB_XCNT(b.x)], 1u) + 1u;
    return b;
}
__device__ __forceinline__ void xcd_barrier_complete(unsigned* bar, unsigned x, unsigned& nloc, unsigned& nx) {
    const unsigned G = gridDim.x * gridDim.y * gridDim.z;
    unsigned sum, cnt, mine, sp = 0u;
    for (;;) {
        sum = 0u; cnt = 0u; mine = 0u;
#pragma unroll
        for (unsigned j = 0; j < 16; ++j) { const unsigned c = xb_ld(&bar[XB_XCNT(j)]); sum += c; cnt += (c > 0u) ? 1u : 0u; mine = (j == x) ? c : mine; }
        if (sum == G) break;
        __builtin_amdgcn_s_sleep(1);
        if ((++sp & 255u) == 0u) { if (xb_ld(&bar[XB_TMO])) break; if (sp > XB_SPIN_CAP) { atomicAdd(&bar[XB_TMO], 1u); break; } }
    }
    nloc = mine > 0u ? mine : 1u; nx = cnt > 0u ? cnt : 1u;
}

__device__ __forceinline__ void xcd_barrier(const XcdBarrier& b) {
    asm volatile("s_waitcnt vmcnt(0)" ::: "memory");
    __syncthreads();
    if (threadIdx.x == 0) {
        unsigned* bar = b.bar;
        __builtin_amdgcn_s_waitcnt(0);
        unsigned nloc = b.st[0], nx = b.st[1];
        if (nloc == 0u) { xcd_barrier_complete(bar, b.x, nloc, nx); b.st[0] = nloc; b.st[1] = nx; }
        const unsigned old = xb_add(&bar[XB_XSUB(b.x)], 1u);
        const unsigned gen = old / nloc;
        if (old + 1u == (gen + 1u) * nloc) {
            __builtin_amdgcn_fence(__ATOMIC_RELEASE, "agent");
            asm volatile("s_waitcnt vmcnt(0)" ::: "memory");
            const unsigned og = xb_add(&bar[XB_TOP], 1u);
            const unsigned tg = og / nx;
            if (og + 1u == (tg + 1u) * nx) xb_add(&bar[XB_TOPGEN], 1u);
            else XB_SPIN(xb_ld(&bar[XB_TOPGEN]) == tg, bar);
            __builtin_amdgcn_fence(__ATOMIC_ACQUIRE, "agent");
            xb_add(&bar[XB_XGEN(b.x)], 1u);
            asm volatile("s_waitcnt vmcnt(0)" ::: "memory");
        } else {
            XB_SPIN(xb_ld(&bar[XB_XGEN(b.x)]) == gen, bar);
            __builtin_amdgcn_fence(__ATOMIC_ACQUIRE, "agent");
            asm volatile("s_waitcnt vmcnt(0)" ::: "memory");
        }
    }
    __syncthreads();
}
constexpr int NWAVES = 8, NTHR = 512;
constexpr int RING_BYTES = 131072, LDSCTL_OFF = RING_BYTES, MISC_OFF = LDSCTL_OFF + 320, LDS_BYTES = 163840;
constexpr int CW_BAR = 4096;
#ifndef MK_N_LAUNCHES
#define MK_N_LAUNCHES 1
#endif
constexpr int NPHASE = 13;

typedef float f4v __attribute__((ext_vector_type(4)));
typedef unsigned u2v __attribute__((ext_vector_type(2)));
typedef unsigned u32x4_t __attribute__((ext_vector_type(4)));
struct Frame { LAS unsigned char* lds; int tid, lane, wave, G, bid; };
template <int CTRL, int ROWMASK> __device__ __forceinline__ float dppf(float old, float src) {
    return __builtin_bit_cast(float, __builtin_amdgcn_update_dpp(__builtin_bit_cast(int, old), __builtin_bit_cast(int, src), CTRL, ROWMASK, 0xf, false)); }
__device__ __forceinline__ float wave_scan_add(float v) {
    v += dppf<0x111, 0xf>(0.f, v); v += dppf<0x112, 0xf>(0.f, v); v += dppf<0x114, 0xf>(0.f, v); v += dppf<0x118, 0xf>(0.f, v);
    v += dppf<0x142, 0xa>(0.f, v); v += dppf<0x143, 0xc>(0.f, v); return v; }
__device__ __forceinline__ float wave_scan_max(float v) {
    const float NI = -INFINITY;
    v = fmaxf(v, dppf<0x111, 0xf>(NI, v)); v = fmaxf(v, dppf<0x112, 0xf>(NI, v)); v = fmaxf(v, dppf<0x114, 0xf>(NI, v)); v = fmaxf(v, dppf<0x118, 0xf>(NI, v));
    v = fmaxf(v, dppf<0x142, 0xa>(NI, v)); v = fmaxf(v, dppf<0x143, 0xc>(NI, v)); return v; }
__device__ __forceinline__ float lane_bcast(float v, int l) { return __builtin_bit_cast(float, __builtin_amdgcn_readlane(__builtin_bit_cast(int, v), l)); }
__device__ __forceinline__ float wave_sum(float v) { return lane_bcast(wave_scan_add(v), 63); }
__device__ __forceinline__ unsigned pk2(float lo, float hi) { return (unsigned)f2bf(lo) | ((unsigned)f2bf(hi) << 16); }
__device__ __forceinline__ float bflo(unsigned w) { return u_as_f(w << 16); }
__device__ __forceinline__ float bfhi(unsigned w) { return u_as_f(w & 0xffff0000u); }

__device__ __forceinline__ void p0_ada_block(const Prm& p, const Frame& F, int cb) {
    static_assert(D6 % 48 == 0 && NB == 8, "48-column blocks");
    LAS float* sl = (LAS float*)F.lds;
    LAS float* red = sl + NB * D;
    for (int i = F.tid; i < NB * D; i += NTHR) { const float cv = p.c[i]; sl[i] = cv / (1.f + __expf(-cv)); }
    __syncthreads();
    const int c4 = F.tid % 12, kl = F.tid / 12;
    if (kl < 42) {
        f4v acc[NB];
#pragma unroll
        for (int b = 0; b < NB; ++b) acc[b] = (f4v){0.f, 0.f, 0.f, 0.f};
        const float* wp = p.w_ada + (size_t)cb * 48 + 4 * c4;
#pragma unroll 7
        for (int k = kl; k < D; k += 42) { const f4v w = __builtin_nontemporal_load((const f4v*)(wp + (size_t)k * D6));
#pragma unroll
            for (int b = 0; b < NB; ++b) acc[b] += w * sl[b * D + k]; }
#pragma unroll
        for (int b = 0; b < NB; ++b) *(LAS f4v*)(red + (kl * NB + b) * 48 + 4 * c4) = acc[b];
    }
    __syncthreads();
    if (F.tid < NB * 48) { const int b = F.tid / 48, col = F.tid % 48; float s = 0.f;
        for (int k = 0; k < 42; ++k) s += red[(k * NB + b) * 48 + col];
        p.MOD()[(size_t)b * D6 + cb * 48 + col] = s + p.b_ada[cb * 48 + col]; }
    __syncthreads();
}
__device__ __forceinline__ void p0_transpose_item(const float* W, int ldw, int K, int N, bf16_t* WT, LAS float* scr, int item, int lane) {
    const int nblk = N / 32, kb = item / nblk, nb = item % nblk, k0 = 64 * kb, n0 = 32 * nb;
#pragma unroll
    for (int i = 0; i < 32; ++i) { const int kk = 2 * i + (lane >> 5); scr[kk * 33 + (lane & 31)] = W[(size_t)(k0 + kk) * ldw + n0 + (lane & 31)]; }
    asm volatile("s_waitcnt lgkmcnt(0)" ::: "memory");
    const int c = lane & 7;
#pragma unroll
    for (int j = 0; j < 4; ++j) { const int n = (lane >> 3) + 8 * j; const LAS float* s = scr + (8 * c) * 33 + n;
        uint4 o; o.x = pk2(s[0 * 33], s[1 * 33]); o.y = pk2(s[2 * 33], s[3 * 33]); o.z = pk2(s[4 * 33], s[5 * 33]); o.w = pk2(s[6 * 33], s[7 * 33]);
        *(uint4*)(WT + (size_t)(n0 + n) * K + k0 + 8 * c) = o; }
    asm volatile("s_waitcnt lgkmcnt(0)" ::: "memory");
}

__device__ __forceinline__ void p0_fold_item(const Prm& p, int item, int lane) {
    static_assert(NK == 128 && KH == 128 && NQ == 2048, "fold item decomposition");
    const int ks = item & 31, nt = (item >> 5) & 7, g = item >> 8;
    const int r = lane & 15, q = lane >> 4;
    const float* arow = p.subkeys + ((size_t)g * NK + nt * 16 + r) * KH + 4 * q;
    const float* brow = p.wq + (size_t)(ks * 64 + r) * NQ + g * KH + 4 * q;
    pg8::f32x4 acc[4];
#pragma unroll
    for (int c = 0; c < 4; ++c) acc[c] = (pg8::f32x4){0.f, 0.f, 0.f, 0.f};
#pragma unroll 2
    for (int s16 = 0; s16 < KH; s16 += 16) {
        const pg8::f32x4 a = *(const pg8::f32x4*)(arow + s16); pg8::f32x4 bv[4];
#pragma unroll
        for (int c = 0; c < 4; ++c) bv[c] = *(const pg8::f32x4*)(brow + (size_t)(c * 16) * NQ + s16);
#pragma unroll
        for (int i = 0; i < 4; ++i)
#pragma unroll
            for (int c = 0; c < 4; ++c) acc[c] = __builtin_amdgcn_mfma_f32_16x16x4f32(a[i], bv[c][i], acc[c], 0, 0, 0);
    }
#pragma unroll
    for (int c = 0; c < 4; ++c)
#pragma unroll
        for (int i = 0; i < 4; ++i) p.WQ_T()[(size_t)(g * NK + nt * 16 + 4 * q + i) * D + ks * 64 + c * 16 + r] = f2bf(acc[c][i]);
}
__device__ __forceinline__ void phase0(const Prm& p, const Frame& F) {
    for (int cb = F.bid; cb < D6 / 48; cb += F.G) p0_ada_block(p, F, cb);
    LAS float* scr = (LAS float*)(F.lds + F.wave * 16384);
    const int gw = F.bid * NWAVES + F.wave, NGW = F.G * NWAVES;
    constexpr int I_IN = (D / 64) * (INM / 32);
    for (int it = gw; it < I_IN; it += NGW) p0_transpose_item(p.w_in, INC, D, INM, p.WIN_T(), scr, it, F.lane);
}
template <bool PART_A, bool PART_B, bool PART_F>
__device__ __forceinline__ void deferred_prep(const Prm& p, const Frame& F, int b0, int nb) {
    __syncthreads();
    LAS float* scr = (LAS float*)(F.lds + F.wave * 16384);
    const int gw = (F.bid - b0) * NWAVES + F.wave, NGW = nb * NWAVES;
    constexpr int I_O = (D / 64) * (D / 32), I_Q = 32 * 8 * 16;
    if (PART_A) for (int it = gw; it < I_O; it += NGW) p0_transpose_item(p.w_out, D, D, D, p.WOUT_T(), scr, it, F.lane);
    if (PART_F) for (int it = gw; it < I_Q; it += NGW) p0_fold_item(p, it, F.lane);
    if (PART_A) {
        float4 v[8], vn[8]; int rr = gw;
#define P0_ROWSRC(rr_) ((const float4*)(p.peer_u + (size_t)(rr_) * D) + F.lane)
        if (rr < NE) { const float4* src = P0_ROWSRC(rr);
#pragma unroll
            for (int j = 0; j < 8; ++j) { const f4v t_ = __builtin_nontemporal_load((const f4v*)(src + 64 * j)); v[j] = make_float4(t_[0], t_[1], t_[2], t_[3]); } }
        for (; rr < NE; rr += NGW) {
            const int rn = rr + NGW;
            if (rn < NE) { const float4* src = P0_ROWSRC(rn);
#pragma unroll
                for (int j = 0; j < 8; ++j) { const f4v t_ = __builtin_nontemporal_load((const f4v*)(src + 64 * j)); vn[j] = make_float4(t_[0], t_[1], t_[2], t_[3]); } }
            const int e = rr; float am = 0.f;
#pragma unroll
            for (int j = 0; j < 8; ++j) am = fmaxf(am, fmaxf(fmaxf(fabsf(v[j].x), fabsf(v[j].y)), fmaxf(fabsf(v[j].z), fabsf(v[j].w))));
#pragma unroll
            for (int o = 1; o < 64; o <<= 1) am = fmaxf(am, __shfl_xor(am, o));
            const float sc = am > 0.f ? 384.f / am : 1.f;
            unsigned* dst = (unsigned*)(p.PU8() + (size_t)e * D) + F.lane;
#pragma unroll
            for (int j = 0; j < 8; ++j) { unsigned w = 0u; w = __builtin_amdgcn_cvt_pk_fp8_f32(v[j].x * sc, v[j].y * sc, w, false); w = __builtin_amdgcn_cvt_pk_fp8_f32(v[j].z * sc, v[j].w * sc, w, true); dst[64 * j] = w; }
            if (F.lane == 0) p.RSU()[e] = am > 0.f ? am / 384.f : 1.f;
#pragma unroll
            for (int j = 0; j < 8; ++j) v[j] = vn[j];
        }
#undef P0_ROWSRC
    }
    if (PART_B) { LAS unsigned char* tl = F.lds; constexpr int RS_ = 2056;
      for (int tile = F.bid - b0; tile < NE / 16; tile += nb) { const int row = F.tid >> 5, l32 = F.tid & 31, e = tile * 16 + row;
        __syncthreads();
        const f4v* src = (const f4v*)(p.peer_v + (size_t)e * D) + l32; f4v x[16]; float am = 0.f;
#pragma unroll
        for (int j = 0; j < 16; ++j) { x[j] = __builtin_nontemporal_load(src + 32 * j); am = fmaxf(am, fmaxf(fmaxf(fabsf(x[j][0]), fabsf(x[j][1])), fmaxf(fabsf(x[j][2]), fabsf(x[j][3])))); }
#pragma unroll
        for (int o = 1; o < 32; o <<= 1) am = fmaxf(am, __shfl_xor(am, o));
        const float sc = am > 0.f ? 384.f / am : 1.f;
#pragma unroll
        for (int j = 0; j < 16; ++j) { unsigned w = 0u; w = __builtin_amdgcn_cvt_pk_fp8_f32(x[j][0] * sc, x[j][1] * sc, w, false); w = __builtin_amdgcn_cvt_pk_fp8_f32(x[j][2] * sc, x[j][3] * sc, w, true);
            *(LAS unsigned*)(tl + row * RS_ + 4 * (l32 + 32 * j)) = w; }
        if (l32 == 0) p.RSV()[e] = am > 0.f ? am / 384.f : 1.f;
        __syncthreads();
#pragma unroll
        for (int k = 0; k < 8; ++k) { const int idx = F.tid + NTHR * k, r = idx & 15, sl = idx >> 4;
            *(u2v*)(p.PV8S() + ((size_t)sl * NE + tile * 16 + r) * 8) = *(const LAS u2v*)(tl + r * RS_ + 8 * sl); }
      } }
}
__device__ __forceinline__ void phase1(const Prm& p, const Frame& F) {
    LAS float* SH = (LAS float*)F.lds; LAS float* SC1 = SH + D;
    LAS bf16_t* WG = (LAS bf16_t*)(F.lds + 2 * D * 4);
    const int rows_per = T / F.G;
    { const int st = (F.bid * 37) % (NG * D / NTHR);
      for (int k = 0; k < NG * D / NTHR; ++k) { const int idx = F.tid + NTHR * ((k + st) % (NG * D / NTHR)); const int d = idx / NG, g = idx % NG; WG[g * D + d] = f2bf(p.w_in[(size_t)d * INC + INM + g]); } }
    int cur_b = -1;
    float4 xpre[8];
    { const float4* x0 = (const float4*)(p.x + (size_t)(F.bid * rows_per + F.wave) * D) + F.lane;
#pragma unroll
      for (int j = 0; j < 8; ++j) xpre[j] = x0[64 * j]; }
    for (int r0 = F.bid * rows_per; r0 < (F.bid + 1) * rows_per; r0 += NWAVES) {
        const int b = r0 / S;
        if (b != cur_b) { __syncthreads();
            for (int n = F.tid; n < 2 * D; n += NTHR) { const float s = p.MOD()[(size_t)b * D6 + n]; SH[n] = n < D ? s : 1.f + s; }
            cur_b = b; __syncthreads(); }
        const int row = r0 + F.wave;
        float4 v[8]; float s = 0.f;
#pragma unroll
        for (int j = 0; j < 8; ++j) v[j] = xpre[j];
        if (r0 + NWAVES < (F.bid + 1) * rows_per) { const float4* xn = (const float4*)(p.x + (size_t)(row + NWAVES) * D) + F.lane;
#pragma unroll
            for (int j = 0; j < 8; ++j) xpre[j] = xn[64 * j]; }
#pragma unroll
        for (int j = 0; j < 8; ++j) s += (v[j].x + v[j].y) + (v[j].z + v[j].w);
        const float mean = wave_sum(s) * (1.f / D); float s2 = 0.f;
#pragma unroll
        for (int j = 0; j < 8; ++j) { v[j].x -= mean; v[j].y -= mean; v[j].z -= mean; v[j].w -= mean; s2 += (v[j].x * v[j].x + v[j].y * v[j].y) + (v[j].z * v[j].z + v[j].w * v[j].w); }
        const float rstd = 1.f / sqrtf(wave_sum(s2) * (1.f / D) + LN_EPS);
        uint2* o8 = (uint2*)(p.U() + (size_t)row * D) + F.lane;
#pragma unroll
        for (int j = 0; j < 8; ++j) { const int c0 = 4 * F.lane + 256 * j; const f4v sh = *(const LAS f4v*)(SH + c0), sc = *(const LAS f4v*)(SC1 + c0);
            v[j].x = v[j].x * rstd * sc.x + sh.x; v[j].y = v[j].y * rstd * sc.y + sh.y; v[j].z = v[j].z * rstd * sc.z + sh.z; v[j].w = v[j].w * rstd * sc.w + sh.w;
            o8[64 * j] = make_uint2(pk2(v[j].x, v[j].y), pk2(v[j].z, v[j].w)); }
        float ga[NG];
#pragma unroll
        for (int g = 0; g < NG; ++g) { float a = 0.f;
#pragma unroll
            for (int j = 0; j < 8; ++j) { const u2v w = *(const LAS u2v*)(WG + g * D + 4 * F.lane + 256 * j); a += v[j].x * bflo(w.x) + v[j].y * bfhi(w.x) + v[j].z * bflo(w.y) + v[j].w * bfhi(w.y); }
            ga[g] = a; }
        float r8[8], r4[4], r2[2]; const bool l0 = F.lane & 1, l1 = F.lane & 2, l2 = F.lane & 4, l3 = F.lane & 8;
#pragma unroll
        for (int i = 0; i < 8; ++i) { const float keep = l0 ? ga[8 + i] : ga[i], send = l0 ? ga[i] : ga[8 + i]; r8[i] = keep + __shfl_xor(send, 1); }
#pragma unroll
        for (int i = 0; i < 4; ++i) { const float keep = l1 ? r8[4 + i] : r8[i], send = l1 ? r8[i] : r8[4 + i]; r4[i] = keep + __shfl_xor(send, 2); }
#pragma unroll
        for (int i = 0; i < 2; ++i) { const float keep = l2 ? r4[2 + i] : r4[i], send = l2 ? r4[i] : r4[2 + i]; r2[i] = keep + __shfl_xor(send, 4); }
        float gacc = (l3 ? r2[1] : r2[0]) + __shfl_xor(l3 ? r2[0] : r2[1], 8);
        gacc += __shfl_xor(gacc, 16); gacc += __shfl_xor(gacc, 32);
        const int gi = (l0 ? 8 : 0) + (l1 ? 4 : 0) + (l2 ? 2 : 0) + (l3 ? 1 : 0);
        if (F.lane < NG) { const float gv = gacc + p.b_in[INM + gi]; p.GATES()[(size_t)row * NG + gi] = (gi & 4) ? logsigmoidf_(gv) : gv; }
    }
}
__device__ __forceinline__ void phase3a(const Prm& p, const Frame& F, int b0, int nb) {
    const size_t gt = (size_t)(F.bid - b0) * NTHR + F.tid, GT = (size_t)nb * NTHR;
    for (size_t i = gt; i < (size_t)T * (CW / 8); i += GT) {
        const size_t row = i / (CW / 8); const int ch = (int)(i % (CW / 8)) * 8, s = (int)(row % S);
        float acc[8];
#pragma unroll
        for (int e = 0; e < 8; ++e) acc[e] = p.conv_b[ch + e];
#pragma unroll
        for (int k = 0; k < 3; ++k) { const int s2 = s + k - 1; if (s2 < 0 || s2 >= S) continue; const bf16_t* pr = p.PJ() + (size_t)(row + k - 1) * INM;
            const uint4 gc = *(const uint4*)(pr + O_GC + ch), hi = *(const uint4*)(pr + O_HIN + ch); const float* cw = p.conv_w + k * CW + ch;
            acc[0] += cw[0] * (bflo(gc.x) * bflo(hi.x)); acc[1] += cw[1] * (bfhi(gc.x) * bfhi(hi.x)); acc[2] += cw[2] * (bflo(gc.y) * bflo(hi.y)); acc[3] += cw[3] * (bfhi(gc.y) * bfhi(hi.y));
            acc[4] += cw[4] * (bflo(gc.z) * bflo(hi.z)); acc[5] += cw[5] * (bfhi(gc.z) * bfhi(hi.z)); acc[6] += cw[6] * (bflo(gc.w) * bflo(hi.w)); acc[7] += cw[7] * (bfhi(gc.w) * bfhi(hi.w)); }
        const uint4 gb = *(const uint4*)(p.PJ() + row * INM + O_GB + ch); uint4 o;
        o.x = pk2(bflo(gb.x) * acc[0], bfhi(gb.x) * acc[1]); o.y = pk2(bflo(gb.y) * acc[2], bfhi(gb.y) * acc[3]); o.z = pk2(bflo(gb.z) * acc[4], bfhi(gb.z) * acc[5]); o.w = pk2(bflo(gb.w) * acc[6], bfhi(gb.w) * acc[7]);
        *(uint4*)(p.Y() + row * D + ch) = o; }
}
namespace ml {
typedef short bf16x8 __attribute__((ext_vector_type(8)));
typedef short s16x4 __attribute__((ext_vector_type(4)));
typedef float f32x4 __attribute__((ext_vector_type(4)));
typedef float f32x2_t __attribute__((ext_vector_type(2)));
typedef __bf16 bf16x2_t __attribute__((ext_vector_type(2)));
typedef unsigned u32x4 __attribute__((ext_vector_type(4)));
typedef unsigned u32x2 __attribute__((ext_vector_type(2)));
constexpr unsigned IMG = 16384u, BUF = 3u * IMG, PT_OFF = 2u * BUF, PT_BYTES = 8192u, N_OFF = PT_OFF + 2u * PT_BYTES;
constexpr unsigned SCT_OFF = 149504u, SCT_BYTES = 1024u;
constexpr unsigned HT_OFF = 133120u;
static_assert(N_OFF + 1024u <= 131072u && HT_OFF + 16384u <= SCT_OFF && SCT_OFF + 3u * SCT_BYTES <= 163840u, "mLSTM LDS map");
__device__ __forceinline__ unsigned cvtpk(float lo, float hi) { f32x2_t v = {lo, hi}; bf16x2_t b = __builtin_convertvector(v, bf16x2_t); return __builtin_bit_cast(unsigned, b); }
__device__ __forceinline__ unsigned off_a(unsigned row, unsigned ch) { return 2048u * (row >> 3) + 512u * (ch >> 2) + 64u * (row & 7u) + 16u * ((ch & 3u) ^ ((row >> 2) & 3u)); }
__device__ __forceinline__ unsigned off_p(unsigned row, unsigned ch) { return 128u * row + 16u * (ch ^ (row & 7u)); }
typedef short v4i16_t __attribute__((ext_vector_type(4)));
__device__ __forceinline__ s16x4 trr(LAS unsigned char* p) { return __builtin_bit_cast(s16x4, __builtin_amdgcn_ds_read_tr16_b64_v4i16((LAS v4i16_t*)p)); }
__device__ __forceinline__ bf16x8 cat8(s16x4 a, s16x4 b) { return (bf16x8){a[0], a[1], a[2], a[3], b[0], b[1], b[2], b[3]}; }
struct CS { float decay, m_next; };
__device__ __forceinline__ CS chunk_scalars(float ig, float fg, float m, LAS float* tab, bool writer, unsigned lane) {
    const float lf = fg;
    const float bc = wave_scan_add(lf), gg = ig - bc, cm = wave_scan_max(gg);
    const float G = fmaxf(m, cm), G63 = lane_bcast(G, 63), b63 = lane_bcast(bc, 63), qs = 0.08838834764831845f;
    if (writer) { tab[lane] = __expf(fminf(G63 - G, 80.f)) * qs; tab[64 + lane] = __expf(m - G) * qs; tab[128 + lane] = __expf(-(bc + G)); tab[192 + lane] = __expf(gg - G63); }
    CS r; r.decay = __expf(m - G63); r.m_next = b63 + G63;
    return r;
}
__device__ __forceinline__ void unit(const Prm& p, const Frame& F, int u) {
    static_assert(QK == 128 && MV == 256 && CHUNK == 64 && S % 64 == 0, "mLSTM unit is specialised");
    const int vhalf = u & 1, h = (u >> 1) & 3, b = (u >> 3) & 7, dir = u >> 6;
    const unsigned lane = F.lane, tid = F.tid; const int wave = F.wave; const unsigned q = lane >> 4, r = lane & 15u;
    LAS unsigned char* L = F.lds;
    const unsigned rx = (r >> 2) & 3u, rlo = 2048u * (r >> 3) + 64u * (r & 7u);
    const unsigned RA = rlo + 16u * (q ^ rx), PB1 = rlo + 16u * ((q >> 1) ^ rx) + 8u * (q & 1u), PB2 = rlo + 16u * ((2u + (q >> 1)) ^ rx) + 8u * (q & 1u);
    const unsigned pp = lane & 3u, tlo = 2048u * q + 64u * rx + 8u * (pp & 1u);
    const unsigned tb00 = tlo + 16u * ((pp >> 1) ^ ((2u * q) & 3u)), tb01 = tlo + 256u + 16u * ((pp >> 1) ^ ((2u * q + 1u) & 3u));
    const unsigned tb10 = tlo + 16u * ((2u + (pp >> 1)) ^ ((2u * q) & 3u)), tb11 = tlo + 256u + 16u * ((2u + (pp >> 1)) ^ ((2u * q + 1u) & 3u));
    const unsigned PP0 = 128u * r + 16u * (q ^ (r & 7u)), PP1 = 128u * r + 16u * ((4u + q) ^ (r & 7u));
#define ML_TRA(c, ks, t) ((((c) & 1) ? ((t) ? tb11 : tb10) : ((t) ? tb01 : tb00)) + 8192u * (ks) + 512u * ((unsigned)(c) >> 1))
    __syncthreads();
    for (unsigned i = tid; i < (2u * PT_BYTES + 1024u) / 16u; i += NTHR) *(LAS u32x4*)(L + PT_OFF + 16u * i) = (u32x4){0u, 0u, 0u, 0u};
    f32x4 C[8];
#pragma unroll
    for (int i = 0; i < 8; ++i) C[i] = (f32x4){0.f, 0.f, 0.f, 0.f};
    float m = 0.f;
    const bf16_t* pj = p.PJ(); bf16_t* H = dir ? p.HB16() : p.HF16();
    const int colq = O_Q + h * QK, colk = O_K + h * QK, colv = O_V + h * MV + vhalf * 128;
    const unsigned srow0 = tid >> 4, sch = tid & 15u;
    u32x4 rq[2], rk[2], rv[2];
    const float* gbase = p.GATES() + dir * 8 + h;
#define ML_GATES(c, ig_, fg_) do { const float* g_ = gbase + (size_t)ml_tok(dir, b, (c) * 64 + (int)lane) * NG; ig_ = g_[0]; fg_ = g_[4]; } while (0)
    float ig0, fg0, ign = 0.f, fgn = 0.f; ML_GATES(0, ig0, fg0); if (S / 64 > 1) ML_GATES(1, ign, fgn);
#define ML_TAB(c) ((LAS float*)(L + SCT_OFF + (unsigned)((c) % 3) * SCT_BYTES))
    CS cs = chunk_scalars(ig0, fg0, m, ML_TAB(0), wave == 0, lane), csn = cs;
    const long sMW = dir ? -(long)MW : (long)MW;
#define ML_LOAD(c) do { _Pragma("unroll") for (int i_ = 0; i_ < 2; ++i_) { const bf16_t* rp = pj + (size_t)ml_tok(dir, b, (c) * 64 + srow0 + 32 * i_) * INM + 8 * sch; \
        rq[i_] = *(const u32x4*)(rp + colq); rk[i_] = *(const u32x4*)(rp + colk); rv[i_] = *(const u32x4*)(rp + colv); } } while (0)
#define ML_STORE(buf, S_) do { _Pragma("unroll") for (int i_ = 0; i_ < 2; ++i_) { const unsigned row = srow0 + 32u * i_, o = (buf) * BUF + off_a(row, sch); const float w = (S_)[192 + row]; \
        *(LAS u32x4*)(L + o) = rq[i_]; *(LAS u32x4*)(L + IMG + o) = rk[i_]; u32x4 v = rv[i_]; \
        v.x = cvtpk(bflo(v.x) * w, bfhi(v.x) * w); v.y = cvtpk(bflo(v.y) * w, bfhi(v.y) * w); v.z = cvtpk(bflo(v.z) * w, bfhi(v.z) * w); v.w = cvtpk(bflo(v.w) * w, bfhi(v.w) * w); \
        *(LAS u32x4*)(L + 2u * IMG + o) = v; } } while (0)
    __syncthreads();
    ML_LOAD(0); ML_STORE(0u, ML_TAB(0));
    constexpr int NC = S / 64;
    for (int c = 0; c < NC; ++c) {
        const unsigned cur = (unsigned)(c & 1);
        LAS unsigned char* Qi = L + cur * BUF; LAS unsigned char* Ki = Qi + IMG; LAS unsigned char* Vi = Qi + 2u * IMG; LAS unsigned char* Pt = L + PT_OFF + cur * PT_BYTES;
        float ig2 = 0.f, fg2 = 0.f;
        if (c + 1 < NC) { ML_LOAD(c + 1); csn = chunk_scalars(ign, fgn, cs.m_next, ML_TAB(c + 1), wave == 0, lane); if (c + 2 < NC) ML_GATES(c + 2, ig2, fg2); }
        __syncthreads();
#define ML_FLUSH(cprev) do { _Pragma("unroll") for (int i_ = 0; i_ < 2; ++i_) { const unsigned n_ = tid + 512u * i_, row_ = n_ >> 4, ch_ = n_ & 15u;     \
            const u32x4 v_ = *(const LAS u32x4*)(L + HT_OFF + 256u * row_ + 16u * (ch_ ^ (row_ & 15u))); \
            *(u32x4*)(H + (size_t)ml_tok(dir, b, (cprev) * 64 + (int)row_) * MW + h * MV + vhalf * 128 + 8 * (int)ch_) = v_; } } while (0)
        const LAS float* sct = ML_TAB(c);
        if (c > 0) ML_FLUSH(c - 1);
#ifndef ML_REP_3B
#define ML_REP_3B 1
#define ML_REP_S 1
#define ML_REP_ST 1
#define ML_REP_3A 1
#define ML_REP_DEN 1
#endif
        f32x4 acc2[4];
#pragma unroll
        for (int tt = 0; tt < 4; ++tt) acc2[tt] = (f32x4){0.f, 0.f, 0.f, 0.f};
#pragma unroll
        for (int ks = 0; ks < 4; ++ks) {
            bf16x8 qa[4];
#pragma unroll
            for (int tt = 0; tt < 4; ++tt) {
                const u32x2 lo = *(const LAS u32x2*)(Qi + PB1 + 4096u * tt + 512u * ks), hi = *(const LAS u32x2*)(Qi + PB2 + 4096u * tt + 512u * ks);
                const u32x4 aw = {lo.x, lo.y, hi.x, hi.y}; qa[tt] = __builtin_bit_cast(bf16x8, aw); }
            const f32x4 c0 = C[2 * ks], c1 = C[2 * ks + 1];
            const u32x4 bw = {cvtpk(c0[0], c0[1]), cvtpk(c0[2], c0[3]), cvtpk(c1[0], c1[1]), cvtpk(c1[2], c1[3])}; const bf16x8 bfr = __builtin_bit_cast(bf16x8, bw);
#pragma unroll
            for (int tt = 0; tt < 4; ++tt) acc2[tt] = __builtin_amdgcn_mfma_f32_16x16x32_bf16(qa[tt], bfr, acc2[tt], 0, 0, 0);
        }
        bf16x8 vB[2];
#pragma unroll
        for (int ks = 0; ks < 2; ++ks) vB[ks] = cat8(trr(Vi + ML_TRA(wave, ks, 0)), trr(Vi + ML_TRA(wave, ks, 1)));
#pragma unroll
        for (int dt = 0; dt < 8; ++dt) C[dt] = C[dt] * cs.decay;
#pragma unroll
        for (int ks = 0; ks < 2; ++ks)
#pragma unroll
            for (int dh = 0; dh < 2; ++dh) { bf16x8 kA[4];
#pragma unroll
                for (int d4 = 0; d4 < 4; ++d4) kA[d4] = cat8(trr(Ki + ML_TRA(4 * dh + d4, ks, 0)), trr(Ki + ML_TRA(4 * dh + d4, ks, 1)));
#pragma unroll
                for (int d4 = 0; d4 < 4; ++d4) C[4 * dh + d4] = __builtin_amdgcn_mfma_f32_16x16x32_bf16(kA[d4], vB[ks], C[4 * dh + d4], 0, 0, 0); }
#pragma unroll
        for (int rep = 0; rep < 2; ++rep) { const int idx = wave + (rep ? 2 : 0);
            if (rep == 0 || wave >= 6) { const int tt = idx >= 6 ? 3 : (idx >= 3 ? 2 : (idx >= 1 ? 1 : 0)), st = idx - tt * (tt + 1) / 2;
                f32x4 sa = (f32x4){0.f, 0.f, 0.f, 0.f};
#pragma unroll
                for (int kh = 0; kh < 2; ++kh) { bf16x8 af[2], bfk[2];
#pragma unroll
                    for (int k2 = 0; k2 < 2; ++k2) { af[k2] = *(const LAS bf16x8*)(Qi + RA + 4096u * tt + 512u * (2 * kh + k2)); bfk[k2] = *(const LAS bf16x8*)(Ki + RA + 4096u * st + 512u * (2 * kh + k2)); }
#pragma unroll
                    for (int k2 = 0; k2 < 2; ++k2) sa = __builtin_amdgcn_mfma_f32_16x16x32_bf16(af[k2], bfk[k2], sa, 0, 0, 0); }
                const unsigned scol = 16u * st + r;
#pragma unroll
                for (int i = 0; i < 4; ++i) { const unsigned trow = 16u * tt + 4u * q + i; const float v = scol <= trow ? sa[i] : 0.f;
                    *(LAS bf16_t*)(Pt + off_p(trow, scol >> 3) + 2u * (scol & 7u)) = (bf16_t)cvtpk(v, 0.f); } } }
        if (c + 1 < NC) ML_STORE(cur ^ 1u, ML_TAB(c + 1));
        __syncthreads();
        { bf16x8 pf[6];
#pragma unroll
          for (int tt = 0; tt < 4; ++tt) { pf[tt] = *(const LAS bf16x8*)(Pt + PP0 + 2048u * tt); if (tt >= 2) pf[2 + tt] = *(const LAS bf16x8*)(Pt + PP1 + 2048u * tt); }
#pragma unroll
          for (int tt = 0; tt < 4; ++tt) { const f32x4 av4 = *(const LAS f32x4*)(sct + 16 * tt + 4 * q), bv4 = *(const LAS f32x4*)(sct + 64 + 16 * tt + 4 * q); f32x4 a1 = __builtin_amdgcn_mfma_f32_16x16x32_bf16(pf[tt], vB[0], (f32x4){0.f, 0.f, 0.f, 0.f}, 0, 0, 0);
            if (tt >= 2) a1 = __builtin_amdgcn_mfma_f32_16x16x32_bf16(pf[2 + tt], vB[1], a1, 0, 0, 0);
#pragma unroll
            for (int i = 0; i < 4; ++i) { const unsigned t = 16u * tt + 4u * q + i, col = 16u * (unsigned)wave + r;
                *(LAS bf16_t*)(L + HT_OFF + 256u * t + 16u * ((col >> 3) ^ (t & 15u)) + 2u * (col & 7u)) = (bf16_t)cvtpk(av4[i] * a1[i] + bv4[i] * acc2[tt][i], 0.f); } } }
        if (vhalf == 0) {
            const LAS float* n_old = (const LAS float*)(L + N_OFF + cur * 512u); LAS float* n_new = (LAS float*)(L + N_OFF + (cur ^ 1u) * 512u);
            bf16x8 wB[2];
#pragma unroll
            for (int ks = 0; ks < 2; ++ks) { const f32x4 w0 = *(const LAS f32x4*)(sct + 192 + 32 * ks + 8 * q), w1 = *(const LAS f32x4*)(sct + 192 + 32 * ks + 8 * q + 4);
                u32x4 w = {cvtpk(w0[0], w0[1]), cvtpk(w0[2], w0[3]), cvtpk(w1[0], w1[1]), cvtpk(w1[2], w1[3])};
                if (r != 0u) w = (u32x4){0u, 0u, 0u, 0u}; wB[ks] = __builtin_bit_cast(bf16x8, w); }
            const size_t dbase = ((size_t)dir * T) * MH + h;
            if (wave < 4) { const int tt = wave; f32x4 d2 = (f32x4){0.f, 0.f, 0.f, 0.f};
#pragma unroll
                for (int ks = 0; ks < 4; ++ks) { const f32x4 n0 = *(const LAS f32x4*)(n_old + 32 * ks + 4 * q), n1 = *(const LAS f32x4*)(n_old + 32 * ks + 16 + 4 * q);
                    u32x4 bw = {cvtpk(n0[0], n0[1]), cvtpk(n0[2], n0[3]), cvtpk(n1[0], n1[1]), cvtpk(n1[2], n1[3])}; if (r != 0u) bw = (u32x4){0u, 0u, 0u, 0u};
                    const u32x2 lo = *(const LAS u32x2*)(Qi + PB1 + 4096u * tt + 512u * ks), hi = *(const LAS u32x2*)(Qi + PB2 + 4096u * tt + 512u * ks);
                    const u32x4 aw = {lo.x, lo.y, hi.x, hi.y};
                    d2 = __builtin_amdgcn_mfma_f32_16x16x32_bf16(__builtin_bit_cast(bf16x8, aw), __builtin_bit_cast(bf16x8, bw), d2, 0, 0, 0); }
#pragma unroll
                for (int i = 0; i < 4; ++i) { const int t = 16 * tt + 4 * (int)q + i; const float bv = sct[64 + t], fl = sct[128 + t];
                    if (r == 0u) { const size_t di = dbase + (size_t)ml_tok(dir, b, c * 64 + t) * MH; p.DEN()[(size_t)2 * T * MH + di] = bv * d2[i]; p.FLR()[di] = fl; } }
            } else { const int tt = wave - 4; f32x4 d1 = (f32x4){0.f, 0.f, 0.f, 0.f};
#pragma unroll
                for (int ks = 0; ks < 2; ++ks) if (ks == 0 || tt >= 2) { const bf16x8 pf = *(const LAS bf16x8*)(Pt + (ks ? PP1 : PP0) + 2048u * tt);
                    d1 = __builtin_amdgcn_mfma_f32_16x16x32_bf16(pf, wB[ks], d1, 0, 0, 0); }
#pragma unroll
                for (int i = 0; i < 4; ++i) { const int t = 16 * tt + 4 * (int)q + i; const float av = sct[t];
                    if (r == 0u) p.DEN()[dbase + (size_t)ml_tok(dir, b, c * 64 + t) * MH] = av * d1[i]; } }
            { const int dt = wave; f32x4 nn = *(const LAS f32x4*)(n_old + 16 * dt + 4 * q) * cs.decay; if (r != 0u) nn = (f32x4){0.f, 0.f, 0.f, 0.f};
#pragma unroll
                for (int ks = 0; ks < 2; ++ks) { const bf16x8 kA = cat8(trr(Ki + ML_TRA(dt, ks, 0)), trr(Ki + ML_TRA(dt, ks, 1)));
                    nn = __builtin_amdgcn_mfma_f32_16x16x32_bf16(kA, wB[ks], nn, 0, 0, 0); }
                if (r == 0u) *(LAS f32x4*)(n_new + 16 * dt + 4 * q) = nn; }
        }
        m = cs.m_next; cs = csn; ign = ig2; fgn = fg2;
    }
    __syncthreads(); ML_FLUSH(NC - 1);
#undef ML_FLUSH
#undef ML_TRA
#undef ML_TABLE
#undef ML_LOAD
#undef ML_GATES
#undef ML_STORE
}
}
__device__ __forceinline__ void phase4(const Prm& p, const Frame& F) {
    static_assert(MV == 256 && MH == 4, "head j = float4 slot j of the lane");
    const int gw = F.bid * NWAVES + F.wave, NGW = F.G * NWAVES;
    for (int row = gw; row < T; row += NGW) {
        const uint2* hf = (const uint2*)(p.HF16() + (size_t)row * MW) + F.lane; const uint2* hb = (const uint2*)(p.HB16() + (size_t)row * MW) + F.lane;
        const uint2* og = (const uint2*)(p.PJ() + (size_t)row * INM + O_O) + F.lane; uint2* yo = (uint2*)(p.Y() + (size_t)row * D + CW) + F.lane;
#pragma unroll
        for (int j = 0; j < MH; ++j) {
            const float* d2 = p.DEN() + (size_t)2 * T * MH;
            const float i_f = 1.f / fmaxf(fabsf(p.DEN()[(size_t)row * MH + j] + d2[(size_t)row * MH + j]), p.FLR()[(size_t)row * MH + j]);
            const float i_b = 1.f / fmaxf(fabsf(p.DEN()[((size_t)T + row) * MH + j] + d2[((size_t)T + row) * MH + j]), p.FLR()[((size_t)T + row) * MH + j]);
            const uint2 a = hf[64 * j], b = hb[64 * j]; float4 h = make_float4(bflo(a.x) * i_f + bflo(b.x) * i_b, bfhi(a.x) * i_f + bfhi(b.x) * i_b, bflo(a.y) * i_f + bflo(b.y) * i_b, bfhi(a.y) * i_f + bfhi(b.y) * i_b);
            const float mean = wave_sum((h.x + h.y) + (h.z + h.w)) * (1.f / MV);
            h.x -= mean; h.y -= mean; h.z -= mean; h.w -= mean;
            const float rstd = 1.f / sqrtf(wave_sum((h.x * h.x + h.y * h.y) + (h.z * h.z + h.w * h.w)) * (1.f / MV) + LN_EPS);
            const float4 nw = *((const float4*)(p.mnorm_w + j * MV) + F.lane); const uint2 o = og[64 * j];
            yo[64 * j] = make_uint2(pk2(h.x * rstd * nw.x * sigmoidf_(bflo(o.x)), h.y * rstd * nw.y * sigmoidf_(bfhi(o.x))), pk2(h.z * rstd * nw.z * sigmoidf_(bflo(o.y)), h.w * rstd * nw.w * sigmoidf_(bfhi(o.y)))); }
    }
}
struct EpiZ {
    static constexpr bool PERM = false, AFTER_DRAIN = false;
    const float* x; const float* mod; bf16_t* out;
    __device__ __forceinline__ void operator()(const pg8::f32x4 (&acc)[2][2][4][2], const pg8::Unit& u, int wr, int wc, int fr, int fq) const {
        const int col0 = u.pn * 256 + wc * 32 + 4 * fq;
#pragma unroll
        for (int ai = 0; ai < 2; ++ai)
#pragma unroll
            for (int m = 0; m < 4; ++m) { const int row = u.pm * 256 + ai * 128 + wr * 64 + m * 16 + fr; const float* g1 = mod + (size_t)(row / S) * D6 + 2 * D; const size_t off = (size_t)row * D + col0;
#pragma unroll
                for (int bj = 0; bj < 2; ++bj)
#pragma unroll
                    for (int n = 0; n < 2; ++n) { const int c = bj * 128 + n * 16; const pg8::f32x4 xv = *(const pg8::f32x4*)(x + off + c), gv = *(const pg8::f32x4*)(g1 + col0 + c);
                        const pg8::f32x4 z = xv * ALPHA + gv * acc[ai][bj][m][n]; *(uint2*)(out + off + c) = make_uint2(pk2(z[0], z[1]), pk2(z[2], z[3])); } }
    }
};

struct EpiF32 {
    static constexpr bool PERM = false, AFTER_DRAIN = false;
    float* out; int ldc;
    __device__ __forceinline__ void operator()(const pg8::f32x4 (&acc)[2][2][4][2], const pg8::Unit& u, int wr, int wc, int fr, int fq) const {
        const int col0 = u.pn * 256 + wc * 32 + 4 * fq;
#pragma unroll
        for (int ai = 0; ai < 2; ++ai)
#pragma unroll
            for (int m = 0; m < 4; ++m) { float* rowp = out + (size_t)(u.pm * 256 + ai * 128 + wr * 64 + m * 16 + fr) * ldc + col0;
#pragma unroll
                for (int bj = 0; bj < 2; ++bj)
#pragma unroll
                    for (int n = 0; n < 2; ++n) *(pg8::f32x4*)(rowp + bj * 128 + n * 16) = acc[ai][bj][m][n]; }
    }
};
__device__ __forceinline__ unsigned skey(float f) { const unsigned u = f_as_u(f); return (u & 0x80000000u) ? ~u : (u | 0x80000000u); }
__device__ __forceinline__ float unskey(unsigned k) { return u_as_f((k & 0x80000000u) ? (k & 0x7fffffffu) : ~k); }
__device__ __forceinline__ void tk_insert(unsigned (&L)[16], unsigned k) {
    if (k > L[15]) { L[15] = k;
#pragma unroll
        for (int i = 14; i >= 0; --i) { const unsigned hi = L[i] > L[i + 1] ? L[i] : L[i + 1], lo = L[i] > L[i + 1] ? L[i + 1] : L[i]; L[i] = hi; L[i + 1] = lo; } }
}
__device__ __forceinline__ void tk_top16(const float* sc, unsigned (&L)[16]) {
#pragma unroll
    for (int i = 0; i < 16; ++i) L[i] = 0u;
#pragma unroll 2
    for (int n4 = 0; n4 < NK / 4; ++n4) { const float4 v = ((const float4*)sc)[n4]; const unsigned b = 127u - 4u * n4;
        tk_insert(L, (skey(v.x) & ~0x7fu) | b); tk_insert(L, (skey(v.y) & ~0x7fu) | (b - 1)); tk_insert(L, (skey(v.z) & ~0x7fu) | (b - 2)); tk_insert(L, (skey(v.w) & ~0x7fu) | (b - 3)); }
}
__device__ __forceinline__ void phase8(const Prm& p, const Frame& F) {
    static_assert(NK == 128 && TOPK == 16, "top-k phase is specialised");
    const long gt = (long)F.bid * NTHR + F.tid, GT = (long)F.G * NTHR;
    for (long i = gt; i < (long)T * PH; i += GT) {
        unsigned A[16], B[16];
        tk_top16(p.SC() + (size_t)i * 2 * NK, A); tk_top16(p.SC() + (size_t)i * 2 * NK + NK, B);
        float V[16]; int E[16];
#pragma unroll
        for (int r = 0; r < 16; ++r) { V[r] = -INFINITY; E[r] = 0; }
#pragma unroll
        for (int a = 0; a < 16; ++a)
#pragma unroll
            for (int b = 0; b < 16; ++b) if ((a + 1) * (b + 1) <= 16) {
                const float v = unskey(A[a] & ~0x7fu) + unskey(B[b] & ~0x7fu); const int e = (int)((127u - (A[a] & 0x7fu)) * NK + (127u - (B[b] & 0x7fu)));
                if (v > V[15]) { V[15] = v; E[15] = e;
#pragma unroll
                    for (int r = 14; r >= 0; --r) { const bool sw = V[r + 1] > V[r]; const float vh = sw ? V[r + 1] : V[r], vl = sw ? V[r] : V[r + 1]; const int eh = sw ? E[r + 1] : E[r], el = sw ? E[r] : E[r + 1];
                        V[r] = vh; V[r + 1] = vl; E[r] = eh; E[r + 1] = el; } } }
        float sum = 0.f; const float vmax = V[0];
#pragma unroll
        for (int r = 0; r < 16; ++r) { V[r] = __expf(V[r] - vmax); sum += V[r]; }
        const float inv = 1.f / sum;
#pragma unroll
        for (int r = 0; r < 16; r += 4) { *(int4*)(p.EIDX() + (size_t)i * TOPK + r) = make_int4(E[r], E[r + 1], E[r + 2], E[r + 3]);
            *(float4*)(p.EW() + (size_t)i * TOPK + r) = make_float4(V[r] * inv, V[r + 1] * inv, V[r + 2] * inv, V[r + 3] * inv); }
    }
}
__device__ __forceinline__ void phase6(const Prm& p, const Frame& F) {
    const int gw = F.bid * NWAVES + F.wave, NGW = F.G * NWAVES;
    float4 v[8]; uint2 zb[8], zn[8];
    if (gw < T) { const uint2* z0 = (const uint2*)((const bf16_t*)p.out + (size_t)gw * D) + F.lane;
#pragma unroll
        for (int j = 0; j < 8; ++j) zb[j] = z0[64 * j]; }
    for (int row = gw; row < T; row += NGW) {
        uint2* x1r = (uint2*)(p.X1B() + (size_t)row * D) + F.lane; const float* mod = p.MOD() + (size_t)(row / S) * D6;
        float s = 0.f;
        if (row + NGW < T) { const uint2* zp = (const uint2*)((const bf16_t*)p.out + (size_t)(row + NGW) * D) + F.lane;
#pragma unroll
            for (int j = 0; j < 8; ++j) zn[j] = zp[64 * j]; }
#pragma unroll
        for (int j = 0; j < 8; ++j) { v[j] = make_float4(bflo(zb[j].x), bfhi(zb[j].x), bflo(zb[j].y), bfhi(zb[j].y)); s += (v[j].x + v[j].y) + (v[j].z + v[j].w); }
        float mean = wave_sum(s) * (1.f / D), s2 = 0.f;
#pragma unroll
        for (int j = 0; j < 8; ++j) { v[j].x -= mean; v[j].y -= mean; v[j].z -= mean; v[j].w -= mean; s2 += (v[j].x * v[j].x + v[j].y * v[j].y) + (v[j].z * v[j].z + v[j].w * v[j].w); }
        float rstd = 1.f / sqrtf(wave_sum(s2) * (1.f / D) + LN_EPS); s = 0.f;
#pragma unroll
        for (int j = 0; j < 8; ++j) { const float4 w = *((const float4*)p.ln1_w + F.lane + 64 * j), bb = *((const float4*)p.ln1_b + F.lane + 64 * j);
            v[j].x = v[j].x * rstd * w.x + bb.x; v[j].y = v[j].y * rstd * w.y + bb.y; v[j].z = v[j].z * rstd * w.z + bb.z; v[j].w = v[j].w * rstd * w.w + bb.w;
            x1r[64 * j] = make_uint2(pk2(v[j].x, v[j].y), pk2(v[j].z, v[j].w)); s += (v[j].x + v[j].y) + (v[j].z + v[j].w); }
        mean = wave_sum(s) * (1.f / D); s2 = 0.f;
#pragma unroll
        for (int j = 0; j < 8; ++j) { v[j].x -= mean; v[j].y -= mean; v[j].z -= mean; v[j].w -= mean; s2 += (v[j].x * v[j].x + v[j].y * v[j].y) + (v[j].z * v[j].z + v[j].w * v[j].w); }
        rstd = 1.f / sqrtf(wave_sum(s2) * (1.f / D) + LN_EPS);
        uint2* o8 = (uint2*)(p.U() + (size_t)row * D) + F.lane;
#pragma unroll
        for (int j = 0; j < 8; ++j) { const float4 sh = *((const float4*)(mod + 3 * D) + F.lane + 64 * j), sc = *((const float4*)(mod + 4 * D) + F.lane + 64 * j);
            o8[64 * j] = make_uint2(pk2(v[j].x * rstd * (1.f + sc.x) + sh.x, v[j].y * rstd * (1.f + sc.y) + sh.y), pk2(v[j].z * rstd * (1.f + sc.z) + sh.z, v[j].w * rstd * (1.f + sc.w) + sh.w)); }
#pragma unroll
        for (int j = 0; j < 8; ++j) zb[j] = zn[j];
    }
}
struct XW { int vx, nx, rank, nloc; };
constexpr int NDS = 16, DSW = D / NDS;
typedef float f2v __attribute__((ext_vector_type(2)));
struct Row8 { uint4 r[8]; };
__device__ __forceinline__ void gather8(Row8& g, const unsigned char* tbu, unsigned loff, int ereg, int pg) {
#pragma unroll
    for (int k = 0; k < 8; ++k) { const unsigned e = (unsigned)__shfl(ereg, 8 * k + pg); g.r[k] = *(const uint4*)(tbu + (((size_t)e << 11) | loff)); }
}
#define PEER_CVT8(a) const f2v c0 = __builtin_amdgcn_cvt_pk_f32_fp8((a).x, false), c1 = __builtin_amdgcn_cvt_pk_f32_fp8((a).x, true), c2 = __builtin_amdgcn_cvt_pk_f32_fp8((a).y, false), c3 = __builtin_amdgcn_cvt_pk_f32_fp8((a).y, true), \
    c4 = __builtin_amdgcn_cvt_pk_f32_fp8((a).z, false), c5 = __builtin_amdgcn_cvt_pk_f32_fp8((a).z, true), c6 = __builtin_amdgcn_cvt_pk_f32_fp8((a).w, false), c7 = __builtin_amdgcn_cvt_pk_f32_fp8((a).w, true)
typedef _Float16 h2t __attribute__((ext_vector_type(2)));
__device__ __forceinline__ float peer_dot16h(const uint4 a, const h2t* u) {
    float acc = __builtin_amdgcn_fdot2(__builtin_amdgcn_cvt_scalef32_pk_f16_fp8(a.x, 1.0f, false), u[0], 0.f, false);
    acc = __builtin_amdgcn_fdot2(__builtin_amdgcn_cvt_scalef32_pk_f16_fp8(a.x, 1.0f, true), u[1], acc, false);
    acc = __builtin_amdgcn_fdot2(__builtin_amdgcn_cvt_scalef32_pk_f16_fp8(a.y, 1.0f, false), u[2], acc, false);
    acc = __builtin_amdgcn_fdot2(__builtin_amdgcn_cvt_scalef32_pk_f16_fp8(a.y, 1.0f, true), u[3], acc, false);
    acc = __builtin_amdgcn_fdot2(__builtin_amdgcn_cvt_scalef32_pk_f16_fp8(a.z, 1.0f, false), u[4], acc, false);
    acc = __builtin_amdgcn_fdot2(__builtin_amdgcn_cvt_scalef32_pk_f16_fp8(a.z, 1.0f, true), u[5], acc, false);
    acc = __builtin_amdgcn_fdot2(__builtin_amdgcn_cvt_scalef32_pk_f16_fp8(a.w, 1.0f, false), u[6], acc, false);
    acc = __builtin_amdgcn_fdot2(__builtin_amdgcn_cvt_scalef32_pk_f16_fp8(a.w, 1.0f, true), u[7], acc, false);
    return acc;
}
__device__ __forceinline__ f2v rscatter16(const float* v, bool b0, bool b1, bool b2, int m0, int m1, int m2) {
    float r8[8], r4[4]; f2v r2;
#pragma unroll
    for (int i = 0; i < 8; ++i) { const float keep = b0 ? v[8 + i] : v[i], send = b0 ? v[i] : v[8 + i]; r8[i] = keep + __shfl_xor(send, m0); }
#pragma unroll
    for (int i = 0; i < 4; ++i) { const float keep = b1 ? r8[4 + i] : r8[i], send = b1 ? r8[i] : r8[4 + i]; r4[i] = keep + __shfl_xor(send, m1); }
    { const float k0 = b2 ? r4[2] : r4[0], s0 = b2 ? r4[0] : r4[2], k1 = b2 ? r4[3] : r4[1], s1 = b2 ? r4[1] : r4[3]; r2.x = k0 + __shfl_xor(s0, m2); r2.y = k1 + __shfl_xor(s1, m2); }
    return r2;
}
__device__ __forceinline__ void phase9(const Prm& p, const Frame& F, const XW& xw) {
    static_assert(DSW == 128 && NSLOT == 128 && D == 2048, "slice row = 8 lanes x 16 bytes");
    const int pg = F.lane >> 3, part = F.lane & 7; const bool p0 = part & 1, p1 = part & 2, p2 = part & 4;
    const int tstep = xw.nloc * NWAVES, t0 = xw.rank * NWAVES + F.wave; const int nt = t0 < T ? (T - t0 + tstep - 1) / tstep : 0;
    const unsigned loff = (unsigned)part * 16u; const int k0 = (p0 ? 8 : 0) + (p1 ? 4 : 0) + (p2 ? 2 : 0);
    for (int ds = xw.vx; ds < NDS; ds += xw.nx) {
        if (nt == 0) continue;
        const unsigned char* tbu = p.PU8() + ds * DSW; _Float16* part_out = (_Float16*)p.SC() + (size_t)ds * T * NSLOT + pg + 8 * k0;
#define UP_TOK(i) (t0 + ((i) < nt ? (i) : nt - 1) * tstep)
#define UP_LOADE(i, ea, eb) do { const int* ep_ = p.EIDX() + (size_t)UP_TOK(i) * NSLOT + F.lane; ea = ep_[0]; eb = ep_[64]; } while (0)
#define UP_LOADU(i, ua_, ub_) do { const uint4* up_ = (const uint4*)(p.U() + (size_t)UP_TOK(i) * D + ds * DSW + part * 16); ua_ = up_[0]; ub_ = up_[1]; } while (0)
        int e0a, e0b, e1a, e1b, e2a, e2b; uint4 ua, ub, una, unb;
        UP_LOADE(0, e0a, e0b); UP_LOADE(1, e1a, e1b); UP_LOADE(2, e2a, e2b); UP_LOADU(0, ua, ub);
        Row8 G0, G1, G2, G3;
        gather8(G0, tbu, loff, e0a, pg); gather8(G1, tbu, loff, e0b, pg); gather8(G2, tbu, loff, e1a, pg);
#define UP_BODY(i, GA, GB, GC, GD) do { \
            gather8(GD, tbu, loff, e1b, pg); UP_LOADU((i) + 1, una, unb); int e3a, e3b; UP_LOADE((i) + 3, e3a, e3b); \
            h2t u[8]; u[0] = (h2t){(_Float16)bflo(ua.x), (_Float16)bfhi(ua.x)}; u[1] = (h2t){(_Float16)bflo(ua.y), (_Float16)bfhi(ua.y)}; u[2] = (h2t){(_Float16)bflo(ua.z), (_Float16)bfhi(ua.z)}; u[3] = (h2t){(_Float16)bflo(ua.w), (_Float16)bfhi(ua.w)}; \
            u[4] = (h2t){(_Float16)bflo(ub.x), (_Float16)bfhi(ub.x)}; u[5] = (h2t){(_Float16)bflo(ub.y), (_Float16)bfhi(ub.y)}; u[6] = (h2t){(_Float16)bflo(ub.z), (_Float16)bfhi(ub.z)}; u[7] = (h2t){(_Float16)bflo(ub.w), (_Float16)bfhi(ub.w)}; \
            float dv[16]; \
            _Pragma("unroll") for (int k = 0; k < 8; ++k) dv[k] = peer_dot16h(GA.r[k], u); \
            gather8(GA, tbu, loff, e2a, pg); \
            _Pragma("unroll") for (int k = 0; k < 8; ++k) dv[8 + k] = peer_dot16h(GB.r[k], u); \
            const f2v r2 = rscatter16(dv, p0, p1, p2, 1, 2, 4);                          \
            if ((i) < nt) { _Float16* po = part_out + (size_t)UP_TOK(i) * NSLOT; po[0] = (_Float16)(r2.x * 0.0625f); po[8] = (_Float16)(r2.y * 0.0625f); } \
            e1a = e2a; e1b = e2b; e2a = e3a; e2b = e3b; ua = una; ub = unb; } while (0)
        for (int i = 0; i < nt; i += 2) { UP_BODY(i, G0, G1, G2, G3); UP_BODY(i + 1, G2, G3, G0, G1); }
#undef UP_BODY
#undef UP_LOADU
#undef UP_LOADE
#undef UP_TOK
    }
}
__device__ __forceinline__ void phase10(const Prm& p, const Frame& F) {
    static_assert(NE <= 16384 && NSLOT == 128 && T % 64 == 0, "14-bit expert id, 64-token groups");
    LAS unsigned* tile = (LAS unsigned*)F.lds;
    for (int tg = F.bid; tg < T / 64; tg += F.G) {
        __syncthreads();
#pragma unroll 4
        for (int k = 0; k < 16; ++k) { const int idx = F.tid + NTHR * k, tl = idx >> 7, sl = idx & 127; const size_t i = ((size_t)tg * 64 + tl) * NSLOT + sl; float s = 0.f;
#pragma unroll
            for (int ds = 0; ds < NDS; ++ds) s += (float)((const _Float16*)p.SC())[(size_t)ds * T * NSLOT + i];
            s *= 16.f;
            const int e = p.EIDX()[i]; const _Float16 w = (_Float16)(p.EW()[i] * gelu_exact(s * p.RSU()[e]) * p.RSV()[e] * 256.f);
            tile[tl * 129 + sl] = (((unsigned)__builtin_bit_cast(unsigned short, w) << 16) & 0xFFFE0000u) | ((unsigned)e << 3); }
        __syncthreads();
        uint4* pk = (uint4*)p.EW() + (size_t)tg * 64 * (NSLOT / 4);
#pragma unroll
        for (int k = 0; k < 4; ++k) { const int j = F.tid + NTHR * k, sq = j >> 6, tl = j & 63; const LAS unsigned* tp = tile + tl * 129 + 4 * sq; pk[j] = make_uint4(tp[0], tp[1], tp[2], tp[3]); }
    }
}
__device__ __forceinline__ void phase11(const Prm& p, const Frame& F) {
    static_assert(NE * 8 <= RING_BYTES && D % 8 == 0 && NE <= 65536, "table slice fits the LDS ring");
    typedef _Float16 h2v __attribute__((ext_vector_type(2)));
    const int c0 = (F.G % 8 == 0) ? (F.bid % 8) * (F.G / 8) + F.bid / 8 : F.bid;
    for (int sidx = c0; sidx < D / 8; sidx += F.G) {
        __syncthreads();
        { const uint4* src = (const uint4*)(p.PV8S() + (size_t)sidx * NE * 8);
          for (int i = F.tid; i < NE / 2; i += NTHR) *(LAS u32x4_t*)(F.lds + 16 * i) = __builtin_bit_cast(u32x4_t, src[i]); }
        __syncthreads();
        const int ntg = (T / 64 - F.wave + NWAVES - 1) / NWAVES, nb = 8 * ntg;
        uint4 b0[4], b1[4], b2[4], b3[4];
        const int kx = (F.G % 8 == 0) ? F.bid >> 3 : F.bid, rot = kx & 3, rotb = (kx >> 2) & 7;
#define DN_TG(bi) (F.wave + ((((bi) >> 3) + rot) % ntg) * NWAVES)
#define DN_PTR(bi) ((const uint4*)p.EW() + (size_t)DN_TG(bi) * 64 * (NSLOT / 4) + ((((bi) & 7) + rotb) & 7) * 4 * 64 + F.lane)
#define DN_LOAD(B, bi) do { const int bc_ = (bi) < nb ? (bi) : nb - 1; const uint4* pk_ = DN_PTR(bc_); _Pragma("unroll") for (int k = 0; k < 4; ++k) B[k] = pk_[k * 64]; } while (0)
#define DN_ONE(v_) do { const unsigned vv_ = (v_); const _Float16 w = __builtin_bit_cast(_Float16, (unsigned short)(vv_ >> 16)); const h2v w2 = {w, w}; \
                const u2v t = *(const LAS u2v*)(F.lds + (vv_ & 0x1FFF8u)); const unsigned tx_ = t.x, ty_ = t.y; \
                a0 += __builtin_amdgcn_cvt_scalef32_pk_f16_fp8(tx_, 1.0f, false) * w2; a1 += __builtin_amdgcn_cvt_scalef32_pk_f16_fp8(tx_, 1.0f, true) * w2; \
                a2 += __builtin_amdgcn_cvt_scalef32_pk_f16_fp8(ty_, 1.0f, false) * w2; a3 += __builtin_amdgcn_cvt_scalef32_pk_f16_fp8(ty_, 1.0f, true) * w2; } while (0)
#ifndef DN_REP
#define DN_REP 0
#endif
#define DN_ACC(B) do { _Pragma("unroll") for (int k = 0; k < 4; ++k) { DN_ONE(B[k].x); DN_ONE(B[k].y); DN_ONE(B[k].z); DN_ONE(B[k].w); } asm volatile("" ::: "memory"); \
            if (DN_REP) { const h2v s0_ = a0, s1_ = a1, s2_ = a2, s3_ = a3; for (int rep_ = 0; rep_ < DN_REP; ++rep_) { _Pragma("unroll") for (int k = 0; k < 4; ++k) { DN_ONE(B[k].x); DN_ONE(B[k].y); DN_ONE(B[k].z); DN_ONE(B[k].w); } \
                asm volatile("" :: "v"(a0), "v"(a1), "v"(a2), "v"(a3) : "memory"); } a0 = s0_; a1 = s1_; a2 = s2_; a3 = s3_; } } while (0)
        DN_LOAD(b0, 0); DN_LOAD(b1, 1); DN_LOAD(b2, 2);
        for (int bi = 0; bi < nb; bi += 8) {
            h2v a0 = {0, 0}, a1 = {0, 0}, a2 = {0, 0}, a3 = {0, 0};
            DN_LOAD(b3, bi + 3); DN_ACC(b0);
            DN_LOAD(b0, bi + 4); DN_ACC(b1);
            DN_LOAD(b1, bi + 5); DN_ACC(b2);
            DN_LOAD(b2, bi + 6); DN_ACC(b3);
            DN_LOAD(b3, bi + 7); DN_ACC(b0);
            DN_LOAD(b0, bi + 8); DN_ACC(b1);
            DN_LOAD(b1, bi + 9); DN_ACC(b2);
            DN_LOAD(b2, bi + 10); DN_ACC(b3);
            const int tg = DN_TG(bi); const float us = 1.f / 256.f;
            const uint4 yv = make_uint4(pk2((float)a0[0] * us, (float)a0[1] * us), pk2((float)a1[0] * us, (float)a1[1] * us), pk2((float)a2[0] * us, (float)a2[1] * us), pk2((float)a3[0] * us, (float)a3[1] * us));
            *(uint4*)(p.Y() + ((size_t)tg * 64 + F.lane) * D + 8 * sidx) = yv;
#if defined(DN_STORE_REP)
            for (int rep_ = 0; rep_ < DN_STORE_REP; ++rep_) { asm volatile("" ::: "memory"); __builtin_nontemporal_store(__builtin_bit_cast(u32x4_t, yv), (u32x4_t*)(p.Y() + ((size_t)tg * 64 + F.lane) * D + 8 * sidx)); }
#endif
        }
#undef DN_ACC
#undef DN_ONE
#undef DN_LOAD
#undef DN_PTR
#undef DN_TG
    }
}
__device__ __forceinline__ void phase12(const Prm& p, const Frame& F) {
    const int gw = F.bid * NWAVES + F.wave, NGW = F.G * NWAVES;
    float4 v[8]; uint2 xb[8], xn[8];
    if (gw < T) { const uint2* xr = (const uint2*)(p.X1B() + (size_t)gw * D) + F.lane;
#pragma unroll
        for (int j = 0; j < 8; ++j) xb[j] = xr[64 * j]; }
    for (int row = gw; row < T; row += NGW) {
        float4* zr = (float4*)(p.out + (size_t)row * D) + F.lane; float s = 0.f;
        if (row + NGW < T) { const uint2* xp = (const uint2*)(p.X1B() + (size_t)(row + NGW) * D) + F.lane;
#pragma unroll
            for (int j = 0; j < 8; ++j) xn[j] = xp[64 * j]; }
        const float* g2 = p.MOD() + (size_t)(row / S) * D6 + 5 * D;
#pragma unroll
        for (int j = 0; j < 8; ++j) { const uint2 y = *((const uint2*)(p.Y() + (size_t)row * D) + F.lane + 64 * j); const float4 g = *((const float4*)g2 + F.lane + 64 * j);
            v[j].x = ALPHA * bflo(xb[j].x) + g.x * bflo(y.x); v[j].y = ALPHA * bfhi(xb[j].x) + g.y * bfhi(y.x); v[j].z = ALPHA * bflo(xb[j].y) + g.z * bflo(y.y); v[j].w = ALPHA * bfhi(xb[j].y) + g.w * bfhi(y.y);
            s += (v[j].x + v[j].y) + (v[j].z + v[j].w); }
        const float mean = wave_sum(s) * (1.f / D); float s2 = 0.f;
#pragma unroll
        for (int j = 0; j < 8; ++j) { v[j].x -= mean; v[j].y -= mean; v[j].z -= mean; v[j].w -= mean; s2 += (v[j].x * v[j].x + v[j].y * v[j].y) + (v[j].z * v[j].z + v[j].w * v[j].w); }
        const float rstd = 1.f / sqrtf(wave_sum(s2) * (1.f / D) + LN_EPS);
#pragma unroll
        for (int j = 0; j < 8; ++j) { const float4 w = *((const float4*)p.ln2_w + F.lane + 64 * j), bb = *((const float4*)p.ln2_b + F.lane + 64 * j);
            zr[64 * j] = make_float4(v[j].x * rstd * w.x + bb.x, v[j].y * rstd * w.y + bb.y, v[j].z * rstd * w.z + bb.z, v[j].w * rstd * w.w + bb.w); }
#pragma unroll
        for (int j = 0; j < 8; ++j) xb[j] = xn[j];
    }
}

struct Args { const float* in[18]; float* out; unsigned char* ws; int ph_lo, ph_hi, li, pad; };
__global__ void __launch_bounds__(NTHR, 2) mk_fwd(Args args) {
    extern __shared__ __attribute__((aligned(16))) unsigned char lds_raw[];
    Frame F; F.lds = (LAS unsigned char*)lds_raw; F.tid = threadIdx.x; F.lane = F.tid & 63; F.wave = __builtin_amdgcn_readfirstlane(F.tid >> 6); F.G = gridDim.x; F.bid = blockIdx.x;
    Prm p; p.x = args.in[0]; p.c = args.in[1]; p.w_ada = args.in[2]; p.b_ada = args.in[3]; p.w_in = args.in[4]; p.b_in = args.in[5]; p.conv_w = args.in[6]; p.conv_b = args.in[7]; p.mnorm_w = args.in[8];
    p.w_out = args.in[9]; p.ln1_w = args.in[10]; p.ln1_b = args.in[11]; p.wq = args.in[12]; p.subkeys = args.in[13]; p.peer_u = args.in[14]; p.peer_v = args.in[15]; p.ln2_w = args.in[16]; p.ln2_b = args.in[17];
    p.out = args.out; p.ws = args.ws;
    volatile LAS unsigned* MISC = (volatile LAS unsigned*)(F.lds + MISC_OFF);
    for (int u = F.tid; u < (LDS_BYTES - LDSCTL_OFF) / 4; u += NTHR) ((LAS unsigned*)(F.lds + LDSCTL_OFF))[u] = 0u;
    __syncthreads();
    const int lo = args.ph_lo, hi = args.ph_hi;
    XcdBarrier bar; bar.bar = (unsigned*)(p.ws + WS_CTL) + CW_BAR + args.li * XCD_BAR_WORDS; bar.x = 0; bar.st = nullptr;
    if (hi - lo > 1) bar = xcd_barrier_post((unsigned*)(p.ws + WS_CTL) + CW_BAR + args.li * XCD_BAR_WORDS, MISC + 8);
#define IN(k) (lo <= (k) && (k) < hi)
#define SEAM(k) do { if (IN(k) && IN((k) + 1)) xcd_barrier(bar); } while (0)
    XW xw; xw.nx = (F.G % 8 == 0) ? 8 : 1; xw.vx = F.bid % xw.nx; xw.rank = F.bid / xw.nx; xw.nloc = F.G / xw.nx;
#define XW_FROM_CENSUS() do { if (hi - lo > 1) { if (F.tid == 0) { unsigned vx_ = 0u; for (unsigned j = 0; j < bar.x; ++j) vx_ += xb_ld(&bar.bar[XB_XCNT(j)]) > 0u ? 1u : 0u; MISC[11] = vx_; } __syncthreads(); \
        xw.vx = (int)MISC[11]; xw.nx = (int)MISC[9]; xw.rank = (int)MISC[10] - 1; xw.nloc = (int)MISC[8]; } } while (0)
    if (IN(0)) { phase0(p, F); deferred_prep<false, true, true>(p, F, 0, F.G); } SEAM(0);
    if (IN(1)) { phase1(p, F); } SEAM(1);
    if (IN(2)) { pg8::Gemm g{p.U(), p.WIN_T(), T, INM, D}; pg8::StaticOrder So; So.init(T, INM, F.G, F.bid);
        pg8::EpiBf16<0> E{p.PJ(), INM, p.b_in, 0, 0, 1.f};
        pg8::gemm_phase<pg8::EpiBf16<0>, pg8::StaticOrder, true, true>(F.lds, g, So, E); } SEAM(2);
    if (IN(3)) { const int nmb = F.G >= 2 ? F.G / 2 : 1;
#ifndef P3_REP_ML
#define P3_REP_ML 1
#define P3_REP_CONV 1
#endif
        if (F.bid < nmb) { for (int rep_ = 0; rep_ < P3_REP_ML; ++rep_) for (int u = F.bid; u < 2 * NB * MH * 2; u += nmb) ml::unit(p, F, u); if (F.G < 2) phase3a(p, F, 0, 1); }
        else { phase3a(p, F, nmb, F.G - nmb); deferred_prep<true, false, false>(p, F, nmb, F.G - nmb); }
        if (F.G < 2) deferred_prep<true, false, false>(p, F, 0, 1); } SEAM(3);
    if (IN(4)) { phase4(p, F); } SEAM(4);
    if (IN(5)) { pg8::Gemm g{p.Y(), p.WOUT_T(), T, D, D}; pg8::StaticOrder So; So.init(T, D, F.G, F.bid);
        EpiZ E{p.x, p.MOD(), (bf16_t*)p.out};
        pg8::gemm_phase<EpiZ, pg8::StaticOrder, true, true>(F.lds, g, So, E); } SEAM(5);
    if (IN(6)) { phase6(p, F); } SEAM(6);
    if (IN(7)) { pg8::Gemm g{p.U(), p.WQ_T(), T, NQ, D}; pg8::StaticOrder So; So.init(T, NQ, F.G, F.bid);
        EpiF32 E{p.SC(), NSC};
        pg8::gemm_phase<EpiF32, pg8::StaticOrder, true, true>(F.lds, g, So, E); } SEAM(7);
    if (IN(8)) { phase8(p, F); } SEAM(8);
    if (IN(9)) { if (lo < 9) XW_FROM_CENSUS(); phase9(p, F, xw); } SEAM(9);
    if (IN(10)) { phase10(p, F); } SEAM(10);
    if (IN(11)) { phase11(p, F); } SEAM(11);
    if (IN(12)) { phase12(p, F); }
#undef IN
#undef SEAM
}

extern "C" void kernel_launch(void* const* d_in, const int* in_sizes, int n_in, void* d_out, int out_size, void* d_ws, size_t ws_size, hipStream_t stream) {
    static int grid = 0;
    if (grid == 0) {
        if (n_in != 18 || out_size != T * D || ws_size < WS_END) { fprintf(stderr, "kernel_launch: unexpected shapes (n_in %d out %d ws %zu, need %zu)\n", n_in, out_size, ws_size, (size_t)WS_END); grid = -1; return; }
        int dev = 0, cus = 0, per_cu = 0;
        if (hipGetDevice(&dev) != hipSuccess || hipDeviceGetAttribute(&cus, hipDeviceAttributeMultiprocessorCount, dev) != hipSuccess) { grid = -1; return; }
        if (hipFuncSetAttribute((const void*)mk_fwd, hipFuncAttributeMaxDynamicSharedMemorySize, LDS_BYTES) != hipSuccess) { fprintf(stderr, "kernel_launch: hipFuncSetAttribute failed\n"); grid = -1; return; }
        if (hipOccupancyMaxActiveBlocksPerMultiprocessor(&per_cu, (const void*)mk_fwd, NTHR, LDS_BYTES) != hipSuccess || per_cu < 1) { fprintf(stderr, "kernel_launch: occupancy query says %d\n", per_cu); }
        (void)hipGetLastError();
        grid = cus;
        if (T % grid != 0 || (T / grid) % NWAVES != 0) { fprintf(stderr, "kernel_launch: grid %d does not divide the rows\n", grid); grid = -1; return; }
    }
    if (grid < 0) return;
    (void)hipMemsetAsync((char*)d_ws + WS_CTL, 0, 1u << 20, stream);
    Args a{};
    for (int i = 0; i < 18; ++i) a.in[i] = (const float*)d_in[i];
    a.out = (float*)d_out; a.ws = (unsigned char*)d_ws;
#if defined(PROBE_A)
    a.ph_lo = 0; a.ph_hi = PROBE_B + 1; a.li = 0; hipLaunchKernelGGL(mk_fwd, dim3(grid), dim3(NTHR), LDS_BYTES, stream, a);
    a.ph_lo = PROBE_A; a.ph_hi = NPHASE; a.li = 1; hipLaunchKernelGGL(mk_fwd, dim3(grid), dim3(NTHR), LDS_BYTES, stream, a);
#elif MK_N_LAUNCHES == 1
    a.ph_lo = 0; a.ph_hi = NPHASE;
    hipLaunchKernelGGL(mk_fwd, dim3(grid), dim3(NTHR), LDS_BYTES, stream, a);
#else
    for (int k = 0; k < NPHASE; ++k) { a.ph_lo = k; a.ph_hi = k + 1; hipLaunchKernelGGL(mk_fwd, dim3(grid), dim3(NTHR), LDS_BYTES, stream, a); }
#endif
}
```

```cpp
#define MK_N_LAUNCHES 1
#if defined(HOST_EMU)
#include <cmath>
#include <cstdint>
#include <cstring>
#include <cstddef>
#define HD inline
#define HDF inline
#else
#include <hip/hip_runtime.h>
#define HD __host__ __device__ __forceinline__
#define HDF __host__ __device__ __forceinline__
#endif

#ifndef CFG_D
#define CFG_D 2048
#define CFG_B 8
#define CFG_S 2048
#define CFG_PH 8
#define CFG_NK 128
#define CFG_TOPK 16
#define CFG_KD 256
#endif
constexpr int D = CFG_D, NB = CFG_B, S = CFG_S, T = NB * S;
constexpr int CW = D / 2, MW = D - CW, MH = 4, MV = MW / MH, QK = MV / 2, NG = 16, CHUNK = 64;
constexpr int INC = 3 * CW + 2 * MH * QK + 2 * MW + NG;
constexpr int INM = INC - NG;
constexpr int O_GB = 0, O_GC = CW, O_HIN = 2 * CW, O_Q = 3 * CW, O_K = O_Q + MH * QK, O_V = O_K + MH * QK, O_O = O_V + MW;
constexpr int PH = CFG_PH, NK = CFG_NK, TOPK = CFG_TOPK, KD = CFG_KD, KH = KD / 2, NE = NK * NK, NSLOT = PH * TOPK;
constexpr int NQ = PH * KD;
static_assert(PH * 2 * NK == NQ || true, "");
constexpr int NSC = PH * 2 * NK;
constexpr float LN_EPS = 1e-5f;
constexpr float ALPHA = 1.189207115002721f;
constexpr int D6 = 6 * D;

typedef unsigned short bf16_t;
HDF unsigned f_as_u(float f) { unsigned u; memcpy(&u, &f, 4); return u; }
HDF float u_as_f(unsigned u) { float f; memcpy(&f, &u, 4); return f; }
HDF bf16_t f2bf(float f) { unsigned u = f_as_u(f); return (bf16_t)((u + 0x7fffu + ((u >> 16) & 1u)) >> 16); }
HDF float bf2f(bf16_t h) { return u_as_f((unsigned)h << 16); }

constexpr size_t al(size_t x) { return (x + 1048575) & ~(size_t)1048575; }
constexpr size_t WS_CTL = 0;
constexpr size_t WS_MOD = al(1);
constexpr size_t WS_MODP = WS_MOD + al((size_t)NB * D6 * 4);
constexpr int NKS = 32;
constexpr size_t WS_GATES = WS_MODP + al((size_t)NKS * NB * D6 * 4);
constexpr size_t WS_DEN = WS_GATES + al((size_t)T * NG * 4);
constexpr size_t WS_FLR = WS_DEN + al((size_t)4 * T * MH * 4);
constexpr size_t WS_EIDX = WS_FLR + al((size_t)2 * T * MH * 4);
constexpr size_t WS_EW = WS_EIDX + al((size_t)T * NSLOT * 4);
constexpr size_t WS_WIN_T = WS_EW + al((size_t)T * NSLOT * 4);
constexpr size_t WS_WOUT_T = WS_WIN_T + al((size_t)INM * D * 2);
constexpr size_t WS_WQ_T = WS_WOUT_T + al((size_t)D * D * 2);
constexpr size_t WS_PU16 = WS_WQ_T + al((size_t)NQ * D * 2);
constexpr size_t WS_PV16 = WS_PU16 + al((size_t)NE * D * 2);
constexpr size_t WS_U = WS_PV16 + al((size_t)NE * D * 2);
constexpr size_t WS_Y = WS_U + al((size_t)T * D * 2);
constexpr size_t WS_P = WS_Y + al((size_t)T * D * 2);
constexpr size_t WS_SC = WS_P;
constexpr size_t WS_TS = WS_SC + al((size_t)T * NSC * 4);
constexpr size_t WS_TI = WS_TS + al((size_t)T * PH * 2 * TOPK * 4);
constexpr size_t WS_P_END = WS_P + al((size_t)T * INM * 2);
constexpr size_t WS_TI_END = WS_TI + al((size_t)T * PH * 2 * TOPK * 4);
constexpr size_t WS_END = WS_P_END > WS_TI_END ? WS_P_END : WS_TI_END;

struct Prm {
    const float *x, *c, *w_ada, *b_ada, *w_in, *b_in, *conv_w, *conv_b, *mnorm_w, *w_out, *ln1_w, *ln1_b, *wq, *subkeys, *peer_u, *peer_v, *ln2_w, *ln2_b;
    float* out;
    unsigned char* ws;
    HDF float* MOD() const { return (float*)(ws + WS_MOD); }
    HDF float* MODP() const { return (float*)(ws + WS_MODP); }
    HDF float* BIN256() const { return (float*)(ws + WS_MODP); }
    HDF float* GATES() const { return (float*)(ws + WS_GATES); }
    HDF float* DEN() const { return (float*)(ws + WS_DEN); }
    HDF float* FLR() const { return (float*)(ws + WS_FLR); }
    HDF int* EIDX() const { return (int*)(ws + WS_EIDX); }
    HDF float* EW() const { return (float*)(ws + WS_EW); }
    HDF bf16_t* WIN_T() const { return (bf16_t*)(ws + WS_WIN_T); }
    HDF unsigned char* WIN8() const { return ws + WS_WIN_T; }
    HDF unsigned char* U8() const { return ws + WS_U; }
    HDF bf16_t* WOUT_T() const { return (bf16_t*)(ws + WS_WOUT_T); }
    HDF bf16_t* WQ_T() const { return (bf16_t*)(ws + WS_WQ_T); }
    HDF bf16_t* PU16() const { return (bf16_t*)(ws + WS_PU16); }
    HDF bf16_t* PV16() const { return (bf16_t*)(ws + WS_PV16); }
    HDF unsigned char* PU8() const { return ws + WS_PU16; }
    HDF unsigned char* PV8() const { return ws + WS_PV16; }
    HDF unsigned char* PV8S() const { return ws + WS_PV16; }
    HDF float* RSU() const { return (float*)(ws + WS_PU16 + (size_t)NE * D); }
    HDF float* RSV() const { return (float*)(ws + WS_PU16 + (size_t)NE * D + (size_t)NE * 4); }
    HDF bf16_t* U() const { return (bf16_t*)(ws + WS_U); }
    HDF bf16_t* Y() const { return (bf16_t*)(ws + WS_Y); }
    HDF bf16_t* PJ() const { return (bf16_t*)(ws + WS_P); }
    HDF float* SC() const { return (float*)(ws + WS_SC); }
    HDF bf16_t* X1B() const { return (bf16_t*)(ws + WS_TS); }
    HDF float* TS() const { return (float*)(ws + WS_TS); }
    HDF int* TI() const { return (int*)(ws + WS_TI); }
    HDF float* HF() const { return out; }
    HDF float* HB() const { return out + (size_t)T * MW; }
    HDF bf16_t* HF16() const { return (bf16_t*)out; }
    HDF bf16_t* HB16() const { return (bf16_t*)out + (size_t)T * MW; }
};

HDF float sigmoidf_(float x) { return 1.f / (1.f + expf(-x)); }
HDF float logsigmoidf_(float x) { return fminf(x, 0.f) - log1pf(expf(-fabsf(x))); }
HDF float gelu_exact(float x) { return 0.5f * x * (1.f + erff(x * 0.7071067811865476f)); }

HD void b_ada(const Prm& p, long n) {
    float acc[NB];
#pragma unroll
    for (int b = 0; b < NB; ++b) acc[b] = 0.f;
    for (int k = 0; k < D; ++k) {
        const float w = p.w_ada[(size_t)k * D6 + n];
#pragma unroll
        for (int b = 0; b < NB; ++b) { const float cv = p.c[b * D + k]; acc[b] += cv * sigmoidf_(cv) * w; }
    }
#pragma unroll
    for (int b = 0; b < NB; ++b) p.MOD()[(size_t)b * D6 + n] = acc[b] + p.b_ada[n];
}
HD void b_wt(const float* W, int ldw, int K, bf16_t* WT, long i) { const long n = i / K, k = i % K; WT[i] = f2bf(W[(size_t)k * ldw + n]); }
HD void b_tab(const float* src, bf16_t* dst, long i) { dst[i] = f2bf(src[i]); }
HD void b_ln_mod1(const Prm& p, long row) {
    const float* xr = p.x + (size_t)row * D; const int b = (int)(row / S);
    const float* sh = p.MOD() + (size_t)b * D6; const float* sc = sh + D;
    float s = 0.f; for (int d = 0; d < D; ++d) s += xr[d];
    const float mean = s / D; float q = 0.f; for (int d = 0; d < D; ++d) { const float t = xr[d] - mean; q += t * t; }
    const float rstd = 1.f / sqrtf(q / D + LN_EPS);
    for (int d = 0; d < D; ++d) p.U()[(size_t)row * D + d] = f2bf((xr[d] - mean) * rstd * (1.f + sc[d]) + sh[d]);
}
HD void b_gates(const Prm& p, long i) {
    const long row = i / NG; const int g = (int)(i % NG); float acc = 0.f;
    for (int d = 0; d < D; ++d) acc += bf2f(p.U()[(size_t)row * D + d]) * p.w_in[(size_t)d * INC + INM + g];
    p.GATES()[i] = acc + p.b_in[INM + g];
}
HD float b_dot16(const bf16_t* a, const bf16_t* b, int K) { float acc = 0.f; for (int k = 0; k < K; ++k) acc += bf2f(a[k]) * bf2f(b[k]); return acc; }
HD void b_gemm1(const Prm& p, long i) { const long row = i / INM; const int n = (int)(i % INM);
    p.PJ()[i] = f2bf(b_dot16(p.U() + (size_t)row * D, p.WIN_T() + (size_t)n * D, D) + p.b_in[n]); }
HD void b_conv(const Prm& p, long i) {
    const long row = i / CW; const int ch = (int)(i % CW); const int s = (int)(row % S);
    const bf16_t* pj = p.PJ(); float acc = p.conv_b[ch];
#pragma unroll
    for (int k = 0; k < 3; ++k) { const int s2 = s + k - 1; if (s2 >= 0 && s2 < S) { const size_t r2 = (size_t)(row + k - 1) * INM;
        acc += p.conv_w[k * CW + ch] * (bf2f(pj[r2 + O_GC + ch]) * bf2f(pj[r2 + O_HIN + ch])); } }
    p.Y()[(size_t)row * D + ch] = f2bf(bf2f(pj[(size_t)row * INM + O_GB + ch]) * acc);
}
HDF long ml_tok(int dir, int b, int pos) { return (long)b * S + (dir ? S - 1 - pos : pos); }
HD void b_mscan(const Prm& p, long i) {
    const int v = (int)(i % (MV + 1)), h = (int)((i / (MV + 1)) % MH), b = (int)((i / ((MV + 1) * MH)) % NB), dir = (int)(i / ((MV + 1) * MH * NB));
    float C[QK];
#pragma unroll
    for (int d = 0; d < QK; ++d) C[d] = 0.f;
    float m = 0.f; const float qs = 1.f / sqrtf((float)QK);
    float* H = dir ? p.HB() : p.HF();
    for (int pos = 0; pos < S; ++pos) {
        const long tok = ml_tok(dir, b, pos); const float* g = p.GATES() + tok * NG + dir * 8;
        const float ig = g[h], lf = logsigmoidf_(g[4 + h]);
        const float mn = fmaxf(lf + m, ig), dec = expf(lf + m - mn), wi = expf(ig - mn); m = mn;
        const bf16_t* pj = p.PJ() + (size_t)tok * INM; const float wv = wi * (v < MV ? bf2f(pj[O_V + h * MV + (v < MV ? v : 0)]) : 1.f); float num = 0.f;
#pragma unroll
        for (int d = 0; d < QK; ++d) { C[d] = dec * C[d] + wv * bf2f(pj[O_K + h * QK + d]); num += bf2f(pj[O_Q + h * QK + d]) * qs * C[d]; }
        if (v < MV) H[(size_t)tok * MW + h * MV + v] = num;
        else { p.DEN()[((size_t)dir * T + tok) * MH + h] = num; p.FLR()[((size_t)dir * T + tok) * MH + h] = expf(-mn); }
    }
}
HD void b_headnorm(const Prm& p, long i) {
    const long row = i / MH; const int h = (int)(i % MH);
    const float* hf = p.HF() + (size_t)row * MW + h * MV; const float* hb = p.HB() + (size_t)row * MW + h * MV;
    const float inf_ = 1.f / fmaxf(fabsf(p.DEN()[(size_t)row * MH + h]), p.FLR()[(size_t)row * MH + h]);
    const float inb_ = 1.f / fmaxf(fabsf(p.DEN()[((size_t)T + row) * MH + h]), p.FLR()[((size_t)T + row) * MH + h]);
    float s = 0.f; for (int v = 0; v < MV; ++v) s += hf[v] * inf_ + hb[v] * inb_;
    const float mean = s / MV; float q = 0.f; for (int v = 0; v < MV; ++v) { const float t = hf[v] * inf_ + hb[v] * inb_ - mean; q += t * t; }
    const float rstd = 1.f / sqrtf(q / MV + LN_EPS);
    for (int v = 0; v < MV; ++v) { const float hn = (hf[v] * inf_ + hb[v] * inb_ - mean) * rstd * p.mnorm_w[h * MV + v];
        const float og = sigmoidf_(bf2f(p.PJ()[(size_t)row * INM + O_O + h * MV + v]));
        p.Y()[(size_t)row * D + CW + h * MV + v] = f2bf(og * hn); }
}
HD void b_gemm2(const Prm& p, long i) { const long row = i / D; const int n = (int)(i % D); const int b = (int)(row / S);
    const float acc = b_dot16(p.Y() + (size_t)row * D, p.WOUT_T() + (size_t)n * D, D);
    p.out[i] = ALPHA * p.x[i] + p.MOD()[(size_t)b * D6 + 2 * D + n] * acc; }
HD void b_ln_mid(const Prm& p, long row) {
    float* zr = p.out + (size_t)row * D; const int b = (int)(row / S);
    const float* sh = p.MOD() + (size_t)b * D6 + 3 * D; const float* sc = sh + D;
    float s = 0.f; for (int d = 0; d < D; ++d) s += zr[d];
    float mean = s / D; float q = 0.f; for (int d = 0; d < D; ++d) { const float t = zr[d] - mean; q += t * t; }
    float rstd = 1.f / sqrtf(q / D + LN_EPS);
    s = 0.f; for (int d = 0; d < D; ++d) { const float x1 = (zr[d] - mean) * rstd * p.ln1_w[d] + p.ln1_b[d]; zr[d] = x1; s += x1; }
    mean = s / D; q = 0.f; for (int d = 0; d < D; ++d) { const float t = zr[d] - mean; q += t * t; }
    rstd = 1.f / sqrtf(q / D + LN_EPS);
    for (int d = 0; d < D; ++d) p.U()[(size_t)row * D + d] = f2bf((zr[d] - mean) * rstd * (1.f + sc[d]) + sh[d]);
}
HD void b_gemm3(const Prm& p, long i) { const long row = i / NQ; const int n = (int)(i % NQ);
    p.Y()[i] = f2bf(b_dot16(p.U() + (size_t)row * D, p.WQ_T() + (size_t)n * D, D)); }
HD void b_scores(const Prm& p, long i) { const long tok = i / NSC; const int c = (int)(i % NSC), grp = c / NK, n = c % NK;
    const bf16_t* q = p.Y() + (size_t)tok * NQ + grp * KH; const float* sk = p.subkeys + ((size_t)grp * NK + n) * KH; float acc = 0.f;
    for (int d = 0; d < KH; ++d) acc += bf2f(q[d]) * sk[d];
    p.SC()[i] = acc; }
HD void b_topk1(const Prm& p, long i) {
    const float* sc = p.SC() + (size_t)i * NK; float pv = INFINITY; int pi = -1;
    for (int r = 0; r < TOPK; ++r) { float best = -INFINITY; int bi = -1;
        for (int n = 0; n < NK; ++n) { const float v = sc[n]; const bool ok = (v < pv) || (v == pv && n > pi); if (ok && v > best) { best = v; bi = n; } }
        p.TS()[(size_t)i * TOPK + r] = best; p.TI()[(size_t)i * TOPK + r] = bi; pv = best; pi = bi; }
}
HD void b_topk2(const Prm& p, long i) {
    const float* s0 = p.TS() + (size_t)i * 2 * TOPK; const float* s1 = s0 + TOPK; const int* i0 = p.TI() + (size_t)i * 2 * TOPK; const int* i1 = i0 + TOPK;
    float pv = INFINITY; int pi = -1; float mx = 0.f, sum = 0.f;
    for (int r = 0; r < TOPK; ++r) { float best = -INFINITY; int bi = -1;
        for (int c = 0; c < TOPK * TOPK; ++c) { const float v = s0[c / TOPK] + s1[c % TOPK]; const bool ok = (v < pv) || (v == pv && c > pi); if (ok && v > best) { best = v; bi = c; } }
        if (r == 0) mx = best;
        const float e = expf(best - mx); sum += e;
        p.EIDX()[(size_t)i * TOPK + r] = i0[bi / TOPK] * NK + i1[bi % TOPK]; p.EW()[(size_t)i * TOPK + r] = e; pv = best; pi = bi; }
    for (int r = 0; r < TOPK; ++r) p.EW()[(size_t)i * TOPK + r] /= sum;
}
HD void b_up(const Prm& p, long i) { const long tok = i / NSLOT; const int e = p.EIDX()[i];
    p.EW()[i] *= gelu_exact(b_dot16(p.U() + (size_t)tok * D, p.PU16() + (size_t)e * D, D)); }
HD void b_down(const Prm& p, long i) { const long tok = i / D; const int d = (int)(i % D); const int b = (int)(tok / S); float y = 0.f;
    for (int sl = 0; sl < NSLOT; ++sl) y += p.EW()[tok * NSLOT + sl] * bf2f(p.PV16()[(size_t)p.EIDX()[tok * NSLOT + sl] * D + d]);
    p.out[i] = ALPHA * p.out[i] + p.MOD()[(size_t)b * D6 + 5 * D + d] * y; }
HD void b_ln2(const Prm& p, long row) {
    float* zr = p.out + (size_t)row * D;
    float s = 0.f; for (int d = 0; d < D; ++d) s += zr[d];
    const float mean = s / D; float q = 0.f; for (int d = 0; d < D; ++d) { const float t = zr[d] - mean; q += t * t; }
    const float rstd = 1.f / sqrtf(q / D + LN_EPS);
    for (int d = 0; d < D; ++d) zr[d] = (zr[d] - mean) * rstd * p.ln2_w[d] + p.ln2_b[d];
}
#include <cstdio>
#define LAS __attribute__((address_space(3)))
#define GAS __attribute__((address_space(1)))
namespace pg8 {
#define PG8_LAS __attribute__((address_space(3)))
typedef unsigned short bf16_t;
typedef short bf16x8 __attribute__((ext_vector_type(8)));
typedef float f32x4 __attribute__((ext_vector_type(4)));
typedef unsigned u32x4 __attribute__((ext_vector_type(4)));
constexpr int BM = 256, BK = 64, HALF = 128, HTB = HALF * BK * 2  , STAGE_BYTES = 8 * HTB, NXCD = 8, WGM = 8;

__host__ __device__ __forceinline__ int lds_byte(int r, int c) { const int st = (r >> 4) * 2 + (c >> 5), rr = r & 15, cc = c & 31, ob = rr * 64 + cc * 2; return st * 1024 + (ob ^ (((ob >> 9) & 1) << 5)); }
__host__ __device__ __forceinline__ void stage_rc(int b, int& R, int& C) { const int st = b / 1024, sb = b % 1024, swz = sb ^ (((sb >> 9) & 1) << 5); R = (st >> 1) * 16 + swz / 64; C = (st & 1) * 32 + (swz % 64) / 2; }
__host__ __device__ __forceinline__ int perm32(int rho) { const int n = rho >> 4, i = rho & 15; return 8 * (i >> 2) + 4 * n + (i & 3); }

struct Unit { int pm, pn; };
struct Gemm { const bf16_t* A; const bf16_t* Bt; int M, N, K; };

struct StaticOrder {
    int nM, nN, nwg, G, c;
    __host__ __device__ void init(int M, int N, int G_, int c_) { nM = M / BM; nN = N / BM; nwg = nM * nN; G = G_; c = c_; }
    __host__ __device__ bool next(int i, Unit& u) const {
        const long L = (long)i * G + c; if (L >= nwg) return false;
        int wgid = (int)L; { const int q = nwg / NXCD, r = nwg % NXCD, xcd = wgid % NXCD, off = wgid / NXCD; wgid = (xcd < r ? xcd * (q + 1) : r * (q + 1) + (xcd - r) * q) + off; }
        const int nig = WGM * nN, gid = wgid / nig, fm = gid * WGM, gsz = (nM - fm) < WGM ? (nM - fm) : WGM;
        u.pm = fm + ((wgid % nig) % gsz); u.pn = (wgid % nig) / gsz; return true;
    }
    __device__ __forceinline__ void a_ready(const Unit&) const {}
    __device__ __forceinline__ void done(const Unit&) const {}
};

__device__ __forceinline__ unsigned cvt_pk_bf16(float lo, float hi) { unsigned r; asm volatile("v_cvt_pk_bf16_f32 %0, %1, %2" : "=v"(r) : "v"(lo), "v"(hi)); return r; }
typedef float f32x2 __attribute__((ext_vector_type(2)));
__device__ __forceinline__ f32x2 gelu_pk(f32x2 v) {
    const f32x2 av = __builtin_elementwise_abs(v), d = av * 0.2316418882f + 1.0f;
    f32x2 t; t.x = __builtin_amdgcn_rcpf(d.x); t.y = __builtin_amdgcn_rcpf(d.y);
    f32x2 q = t * 0.5307027145f + (-0.7265760135f); q = q * t + 0.7107068705f; q = q * t + (-0.142248368f); q = q * t + 0.127414796f; q = q * t;
    const f32x2 s = (v * v) * (-0.72134752044f);
    f32x2 e; e.x = __builtin_amdgcn_exp2f(s.x); e.y = __builtin_amdgcn_exp2f(s.y);
    const f32x2 m = v * (q * e), r = v - m;
    f32x2 o; o.x = v.x < 0.f ? m.x : r.x; o.y = v.y < 0.f ? m.y : r.y; return o;
}

template <int ACT  > struct EpiBf16 {
    static constexpr bool PERM = true, AFTER_DRAIN = false; static_assert(ACT == 0 || ACT == 1, "EpiBf16: ACT is 0 (none) or 1 (gelu_pk)");
    bf16_t* O; int ldc; const float* bias; int split_cols; size_t split_stride; float scale0;
    __device__ __forceinline__ void operator()(const f32x4 (&acc)[2][2][4][2], const Unit& u, int wr, int wc, int fr, int fq) const {
        const int row0 = u.pm * BM + wr * 64 + fr; int colt = u.pn * BM; bf16_t* base = O;
        float sc = 1.f; if (split_cols) { const int t = colt / split_cols; base += (size_t)t * split_stride; colt -= t * split_cols; if (t == 0) sc = scale0; }
        const int col0 = colt + wc * 32 + 8 * fq, bcol0 = u.pn * BM + wc * 32 + 8 * fq;
        f32x4 bv[2][2];
#pragma unroll
        for (int bj = 0; bj < 2; ++bj)
#pragma unroll
            for (int n = 0; n < 2; ++n) bv[bj][n] = bias ? *(const f32x4*)(bias + bcol0 + bj * HALF + 4 * n) : (f32x4){0.f, 0.f, 0.f, 0.f};
#pragma unroll
        for (int ai = 0; ai < 2; ++ai)
#pragma unroll
            for (int m = 0; m < 4; ++m) { bf16_t* rowp = base + (size_t)(row0 + ai * HALF + m * 16) * ldc + col0;
#pragma unroll
                for (int bj = 0; bj < 2; ++bj) { f32x4 v0 = acc[ai][bj][m][0] + bv[bj][0], v1 = acc[ai][bj][m][1] + bv[bj][1];
                    if (ACT == 1) { f32x2 a = gelu_pk((f32x2){v0[0], v0[1]}), b = gelu_pk((f32x2){v0[2], v0[3]}), c = gelu_pk((f32x2){v1[0], v1[1]}), d = gelu_pk((f32x2){v1[2], v1[3]});
                        v0 = (f32x4){a.x, a.y, b.x, b.y}; v1 = (f32x4){c.x, c.y, d.x, d.y}; }
                    v0 = v0 * sc; v1 = v1 * sc; u32x4 w; w.x = cvt_pk_bf16(v0[0], v0[1]); w.y = cvt_pk_bf16(v0[2], v0[3]); w.z = cvt_pk_bf16(v1[0], v1[1]); w.w = cvt_pk_bf16(v1[2], v1[3]);
                    *(u32x4*)(rowp + bj * HALF) = w; } }
    }
};
template <class Epi, class Sched, bool ALIGN_EPI = false, bool SP2 = false>
__device__ __forceinline__ void gemm_phase(PG8_LAS unsigned char* lds, const Gemm g, const Sched& S, const Epi& E) {
    const int tid = threadIdx.x, wid = __builtin_amdgcn_readfirstlane(tid >> 6), lane = tid & 63, wr = wid >> 2, wc = wid & 3, fr = lane & 15, fq = lane >> 4;
    const int K = g.K, nt = K / BK;
    unsigned voffA[2], voffB[2];
#pragma unroll
    for (int i = 0; i < 2; ++i) { int R, C; stage_rc(tid * 16 + i * 8192, R, C); const int Rb = Epi::PERM ? ((R & ~31) + perm32(R & 31)) : R;
        voffA[i] = (unsigned)(R * K + C) * 2u; voffB[i] = (unsigned)(Rb * K + C) * 2u; }
    const size_t kstep = (size_t)(BK * 2);
    const size_t hstep = (size_t)HALF * K * 2;
    const size_t tstep = 2 * hstep;
    const unsigned ldsw = (unsigned)wid * 1024u;
    const int aoff = lds_byte(wr * 64 + fr, fq * 8), boff = lds_byte(wc * 32 + fr, fq * 8);
#define PG8_SA(b, h) (((b) * 2 + (h)) * HTB)
#define PG8_SB(b, h) ((4 + (b) * 2 + (h)) * HTB)
#define PG8_STAGE(bufoff, gbase, voff) do { _Pragma("unroll") for (int _i = 0; _i < 2; ++_i) \
        __builtin_amdgcn_global_load_lds((const unsigned*)((const char*)(gbase) + (voff)[_i]), (PG8_LAS unsigned*)(lds + (bufoff) + ldsw + _i * 8192), 16, 0, 0); } while (0)
#define PG8_LDA(dst, b, h) do { _Pragma("unroll") for (int m = 0; m < 4; ++m) _Pragma("unroll") for (int k = 0; k < 2; ++k) dst[m][k] = *(const PG8_LAS bf16x8*)(lds + PG8_SA(b, h) + aoff + m * 2048 + k * 1024); } while (0)
#define PG8_LDB(dst, b, h) do { _Pragma("unroll") for (int n = 0; n < 2; ++n) _Pragma("unroll") for (int k = 0; k < 2; ++k) dst[n][k] = *(const PG8_LAS bf16x8*)(lds + PG8_SB(b, h) + boff + n * 2048 + k * 1024); } while (0)
#define PG8_MMA(ai, bj, At, Bt) do { __builtin_amdgcn_s_setprio(1); _Pragma("unroll") for (int m = 0; m < 4; ++m) _Pragma("unroll") for (int n = 0; n < 2; ++n) _Pragma("unroll") for (int k = 0; k < 2; ++k) \
        acc[ai][bj][m][n] = __builtin_amdgcn_mfma_f32_16x16x32_bf16(Bt[n][k], At[m][k], acc[ai][bj][m][n], 0, 0, 0); __builtin_amdgcn_s_setprio(0); } while (0)
#define PG8_WAIT_V(n) asm volatile("s_waitcnt vmcnt(" #n ")" ::: "memory")
#define PG8_WAIT_L(n) asm volatile("s_waitcnt lgkmcnt(" #n ")" ::: "memory")
#define PG8_BAR __builtin_amdgcn_s_barrier()
#define PG8_SCHED __builtin_amdgcn_sched_barrier(0)
    Unit cur, nxt; int ui = 0;
    if (!S.next(0, cur)) return;
    f32x4 acc[2][2][4][2];
#pragma unroll
    for (int a = 0; a < 2; ++a)
#pragma unroll
        for (int b = 0; b < 2; ++b)
#pragma unroll
            for (int m = 0; m < 4; ++m)
#pragma unroll
                for (int n = 0; n < 2; ++n) acc[a][b][m][n] = (f32x4){0.f, 0.f, 0.f, 0.f};
    bf16x8 At[4][2], B0[2][2], B1[2][2];
    const char* cA = (const char*)g.A + (size_t)cur.pm * tstep; const char* cB = (const char*)g.Bt + (size_t)cur.pn * tstep;
    S.a_ready(cur);
    if constexpr (SP2) {
        PG8_STAGE(PG8_SB(0, 0), cB, voffB); PG8_STAGE(PG8_SB(0, 1), cB + hstep, voffB); PG8_STAGE(PG8_SA(0, 0), cA, voffA); PG8_STAGE(PG8_SA(0, 1), cA + hstep, voffA);
        if (wr == 1) PG8_BAR;
        PG8_WAIT_V(2); PG8_BAR;
        PG8_STAGE(PG8_SB(1, 0), cB + kstep, voffB); PG8_STAGE(PG8_SA(1, 0), cA + kstep, voffA); PG8_STAGE(PG8_SB(1, 1), cB + hstep + kstep, voffB);
        PG8_WAIT_V(6); PG8_BAR;
    } else {
        PG8_STAGE(PG8_SB(0, 0), cB, voffB); PG8_STAGE(PG8_SA(0, 0), cA, voffA); PG8_STAGE(PG8_SB(0, 1), cB + hstep, voffB); PG8_STAGE(PG8_SA(0, 1), cA + hstep, voffA);
        if (wr == 1) PG8_BAR;
        PG8_WAIT_V(4); PG8_BAR;
        PG8_STAGE(PG8_SB(1, 0), cB + kstep, voffB); PG8_STAGE(PG8_SA(1, 0), cA + kstep, voffA); PG8_STAGE(PG8_SB(1, 1), cB + hstep + kstep, voffB);
        PG8_WAIT_V(6); PG8_BAR;
    }
    for (;;) {
        const bool has_next = S.next(ui + 1, nxt);
        const char* nA = has_next ? (const char*)g.A + (size_t)nxt.pm * tstep : cA; const char* nB = has_next ? (const char*)g.Bt + (size_t)nxt.pn * tstep : cB;
        for (int t = 0; t < nt; t += 2) {
            const bool last = (t == nt - 2);
            const char* a1 = cA + (size_t)(t + 1) * kstep;
            const char* a2 = last ? nA : cA + (size_t)(t + 2) * kstep; const char* b2 = last ? nB : cB + (size_t)(t + 2) * kstep;
            const char* a3 = a2 + kstep; const char* b3 = b2 + kstep;
            if (last && has_next) S.a_ready(nxt);
            if constexpr (SP2) {
            PG8_LDB(B0, 0, 0); PG8_LDB(B1, 0, 1); PG8_SCHED; PG8_LDA(At, 0, 0); PG8_STAGE(PG8_SA(1, 1), a1 + hstep, voffA);
            PG8_WAIT_V(8); PG8_WAIT_L(0); PG8_BAR; PG8_MMA(0, 0, At, B0); PG8_MMA(0, 1, At, B1); PG8_BAR; PG8_SCHED;
            PG8_LDA(At, 0, 1); PG8_STAGE(PG8_SB(0, 0), b2, voffB); PG8_STAGE(PG8_SB(0, 1), b2 + hstep, voffB); PG8_STAGE(PG8_SA(0, 0), a2, voffA);
            PG8_WAIT_V(8); PG8_WAIT_L(0); PG8_BAR; PG8_MMA(1, 0, At, B0); PG8_MMA(1, 1, At, B1); PG8_BAR; PG8_SCHED;
            PG8_LDB(B0, 1, 0); PG8_LDB(B1, 1, 1); PG8_SCHED; PG8_LDA(At, 1, 0); PG8_STAGE(PG8_SA(0, 1), a2 + hstep, voffA);
            PG8_WAIT_V(8); PG8_WAIT_L(0); PG8_BAR; PG8_MMA(0, 0, At, B0); PG8_MMA(0, 1, At, B1); PG8_BAR; PG8_SCHED;
            PG8_LDA(At, 1, 1); PG8_STAGE(PG8_SB(1, 0), b3, voffB); PG8_STAGE(PG8_SB(1, 1), b3 + hstep, voffB); PG8_STAGE(PG8_SA(1, 0), a3, voffA);
            PG8_WAIT_V(8); PG8_WAIT_L(0); PG8_BAR; PG8_MMA(1, 0, At, B0); PG8_MMA(1, 1, At, B1); PG8_BAR; PG8_SCHED;
            } else {
            PG8_LDB(B0, 0, 0); PG8_SCHED; PG8_LDA(At, 0, 0); PG8_STAGE(PG8_SA(1, 1), a1 + hstep, voffA);
            PG8_WAIT_L(8); PG8_BAR; PG8_WAIT_L(0); PG8_MMA(0, 0, At, B0); PG8_BAR; PG8_SCHED;
            PG8_LDB(B1, 0, 1); PG8_STAGE(PG8_SB(0, 0), b2, voffB);
            PG8_BAR; PG8_WAIT_L(0); PG8_MMA(0, 1, At, B1); PG8_BAR;
            PG8_LDA(At, 0, 1); PG8_STAGE(PG8_SA(0, 0), a2, voffA);
            PG8_BAR; PG8_WAIT_L(0); PG8_MMA(1, 0, At, B0); PG8_BAR; PG8_SCHED;
            PG8_STAGE(PG8_SB(0, 1), b2 + hstep, voffB);
            PG8_WAIT_V(6); PG8_BAR; PG8_MMA(1, 1, At, B1); PG8_BAR;
            PG8_LDB(B0, 1, 0); PG8_SCHED; PG8_LDA(At, 1, 0); PG8_STAGE(PG8_SA(0, 1), a2 + hstep, voffA);
            PG8_WAIT_L(8); PG8_BAR; PG8_WAIT_L(0); PG8_MMA(0, 0, At, B0); PG8_BAR; PG8_SCHED;
            PG8_LDB(B1, 1, 1); PG8_STAGE(PG8_SB(1, 0), b3, voffB);
            PG8_BAR; PG8_WAIT_L(0); PG8_MMA(0, 1, At, B1); PG8_BAR;
            PG8_LDA(At, 1, 1); PG8_STAGE(PG8_SA(1, 0), a3, voffA);
            PG8_BAR; PG8_WAIT_L(0); PG8_MMA(1, 0, At, B0); PG8_BAR; PG8_SCHED;
            PG8_STAGE(PG8_SB(1, 1), b3 + hstep, voffB);
            PG8_WAIT_V(6); PG8_BAR; PG8_MMA(1, 1, At, B1); PG8_BAR;
            }
        }
        if constexpr (ALIGN_EPI) { if (wr == 0) PG8_BAR; }
        if constexpr (!Epi::AFTER_DRAIN) { E(acc, cur, wr, wc, fr, fq); S.done(cur); }
        if (!has_next) break;
#pragma unroll
        for (int a = 0; a < 2; ++a)
#pragma unroll
            for (int b = 0; b < 2; ++b)
#pragma unroll
                for (int m = 0; m < 4; ++m)
#pragma unroll
                    for (int n = 0; n < 2; ++n) acc[a][b][m][n] = (f32x4){0.f, 0.f, 0.f, 0.f};
        cur = nxt; cA = nA; cB = nB; ++ui;
        if constexpr (ALIGN_EPI) { if (wr == 1) PG8_BAR; }
    }
    PG8_WAIT_V(0);
    if constexpr (!ALIGN_EPI) { if (wr == 0) PG8_BAR; }
    PG8_BAR;
    if constexpr (Epi::AFTER_DRAIN) { E.fused(acc, cur, wr, wc, fr, fq, lds, wid, lane); S.done(cur); }
#undef PG8_SA
#undef PG8_SB
#undef PG8_STAGE
#undef PG8_LDA
#undef PG8_LDB
#undef PG8_MMA
#undef PG8_WAIT_V
#undef PG8_WAIT_L
#undef PG8_BAR
#undef PG8_SCHED
}
}
#define XB_TMO      128
#define XB_XCNT(j)  (256  + 64 * (j))
#define XB_XSUB(j)  (1280 + 64 * (j))
#define XB_XGEN(j)  (2304 + 64 * (j))
#define XB_TOP      3328
#define XB_TOPGEN   3392
#define XCD_BAR_WORDS 3456
#define XB_SPIN_CAP (1u << 18)

__device__ __forceinline__ unsigned xb_ld(unsigned* p)              { return __hip_atomic_load(p, __ATOMIC_RELAXED, __HIP_MEMORY_SCOPE_AGENT); }
__device__ __forceinline__ unsigned xb_add(unsigned* p, unsigned v) { return __hip_atomic_fetch_add(p, v, __ATOMIC_RELAXED, __HIP_MEMORY_SCOPE_AGENT); }
__device__ __forceinline__ unsigned xb_xcc_id() { return (unsigned)__builtin_amdgcn_s_getreg((3 << 11) | 20) & 0xFu; }
#define XB_SPIN(cond, bar) do { unsigned _sp = 0; while (cond) { __builtin_amdgcn_s_sleep(1); \
    if ((++_sp & 255u) == 0u) { if (xb_ld(&(bar)[XB_TMO])) break; if (_sp > XB_SPIN_CAP) { atomicAdd(&(bar)[XB_TMO], 1u); break; } } } } while (0)

struct XcdBarrier {
    unsigned* bar; unsigned x;
    volatile LAS unsigned* st;
};

__device__ __forceinline__ XcdBarrier xcd_barrier_post(unsigned* bar, volatile LAS unsigned* st) {
    XcdBarrier b; b.bar = bar; b.x = xb_xcc_id(); b.st = st;
    if (threadIdx.x == 0) st[2] = xb_add(&bar[XB_XCNT(b.x)], 1u) + 1u;
    return b;
}
__device__ __forceinline__ void xcd_barrier_complete(unsigned* bar, unsigned x, unsigned& nloc, unsigned& nx) {
    const unsigned G = gridDim.x * gridDim.y * gridDim.z;
    unsigned sum, cnt, mine, sp = 0u;
    for (;;) {
        sum = 0u; cnt = 0u; mine = 0u;
#pragma unroll
        for (unsigned j = 0; j < 16; ++j) { const unsigned c = xb_ld(&bar[XB_XCNT(j)]); sum += c; cnt += (c > 0u) ? 1u : 0u; mine = (j == x) ? c : mine; }
        if (sum == G) break;
        __builtin_amdgcn_s_sleep(1);
        if ((++sp & 255u) == 0u) { if (xb_ld(&bar[XB_TMO])) break; if (sp > XB_SPIN_CAP) { atomicAdd(&bar[XB_TMO], 1u); break; } }
    }
    nloc = mine > 0u ? mine : 1u; nx = cnt > 0u ? cnt : 1u;
}

__device__ __forceinline__ void xcd_barrier(const XcdBarrier& b) {
    asm volatile("s_waitcnt vmcnt(0)" ::: "memory");
    __syncthreads();
    if (threadIdx.x == 0) {
        unsigned* bar = b.bar;
        __builtin_amdgcn_s_waitcnt(0);
        unsigned nloc = b.st[0], nx = b.st[1];
        if (nloc == 0u) { xcd_barrier_complete(bar, b.x, nloc, nx); b.st[0] = nloc; b.st[1] = nx; }
        const unsigned old = xb_add(&bar[XB_XSUB(b.x)], 1u);
        const unsigned gen = old / nloc;
        if (old + 1u == (gen + 1u) * nloc) {
            __builtin_amdgcn_fence(__ATOMIC_RELEASE, "agent");
            asm volatile("s_waitcnt vmcnt(0)" ::: "memory");
            const unsigned og = xb_add(&bar[XB_TOP], 1u);
            const unsigned tg = og / nx;
            if (og + 1u == (tg + 1u) * nx) xb_add(&bar[XB_TOPGEN], 1u);
            else XB_SPIN(xb_ld(&bar[XB_TOPGEN]) == tg, bar);
            __builtin_amdgcn_fence(__ATOMIC_ACQUIRE, "agent");
            xb_add(&bar[XB_XGEN(b.x)], 1u);
            asm volatile("s_waitcnt vmcnt(0)" ::: "memory");
        } else {
            XB_SPIN(xb_ld(&bar[XB_XGEN(b.x)]) == gen, bar);
            __builtin_amdgcn_fence(__ATOMIC_ACQUIRE, "agent");
            asm volatile("s_waitcnt vmcnt(0)" ::: "memory");
        }
    }
    __syncthreads();
}
constexpr int NWAVES = 8, NTHR = 512;
constexpr int RING_BYTES = 131072, LDSCTL_OFF = RING_BYTES, MISC_OFF = LDSCTL_OFF + 320, LDS_BYTES = 163840;
constexpr int CW_BAR = 4096;
#ifndef MK_N_LAUNCHES
#define MK_N_LAUNCHES 1
#endif
constexpr int NPHASE = 13;

typedef float f4v __attribute__((ext_vector_type(4)));
typedef unsigned u2v __attribute__((ext_vector_type(2)));
typedef unsigned u32x4_t __attribute__((ext_vector_type(4)));
struct Frame { LAS unsigned char* lds; int tid, lane, wave, G, bid; };
template <int CTRL, int ROWMASK> __device__ __forceinline__ float dppf(float old, float src) {
    return __builtin_bit_cast(float, __builtin_amdgcn_update_dpp(__builtin_bit_cast(int, old), __builtin_bit_cast(int, src), CTRL, ROWMASK, 0xf, false)); }
__device__ __forceinline__ float wave_scan_add(float v) {
    v += dppf<0x111, 0xf>(0.f, v); v += dppf<0x112, 0xf>(0.f, v); v += dppf<0x114, 0xf>(0.f, v); v += dppf<0x118, 0xf>(0.f, v);
    v += dppf<0x142, 0xa>(0.f, v); v += dppf<0x143, 0xc>(0.f, v); return v; }
__device__ __forceinline__ float wave_scan_max(float v) {
    const float NI = -INFINITY;
    v = fmaxf(v, dppf<0x111, 0xf>(NI, v)); v = fmaxf(v, dppf<0x112, 0xf>(NI, v)); v = fmaxf(v, dppf<0x114, 0xf>(NI, v)); v = fmaxf(v, dppf<0x118, 0xf>(NI, v));
    v = fmaxf(v, dppf<0x142, 0xa>(NI, v)); v = fmaxf(v, dppf<0x143, 0xc>(NI, v)); return v; }
__device__ __forceinline__ float lane_bcast(float v, int l) { return __builtin_bit_cast(float, __builtin_amdgcn_readlane(__builtin_bit_cast(int, v), l)); }
__device__ __forceinline__ float wave_sum(float v) { return lane_bcast(wave_scan_add(v), 63); }
__device__ __forceinline__ unsigned pk2(float lo, float hi) { return (unsigned)f2bf(lo) | ((unsigned)f2bf(hi) << 16); }
__device__ __forceinline__ float bflo(unsigned w) { return u_as_f(w << 16); }
__device__ __forceinline__ float bfhi(unsigned w) { return u_as_f(w & 0xffff0000u); }

__device__ __forceinline__ void p0_ada_block(const Prm& p, const Frame& F, int cb) {
    static_assert(D6 % 48 == 0 && NB == 8, "48-column blocks");
    LAS float* sl = (LAS float*)F.lds;
    LAS float* red = sl + NB * D;
    for (int i = F.tid; i < NB * D; i += NTHR) { const float cv = p.c[i]; sl[i] = cv / (1.f + __expf(-cv)); }
    __syncthreads();
    const int c4 = F.tid % 12, kl = F.tid / 12;
    if (kl < 42) {
        f4v acc[NB];
#pragma unroll
        for (int b = 0; b < NB; ++b) acc[b] = (f4v){0.f, 0.f, 0.f, 0.f};
        const float* wp = p.w_ada + (size_t)cb * 48 + 4 * c4;
#pragma unroll 7
        for (int k = kl; k < D; k += 42) { const f4v w = __builtin_nontemporal_load((const f4v*)(wp + (size_t)k * D6));
#pragma unroll
            for (int b = 0; b < NB; ++b) acc[b] += w * sl[b * D + k]; }
#pragma unroll
        for (int b = 0; b < NB; ++b) *(LAS f4v*)(red + (kl * NB + b) * 48 + 4 * c4) = acc[b];
    }
    __syncthreads();
    if (F.tid < NB * 48) { const int b = F.tid / 48, col = F.tid % 48; float s = 0.f;
        for (int k = 0; k < 42; ++k) s += red[(k * NB + b) * 48 + col];
        p.MOD()[(size_t)b * D6 + cb * 48 + col] = s + p.b_ada[cb * 48 + col]; }
    __syncthreads();
}
__device__ __forceinline__ void p0_transpose_item(const float* W, int ldw, int K, int N, bf16_t* WT, LAS float* scr, int item, int lane) {
    const int nblk = N / 32, kb = item / nblk, nb = item % nblk, k0 = 64 * kb, n0 = 32 * nb;
#pragma unroll
    for (int i = 0; i < 32; ++i) { const int kk = 2 * i + (lane >> 5); scr[kk * 33 + (lane & 31)] = W[(size_t)(k0 + kk) * ldw + n0 + (lane & 31)]; }
    asm volatile("s_waitcnt lgkmcnt(0)" ::: "memory");
    const int c = lane & 7;
#pragma unroll
    for (int j = 0; j < 4; ++j) { const int n = (lane >> 3) + 8 * j; const LAS float* s = scr + (8 * c) * 33 + n;
        uint4 o; o.x = pk2(s[0 * 33], s[1 * 33]); o.y = pk2(s[2 * 33], s[3 * 33]); o.z = pk2(s[4 * 33], s[5 * 33]); o.w = pk2(s[6 * 33], s[7 * 33]);
        *(uint4*)(WT + (size_t)(n0 + n) * K + k0 + 8 * c) = o; }
    asm volatile("s_waitcnt lgkmcnt(0)" ::: "memory");
}

__device__ __forceinline__ void p0_fold_item(const Prm& p, int item, int lane) {
    static_assert(NK == 128 && KH == 128 && NQ == 2048, "fold item decomposition");
    const int ks = item & 31, nt = (item >> 5) & 7, g = item >> 8;
    const int r = lane & 15, q = lane >> 4;
    const float* arow = p.subkeys + ((size_t)g * NK + nt * 16 + r) * KH + 4 * q;
    const float* brow = p.wq + (size_t)(ks * 64 + r) * NQ + g * KH + 4 * q;
    pg8::f32x4 acc[4];
#pragma unroll
    for (int c = 0; c < 4; ++c) acc[c] = (pg8::f32x4){0.f, 0.f, 0.f, 0.f};
#pragma unroll 2
    for (int s16 = 0; s16 < KH; s16 += 16) {
        const pg8::f32x4 a = *(const pg8::f32x4*)(arow + s16); pg8::f32x4 bv[4];
#pragma unroll
        for (int c = 0; c < 4; ++c) bv[c] = *(const pg8::f32x4*)(brow + (size_t)(c * 16) * NQ + s16);
#pragma unroll
        for (int i = 0; i < 4; ++i)
#pragma unroll
            for (int c = 0; c < 4; ++c) acc[c] = __builtin_amdgcn_mfma_f32_16x16x4f32(a[i], bv[c][i], acc[c], 0, 0, 0);
    }
#pragma unroll
    for (int c = 0; c < 4; ++c)
#pragma unroll
        for (int i = 0; i < 4; ++i) p.WQ_T()[(size_t)(g * NK + nt * 16 + 4 * q + i) * D + ks * 64 + c * 16 + r] = f2bf(acc[c][i]);
}
__device__ __forceinline__ void phase0(const Prm& p, const Frame& F) {
    for (int cb = F.bid; cb < D6 / 48; cb += F.G) p0_ada_block(p, F, cb);
    LAS float* scr = (LAS float*)(F.lds + F.wave * 16384);
    const int gw = F.bid * NWAVES + F.wave, NGW = F.G * NWAVES;
    constexpr int I_IN = (D / 64) * (INM / 32);
    for (int it = gw; it < I_IN; it += NGW) p0_transpose_item(p.w_in, INC, D, INM, p.WIN_T(), scr, it, F.lane);
}
template <bool PART_A, bool PART_B, bool PART_F>
__device__ __forceinline__ void deferred_prep(const Prm& p, const Frame& F, int b0, int nb) {
    __syncthreads();
    LAS float* scr = (LAS float*)(F.lds + F.wave * 16384);
    const int gw = (F.bid - b0) * NWAVES + F.wave, NGW = nb * NWAVES;
    constexpr int I_O = (D / 64) * (D / 32), I_Q = 32 * 8 * 16;
    if (PART_A) for (int it = gw; it < I_O; it += NGW) p0_transpose_item(p.w_out, D, D, D, p.WOUT_T(), scr, it, F.lane);
    if (PART_F) for (int it = gw; it < I_Q; it += NGW) p0_fold_item(p, it, F.lane);
    if (PART_A) {
        float4 v[8], vn[8]; int rr = gw;
#define P0_ROWSRC(rr_) ((const float4*)(p.peer_u + (size_t)(rr_) * D) + F.lane)
        if (rr < NE) { const float4* src = P0_ROWSRC(rr);
#pragma unroll
            for (int j = 0; j < 8; ++j) { const f4v t_ = __builtin_nontemporal_load((const f4v*)(src + 64 * j)); v[j] = make_float4(t_[0], t_[1], t_[2], t_[3]); } }
        for (; rr < NE; rr += NGW) {
            const int rn = rr + NGW;
            if (rn < NE) { const float4* src = P0_ROWSRC(rn);
#pragma unroll
                for (int j = 0; j < 8; ++j) { const f4v t_ = __builtin_nontemporal_load((const f4v*)(src + 64 * j)); vn[j] = make_float4(t_[0], t_[1], t_[2], t_[3]); } }
            const int e = rr; float am = 0.f;
#pragma unroll
            for (int j = 0; j < 8; ++j) am = fmaxf(am, fmaxf(fmaxf(fabsf(v[j].x), fabsf(v[j].y)), fmaxf(fabsf(v[j].z), fabsf(v[j].w))));
#pragma unroll
            for (int o = 1; o < 64; o <<= 1) am = fmaxf(am, __shfl_xor(am, o));
            const float sc = am > 0.f ? 384.f / am : 1.f;
            unsigned* dst = (unsigned*)(p.PU8() + (size_t)e * D) + F.lane;
#pragma unroll
            for (int j = 0; j < 8; ++j) { unsigned w = 0u; w = __builtin_amdgcn_cvt_pk_fp8_f32(v[j].x * sc, v[j].y * sc, w, false); w = __builtin_amdgcn_cvt_pk_fp8_f32(v[j].z * sc, v[j].w * sc, w, true); dst[64 * j] = w; }
            if (F.lane == 0) p.RSU()[e] = am > 0.f ? am / 384.f : 1.f;
#pragma unroll
            for (int j = 0; j < 8; ++j) v[j] = vn[j];
        }
#undef P0_ROWSRC
    }
    if (PART_B) { LAS unsigned char* tl = F.lds; constexpr int RS_ = 2056;
      for (int tile = F.bid - b0; tile < NE / 16; tile += nb) { const int row = F.tid >> 5, l32 = F.tid & 31, e = tile * 16 + row;
        __syncthreads();
        const f4v* src = (const f4v*)(p.peer_v + (size_t)e * D) + l32; f4v x[16]; float am = 0.f;
#pragma unroll
        for (int j = 0; j < 16; ++j) { x[j] = __builtin_nontemporal_load(src + 32 * j); am = fmaxf(am, fmaxf(fmaxf(fabsf(x[j][0]), fabsf(x[j][1])), fmaxf(fabsf(x[j][2]), fabsf(x[j][3])))); }
#pragma unroll
        for (int o = 1; o < 32; o <<= 1) am = fmaxf(am, __shfl_xor(am, o));
        const float sc = am > 0.f ? 384.f / am : 1.f;
#pragma unroll
        for (int j = 0; j < 16; ++j) { unsigned w = 0u; w = __builtin_amdgcn_cvt_pk_fp8_f32(x[j][0] * sc, x[j][1] * sc, w, false); w = __builtin_amdgcn_cvt_pk_fp8_f32(x[j][2] * sc, x[j][3] * sc, w, true);
            *(LAS unsigned*)(tl + row * RS_ + 4 * (l32 + 32 * j)) = w; }
        if (l32 == 0) p.RSV()[e] = am > 0.f ? am / 384.f : 1.f;
        __syncthreads();
#pragma unroll
        for (int k = 0; k < 8; ++k) { const int idx = F.tid + NTHR * k, r = idx & 15, sl = idx >> 4;
            *(u2v*)(p.PV8S() + ((size_t)sl * NE + tile * 16 + r) * 8) = *(const LAS u2v*)(tl + r * RS_ + 8 * sl); }
      } }
}
__device__ __forceinline__ void phase1(const Prm& p, const Frame& F) {
    LAS float* SH = (LAS float*)F.lds; LAS float* SC1 = SH + D;
    LAS bf16_t* WG = (LAS bf16_t*)(F.lds + 2 * D * 4);
    const int rows_per = T / F.G;
    { const int st = (F.bid * 37) % (NG * D / NTHR);
      for (int k = 0; k < NG * D / NTHR; ++k) { const int idx = F.tid + NTHR * ((k + st) % (NG * D / NTHR)); const int d = idx / NG, g = idx % NG; WG[g * D + d] = f2bf(p.w_in[(size_t)d * INC + INM + g]); } }
    int cur_b = -1;
    float4 xpre[8];
    { const float4* x0 = (const float4*)(p.x + (size_t)(F.bid * rows_per + F.wave) * D) + F.lane;
#pragma unroll
      for (int j = 0; j < 8; ++j) xpre[j] = x0[64 * j]; }
    for (int r0 = F.bid * rows_per; r0 < (F.bid + 1) * rows_per; r0 += NWAVES) {
        const int b = r0 / S;
        if (b != cur_b) { __syncthreads();
            for (int n = F.tid; n < 2 * D; n += NTHR) { const float s = p.MOD()[(size_t)b * D6 + n]; SH[n] = n < D ? s : 1.f + s; }
            cur_b = b; __syncthreads(); }
        const int row = r0 + F.wave;
        float4 v[8]; float s = 0.f;
#pragma unroll
        for (int j = 0; j < 8; ++j) v[j] = xpre[j];
        if (r0 + NWAVES < (F.bid + 1) * rows_per) { const float4* xn = (const float4*)(p.x + (size_t)(row + NWAVES) * D) + F.lane;
#pragma unroll
            for (int j = 0; j < 8; ++j) xpre[j] = xn[64 * j]; }
#pragma unroll
        for (int j = 0; j < 8; ++j) s += (v[j].x + v[j].y) + (v[j].z + v[j].w);
        const float mean = wave_sum(s) * (1.f / D); float s2 = 0.f;
#pragma unroll
        for (int j = 0; j < 8; ++j) { v[j].x -= mean; v[j].y -= mean; v[j].z -= mean; v[j].w -= mean; s2 += (v[j].x * v[j].x + v[j].y * v[j].y) + (v[j].z * v[j].z + v[j].w * v[j].w); }
        const float rstd = 1.f / sqrtf(wave_sum(s2) * (1.f / D) + LN_EPS);
        uint2* o8 = (uint2*)(p.U() + (size_t)row * D) + F.lane;
#pragma unroll
        for (int j = 0; j < 8; ++j) { const int c0 = 4 * F.lane + 256 * j; const f4v sh = *(const LAS f4v*)(SH + c0), sc = *(const LAS f4v*)(SC1 + c0);
            v[j].x = v[j].x * rstd * sc.x + sh.x; v[j].y = v[j].y * rstd * sc.y + sh.y; v[j].z = v[j].z * rstd * sc.z + sh.z; v[j].w = v[j].w * rstd * sc.w + sh.w;
            o8[64 * j] = make_uint2(pk2(v[j].x, v[j].y), pk2(v[j].z, v[j].w)); }
        float ga[NG];
#pragma unroll
        for (int g = 0; g < NG; ++g) { float a = 0.f;
#pragma unroll
            for (int j = 0; j < 8; ++j) { const u2v w = *(const LAS u2v*)(WG + g * D + 4 * F.lane + 256 * j); a += v[j].x * bflo(w.x) + v[j].y * bfhi(w.x) + v[j].z * bflo(w.y) + v[j].w * bfhi(w.y); }
            ga[g] = a; }
        float r8[8], r4[4], r2[2]; const bool l0 = F.lane & 1, l1 = F.lane & 2, l2 = F.lane & 4, l3 = F.lane & 8;
#pragma unroll
        for (int i = 0; i < 8; ++i) { const float keep = l0 ? ga[8 + i] : ga[i], send = l0 ? ga[i] : ga[8 + i]; r8[i] = keep + __shfl_xor(send, 1); }
#pragma unroll
        for (int i = 0; i < 4; ++i) { const float keep = l1 ? r8[4 + i] : r8[i], send = l1 ? r8[i] : r8[4 + i]; r4[i] = keep + __shfl_xor(send, 2); }
#pragma unroll
        for (int i = 0; i < 2; ++i) { const float keep = l2 ? r4[2 + i] : r4[i], send = l2 ? r4[i] : r4[2 + i]; r2[i] = keep + __shfl_xor(send, 4); }
        float gacc = (l3 ? r2[1] : r2[0]) + __shfl_xor(l3 ? r2[0] : r2[1], 8);
        gacc += __shfl_xor(gacc, 16); gacc += __shfl_xor(gacc, 32);
        const int gi = (l0 ? 8 : 0) + (l1 ? 4 : 0) + (l2 ? 2 : 0) + (l3 ? 1 : 0);
        if (F.lane < NG) { const float gv = gacc + p.b_in[INM + gi]; p.GATES()[(size_t)row * NG + gi] = (gi & 4) ? logsigmoidf_(gv) : gv; }
    }
}
__device__ __forceinline__ void phase3a(const Prm& p, const Frame& F, int b0, int nb) {
    const size_t gt = (size_t)(F.bid - b0) * NTHR + F.tid, GT = (size_t)nb * NTHR;
    for (size_t i = gt; i < (size_t)T * (CW / 8); i += GT) {
        const size_t row = i / (CW / 8); const int ch = (int)(i % (CW / 8)) * 8, s = (int)(row % S);
        float acc[8];
#pragma unroll
        for (int e = 0; e < 8; ++e) acc[e] = p.conv_b[ch + e];
#pragma unroll
        for (int k = 0; k < 3; ++k) { const int s2 = s + k - 1; if (s2 < 0 || s2 >= S) continue; const bf16_t* pr = p.PJ() + (size_t)(row + k - 1) * INM;
            const uint4 gc = *(const uint4*)(pr + O_GC + ch), hi = *(const uint4*)(pr + O_HIN + ch); const float* cw = p.conv_w + k * CW + ch;
            acc[0] += cw[0] * (bflo(gc.x) * bflo(hi.x)); acc[1] += cw[1] * (bfhi(gc.x) * bfhi(hi.x)); acc[2] += cw[2] * (bflo(gc.y) * bflo(hi.y)); acc[3] += cw[3] * (bfhi(gc.y) * bfhi(hi.y));
            acc[4] += cw[4] * (bflo(gc.z) * bflo(hi.z)); acc[5] += cw[5] * (bfhi(gc.z) * bfhi(hi.z)); acc[6] += cw[6] * (bflo(gc.w) * bflo(hi.w)); acc[7] += cw[7] * (bfhi(gc.w) * bfhi(hi.w)); }
        const uint4 gb = *(const uint4*)(p.PJ() + row * INM + O_GB + ch); uint4 o;
        o.x = pk2(bflo(gb.x) * acc[0], bfhi(gb.x) * acc[1]); o.y = pk2(bflo(gb.y) * acc[2], bfhi(gb.y) * acc[3]); o.z = pk2(bflo(gb.z) * acc[4], bfhi(gb.z) * acc[5]); o.w = pk2(bflo(gb.w) * acc[6], bfhi(gb.w) * acc[7]);
        *(uint4*)(p.Y() + row * D + ch) = o; }
}
namespace ml {
typedef short bf16x8 __attribute__((ext_vector_type(8)));
typedef short s16x4 __attribute__((ext_vector_type(4)));
typedef float f32x4 __attribute__((ext_vector_type(4)));
typedef float f32x2_t __attribute__((ext_vector_type(2)));
typedef __bf16 bf16x2_t __attribute__((ext_vector_type(2)));
typedef unsigned u32x4 __attribute__((ext_vector_type(4)));
typedef unsigned u32x2 __attribute__((ext_vector_type(2)));
constexpr unsigned IMG = 16384u, BUF = 3u * IMG, PT_OFF = 2u * BUF, PT_BYTES = 8192u, N_OFF = PT_OFF + 2u * PT_BYTES;
constexpr unsigned SCT_OFF = 149504u, SCT_BYTES = 1024u;
constexpr unsigned HT_OFF = 133120u;
static_assert(N_OFF + 1024u <= 131072u && HT_OFF + 16384u <= SCT_OFF && SCT_OFF + 3u * SCT_BYTES <= 163840u, "mLSTM LDS map");
__device__ __forceinline__ unsigned cvtpk(float lo, float hi) { f32x2_t v = {lo, hi}; bf16x2_t b = __builtin_convertvector(v, bf16x2_t); return __builtin_bit_cast(unsigned, b); }
__device__ __forceinline__ unsigned off_a(unsigned row, unsigned ch) { return 2048u * (row >> 3) + 512u * (ch >> 2) + 64u * (row & 7u) + 16u * ((ch & 3u) ^ ((row >> 2) & 3u)); }
__device__ __forceinline__ unsigned off_p(unsigned row, unsigned ch) { return 128u * row + 16u * (ch ^ (row & 7u)); }
typedef short v4i16_t __attribute__((ext_vector_type(4)));
__device__ __forceinline__ s16x4 trr(LAS unsigned char* p) { return __builtin_bit_cast(s16x4, __builtin_amdgcn_ds_read_tr16_b64_v4i16((LAS v4i16_t*)p)); }
__device__ __forceinline__ bf16x8 cat8(s16x4 a, s16x4 b) { return (bf16x8){a[0], a[1], a[2], a[3], b[0], b[1], b[2], b[3]}; }
struct CS { float decay, m_next; };
__device__ __forceinline__ CS chunk_scalars(float ig, float fg, float m, LAS float* tab, bool writer, unsigned lane) {
    const float lf = fg;
    const float bc = wave_scan_add(lf), gg = ig - bc, cm = wave_scan_max(gg);
    const float G = fmaxf(m, cm), G63 = lane_bcast(G, 63), b63 = lane_bcast(bc, 63), qs = 0.08838834764831845f;
    if (writer) { tab[lane] = __expf(fminf(G63 - G, 80.f)) * qs; tab[64 + lane] = __expf(m - G) * qs; tab[128 + lane] = __expf(-(bc + G)); tab[192 + lane] = __expf(gg - G63); }
    CS r; r.decay = __expf(m - G63); r.m_next = b63 + G63;
    return r;
}
__device__ __forceinline__ void unit(const Prm& p, const Frame& F, int u) {
    static_assert(QK == 128 && MV == 256 && CHUNK == 64 && S % 64 == 0, "mLSTM unit is specialised");
    const int vhalf = u & 1, h = (u >> 1) & 3, b = (u >> 3) & 7, dir = u >> 6;
    const unsigned lane = F.lane, tid = F.tid; const int wave = F.wave; const unsigned q = lane >> 4, r = lane & 15u;
    LAS unsigned char* L = F.lds;
    const unsigned rx = (r >> 2) & 3u, rlo = 2048u * (r >> 3) + 64u * (r & 7u);
    const unsigned RA = rlo + 16u * (q ^ rx), PB1 = rlo + 16u * ((q >> 1) ^ rx) + 8u * (q & 1u), PB2 = rlo + 16u * ((2u + (q >> 1)) ^ rx) + 8u * (q & 1u);
    const unsigned pp = lane & 3u, tlo = 2048u * q + 64u * rx + 8u * (pp & 1u);
    const unsigned tb00 = tlo + 16u * ((pp >> 1) ^ ((2u * q) & 3u)), tb01 = tlo + 256u + 16u * ((pp >> 1) ^ ((2u * q + 1u) & 3u));
    const unsigned tb10 = tlo + 16u * ((2u + (pp >> 1)) ^ ((2u * q) & 3u)), tb11 = tlo + 256u + 16u * ((2u + (pp >> 1)) ^ ((2u * q + 1u) & 3u));
    const unsigned PP0 = 128u * r + 16u * (q ^ (r & 7u)), PP1 = 128u * r + 16u * ((4u + q) ^ (r & 7u));
#define ML_TRA(c, ks, t) ((((c) & 1) ? ((t) ? tb11 : tb10) : ((t) ? tb01 : tb00)) + 8192u * (ks) + 512u * ((unsigned)(c) >> 1))
    __syncthreads();
    for (unsigned i = tid; i < (2u * PT_BYTES + 1024u) / 16u; i += NTHR) *(LAS u32x4*)(L + PT_OFF + 16u * i) = (u32x4){0u, 0u, 0u, 0u};
    f32x4 C[8];
#pragma unroll
    for (int i = 0; i < 8; ++i) C[i] = (f32x4){0.f, 0.f, 0.f, 0.f};
    float m = 0.f;
    const bf16_t* pj = p.PJ(); bf16_t* H = dir ? p.HB16() : p.HF16();
    const int colq = O_Q + h * QK, colk = O_K + h * QK, colv = O_V + h * MV + vhalf * 128;
    const unsigned srow0 = tid >> 4, sch = tid & 15u;
    u32x4 rq[2], rk[2], rv[2];
    const float* gbase = p.GATES() + dir * 8 + h;
#define ML_GATES(c, ig_, fg_) do { const float* g_ = gbase + (size_t)ml_tok(dir, b, (c) * 64 + (int)lane) * NG; ig_ = g_[0]; fg_ = g_[4]; } while (0)
    float ig0, fg0, ign = 0.f, fgn = 0.f; ML_GATES(0, ig0, fg0); if (S / 64 > 1) ML_GATES(1, ign, fgn);
#define ML_TAB(c) ((LAS float*)(L + SCT_OFF + (unsigned)((c) % 3) * SCT_BYTES))
    CS cs = chunk_scalars(ig0, fg0, m, ML_TAB(0), wave == 0, lane), csn = cs;
    const long sMW = dir ? -(long)MW : (long)MW;
#define ML_LOAD(c) do { _Pragma("unroll") for (int i_ = 0; i_ < 2; ++i_) { const bf16_t* rp = pj + (size_t)ml_tok(dir, b, (c) * 64 + srow0 + 32 * i_) * INM + 8 * sch; \
        rq[i_] = *(const u32x4*)(rp + colq); rk[i_] = *(const u32x4*)(rp + colk); rv[i_] = *(const u32x4*)(rp + colv); } } while (0)
#define ML_STORE(buf, S_) do { _Pragma("unroll") for (int i_ = 0; i_ < 2; ++i_) { const unsigned row = srow0 + 32u * i_, o = (buf) * BUF + off_a(row, sch); const float w = (S_)[192 + row]; \
        *(LAS u32x4*)(L + o) = rq[i_]; *(LAS u32x4*)(L + IMG + o) = rk[i_]; u32x4 v = rv[i_]; \
        v.x = cvtpk(bflo(v.x) * w, bfhi(v.x) * w); v.y = cvtpk(bflo(v.y) * w, bfhi(v.y) * w); v.z = cvtpk(bflo(v.z) * w, bfhi(v.z) * w); v.w = cvtpk(bflo(v.w) * w, bfhi(v.w) * w); \
        *(LAS u32x4*)(L + 2u * IMG + o) = v; } } while (0)
    __syncthreads();
    ML_LOAD(0); ML_STORE(0u, ML_TAB(0));
    constexpr int NC = S / 64;
    for (int c = 0; c < NC; ++c) {
        const unsigned cur = (unsigned)(c & 1);
        LAS unsigned char* Qi = L + cur * BUF; LAS unsigned char* Ki = Qi + IMG; LAS unsigned char* Vi = Qi + 2u * IMG; LAS unsigned char* Pt = L + PT_OFF + cur * PT_BYTES;
        float ig2 = 0.f, fg2 = 0.f;
        if (c + 1 < NC) { ML_LOAD(c + 1); csn = chunk_scalars(ign, fgn, cs.m_next, ML_TAB(c + 1), wave == 0, lane); if (c + 2 < NC) ML_GATES(c + 2, ig2, fg2); }
        __syncthreads();
#define ML_FLUSH(cprev) do { _Pragma("unroll") for (int i_ = 0; i_ < 2; ++i_) { const unsigned n_ = tid + 512u * i_, row_ = n_ >> 4, ch_ = n_ & 15u;     \
            const u32x4 v_ = *(const LAS u32x4*)(L + HT_OFF + 256u * row_ + 16u * (ch_ ^ (row_ & 15u))); \
            *(u32x4*)(H + (size_t)ml_tok(dir, b, (cprev) * 64 + (int)row_) * MW + h * MV + vhalf * 128 + 8 * (int)ch_) = v_; } } while (0)
        const LAS float* sct = ML_TAB(c);
        if (c > 0) ML_FLUSH(c - 1);
#ifndef ML_REP_3B
#define ML_REP_3B 1
#define ML_REP_S 1
#define ML_REP_ST 1
#define ML_REP_3A 1
#define ML_REP_DEN 1
#endif
        f32x4 acc2[4];
#pragma unroll
        for (int tt = 0; tt < 4; ++tt) acc2[tt] = (f32x4){0.f, 0.f, 0.f, 0.f};
#pragma unroll
        for (int ks = 0; ks < 4; ++ks) {
            bf16x8 qa[4];
#pragma unroll
            for (int tt = 0; tt < 4; ++tt) {
                const u32x2 lo = *(const LAS u32x2*)(Qi + PB1 + 4096u * tt + 512u * ks), hi = *(const LAS u32x2*)(Qi + PB2 + 4096u * tt + 512u * ks);
                const u32x4 aw = {lo.x, lo.y, hi.x, hi.y}; qa[tt] = __builtin_bit_cast(bf16x8, aw); }
            const f32x4 c0 = C[2 * ks], c1 = C[2 * ks + 1];
            const u32x4 bw = {cvtpk(c0[0], c0[1]), cvtpk(c0[2], c0[3]), cvtpk(c1[0], c1[1]), cvtpk(c1[2], c1[3])}; const bf16x8 bfr = __builtin_bit_cast(bf16x8, bw);
#pragma unroll
            for (int tt = 0; tt < 4; ++tt) acc2[tt] = __builtin_amdgcn_mfma_f32_16x16x32_bf16(qa[tt], bfr, acc2[tt], 0, 0, 0);
        }
        bf16x8 vB[2];
#pragma unroll
        for (int ks = 0; ks < 2; ++ks) vB[ks] = cat8(trr(Vi + ML_TRA(wave, ks, 0)), trr(Vi + ML_TRA(wave, ks, 1)));
#pragma unroll
        for (int dt = 0; dt < 8; ++dt) C[dt] = C[dt] * cs.decay;
#pragma unroll
        for (int ks = 0; ks < 2; ++ks)
#pragma unroll
            for (int dh = 0; dh < 2; ++dh) { bf16x8 kA[4];
#pragma unroll
                for (int d4 = 0; d4 < 4; ++d4) kA[d4] = cat8(trr(Ki + ML_TRA(4 * dh + d4, ks, 0)), trr(Ki + ML_TRA(4 * dh + d4, ks, 1)));
#pragma unroll
                for (int d4 = 0; d4 < 4; ++d4) C[4 * dh + d4] = __builtin_amdgcn_mfma_f32_16x16x32_bf16(kA[d4], vB[ks], C[4 * dh + d4], 0, 0, 0); }
#pragma unroll
        for (int rep = 0; rep < 2; ++rep) { const int idx = wave + (rep ? 2 : 0);
            if (rep == 0 || wave >= 6) { const int tt = idx >= 6 ? 3 : (idx >= 3 ? 2 : (idx >= 1 ? 1 : 0)), st = idx - tt * (tt + 1) / 2;
                f32x4 sa = (f32x4){0.f, 0.f, 0.f, 0.f};
#pragma unroll
                for (int kh = 0; kh < 2; ++kh) { bf16x8 af[2], bfk[2];
#pragma unroll
                    for (int k2 = 0; k2 < 2; ++k2) { af[k2] = *(const LAS bf16x8*)(Qi + RA + 4096u * tt + 512u * (2 * kh + k2)); bfk[k2] = *(const LAS bf16x8*)(Ki + RA + 4096u * st + 512u * (2 * kh + k2)); }
#pragma unroll
                    for (int k2 = 0; k2 < 2; ++k2) sa = __builtin_amdgcn_mfma_f32_16x16x32_bf16(af[k2], bfk[k2], sa, 0, 0, 0); }
                const unsigned scol = 16u * st + r;
#pragma unroll
                for (int i = 0; i < 4; ++i) { const unsigned trow = 16u * tt + 4u * q + i; const float v = scol <= trow ? sa[i] : 0.f;
                    *(LAS bf16_t*)(Pt + off_p(trow, scol >> 3) + 2u * (scol & 7u)) = (bf16_t)cvtpk(v, 0.f); } } }
        if (c + 1 < NC) ML_STORE(cur ^ 1u, ML_TAB(c + 1));
        __syncthreads();
        { bf16x8 pf[6];
#pragma unroll
          for (int tt = 0; tt < 4; ++tt) { pf[tt] = *(const LAS bf16x8*)(Pt + PP0 + 2048u * tt); if (tt >= 2) pf[2 + tt] = *(const LAS bf16x8*)(Pt + PP1 + 2048u * tt); }
#pragma unroll
          for (int tt = 0; tt < 4; ++tt) { const f32x4 av4 = *(const LAS f32x4*)(sct + 16 * tt + 4 * q), bv4 = *(const LAS f32x4*)(sct + 64 + 16 * tt + 4 * q); f32x4 a1 = __builtin_amdgcn_mfma_f32_16x16x32_bf16(pf[tt], vB[0], (f32x4){0.f, 0.f, 0.f, 0.f}, 0, 0, 0);
            if (tt >= 2) a1 = __builtin_amdgcn_mfma_f32_16x16x32_bf16(pf[2 + tt], vB[1], a1, 0, 0, 0);
#pragma unroll
            for (int i = 0; i < 4; ++i) { const unsigned t = 16u * tt + 4u * q + i, col = 16u * (unsigned)wave + r;
                *(LAS bf16_t*)(L + HT_OFF + 256u * t + 16u * ((col >> 3) ^ (t & 15u)) + 2u * (col & 7u)) = (bf16_t)cvtpk(av4[i] * a1[i] + bv4[i] * acc2[tt][i], 0.f); } } }
        if (vhalf == 0) {
            const LAS float* n_old = (const LAS float*)(L + N_OFF + cur * 512u); LAS float* n_new = (LAS float*)(L + N_OFF + (cur ^ 1u) * 512u);
            bf16x8 wB[2];
#pragma unroll
            for (int ks = 0; ks < 2; ++ks) { const f32x4 w0 = *(const LAS f32x4*)(sct + 192 + 32 * ks + 8 * q), w1 = *(const LAS f32x4*)(sct + 192 + 32 * ks + 8 * q + 4);
                u32x4 w = {cvtpk(w0[0], w0[1]), cvtpk(w0[2], w0[3]), cvtpk(w1[0], w1[1]), cvtpk(w1[2], w1[3])};
                if (r != 0u) w = (u32x4){0u, 0u, 0u, 0u}; wB[ks] = __builtin_bit_cast(bf16x8, w); }
            const size_t dbase = ((size_t)dir * T) * MH + h;
            if (wave < 4) { const int tt = wave; f32x4 d2 = (f32x4){0.f, 0.f, 0.f, 0.f};
#pragma unroll
                for (int ks = 0; ks < 4; ++ks) { const f32x4 n0 = *(const LAS f32x4*)(n_old + 32 * ks + 4 * q), n1 = *(const LAS f32x4*)(n_old + 32 * ks + 16 + 4 * q);
                    u32x4 bw = {cvtpk(n0[0], n0[1]), cvtpk(n0[2], n0[3]), cvtpk(n1[0], n1[1]), cvtpk(n1[2], n1[3])}; if (r != 0u) bw = (u32x4){0u, 0u, 0u, 0u};
                    const u32x2 lo = *(const LAS u32x2*)(Qi + PB1 + 4096u * tt + 512u * ks), hi = *(const LAS u32x2*)(Qi + PB2 + 4096u * tt + 512u * ks);
                    const u32x4 aw = {lo.x, lo.y, hi.x, hi.y};
                    d2 = __builtin_amdgcn_mfma_f32_16x16x32_bf16(__builtin_bit_cast(bf16x8, aw), __builtin_bit_cast(bf16x8, bw), d2, 0, 0, 0); }
#pragma unroll
                for (int i = 0; i < 4; ++i) { const int t = 16 * tt + 4 * (int)q + i; const float bv = sct[64 + t], fl = sct[128 + t];
                    if (r == 0u) { const size_t di = dbase + (size_t)ml_tok(dir, b, c * 64 + t) * MH; p.DEN()[(size_t)2 * T * MH + di] = bv * d2[i]; p.FLR()[di] = fl; } }
            } else { const int tt = wave - 4; f32x4 d1 = (f32x4){0.f, 0.f, 0.f, 0.f};
#pragma unroll
                for (int ks = 0; ks < 2; ++ks) if (ks == 0 || tt >= 2) { const bf16x8 pf = *(const LAS bf16x8*)(Pt + (ks ? PP1 : PP0) + 2048u * tt);
                    d1 = __builtin_amdgcn_mfma_f32_16x16x32_bf16(pf, wB[ks], d1, 0, 0, 0); }
#pragma unroll
                for (int i = 0; i < 4; ++i) { const int t = 16 * tt + 4 * (int)q + i; const float av = sct[t];
                    if (r == 0u) p.DEN()[dbase + (size_t)ml_tok(dir, b, c * 64 + t) * MH] = av * d1[i]; } }
            { const int dt = wave; f32x4 nn = *(const LAS f32x4*)(n_old + 16 * dt + 4 * q) * cs.decay; if (r != 0u) nn = (f32x4){0.f, 0.f, 0.f, 0.f};
#pragma unroll
                for (int ks = 0; ks < 2; ++ks) { const bf16x8 kA = cat8(trr(Ki + ML_TRA(dt, ks, 0)), trr(Ki + ML_TRA(dt, ks, 1)));
                    nn = __builtin_amdgcn_mfma_f32_16x16x32_bf16(kA, wB[ks], nn, 0, 0, 0); }
                if (r == 0u) *(LAS f32x4*)(n_new + 16 * dt + 4 * q) = nn; }
        }
        m = cs.m_next; cs = csn; ign = ig2; fgn = fg2;
    }
    __syncthreads(); ML_FLUSH(NC - 1);
#undef ML_FLUSH
#undef ML_TRA
#undef ML_TABLE
#undef ML_LOAD
#undef ML_GATES
#undef ML_STORE
}
}
__device__ __forceinline__ void phase4(const Prm& p, const Frame& F) {
    static_assert(MV == 256 && MH == 4, "head j = float4 slot j of the lane");
    const int gw = F.bid * NWAVES + F.wave, NGW = F.G * NWAVES;
    for (int row = gw; row < T; row += NGW) {
        const uint2* hf = (const uint2*)(p.HF16() + (size_t)row * MW) + F.lane; const uint2* hb = (const uint2*)(p.HB16() + (size_t)row * MW) + F.lane;
        const uint2* og = (const uint2*)(p.PJ() + (size_t)row * INM + O_O) + F.lane; uint2* yo = (uint2*)(p.Y() + (size_t)row * D + CW) + F.lane;
#pragma unroll
        for (int j = 0; j < MH; ++j) {
            const float* d2 = p.DEN() + (size_t)2 * T * MH;
            const float i_f = 1.f / fmaxf(fabsf(p.DEN()[(size_t)row * MH + j] + d2[(size_t)row * MH + j]), p.FLR()[(size_t)row * MH + j]);
            const float i_b = 1.f / fmaxf(fabsf(p.DEN()[((size_t)T + row) * MH + j] + d2[((size_t)T + row) * MH + j]), p.FLR()[((size_t)T + row) * MH + j]);
            const uint2 a = hf[64 * j], b = hb[64 * j]; float4 h = make_float4(bflo(a.x) * i_f + bflo(b.x) * i_b, bfhi(a.x) * i_f + bfhi(b.x) * i_b, bflo(a.y) * i_f + bflo(b.y) * i_b, bfhi(a.y) * i_f + bfhi(b.y) * i_b);
            const float mean = wave_sum((h.x + h.y) + (h.z + h.w)) * (1.f / MV);
            h.x -= mean; h.y -= mean; h.z -= mean; h.w -= mean;
            const float rstd = 1.f / sqrtf(wave_sum((h.x * h.x + h.y * h.y) + (h.z * h.z + h.w * h.w)) * (1.f / MV) + LN_EPS);
            const float4 nw = *((const float4*)(p.mnorm_w + j * MV) + F.lane); const uint2 o = og[64 * j];
            yo[64 * j] = make_uint2(pk2(h.x * rstd * nw.x * sigmoidf_(bflo(o.x)), h.y * rstd * nw.y * sigmoidf_(bfhi(o.x))), pk2(h.z * rstd * nw.z * sigmoidf_(bflo(o.y)), h.w * rstd * nw.w * sigmoidf_(bfhi(o.y)))); }
    }
}
struct EpiZ {
    static constexpr bool PERM = false, AFTER_DRAIN = false;
    const float* x; const float* mod; bf16_t* out;
    __device__ __forceinline__ void operator()(const pg8::f32x4 (&acc)[2][2][4][2], const pg8::Unit& u, int wr, int wc, int fr, int fq) const {
        const int col0 = u.pn * 256 + wc * 32 + 4 * fq;
#pragma unroll
        for (int ai = 0; ai < 2; ++ai)
#pragma unroll
            for (int m = 0; m < 4; ++m) { const int row = u.pm * 256 + ai * 128 + wr * 64 + m * 16 + fr; const float* g1 = mod + (size_t)(row / S) * D6 + 2 * D; const size_t off = (size_t)row * D + col0;
#pragma unroll
                for (int bj = 0; bj < 2; ++bj)
#pragma unroll
                    for (int n = 0; n < 2; ++n) { const int c = bj * 128 + n * 16; const pg8::f32x4 xv = *(const pg8::f32x4*)(x + off + c), gv = *(const pg8::f32x4*)(g1 + col0 + c);
                        const pg8::f32x4 z = xv * ALPHA + gv * acc[ai][bj][m][n]; *(uint2*)(out + off + c) = make_uint2(pk2(z[0], z[1]), pk2(z[2], z[3])); } }
    }
};

struct EpiF32 {
    static constexpr bool PERM = false, AFTER_DRAIN = false;
    float* out; int ldc;
    __device__ __forceinline__ void operator()(const pg8::f32x4 (&acc)[2][2][4][2], const pg8::Unit& u, int wr, int wc, int fr, int fq) const {
        const int col0 = u.pn * 256 + wc * 32 + 4 * fq;
#pragma unroll
        for (int ai = 0; ai < 2; ++ai)
#pragma unroll
            for (int m = 0; m < 4; ++m) { float* rowp = out + (size_t)(u.pm * 256 + ai * 128 + wr * 64 + m * 16 + fr) * ldc + col0;
#pragma unroll
                for (int bj = 0; bj < 2; ++bj)
#pragma unroll
                    for (int n = 0; n < 2; ++n) *(pg8::f32x4*)(rowp + bj * 128 + n * 16) = acc[ai][bj][m][n]; }
    }
};
__device__ __forceinline__ unsigned skey(float f) { const unsigned u = f_as_u(f); return (u & 0x80000000u) ? ~u : (u | 0x80000000u); }
__device__ __forceinline__ float unskey(unsigned k) { return u_as_f((k & 0x80000000u) ? (k & 0x7fffffffu) : ~k); }
__device__ __forceinline__ void tk_cx(unsigned& a, unsigned& b) { const unsigned hi = a > b ? a : b, lo = a > b ? b : a; a = hi; b = lo; }
__device__ __forceinline__ void tk_sort16(unsigned (&v)[16]) {
#pragma unroll
    for (int k = 2; k <= 16; k <<= 1)
#pragma unroll
        for (int j = k >> 1; j >= 1; j >>= 1)
#pragma unroll
            for (int i = 0; i < 16; ++i) { const int l = i ^ j; if (l > i) { if ((i & k) == 0) tk_cx(v[i], v[l]); else tk_cx(v[l], v[i]); } }
}
__device__ __forceinline__ void tk_merge16(unsigned (&L)[16], const unsigned (&C)[16]) {
#pragma unroll
    for (int i = 0; i < 16; ++i) L[i] = L[i] > C[15 - i] ? L[i] : C[15 - i];
#pragma unroll
    for (int j = 8; j >= 1; j >>= 1)
#pragma unroll
        for (int i = 0; i < 16; ++i) { const int l = i ^ j; if (l > i) tk_cx(L[i], L[l]); }
}
__device__ __forceinline__ void tk_top16(const float* sc, unsigned (&L)[16]) {
#pragma unroll 1
    for (int ch = 0; ch < NK / 16; ++ch) { unsigned C[16];
#pragma unroll
        for (int q4 = 0; q4 < 4; ++q4) { const float4 v = ((const float4*)sc)[4 * ch + q4]; const unsigned b = 127u - 16u * ch - 4u * q4;
            C[4 * q4] = (skey(v.x) & ~0x7fu) | b; C[4 * q4 + 1] = (skey(v.y) & ~0x7fu) | (b - 1); C[4 * q4 + 2] = (skey(v.z) & ~0x7fu) | (b - 2); C[4 * q4 + 3] = (skey(v.w) & ~0x7fu) | (b - 3); }
        tk_sort16(C);
        if (ch == 0) {
#pragma unroll
            for (int i = 0; i < 16; ++i) L[i] = C[i]; }
        else tk_merge16(L, C); }
}
__device__ __forceinline__ void phase8(const Prm& p, const Frame& F) {
    static_assert(NK == 128 && TOPK == 16, "top-k phase is specialised");
    const long gt = (long)F.bid * NTHR + F.tid, GT = (long)F.G * NTHR;
    LAS unsigned* ix = (LAS unsigned*)F.lds + F.tid;
    for (long i = gt; i < (long)T * PH; i += GT) {
        unsigned A[16], B[16];
        tk_top16(p.SC() + (size_t)i * 2 * NK, A); tk_top16(p.SC() + (size_t)i * 2 * NK + NK, B);
        float sa[16], sb[16];
#pragma unroll
        for (int k = 0; k < 16; ++k) { sa[k] = unskey(A[k] & ~0x7fu); sb[k] = unskey(B[k] & ~0x7fu); ix[NTHR * k] = 127u - (A[k] & 0x7fu); ix[NTHR * (16 + k)] = 127u - (B[k] & 0x7fu); }
        unsigned L[16], C[16]; int n = 0;
#pragma unroll
        for (int a = 0; a < 16; ++a)
#pragma unroll
            for (int b = 0; b < 16; ++b) if ((a + 1) * (b + 1) <= 16) { const unsigned key = (skey(sa[a] + sb[b]) & ~0xffu) | (unsigned)(255 - (16 * a + b));
                C[n & 15] = key; ++n;
                if ((n & 15) == 0 || n == 50) { if (n == 50) {
#pragma unroll
                        for (int z = 2; z < 16; ++z) C[z] = 0u; }
                    tk_sort16(C);
                    if (n == 16) {
#pragma unroll
                        for (int z = 0; z < 16; ++z) L[z] = C[z]; }
                    else tk_merge16(L, C); } }
        float V[16]; float sum = 0.f; const float vmax = unskey(L[0] & ~0xffu);
#pragma unroll
        for (int r = 0; r < 16; ++r) { V[r] = __expf(unskey(L[r] & ~0xffu) - vmax); sum += V[r]; }
        const float inv = 1.f / sum; int E[16];
#pragma unroll
        for (int r = 0; r < 16; ++r) { const unsigned fl = 255u - (L[r] & 0xffu); E[r] = (int)(ix[NTHR * (fl >> 4)] * NK + ix[NTHR * (16 + (fl & 15u))]); }
#pragma unroll
        for (int r = 0; r < 16; r += 4) { *(int4*)(p.EIDX() + (size_t)i * TOPK + r) = make_int4(E[r], E[r + 1], E[r + 2], E[r + 3]);
            *(float4*)(p.EW() + (size_t)i * TOPK + r) = make_float4(V[r] * inv, V[r + 1] * inv, V[r + 2] * inv, V[r + 3] * inv); }
    }
}
__device__ __forceinline__ void phase6(const Prm& p, const Frame& F) {
    const int gw = F.bid * NWAVES + F.wave, NGW = F.G * NWAVES;
    float4 v[8]; uint2 zb[8], zn[8];
    if (gw < T) { const uint2* z0 = (const uint2*)((const bf16_t*)p.out + (size_t)gw * D) + F.lane;
#pragma unroll
        for (int j = 0; j < 8; ++j) zb[j] = z0[64 * j]; }
    for (int row = gw; row < T; row += NGW) {
        uint2* x1r = (uint2*)(p.X1B() + (size_t)row * D) + F.lane; const float* mod = p.MOD() + (size_t)(row / S) * D6;
        float s = 0.f;
        if (row + NGW < T) { const uint2* zp = (const uint2*)((const bf16_t*)p.out + (size_t)(row + NGW) * D) + F.lane;
#pragma unroll
            for (int j = 0; j < 8; ++j) zn[j] = zp[64 * j]; }
#pragma unroll
        for (int j = 0; j < 8; ++j) { v[j] = make_float4(bflo(zb[j].x), bfhi(zb[j].x), bflo(zb[j].y), bfhi(zb[j].y)); s += (v[j].x + v[j].y) + (v[j].z + v[j].w); }
        float mean = wave_sum(s) * (1.f / D), s2 = 0.f;
#pragma unroll
        for (int j = 0; j < 8; ++j) { v[j].x -= mean; v[j].y -= mean; v[j].z -= mean; v[j].w -= mean; s2 += (v[j].x * v[j].x + v[j].y * v[j].y) + (v[j].z * v[j].z + v[j].w * v[j].w); }
        float rstd = 1.f / sqrtf(wave_sum(s2) * (1.f / D) + LN_EPS); s = 0.f;
#pragma unroll
        for (int j = 0; j < 8; ++j) { const float4 w = *((const float4*)p.ln1_w + F.lane + 64 * j), bb = *((const float4*)p.ln1_b + F.lane + 64 * j);
            v[j].x = v[j].x * rstd * w.x + bb.x; v[j].y = v[j].y * rstd * w.y + bb.y; v[j].z = v[j].z * rstd * w.z + bb.z; v[j].w = v[j].w * rstd * w.w + bb.w;
            x1r[64 * j] = make_uint2(pk2(v[j].x, v[j].y), pk2(v[j].z, v[j].w)); s += (v[j].x + v[j].y) + (v[j].z + v[j].w); }
        mean = wave_sum(s) * (1.f / D); s2 = 0.f;
#pragma unroll
        for (int j = 0; j < 8; ++j) { v[j].x -= mean; v[j].y -= mean; v[j].z -= mean; v[j].w -= mean; s2 += (v[j].x * v[j].x + v[j].y * v[j].y) + (v[j].z * v[j].z + v[j].w * v[j].w); }
        rstd = 1.f / sqrtf(wave_sum(s2) * (1.f / D) + LN_EPS);
        uint2* o8 = (uint2*)(p.U() + (size_t)row * D) + F.lane;
#pragma unroll
        for (int j = 0; j < 8; ++j) { const float4 sh = *((const float4*)(mod + 3 * D) + F.lane + 64 * j), sc = *((const float4*)(mod + 4 * D) + F.lane + 64 * j);
            o8[64 * j] = make_uint2(pk2(v[j].x * rstd * (1.f + sc.x) + sh.x, v[j].y * rstd * (1.f + sc.y) + sh.y), pk2(v[j].z * rstd * (1.f + sc.z) + sh.z, v[j].w * rstd * (1.f + sc.w) + sh.w)); }
#pragma unroll
        for (int j = 0; j < 8; ++j) zb[j] = zn[j];
    }
}
struct XW { int vx, nx, rank, nloc; };
constexpr int NDS = 16, DSW = D / NDS;
typedef float f2v __attribute__((ext_vector_type(2)));
struct Row8 { uint4 r[8]; };
__device__ __forceinline__ void gather8(Row8& g, const unsigned char* tbu, unsigned loff, int ereg, int pg) {
#pragma unroll
    for (int k = 0; k < 8; ++k) { const unsigned e = (unsigned)__shfl(ereg, 8 * k + pg); g.r[k] = *(const uint4*)(tbu + (((size_t)e << 11) | loff)); }
}
#define PEER_CVT8(a) const f2v c0 = __builtin_amdgcn_cvt_pk_f32_fp8((a).x, false), c1 = __builtin_amdgcn_cvt_pk_f32_fp8((a).x, true), c2 = __builtin_amdgcn_cvt_pk_f32_fp8((a).y, false), c3 = __builtin_amdgcn_cvt_pk_f32_fp8((a).y, true), \
    c4 = __builtin_amdgcn_cvt_pk_f32_fp8((a).z, false), c5 = __builtin_amdgcn_cvt_pk_f32_fp8((a).z, true), c6 = __builtin_amdgcn_cvt_pk_f32_fp8((a).w, false), c7 = __builtin_amdgcn_cvt_pk_f32_fp8((a).w, true)
typedef _Float16 h2t __attribute__((ext_vector_type(2)));
__device__ __forceinline__ float peer_dot16h(const uint4 a, const h2t* u) {
    float acc = __builtin_amdgcn_fdot2(__builtin_amdgcn_cvt_scalef32_pk_f16_fp8(a.x, 1.0f, false), u[0], 0.f, false);
    acc = __builtin_amdgcn_fdot2(__builtin_amdgcn_cvt_scalef32_pk_f16_fp8(a.x, 1.0f, true), u[1], acc, false);
    acc = __builtin_amdgcn_fdot2(__builtin_amdgcn_cvt_scalef32_pk_f16_fp8(a.y, 1.0f, false), u[2], acc, false);
    acc = __builtin_amdgcn_fdot2(__builtin_amdgcn_cvt_scalef32_pk_f16_fp8(a.y, 1.0f, true), u[3], acc, false);
    acc = __builtin_amdgcn_fdot2(__builtin_amdgcn_cvt_scalef32_pk_f16_fp8(a.z, 1.0f, false), u[4], acc, false);
    acc = __builtin_amdgcn_fdot2(__builtin_amdgcn_cvt_scalef32_pk_f16_fp8(a.z, 1.0f, true), u[5], acc, false);
    acc = __builtin_amdgcn_fdot2(__builtin_amdgcn_cvt_scalef32_pk_f16_fp8(a.w, 1.0f, false), u[6], acc, false);
    acc = __builtin_amdgcn_fdot2(__builtin_amdgcn_cvt_scalef32_pk_f16_fp8(a.w, 1.0f, true), u[7], acc, false);
    return acc;
}
__device__ __forceinline__ f2v rscatter16(const float* v, bool b0, bool b1, bool b2, int m0, int m1, int m2) {
    float r8[8], r4[4]; f2v r2;
#pragma unroll
    for (int i = 0; i < 8; ++i) { const float keep = b0 ? v[8 + i] : v[i], send = b0 ? v[i] : v[8 + i]; r8[i] = keep + __shfl_xor(send, m0); }
#pragma unroll
    for (int i = 0; i < 4; ++i) { const float keep = b1 ? r8[4 + i] : r8[i], send = b1 ? r8[i] : r8[4 + i]; r4[i] = keep + __shfl_xor(send, m1); }
    { const float k0 = b2 ? r4[2] : r4[0], s0 = b2 ? r4[0] : r4[2], k1 = b2 ? r4[3] : r4[1], s1 = b2 ? r4[1] : r4[3]; r2.x = k0 + __shfl_xor(s0, m2); r2.y = k1 + __shfl_xor(s1, m2); }
    return r2;
}
__device__ __forceinline__ void phase9(const Prm& p, const Frame& F, const XW& xw) {
    static_assert(DSW == 128 && NSLOT == 128 && D == 2048, "slice row = 8 lanes x 16 bytes");
    const int pg = F.lane >> 3, part = F.lane & 7; const bool p0 = part & 1, p1 = part & 2, p2 = part & 4;
    const int tstep = xw.nloc * NWAVES, t0 = xw.rank * NWAVES + F.wave; const int nt = t0 < T ? (T - t0 + tstep - 1) / tstep : 0;
    const unsigned loff = (unsigned)part * 16u; const int k0 = (p0 ? 8 : 0) + (p1 ? 4 : 0) + (p2 ? 2 : 0);
    for (int ds = xw.vx; ds < NDS; ds += xw.nx) {
        if (nt == 0) continue;
        const unsigned char* tbu = p.PU8() + ds * DSW; _Float16* part_out = (_Float16*)p.SC() + (size_t)ds * T * NSLOT + pg + 8 * k0;
#define UP_TOK(i) (t0 + ((i) < nt ? (i) : nt - 1) * tstep)
#define UP_LOADE(i, ea, eb) do { const int* ep_ = p.EIDX() + (size_t)UP_TOK(i) * NSLOT + F.lane; ea = ep_[0]; eb = ep_[64]; } while (0)
#define UP_LOADU(i, ua_, ub_) do { const uint4* up_ = (const uint4*)(p.U() + (size_t)UP_TOK(i) * D + ds * DSW + part * 16); ua_ = up_[0]; ub_ = up_[1]; } while (0)
        int e0a, e0b, e1a, e1b, e2a, e2b; uint4 ua, ub, una, unb;
        UP_LOADE(0, e0a, e0b); UP_LOADE(1, e1a, e1b); UP_LOADE(2, e2a, e2b); UP_LOADU(0, ua, ub);
        Row8 G0, G1, G2, G3;
        gather8(G0, tbu, loff, e0a, pg); gather8(G1, tbu, loff, e0b, pg); gather8(G2, tbu, loff, e1a, pg);
#define UP_BODY(i, GA, GB, GC, GD) do { \
            gather8(GD, tbu, loff, e1b, pg); UP_LOADU((i) + 1, una, unb); int e3a, e3b; UP_LOADE((i) + 3, e3a, e3b); \
            h2t u[8]; u[0] = (h2t){(_Float16)bflo(ua.x), (_Float16)bfhi(ua.x)}; u[1] = (h2t){(_Float16)bflo(ua.y), (_Float16)bfhi(ua.y)}; u[2] = (h2t){(_Float16)bflo(ua.z), (_Float16)bfhi(ua.z)}; u[3] = (h2t){(_Float16)bflo(ua.w), (_Float16)bfhi(ua.w)}; \
            u[4] = (h2t){(_Float16)bflo(ub.x), (_Float16)bfhi(ub.x)}; u[5] = (h2t){(_Float16)bflo(ub.y), (_Float16)bfhi(ub.y)}; u[6] = (h2t){(_Float16)bflo(ub.z), (_Float16)bfhi(ub.z)}; u[7] = (h2t){(_Float16)bflo(ub.w), (_Float16)bfhi(ub.w)}; \
            float dv[16]; \
            _Pragma("unroll") for (int k = 0; k < 8; ++k) dv[k] = peer_dot16h(GA.r[k], u); \
            gather8(GA, tbu, loff, e2a, pg); \
            _Pragma("unroll") for (int k = 0; k < 8; ++k) dv[8 + k] = peer_dot16h(GB.r[k], u); \
            const f2v r2 = rscatter16(dv, p0, p1, p2, 1, 2, 4);                          \
            if ((i) < nt) { _Float16* po = part_out + (size_t)UP_TOK(i) * NSLOT; po[0] = (_Float16)(r2.x * 0.0625f); po[8] = (_Float16)(r2.y * 0.0625f); } \
            e1a = e2a; e1b = e2b; e2a = e3a; e2b = e3b; ua = una; ub = unb; } while (0)
        for (int i = 0; i < nt; i += 2) { UP_BODY(i, G0, G1, G2, G3); UP_BODY(i + 1, G2, G3, G0, G1); }
#undef UP_BODY
#undef UP_LOADU
#undef UP_LOADE
#undef UP_TOK
    }
}
__device__ __forceinline__ void phase10(const Prm& p, const Frame& F) {
    static_assert(NE <= 16384 && NSLOT == 128 && T % 64 == 0, "14-bit expert id, 64-token groups");
    LAS unsigned* tile = (LAS unsigned*)F.lds;
    for (int tg = F.bid; tg < T / 64; tg += F.G) {
        __syncthreads();
#pragma unroll 4
        for (int k = 0; k < 16; ++k) { const int idx = F.tid + NTHR * k, tl = idx >> 7, sl = idx & 127; const size_t i = ((size_t)tg * 64 + tl) * NSLOT + sl; float s = 0.f;
#pragma unroll
            for (int ds = 0; ds < NDS; ++ds) s += (float)((const _Float16*)p.SC())[(size_t)ds * T * NSLOT + i];
            s *= 16.f;
            const int e = p.EIDX()[i]; const _Float16 w = (_Float16)(p.EW()[i] * gelu_exact(s * p.RSU()[e]) * p.RSV()[e] * 256.f);
            tile[tl * 129 + sl] = (((unsigned)__builtin_bit_cast(unsigned short, w) << 16) & 0xFFFE0000u) | ((unsigned)e << 3); }
        __syncthreads();
        uint4* pk = (uint4*)p.EW() + (size_t)tg * 64 * (NSLOT / 4);
#pragma unroll
        for (int k = 0; k < 4; ++k) { const int j = F.tid + NTHR * k, sq = j >> 6, tl = j & 63; const LAS unsigned* tp = tile + tl * 129 + 4 * sq; pk[j] = make_uint4(tp[0], tp[1], tp[2], tp[3]); }
    }
}
__device__ __forceinline__ void phase11(const Prm& p, const Frame& F) {
    static_assert(NE * 8 <= RING_BYTES && D % 8 == 0 && NE <= 65536, "table slice fits the LDS ring");
    typedef _Float16 h2v __attribute__((ext_vector_type(2)));
    const int c0 = (F.G % 8 == 0) ? (F.bid % 8) * (F.G / 8) + F.bid / 8 : F.bid;
    for (int sidx = c0; sidx < D / 8; sidx += F.G) {
        __syncthreads();
        { const uint4* src = (const uint4*)(p.PV8S() + (size_t)sidx * NE * 8);
          for (int i = F.tid; i < NE / 2; i += NTHR) *(LAS u32x4_t*)(F.lds + 16 * i) = __builtin_bit_cast(u32x4_t, src[i]); }
        __syncthreads();
        const int ntg = (T / 64 - F.wave + NWAVES - 1) / NWAVES, nb = 8 * ntg;
        uint4 b0[4], b1[4], b2[4], b3[4];
        const int kx = (F.G % 8 == 0) ? F.bid >> 3 : F.bid, rot = kx & 3, rotb = (kx >> 2) & 7;
#define DN_TG(bi) (F.wave + ((((bi) >> 3) + rot) % ntg) * NWAVES)
#define DN_PTR(bi) ((const uint4*)p.EW() + (size_t)DN_TG(bi) * 64 * (NSLOT / 4) + ((((bi) & 7) + rotb) & 7) * 4 * 64 + F.lane)
#define DN_LOAD(B, bi) do { const int bc_ = (bi) < nb ? (bi) : nb - 1; const uint4* pk_ = DN_PTR(bc_); _Pragma("unroll") for (int k = 0; k < 4; ++k) B[k] = pk_[k * 64]; } while (0)
#define DN_ONE(v_) do { const unsigned vv_ = (v_); const _Float16 w = __builtin_bit_cast(_Float16, (unsigned short)(vv_ >> 16)); const h2v w2 = {w, w}; \
                const u2v t = *(const LAS u2v*)(F.lds + (vv_ & 0x1FFF8u)); const unsigned tx_ = t.x, ty_ = t.y; \
                a0 += __builtin_amdgcn_cvt_scalef32_pk_f16_fp8(tx_, 1.0f, false) * w2; a1 += __builtin_amdgcn_cvt_scalef32_pk_f16_fp8(tx_, 1.0f, true) * w2; \
                a2 += __builtin_amdgcn_cvt_scalef32_pk_f16_fp8(ty_, 1.0f, false) * w2; a3 += __builtin_amdgcn_cvt_scalef32_pk_f16_fp8(ty_, 1.0f, true) * w2; } while (0)
#ifndef DN_REP
#define DN_REP 0
#endif
#define DN_ACC(B) do { _Pragma("unroll") for (int k = 0; k < 4; ++k) { DN_ONE(B[k].x); DN_ONE(B[k].y); DN_ONE(B[k].z); DN_ONE(B[k].w); } asm volatile("" ::: "memory"); \
            if (DN_REP) { const h2v s0_ = a0, s1_ = a1, s2_ = a2, s3_ = a3; for (int rep_ = 0; rep_ < DN_REP; ++rep_) { _Pragma("unroll") for (int k = 0; k < 4; ++k) { DN_ONE(B[k].x); DN_ONE(B[k].y); DN_ONE(B[k].z); DN_ONE(B[k].w); } \
                asm volatile("" :: "v"(a0), "v"(a1), "v"(a2), "v"(a3) : "memory"); } a0 = s0_; a1 = s1_; a2 = s2_; a3 = s3_; } } while (0)
        DN_LOAD(b0, 0); DN_LOAD(b1, 1); DN_LOAD(b2, 2);
        for (int bi = 0; bi < nb; bi += 8) {
            h2v a0 = {0, 0}, a1 = {0, 0}, a2 = {0, 0}, a3 = {0, 0};
            DN_LOAD(b3, bi + 3); DN_ACC(b0);
            DN_LOAD(b0, bi + 4); DN_ACC(b1);
            DN_LOAD(b1, bi + 5); DN_ACC(b2);
            DN_LOAD(b2, bi + 6); DN_ACC(b3);
            DN_LOAD(b3, bi + 7); DN_ACC(b0);
            DN_LOAD(b0, bi + 8); DN_ACC(b1);
            DN_LOAD(b1, bi + 9); DN_ACC(b2);
            DN_LOAD(b2, bi + 10); DN_ACC(b3);
            const int tg = DN_TG(bi); const float us = 1.f / 256.f;
            const uint4 yv = make_uint4(pk2((float)a0[0] * us, (float)a0[1] * us), pk2((float)a1[0] * us, (float)a1[1] * us), pk2((float)a2[0] * us, (float)a2[1] * us), pk2((float)a3[0] * us, (float)a3[1] * us));
            *(uint4*)(p.Y() + ((size_t)tg * 64 + F.lane) * D + 8 * sidx) = yv;
#if defined(DN_STORE_REP)
            for (int rep_ = 0; rep_ < DN_STORE_REP; ++rep_) { asm volatile("" ::: "memory"); __builtin_nontemporal_store(__builtin_bit_cast(u32x4_t, yv), (u32x4_t*)(p.Y() + ((size_t)tg * 64 + F.lane) * D + 8 * sidx)); }
#endif
        }
#undef DN_ACC
#undef DN_ONE
#undef DN_LOAD
#undef DN_PTR
#undef DN_TG
    }
}
__device__ __forceinline__ void phase12(const Prm& p, const Frame& F) {
    const int gw = F.bid * NWAVES + F.wave, NGW = F.G * NWAVES;
    float4 v[8]; uint2 xb[8], xn[8];
    if (gw < T) { const uint2* xr = (const uint2*)(p.X1B() + (size_t)gw * D) + F.lane;
#pragma unroll
        for (int j = 0; j < 8; ++j) xb[j] = xr[64 * j]; }
    for (int row = gw; row < T; row += NGW) {
        float4* zr = (float4*)(p.out + (size_t)row * D) + F.lane; float s = 0.f;
        if (row + NGW < T) { const uint2* xp = (const uint2*)(p.X1B() + (size_t)(row + NGW) * D) + F.lane;
#pragma unroll
            for (int j = 0; j < 8; ++j) xn[j] = xp[64 * j]; }
        const float* g2 = p.MOD() + (size_t)(row / S) * D6 + 5 * D;
#pragma unroll
        for (int j = 0; j < 8; ++j) { const uint2 y = *((const uint2*)(p.Y() + (size_t)row * D) + F.lane + 64 * j); const float4 g = *((const float4*)g2 + F.lane + 64 * j);
            v[j].x = ALPHA * bflo(xb[j].x) + g.x * bflo(y.x); v[j].y = ALPHA * bfhi(xb[j].x) + g.y * bfhi(y.x); v[j].z = ALPHA * bflo(xb[j].y) + g.z * bflo(y.y); v[j].w = ALPHA * bfhi(xb[j].y) + g.w * bfhi(y.y);
            s += (v[j].x + v[j].y) + (v[j].z + v[j].w); }
        const float mean = wave_sum(s) * (1.f / D); float s2 = 0.f;
#pragma unroll
        for (int j = 0; j < 8; ++j) { v[j].x -= mean; v[j].y -= mean; v[j].z -= mean; v[j].w -= mean; s2 += (v[j].x * v[j].x + v[j].y * v[j].y) + (v[j].z * v[j].z + v[j].w * v[j].w); }
        const float rstd = 1.f / sqrtf(wave_sum(s2) * (1.f / D) + LN_EPS);
#pragma unroll
        for (int j = 0; j < 8; ++j) { const float4 w = *((const float4*)p.ln2_w + F.lane + 64 * j), bb = *((const float4*)p.ln2_b + F.lane + 64 * j);
            zr[64 * j] = make_float4(v[j].x * rstd * w.x + bb.x, v[j].y * rstd * w.y + bb.y, v[j].z * rstd * w.z + bb.z, v[j].w * rstd * w.w + bb.w); }
#pragma unroll
        for (int j = 0; j < 8; ++j) xb[j] = xn[j];
    }
}

struct Args { const float* in[18]; float* out; unsigned char* ws; int ph_lo, ph_hi, li, pad; };
__global__ void __launch_bounds__(NTHR, 2) mk_fwd(Args args) {
    extern __shared__ __attribute__((aligned(16))) unsigned char lds_raw[];
    Frame F; F.lds = (LAS unsigned char*)lds_raw; F.tid = threadIdx.x; F.lane = F.tid & 63; F.wave = __builtin_amdgcn_readfirstlane(F.tid >> 6); F.G = gridDim.x; F.bid = blockIdx.x;
    Prm p; p.x = args.in[0]; p.c = args.in[1]; p.w_ada = args.in[2]; p.b_ada = args.in[3]; p.w_in = args.in[4]; p.b_in = args.in[5]; p.conv_w = args.in[6]; p.conv_b = args.in[7]; p.mnorm_w = args.in[8];
    p.w_out = args.in[9]; p.ln1_w = args.in[10]; p.ln1_b = args.in[11]; p.wq = args.in[12]; p.subkeys = args.in[13]; p.peer_u = args.in[14]; p.peer_v = args.in[15]; p.ln2_w = args.in[16]; p.ln2_b = args.in[17];
    p.out = args.out; p.ws = args.ws;
    volatile LAS unsigned* MISC = (volatile LAS unsigned*)(F.lds + MISC_OFF);
    for (int u = F.tid; u < (LDS_BYTES - LDSCTL_OFF) / 4; u += NTHR) ((LAS unsigned*)(F.lds + LDSCTL_OFF))[u] = 0u;
    __syncthreads();
    const int lo = args.ph_lo, hi = args.ph_hi;
    XcdBarrier bar; bar.bar = (unsigned*)(p.ws + WS_CTL) + CW_BAR + args.li * XCD_BAR_WORDS; bar.x = 0; bar.st = nullptr;
    if (hi - lo > 1) bar = xcd_barrier_post((unsigned*)(p.ws + WS_CTL) + CW_BAR + args.li * XCD_BAR_WORDS, MISC + 8);
#define IN(k) (lo <= (k) && (k) < hi)
#define SEAM(k) do { if (IN(k) && IN((k) + 1)) xcd_barrier(bar); } while (0)
    XW xw; xw.nx = (F.G % 8 == 0) ? 8 : 1; xw.vx = F.bid % xw.nx; xw.rank = F.bid / xw.nx; xw.nloc = F.G / xw.nx;
#define XW_FROM_CENSUS() do { if (hi - lo > 1) { if (F.tid == 0) { unsigned vx_ = 0u; for (unsigned j = 0; j < bar.x; ++j) vx_ += xb_ld(&bar.bar[XB_XCNT(j)]) > 0u ? 1u : 0u; MISC[11] = vx_; } __syncthreads(); \
        xw.vx = (int)MISC[11]; xw.nx = (int)MISC[9]; xw.rank = (int)MISC[10] - 1; xw.nloc = (int)MISC[8]; } } while (0)
    if (IN(0)) { phase0(p, F); deferred_prep<false, true, true>(p, F, 0, F.G); } SEAM(0);
    if (IN(1)) { phase1(p, F); } SEAM(1);
    if (IN(2)) { pg8::Gemm g{p.U(), p.WIN_T(), T, INM, D}; pg8::StaticOrder So; So.init(T, INM, F.G, F.bid);
        pg8::EpiBf16<0> E{p.PJ(), INM, p.b_in, 0, 0, 1.f};
        pg8::gemm_phase<pg8::EpiBf16<0>, pg8::StaticOrder, true, true>(F.lds, g, So, E); } SEAM(2);
    if (IN(3)) { const int nmb = F.G >= 2 ? F.G / 2 : 1;
#ifndef P3_REP_ML
#define P3_REP_ML 1
#define P3_REP_CONV 1
#endif
        if (F.bid < nmb) { for (int rep_ = 0; rep_ < P3_REP_ML; ++rep_) for (int u = F.bid; u < 2 * NB * MH * 2; u += nmb) ml::unit(p, F, u); if (F.G < 2) phase3a(p, F, 0, 1); }
        else { phase3a(p, F, nmb, F.G - nmb); deferred_prep<true, false, false>(p, F, nmb, F.G - nmb); }
        if (F.G < 2) deferred_prep<true, false, false>(p, F, 0, 1); } SEAM(3);
    if (IN(4)) { phase4(p, F); } SEAM(4);
    if (IN(5)) { pg8::Gemm g{p.Y(), p.WOUT_T(), T, D, D}; pg8::StaticOrder So; So.init(T, D, F.G, F.bid);
        EpiZ E{p.x, p.MOD(), (bf16_t*)p.out};
        pg8::gemm_phase<EpiZ, pg8::StaticOrder, true, true>(F.lds, g, So, E); } SEAM(5);
    if (IN(6)) { phase6(p, F); } SEAM(6);
    if (IN(7)) { pg8::Gemm g{p.U(), p.WQ_T(), T, NQ, D}; pg8::StaticOrder So; So.init(T, NQ, F.G, F.bid);
        EpiF32 E{p.SC(), NSC};
        pg8::gemm_phase<EpiF32, pg8::StaticOrder, true, true>(F.lds, g, So, E); } SEAM(7);
    if (IN(8)) { phase8(p, F); } SEAM(8);
    if (IN(9)) { if (lo < 9) XW_FROM_CENSUS(); phase9(p, F, xw); } SEAM(9);
    if (IN(10)) { phase10(p, F); } SEAM(10);
    if (IN(11)) { phase11(p, F); } SEAM(11);
    if (IN(12)) { phase12(p, F); }
#undef IN
#undef SEAM
}

extern "C" void kernel_launch(void* const* d_in, const int* in_sizes, int n_in, void* d_out, int out_size, void* d_ws, size_t ws_size, hipStream_t stream) {
    static int grid = 0;
    if (grid == 0) {
        if (n_in != 18 || out_size != T * D || ws_size < WS_END) { fprintf(stderr, "kernel_launch: unexpected shapes (n_in %d out %d ws %zu, need %zu)\n", n_in, out_size, ws_size, (size_t)WS_END); grid = -1; return; }
        int dev = 0, cus = 0, per_cu = 0;
        if (hipGetDevice(&dev) != hipSuccess || hipDeviceGetAttribute(&cus, hipDeviceAttributeMultiprocessorCount, dev) != hipSuccess) { grid = -1; return; }
        if (hipFuncSetAttribute((const void*)mk_fwd, hipFuncAttributeMaxDynamicSharedMemorySize, LDS_BYTES) != hipSuccess) { fprintf(stderr, "kernel_launch: hipFuncSetAttribute failed\n"); grid = -1; return; }
        if (hipOccupancyMaxActiveBlocksPerMultiprocessor(&per_cu, (const void*)mk_fwd, NTHR, LDS_BYTES) != hipSuccess || per_cu < 1) { fprintf(stderr, "kernel_launch: occupancy query says %d\n", per_cu); }
        (void)hipGetLastError();
        grid = cus;
        if (T % grid != 0 || (T / grid) % NWAVES != 0) { fprintf(stderr, "kernel_launch: grid %d does not divide the rows\n", grid); grid = -1; return; }
    }
    if (grid < 0) return;
    (void)hipMemsetAsync((char*)d_ws + WS_CTL, 0, 1u << 20, stream);
    Args a{};
    for (int i = 0; i < 18; ++i) a.in[i] = (const float*)d_in[i];
    a.out = (float*)d_out; a.ws = (unsigned char*)d_ws;
#if defined(PROBE_A)
    a.ph_lo = 0; a.ph_hi = PROBE_B + 1; a.li = 0; hipLaunchKernelGGL(mk_fwd, dim3(grid), dim3(NTHR), LDS_BYTES, stream, a);
    a.ph_lo = PROBE_A; a.ph_hi = NPHASE; a.li = 1; hipLaunchKernelGGL(mk_fwd, dim3(grid), dim3(NTHR), LDS_BYTES, stream, a);
#elif MK_N_LAUNCHES == 1
    a.ph_lo = 0; a.ph_hi = NPHASE;
    hipLaunchKernelGGL(mk_fwd, dim3(grid), dim3(NTHR), LDS_BYTES, stream, a);
#else
    for (int k = 0; k < NPHASE; ++k) { a.ph_lo = k; a.ph_hi = k + 1; hipLaunchKernelGGL(mk_fwd, dim3(grid), dim3(NTHR), LDS_BYTES, stream, a); }
#endif
}
```

```cpp
#define MK_N_LAUNCHES 1
#if defined(HOST_EMU)
#include <cmath>
#include <cstdint>
#include <cstring>
#include <cstddef>
#define HD inline
#define HDF inline
#else
#include <hip/hip_runtime.h>
#define HD __host__ __device__ __forceinline__
#define HDF __host__ __device__ __forceinline__
#endif

#ifndef CFG_D
#define CFG_D 2048
#define CFG_B 8
#define CFG_S 2048
#define CFG_PH 8
#define CFG_NK 128
#define CFG_TOPK 16
#define CFG_KD 256
#endif
constexpr int D = CFG_D, NB = CFG_B, S = CFG_S, T = NB * S;
constexpr int CW = D / 2, MW = D - CW, MH = 4, MV = MW / MH, QK = MV / 2, NG = 16, CHUNK = 64;
constexpr int INC = 3 * CW + 2 * MH * QK + 2 * MW + NG;
constexpr int INM = INC - NG;
constexpr int O_GB = 0, O_GC = CW, O_HIN = 2 * CW, O_Q = 3 * CW, O_K = O_Q + MH * QK, O_V = O_K + MH * QK, O_O = O_V + MW;
constexpr int PH = CFG_PH, NK = CFG_NK, TOPK = CFG_TOPK, KD = CFG_KD, KH = KD / 2, NE = NK * NK, NSLOT = PH * TOPK;
constexpr int NQ = PH * KD;
static_assert(PH * 2 * NK == NQ || true, "");
constexpr int NSC = PH * 2 * NK;
constexpr float LN_EPS = 1e-5f;
constexpr float ALPHA = 1.189207115002721f;
constexpr int D6 = 6 * D;

typedef unsigned short bf16_t;
HDF unsigned f_as_u(float f) { unsigned u; memcpy(&u, &f, 4); return u; }
HDF float u_as_f(unsigned u) { float f; memcpy(&f, &u, 4); return f; }
HDF bf16_t f2bf(float f) { unsigned u = f_as_u(f); return (bf16_t)((u + 0x7fffu + ((u >> 16) & 1u)) >> 16); }
HDF float bf2f(bf16_t h) { return u_as_f((unsigned)h << 16); }

constexpr size_t al(size_t x) { return (x + 1048575) & ~(size_t)1048575; }
constexpr size_t WS_CTL = 0;
constexpr size_t WS_MOD = al(1);
constexpr size_t WS_MODP = WS_MOD + al((size_t)NB * D6 * 4);
constexpr int NKS = 32;
constexpr size_t WS_GATES = WS_MODP + al((size_t)NKS * NB * D6 * 4);
constexpr size_t WS_DEN = WS_GATES + al((size_t)T * NG * 4);
constexpr size_t WS_FLR = WS_DEN + al((size_t)4 * T * MH * 4);
constexpr size_t WS_EIDX = WS_FLR + al((size_t)2 * T * MH * 4);
constexpr size_t WS_EW = WS_EIDX + al((size_t)T * NSLOT * 4);
constexpr size_t WS_WIN_T = WS_EW + al((size_t)T * NSLOT * 4);
constexpr size_t WS_WOUT_T = WS_WIN_T + al((size_t)INM * D * 2);
constexpr size_t WS_WQ_T = WS_WOUT_T + al((size_t)D * D * 2);
constexpr size_t WS_PU16 = WS_WQ_T + al((size_t)NQ * D * 2);
constexpr size_t WS_PV16 = WS_PU16 + al((size_t)NE * D * 2);
constexpr size_t WS_U = WS_PV16 + al((size_t)NE * D * 2);
constexpr size_t WS_Y = WS_U + al((size_t)T * D * 2);
constexpr size_t WS_P = WS_Y + al((size_t)T * D * 2);
constexpr size_t WS_SC = WS_P;
constexpr size_t WS_TS = WS_SC + al((size_t)T * NSC * 4);
constexpr size_t WS_TI = WS_TS + al((size_t)T * PH * 2 * TOPK * 4);
constexpr size_t WS_P_END = WS_P + al((size_t)T * INM * 2);
constexpr size_t WS_TI_END = WS_TI + al((size_t)T * PH * 2 * TOPK * 4);
constexpr size_t WS_END = WS_P_END > WS_TI_END ? WS_P_END : WS_TI_END;

struct Prm {
    const float *x, *c, *w_ada, *b_ada, *w_in, *b_in, *conv_w, *conv_b, *mnorm_w, *w_out, *ln1_w, *ln1_b, *wq, *subkeys, *peer_u, *peer_v, *ln2_w, *ln2_b;
    float* out;
    unsigned char* ws;
    HDF float* MOD() const { return (float*)(ws + WS_MOD); }
    HDF float* MODP() const { return (float*)(ws + WS_MODP); }
    HDF float* BIN256() const { return (float*)(ws + WS_MODP); }
    HDF float* GATES() const { return (float*)(ws + WS_GATES); }
    HDF float* DEN() const { return (float*)(ws + WS_DEN); }
    HDF float* FLR() const { return (float*)(ws + WS_FLR); }
    HDF int* EIDX() const { return (int*)(ws + WS_EIDX); }
    HDF float* EW() const { return (float*)(ws + WS_EW); }
    HDF bf16_t* WIN_T() const { return (bf16_t*)(ws + WS_WIN_T); }
    HDF unsigned char* WIN8() const { return ws + WS_WIN_T; }
    HDF unsigned char* U8() const { return ws + WS_U; }
    HDF bf16_t* WOUT_T() const { return (bf16_t*)(ws + WS_WOUT_T); }
    HDF bf16_t* WQ_T() const { return (bf16_t*)(ws + WS_WQ_T); }
    HDF bf16_t* PU16() const { return (bf16_t*)(ws + WS_PU16); }
    HDF bf16_t* PV16() const { return (bf16_t*)(ws + WS_PV16); }
    HDF unsigned char* PU8() const { return ws + WS_PU16; }
    HDF unsigned char* PV8() const { return ws + WS_PV16; }
    HDF unsigned char* PV8S() const { return ws + WS_PV16; }
    HDF float* RSU() const { return (float*)(ws + WS_PU16 + (size_t)NE * D); }
    HDF float* RSV() const { return (float*)(ws + WS_PU16 + (size_t)NE * D + (size_t)NE * 4); }
    HDF bf16_t* U() const { return (bf16_t*)(ws + WS_U); }
    HDF bf16_t* Y() const { return (bf16_t*)(ws + WS_Y); }
    HDF bf16_t* PJ() const { return (bf16_t*)(ws + WS_P); }
    HDF float* SC() const { return (float*)(ws + WS_SC); }
    HDF bf16_t* X1B() const { return (bf16_t*)(ws + WS_TS); }
    HDF float* TS() const { return (float*)(ws + WS_TS); }
    HDF int* TI() const { return (int*)(ws + WS_TI); }
    HDF float* HF() const { return out; }
    HDF float* HB() const { return out + (size_t)T * MW; }
    HDF bf16_t* HF16() const { return (bf16_t*)out; }
    HDF bf16_t* HB16() const { return (bf16_t*)out + (size_t)T * MW; }
};

HDF float sigmoidf_(float x) { return 1.f / (1.f + expf(-x)); }
HDF float logsigmoidf_(float x) { return fminf(x, 0.f) - log1pf(expf(-fabsf(x))); }
HDF float gelu_exact(float x) { return 0.5f * x * (1.f + erff(x * 0.7071067811865476f)); }

HD void b_ada(const Prm& p, long n) {
    float acc[NB];
#pragma unroll
    for (int b = 0; b < NB; ++b) acc[b] = 0.f;
    for (int k = 0; k < D; ++k) {
        const float w = p.w_ada[(size_t)k * D6 + n];
#pragma unroll
        for (int b = 0; b < NB; ++b) { const float cv = p.c[b * D + k]; acc[b] += cv * sigmoidf_(cv) * w; }
    }
#pragma unroll
    for (int b = 0; b < NB; ++b) p.MOD()[(size_t)b * D6 + n] = acc[b] + p.b_ada[n];
}
HD void b_wt(const float* W, int ldw, int K, bf16_t* WT, long i) { const long n = i / K, k = i % K; WT[i] = f2bf(W[(size_t)k * ldw + n]); }
HD void b_tab(const float* src, bf16_t* dst, long i) { dst[i] = f2bf(src[i]); }
HD void b_ln_mod1(const Prm& p, long row) {
    const float* xr = p.x + (size_t)row * D; const int b = (int)(row / S);
    const float* sh = p.MOD() + (size_t)b * D6; const float* sc = sh + D;
    float s = 0.f; for (int d = 0; d < D; ++d) s += xr[d];
    const float mean = s / D; float q = 0.f; for (int d = 0; d < D; ++d) { const float t = xr[d] - mean; q += t * t; }
    const float rstd = 1.f / sqrtf(q / D + LN_EPS);
    for (int d = 0; d < D; ++d) p.U()[(size_t)row * D + d] = f2bf((xr[d] - mean) * rstd * (1.f + sc[d]) + sh[d]);
}
HD void b_gates(const Prm& p, long i) {
    const long row = i / NG; const int g = (int)(i % NG); float acc = 0.f;
    for (int d = 0; d < D; ++d) acc += bf2f(p.U()[(size_t)row * D + d]) * p.w_in[(size_t)d * INC + INM + g];
    p.GATES()[i] = acc + p.b_in[INM + g];
}
HD float b_dot16(const bf16_t* a, const bf16_t* b, int K) { float acc = 0.f; for (int k = 0; k < K; ++k) acc += bf2f(a[k]) * bf2f(b[k]); return acc; }
HD void b_gemm1(const Prm& p, long i) { const long row = i / INM; const int n = (int)(i % INM);
    p.PJ()[i] = f2bf(b_dot16(p.U() + (size_t)row * D, p.WIN_T() + (size_t)n * D, D) + p.b_in[n]); }
HD void b_conv(const Prm& p, long i) {
    const long row = i / CW; const int ch = (int)(i % CW); const int s = (int)(row % S);
    const bf16_t* pj = p.PJ(); float acc = p.conv_b[ch];
#pragma unroll
    for (int k = 0; k < 3; ++k) { const int s2 = s + k - 1; if (s2 >= 0 && s2 < S) { const size_t r2 = (size_t)(row + k - 1) * INM;
        acc += p.conv_w[k * CW + ch] * (bf2f(pj[r2 + O_GC + ch]) * bf2f(pj[r2 + O_HIN + ch])); } }
    p.Y()[(size_t)row * D + ch] = f2bf(bf2f(pj[(size_t)row * INM + O_GB + ch]) * acc);
}
HDF long ml_tok(int dir, int b, int pos) { return (long)b * S + (dir ? S - 1 - pos : pos); }
HD void b_mscan(const Prm& p, long i) {
    const int v = (int)(i % (MV + 1)), h = (int)((i / (MV + 1)) % MH), b = (int)((i / ((MV + 1) * MH)) % NB), dir = (int)(i / ((MV + 1) * MH * NB));
    float C[QK];
#pragma unroll
    for (int d = 0; d < QK; ++d) C[d] = 0.f;
    float m = 0.f; const float qs = 1.f / sqrtf((float)QK);
    float* H = dir ? p.HB() : p.HF();
    for (int pos = 0; pos < S; ++pos) {
        const long tok = ml_tok(dir, b, pos); const float* g = p.GATES() + tok * NG + dir * 8;
        const float ig = g[h], lf = logsigmoidf_(g[4 + h]);
        const float mn = fmaxf(lf + m, ig), dec = expf(lf + m - mn), wi = expf(ig - mn); m = mn;
        const bf16_t* pj = p.PJ() + (size_t)tok * INM; const float wv = wi * (v < MV ? bf2f(pj[O_V + h * MV + (v < MV ? v : 0)]) : 1.f); float num = 0.f;
#pragma unroll
        for (int d = 0; d < QK; ++d) { C[d] = dec * C[d] + wv * bf2f(pj[O_K + h * QK + d]); num += bf2f(pj[O_Q + h * QK + d]) * qs * C[d]; }
        if (v < MV) H[(size_t)tok * MW + h * MV + v] = num;
        else { p.DEN()[((size_t)dir * T + tok) * MH + h] = num; p.FLR()[((size_t)dir * T + tok) * MH + h] = expf(-mn); }
    }
}
HD void b_headnorm(const Prm& p, long i) {
    const long row = i / MH; const int h = (int)(i % MH);
    const float* hf = p.HF() + (size_t)row * MW + h * MV; const float* hb = p.HB() + (size_t)row * MW + h * MV;
    const float inf_ = 1.f / fmaxf(fabsf(p.DEN()[(size_t)row * MH + h]), p.FLR()[(size_t)row * MH + h]);
    const float inb_ = 1.f / fmaxf(fabsf(p.DEN()[((size_t)T + row) * MH + h]), p.FLR()[((size_t)T + row) * MH + h]);
    float s = 0.f; for (int v = 0; v < MV; ++v) s += hf[v] * inf_ + hb[v] * inb_;
    const float mean = s / MV; float q = 0.f; for (int v = 0; v < MV; ++v) { const float t = hf[v] * inf_ + hb[v] * inb_ - mean; q += t * t; }
    const float rstd = 1.f / sqrtf(q / MV + LN_EPS);
    for (int v = 0; v < MV; ++v) { const float hn = (hf[v] * inf_ + hb[v] * inb_ - mean) * rstd * p.mnorm_w[h * MV + v];
        const float og = sigmoidf_(bf2f(p.PJ()[(size_t)row * INM + O_O + h * MV + v]));
        p.Y()[(size_t)row * D + CW + h * MV + v] = f2bf(og * hn); }
}
HD void b_gemm2(const Prm& p, long i) { const long row = i / D; const int n = (int)(i % D); const int b = (int)(row / S);
    const float acc = b_dot16(p.Y() + (size_t)row * D, p.WOUT_T() + (size_t)n * D, D);
    p.out[i] = ALPHA * p.x[i] + p.MOD()[(size_t)b * D6 + 2 * D + n] * acc; }
HD void b_ln_mid(const Prm& p, long row) {
    float* zr = p.out + (size_t)row * D; const int b = (int)(row / S);
    const float* sh = p.MOD() + (size_t)b * D6 + 3 * D; const float* sc = sh + D;
    float s = 0.f; for (int d = 0; d < D; ++d) s += zr[d];
    float mean = s / D; float q = 0.f; for (int d = 0; d < D; ++d) { const float t = zr[d] - mean; q += t * t; }
    float rstd = 1.f / sqrtf(q / D + LN_EPS);
    s = 0.f; for (int d = 0; d < D; ++d) { const float x1 = (zr[d] - mean) * rstd * p.ln1_w[d] + p.ln1_b[d]; zr[d] = x1; s += x1; }
    mean = s / D; q = 0.f; for (int d = 0; d < D; ++d) { const float t = zr[d] - mean; q += t * t; }
    rstd = 1.f / sqrtf(q / D + LN_EPS);
    for (int d = 0; d < D; ++d) p.U()[(size_t)row * D + d] = f2bf((zr[d] - mean) * rstd * (1.f + sc[d]) + sh[d]);
}
HD void b_gemm3(const Prm& p, long i) { const long row = i / NQ; const int n = (int)(i % NQ);
    p.Y()[i] = f2bf(b_dot16(p.U() + (size_t)row * D, p.WQ_T() + (size_t)n * D, D)); }
HD void b_scores(const Prm& p, long i) { const long tok = i / NSC; const int c = (int)(i % NSC), grp = c / NK, n = c % NK;
    const bf16_t* q = p.Y() + (size_t)tok * NQ + grp * KH; const float* sk = p.subkeys + ((size_t)grp * NK + n) * KH; float acc = 0.f;
    for (int d = 0; d < KH; ++d) acc += bf2f(q[d]) * sk[d];
    p.SC()[i] = acc; }
HD void b_topk1(const Prm& p, long i) {
    const float* sc = p.SC() + (size_t)i * NK; float pv = INFINITY; int pi = -1;
    for (int r = 0; r < TOPK; ++r) { float best = -INFINITY; int bi = -1;
        for (int n = 0; n < NK; ++n) { const float v = sc[n]; const bool ok = (v < pv) || (v == pv && n > pi); if (ok && v > best) { best = v; bi = n; } }
        p.TS()[(size_t)i * TOPK + r] = best; p.TI()[(size_t)i * TOPK + r] = bi; pv = best; pi = bi; }
}
HD void b_topk2(const Prm& p, long i) {
    const float* s0 = p.TS() + (size_t)i * 2 * TOPK; const float* s1 = s0 + TOPK; const int* i0 = p.TI() + (size_t)i * 2 * TOPK; const int* i1 = i0 + TOPK;
    float pv = INFINITY; int pi = -1; float mx = 0.f, sum = 0.f;
    for (int r = 0; r < TOPK; ++r) { float best = -INFINITY; int bi = -1;
        for (int c = 0; c < TOPK * TOPK; ++c) { const float v = s0[c / TOPK] + s1[c % TOPK]; const bool ok = (v < pv) || (v == pv && c > pi); if (ok && v > best) { best = v; bi = c; } }
        if (r == 0) mx = best;
        const float e = expf(best - mx); sum += e;
        p.EIDX()[(size_t)i * TOPK + r] = i0[bi / TOPK] * NK + i1[bi % TOPK]; p.EW()[(size_t)i * TOPK + r] = e; pv = best; pi = bi; }
    for (int r = 0; r < TOPK; ++r) p.EW()[(size_t)i * TOPK + r] /= sum;
}
HD void b_up(const Prm& p, long i) { const long tok = i / NSLOT; const int e = p.EIDX()[i];
    p.EW()[i] *= gelu_exact(b_dot16(p.U() + (size_t)tok * D, p.PU16() + (size_t)e * D, D)); }
HD void b_down(const Prm& p, long i) { const long tok = i / D; const int d = (int)(i % D); const int b = (int)(tok / S); float y = 0.f;
    for (int sl = 0; sl < NSLOT; ++sl) y += p.EW()[tok * NSLOT + sl] * bf2f(p.PV16()[(size_t)p.EIDX()[tok * NSLOT + sl] * D + d]);
    p.out[i] = ALPHA * p.out[i] + p.MOD()[(size_t)b * D6 + 5 * D + d] * y; }
HD void b_ln2(const Prm& p, long row) {
    float* zr = p.out + (size_t)row * D;
    float s = 0.f; for (int d = 0; d < D; ++d) s += zr[d];
    const float mean = s / D; float q = 0.f; for (int d = 0; d < D; ++d) { const float t = zr[d] - mean; q += t * t; }
    const float rstd = 1.f / sqrtf(q / D + LN_EPS);
    for (int d = 0; d < D; ++d) zr[d] = (zr[d] - mean) * rstd * p.ln2_w[d] + p.ln2_b[d];
}
#include <cstdio>
#define LAS __attribute__((address_space(3)))
#define GAS __attribute__((address_space(1)))
namespace pg8 {
#define PG8_LAS __attribute__((address_space(3)))
typedef unsigned short bf16_t;
typedef short bf16x8 __attribute__((ext_vector_type(8)));
typedef float f32x4 __attribute__((ext_vector_type(4)));
typedef unsigned u32x4 __attribute__((ext_vector_type(4)));
constexpr int BM = 256, BK = 64, HALF = 128, HTB = HALF * BK * 2  , STAGE_BYTES = 8 * HTB, NXCD = 8, WGM = 8;

__host__ __device__ __forceinline__ int lds_byte(int r, int c) { const int st = (r >> 4) * 2 + (c >> 5), rr = r & 15, cc = c & 31, ob = rr * 64 + cc * 2; return st * 1024 + (ob ^ (((ob >> 9) & 1) << 5)); }
__host__ __device__ __forceinline__ void stage_rc(int b, int& R, int& C) { const int st = b / 1024, sb = b % 1024, swz = sb ^ (((sb >> 9) & 1) << 5); R = (st >> 1) * 16 + swz / 64; C = (st & 1) * 32 + (swz % 64) / 2; }
__host__ __device__ __forceinline__ int perm32(int rho) { const int n = rho >> 4, i = rho & 15; return 8 * (i >> 2) + 4 * n + (i & 3); }

struct Unit { int pm, pn; };
struct Gemm { const bf16_t* A; const bf16_t* Bt; int M, N, K; };

struct StaticOrder {
    int nM, nN, nwg, G, c;
    __host__ __device__ void init(int M, int N, int G_, int c_) { nM = M / BM; nN = N / BM; nwg = nM * nN; G = G_; c = c_; }
    __host__ __device__ bool next(int i, Unit& u) const {
        const long L = (long)i * G + c; if (L >= nwg) return false;
        int wgid = (int)L; { const int q = nwg / NXCD, r = nwg % NXCD, xcd = wgid % NXCD, off = wgid / NXCD; wgid = (xcd < r ? xcd * (q + 1) : r * (q + 1) + (xcd - r) * q) + off; }
        const int nig = WGM * nN, gid = wgid / nig, fm = gid * WGM, gsz = (nM - fm) < WGM ? (nM - fm) : WGM;
        u.pm = fm + ((wgid % nig) % gsz); u.pn = (wgid % nig) / gsz; return true;
    }
    __device__ __forceinline__ void a_ready(const Unit&) const {}
    __device__ __forceinline__ void done(const Unit&) const {}
};

__device__ __forceinline__ unsigned cvt_pk_bf16(float lo, float hi) { unsigned r; asm volatile("v_cvt_pk_bf16_f32 %0, %1, %2" : "=v"(r) : "v"(lo), "v"(hi)); return r; }
typedef float f32x2 __attribute__((ext_vector_type(2)));
__device__ __forceinline__ f32x2 gelu_pk(f32x2 v) {
    const f32x2 av = __builtin_elementwise_abs(v), d = av * 0.2316418882f + 1.0f;
    f32x2 t; t.x = __builtin_amdgcn_rcpf(d.x); t.y = __builtin_amdgcn_rcpf(d.y);
    f32x2 q = t * 0.5307027145f + (-0.7265760135f); q = q * t + 0.7107068705f; q = q * t + (-0.142248368f); q = q * t + 0.127414796f; q = q * t;
    const f32x2 s = (v * v) * (-0.72134752044f);
    f32x2 e; e.x = __builtin_amdgcn_exp2f(s.x); e.y = __builtin_amdgcn_exp2f(s.y);
    const f32x2 m = v * (q * e), r = v - m;
    f32x2 o; o.x = v.x < 0.f ? m.x : r.x; o.y = v.y < 0.f ? m.y : r.y; return o;
}

template <int ACT  > struct EpiBf16 {
    static constexpr bool PERM = true, AFTER_DRAIN = false; static_assert(ACT == 0 || ACT == 1, "EpiBf16: ACT is 0 (none) or 1 (gelu_pk)");
    bf16_t* O; int ldc; const float* bias; int split_cols; size_t split_stride; float scale0;
    __device__ __forceinline__ void operator()(const f32x4 (&acc)[2][2][4][2], const Unit& u, int wr, int wc, int fr, int fq) const {
        const int row0 = u.pm * BM + wr * 64 + fr; int colt = u.pn * BM; bf16_t* base = O;
        float sc = 1.f; if (split_cols) { const int t = colt / split_cols; base += (size_t)t * split_stride; colt -= t * split_cols; if (t == 0) sc = scale0; }
        const int col0 = colt + wc * 32 + 8 * fq, bcol0 = u.pn * BM + wc * 32 + 8 * fq;
        f32x4 bv[2][2];
#pragma unroll
        for (int bj = 0; bj < 2; ++bj)
#pragma unroll
            for (int n = 0; n < 2; ++n) bv[bj][n] = bias ? *(const f32x4*)(bias + bcol0 + bj * HALF + 4 * n) : (f32x4){0.f, 0.f, 0.f, 0.f};
#pragma unroll
        for (int ai = 0; ai < 2; ++ai)
#pragma unroll
            for (int m = 0; m < 4; ++m) { bf16_t* rowp = base + (size_t)(row0 + ai * HALF + m * 16) * ldc + col0;
#pragma unroll
                for (int bj = 0; bj < 2; ++bj) { f32x4 v0 = acc[ai][bj][m][0] + bv[bj][0], v1 = acc[ai][bj][m][1] + bv[bj][1];
                    if (ACT == 1) { f32x2 a = gelu_pk((f32x2){v0[0], v0[1]}), b = gelu_pk((f32x2){v0[2], v0[3]}), c = gelu_pk((f32x2){v1[0], v1[1]}), d = gelu_pk((f32x2){v1[2], v1[3]});
                        v0 = (f32x4){a.x, a.y, b.x, b.y}; v1 = (f32x4){c.x, c.y, d.x, d.y}; }
                    v0 = v0 * sc; v1 = v1 * sc; u32x4 w; w.x = cvt_pk_bf16(v0[0], v0[1]); w.y = cvt_pk_bf16(v0[2], v0[3]); w.z = cvt_pk_bf16(v1[0], v1[1]); w.w = cvt_pk_bf16(v1[2], v1[3]);
                    *(u32x4*)(rowp + bj * HALF) = w; } }
    }
};
template <class Epi, class Sched, bool ALIGN_EPI = false, bool SP2 = false>
__device__ __forceinline__ void gemm_phase(PG8_LAS unsigned char* lds, const Gemm g, const Sched& S, const Epi& E) {
    const int tid = threadIdx.x, wid = __builtin_amdgcn_readfirstlane(tid >> 6), lane = tid & 63, wr = wid >> 2, wc = wid & 3, fr = lane & 15, fq = lane >> 4;
    const int K = g.K, nt = K / BK;
    unsigned voffA[2], voffB[2];
#pragma unroll
    for (int i = 0; i < 2; ++i) { int R, C; stage_rc(tid * 16 + i * 8192, R, C); const int Rb = Epi::PERM ? ((R & ~31) + perm32(R & 31)) : R;
        voffA[i] = (unsigned)(R * K + C) * 2u; voffB[i] = (unsigned)(Rb * K + C) * 2u; }
    const size_t kstep = (size_t)(BK * 2);
    const size_t hstep = (size_t)HALF * K * 2;
    const size_t tstep = 2 * hstep;
    const unsigned ldsw = (unsigned)wid * 1024u;
    const int aoff = lds_byte(wr * 64 + fr, fq * 8), boff = lds_byte(wc * 32 + fr, fq * 8);
#define PG8_SA(b, h) (((b) * 2 + (h)) * HTB)
#define PG8_SB(b, h) ((4 + (b) * 2 + (h)) * HTB)
#define PG8_STAGE(bufoff, gbase, voff) do { _Pragma("unroll") for (int _i = 0; _i < 2; ++_i) \
        __builtin_amdgcn_global_load_lds((const unsigned*)((const char*)(gbase) + (voff)[_i]), (PG8_LAS unsigned*)(lds + (bufoff) + ldsw + _i * 8192), 16, 0, 0); } while (0)
#define PG8_LDA(dst, b, h) do { _Pragma("unroll") for (int m = 0; m < 4; ++m) _Pragma("unroll") for (int k = 0; k < 2; ++k) dst[m][k] = *(const PG8_LAS bf16x8*)(lds + PG8_SA(b, h) + aoff + m * 2048 + k * 1024); } while (0)
#define PG8_LDB(dst, b, h) do { _Pragma("unroll") for (int n = 0; n < 2; ++n) _Pragma("unroll") for (int k = 0; k < 2; ++k) dst[n][k] = *(const PG8_LAS bf16x8*)(lds + PG8_SB(b, h) + boff + n * 2048 + k * 1024); } while (0)
#define PG8_MMA(ai, bj, At, Bt) do { __builtin_amdgcn_s_setprio(1); _Pragma("unroll") for (int m = 0; m < 4; ++m) _Pragma("unroll") for (int n = 0; n < 2; ++n) _Pragma("unroll") for (int k = 0; k < 2; ++k) \
        acc[ai][bj][m][n] = __builtin_amdgcn_mfma_f32_16x16x32_bf16(Bt[n][k], At[m][k], acc[ai][bj][m][n], 0, 0, 0); __builtin_amdgcn_s_setprio(0); } while (0)
#define PG8_WAIT_V(n) asm volatile("s_waitcnt vmcnt(" #n ")" ::: "memory")
#define PG8_WAIT_L(n) asm volatile("s_waitcnt lgkmcnt(" #n ")" ::: "memory")
#define PG8_BAR __builtin_amdgcn_s_barrier()
#define PG8_SCHED __builtin_amdgcn_sched_barrier(0)
    Unit cur, nxt; int ui = 0;
    if (!S.next(0, cur)) return;
    f32x4 acc[2][2][4][2];
#pragma unroll
    for (int a = 0; a < 2; ++a)
#pragma unroll
        for (int b = 0; b < 2; ++b)
#pragma unroll
            for (int m = 0; m < 4; ++m)
#pragma unroll
                for (int n = 0; n < 2; ++n) acc[a][b][m][n] = (f32x4){0.f, 0.f, 0.f, 0.f};
    bf16x8 At[4][2], B0[2][2], B1[2][2];
    const char* cA = (const char*)g.A + (size_t)cur.pm * tstep; const char* cB = (const char*)g.Bt + (size_t)cur.pn * tstep;
    S.a_ready(cur);
    if constexpr (SP2) {
        PG8_STAGE(PG8_SB(0, 0), cB, voffB); PG8_STAGE(PG8_SB(0, 1), cB + hstep, voffB); PG8_STAGE(PG8_SA(0, 0), cA, voffA); PG8_STAGE(PG8_SA(0, 1), cA + hstep, voffA);
        if (wr == 1) PG8_BAR;
        PG8_WAIT_V(2); PG8_BAR;
        PG8_STAGE(PG8_SB(1, 0), cB + kstep, voffB); PG8_STAGE(PG8_SA(1, 0), cA + kstep, voffA); PG8_STAGE(PG8_SB(1, 1), cB + hstep + kstep, voffB);
        PG8_WAIT_V(6); PG8_BAR;
    } else {
        PG8_STAGE(PG8_SB(0, 0), cB, voffB); PG8_STAGE(PG8_SA(0, 0), cA, voffA); PG8_STAGE(PG8_SB(0, 1), cB + hstep, voffB); PG8_STAGE(PG8_SA(0, 1), cA + hstep, voffA);
        if (wr == 1) PG8_BAR;
        PG8_WAIT_V(4); PG8_BAR;
        PG8_STAGE(PG8_SB(1, 0), cB + kstep, voffB); PG8_STAGE(PG8_SA(1, 0), cA + kstep, voffA); PG8_STAGE(PG8_SB(1, 1), cB + hstep + kstep, voffB);
        PG8_WAIT_V(6); PG8_BAR;
    }
    for (;;) {
        const bool has_next = S.next(ui + 1, nxt);
        const char* nA = has_next ? (const char*)g.A + (size_t)nxt.pm * tstep : cA; const char* nB = has_next ? (const char*)g.Bt + (size_t)nxt.pn * tstep : cB;
        for (int t = 0; t < nt; t += 2) {
            const bool last = (t == nt - 2);
            const char* a1 = cA + (size_t)(t + 1) * kstep;
            const char* a2 = last ? nA : cA + (size_t)(t + 2) * kstep; const char* b2 = last ? nB : cB + (size_t)(t + 2) * kstep;
            const char* a3 = a2 + kstep; const char* b3 = b2 + kstep;
            if (last && has_next) S.a_ready(nxt);
            if constexpr (SP2) {
            PG8_LDB(B0, 0, 0); PG8_LDB(B1, 0, 1); PG8_SCHED; PG8_LDA(At, 0, 0); PG8_STAGE(PG8_SA(1, 1), a1 + hstep, voffA);
            PG8_WAIT_V(8); PG8_WAIT_L(0); PG8_BAR; PG8_MMA(0, 0, At, B0); PG8_MMA(0, 1, At, B1); PG8_BAR; PG8_SCHED;
            PG8_LDA(At, 0, 1); PG8_STAGE(PG8_SB(0, 0), b2, voffB); PG8_STAGE(PG8_SB(0, 1), b2 + hstep, voffB); PG8_STAGE(PG8_SA(0, 0), a2, voffA);
            PG8_WAIT_V(8); PG8_WAIT_L(0); PG8_BAR; PG8_MMA(1, 0, At, B0); PG8_MMA(1, 1, At, B1); PG8_BAR; PG8_SCHED;
            PG8_LDB(B0, 1, 0); PG8_LDB(B1, 1, 1); PG8_SCHED; PG8_LDA(At, 1, 0); PG8_STAGE(PG8_SA(0, 1), a2 + hstep, voffA);
            PG8_WAIT_V(8); PG8_WAIT_L(0); PG8_BAR; PG8_MMA(0, 0, At, B0); PG8_MMA(0, 1, At, B1); PG8_BAR; PG8_SCHED;
            PG8_LDA(At, 1, 1); PG8_STAGE(PG8_SB(1, 0), b3, voffB); PG8_STAGE(PG8_SB(1, 1), b3 + hstep, voffB); PG8_STAGE(PG8_SA(1, 0), a3, voffA);
            PG8_WAIT_V(8); PG8_WAIT_L(0); PG8_BAR; PG8_MMA(1, 0, At, B0); PG8_MMA(1, 1, At, B1); PG8_BAR; PG8_SCHED;
            } else {
            PG8_LDB(B0, 0, 0); PG8_SCHED; PG8_LDA(At, 0, 0); PG8_STAGE(PG8_SA(1, 1), a1 + hstep, voffA);
            PG8_WAIT_L(8); PG8_BAR; PG8_WAIT_L(0); PG8_MMA(0, 0, At, B0); PG8_BAR; PG8_SCHED;
            PG8_LDB(B1, 0, 1); PG8_STAGE(PG8_SB(0, 0), b2, voffB);
            PG8_BAR; PG8_WAIT_L(0); PG8_MMA(0, 1, At, B1); PG8_BAR;
            PG8_LDA(At, 0, 1); PG8_STAGE(PG8_SA(0, 0), a2, voffA);
            PG8_BAR; PG8_WAIT_L(0); PG8_MMA(1, 0, At, B0); PG8_BAR; PG8_SCHED;
            PG8_STAGE(PG8_SB(0, 1), b2 + hstep, voffB);
            PG8_WAIT_V(6); PG8_BAR; PG8_MMA(1, 1, At, B1); PG8_BAR;
            PG8_LDB(B0, 1, 0); PG8_SCHED; PG8_LDA(At, 1, 0); PG8_STAGE(PG8_SA(0, 1), a2 + hstep, voffA);
            PG8_WAIT_L(8); PG8_BAR; PG8_WAIT_L(0); PG8_MMA(0, 0, At, B0); PG8_BAR; PG8_SCHED;
            PG8_LDB(B1, 1, 1); PG8_STAGE(PG8_SB(1, 0), b3, voffB);
            PG8_BAR; PG8_WAIT_L(0); PG8_MMA(0, 1, At, B1); PG8_BAR;
            PG8_LDA(At, 1, 1); PG8_STAGE(PG8_SA(1, 0), a3, voffA);
            PG8_BAR; PG8_WAIT_L(0); PG8_MMA(1, 0, At, B0); PG8_BAR; PG8_SCHED;
            PG8_STAGE(PG8_SB(1, 1), b3 + hstep, voffB);
            PG8_WAIT_V(6); PG8_BAR; PG8_MMA(1, 1, At, B1); PG8_BAR;
            }
        }
        if constexpr (ALIGN_EPI) { if (wr == 0) PG8_BAR; }
        if constexpr (!Epi::AFTER_DRAIN) { E(acc, cur, wr, wc, fr, fq); S.done(cur); }
        if (!has_next) break;
#pragma unroll
        for (int a = 0; a < 2; ++a)
#pragma unroll
            for (int b = 0; b < 2; ++b)
#pragma unroll
                for (int m = 0; m < 4; ++m)
#pragma unroll
                    for (int n = 0; n < 2; ++n) acc[a][b][m][n] = (f32x4){0.f, 0.f, 0.f, 0.f};
        cur = nxt; cA = nA; cB = nB; ++ui;
        if constexpr (ALIGN_EPI) { if (wr == 1) PG8_BAR; }
    }
    PG8_WAIT_V(0);
    if constexpr (!ALIGN_EPI) { if (wr == 0) PG8_BAR; }
    PG8_BAR;
    if constexpr (Epi::AFTER_DRAIN) { E.fused(acc, cur, wr, wc, fr, fq, lds, wid, lane); S.done(cur); }
#undef PG8_SA
#undef PG8_SB
#undef PG8_STAGE
#undef PG8_LDA
#undef PG8_LDB
#undef PG8_MMA
#undef PG8_WAIT_V
#undef PG8_WAIT_L
#undef PG8_BAR
#undef PG8_SCHED
}
}
#define XB_TMO      128
#define XB_XCNT(j)  (256  + 64 * (j))
#define XB_XSUB(j)  (1280 + 64 * (j))
#define XB_XGEN(j)  (2304 + 64 * (j))
#define XB_TOP      3328
#define XB_TOPGEN   3392
#define XCD_BAR_WORDS 3456
#define XB_SPIN_CAP (1u << 18)

__device__ __forceinline__ unsigned xb_ld(unsigned* p)              { return __hip_atomic_load(p, __ATOMIC_RELAXED, __HIP_MEMORY_SCOPE_AGENT); }
__device__ __forceinline__ unsigned xb_add(unsigned* p, unsigned v) { return __hip_atomic_fetch_add(p, v, __ATOMIC_RELAXED, __HIP_MEMORY_SCOPE_AGENT); }
__device__ __forceinline__ unsigned xb_xcc_id() { return (unsigned)__builtin_amdgcn_s_getreg((3 << 11) | 20) & 0xFu; }
#define XB_SPIN(cond, bar) do { unsigned _sp = 0; while (cond) { __builtin_amdgcn_s_sleep(1); \
    if ((++_sp & 255u) == 0u) { if (xb_ld(&(bar)[XB_TMO])) break; if (_sp > XB_SPIN_CAP) { atomicAdd(&(bar)[XB_TMO], 1u); break; } } } } while (0)

struct XcdBarrier {
    unsigned* bar; unsigned x;
    volatile LAS unsigned* st;
};

__device__ __forceinline__ XcdBarrier xcd_barrier_post(unsigned* bar, volatile LAS unsigned* st) {
    XcdBarrier b; b.bar = bar; b.x = xb_xcc_id(); b.st = st;
    if (threadIdx.x == 0) st[2] = xb_add(&bar[XB_XCNT(b.x)], 1u) + 1u;
    return b;
}
__device__ __forceinline__ void xcd_barrier_complete(unsigned* bar, unsigned x, unsigned& nloc, unsigned& nx) {
    const unsigned G = gridDim.x * gridDim.y * gridDim.z;
    unsigned sum, cnt, mine, sp = 0u;
    for (;;) {
        sum = 0u; cnt = 0u; mine = 0u;
#pragma unroll
        for (unsigned j = 0; j < 16; ++j) { const unsigned c = xb_ld(&bar[XB_XCNT(j)]); sum += c; cnt += (c > 0u) ? 1u : 0u; mine = (j == x) ? c : mine; }
        if (sum == G) break;
        __builtin_amdgcn_s_sleep(1);
        if ((++sp & 255u) == 0u) { if (xb_ld(&bar[XB_TMO])) break; if (sp > XB_SPIN_CAP) { atomicAdd(&bar[XB_TMO], 1u); break; } }
    }
    nloc = mine > 0u ? mine : 1u; nx = cnt > 0u ? cnt : 1u;
}

__device__ __forceinline__ void xcd_barrier(const XcdBarrier& b) {
    asm volatile("s_waitcnt vmcnt(0)" ::: "memory");
    __syncthreads();
    if (threadIdx.x == 0) {
        unsigned* bar = b.bar;
        __builtin_amdgcn_s_waitcnt(0);
        unsigned nloc = b.st[0], nx = b.st[1];
        if (nloc == 0u) { xcd_barrier_complete(bar, b.x, nloc, nx); b.st[0] = nloc; b.st[1] = nx; }
        const unsigned old = xb_add(&bar[XB_XSUB(b.x)], 1u);
        const unsigned gen = old / nloc;
        if (old + 1u == (gen + 1u) * nloc) {
            __builtin_amdgcn_fence(__ATOMIC_RELEASE, "agent");
            asm volatile("s_waitcnt vmcnt(0)" ::: "memory");
            const unsigned og = xb_add(&bar[XB_TOP], 1u);
            const unsigned tg = og / nx;
            if (og + 1u == (tg + 1u) * nx) xb_add(&bar[XB_TOPGEN], 1u);
            else XB_SPIN(xb_ld(&bar[XB_TOPGEN]) == tg, bar);
            __builtin_amdgcn_fence(__ATOMIC_ACQUIRE, "agent");
            xb_add(&bar[XB_XGEN(b.x)], 1u);
            asm volatile("s_waitcnt vmcnt(0)" ::: "memory");
        } else {
            XB_SPIN(xb_ld(&bar[XB_XGEN(b.x)]) == gen, bar);
            __builtin_amdgcn_fence(__ATOMIC_ACQUIRE, "agent");
            asm volatile("s_waitcnt vmcnt(0)" ::: "memory");
        }
    }
    __syncthreads();
}
constexpr int NWAVES = 8, NTHR = 512;
constexpr int RING_BYTES = 131072, LDSCTL_OFF = RING_BYTES, MISC_OFF = LDSCTL_OFF + 320, LDS_BYTES = 163840;
constexpr int CW_BAR = 4096;
#ifndef MK_N_LAUNCHES
#define MK_N_LAUNCHES 1
#endif
constexpr int NPHASE = 13;

typedef float f4v __attribute__((ext_vector_type(4)));
typedef unsigned u2v __attribute__((ext_vector_type(2)));
typedef unsigned u32x4_t __attribute__((ext_vector_type(4)));
struct Frame { LAS unsigned char* lds; int tid, lane, wave, G, bid; };
template <int CTRL, int ROWMASK> __device__ __forceinline__ float dppf(float old, float src) {
    return __builtin_bit_cast(float, __builtin_amdgcn_update_dpp(__builtin_bit_cast(int, old), __builtin_bit_cast(int, src), CTRL, ROWMASK, 0xf, false)); }
__device__ __forceinline__ float wave_scan_add(float v) {
    v += dppf<0x111, 0xf>(0.f, v); v += dppf<0x112, 0xf>(0.f, v); v += dppf<0x114, 0xf>(0.f, v); v += dppf<0x118, 0xf>(0.f, v);
    v += dppf<0x142, 0xa>(0.f, v); v += dppf<0x143, 0xc>(0.f, v); return v; }
__device__ __forceinline__ float wave_scan_max(float v) {
    const float NI = -INFINITY;
    v = fmaxf(v, dppf<0x111, 0xf>(NI, v)); v = fmaxf(v, dppf<0x112, 0xf>(NI, v)); v = fmaxf(v, dppf<0x114, 0xf>(NI, v)); v = fmaxf(v, dppf<0x118, 0xf>(NI, v));
    v = fmaxf(v, dppf<0x142, 0xa>(NI, v)); v = fmaxf(v, dppf<0x143, 0xc>(NI, v)); return v; }
__device__ __forceinline__ float lane_bcast(float v, int l) { return __builtin_bit_cast(float, __builtin_amdgcn_readlane(__builtin_bit_cast(int, v), l)); }
__device__ __forceinline__ float wave_sum(float v) { return lane_bcast(wave_scan_add(v), 63); }
__device__ __forceinline__ unsigned pk2(float lo, float hi) { return (unsigned)f2bf(lo) | ((unsigned)f2bf(hi) << 16); }
__device__ __forceinline__ float bflo(unsigned w) { return u_as_f(w << 16); }
__device__ __forceinline__ float bfhi(unsigned w) { return u_as_f(w & 0xffff0000u); }

__device__ __forceinline__ void p0_ada_block(const Prm& p, const Frame& F, int cb) {
    static_assert(D6 % 48 == 0 && NB == 8, "48-column blocks");
    LAS float* sl = (LAS float*)F.lds;
    LAS float* red = sl + NB * D;
    for (int i = F.tid; i < NB * D; i += NTHR) { const float cv = p.c[i]; sl[i] = cv / (1.f + __expf(-cv)); }
    __syncthreads();
    const int c4 = F.tid % 12, kl = F.tid / 12;
    if (kl < 42) {
        f4v acc[NB];
#pragma unroll
        for (int b = 0; b < NB; ++b) acc[b] = (f4v){0.f, 0.f, 0.f, 0.f};
        const float* wp = p.w_ada + (size_t)cb * 48 + 4 * c4;
#pragma unroll 7
        for (int k = kl; k < D; k += 42) { const f4v w = __builtin_nontemporal_load((const f4v*)(wp + (size_t)k * D6));
#pragma unroll
            for (int b = 0; b < NB; ++b) acc[b] += w * sl[b * D + k]; }
#pragma unroll
        for (int b = 0; b < NB; ++b) *(LAS f4v*)(red + (kl * NB + b) * 48 + 4 * c4) = acc[b];
    }
    __syncthreads();
    if (F.tid < NB * 48) { const int b = F.tid / 48, col = F.tid % 48; float s = 0.f;
        for (int k = 0; k < 42; ++k) s += red[(k * NB + b) * 48 + col];
        p.MOD()[(size_t)b * D6 + cb * 48 + col] = s + p.b_ada[cb * 48 + col]; }
    __syncthreads();
}
__device__ __forceinline__ void p0_transpose_item(const float* W, int ldw, int K, int N, bf16_t* WT, LAS float* scr, int item, int lane) {
    const int nblk = N / 32, kb = item / nblk, nb = item % nblk, k0 = 64 * kb, n0 = 32 * nb;
#pragma unroll
    for (int i = 0; i < 32; ++i) { const int kk = 2 * i + (lane >> 5); scr[kk * 33 + (lane & 31)] = W[(size_t)(k0 + kk) * ldw + n0 + (lane & 31)]; }
    asm volatile("s_waitcnt lgkmcnt(0)" ::: "memory");
    const int c = lane & 7;
#pragma unroll
    for (int j = 0; j < 4; ++j) { const int n = (lane >> 3) + 8 * j; const LAS float* s = scr + (8 * c) * 33 + n;
        uint4 o; o.x = pk2(s[0 * 33], s[1 * 33]); o.y = pk2(s[2 * 33], s[3 * 33]); o.z = pk2(s[4 * 33], s[5 * 33]); o.w = pk2(s[6 * 33], s[7 * 33]);
        *(uint4*)(WT + (size_t)(n0 + n) * K + k0 + 8 * c) = o; }
    asm volatile("s_waitcnt lgkmcnt(0)" ::: "memory");
}

__device__ __forceinline__ void p0_fold_item(const Prm& p, int item, int lane) {
    static_assert(NK == 128 && KH == 128 && NQ == 2048, "fold item decomposition");
    const int ks = item & 31, nt = (item >> 5) & 7, g = item >> 8;
    const int r = lane & 15, q = lane >> 4;
    const float* arow = p.subkeys + ((size_t)g * NK + nt * 16 + r) * KH + 4 * q;
    const float* brow = p.wq + (size_t)(ks * 64 + r) * NQ + g * KH + 4 * q;
    pg8::f32x4 acc[4];
#pragma unroll
    for (int c = 0; c < 4; ++c) acc[c] = (pg8::f32x4){0.f, 0.f, 0.f, 0.f};
#pragma unroll 2
    for (int s16 = 0; s16 < KH; s16 += 16) {
        const pg8::f32x4 a = *(const pg8::f32x4*)(arow + s16); pg8::f32x4 bv[4];
#pragma unroll
        for (int c = 0; c < 4; ++c) bv[c] = *(const pg8::f32x4*)(brow + (size_t)(c * 16) * NQ + s16);
#pragma unroll
        for (int i = 0; i < 4; ++i)
#pragma unroll
            for (int c = 0; c < 4; ++c) acc[c] = __builtin_amdgcn_mfma_f32_16x16x4f32(a[i], bv[c][i], acc[c], 0, 0, 0);
    }
#pragma unroll
    for (int c = 0; c < 4; ++c)
#pragma unroll
        for (int i = 0; i < 4; ++i) p.WQ_T()[(size_t)(g * NK + nt * 16 + 4 * q + i) * D + ks * 64 + c * 16 + r] = f2bf(acc[c][i]);
}
__device__ __forceinline__ void phase0(const Prm& p, const Frame& F) {
    for (int cb = F.bid; cb < D6 / 48; cb += F.G) p0_ada_block(p, F, cb);
    LAS float* scr = (LAS float*)(F.lds + F.wave * 16384);
    const int gw = F.bid * NWAVES + F.wave, NGW = F.G * NWAVES;
    constexpr int I_IN = (D / 64) * (INM / 32);
    for (int it = gw; it < I_IN; it += NGW) p0_transpose_item(p.w_in, INC, D, INM, p.WIN_T(), scr, it, F.lane);
}
template <bool PART_A, bool PART_B, bool PART_F>
__device__ __forceinline__ void deferred_prep(const Prm& p, const Frame& F, int b0, int nb) {
    __syncthreads();
    LAS float* scr = (LAS float*)(F.lds + F.wave * 16384);
    const int gw = (F.bid - b0) * NWAVES + F.wave, NGW = nb * NWAVES;
    constexpr int I_O = (D / 64) * (D / 32), I_Q = 32 * 8 * 16;
    if (PART_A) for (int it = gw; it < I_O; it += NGW) p0_transpose_item(p.w_out, D, D, D, p.WOUT_T(), scr, it, F.lane);
    if (PART_F) for (int it = gw; it < I_Q; it += NGW) p0_fold_item(p, it, F.lane);
    if (PART_A) {
        float4 v[8], vn[8]; int rr = gw;
#define P0_ROWSRC(rr_) ((const float4*)(p.peer_u + (size_t)(rr_) * D) + F.lane)
        if (rr < NE) { const float4* src = P0_ROWSRC(rr);
#pragma unroll
            for (int j = 0; j < 8; ++j) { const f4v t_ = __builtin_nontemporal_load((const f4v*)(src + 64 * j)); v[j] = make_float4(t_[0], t_[1], t_[2], t_[3]); } }
        for (; rr < NE; rr += NGW) {
            const int rn = rr + NGW;
            if (rn < NE) { const float4* src = P0_ROWSRC(rn);
#pragma unroll
                for (int j = 0; j < 8; ++j) { const f4v t_ = __builtin_nontemporal_load((const f4v*)(src + 64 * j)); vn[j] = make_float4(t_[0], t_[1], t_[2], t_[3]); } }
            const int e = rr; float am = 0.f;
#pragma unroll
            for (int j = 0; j < 8; ++j) am = fmaxf(am, fmaxf(fmaxf(fabsf(v[j].x), fabsf(v[j].y)), fmaxf(fabsf(v[j].z), fabsf(v[j].w))));
#pragma unroll
            for (int o = 1; o < 64; o <<= 1) am = fmaxf(am, __shfl_xor(am, o));
            const float sc = am > 0.f ? 384.f / am : 1.f;
            unsigned* dst = (unsigned*)(p.PU8() + (size_t)e * D) + F.lane;
#pragma unroll
            for (int j = 0; j < 8; ++j) { unsigned w = 0u; w = __builtin_amdgcn_cvt_pk_fp8_f32(v[j].x * sc, v[j].y * sc, w, false); w = __builtin_amdgcn_cvt_pk_fp8_f32(v[j].z * sc, v[j].w * sc, w, true); dst[64 * j] = w; }
            if (F.lane == 0) p.RSU()[e] = am > 0.f ? am / 384.f : 1.f;
#pragma unroll
            for (int j = 0; j < 8; ++j) v[j] = vn[j];
        }
#undef P0_ROWSRC
    }
    if (PART_B) { LAS unsigned char* tl = F.lds; constexpr int RS_ = 2056;
      for (int tile = F.bid - b0; tile < NE / 16; tile += nb) { const int row = F.tid >> 5, l32 = F.tid & 31, e = tile * 16 + row;
        __syncthreads();
        const f4v* src = (const f4v*)(p.peer_v + (size_t)e * D) + l32; f4v x[16]; float am = 0.f;
#pragma unroll
        for (int j = 0; j < 16; ++j) { x[j] = __builtin_nontemporal_load(src + 32 * j); am = fmaxf(am, fmaxf(fmaxf(fabsf(x[j][0]), fabsf(x[j][1])), fmaxf(fabsf(x[j][2]), fabsf(x[j][3])))); }
#pragma unroll
        for (int o = 1; o < 32; o <<= 1) am = fmaxf(am, __shfl_xor(am, o));
        const float sc = am > 0.f ? 384.f / am : 1.f;
#pragma unroll
        for (int j = 0; j < 16; ++j) { unsigned w = 0u; w = __builtin_amdgcn_cvt_pk_fp8_f32(x[j][0] * sc, x[j][1] * sc, w, false); w = __builtin_amdgcn_cvt_pk_fp8_f32(x[j][2] * sc, x[j][3] * sc, w, true);
            *(LAS unsigned*)(tl + row * RS_ + 4 * (l32 + 32 * j)) = w; }
        if (l32 == 0) p.RSV()[e] = am > 0.f ? am / 384.f : 1.f;
        __syncthreads();
#pragma unroll
        for (int k = 0; k < 8; ++k) { const int idx = F.tid + NTHR * k, r = idx & 15, sl = idx >> 4;
            *(u2v*)(p.PV8S() + ((size_t)sl * NE + tile * 16 + r) * 8) = *(const LAS u2v*)(tl + r * RS_ + 8 * sl); }
      } }
}
__device__ __forceinline__ void phase1(const Prm& p, const Frame& F) {
    static_assert(NG == 16 && D % 32 == 0, "gate tile = one 16-column MFMA tile");
    LAS float* SH = (LAS float*)F.lds; LAS float* SC1 = SH + D;
    constexpr unsigned WGS = 2 * D + 16, WG_OFF = 2 * D * 4, US_OFF = ((WG_OFF + NG * WGS + 255u) / 256u) * 256u;
    constexpr unsigned US_HI = 132096u;
    static_assert(US_OFF + 5 * 2 * D * 2 <= (unsigned)LDSCTL_OFF && US_HI + 3 * 2 * D * 2 <= (unsigned)LDS_BYTES && US_HI >= (unsigned)MISC_OFF + 128u, "P1 LDS map");
    LAS unsigned char* WGb = F.lds + WG_OFF; LAS unsigned char* USb = F.wave < 5 ? F.lds + US_OFF + F.wave * (2 * D * 2) : F.lds + US_HI + (F.wave - 5) * (2 * D * 2);
    const int rows_per = T / F.G;
    { const int st = (F.bid * 37) % (NG * D / NTHR);
      for (int k = 0; k < NG * D / NTHR; ++k) { const int idx = F.tid + NTHR * ((k + st) % (NG * D / NTHR)); const int d = idx / NG, g = idx % NG; *(LAS bf16_t*)(WGb + g * WGS + 2 * d) = f2bf(p.w_in[(size_t)d * INC + INM + g]); } }
    int cur_b = -1;
    float4 xpre[8];
    { const float4* x0 = (const float4*)(p.x + (size_t)(F.bid * rows_per + F.wave) * D) + F.lane;
#pragma unroll
      for (int j = 0; j < 8; ++j) xpre[j] = x0[64 * j]; }
    int it = 0;
    for (int r0 = F.bid * rows_per; r0 < (F.bid + 1) * rows_per; r0 += NWAVES, ++it) {
        const int b = r0 / S;
        if (b != cur_b) { __syncthreads();
            for (int n = F.tid; n < 2 * D; n += NTHR) { const float s = p.MOD()[(size_t)b * D6 + n]; SH[n] = n < D ? s : 1.f + s; }
            cur_b = b; __syncthreads(); }
        const int row = r0 + F.wave;
        float4 v[8]; float s = 0.f;
#pragma unroll
        for (int j = 0; j < 8; ++j) v[j] = xpre[j];
        if (r0 + NWAVES < (F.bid + 1) * rows_per) { const float4* xn = (const float4*)(p.x + (size_t)(row + NWAVES) * D) + F.lane;
#pragma unroll
            for (int j = 0; j < 8; ++j) xpre[j] = xn[64 * j]; }
#pragma unroll
        for (int j = 0; j < 8; ++j) s += (v[j].x + v[j].y) + (v[j].z + v[j].w);
        const float mean = wave_sum(s) * (1.f / D); float s2 = 0.f;
#pragma unroll
        for (int j = 0; j < 8; ++j) { v[j].x -= mean; v[j].y -= mean; v[j].z -= mean; v[j].w -= mean; s2 += (v[j].x * v[j].x + v[j].y * v[j].y) + (v[j].z * v[j].z + v[j].w * v[j].w); }
        const float rstd = 1.f / sqrtf(wave_sum(s2) * (1.f / D) + LN_EPS);
        uint2* o8 = (uint2*)(p.U() + (size_t)row * D) + F.lane; LAS u2v* us = (LAS u2v*)(USb + (it & 1) * (2 * D)) + F.lane;
#pragma unroll
        for (int j = 0; j < 8; ++j) { const int c0 = 4 * F.lane + 256 * j; const f4v sh = *(const LAS f4v*)(SH + c0), sc = *(const LAS f4v*)(SC1 + c0);
            const unsigned w0 = pk2(v[j].x * rstd * sc.x + sh.x, v[j].y * rstd * sc.y + sh.y), w1 = pk2(v[j].z * rstd * sc.z + sh.z, v[j].w * rstd * sc.w + sh.w);
            o8[64 * j] = make_uint2(w0, w1); us[64 * j] = (u2v){w0, w1}; }
        if (it & 1) {
            const unsigned lane = F.lane, r = lane & 15u, q = lane >> 4; pg8::f32x4 acc = {0.f, 0.f, 0.f, 0.f};
            const LAS unsigned char* ap = USb + (r & 1u) * (2 * D) + 16u * q; const LAS unsigned char* bp = WGb + r * WGS + 16u * q;
#pragma unroll 8
            for (int ks = 0; ks < D / 32; ++ks) acc = __builtin_amdgcn_mfma_f32_16x16x32_bf16(*(const LAS pg8::bf16x8*)(ap + 64 * ks), *(const LAS pg8::bf16x8*)(bp + 64 * ks), acc, 0, 0, 0);
            if (lane < NG) { const float bi = p.b_in[INM + lane]; const float g0 = acc[0] + bi, g1 = acc[1] + bi; const bool fg = lane & 4;
                p.GATES()[(size_t)(row - NWAVES) * NG + lane] = fg ? logsigmoidf_(g0) : g0; p.GATES()[(size_t)row * NG + lane] = fg ? logsigmoidf_(g1) : g1; } }
    }
}
__device__ __forceinline__ void phase3a(const Prm& p, const Frame& F, int b0, int nb) {
    const size_t gt = (size_t)(F.bid - b0) * NTHR + F.tid, GT = (size_t)nb * NTHR;
    for (size_t i = gt; i < (size_t)T * (CW / 8); i += GT) {
        const size_t row = i / (CW / 8); const int ch = (int)(i % (CW / 8)) * 8, s = (int)(row % S);
        float acc[8];
#pragma unroll
        for (int e = 0; e < 8; ++e) acc[e] = p.conv_b[ch + e];
#pragma unroll
        for (int k = 0; k < 3; ++k) { const int s2 = s + k - 1; if (s2 < 0 || s2 >= S) continue; const bf16_t* pr = p.PJ() + (size_t)(row + k - 1) * INM;
            const uint4 gc = *(const uint4*)(pr + O_GC + ch), hi = *(const uint4*)(pr + O_HIN + ch); const float* cw = p.conv_w + k * CW + ch;
            acc[0] += cw[0] * (bflo(gc.x) * bflo(hi.x)); acc[1] += cw[1] * (bfhi(gc.x) * bfhi(hi.x)); acc[2] += cw[2] * (bflo(gc.y) * bflo(hi.y)); acc[3] += cw[3] * (bfhi(gc.y) * bfhi(hi.y));
            acc[4] += cw[4] * (bflo(gc.z) * bflo(hi.z)); acc[5] += cw[5] * (bfhi(gc.z) * bfhi(hi.z)); acc[6] += cw[6] * (bflo(gc.w) * bflo(hi.w)); acc[7] += cw[7] * (bfhi(gc.w) * bfhi(hi.w)); }
        const uint4 gb = *(const uint4*)(p.PJ() + row * INM + O_GB + ch); uint4 o;
        o.x = pk2(bflo(gb.x) * acc[0], bfhi(gb.x) * acc[1]); o.y = pk2(bflo(gb.y) * acc[2], bfhi(gb.y) * acc[3]); o.z = pk2(bflo(gb.z) * acc[4], bfhi(gb.z) * acc[5]); o.w = pk2(bflo(gb.w) * acc[6], bfhi(gb.w) * acc[7]);
        *(uint4*)(p.Y() + row * D + ch) = o; }
}
namespace ml {
typedef short bf16x8 __attribute__((ext_vector_type(8)));
typedef short s16x4 __attribute__((ext_vector_type(4)));
typedef float f32x4 __attribute__((ext_vector_type(4)));
typedef float f32x2_t __attribute__((ext_vector_type(2)));
typedef __bf16 bf16x2_t __attribute__((ext_vector_type(2)));
typedef unsigned u32x4 __attribute__((ext_vector_type(4)));
typedef unsigned u32x2 __attribute__((ext_vector_type(2)));
constexpr unsigned IMG = 16384u, BUF = 3u * IMG, PT_OFF = 2u * BUF, PT_BYTES = 8192u, N_OFF = PT_OFF + 2u * PT_BYTES;
constexpr unsigned SCT_OFF = 149504u, SCT_BYTES = 1024u;
constexpr unsigned HT_OFF = 133120u;
static_assert(N_OFF + 1024u <= 131072u && HT_OFF + 16384u <= SCT_OFF && SCT_OFF + 3u * SCT_BYTES <= 163840u, "mLSTM LDS map");
__device__ __forceinline__ unsigned cvtpk(float lo, float hi) { f32x2_t v = {lo, hi}; bf16x2_t b = __builtin_convertvector(v, bf16x2_t); return __builtin_bit_cast(unsigned, b); }
__device__ __forceinline__ unsigned off_a(unsigned row, unsigned ch) { return 2048u * (row >> 3) + 512u * (ch >> 2) + 64u * (row & 7u) + 16u * ((ch & 3u) ^ ((row >> 2) & 3u)); }
__device__ __forceinline__ unsigned off_p(unsigned row, unsigned ch) { return 128u * row + 16u * (ch ^ (row & 7u)); }
typedef short v4i16_t __attribute__((ext_vector_type(4)));
__device__ __forceinline__ s16x4 trr(LAS unsigned char* p) { return __builtin_bit_cast(s16x4, __builtin_amdgcn_ds_read_tr16_b64_v4i16((LAS v4i16_t*)p)); }
__device__ __forceinline__ bf16x8 cat8(s16x4 a, s16x4 b) { return (bf16x8){a[0], a[1], a[2], a[3], b[0], b[1], b[2], b[3]}; }
struct CS { float decay, m_next; };
__device__ __forceinline__ CS chunk_scalars(float ig, float fg, float m, LAS float* tab, bool writer, unsigned lane) {
    const float lf = fg;
    const float bc = wave_scan_add(lf), gg = ig - bc, cm = wave_scan_max(gg);
    const float G = fmaxf(m, cm), G63 = lane_bcast(G, 63), b63 = lane_bcast(bc, 63), qs = 0.08838834764831845f;
    if (writer) { tab[lane] = __expf(fminf(G63 - G, 80.f)) * qs; tab[64 + lane] = __expf(m - G) * qs; tab[128 + lane] = __expf(-(bc + G)); tab[192 + lane] = __expf(gg - G63); }
    CS r; r.decay = __expf(m - G63); r.m_next = b63 + G63;
    return r;
}
__device__ __forceinline__ void unit(const Prm& p, const Frame& F, int u) {
    static_assert(QK == 128 && MV == 256 && CHUNK == 64 && S % 64 == 0, "mLSTM unit is specialised");
    const int vhalf = u & 1, h = (u >> 1) & 3, b = (u >> 3) & 7, dir = u >> 6;
    const unsigned lane = F.lane, tid = F.tid; const int wave = F.wave; const unsigned q = lane >> 4, r = lane & 15u;
    LAS unsigned char* L = F.lds;
    const unsigned rx = (r >> 2) & 3u, rlo = 2048u * (r >> 3) + 64u * (r & 7u);
    const unsigned RA = rlo + 16u * (q ^ rx), PB1 = rlo + 16u * ((q >> 1) ^ rx) + 8u * (q & 1u), PB2 = rlo + 16u * ((2u + (q >> 1)) ^ rx) + 8u * (q & 1u);
    const unsigned pp = lane & 3u, tlo = 2048u * q + 64u * rx + 8u * (pp & 1u);
    const unsigned tb00 = tlo + 16u * ((pp >> 1) ^ ((2u * q) & 3u)), tb01 = tlo + 256u + 16u * ((pp >> 1) ^ ((2u * q + 1u) & 3u));
    const unsigned tb10 = tlo + 16u * ((2u + (pp >> 1)) ^ ((2u * q) & 3u)), tb11 = tlo + 256u + 16u * ((2u + (pp >> 1)) ^ ((2u * q + 1u) & 3u));
    const unsigned PP0 = 128u * r + 16u * (q ^ (r & 7u)), PP1 = 128u * r + 16u * ((4u + q) ^ (r & 7u));
#define ML_TRA(c, ks, t) ((((c) & 1) ? ((t) ? tb11 : tb10) : ((t) ? tb01 : tb00)) + 8192u * (ks) + 512u * ((unsigned)(c) >> 1))
    __syncthreads();
    for (unsigned i = tid; i < (2u * PT_BYTES + 1024u) / 16u; i += NTHR) *(LAS u32x4*)(L + PT_OFF + 16u * i) = (u32x4){0u, 0u, 0u, 0u};
    f32x4 C[8];
#pragma unroll
    for (int i = 0; i < 8; ++i) C[i] = (f32x4){0.f, 0.f, 0.f, 0.f};
    float m = 0.f;
    const bf16_t* pj = p.PJ(); bf16_t* H = dir ? p.HB16() : p.HF16();
    const int colq = O_Q + h * QK, colk = O_K + h * QK, colv = O_V + h * MV + vhalf * 128;
    const unsigned srow0 = tid >> 4, sch = tid & 15u;
    u32x4 rq[2], rk[2], rv[2];
    const float* gbase = p.GATES() + dir * 8 + h;
#define ML_GATES(c, ig_, fg_) do { const float* g_ = gbase + (size_t)ml_tok(dir, b, (c) * 64 + (int)lane) * NG; ig_ = g_[0]; fg_ = g_[4]; } while (0)
    float ig0, fg0, ign = 0.f, fgn = 0.f; ML_GATES(0, ig0, fg0); if (S / 64 > 1) ML_GATES(1, ign, fgn);
#define ML_TAB(c) ((LAS float*)(L + SCT_OFF + (unsigned)((c) % 3) * SCT_BYTES))
    CS cs = chunk_scalars(ig0, fg0, m, ML_TAB(0), wave == 0, lane), csn = cs;
    const long sMW = dir ? -(long)MW : (long)MW;
#define ML_LOAD(c) do { _Pragma("unroll") for (int i_ = 0; i_ < 2; ++i_) { const bf16_t* rp = pj + (size_t)ml_tok(dir, b, (c) * 64 + srow0 + 32 * i_) * INM + 8 * sch; \
        rq[i_] = *(const u32x4*)(rp + colq); rk[i_] = *(const u32x4*)(rp + colk); rv[i_] = *(const u32x4*)(rp + colv); } } while (0)
#define ML_STORE(buf, S_) do { _Pragma("unroll") for (int i_ = 0; i_ < 2; ++i_) { const unsigned row = srow0 + 32u * i_, o = (buf) * BUF + off_a(row, sch); const float w = (S_)[192 + row]; \
        *(LAS u32x4*)(L + o) = rq[i_]; *(LAS u32x4*)(L + IMG + o) = rk[i_]; u32x4 v = rv[i_]; \
        v.x = cvtpk(bflo(v.x) * w, bfhi(v.x) * w); v.y = cvtpk(bflo(v.y) * w, bfhi(v.y) * w); v.z = cvtpk(bflo(v.z) * w, bfhi(v.z) * w); v.w = cvtpk(bflo(v.w) * w, bfhi(v.w) * w); \
        *(LAS u32x4*)(L + 2u * IMG + o) = v; } } while (0)
    __syncthreads();
    ML_LOAD(0); ML_STORE(0u, ML_TAB(0));
    constexpr int NC = S / 64;
    for (int c = 0; c < NC; ++c) {
        const unsigned cur = (unsigned)(c & 1);
        LAS unsigned char* Qi = L + cur * BUF; LAS unsigned char* Ki = Qi + IMG; LAS unsigned char* Vi = Qi + 2u * IMG; LAS unsigned char* Pt = L + PT_OFF + cur * PT_BYTES;
        float ig2 = 0.f, fg2 = 0.f;
        if (c + 1 < NC) { ML_LOAD(c + 1); csn = chunk_scalars(ign, fgn, cs.m_next, ML_TAB(c + 1), wave == 0, lane); if (c + 2 < NC) ML_GATES(c + 2, ig2, fg2); }
        __syncthreads();
#define ML_FLUSH(cprev) do { _Pragma("unroll") for (int i_ = 0; i_ < 2; ++i_) { const unsigned n_ = tid + 512u * i_, row_ = n_ >> 4, ch_ = n_ & 15u;     \
            const u32x4 v_ = *(const LAS u32x4*)(L + HT_OFF + 256u * row_ + 16u * (ch_ ^ (row_ & 15u))); \
            *(u32x4*)(H + (size_t)ml_tok(dir, b, (cprev) * 64 + (int)row_) * MW + h * MV + vhalf * 128 + 8 * (int)ch_) = v_; } } while (0)
        const LAS float* sct = ML_TAB(c);
        if (c > 0) ML_FLUSH(c - 1);
#ifndef ML_REP_3B
#define ML_REP_3B 1
#define ML_REP_S 1
#define ML_REP_ST 1
#define ML_REP_3A 1
#define ML_REP_DEN 1
#endif
        f32x4 acc2[4];
#pragma unroll
        for (int tt = 0; tt < 4; ++tt) acc2[tt] = (f32x4){0.f, 0.f, 0.f, 0.f};
#pragma unroll
        for (int ks = 0; ks < 4; ++ks) {
            bf16x8 qa[4];
#pragma unroll
            for (int tt = 0; tt < 4; ++tt) {
                const u32x2 lo = *(const LAS u32x2*)(Qi + PB1 + 4096u * tt + 512u * ks), hi = *(const LAS u32x2*)(Qi + PB2 + 4096u * tt + 512u * ks);
                const u32x4 aw = {lo.x, lo.y, hi.x, hi.y}; qa[tt] = __builtin_bit_cast(bf16x8, aw); }
            const f32x4 c0 = C[2 * ks], c1 = C[2 * ks + 1];
            const u32x4 bw = {cvtpk(c0[0], c0[1]), cvtpk(c0[2], c0[3]), cvtpk(c1[0], c1[1]), cvtpk(c1[2], c1[3])}; const bf16x8 bfr = __builtin_bit_cast(bf16x8, bw);
#pragma unroll
            for (int tt = 0; tt < 4; ++tt) acc2[tt] = __builtin_amdgcn_mfma_f32_16x16x32_bf16(qa[tt], bfr, acc2[tt], 0, 0, 0);
        }
        bf16x8 vB[2];
#pragma unroll
        for (int ks = 0; ks < 2; ++ks) vB[ks] = cat8(trr(Vi + ML_TRA(wave, ks, 0)), trr(Vi + ML_TRA(wave, ks, 1)));
#pragma unroll
        for (int dt = 0; dt < 8; ++dt) C[dt] = C[dt] * cs.decay;
#pragma unroll
        for (int ks = 0; ks < 2; ++ks)
#pragma unroll
            for (int dh = 0; dh < 2; ++dh) { bf16x8 kA[4];
#pragma unroll
                for (int d4 = 0; d4 < 4; ++d4) kA[d4] = cat8(trr(Ki + ML_TRA(4 * dh + d4, ks, 0)), trr(Ki + ML_TRA(4 * dh + d4, ks, 1)));
#pragma unroll
                for (int d4 = 0; d4 < 4; ++d4) C[4 * dh + d4] = __builtin_amdgcn_mfma_f32_16x16x32_bf16(kA[d4], vB[ks], C[4 * dh + d4], 0, 0, 0); }
#pragma unroll
        for (int rep = 0; rep < 2; ++rep) { const int idx = wave + (rep ? 2 : 0);
            if (rep == 0 || wave >= 6) { const int tt = idx >= 6 ? 3 : (idx >= 3 ? 2 : (idx >= 1 ? 1 : 0)), st = idx - tt * (tt + 1) / 2;
                f32x4 sa = (f32x4){0.f, 0.f, 0.f, 0.f};
#pragma unroll
                for (int kh = 0; kh < 2; ++kh) { bf16x8 af[2], bfk[2];
#pragma unroll
                    for (int k2 = 0; k2 < 2; ++k2) { af[k2] = *(const LAS bf16x8*)(Qi + RA + 4096u * tt + 512u * (2 * kh + k2)); bfk[k2] = *(const LAS bf16x8*)(Ki + RA + 4096u * st + 512u * (2 * kh + k2)); }
#pragma unroll
                    for (int k2 = 0; k2 < 2; ++k2) sa = __builtin_amdgcn_mfma_f32_16x16x32_bf16(af[k2], bfk[k2], sa, 0, 0, 0); }
                const unsigned scol = 16u * st + r;
#pragma unroll
                for (int i = 0; i < 4; ++i) { const unsigned trow = 16u * tt + 4u * q + i; const float v = scol <= trow ? sa[i] : 0.f;
                    *(LAS bf16_t*)(Pt + off_p(trow, scol >> 3) + 2u * (scol & 7u)) = (bf16_t)cvtpk(v, 0.f); } } }
        if (c + 1 < NC) ML_STORE(cur ^ 1u, ML_TAB(c + 1));
        __syncthreads();
        { bf16x8 pf[6];
#pragma unroll
          for (int tt = 0; tt < 4; ++tt) { pf[tt] = *(const LAS bf16x8*)(Pt + PP0 + 2048u * tt); if (tt >= 2) pf[2 + tt] = *(const LAS bf16x8*)(Pt + PP1 + 2048u * tt); }
#pragma unroll
          for (int tt = 0; tt < 4; ++tt) { const f32x4 av4 = *(const LAS f32x4*)(sct + 16 * tt + 4 * q), bv4 = *(const LAS f32x4*)(sct + 64 + 16 * tt + 4 * q); f32x4 a1 = __builtin_amdgcn_mfma_f32_16x16x32_bf16(pf[tt], vB[0], (f32x4){0.f, 0.f, 0.f, 0.f}, 0, 0, 0);
            if (tt >= 2) a1 = __builtin_amdgcn_mfma_f32_16x16x32_bf16(pf[2 + tt], vB[1], a1, 0, 0, 0);
#pragma unroll
            for (int i = 0; i < 4; ++i) { const unsigned t = 16u * tt + 4u * q + i, col = 16u * (unsigned)wave + r;
                *(LAS bf16_t*)(L + HT_OFF + 256u * t + 16u * ((col >> 3) ^ (t & 15u)) + 2u * (col & 7u)) = (bf16_t)cvtpk(av4[i] * a1[i] + bv4[i] * acc2[tt][i], 0.f); } } }
        if (vhalf == 0) {
            const LAS float* n_old = (const LAS float*)(L + N_OFF + cur * 512u); LAS float* n_new = (LAS float*)(L + N_OFF + (cur ^ 1u) * 512u);
            bf16x8 wB[2];
#pragma unroll
            for (int ks = 0; ks < 2; ++ks) { const f32x4 w0 = *(const LAS f32x4*)(sct + 192 + 32 * ks + 8 * q), w1 = *(const LAS f32x4*)(sct + 192 + 32 * ks + 8 * q + 4);
                u32x4 w = {cvtpk(w0[0], w0[1]), cvtpk(w0[2], w0[3]), cvtpk(w1[0], w1[1]), cvtpk(w1[2], w1[3])};
                if (r != 0u) w = (u32x4){0u, 0u, 0u, 0u}; wB[ks] = __builtin_bit_cast(bf16x8, w); }
            const size_t dbase = ((size_t)dir * T) * MH + h;
            if (wave < 4) { const int tt = wave; f32x4 d2 = (f32x4){0.f, 0.f, 0.f, 0.f};
#pragma unroll
                for (int ks = 0; ks < 4; ++ks) { const f32x4 n0 = *(const LAS f32x4*)(n_old + 32 * ks + 4 * q), n1 = *(const LAS f32x4*)(n_old + 32 * ks + 16 + 4 * q);
                    u32x4 bw = {cvtpk(n0[0], n0[1]), cvtpk(n0[2], n0[3]), cvtpk(n1[0], n1[1]), cvtpk(n1[2], n1[3])}; if (r != 0u) bw = (u32x4){0u, 0u, 0u, 0u};
                    const u32x2 lo = *(const LAS u32x2*)(Qi + PB1 + 4096u * tt + 512u * ks), hi = *(const LAS u32x2*)(Qi + PB2 + 4096u * tt + 512u * ks);
                    const u32x4 aw = {lo.x, lo.y, hi.x, hi.y};
                    d2 = __builtin_amdgcn_mfma_f32_16x16x32_bf16(__builtin_bit_cast(bf16x8, aw), __builtin_bit_cast(bf16x8, bw), d2, 0, 0, 0); }
#pragma unroll
                for (int i = 0; i < 4; ++i) { const int t = 16 * tt + 4 * (int)q + i; const float bv = sct[64 + t], fl = sct[128 + t];
                    if (r == 0u) { const size_t di = dbase + (size_t)ml_tok(dir, b, c * 64 + t) * MH; p.DEN()[(size_t)2 * T * MH + di] = bv * d2[i]; p.FLR()[di] = fl; } }
            } else { const int tt = wave - 4; f32x4 d1 = (f32x4){0.f, 0.f, 0.f, 0.f};
#pragma unroll
                for (int ks = 0; ks < 2; ++ks) if (ks == 0 || tt >= 2) { const bf16x8 pf = *(const LAS bf16x8*)(Pt + (ks ? PP1 : PP0) + 2048u * tt);
                    d1 = __builtin_amdgcn_mfma_f32_16x16x32_bf16(pf, wB[ks], d1, 0, 0, 0); }
#pragma unroll
                for (int i = 0; i < 4; ++i) { const int t = 16 * tt + 4 * (int)q + i; const float av = sct[t];
                    if (r == 0u) p.DEN()[dbase + (size_t)ml_tok(dir, b, c * 64 + t) * MH] = av * d1[i]; } }
            { const int dt = wave; f32x4 nn = *(const LAS f32x4*)(n_old + 16 * dt + 4 * q) * cs.decay; if (r != 0u) nn = (f32x4){0.f, 0.f, 0.f, 0.f};
#pragma unroll
                for (int ks = 0; ks < 2; ++ks) { const bf16x8 kA = cat8(trr(Ki + ML_TRA(dt, ks, 0)), trr(Ki + ML_TRA(dt, ks, 1)));
                    nn = __builtin_amdgcn_mfma_f32_16x16x32_bf16(kA, wB[ks], nn, 0, 0, 0); }
                if (r == 0u) *(LAS f32x4*)(n_new + 16 * dt + 4 * q) = nn; }
        }
        m = cs.m_next; cs = csn; ign = ig2; fgn = fg2;
    }
    __syncthreads(); ML_FLUSH(NC - 1);
#undef ML_FLUSH
#undef ML_TRA
#undef ML_TABLE
#undef ML_LOAD
#undef ML_GATES
#undef ML_STORE
}
}
__device__ __forceinline__ void phase4(const Prm& p, const Frame& F) {
    static_assert(MV == 256 && MH == 4, "head j = float4 slot j of the lane");
    const int gw = F.bid * NWAVES + F.wave, NGW = F.G * NWAVES;
    for (int row = gw; row < T; row += NGW) {
        const uint2* hf = (const uint2*)(p.HF16() + (size_t)row * MW) + F.lane; const uint2* hb = (const uint2*)(p.HB16() + (size_t)row * MW) + F.lane;
        const uint2* og = (const uint2*)(p.PJ() + (size_t)row * INM + O_O) + F.lane; uint2* yo = (uint2*)(p.Y() + (size_t)row * D + CW) + F.lane;
#pragma unroll
        for (int j = 0; j < MH; ++j) {
            const float* d2 = p.DEN() + (size_t)2 * T * MH;
            const float i_f = 1.f / fmaxf(fabsf(p.DEN()[(size_t)row * MH + j] + d2[(size_t)row * MH + j]), p.FLR()[(size_t)row * MH + j]);
            const float i_b = 1.f / fmaxf(fabsf(p.DEN()[((size_t)T + row) * MH + j] + d2[((size_t)T + row) * MH + j]), p.FLR()[((size_t)T + row) * MH + j]);
            const uint2 a = hf[64 * j], b = hb[64 * j]; float4 h = make_float4(bflo(a.x) * i_f + bflo(b.x) * i_b, bfhi(a.x) * i_f + bfhi(b.x) * i_b, bflo(a.y) * i_f + bflo(b.y) * i_b, bfhi(a.y) * i_f + bfhi(b.y) * i_b);
            const float mean = wave_sum((h.x + h.y) + (h.z + h.w)) * (1.f / MV);
            h.x -= mean; h.y -= mean; h.z -= mean; h.w -= mean;
            const float rstd = 1.f / sqrtf(wave_sum((h.x * h.x + h.y * h.y) + (h.z * h.z + h.w * h.w)) * (1.f / MV) + LN_EPS);
            const float4 nw = *((const float4*)(p.mnorm_w + j * MV) + F.lane); const uint2 o = og[64 * j];
            yo[64 * j] = make_uint2(pk2(h.x * rstd * nw.x * sigmoidf_(bflo(o.x)), h.y * rstd * nw.y * sigmoidf_(bfhi(o.x))), pk2(h.z * rstd * nw.z * sigmoidf_(bflo(o.y)), h.w * rstd * nw.w * sigmoidf_(bfhi(o.y)))); }
    }
}
struct EpiZ {
    static constexpr bool PERM = false, AFTER_DRAIN = false;
    const float* x; const float* mod; bf16_t* out;
    __device__ __forceinline__ void operator()(const pg8::f32x4 (&acc)[2][2][4][2], const pg8::Unit& u, int wr, int wc, int fr, int fq) const {
        const int col0 = u.pn * 256 + wc * 32 + 4 * fq;
#pragma unroll
        for (int ai = 0; ai < 2; ++ai)
#pragma unroll
            for (int m = 0; m < 4; ++m) { const int row = u.pm * 256 + ai * 128 + wr * 64 + m * 16 + fr; const float* g1 = mod + (size_t)(row / S) * D6 + 2 * D; const size_t off = (size_t)row * D + col0;
#pragma unroll
                for (int bj = 0; bj < 2; ++bj)
#pragma unroll
                    for (int n = 0; n < 2; ++n) { const int c = bj * 128 + n * 16; const pg8::f32x4 xv = *(const pg8::f32x4*)(x + off + c), gv = *(const pg8::f32x4*)(g1 + col0 + c);
                        const pg8::f32x4 z = xv * ALPHA + gv * acc[ai][bj][m][n]; *(uint2*)(out + off + c) = make_uint2(pk2(z[0], z[1]), pk2(z[2], z[3])); } }
    }
};

struct EpiF32 {
    static constexpr bool PERM = false, AFTER_DRAIN = false;
    float* out; int ldc;
    __device__ __forceinline__ void operator()(const pg8::f32x4 (&acc)[2][2][4][2], const pg8::Unit& u, int wr, int wc, int fr, int fq) const {
        const int col0 = u.pn * 256 + wc * 32 + 4 * fq;
#pragma unroll
        for (int ai = 0; ai < 2; ++ai)
#pragma unroll
            for (int m = 0; m < 4; ++m) { float* rowp = out + (size_t)(u.pm * 256 + ai * 128 + wr * 64 + m * 16 + fr) * ldc + col0;
#pragma unroll
                for (int bj = 0; bj < 2; ++bj)
#pragma unroll
                    for (int n = 0; n < 2; ++n) *(pg8::f32x4*)(rowp + bj * 128 + n * 16) = acc[ai][bj][m][n]; }
    }
};
__device__ __forceinline__ unsigned skey(float f) { const unsigned u = f_as_u(f); return (u & 0x80000000u) ? ~u : (u | 0x80000000u); }
__device__ __forceinline__ float unskey(unsigned k) { return u_as_f((k & 0x80000000u) ? (k & 0x7fffffffu) : ~k); }
__device__ __forceinline__ void tk_cx(unsigned& a, unsigned& b) { const unsigned hi = a > b ? a : b, lo = a > b ? b : a; a = hi; b = lo; }
__device__ __forceinline__ void tk_sort16(unsigned (&v)[16]) {
#pragma unroll
    for (int k = 2; k <= 16; k <<= 1)
#pragma unroll
        for (int j = k >> 1; j >= 1; j >>= 1)
#pragma unroll
            for (int i = 0; i < 16; ++i) { const int l = i ^ j; if (l > i) { if ((i & k) == 0) tk_cx(v[i], v[l]); else tk_cx(v[l], v[i]); } }
}
__device__ __forceinline__ void tk_merge16(unsigned (&L)[16], const unsigned (&C)[16]) {
#pragma unroll
    for (int i = 0; i < 16; ++i) L[i] = L[i] > C[15 - i] ? L[i] : C[15 - i];
#pragma unroll
    for (int j = 8; j >= 1; j >>= 1)
#pragma unroll
        for (int i = 0; i < 16; ++i) { const int l = i ^ j; if (l > i) tk_cx(L[i], L[l]); }
}
__device__ __forceinline__ void tk_top16(const float* sc, unsigned (&L)[16]) {
#pragma unroll 1
    for (int ch = 0; ch < NK / 16; ++ch) { unsigned C[16];
#pragma unroll
        for (int q4 = 0; q4 < 4; ++q4) { const float4 v = ((const float4*)sc)[4 * ch + q4]; const unsigned b = 127u - 16u * ch - 4u * q4;
            C[4 * q4] = (skey(v.x) & ~0x7fu) | b; C[4 * q4 + 1] = (skey(v.y) & ~0x7fu) | (b - 1); C[4 * q4 + 2] = (skey(v.z) & ~0x7fu) | (b - 2); C[4 * q4 + 3] = (skey(v.w) & ~0x7fu) | (b - 3); }
        tk_sort16(C);
        if (ch == 0) {
#pragma unroll
            for (int i = 0; i < 16; ++i) L[i] = C[i]; }
        else tk_merge16(L, C); }
}
__device__ __forceinline__ void phase8(const Prm& p, const Frame& F) {
    static_assert(NK == 128 && TOPK == 16, "top-k phase is specialised");
    const long gt = (long)F.bid * NTHR + F.tid, GT = (long)F.G * NTHR;
    LAS unsigned* ix = (LAS unsigned*)F.lds + F.tid;
    for (long i = gt; i < (long)T * PH; i += GT) {
        unsigned A[16], B[16];
        tk_top16(p.SC() + (size_t)i * 2 * NK, A); tk_top16(p.SC() + (size_t)i * 2 * NK + NK, B);
        float sa[16], sb[16];
#pragma unroll
        for (int k = 0; k < 16; ++k) { sa[k] = unskey(A[k] & ~0x7fu); sb[k] = unskey(B[k] & ~0x7fu); ix[NTHR * k] = 127u - (A[k] & 0x7fu); ix[NTHR * (16 + k)] = 127u - (B[k] & 0x7fu); }
        unsigned L[16], C[16]; int n = 0;
#pragma unroll
        for (int a = 0; a < 16; ++a)
#pragma unroll
            for (int b = 0; b < 16; ++b) if ((a + 1) * (b + 1) <= 16) { const unsigned key = (skey(sa[a] + sb[b]) & ~0xffu) | (unsigned)(255 - (16 * a + b));
                C[n & 15] = key; ++n;
                if ((n & 15) == 0 || n == 50) { if (n == 50) {
#pragma unroll
                        for (int z = 2; z < 16; ++z) C[z] = 0u; }
                    tk_sort16(C);
                    if (n == 16) {
#pragma unroll
                        for (int z = 0; z < 16; ++z) L[z] = C[z]; }
                    else tk_merge16(L, C); } }
        float V[16]; float sum = 0.f; const float vmax = unskey(L[0] & ~0xffu);
#pragma unroll
        for (int r = 0; r < 16; ++r) { V[r] = __expf(unskey(L[r] & ~0xffu) - vmax); sum += V[r]; }
        const float inv = 1.f / sum; int E[16];
#pragma unroll
        for (int r = 0; r < 16; ++r) { const unsigned fl = 255u - (L[r] & 0xffu); E[r] = (int)(ix[NTHR * (fl >> 4)] * NK + ix[NTHR * (16 + (fl & 15u))]); }
#pragma unroll
        for (int r = 0; r < 16; r += 4) { *(int4*)(p.EIDX() + (size_t)i * TOPK + r) = make_int4(E[r], E[r + 1], E[r + 2], E[r + 3]);
            *(float4*)(p.EW() + (size_t)i * TOPK + r) = make_float4(V[r] * inv, V[r + 1] * inv, V[r + 2] * inv, V[r + 3] * inv); }
    }
}
__device__ __forceinline__ void phase6(const Prm& p, const Frame& F) {
    LAS float* PW = (LAS float*)F.lds; LAS float* PB = PW + D; LAS float* PSH = PW + 2 * D; LAS float* PSC = PW + 3 * D;
    const int rows_per = T / F.G, r_begin = F.bid * rows_per, r_end = r_begin + rows_per;
    int cur_b = -1;
    for (int i = F.tid; i < D; i += NTHR) { PW[i] = p.ln1_w[i]; PB[i] = p.ln1_b[i]; }
    float4 v[8]; uint2 zb[8], zn[8];
    { const uint2* z0 = (const uint2*)((const bf16_t*)p.out + (size_t)(r_begin + F.wave) * D) + F.lane;
#pragma unroll
      for (int j = 0; j < 8; ++j) zb[j] = z0[64 * j]; }
    for (int r0 = r_begin; r0 < r_end; r0 += NWAVES) {
        const int row = r0 + F.wave, b = r0 / S;
        if (b != cur_b) { __syncthreads(); const float* mod = p.MOD() + (size_t)b * D6;
            for (int i = F.tid; i < D; i += NTHR) { PSH[i] = mod[3 * D + i]; PSC[i] = 1.f + mod[4 * D + i]; }
            cur_b = b; __syncthreads(); }
        uint2* x1r = (uint2*)(p.X1B() + (size_t)row * D) + F.lane;
        float s = 0.f;
        if (r0 + NWAVES < r_end) { const uint2* zp = (const uint2*)((const bf16_t*)p.out + (size_t)(row + NWAVES) * D) + F.lane;
#pragma unroll
            for (int j = 0; j < 8; ++j) zn[j] = zp[64 * j]; }
#pragma unroll
        for (int j = 0; j < 8; ++j) { v[j] = make_float4(bflo(zb[j].x), bfhi(zb[j].x), bflo(zb[j].y), bfhi(zb[j].y)); s += (v[j].x + v[j].y) + (v[j].z + v[j].w); }
        float mean = wave_sum(s) * (1.f / D), s2 = 0.f;
#pragma unroll
        for (int j = 0; j < 8; ++j) { v[j].x -= mean; v[j].y -= mean; v[j].z -= mean; v[j].w -= mean; s2 += (v[j].x * v[j].x + v[j].y * v[j].y) + (v[j].z * v[j].z + v[j].w * v[j].w); }
        float rstd = 1.f / sqrtf(wave_sum(s2) * (1.f / D) + LN_EPS); s = 0.f;
#pragma unroll
        for (int j = 0; j < 8; ++j) { const f4v w = *(const LAS f4v*)(PW + 4 * F.lane + 256 * j), bb = *(const LAS f4v*)(PB + 4 * F.lane + 256 * j);
            v[j].x = v[j].x * rstd * w[0] + bb[0]; v[j].y = v[j].y * rstd * w[1] + bb[1]; v[j].z = v[j].z * rstd * w[2] + bb[2]; v[j].w = v[j].w * rstd * w[3] + bb[3];
            x1r[64 * j] = make_uint2(pk2(v[j].x, v[j].y), pk2(v[j].z, v[j].w)); s += (v[j].x + v[j].y) + (v[j].z + v[j].w); }
        mean = wave_sum(s) * (1.f / D); s2 = 0.f;
#pragma unroll
        for (int j = 0; j < 8; ++j) { v[j].x -= mean; v[j].y -= mean; v[j].z -= mean; v[j].w -= mean; s2 += (v[j].x * v[j].x + v[j].y * v[j].y) + (v[j].z * v[j].z + v[j].w * v[j].w); }
        rstd = 1.f / sqrtf(wave_sum(s2) * (1.f / D) + LN_EPS);
        uint2* o8 = (uint2*)(p.U() + (size_t)row * D) + F.lane;
#pragma unroll
        for (int j = 0; j < 8; ++j) { const f4v sh = *(const LAS f4v*)(PSH + 4 * F.lane + 256 * j), sc = *(const LAS f4v*)(PSC + 4 * F.lane + 256 * j);
            o8[64 * j] = make_uint2(pk2(v[j].x * rstd * sc[0] + sh[0], v[j].y * rstd * sc[1] + sh[1]), pk2(v[j].z * rstd * sc[2] + sh[2], v[j].w * rstd * sc[3] + sh[3])); }
#pragma unroll
        for (int j = 0; j < 8; ++j) zb[j] = zn[j];
    }
}
struct XW { int vx, nx, rank, nloc; };
constexpr int NDS = 16, DSW = D / NDS;
typedef float f2v __attribute__((ext_vector_type(2)));
struct Row8 { uint4 r[8]; };
__device__ __forceinline__ void gather8(Row8& g, const unsigned char* tbu, unsigned loff, int ereg, int pg) {
#pragma unroll
    for (int k = 0; k < 8; ++k) { const unsigned e = (unsigned)__shfl(ereg, 8 * k + pg); g.r[k] = *(const uint4*)(tbu + (((size_t)e << 11) | loff)); }
}
#define PEER_CVT8(a) const f2v c0 = __builtin_amdgcn_cvt_pk_f32_fp8((a).x, false), c1 = __builtin_amdgcn_cvt_pk_f32_fp8((a).x, true), c2 = __builtin_amdgcn_cvt_pk_f32_fp8((a).y, false), c3 = __builtin_amdgcn_cvt_pk_f32_fp8((a).y, true), \
    c4 = __builtin_amdgcn_cvt_pk_f32_fp8((a).z, false), c5 = __builtin_amdgcn_cvt_pk_f32_fp8((a).z, true), c6 = __builtin_amdgcn_cvt_pk_f32_fp8((a).w, false), c7 = __builtin_amdgcn_cvt_pk_f32_fp8((a).w, true)
typedef _Float16 h2t __attribute__((ext_vector_type(2)));
__device__ __forceinline__ float peer_dot16h(const uint4 a, const h2t* u) {
    float acc = __builtin_amdgcn_fdot2(__builtin_amdgcn_cvt_scalef32_pk_f16_fp8(a.x, 1.0f, false), u[0], 0.f, false);
    acc = __builtin_amdgcn_fdot2(__builtin_amdgcn_cvt_scalef32_pk_f16_fp8(a.x, 1.0f, true), u[1], acc, false);
    acc = __builtin_amdgcn_fdot2(__builtin_amdgcn_cvt_scalef32_pk_f16_fp8(a.y, 1.0f, false), u[2], acc, false);
    acc = __builtin_amdgcn_fdot2(__builtin_amdgcn_cvt_scalef32_pk_f16_fp8(a.y, 1.0f, true), u[3], acc, false);
    acc = __builtin_amdgcn_fdot2(__builtin_amdgcn_cvt_scalef32_pk_f16_fp8(a.z, 1.0f, false), u[4], acc, false);
    acc = __builtin_amdgcn_fdot2(__builtin_amdgcn_cvt_scalef32_pk_f16_fp8(a.z, 1.0f, true), u[5], acc, false);
    acc = __builtin_amdgcn_fdot2(__builtin_amdgcn_cvt_scalef32_pk_f16_fp8(a.w, 1.0f, false), u[6], acc, false);
    acc = __builtin_amdgcn_fdot2(__builtin_amdgcn_cvt_scalef32_pk_f16_fp8(a.w, 1.0f, true), u[7], acc, false);
    return acc;
}
__device__ __forceinline__ f2v rscatter16(const float* v, bool b0, bool b1, bool b2, int m0, int m1, int m2) {
    float r8[8], r4[4]; f2v r2;
#pragma unroll
    for (int i = 0; i < 8; ++i) { const float keep = b0 ? v[8 + i] : v[i], send = b0 ? v[i] : v[8 + i]; r8[i] = keep + __shfl_xor(send, m0); }
#pragma unroll
    for (int i = 0; i < 4; ++i) { const float keep = b1 ? r8[4 + i] : r8[i], send = b1 ? r8[i] : r8[4 + i]; r4[i] = keep + __shfl_xor(send, m1); }
    { const float k0 = b2 ? r4[2] : r4[0], s0 = b2 ? r4[0] : r4[2], k1 = b2 ? r4[3] : r4[1], s1 = b2 ? r4[1] : r4[3]; r2.x = k0 + __shfl_xor(s0, m2); r2.y = k1 + __shfl_xor(s1, m2); }
    return r2;
}
__device__ __forceinline__ void phase9(const Prm& p, const Frame& F, const XW& xw) {
    static_assert(DSW == 128 && NSLOT == 128 && D == 2048, "slice row = 8 lanes x 16 bytes");
    const int pg = F.lane >> 3, part = F.lane & 7; const bool p0 = part & 1, p1 = part & 2, p2 = part & 4;
    const int tstep = xw.nloc * NWAVES, t0 = xw.rank * NWAVES + F.wave; const int nt = t0 < T ? (T - t0 + tstep - 1) / tstep : 0;
    const unsigned loff = (unsigned)part * 16u; const int k0 = (p0 ? 8 : 0) + (p1 ? 4 : 0) + (p2 ? 2 : 0);
    for (int ds = xw.vx; ds < NDS; ds += xw.nx) {
        if (nt == 0) continue;
        const unsigned char* tbu = p.PU8() + ds * DSW; _Float16* part_out = (_Float16*)p.SC() + (size_t)ds * T * NSLOT + pg + 8 * k0;
#define UP_TOK(i) (t0 + ((i) < nt ? (i) : nt - 1) * tstep)
#define UP_LOADE(i, ea, eb) do { const int* ep_ = p.EIDX() + (size_t)UP_TOK(i) * NSLOT + F.lane; ea = ep_[0]; eb = ep_[64]; } while (0)
#define UP_LOADU(i, ua_, ub_) do { const uint4* up_ = (const uint4*)(p.U() + (size_t)UP_TOK(i) * D + ds * DSW + part * 16); ua_ = up_[0]; ub_ = up_[1]; } while (0)
        int e0a, e0b, e1a, e1b, e2a, e2b; uint4 ua, ub, una, unb;
        UP_LOADE(0, e0a, e0b); UP_LOADE(1, e1a, e1b); UP_LOADE(2, e2a, e2b); UP_LOADU(0, ua, ub);
        Row8 G0, G1, G2, G3;
        gather8(G0, tbu, loff, e0a, pg); gather8(G1, tbu, loff, e0b, pg); gather8(G2, tbu, loff, e1a, pg);
#define UP_BODY(i, GA, GB, GC, GD) do { \
            gather8(GD, tbu, loff, e1b, pg); UP_LOADU((i) + 1, una, unb); int e3a, e3b; UP_LOADE((i) + 3, e3a, e3b); \
            h2t u[8]; u[0] = (h2t){(_Float16)bflo(ua.x), (_Float16)bfhi(ua.x)}; u[1] = (h2t){(_Float16)bflo(ua.y), (_Float16)bfhi(ua.y)}; u[2] = (h2t){(_Float16)bflo(ua.z), (_Float16)bfhi(ua.z)}; u[3] = (h2t){(_Float16)bflo(ua.w), (_Float16)bfhi(ua.w)}; \
            u[4] = (h2t){(_Float16)bflo(ub.x), (_Float16)bfhi(ub.x)}; u[5] = (h2t){(_Float16)bflo(ub.y), (_Float16)bfhi(ub.y)}; u[6] = (h2t){(_Float16)bflo(ub.z), (_Float16)bfhi(ub.z)}; u[7] = (h2t){(_Float16)bflo(ub.w), (_Float16)bfhi(ub.w)}; \
            float dv[16]; \
            _Pragma("unroll") for (int k = 0; k < 8; ++k) dv[k] = peer_dot16h(GA.r[k], u); \
            gather8(GA, tbu, loff, e2a, pg); \
            _Pragma("unroll") for (int k = 0; k < 8; ++k) dv[8 + k] = peer_dot16h(GB.r[k], u); \
            const f2v r2 = rscatter16(dv, p0, p1, p2, 1, 2, 4);                          \
            if ((i) < nt) { _Float16* po = part_out + (size_t)UP_TOK(i) * NSLOT; po[0] = (_Float16)(r2.x * 0.0625f); po[8] = (_Float16)(r2.y * 0.0625f); } \
            e1a = e2a; e1b = e2b; e2a = e3a; e2b = e3b; ua = una; ub = unb; } while (0)
        for (int i = 0; i < nt; i += 2) { UP_BODY(i, G0, G1, G2, G3); UP_BODY(i + 1, G2, G3, G0, G1); }
#undef UP_BODY
#undef UP_LOADU
#undef UP_LOADE
#undef UP_TOK
    }
}
__device__ __forceinline__ void phase10(const Prm& p, const Frame& F) {
    static_assert(NE <= 16384 && NSLOT == 128 && T % 64 == 0, "14-bit expert id, 64-token groups");
    LAS unsigned* tile = (LAS unsigned*)F.lds;
    for (int tg = F.bid; tg < T / 64; tg += F.G) {
        __syncthreads();
#pragma unroll
        for (int k = 0; k < 2; ++k) { const int idx = F.tid + NTHR * k, tl = idx >> 4, so = idx & 15; const size_t i0 = ((size_t)tg * 64 + tl) * NSLOT + 8 * so;
            float sm[8];
#pragma unroll
            for (int j = 0; j < 8; ++j) sm[j] = 0.f;
#pragma unroll
            for (int ds = 0; ds < NDS; ++ds) { const uint4 q4 = *(const uint4*)((const _Float16*)p.SC() + (size_t)ds * T * NSLOT + i0);
                typedef _Float16 h2c __attribute__((ext_vector_type(2)));
                const unsigned qq[4] = {q4.x, q4.y, q4.z, q4.w};
#pragma unroll
                for (int j = 0; j < 4; ++j) { const h2c hv = __builtin_bit_cast(h2c, qq[j]); sm[2 * j] += (float)hv[0]; sm[2 * j + 1] += (float)hv[1]; } }
            const int4 ea = *(const int4*)(p.EIDX() + i0), eb = *(const int4*)(p.EIDX() + i0 + 4); const float4 ga = *(const float4*)(p.EW() + i0), gb = *(const float4*)(p.EW() + i0 + 4);
            const int ee[8] = {ea.x, ea.y, ea.z, ea.w, eb.x, eb.y, eb.z, eb.w}; const float gg[8] = {ga.x, ga.y, ga.z, ga.w, gb.x, gb.y, gb.z, gb.w};
#pragma unroll
            for (int j = 0; j < 8; ++j) { const int e = ee[j]; const _Float16 w = (_Float16)(gg[j] * gelu_exact(sm[j] * 16.f * p.RSU()[e]) * p.RSV()[e] * 256.f);
                tile[tl * 129 + 8 * so + j] = (((unsigned)__builtin_bit_cast(unsigned short, w) << 16) & 0xFFFE0000u) | ((unsigned)e << 3); } }
        __syncthreads();
        uint4* pk = (uint4*)p.EW() + (size_t)tg * 64 * (NSLOT / 4);
#pragma unroll
        for (int k = 0; k < 4; ++k) { const int j = F.tid + NTHR * k, sq = j >> 6, tl = j & 63; const LAS unsigned* tp = tile + tl * 129 + 4 * sq; pk[j] = make_uint4(tp[0], tp[1], tp[2], tp[3]); }
    }
}
__device__ __forceinline__ void phase11(const Prm& p, const Frame& F) {
    static_assert(NE * 8 <= RING_BYTES && D % 8 == 0 && NE <= 65536, "table slice fits the LDS ring");
    typedef _Float16 h2v __attribute__((ext_vector_type(2)));
    const int c0 = (F.G % 8 == 0) ? (F.bid % 8) * (F.G / 8) + F.bid / 8 : F.bid;
    for (int sidx = c0; sidx < D / 8; sidx += F.G) {
        __syncthreads();
        { const uint4* src = (const uint4*)(p.PV8S() + (size_t)sidx * NE * 8);
          for (int i = F.tid; i < NE / 2; i += NTHR) *(LAS u32x4_t*)(F.lds + 16 * i) = __builtin_bit_cast(u32x4_t, src[i]); }
        __syncthreads();
        const int ntg = (T / 64 - F.wave + NWAVES - 1) / NWAVES, nb = 8 * ntg;
        uint4 b0[4], b1[4], b2[4], b3[4];
        const int kx = (F.G % 8 == 0) ? F.bid >> 3 : F.bid, rot = kx & 3, rotb = (kx >> 2) & 7;
#define DN_TG(bi) (F.wave + ((((bi) >> 3) + rot) % ntg) * NWAVES)
#define DN_PTR(bi) ((const uint4*)p.EW() + (size_t)DN_TG(bi) * 64 * (NSLOT / 4) + ((((bi) & 7) + rotb) & 7) * 4 * 64 + F.lane)
#define DN_LOAD(B, bi) do { const int bc_ = (bi) < nb ? (bi) : nb - 1; const uint4* pk_ = DN_PTR(bc_); _Pragma("unroll") for (int k = 0; k < 4; ++k) B[k] = pk_[k * 64]; } while (0)
#define DN_ONE(v_) do { const unsigned vv_ = (v_); const _Float16 w = __builtin_bit_cast(_Float16, (unsigned short)(vv_ >> 16)); const h2v w2 = {w, w}; \
                const u2v t = *(const LAS u2v*)(F.lds + (vv_ & 0x1FFF8u)); const unsigned tx_ = t.x, ty_ = t.y; \
                a0 += __builtin_amdgcn_cvt_scalef32_pk_f16_fp8(tx_, 1.0f, false) * w2; a1 += __builtin_amdgcn_cvt_scalef32_pk_f16_fp8(tx_, 1.0f, true) * w2; \
                a2 += __builtin_amdgcn_cvt_scalef32_pk_f16_fp8(ty_, 1.0f, false) * w2; a3 += __builtin_amdgcn_cvt_scalef32_pk_f16_fp8(ty_, 1.0f, true) * w2; } while (0)
#ifndef DN_REP
#define DN_REP 0
#endif
#define DN_ACC(B) do { _Pragma("unroll") for (int k = 0; k < 4; ++k) { DN_ONE(B[k].x); DN_ONE(B[k].y); DN_ONE(B[k].z); DN_ONE(B[k].w); } asm volatile("" ::: "memory"); \
            if (DN_REP) { const h2v s0_ = a0, s1_ = a1, s2_ = a2, s3_ = a3; for (int rep_ = 0; rep_ < DN_REP; ++rep_) { _Pragma("unroll") for (int k = 0; k < 4; ++k) { DN_ONE(B[k].x); DN_ONE(B[k].y); DN_ONE(B[k].z); DN_ONE(B[k].w); } \
                asm volatile("" :: "v"(a0), "v"(a1), "v"(a2), "v"(a3) : "memory"); } a0 = s0_; a1 = s1_; a2 = s2_; a3 = s3_; } } while (0)
        DN_LOAD(b0, 0); DN_LOAD(b1, 1); DN_LOAD(b2, 2);
        for (int bi = 0; bi < nb; bi += 8) {
            h2v a0 = {0, 0}, a1 = {0, 0}, a2 = {0, 0}, a3 = {0, 0};
            DN_LOAD(b3, bi + 3); DN_ACC(b0);
            DN_LOAD(b0, bi + 4); DN_ACC(b1);
            DN_LOAD(b1, bi + 5); DN_ACC(b2);
            DN_LOAD(b2, bi + 6); DN_ACC(b3);
            DN_LOAD(b3, bi + 7); DN_ACC(b0);
            DN_LOAD(b0, bi + 8); DN_ACC(b1);
            DN_LOAD(b1, bi + 9); DN_ACC(b2);
            DN_LOAD(b2, bi + 10); DN_ACC(b3);
            const int tg = DN_TG(bi); const float us = 1.f / 256.f;
            const uint4 yv = make_uint4(pk2((float)a0[0] * us, (float)a0[1] * us), pk2((float)a1[0] * us, (float)a1[1] * us), pk2((float)a2[0] * us, (float)a2[1] * us), pk2((float)a3[0] * us, (float)a3[1] * us));
            *(uint4*)(p.Y() + ((size_t)tg * 64 + F.lane) * D + 8 * sidx) = yv;
#if defined(DN_STORE_REP)
            for (int rep_ = 0; rep_ < DN_STORE_REP; ++rep_) { asm volatile("" ::: "memory"); __builtin_nontemporal_store(__builtin_bit_cast(u32x4_t, yv), (u32x4_t*)(p.Y() + ((size_t)tg * 64 + F.lane) * D + 8 * sidx)); }
#endif
        }
#undef DN_ACC
#undef DN_ONE
#undef DN_LOAD
#undef DN_PTR
#undef DN_TG
    }
}
__device__ __forceinline__ void phase12(const Prm& p, const Frame& F) {
    LAS float* PW = (LAS float*)F.lds; LAS float* PB = PW + D; LAS float* PG = PW + 2 * D;
    const int rows_per = T / F.G, r_begin = F.bid * rows_per, r_end = r_begin + rows_per;
    int cur_b = -1;
    for (int i = F.tid; i < D; i += NTHR) { PW[i] = p.ln2_w[i]; PB[i] = p.ln2_b[i]; }
    float4 v[8]; uint2 xb[8], xn[8], yb[8], yn[8];
    { const uint2* xr = (const uint2*)(p.X1B() + (size_t)(r_begin + F.wave) * D) + F.lane; const uint2* yr = (const uint2*)(p.Y() + (size_t)(r_begin + F.wave) * D) + F.lane;
#pragma unroll
      for (int j = 0; j < 8; ++j) { xb[j] = xr[64 * j]; yb[j] = yr[64 * j]; } }
    for (int r0 = r_begin; r0 < r_end; r0 += NWAVES) {
        const int row = r0 + F.wave, b = r0 / S;
        if (b != cur_b) { __syncthreads(); const float* g2 = p.MOD() + (size_t)b * D6 + 5 * D;
            for (int i = F.tid; i < D; i += NTHR) PG[i] = g2[i];
            cur_b = b; __syncthreads(); }
        float4* zr = (float4*)(p.out + (size_t)row * D) + F.lane; float s = 0.f;
        if (r0 + NWAVES < r_end) { const uint2* xp = (const uint2*)(p.X1B() + (size_t)(row + NWAVES) * D) + F.lane; const uint2* yp = (const uint2*)(p.Y() + (size_t)(row + NWAVES) * D) + F.lane;
#pragma unroll
            for (int j = 0; j < 8; ++j) { xn[j] = xp[64 * j]; yn[j] = yp[64 * j]; } }
#pragma unroll
        for (int j = 0; j < 8; ++j) { const f4v g = *(const LAS f4v*)(PG + 4 * F.lane + 256 * j);
            v[j].x = ALPHA * bflo(xb[j].x) + g[0] * bflo(yb[j].x); v[j].y = ALPHA * bfhi(xb[j].x) + g[1] * bfhi(yb[j].x); v[j].z = ALPHA * bflo(xb[j].y) + g[2] * bflo(yb[j].y); v[j].w = ALPHA * bfhi(xb[j].y) + g[3] * bfhi(yb[j].y);
            s += (v[j].x + v[j].y) + (v[j].z + v[j].w); }
        const float mean = wave_sum(s) * (1.f / D); float s2 = 0.f;
#pragma unroll
        for (int j = 0; j < 8; ++j) { v[j].x -= mean; v[j].y -= mean; v[j].z -= mean; v[j].w -= mean; s2 += (v[j].x * v[j].x + v[j].y * v[j].y) + (v[j].z * v[j].z + v[j].w * v[j].w); }
        const float rstd = 1.f / sqrtf(wave_sum(s2) * (1.f / D) + LN_EPS);
#pragma unroll
        for (int j = 0; j < 8; ++j) { const f4v w = *(const LAS f4v*)(PW + 4 * F.lane + 256 * j), bb = *(const LAS f4v*)(PB + 4 * F.lane + 256 * j);
            zr[64 * j] = make_float4(v[j].x * rstd * w[0] + bb[0], v[j].y * rstd * w[1] + bb[1], v[j].z * rstd * w[2] + bb[2], v[j].w * rstd * w[3] + bb[3]); }
#pragma unroll
        for (int j = 0; j < 8; ++j) { xb[j] = xn[j]; yb[j] = yn[j]; }
    }
}

struct Args { const float* in[18]; float* out; unsigned char* ws; int ph_lo, ph_hi, li, pad; };
__global__ void __launch_bounds__(NTHR, 2) mk_fwd(Args args) {
    extern __shared__ __attribute__((aligned(16))) unsigned char lds_raw[];
    Frame F; F.lds = (LAS unsigned char*)lds_raw; F.tid = threadIdx.x; F.lane = F.tid & 63; F.wave = __builtin_amdgcn_readfirstlane(F.tid >> 6); F.G = gridDim.x; F.bid = blockIdx.x;
    Prm p; p.x = args.in[0]; p.c = args.in[1]; p.w_ada = args.in[2]; p.b_ada = args.in[3]; p.w_in = args.in[4]; p.b_in = args.in[5]; p.conv_w = args.in[6]; p.conv_b = args.in[7]; p.mnorm_w = args.in[8];
    p.w_out = args.in[9]; p.ln1_w = args.in[10]; p.ln1_b = args.in[11]; p.wq = args.in[12]; p.subkeys = args.in[13]; p.peer_u = args.in[14]; p.peer_v = args.in[15]; p.ln2_w = args.in[16]; p.ln2_b = args.in[17];
    p.out = args.out; p.ws = args.ws;
    volatile LAS unsigned* MISC = (volatile LAS unsigned*)(F.lds + MISC_OFF);
    for (int u = F.tid; u < (LDS_BYTES - LDSCTL_OFF) / 4; u += NTHR) ((LAS unsigned*)(F.lds + LDSCTL_OFF))[u] = 0u;
    __syncthreads();
    const int lo = args.ph_lo, hi = args.ph_hi;
    XcdBarrier bar; bar.bar = (unsigned*)(p.ws + WS_CTL) + CW_BAR + args.li * XCD_BAR_WORDS; bar.x = 0; bar.st = nullptr;
    if (hi - lo > 1) bar = xcd_barrier_post((unsigned*)(p.ws + WS_CTL) + CW_BAR + args.li * XCD_BAR_WORDS, MISC + 8);
#define IN(k) (lo <= (k) && (k) < hi)
#define SEAM(k) do { if (IN(k) && IN((k) + 1)) xcd_barrier(bar); } while (0)
    XW xw; xw.nx = (F.G % 8 == 0) ? 8 : 1; xw.vx = F.bid % xw.nx; xw.rank = F.bid / xw.nx; xw.nloc = F.G / xw.nx;
#define XW_FROM_CENSUS() do { if (hi - lo > 1) { if (F.tid == 0) { unsigned vx_ = 0u; for (unsigned j = 0; j < bar.x; ++j) vx_ += xb_ld(&bar.bar[XB_XCNT(j)]) > 0u ? 1u : 0u; MISC[11] = vx_; } __syncthreads(); \
        xw.vx = (int)MISC[11]; xw.nx = (int)MISC[9]; xw.rank = (int)MISC[10] - 1; xw.nloc = (int)MISC[8]; } } while (0)
    if (IN(0)) { phase0(p, F); deferred_prep<false, true, true>(p, F, 0, F.G); } SEAM(0);
    if (IN(1)) { phase1(p, F); } SEAM(1);
    if (IN(2)) { pg8::Gemm g{p.U(), p.WIN_T(), T, INM, D}; pg8::StaticOrder So; So.init(T, INM, F.G, F.bid);
        pg8::EpiBf16<0> E{p.PJ(), INM, p.b_in, 0, 0, 1.f};
        pg8::gemm_phase<pg8::EpiBf16<0>, pg8::StaticOrder, true, true>(F.lds, g, So, E); } SEAM(2);
    if (IN(3)) { const int nmb = F.G >= 2 ? F.G / 2 : 1;
#ifndef P3_REP_ML
#define P3_REP_ML 1
#define P3_REP_CONV 1
#endif
        if (F.bid < nmb) { for (int rep_ = 0; rep_ < P3_REP_ML; ++rep_) for (int u = F.bid; u < 2 * NB * MH * 2; u += nmb) ml::unit(p, F, u); if (F.G < 2) phase3a(p, F, 0, 1); }
        else { phase3a(p, F, nmb, F.G - nmb); deferred_prep<true, false, false>(p, F, nmb, F.G - nmb); }
        if (F.G < 2) deferred_prep<true, false, false>(p, F, 0, 1); } SEAM(3);
    if (IN(4)) { phase4(p, F); } SEAM(4);
    if (IN(5)) { pg8::Gemm g{p.Y(), p.WOUT_T(), T, D, D}; pg8::StaticOrder So; So.init(T, D, F.G, F.bid);
        EpiZ E{p.x, p.MOD(), (bf16_t*)p.out};
        pg8::gemm_phase<EpiZ, pg8::StaticOrder, true, true>(F.lds, g, So, E); } SEAM(5);
    if (IN(6)) { phase6(p, F); } SEAM(6);
    if (IN(7)) { pg8::Gemm g{p.U(), p.WQ_T(), T, NQ, D}; pg8::StaticOrder So; So.init(T, NQ, F.G, F.bid);
        EpiF32 E{p.SC(), NSC};
        pg8::gemm_phase<EpiF32, pg8::StaticOrder, true, true>(F.lds, g, So, E); } SEAM(7);
    if (IN(8)) { phase8(p, F); } SEAM(8);
    if (IN(9)) { if (lo < 9) XW_FROM_CENSUS(); phase9(p, F, xw); } SEAM(9);
    if (IN(10)) { phase10(p, F); } SEAM(10);
    if (IN(11)) { phase11(p, F); } SEAM(11);
    if (IN(12)) { phase12(p, F); }
#undef IN
#undef SEAM
}

extern "C" void kernel_launch(void* const* d_in, const int* in_sizes, int n_in, void* d_out, int out_size, void* d_ws, size_t ws_size, hipStream_t stream) {
    static int grid = 0;
    if (grid == 0) {
        if (n_in != 18 || out_size != T * D || ws_size < WS_END) { fprintf(stderr, "kernel_launch: unexpected shapes (n_in %d out %d ws %zu, need %zu)\n", n_in, out_size, ws_size, (size_t)WS_END); grid = -1; return; }
        int dev = 0, cus = 0, per_cu = 0;
        if (hipGetDevice(&dev) != hipSuccess || hipDeviceGetAttribute(&cus, hipDeviceAttributeMultiprocessorCount, dev) != hipSuccess) { grid = -1; return; }
        if (hipFuncSetAttribute((const void*)mk_fwd, hipFuncAttributeMaxDynamicSharedMemorySize, LDS_BYTES) != hipSuccess) { fprintf(stderr, "kernel_launch: hipFuncSetAttribute failed\n"); grid = -1; return; }
        if (hipOccupancyMaxActiveBlocksPerMultiprocessor(&per_cu, (const void*)mk_fwd, NTHR, LDS_BYTES) != hipSuccess || per_cu < 1) { fprintf(stderr, "kernel_launch: note: the occupancy query says %d workgroups per CU (advisory; 160 KiB of LDS admits exactly one)\n", per_cu); }
        (void)hipGetLastError();
        grid = cus;
        if (T % grid != 0 || (T / grid) % (2 * NWAVES) != 0) { fprintf(stderr, "kernel_launch: grid %d does not divide the rows\n", grid); grid = -1; return; }
    }
    if (grid < 0) return;
    (void)hipMemsetAsync((char*)d_ws + WS_CTL, 0, 1u << 20, stream);
    Args a{};
    for (int i = 0; i < 18; ++i) a.in[i] = (const float*)d_in[i];
    a.out = (float*)d_out; a.ws = (unsigned char*)d_ws;
#if defined(PROBE_A)
    a.ph_lo = 0; a.ph_hi = PROBE_B + 1; a.li = 0; hipLaunchKernelGGL(mk_fwd, dim3(grid), dim3(NTHR), LDS_BYTES, stream, a);
    a.ph_lo = PROBE_A; a.ph_hi = NPHASE; a.li = 1; hipLaunchKernelGGL(mk_fwd, dim3(grid), dim3(NTHR), LDS_BYTES, stream, a);
#elif MK_N_LAUNCHES == 1
    a.ph_lo = 0; a.ph_hi = NPHASE;
    hipLaunchKernelGGL(mk_fwd, dim3(grid), dim3(NTHR), LDS_BYTES, stream, a);
#else
    for (int k = 0; k < NPHASE; ++k) { a.ph_lo = k; a.ph_hi = k + 1; hipLaunchKernelGGL(mk_fwd, dim3(grid), dim3(NTHR), LDS_BYTES, stream, a); }
#endif
}
```

```cpp
#define MK_N_LAUNCHES 1
#if defined(HOST_EMU)
#include <cmath>
#include <cstdint>
#include <cstring>
#include <cstddef>
#define HD inline
#define HDF inline
#else
#include <hip/hip_runtime.h>
#define HD __host__ __device__ __forceinline__
#define HDF __host__ __device__ __forceinline__
#endif

#ifndef CFG_D
#define CFG_D 2048
#define CFG_B 8
#define CFG_S 2048
#define CFG_PH 8
#define CFG_NK 128
#define CFG_TOPK 16
#define CFG_KD 256
#endif
constexpr int D = CFG_D, NB = CFG_B, S = CFG_S, T = NB * S;
constexpr int CW = D / 2, MW = D - CW, MH = 4, MV = MW / MH, QK = MV / 2, NG = 16, CHUNK = 64;
constexpr int INC = 3 * CW + 2 * MH * QK + 2 * MW + NG;
constexpr int INM = INC - NG;
constexpr int O_GB = 0, O_GC = CW, O_HIN = 2 * CW, O_Q = 3 * CW, O_K = O_Q + MH * QK, O_V = O_K + MH * QK, O_O = O_V + MW;
constexpr int PH = CFG_PH, NK = CFG_NK, TOPK = CFG_TOPK, KD = CFG_KD, KH = KD / 2, NE = NK * NK, NSLOT = PH * TOPK;
constexpr int NQ = PH * KD;
static_assert(PH * 2 * NK == NQ || true, "");
constexpr int NSC = PH * 2 * NK;
constexpr float LN_EPS = 1e-5f;
constexpr float ALPHA = 1.189207115002721f;
constexpr int D6 = 6 * D;

typedef unsigned short bf16_t;
HDF unsigned f_as_u(float f) { unsigned u; memcpy(&u, &f, 4); return u; }
HDF float u_as_f(unsigned u) { float f; memcpy(&f, &u, 4); return f; }
HDF bf16_t f2bf(float f) { unsigned u = f_as_u(f); return (bf16_t)((u + 0x7fffu + ((u >> 16) & 1u)) >> 16); }
HDF float bf2f(bf16_t h) { return u_as_f((unsigned)h << 16); }

constexpr size_t al(size_t x) { return (x + 1048575) & ~(size_t)1048575; }
constexpr size_t WS_CTL = 0;
constexpr size_t WS_MOD = al(1);
constexpr size_t WS_MODP = WS_MOD + al((size_t)NB * D6 * 4);
constexpr int NKS = 32;
constexpr size_t WS_GATES = WS_MODP + al((size_t)NKS * NB * D6 * 4);
constexpr size_t WS_DEN = WS_GATES + al((size_t)T * NG * 4);
constexpr size_t WS_FLR = WS_DEN + al((size_t)4 * T * MH * 4);
constexpr size_t WS_EIDX = WS_FLR + al((size_t)2 * T * MH * 4);
constexpr size_t WS_EW = WS_EIDX + al((size_t)T * NSLOT * 4);
constexpr size_t WS_WIN_T = WS_EW + al((size_t)T * NSLOT * 4);
constexpr size_t WS_WOUT_T = WS_WIN_T + al((size_t)INM * D * 2);
constexpr size_t WS_WQ_T = WS_WOUT_T + al((size_t)D * D * 2);
constexpr size_t WS_PU16 = WS_WQ_T + al((size_t)NQ * D * 2);
constexpr size_t WS_PV16 = WS_PU16 + al((size_t)NE * D * 2);
constexpr size_t WS_U = WS_PV16 + al((size_t)NE * D * 2);
constexpr size_t WS_Y = WS_U + al((size_t)T * D * 2);
constexpr size_t WS_P = WS_Y + al((size_t)T * D * 2);
constexpr size_t WS_SC = WS_P;
constexpr size_t WS_TS = WS_SC + al((size_t)T * NSC * 4);
constexpr size_t WS_TI = WS_TS + al((size_t)T * PH * 2 * TOPK * 4);
constexpr size_t WS_P_END = WS_P + al((size_t)T * INM * 2);
constexpr size_t WS_TI_END = WS_TI + al((size_t)T * PH * 2 * TOPK * 4);
constexpr size_t WS_END = WS_P_END > WS_TI_END ? WS_P_END : WS_TI_END;

struct Prm {
    const float *x, *c, *w_ada, *b_ada, *w_in, *b_in, *conv_w, *conv_b, *mnorm_w, *w_out, *ln1_w, *ln1_b, *wq, *subkeys, *peer_u, *peer_v, *ln2_w, *ln2_b;
    float* out;
    unsigned char* ws;
    HDF float* MOD() const { return (float*)(ws + WS_MOD); }
    HDF float* MODP() const { return (float*)(ws + WS_MODP); }
    HDF float* BIN256() const { return (float*)(ws + WS_MODP); }
    HDF float* GATES() const { return (float*)(ws + WS_GATES); }
    HDF float* DEN() const { return (float*)(ws + WS_DEN); }
    HDF float* FLR() const { return (float*)(ws + WS_FLR); }
    HDF int* EIDX() const { return (int*)(ws + WS_EIDX); }
    HDF float* EW() const { return (float*)(ws + WS_EW); }
    HDF bf16_t* WIN_T() const { return (bf16_t*)(ws + WS_WIN_T); }
    HDF unsigned char* WIN8() const { return ws + WS_WIN_T; }
    HDF unsigned char* U8() const { return ws + WS_U; }
    HDF bf16_t* WOUT_T() const { return (bf16_t*)(ws + WS_WOUT_T); }
    HDF bf16_t* WQ_T() const { return (bf16_t*)(ws + WS_WQ_T); }
    HDF bf16_t* PU16() const { return (bf16_t*)(ws + WS_PU16); }
    HDF bf16_t* PV16() const { return (bf16_t*)(ws + WS_PV16); }
    HDF unsigned char* PU8() const { return ws + WS_PU16; }
    HDF unsigned char* PV8() const { return ws + WS_PV16; }
    HDF unsigned char* PV8S() const { return ws + WS_PV16; }
    HDF float* RSU() const { return (float*)(ws + WS_PU16 + (size_t)NE * D); }
    HDF float* RSV() const { return (float*)(ws + WS_PU16 + (size_t)NE * D + (size_t)NE * 4); }
    HDF bf16_t* U() const { return (bf16_t*)(ws + WS_U); }
    HDF bf16_t* Y() const { return (bf16_t*)(ws + WS_Y); }
    HDF bf16_t* PJ() const { return (bf16_t*)(ws + WS_P); }
    HDF float* SC() const { return (float*)(ws + WS_SC); }
    HDF bf16_t* X1B() const { return (bf16_t*)(ws + WS_TS); }
    HDF float* TS() const { return (float*)(ws + WS_TS); }
    HDF int* TI() const { return (int*)(ws + WS_TI); }
    HDF float* HF() const { return out; }
    HDF float* HB() const { return out + (size_t)T * MW; }
    HDF bf16_t* HF16() const { return (bf16_t*)out; }
    HDF bf16_t* HB16() const { return (bf16_t*)out + (size_t)T * MW; }
};

HDF float sigmoidf_(float x) { return 1.f / (1.f + expf(-x)); }
HDF float logsigmoidf_(float x) { return fminf(x, 0.f) - log1pf(expf(-fabsf(x))); }
HDF float gelu_exact(float x) { return 0.5f * x * (1.f + erff(x * 0.7071067811865476f)); }

HD void b_ada(const Prm& p, long n) {
    float acc[NB];
#pragma unroll
    for (int b = 0; b < NB; ++b) acc[b] = 0.f;
    for (int k = 0; k < D; ++k) {
        const float w = p.w_ada[(size_t)k * D6 + n];
#pragma unroll
        for (int b = 0; b < NB; ++b) { const float cv = p.c[b * D + k]; acc[b] += cv * sigmoidf_(cv) * w; }
    }
#pragma unroll
    for (int b = 0; b < NB; ++b) p.MOD()[(size_t)b * D6 + n] = acc[b] + p.b_ada[n];
}
HD void b_wt(const float* W, int ldw, int K, bf16_t* WT, long i) { const long n = i / K, k = i % K; WT[i] = f2bf(W[(size_t)k * ldw + n]); }
HD void b_tab(const float* src, bf16_t* dst, long i) { dst[i] = f2bf(src[i]); }
HD void b_ln_mod1(const Prm& p, long row) {
    const float* xr = p.x + (size_t)row * D; const int b = (int)(row / S);
    const float* sh = p.MOD() + (size_t)b * D6; const float* sc = sh + D;
    float s = 0.f; for (int d = 0; d < D; ++d) s += xr[d];
    const float mean = s / D; float q = 0.f; for (int d = 0; d < D; ++d) { const float t = xr[d] - mean; q += t * t; }
    const float rstd = 1.f / sqrtf(q / D + LN_EPS);
    for (int d = 0; d < D; ++d) p.U()[(size_t)row * D + d] = f2bf((xr[d] - mean) * rstd * (1.f + sc[d]) + sh[d]);
}
HD void b_gates(const Prm& p, long i) {
    const long row = i / NG; const int g = (int)(i % NG); float acc = 0.f;
    for (int d = 0; d < D; ++d) acc += bf2f(p.U()[(size_t)row * D + d]) * p.w_in[(size_t)d * INC + INM + g];
    p.GATES()[i] = acc + p.b_in[INM + g];
}
HD float b_dot16(const bf16_t* a, const bf16_t* b, int K) { float acc = 0.f; for (int k = 0; k < K; ++k) acc += bf2f(a[k]) * bf2f(b[k]); return acc; }
HD void b_gemm1(const Prm& p, long i) { const long row = i / INM; const int n = (int)(i % INM);
    p.PJ()[i] = f2bf(b_dot16(p.U() + (size_t)row * D, p.WIN_T() + (size_t)n * D, D) + p.b_in[n]); }
HD void b_conv(const Prm& p, long i) {
    const long row = i / CW; const int ch = (int)(i % CW); const int s = (int)(row % S);
    const bf16_t* pj = p.PJ(); float acc = p.conv_b[ch];
#pragma unroll
    for (int k = 0; k < 3; ++k) { const int s2 = s + k - 1; if (s2 >= 0 && s2 < S) { const size_t r2 = (size_t)(row + k - 1) * INM;
        acc += p.conv_w[k * CW + ch] * (bf2f(pj[r2 + O_GC + ch]) * bf2f(pj[r2 + O_HIN + ch])); } }
    p.Y()[(size_t)row * D + ch] = f2bf(bf2f(pj[(size_t)row * INM + O_GB + ch]) * acc);
}
HDF long ml_tok(int dir, int b, int pos) { return (long)b * S + (dir ? S - 1 - pos : pos); }
HD void b_mscan(const Prm& p, long i) {
    const int v = (int)(i % (MV + 1)), h = (int)((i / (MV + 1)) % MH), b = (int)((i / ((MV + 1) * MH)) % NB), dir = (int)(i / ((MV + 1) * MH * NB));
    float C[QK];
#pragma unroll
    for (int d = 0; d < QK; ++d) C[d] = 0.f;
    float m = 0.f; const float qs = 1.f / sqrtf((float)QK);
    float* H = dir ? p.HB() : p.HF();
    for (int pos = 0; pos < S; ++pos) {
        const long tok = ml_tok(dir, b, pos); const float* g = p.GATES() + tok * NG + dir * 8;
        const float ig = g[h], lf = logsigmoidf_(g[4 + h]);
        const float mn = fmaxf(lf + m, ig), dec = expf(lf + m - mn), wi = expf(ig - mn); m = mn;
        const bf16_t* pj = p.PJ() + (size_t)tok * INM; const float wv = wi * (v < MV ? bf2f(pj[O_V + h * MV + (v < MV ? v : 0)]) : 1.f); float num = 0.f;
#pragma unroll
        for (int d = 0; d < QK; ++d) { C[d] = dec * C[d] + wv * bf2f(pj[O_K + h * QK + d]); num += bf2f(pj[O_Q + h * QK + d]) * qs * C[d]; }
        if (v < MV) H[(size_t)tok * MW + h * MV + v] = num;
        else { p.DEN()[((size_t)dir * T + tok) * MH + h] = num; p.FLR()[((size_t)dir * T + tok) * MH + h] = expf(-mn); }
    }
}
HD void b_headnorm(const Prm& p, long i) {
    const long row = i / MH; const int h = (int)(i % MH);
    const float* hf = p.HF() + (size_t)row * MW + h * MV; const float* hb = p.HB() + (size_t)row * MW + h * MV;
    const float inf_ = 1.f / fmaxf(fabsf(p.DEN()[(size_t)row * MH + h]), p.FLR()[(size_t)row * MH + h]);
    const float inb_ = 1.f / fmaxf(fabsf(p.DEN()[((size_t)T + row) * MH + h]), p.FLR()[((size_t)T + row) * MH + h]);
    float s = 0.f; for (int v = 0; v < MV; ++v) s += hf[v] * inf_ + hb[v] * inb_;
    const float mean = s / MV; float q = 0.f; for (int v = 0; v < MV; ++v) { const float t = hf[v] * inf_ + hb[v] * inb_ - mean; q += t * t; }
    const float rstd = 1.f / sqrtf(q / MV + LN_EPS);
    for (int v = 0; v < MV; ++v) { const float hn = (hf[v] * inf_ + hb[v] * inb_ - mean) * rstd * p.mnorm_w[h * MV + v];
        const float og = sigmoidf_(bf2f(p.PJ()[(size_t)row * INM + O_O + h * MV + v]));
        p.Y()[(size_t)row * D + CW + h * MV + v] = f2bf(og * hn); }
}
HD void b_gemm2(const Prm& p, long i) { const long row = i / D; const int n = (int)(i % D); const int b = (int)(row / S);
    const float acc = b_dot16(p.Y() + (size_t)row * D, p.WOUT_T() + (size_t)n * D, D);
    p.out[i] = ALPHA * p.x[i] + p.MOD()[(size_t)b * D6 + 2 * D + n] * acc; }
HD void b_ln_mid(const Prm& p, long row) {
    float* zr = p.out + (size_t)row * D; const int b = (int)(row / S);
    const float* sh = p.MOD() + (size_t)b * D6 + 3 * D; const float* sc = sh + D;
    float s = 0.f; for (int d = 0; d < D; ++d) s += zr[d];
    float mean = s / D; float q = 0.f; for (int d = 0; d < D; ++d) { const float t = zr[d] - mean; q += t * t; }
    float rstd = 1.f / sqrtf(q / D + LN_EPS);
    s = 0.f; for (int d = 0; d < D; ++d) { const float x1 = (zr[d] - mean) * rstd * p.ln1_w[d] + p.ln1_b[d]; zr[d] = x1; s += x1; }
    mean = s / D; q = 0.f; for (int d = 0; d < D; ++d) { const float t = zr[d] - mean; q += t * t; }
    rstd = 1.f / sqrtf(q / D + LN_EPS);
    for (int d = 0; d < D; ++d) p.U()[(size_t)row * D + d] = f2bf((zr[d] - mean) * rstd * (1.f + sc[d]) + sh[d]);
}
HD void b_gemm3(const Prm& p, long i) { const long row = i / NQ; const int n = (int)(i % NQ);
    p.Y()[i] = f2bf(b_dot16(p.U() + (size_t)row * D, p.WQ_T() + (size_t)n * D, D)); }
HD void b_scores(const Prm& p, long i) { const long tok = i / NSC; const int c = (int)(i % NSC), grp = c / NK, n = c % NK;
    const bf16_t* q = p.Y() + (size_t)tok * NQ + grp * KH; const float* sk = p.subkeys + ((size_t)grp * NK + n) * KH; float acc = 0.f;
    for (int d = 0; d < KH; ++d) acc += bf2f(q[d]) * sk[d];
    p.SC()[i] = acc; }
HD void b_topk1(const Prm& p, long i) {
    const float* sc = p.SC() + (size_t)i * NK; float pv = INFINITY; int pi = -1;
    for (int r = 0; r < TOPK; ++r) { float best = -INFINITY; int bi = -1;
        for (int n = 0; n < NK; ++n) { const float v = sc[n]; const bool ok = (v < pv) || (v == pv && n > pi); if (ok && v > best) { best = v; bi = n; } }
        p.TS()[(size_t)i * TOPK + r] = best; p.TI()[(size_t)i * TOPK + r] = bi; pv = best; pi = bi; }
}
HD void b_topk2(const Prm& p, long i) {
    const float* s0 = p.TS() + (size_t)i * 2 * TOPK; const float* s1 = s0 + TOPK; const int* i0 = p.TI() + (size_t)i * 2 * TOPK; const int* i1 = i0 + TOPK;
    float pv = INFINITY; int pi = -1; float mx = 0.f, sum = 0.f;
    for (int r = 0; r < TOPK; ++r) { float best = -INFINITY; int bi = -1;
        for (int c = 0; c < TOPK * TOPK; ++c) { const float v = s0[c / TOPK] + s1[c % TOPK]; const bool ok = (v < pv) || (v == pv && c > pi); if (ok && v > best) { best = v; bi = c; } }
        if (r == 0) mx = best;
        const float e = expf(best - mx); sum += e;
        p.EIDX()[(size_t)i * TOPK + r] = i0[bi / TOPK] * NK + i1[bi % TOPK]; p.EW()[(size_t)i * TOPK + r] = e; pv = best; pi = bi; }
    for (int r = 0; r < TOPK; ++r) p.EW()[(size_t)i * TOPK + r] /= sum;
}
HD void b_up(const Prm& p, long i) { const long tok = i / NSLOT; const int e = p.EIDX()[i];
    p.EW()[i] *= gelu_exact(b_dot16(p.U() + (size_t)tok * D, p.PU16() + (size_t)e * D, D)); }
HD void b_down(const Prm& p, long i) { const long tok = i / D; const int d = (int)(i % D); const int b = (int)(tok / S); float y = 0.f;
    for (int sl = 0; sl < NSLOT; ++sl) y += p.EW()[tok * NSLOT + sl] * bf2f(p.PV16()[(size_t)p.EIDX()[tok * NSLOT + sl] * D + d]);
    p.out[i] = ALPHA * p.out[i] + p.MOD()[(size_t)b * D6 + 5 * D + d] * y; }
HD void b_ln2(const Prm& p, long row) {
    float* zr = p.out + (size_t)row * D;
    float s = 0.f; for (int d = 0; d < D; ++d) s += zr[d];
    const float mean = s / D; float q = 0.f; for (int d = 0; d < D; ++d) { const float t = zr[d] - mean; q += t * t; }
    const float rstd = 1.f / sqrtf(q / D + LN_EPS);
    for (int d = 0; d < D; ++d) zr[d] = (zr[d] - mean) * rstd * p.ln2_w[d] + p.ln2_b[d];
}
#include <cstdio>
#define LAS __attribute__((address_space(3)))
#define GAS __attribute__((address_space(1)))
namespace pg8 {
#define PG8_LAS __attribute__((address_space(3)))
typedef unsigned short bf16_t;
typedef short bf16x8 __attribute__((ext_vector_type(8)));
typedef float f32x4 __attribute__((ext_vector_type(4)));
typedef unsigned u32x4 __attribute__((ext_vector_type(4)));
constexpr int BM = 256, BK = 64, HALF = 128, HTB = HALF * BK * 2  , STAGE_BYTES = 8 * HTB, NXCD = 8, WGM = 8;

__host__ __device__ __forceinline__ int lds_byte(int r, int c) { const int st = (r >> 4) * 2 + (c >> 5), rr = r & 15, cc = c & 31, ob = rr * 64 + cc * 2; return st * 1024 + (ob ^ (((ob >> 9) & 1) << 5)); }
__host__ __device__ __forceinline__ void stage_rc(int b, int& R, int& C) { const int st = b / 1024, sb = b % 1024, swz = sb ^ (((sb >> 9) & 1) << 5); R = (st >> 1) * 16 + swz / 64; C = (st & 1) * 32 + (swz % 64) / 2; }
__host__ __device__ __forceinline__ int perm32(int rho) { const int n = rho >> 4, i = rho & 15; return 8 * (i >> 2) + 4 * n + (i & 3); }

struct Unit { int pm, pn; };
struct Gemm { const bf16_t* A; const bf16_t* Bt; int M, N, K; };

struct StaticOrder {
    int nM, nN, nwg, G, c;
    __host__ __device__ void init(int M, int N, int G_, int c_) { nM = M / BM; nN = N / BM; nwg = nM * nN; G = G_; c = c_; }
    __host__ __device__ bool next(int i, Unit& u) const {
        const long L = (long)i * G + c; if (L >= nwg) return false;
        int wgid = (int)L; { const int q = nwg / NXCD, r = nwg % NXCD, xcd = wgid % NXCD, off = wgid / NXCD; wgid = (xcd < r ? xcd * (q + 1) : r * (q + 1) + (xcd - r) * q) + off; }
        const int nig = WGM * nN, gid = wgid / nig, fm = gid * WGM, gsz = (nM - fm) < WGM ? (nM - fm) : WGM;
        u.pm = fm + ((wgid % nig) % gsz); u.pn = (wgid % nig) / gsz; return true;
    }
    __device__ __forceinline__ void a_ready(const Unit&) const {}
    __device__ __forceinline__ void done(const Unit&) const {}
};

__device__ __forceinline__ unsigned cvt_pk_bf16(float lo, float hi) { unsigned r; asm volatile("v_cvt_pk_bf16_f32 %0, %1, %2" : "=v"(r) : "v"(lo), "v"(hi)); return r; }
typedef float f32x2 __attribute__((ext_vector_type(2)));
__device__ __forceinline__ f32x2 gelu_pk(f32x2 v) {
    const f32x2 av = __builtin_elementwise_abs(v), d = av * 0.2316418882f + 1.0f;
    f32x2 t; t.x = __builtin_amdgcn_rcpf(d.x); t.y = __builtin_amdgcn_rcpf(d.y);
    f32x2 q = t * 0.5307027145f + (-0.7265760135f); q = q * t + 0.7107068705f; q = q * t + (-0.142248368f); q = q * t + 0.127414796f; q = q * t;
    const f32x2 s = (v * v) * (-0.72134752044f);
    f32x2 e; e.x = __builtin_amdgcn_exp2f(s.x); e.y = __builtin_amdgcn_exp2f(s.y);
    const f32x2 m = v * (q * e), r = v - m;
    f32x2 o; o.x = v.x < 0.f ? m.x : r.x; o.y = v.y < 0.f ? m.y : r.y; return o;
}

template <int ACT  > struct EpiBf16 {
    static constexpr bool PERM = true, AFTER_DRAIN = false; static_assert(ACT == 0 || ACT == 1, "EpiBf16: ACT is 0 (none) or 1 (gelu_pk)");
    bf16_t* O; int ldc; const float* bias; int split_cols; size_t split_stride; float scale0;
    __device__ __forceinline__ void operator()(const f32x4 (&acc)[2][2][4][2], const Unit& u, int wr, int wc, int fr, int fq) const {
        const int row0 = u.pm * BM + wr * 64 + fr; int colt = u.pn * BM; bf16_t* base = O;
        float sc = 1.f; if (split_cols) { const int t = colt / split_cols; base += (size_t)t * split_stride; colt -= t * split_cols; if (t == 0) sc = scale0; }
        const int col0 = colt + wc * 32 + 8 * fq, bcol0 = u.pn * BM + wc * 32 + 8 * fq;
        f32x4 bv[2][2];
#pragma unroll
        for (int bj = 0; bj < 2; ++bj)
#pragma unroll
            for (int n = 0; n < 2; ++n) bv[bj][n] = bias ? *(const f32x4*)(bias + bcol0 + bj * HALF + 4 * n) : (f32x4){0.f, 0.f, 0.f, 0.f};
#pragma unroll
        for (int ai = 0; ai < 2; ++ai)
#pragma unroll
            for (int m = 0; m < 4; ++m) { bf16_t* rowp = base + (size_t)(row0 + ai * HALF + m * 16) * ldc + col0;
#pragma unroll
                for (int bj = 0; bj < 2; ++bj) { f32x4 v0 = acc[ai][bj][m][0] + bv[bj][0], v1 = acc[ai][bj][m][1] + bv[bj][1];
                    if (ACT == 1) { f32x2 a = gelu_pk((f32x2){v0[0], v0[1]}), b = gelu_pk((f32x2){v0[2], v0[3]}), c = gelu_pk((f32x2){v1[0], v1[1]}), d = gelu_pk((f32x2){v1[2], v1[3]});
                        v0 = (f32x4){a.x, a.y, b.x, b.y}; v1 = (f32x4){c.x, c.y, d.x, d.y}; }
                    v0 = v0 * sc; v1 = v1 * sc; u32x4 w; w.x = cvt_pk_bf16(v0[0], v0[1]); w.y = cvt_pk_bf16(v0[2], v0[3]); w.z = cvt_pk_bf16(v1[0], v1[1]); w.w = cvt_pk_bf16(v1[2], v1[3]);
                    *(u32x4*)(rowp + bj * HALF) = w; } }
    }
};
template <class Epi, class Sched, bool ALIGN_EPI = false, bool SP2 = false>
__device__ __forceinline__ void gemm_phase(PG8_LAS unsigned char* lds, const Gemm g, const Sched& S, const Epi& E) {
    const int tid = threadIdx.x, wid = __builtin_amdgcn_readfirstlane(tid >> 6), lane = tid & 63, wr = wid >> 2, wc = wid & 3, fr = lane & 15, fq = lane >> 4;
    const int K = g.K, nt = K / BK;
    unsigned voffA[2], voffB[2];
#pragma unroll
    for (int i = 0; i < 2; ++i) { int R, C; stage_rc(tid * 16 + i * 8192, R, C); const int Rb = Epi::PERM ? ((R & ~31) + perm32(R & 31)) : R;
        voffA[i] = (unsigned)(R * K + C) * 2u; voffB[i] = (unsigned)(Rb * K + C) * 2u; }
    const size_t kstep = (size_t)(BK * 2);
    const size_t hstep = (size_t)HALF * K * 2;
    const size_t tstep = 2 * hstep;
    const unsigned ldsw = (unsigned)wid * 1024u;
    const int aoff = lds_byte(wr * 64 + fr, fq * 8), boff = lds_byte(wc * 32 + fr, fq * 8);
#define PG8_SA(b, h) (((b) * 2 + (h)) * HTB)
#define PG8_SB(b, h) ((4 + (b) * 2 + (h)) * HTB)
#define PG8_STAGE(bufoff, gbase, voff) do { _Pragma("unroll") for (int _i = 0; _i < 2; ++_i) \
        __builtin_amdgcn_global_load_lds((const unsigned*)((const char*)(gbase) + (voff)[_i]), (PG8_LAS unsigned*)(lds + (bufoff) + ldsw + _i * 8192), 16, 0, 0); } while (0)
#define PG8_LDA(dst, b, h) do { _Pragma("unroll") for (int m = 0; m < 4; ++m) _Pragma("unroll") for (int k = 0; k < 2; ++k) dst[m][k] = *(const PG8_LAS bf16x8*)(lds + PG8_SA(b, h) + aoff + m * 2048 + k * 1024); } while (0)
#define PG8_LDB(dst, b, h) do { _Pragma("unroll") for (int n = 0; n < 2; ++n) _Pragma("unroll") for (int k = 0; k < 2; ++k) dst[n][k] = *(const PG8_LAS bf16x8*)(lds + PG8_SB(b, h) + boff + n * 2048 + k * 1024); } while (0)
#define PG8_MMA(ai, bj, At, Bt) do { __builtin_amdgcn_s_setprio(1); _Pragma("unroll") for (int m = 0; m < 4; ++m) _Pragma("unroll") for (int n = 0; n < 2; ++n) _Pragma("unroll") for (int k = 0; k < 2; ++k) \
        acc[ai][bj][m][n] = __builtin_amdgcn_mfma_f32_16x16x32_bf16(Bt[n][k], At[m][k], acc[ai][bj][m][n], 0, 0, 0); __builtin_amdgcn_s_setprio(0); } while (0)
#define PG8_WAIT_V(n) asm volatile("s_waitcnt vmcnt(" #n ")" ::: "memory")
#define PG8_WAIT_L(n) asm volatile("s_waitcnt lgkmcnt(" #n ")" ::: "memory")
#define PG8_BAR __builtin_amdgcn_s_barrier()
#define PG8_SCHED __builtin_amdgcn_sched_barrier(0)
    Unit cur, nxt; int ui = 0;
    if (!S.next(0, cur)) return;
    f32x4 acc[2][2][4][2];
#pragma unroll
    for (int a = 0; a < 2; ++a)
#pragma unroll
        for (int b = 0; b < 2; ++b)
#pragma unroll
            for (int m = 0; m < 4; ++m)
#pragma unroll
                for (int n = 0; n < 2; ++n) acc[a][b][m][n] = (f32x4){0.f, 0.f, 0.f, 0.f};
    bf16x8 At[4][2], B0[2][2], B1[2][2];
    const char* cA = (const char*)g.A + (size_t)cur.pm * tstep; const char* cB = (const char*)g.Bt + (size_t)cur.pn * tstep;
    S.a_ready(cur);
    if constexpr (SP2) {
        PG8_STAGE(PG8_SB(0, 0), cB, voffB); PG8_STAGE(PG8_SB(0, 1), cB + hstep, voffB); PG8_STAGE(PG8_SA(0, 0), cA, voffA); PG8_STAGE(PG8_SA(0, 1), cA + hstep, voffA);
        if (wr == 1) PG8_BAR;
        PG8_WAIT_V(2); PG8_BAR;
        PG8_STAGE(PG8_SB(1, 0), cB + kstep, voffB); PG8_STAGE(PG8_SA(1, 0), cA + kstep, voffA); PG8_STAGE(PG8_SB(1, 1), cB + hstep + kstep, voffB);
        PG8_WAIT_V(6); PG8_BAR;
    } else {
        PG8_STAGE(PG8_SB(0, 0), cB, voffB); PG8_STAGE(PG8_SA(0, 0), cA, voffA); PG8_STAGE(PG8_SB(0, 1), cB + hstep, voffB); PG8_STAGE(PG8_SA(0, 1), cA + hstep, voffA);
        if (wr == 1) PG8_BAR;
        PG8_WAIT_V(4); PG8_BAR;
        PG8_STAGE(PG8_SB(1, 0), cB + kstep, voffB); PG8_STAGE(PG8_SA(1, 0), cA + kstep, voffA); PG8_STAGE(PG8_SB(1, 1), cB + hstep + kstep, voffB);
        PG8_WAIT_V(6); PG8_BAR;
    }
    for (;;) {
        const bool has_next = S.next(ui + 1, nxt);
        const char* nA = has_next ? (const char*)g.A + (size_t)nxt.pm * tstep : cA; const char* nB = has_next ? (const char*)g.Bt + (size_t)nxt.pn * tstep : cB;
        for (int t = 0; t < nt; t += 2) {
            const bool last = (t == nt - 2);
            const char* a1 = cA + (size_t)(t + 1) * kstep;
            const char* a2 = last ? nA : cA + (size_t)(t + 2) * kstep; const char* b2 = last ? nB : cB + (size_t)(t + 2) * kstep;
            const char* a3 = a2 + kstep; const char* b3 = b2 + kstep;
            if (last && has_next) S.a_ready(nxt);
            if constexpr (SP2) {
            PG8_LDB(B0, 0, 0); PG8_LDB(B1, 0, 1); PG8_SCHED; PG8_LDA(At, 0, 0); PG8_STAGE(PG8_SA(1, 1), a1 + hstep, voffA);
            PG8_WAIT_V(8); PG8_WAIT_L(0); PG8_BAR; PG8_MMA(0, 0, At, B0); PG8_MMA(0, 1, At, B1); PG8_BAR; PG8_SCHED;
            PG8_LDA(At, 0, 1); PG8_STAGE(PG8_SB(0, 0), b2, voffB); PG8_STAGE(PG8_SB(0, 1), b2 + hstep, voffB); PG8_STAGE(PG8_SA(0, 0), a2, voffA);
            PG8_WAIT_V(8); PG8_WAIT_L(0); PG8_BAR; PG8_MMA(1, 0, At, B0); PG8_MMA(1, 1, At, B1); PG8_BAR; PG8_SCHED;
            PG8_LDB(B0, 1, 0); PG8_LDB(B1, 1, 1); PG8_SCHED; PG8_LDA(At, 1, 0); PG8_STAGE(PG8_SA(0, 1), a2 + hstep, voffA);
            PG8_WAIT_V(8); PG8_WAIT_L(0); PG8_BAR; PG8_MMA(0, 0, At, B0); PG8_MMA(0, 1, At, B1); PG8_BAR; PG8_SCHED;
            PG8_LDA(At, 1, 1); PG8_STAGE(PG8_SB(1, 0), b3, voffB); PG8_STAGE(PG8_SB(1, 1), b3 + hstep, voffB); PG8_STAGE(PG8_SA(1, 0), a3, voffA);
            PG8_WAIT_V(8); PG8_WAIT_L(0); PG8_BAR; PG8_MMA(1, 0, At, B0); PG8_MMA(1, 1, At, B1); PG8_BAR; PG8_SCHED;
            } else {
            PG8_LDB(B0, 0, 0); PG8_SCHED; PG8_LDA(At, 0, 0); PG8_STAGE(PG8_SA(1, 1), a1 + hstep, voffA);
            PG8_WAIT_L(8); PG8_BAR; PG8_WAIT_L(0); PG8_MMA(0, 0, At, B0); PG8_BAR; PG8_SCHED;
            PG8_LDB(B1, 0, 1); PG8_STAGE(PG8_SB(0, 0), b2, voffB);
            PG8_BAR; PG8_WAIT_L(0); PG8_MMA(0, 1, At, B1); PG8_BAR;
            PG8_LDA(At, 0, 1); PG8_STAGE(PG8_SA(0, 0), a2, voffA);
            PG8_BAR; PG8_WAIT_L(0); PG8_MMA(1, 0, At, B0); PG8_BAR; PG8_SCHED;
            PG8_STAGE(PG8_SB(0, 1), b2 + hstep, voffB);
            PG8_WAIT_V(6); PG8_BAR; PG8_MMA(1, 1, At, B1); PG8_BAR;
            PG8_LDB(B0, 1, 0); PG8_SCHED; PG8_LDA(At, 1, 0); PG8_STAGE(PG8_SA(0, 1), a2 + hstep, voffA);
            PG8_WAIT_L(8); PG8_BAR; PG8_WAIT_L(0); PG8_MMA(0, 0, At, B0); PG8_BAR; PG8_SCHED;
            PG8_LDB(B1, 1, 1); PG8_STAGE(PG8_SB(1, 0), b3, voffB);
            PG8_BAR; PG8_WAIT_L(0); PG8_MMA(0, 1, At, B1); PG8_BAR;
            PG8_LDA(At, 1, 1); PG8_STAGE(PG8_SA(1, 0), a3, voffA);
            PG8_BAR; PG8_WAIT_L(0); PG8_MMA(1, 0, At, B0); PG8_BAR; PG8_SCHED;
            PG8_STAGE(PG8_SB(1, 1), b3 + hstep, voffB);
            PG8_WAIT_V(6); PG8_BAR; PG8_MMA(1, 1, At, B1); PG8_BAR;
            }
        }
        if constexpr (ALIGN_EPI) { if (wr == 0) PG8_BAR; }
        if constexpr (!Epi::AFTER_DRAIN) { E(acc, cur, wr, wc, fr, fq); S.done(cur); }
        if (!has_next) break;
#pragma unroll
        for (int a = 0; a < 2; ++a)
#pragma unroll
            for (int b = 0; b < 2; ++b)
#pragma unroll
                for (int m = 0; m < 4; ++m)
#pragma unroll
                    for (int n = 0; n < 2; ++n) acc[a][b][m][n] = (f32x4){0.f, 0.f, 0.f, 0.f};
        cur = nxt; cA = nA; cB = nB; ++ui;
        if constexpr (ALIGN_EPI) { if (wr == 1) PG8_BAR; }
    }
    PG8_WAIT_V(0);
    if constexpr (!ALIGN_EPI) { if (wr == 0) PG8_BAR; }
    PG8_BAR;
    if constexpr (Epi::AFTER_DRAIN) { E.fused(acc, cur, wr, wc, fr, fq, lds, wid, lane); S.done(cur); }
#undef PG8_SA
#undef PG8_SB
#undef PG8_STAGE
#undef PG8_LDA
#undef PG8_LDB
#undef PG8_MMA
#undef PG8_WAIT_V
#undef PG8_WAIT_L
#undef PG8_BAR
#undef PG8_SCHED
}
}
#define XB_TMO      128
#define XB_XCNT(j)  (256  + 64 * (j))
#define XB_XSUB(j)  (1280 + 64 * (j))
#define XB_XGEN(j)  (2304 + 64 * (j))
#define XB_TOP      3328
#define XB_TOPGEN   3392
#define XCD_BAR_WORDS 3456
#define XB_SPIN_CAP (1u << 18)

__device__ __forceinline__ unsigned xb_ld(unsigned* p)              { return __hip_atomic_load(p, __ATOMIC_RELAXED, __HIP_MEMORY_SCOPE_AGENT); }
__device__ __forceinline__ unsigned xb_add(unsigned* p, unsigned v) { return __hip_atomic_fetch_add(p, v, __ATOMIC_RELAXED, __HIP_MEMORY_SCOPE_AGENT); }
__device__ __forceinline__ unsigned xb_xcc_id() { return (unsigned)__builtin_amdgcn_s_getreg((3 << 11) | 20) & 0xFu; }
#define XB_SPIN(cond, bar) do { unsigned _sp = 0; while (cond) { __builtin_amdgcn_s_sleep(1); \
    if ((++_sp & 255u) == 0u) { if (xb_ld(&(bar)[XB_TMO])) break; if (_sp > XB_SPIN_CAP) { atomicAdd(&(bar)[XB_TMO], 1u); break; } } } } while (0)

struct XcdBarrier {
    unsigned* bar; unsigned x;
    volatile LAS unsigned* st;
};

__device__ __forceinline__ XcdBarrier xcd_barrier_post(unsigned* bar, volatile LAS unsigned* st) {
    XcdBarrier b; b.bar = bar; b.x = xb_xcc_id(); b.st = st;
    if (threadIdx.x == 0) st[2] = xb_add(&bar[XB_XCNT(b.x)], 1u) + 1u;
    return b;
}
__device__ __forceinline__ void xcd_barrier_complete(unsigned* bar, unsigned x, unsigned& nloc, unsigned& nx) {
    const unsigned G = gridDim.x * gridDim.y * gridDim.z;
    unsigned sum, cnt, mine, sp = 0u;
    for (;;) {
        sum = 0u; cnt = 0u; mine = 0u;
#pragma unroll
        for (unsigned j = 0; j < 16; ++j) { const unsigned c = xb_ld(&bar[XB_XCNT(j)]); sum += c; cnt += (c > 0u) ? 1u : 0u; mine = (j == x) ? c : mine; }
        if (sum == G) break;
        __builtin_amdgcn_s_sleep(1);
        if ((++sp & 255u) == 0u) { if (xb_ld(&bar[XB_TMO])) break; if (sp > XB_SPIN_CAP) { atomicAdd(&bar[XB_TMO], 1u); break; } }
    }
    nloc = mine > 0u ? mine : 1u; nx = cnt > 0u ? cnt : 1u;
}

__device__ __forceinline__ void xcd_barrier(const XcdBarrier& b) {
    asm volatile("s_waitcnt vmcnt(0)" ::: "memory");
    __syncthreads();
    if (threadIdx.x == 0) {
        unsigned* bar = b.bar;
        __builtin_amdgcn_s_waitcnt(0);
        unsigned nloc = b.st[0], nx = b.st[1];
        if (nloc == 0u) { xcd_barrier_complete(bar, b.x, nloc, nx); b.st[0] = nloc; b.st[1] = nx; }
        const unsigned old = xb_add(&bar[XB_XSUB(b.x)], 1u);
        const unsigned gen = old / nloc;
        if (old + 1u == (gen + 1u) * nloc) {
            __builtin_amdgcn_fence(__ATOMIC_RELEASE, "agent");
            asm volatile("s_waitcnt vmcnt(0)" ::: "memory");
            const unsigned og = xb_add(&bar[XB_TOP], 1u);
            const unsigned tg = og / nx;
            if (og + 1u == (tg + 1u) * nx) xb_add(&bar[XB_TOPGEN], 1u);
            else XB_SPIN(xb_ld(&bar[XB_TOPGEN]) == tg, bar);
            __builtin_amdgcn_fence(__ATOMIC_ACQUIRE, "agent");
            xb_add(&bar[XB_XGEN(b.x)], 1u);
            asm volatile("s_waitcnt vmcnt(0)" ::: "memory");
        } else {
            XB_SPIN(xb_ld(&bar[XB_XGEN(b.x)]) == gen, bar);
            __builtin_amdgcn_fence(__ATOMIC_ACQUIRE, "agent");
            asm volatile("s_waitcnt vmcnt(0)" ::: "memory");
        }
    }
    __syncthreads();
}
constexpr int NWAVES = 8, NTHR = 512;
constexpr int RING_BYTES = 131072, LDSCTL_OFF = RING_BYTES, MISC_OFF = LDSCTL_OFF + 320, LDS_BYTES = 163840;
constexpr int CW_BAR = 4096;
#ifndef MK_N_LAUNCHES
#define MK_N_LAUNCHES 1
#endif
constexpr int NPHASE = 13;

typedef float f4v __attribute__((ext_vector_type(4)));
typedef unsigned u2v __attribute__((ext_vector_type(2)));
typedef unsigned u32x4_t __attribute__((ext_vector_type(4)));
struct Frame { LAS unsigned char* lds; int tid, lane, wave, G, bid; };
template <int CTRL, int ROWMASK> __device__ __forceinline__ float dppf(float old, float src) {
    return __builtin_bit_cast(float, __builtin_amdgcn_update_dpp(__builtin_bit_cast(int, old), __builtin_bit_cast(int, src), CTRL, ROWMASK, 0xf, false)); }
__device__ __forceinline__ float wave_scan_add(float v) {
    v += dppf<0x111, 0xf>(0.f, v); v += dppf<0x112, 0xf>(0.f, v); v += dppf<0x114, 0xf>(0.f, v); v += dppf<0x118, 0xf>(0.f, v);
    v += dppf<0x142, 0xa>(0.f, v); v += dppf<0x143, 0xc>(0.f, v); return v; }
__device__ __forceinline__ float wave_scan_max(float v) {
    const float NI = -INFINITY;
    v = fmaxf(v, dppf<0x111, 0xf>(NI, v)); v = fmaxf(v, dppf<0x112, 0xf>(NI, v)); v = fmaxf(v, dppf<0x114, 0xf>(NI, v)); v = fmaxf(v, dppf<0x118, 0xf>(NI, v));
    v = fmaxf(v, dppf<0x142, 0xa>(NI, v)); v = fmaxf(v, dppf<0x143, 0xc>(NI, v)); return v; }
__device__ __forceinline__ float lane_bcast(float v, int l) { return __builtin_bit_cast(float, __builtin_amdgcn_readlane(__builtin_bit_cast(int, v), l)); }
__device__ __forceinline__ float wave_sum(float v) { return lane_bcast(wave_scan_add(v), 63); }
__device__ __forceinline__ unsigned pk2(float lo, float hi) { return (unsigned)f2bf(lo) | ((unsigned)f2bf(hi) << 16); }
__device__ __forceinline__ float bflo(unsigned w) { return u_as_f(w << 16); }
__device__ __forceinline__ float bfhi(unsigned w) { return u_as_f(w & 0xffff0000u); }

__device__ __forceinline__ void p0_ada_block(const Prm& p, const Frame& F, int cb) {
    static_assert(D6 % 48 == 0 && NB == 8, "48-column blocks");
    LAS float* sl = (LAS float*)F.lds;
    LAS float* red = sl + NB * D;
    for (int i = F.tid; i < NB * D; i += NTHR) { const float cv = p.c[i]; sl[i] = cv / (1.f + __expf(-cv)); }
    __syncthreads();
    const int c4 = F.tid % 12, kl = F.tid / 12;
    if (kl < 42) {
        f4v acc[NB];
#pragma unroll
        for (int b = 0; b < NB; ++b) acc[b] = (f4v){0.f, 0.f, 0.f, 0.f};
        const float* wp = p.w_ada + (size_t)cb * 48 + 4 * c4;
#pragma unroll 7
        for (int k = kl; k < D; k += 42) { const f4v w = __builtin_nontemporal_load((const f4v*)(wp + (size_t)k * D6));
#pragma unroll
            for (int b = 0; b < NB; ++b) acc[b] += w * sl[b * D + k]; }
#pragma unroll
        for (int b = 0; b < NB; ++b) *(LAS f4v*)(red + (kl * NB + b) * 48 + 4 * c4) = acc[b];
    }
    __syncthreads();
    if (F.tid < NB * 48) { const int b = F.tid / 48, col = F.tid % 48; float s = 0.f;
        for (int k = 0; k < 42; ++k) s += red[(k * NB + b) * 48 + col];
        p.MOD()[(size_t)b * D6 + cb * 48 + col] = s + p.b_ada[cb * 48 + col]; }
    __syncthreads();
}
__device__ __forceinline__ void p0_transpose_item(const float* W, int ldw, int K, int N, bf16_t* WT, LAS float* scr, int item, int lane) {
    const int nblk = N / 32, kb = item / nblk, nb = item % nblk, k0 = 64 * kb, n0 = 32 * nb;
#pragma unroll
    for (int i = 0; i < 32; ++i) { const int kk = 2 * i + (lane >> 5); scr[kk * 33 + (lane & 31)] = W[(size_t)(k0 + kk) * ldw + n0 + (lane & 31)]; }
    asm volatile("s_waitcnt lgkmcnt(0)" ::: "memory");
    const int c = lane & 7;
#pragma unroll
    for (int j = 0; j < 4; ++j) { const int n = (lane >> 3) + 8 * j; const LAS float* s = scr + (8 * c) * 33 + n;
        uint4 o; o.x = pk2(s[0 * 33], s[1 * 33]); o.y = pk2(s[2 * 33], s[3 * 33]); o.z = pk2(s[4 * 33], s[5 * 33]); o.w = pk2(s[6 * 33], s[7 * 33]);
        *(uint4*)(WT + (size_t)(n0 + n) * K + k0 + 8 * c) = o; }
    asm volatile("s_waitcnt lgkmcnt(0)" ::: "memory");
}

__device__ __forceinline__ void p0_fold_item(const Prm& p, int item, int lane) {
    static_assert(NK == 128 && KH == 128 && NQ == 2048, "fold item decomposition");
    const int ks = item & 31, nt = (item >> 5) & 7, g = item >> 8;
    const int r = lane & 15, q = lane >> 4;
    const float* arow = p.subkeys + ((size_t)g * NK + nt * 16 + r) * KH + 4 * q;
    const float* brow = p.wq + (size_t)(ks * 64 + r) * NQ + g * KH + 4 * q;
    pg8::f32x4 acc[4];
#pragma unroll
    for (int c = 0; c < 4; ++c) acc[c] = (pg8::f32x4){0.f, 0.f, 0.f, 0.f};
#pragma unroll 2
    for (int s16 = 0; s16 < KH; s16 += 16) {
        const pg8::f32x4 a = *(const pg8::f32x4*)(arow + s16); pg8::f32x4 bv[4];
#pragma unroll
        for (int c = 0; c < 4; ++c) bv[c] = *(const pg8::f32x4*)(brow + (size_t)(c * 16) * NQ + s16);
#pragma unroll
        for (int i = 0; i < 4; ++i)
#pragma unroll
            for (int c = 0; c < 4; ++c) acc[c] = __builtin_amdgcn_mfma_f32_16x16x4f32(a[i], bv[c][i], acc[c], 0, 0, 0);
    }
#pragma unroll
    for (int c = 0; c < 4; ++c)
#pragma unroll
        for (int i = 0; i < 4; ++i) p.WQ_T()[(size_t)(g * NK + nt * 16 + 4 * q + i) * D + ks * 64 + c * 16 + r] = f2bf(acc[c][i]);
}
__device__ __forceinline__ void phase0(const Prm& p, const Frame& F) {
    for (int cb = F.bid; cb < D6 / 48; cb += F.G) p0_ada_block(p, F, cb);
    LAS float* scr = (LAS float*)(F.lds + F.wave * 16384);
    const int gw = F.bid * NWAVES + F.wave, NGW = F.G * NWAVES;
    constexpr int I_IN = (D / 64) * (INM / 32);
    for (int it = gw; it < I_IN; it += NGW) p0_transpose_item(p.w_in, INC, D, INM, p.WIN_T(), scr, it, F.lane);
}
template <bool PART_A, bool PART_B, bool PART_F>
__device__ __forceinline__ void deferred_prep(const Prm& p, const Frame& F, int b0, int nb) {
    __syncthreads();
    LAS float* scr = (LAS float*)(F.lds + F.wave * 16384);
    const int gw = (F.bid - b0) * NWAVES + F.wave, NGW = nb * NWAVES;
    constexpr int I_O = (D / 64) * (D / 32), I_Q = 32 * 8 * 16;
    if (PART_A) for (int it = gw; it < I_O; it += NGW) p0_transpose_item(p.w_out, D, D, D, p.WOUT_T(), scr, it, F.lane);
    if (PART_F) for (int it = gw; it < I_Q; it += NGW) p0_fold_item(p, it, F.lane);
    if (PART_A) {
        float4 v[8], vn[8]; int rr = gw;
#define P0_ROWSRC(rr_) ((const float4*)(p.peer_u + (size_t)(rr_) * D) + F.lane)
        if (rr < NE) { const float4* src = P0_ROWSRC(rr);
#pragma unroll
            for (int j = 0; j < 8; ++j) { const f4v t_ = __builtin_nontemporal_load((const f4v*)(src + 64 * j)); v[j] = make_float4(t_[0], t_[1], t_[2], t_[3]); } }
        for (; rr < NE; rr += NGW) {
            const int rn = rr + NGW;
            if (rn < NE) { const float4* src = P0_ROWSRC(rn);
#pragma unroll
                for (int j = 0; j < 8; ++j) { const f4v t_ = __builtin_nontemporal_load((const f4v*)(src + 64 * j)); vn[j] = make_float4(t_[0], t_[1], t_[2], t_[3]); } }
            const int e = rr; float am = 0.f;
#pragma unroll
            for (int j = 0; j < 8; ++j) am = fmaxf(am, fmaxf(fmaxf(fabsf(v[j].x), fabsf(v[j].y)), fmaxf(fabsf(v[j].z), fabsf(v[j].w))));
#pragma unroll
            for (int o = 1; o < 64; o <<= 1) am = fmaxf(am, __shfl_xor(am, o));
            const float sc = am > 0.f ? 384.f / am : 1.f;
            unsigned* dst = (unsigned*)(p.PU8() + (size_t)e * D) + F.lane;
#pragma unroll
            for (int j = 0; j < 8; ++j) { unsigned w = 0u; w = __builtin_amdgcn_cvt_pk_fp8_f32(v[j].x * sc, v[j].y * sc, w, false); w = __builtin_amdgcn_cvt_pk_fp8_f32(v[j].z * sc, v[j].w * sc, w, true); dst[64 * j] = w; }
            if (F.lane == 0) p.RSU()[e] = am > 0.f ? am / 384.f : 1.f;
#pragma unroll
            for (int j = 0; j < 8; ++j) v[j] = vn[j];
        }
#undef P0_ROWSRC
    }
    if (PART_B) { LAS unsigned char* tl = F.lds; constexpr int RS_ = 2056;
      for (int tile = F.bid - b0; tile < NE / 16; tile += nb) { const int row = F.tid >> 5, l32 = F.tid & 31, e = tile * 16 + row;
        __syncthreads();
        const f4v* src = (const f4v*)(p.peer_v + (size_t)e * D) + l32; f4v x[16]; float am = 0.f;
#pragma unroll
        for (int j = 0; j < 16; ++j) { x[j] = __builtin_nontemporal_load(src + 32 * j); am = fmaxf(am, fmaxf(fmaxf(fabsf(x[j][0]), fabsf(x[j][1])), fmaxf(fabsf(x[j][2]), fabsf(x[j][3])))); }
#pragma unroll
        for (int o = 1; o < 32; o <<= 1) am = fmaxf(am, __shfl_xor(am, o));
        const float sc = am > 0.f ? 384.f / am : 1.f;
#pragma unroll
        for (int j = 0; j < 16; ++j) { unsigned w = 0u; w = __builtin_amdgcn_cvt_pk_fp8_f32(x[j][0] * sc, x[j][1] * sc, w, false); w = __builtin_amdgcn_cvt_pk_fp8_f32(x[j][2] * sc, x[j][3] * sc, w, true);
            *(LAS unsigned*)(tl + row * RS_ + 4 * (l32 + 32 * j)) = w; }
        if (l32 == 0) p.RSV()[e] = am > 0.f ? am / 384.f : 1.f;
        __syncthreads();
#pragma unroll
        for (int k = 0; k < 8; ++k) { const int idx = F.tid + NTHR * k, r = idx & 15, sl = idx >> 4;
            *(u2v*)(p.PV8S() + ((size_t)sl * NE + tile * 16 + r) * 8) = *(const LAS u2v*)(tl + r * RS_ + 8 * sl); }
      } }
}
__device__ __forceinline__ void phase1(const Prm& p, const Frame& F) {
    static_assert(NG == 16 && D % 32 == 0, "gate tile = one 16-column MFMA tile");
    LAS float* SH = (LAS float*)F.lds; LAS float* SC1 = SH + D;
    constexpr unsigned WGS = 2 * D + 16, WG_OFF = 2 * D * 4, US_OFF = ((WG_OFF + NG * WGS + 255u) / 256u) * 256u;
    constexpr unsigned US_HI = 132096u;
    static_assert(US_OFF + 5 * 2 * D * 2 <= (unsigned)LDSCTL_OFF && US_HI + 3 * 2 * D * 2 <= (unsigned)LDS_BYTES && US_HI >= (unsigned)MISC_OFF + 128u, "P1 LDS map");
    LAS unsigned char* WGb = F.lds + WG_OFF; LAS unsigned char* USb = F.wave < 5 ? F.lds + US_OFF + F.wave * (2 * D * 2) : F.lds + US_HI + (F.wave - 5) * (2 * D * 2);
    const int rows_per = T / F.G;
    { const int st = (F.bid * 37) % (NG * D / NTHR);
      for (int k = 0; k < NG * D / NTHR; ++k) { const int idx = F.tid + NTHR * ((k + st) % (NG * D / NTHR)); const int d = idx / NG, g = idx % NG; *(LAS bf16_t*)(WGb + g * WGS + 2 * d) = f2bf(p.w_in[(size_t)d * INC + INM + g]); } }
    int cur_b = -1;
    float4 xpre[8];
    { const float4* x0 = (const float4*)(p.x + (size_t)(F.bid * rows_per + F.wave) * D) + F.lane;
#pragma unroll
      for (int j = 0; j < 8; ++j) xpre[j] = x0[64 * j]; }
    int it = 0;
    for (int r0 = F.bid * rows_per; r0 < (F.bid + 1) * rows_per; r0 += NWAVES, ++it) {
        const int b = r0 / S;
        if (b != cur_b) { __syncthreads();
            for (int n = F.tid; n < 2 * D; n += NTHR) { const float s = p.MOD()[(size_t)b * D6 + n]; SH[n] = n < D ? s : 1.f + s; }
            cur_b = b; __syncthreads(); }
        const int row = r0 + F.wave;
        float4 v[8]; float s = 0.f;
#pragma unroll
        for (int j = 0; j < 8; ++j) v[j] = xpre[j];
        if (r0 + NWAVES < (F.bid + 1) * rows_per) { const float4* xn = (const float4*)(p.x + (size_t)(row + NWAVES) * D) + F.lane;
#pragma unroll
            for (int j = 0; j < 8; ++j) xpre[j] = xn[64 * j]; }
#pragma unroll
        for (int j = 0; j < 8; ++j) s += (v[j].x + v[j].y) + (v[j].z + v[j].w);
        const float mean = wave_sum(s) * (1.f / D); float s2 = 0.f;
#pragma unroll
        for (int j = 0; j < 8; ++j) { v[j].x -= mean; v[j].y -= mean; v[j].z -= mean; v[j].w -= mean; s2 += (v[j].x * v[j].x + v[j].y * v[j].y) + (v[j].z * v[j].z + v[j].w * v[j].w); }
        const float rstd = 1.f / sqrtf(wave_sum(s2) * (1.f / D) + LN_EPS);
        uint2* o8 = (uint2*)(p.U() + (size_t)row * D) + F.lane; LAS u2v* us = (LAS u2v*)(USb + (it & 1) * (2 * D)) + F.lane;
#pragma unroll
        for (int j = 0; j < 8; ++j) { const int c0 = 4 * F.lane + 256 * j; const f4v sh = *(const LAS f4v*)(SH + c0), sc = *(const LAS f4v*)(SC1 + c0);
            const unsigned w0 = pk2(v[j].x * rstd * sc.x + sh.x, v[j].y * rstd * sc.y + sh.y), w1 = pk2(v[j].z * rstd * sc.z + sh.z, v[j].w * rstd * sc.w + sh.w);
            o8[64 * j] = make_uint2(w0, w1); us[64 * j] = (u2v){w0, w1}; }
        if (it & 1) {
            const unsigned lane = F.lane, r = lane & 15u, q = lane >> 4; pg8::f32x4 acc = {0.f, 0.f, 0.f, 0.f};
            const LAS unsigned char* ap = USb + (r & 1u) * (2 * D) + 16u * q; const LAS unsigned char* bp = WGb + r * WGS + 16u * q;
#pragma unroll 8
            for (int ks = 0; ks < D / 32; ++ks) acc = __builtin_amdgcn_mfma_f32_16x16x32_bf16(*(const LAS pg8::bf16x8*)(ap + 64 * ks), *(const LAS pg8::bf16x8*)(bp + 64 * ks), acc, 0, 0, 0);
            if (lane < NG) { const float bi = p.b_in[INM + lane]; const float g0 = acc[0] + bi, g1 = acc[1] + bi; const bool fg = lane & 4;
                p.GATES()[(size_t)(row - NWAVES) * NG + lane] = fg ? logsigmoidf_(g0) : g0; p.GATES()[(size_t)row * NG + lane] = fg ? logsigmoidf_(g1) : g1; } }
    }
}
__device__ __forceinline__ void phase3a(const Prm& p, const Frame& F, int b0, int nb) {
    const size_t gt = (size_t)(F.bid - b0) * NTHR + F.tid, GT = (size_t)nb * NTHR;
    for (size_t i = gt; i < (size_t)T * (CW / 8); i += GT) {
        const size_t row = i / (CW / 8); const int ch = (int)(i % (CW / 8)) * 8, s = (int)(row % S);
        float acc[8];
#pragma unroll
        for (int e = 0; e < 8; ++e) acc[e] = p.conv_b[ch + e];
#pragma unroll
        for (int k = 0; k < 3; ++k) { const int s2 = s + k - 1; if (s2 < 0 || s2 >= S) continue; const bf16_t* pr = p.PJ() + (size_t)(row + k - 1) * INM;
            const uint4 gc = *(const uint4*)(pr + O_GC + ch), hi = *(const uint4*)(pr + O_HIN + ch); const float* cw = p.conv_w + k * CW + ch;
            acc[0] += cw[0] * (bflo(gc.x) * bflo(hi.x)); acc[1] += cw[1] * (bfhi(gc.x) * bfhi(hi.x)); acc[2] += cw[2] * (bflo(gc.y) * bflo(hi.y)); acc[3] += cw[3] * (bfhi(gc.y) * bfhi(hi.y));
            acc[4] += cw[4] * (bflo(gc.z) * bflo(hi.z)); acc[5] += cw[5] * (bfhi(gc.z) * bfhi(hi.z)); acc[6] += cw[6] * (bflo(gc.w) * bflo(hi.w)); acc[7] += cw[7] * (bfhi(gc.w) * bfhi(hi.w)); }
        const uint4 gb = *(const uint4*)(p.PJ() + row * INM + O_GB + ch); uint4 o;
        o.x = pk2(bflo(gb.x) * acc[0], bfhi(gb.x) * acc[1]); o.y = pk2(bflo(gb.y) * acc[2], bfhi(gb.y) * acc[3]); o.z = pk2(bflo(gb.z) * acc[4], bfhi(gb.z) * acc[5]); o.w = pk2(bflo(gb.w) * acc[6], bfhi(gb.w) * acc[7]);
        *(uint4*)(p.Y() + row * D + ch) = o; }
}
namespace ml {
typedef short bf16x8 __attribute__((ext_vector_type(8)));
typedef short s16x4 __attribute__((ext_vector_type(4)));
typedef float f32x4 __attribute__((ext_vector_type(4)));
typedef float f32x2_t __attribute__((ext_vector_type(2)));
typedef __bf16 bf16x2_t __attribute__((ext_vector_type(2)));
typedef unsigned u32x4 __attribute__((ext_vector_type(4)));
typedef unsigned u32x2 __attribute__((ext_vector_type(2)));
constexpr unsigned IMG = 16384u, BUF = 3u * IMG, PT_OFF = 2u * BUF, PT_BYTES = 8192u, N_OFF = PT_OFF + 2u * PT_BYTES;
constexpr unsigned SCT_OFF = 149504u, SCT_BYTES = 1280u;
constexpr unsigned HT_OFF = 133120u;
static_assert(N_OFF + 1024u <= 131072u && HT_OFF + 16384u <= SCT_OFF && SCT_OFF + 3u * SCT_BYTES <= 163840u, "mLSTM LDS map");
__device__ __forceinline__ unsigned cvtpk(float lo, float hi) { f32x2_t v = {lo, hi}; bf16x2_t b = __builtin_convertvector(v, bf16x2_t); return __builtin_bit_cast(unsigned, b); }
__device__ __forceinline__ unsigned off_a(unsigned row, unsigned ch) { return 2048u * (row >> 3) + 512u * (ch >> 2) + 64u * (row & 7u) + 16u * ((ch & 3u) ^ ((row >> 2) & 3u)); }
__device__ __forceinline__ unsigned off_p(unsigned row, unsigned ch) { return 128u * row + 16u * (ch ^ (row & 7u)); }
typedef short v4i16_t __attribute__((ext_vector_type(4)));
__device__ __forceinline__ s16x4 trr(LAS unsigned char* p) { return __builtin_bit_cast(s16x4, __builtin_amdgcn_ds_read_tr16_b64_v4i16((LAS v4i16_t*)p)); }
__device__ __forceinline__ bf16x8 cat8(s16x4 a, s16x4 b) { return (bf16x8){a[0], a[1], a[2], a[3], b[0], b[1], b[2], b[3]}; }
struct CS { float decay, m_next; };
__device__ __forceinline__ CS chunk_scalars(float ig, float fg, float m, LAS float* tab, bool writer, unsigned lane) {
    const float lf = fg;
    const float bc = wave_scan_add(lf), gg = ig - bc, cm = wave_scan_max(gg);
    const float G = fmaxf(m, cm), G63 = lane_bcast(G, 63), b63 = lane_bcast(bc, 63), qs = 0.08838834764831845f;
    if (writer) { tab[lane] = __expf(fminf(G63 - G, 80.f)) * qs; tab[64 + lane] = __expf(m - G) * qs; tab[128 + lane] = __expf(-(bc + G)); tab[192 + lane] = __expf(gg - G63); }
    CS r; r.decay = __expf(m - G63); r.m_next = b63 + G63; if (writer && lane == 0u) tab[256] = r.decay;
    return r;
}
__device__ __forceinline__ void unit(const Prm& p, const Frame& F, int u) {
    static_assert(QK == 128 && MV == 256 && CHUNK == 64 && S % 64 == 0, "mLSTM unit is specialised");
    const int vhalf = u & 1, h = (u >> 1) & 3, b = (u >> 3) & 7, dir = u >> 6;
    const unsigned lane = F.lane, tid = F.tid; const int wave = F.wave; const unsigned q = lane >> 4, r = lane & 15u;
    LAS unsigned char* L = F.lds;
    const unsigned rx = (r >> 2) & 3u, rlo = 2048u * (r >> 3) + 64u * (r & 7u);
    const unsigned RA = rlo + 16u * (q ^ rx), PB1 = rlo + 16u * ((q >> 1) ^ rx) + 8u * (q & 1u), PB2 = rlo + 16u * ((2u + (q >> 1)) ^ rx) + 8u * (q & 1u);
    const unsigned pp = lane & 3u, tlo = 2048u * q + 64u * rx + 8u * (pp & 1u);
    const unsigned tb00 = tlo + 16u * ((pp >> 1) ^ ((2u * q) & 3u)), tb01 = tlo + 256u + 16u * ((pp >> 1) ^ ((2u * q + 1u) & 3u));
    const unsigned tb10 = tlo + 16u * ((2u + (pp >> 1)) ^ ((2u * q) & 3u)), tb11 = tlo + 256u + 16u * ((2u + (pp >> 1)) ^ ((2u * q + 1u) & 3u));
    const unsigned PP0 = 128u * r + 16u * (q ^ (r & 7u)), PP1 = 128u * r + 16u * ((4u + q) ^ (r & 7u));
#define ML_TRA(c, ks, t) ((((c) & 1) ? ((t) ? tb11 : tb10) : ((t) ? tb01 : tb00)) + 8192u * (ks) + 512u * ((unsigned)(c) >> 1))
    __syncthreads();
    for (unsigned i = tid; i < (2u * PT_BYTES + 1024u) / 16u; i += NTHR) *(LAS u32x4*)(L + PT_OFF + 16u * i) = (u32x4){0u, 0u, 0u, 0u};
    f32x4 C[8];
#pragma unroll
    for (int i = 0; i < 8; ++i) C[i] = (f32x4){0.f, 0.f, 0.f, 0.f};
    float m = 0.f;
    const bf16_t* pj = p.PJ(); bf16_t* H = dir ? p.HB16() : p.HF16();
    const int colq = O_Q + h * QK, colk = O_K + h * QK, colv = O_V + h * MV + vhalf * 128;
    const unsigned srow0 = tid >> 4, sch = tid & 15u;
    u32x4 rq[2], rk[2], rv[2];
    const float* gbase = p.GATES() + dir * 8 + h;
#define ML_GATES(c, ig_, fg_) do { const float* g_ = gbase + (size_t)ml_tok(dir, b, (c) * 64 + (int)lane) * NG; ig_ = g_[0]; fg_ = g_[4]; } while (0)
    float ig0, fg0, ign = 0.f, fgn = 0.f; ML_GATES(0, ig0, fg0); if (S / 64 > 1) ML_GATES(1, ign, fgn);
#define ML_TAB(c) ((LAS float*)(L + SCT_OFF + (unsigned)((c) % 3) * SCT_BYTES))
    CS cs = {0.f, 0.f}, csn = {0.f, 0.f}; if (wave == 0) { cs = chunk_scalars(ig0, fg0, m, ML_TAB(0), true, lane); csn = cs; }
    const long sMW = dir ? -(long)MW : (long)MW;
#define ML_LOAD(c) do { _Pragma("unroll") for (int i_ = 0; i_ < 2; ++i_) { const bf16_t* rp = pj + (size_t)ml_tok(dir, b, (c) * 64 + srow0 + 32 * i_) * INM + 8 * sch; \
        rq[i_] = *(const u32x4*)(rp + colq); rk[i_] = *(const u32x4*)(rp + colk); rv[i_] = *(const u32x4*)(rp + colv); } } while (0)
#define ML_STORE(buf, S_) do { _Pragma("unroll") for (int i_ = 0; i_ < 2; ++i_) { const unsigned row = srow0 + 32u * i_, o = (buf) * BUF + off_a(row, sch); const float w = (S_)[192 + row]; \
        *(LAS u32x4*)(L + o) = rq[i_]; *(LAS u32x4*)(L + IMG + o) = rk[i_]; u32x4 v = rv[i_]; \
        v.x = cvtpk(bflo(v.x) * w, bfhi(v.x) * w); v.y = cvtpk(bflo(v.y) * w, bfhi(v.y) * w); v.z = cvtpk(bflo(v.z) * w, bfhi(v.z) * w); v.w = cvtpk(bflo(v.w) * w, bfhi(v.w) * w); \
        *(LAS u32x4*)(L + 2u * IMG + o) = v; } } while (0)
    __syncthreads();
    ML_LOAD(0); ML_STORE(0u, ML_TAB(0));
    constexpr int NC = S / 64;
    for (int c = 0; c < NC; ++c) {
        const unsigned cur = (unsigned)(c & 1);
        LAS unsigned char* Qi = L + cur * BUF; LAS unsigned char* Ki = Qi + IMG; LAS unsigned char* Vi = Qi + 2u * IMG; LAS unsigned char* Pt = L + PT_OFF + cur * PT_BYTES;
        float ig2 = 0.f, fg2 = 0.f;
        if (c + 1 < NC) { ML_LOAD(c + 1); if (wave == 0) { csn = chunk_scalars(ign, fgn, cs.m_next, ML_TAB(c + 1), true, lane); if (c + 2 < NC) ML_GATES(c + 2, ig2, fg2); } }
        __syncthreads();
#define ML_FLUSH(cprev) do { _Pragma("unroll") for (int i_ = 0; i_ < 2; ++i_) { const unsigned n_ = tid + 512u * i_, row_ = n_ >> 4, ch_ = n_ & 15u;     \
            const u32x4 v_ = *(const LAS u32x4*)(L + HT_OFF + 256u * row_ + 16u * (ch_ ^ (row_ & 15u))); \
            *(u32x4*)(H + (size_t)ml_tok(dir, b, (cprev) * 64 + (int)row_) * MW + h * MV + vhalf * 128 + 8 * (int)ch_) = v_; } } while (0)
        const LAS float* sct = ML_TAB(c); const float dcy = sct[256];
        if (c > 0) ML_FLUSH(c - 1);
#ifndef ML_REP_3B
#define ML_REP_3B 1
#define ML_REP_S 1
#define ML_REP_ST 1
#define ML_REP_3A 1
#define ML_REP_DEN 1
#endif
        f32x4 acc2[4];
#pragma unroll
        for (int tt = 0; tt < 4; ++tt) acc2[tt] = (f32x4){0.f, 0.f, 0.f, 0.f};
#pragma unroll
        for (int ks = 0; ks < 4; ++ks) {
            bf16x8 qa[4];
#pragma unroll
            for (int tt = 0; tt < 4; ++tt) {
                const u32x2 lo = *(const LAS u32x2*)(Qi + PB1 + 4096u * tt + 512u * ks), hi = *(const LAS u32x2*)(Qi + PB2 + 4096u * tt + 512u * ks);
                const u32x4 aw = {lo.x, lo.y, hi.x, hi.y}; qa[tt] = __builtin_bit_cast(bf16x8, aw); }
            const f32x4 c0 = C[2 * ks], c1 = C[2 * ks + 1];
            const u32x4 bw = {cvtpk(c0[0], c0[1]), cvtpk(c0[2], c0[3]), cvtpk(c1[0], c1[1]), cvtpk(c1[2], c1[3])}; const bf16x8 bfr = __builtin_bit_cast(bf16x8, bw);
#pragma unroll
            for (int tt = 0; tt < 4; ++tt) acc2[tt] = __builtin_amdgcn_mfma_f32_16x16x32_bf16(qa[tt], bfr, acc2[tt], 0, 0, 0);
        }
        bf16x8 vB[2];
#pragma unroll
        for (int ks = 0; ks < 2; ++ks) vB[ks] = cat8(trr(Vi + ML_TRA(wave, ks, 0)), trr(Vi + ML_TRA(wave, ks, 1)));
#pragma unroll
        for (int dt = 0; dt < 8; ++dt) C[dt] = C[dt] * dcy;
#pragma unroll
        for (int ks = 0; ks < 2; ++ks)
#pragma unroll
            for (int dh = 0; dh < 2; ++dh) { bf16x8 kA[4];
#pragma unroll
                for (int d4 = 0; d4 < 4; ++d4) kA[d4] = cat8(trr(Ki + ML_TRA(4 * dh + d4, ks, 0)), trr(Ki + ML_TRA(4 * dh + d4, ks, 1)));
#pragma unroll
                for (int d4 = 0; d4 < 4; ++d4) C[4 * dh + d4] = __builtin_amdgcn_mfma_f32_16x16x32_bf16(kA[d4], vB[ks], C[4 * dh + d4], 0, 0, 0); }
#pragma unroll
        for (int rep = 0; rep < 2; ++rep) { const int idx = wave + (rep ? 2 : 0);
            if (rep == 0 || wave >= 6) { const int tt = idx >= 6 ? 3 : (idx >= 3 ? 2 : (idx >= 1 ? 1 : 0)), st = idx - tt * (tt + 1) / 2;
                f32x4 sa = (f32x4){0.f, 0.f, 0.f, 0.f};
#pragma unroll
                for (int kh = 0; kh < 2; ++kh) { bf16x8 af[2], bfk[2];
#pragma unroll
                    for (int k2 = 0; k2 < 2; ++k2) { af[k2] = *(const LAS bf16x8*)(Qi + RA + 4096u * tt + 512u * (2 * kh + k2)); bfk[k2] = *(const LAS bf16x8*)(Ki + RA + 4096u * st + 512u * (2 * kh + k2)); }
#pragma unroll
                    for (int k2 = 0; k2 < 2; ++k2) sa = __builtin_amdgcn_mfma_f32_16x16x32_bf16(af[k2], bfk[k2], sa, 0, 0, 0); }
                const unsigned scol = 16u * st + r;
#pragma unroll
                for (int i = 0; i < 4; ++i) { const unsigned trow = 16u * tt + 4u * q + i; const float v = scol <= trow ? sa[i] : 0.f;
                    *(LAS bf16_t*)(Pt + off_p(trow, scol >> 3) + 2u * (scol & 7u)) = (bf16_t)cvtpk(v, 0.f); } } }
        if (c + 1 < NC) ML_STORE(cur ^ 1u, ML_TAB(c + 1));
        __syncthreads();
        { bf16x8 pf[6];
#pragma unroll
          for (int tt = 0; tt < 4; ++tt) { pf[tt] = *(const LAS bf16x8*)(Pt + PP0 + 2048u * tt); if (tt >= 2) pf[2 + tt] = *(const LAS bf16x8*)(Pt + PP1 + 2048u * tt); }
#pragma unroll
          for (int tt = 0; tt < 4; ++tt) { const f32x4 av4 = *(const LAS f32x4*)(sct + 16 * tt + 4 * q), bv4 = *(const LAS f32x4*)(sct + 64 + 16 * tt + 4 * q); f32x4 a1 = __builtin_amdgcn_mfma_f32_16x16x32_bf16(pf[tt], vB[0], (f32x4){0.f, 0.f, 0.f, 0.f}, 0, 0, 0);
            if (tt >= 2) a1 = __builtin_amdgcn_mfma_f32_16x16x32_bf16(pf[2 + tt], vB[1], a1, 0, 0, 0);
#pragma unroll
            for (int i = 0; i < 4; ++i) { const unsigned t = 16u * tt + 4u * q + i, col = 16u * (unsigned)wave + r;
                *(LAS bf16_t*)(L + HT_OFF + 256u * t + 16u * ((col >> 3) ^ (t & 15u)) + 2u * (col & 7u)) = (bf16_t)cvtpk(av4[i] * a1[i] + bv4[i] * acc2[tt][i], 0.f); } } }
        if (vhalf == 0) {
            const LAS float* n_old = (const LAS float*)(L + N_OFF + cur * 512u); LAS float* n_new = (LAS float*)(L + N_OFF + (cur ^ 1u) * 512u);
            bf16x8 wB[2];
#pragma unroll
            for (int ks = 0; ks < 2; ++ks) { const f32x4 w0 = *(const LAS f32x4*)(sct + 192 + 32 * ks + 8 * q), w1 = *(const LAS f32x4*)(sct + 192 + 32 * ks + 8 * q + 4);
                u32x4 w = {cvtpk(w0[0], w0[1]), cvtpk(w0[2], w0[3]), cvtpk(w1[0], w1[1]), cvtpk(w1[2], w1[3])};
                if (r != 0u) w = (u32x4){0u, 0u, 0u, 0u}; wB[ks] = __builtin_bit_cast(bf16x8, w); }
            const size_t dbase = ((size_t)dir * T) * MH + h;
            if (wave < 4) { const int tt = wave; f32x4 d2 = (f32x4){0.f, 0.f, 0.f, 0.f};
#pragma unroll
                for (int ks = 0; ks < 4; ++ks) { const f32x4 n0 = *(const LAS f32x4*)(n_old + 32 * ks + 4 * q), n1 = *(const LAS f32x4*)(n_old + 32 * ks + 16 + 4 * q);
                    u32x4 bw = {cvtpk(n0[0], n0[1]), cvtpk(n0[2], n0[3]), cvtpk(n1[0], n1[1]), cvtpk(n1[2], n1[3])}; if (r != 0u) bw = (u32x4){0u, 0u, 0u, 0u};
                    const u32x2 lo = *(const LAS u32x2*)(Qi + PB1 + 4096u * tt + 512u * ks), hi = *(const LAS u32x2*)(Qi + PB2 + 4096u * tt + 512u * ks);
                    const u32x4 aw = {lo.x, lo.y, hi.x, hi.y};
                    d2 = __builtin_amdgcn_mfma_f32_16x16x32_bf16(__builtin_bit_cast(bf16x8, aw), __builtin_bit_cast(bf16x8, bw), d2, 0, 0, 0); }
#pragma unroll
                for (int i = 0; i < 4; ++i) { const int t = 16 * tt + 4 * (int)q + i; const float bv = sct[64 + t], fl = sct[128 + t];
                    if (r == 0u) { const size_t di = dbase + (size_t)ml_tok(dir, b, c * 64 + t) * MH; p.DEN()[(size_t)2 * T * MH + di] = bv * d2[i]; p.FLR()[di] = fl; } }
            } else { const int tt = wave - 4; f32x4 d1 = (f32x4){0.f, 0.f, 0.f, 0.f};
#pragma unroll
                for (int ks = 0; ks < 2; ++ks) if (ks == 0 || tt >= 2) { const bf16x8 pf = *(const LAS bf16x8*)(Pt + (ks ? PP1 : PP0) + 2048u * tt);
                    d1 = __builtin_amdgcn_mfma_f32_16x16x32_bf16(pf, wB[ks], d1, 0, 0, 0); }
#pragma unroll
                for (int i = 0; i < 4; ++i) { const int t = 16 * tt + 4 * (int)q + i; const float av = sct[t];
                    if (r == 0u) p.DEN()[dbase + (size_t)ml_tok(dir, b, c * 64 + t) * MH] = av * d1[i]; } }
            { const int dt = wave; f32x4 nn = *(const LAS f32x4*)(n_old + 16 * dt + 4 * q) * dcy; if (r != 0u) nn = (f32x4){0.f, 0.f, 0.f, 0.f};
#pragma unroll
                for (int ks = 0; ks < 2; ++ks) { const bf16x8 kA = cat8(trr(Ki + ML_TRA(dt, ks, 0)), trr(Ki + ML_TRA(dt, ks, 1)));
                    nn = __builtin_amdgcn_mfma_f32_16x16x32_bf16(kA, wB[ks], nn, 0, 0, 0); }
                if (r == 0u) *(LAS f32x4*)(n_new + 16 * dt + 4 * q) = nn; }
        }
        m = cs.m_next; cs = csn; ign = ig2; fgn = fg2;
    }
    __syncthreads(); ML_FLUSH(NC - 1);
#undef ML_FLUSH
#undef ML_TRA
#undef ML_TABLE
#undef ML_LOAD
#undef ML_GATES
#undef ML_STORE
}
}
__device__ __forceinline__ void phase4(const Prm& p, const Frame& F) {
    static_assert(MV == 256 && MH == 4, "head j = float4 slot j of the lane");
    const int gw = F.bid * NWAVES + F.wave, NGW = F.G * NWAVES;
    for (int row = gw; row < T; row += NGW) {
        const uint2* hf = (const uint2*)(p.HF16() + (size_t)row * MW) + F.lane; const uint2* hb = (const uint2*)(p.HB16() + (size_t)row * MW) + F.lane;
        const uint2* og = (const uint2*)(p.PJ() + (size_t)row * INM + O_O) + F.lane; uint2* yo = (uint2*)(p.Y() + (size_t)row * D + CW) + F.lane;
#pragma unroll
        for (int j = 0; j < MH; ++j) {
            const float* d2 = p.DEN() + (size_t)2 * T * MH;
            const float i_f = 1.f / fmaxf(fabsf(p.DEN()[(size_t)row * MH + j] + d2[(size_t)row * MH + j]), p.FLR()[(size_t)row * MH + j]);
            const float i_b = 1.f / fmaxf(fabsf(p.DEN()[((size_t)T + row) * MH + j] + d2[((size_t)T + row) * MH + j]), p.FLR()[((size_t)T + row) * MH + j]);
            const uint2 a = hf[64 * j], b = hb[64 * j]; float4 h = make_float4(bflo(a.x) * i_f + bflo(b.x) * i_b, bfhi(a.x) * i_f + bfhi(b.x) * i_b, bflo(a.y) * i_f + bflo(b.y) * i_b, bfhi(a.y) * i_f + bfhi(b.y) * i_b);
            const float mean = wave_sum((h.x + h.y) + (h.z + h.w)) * (1.f / MV);
            h.x -= mean; h.y -= mean; h.z -= mean; h.w -= mean;
            const float rstd = 1.f / sqrtf(wave_sum((h.x * h.x + h.y * h.y) + (h.z * h.z + h.w * h.w)) * (1.f / MV) + LN_EPS);
            const float4 nw = *((const float4*)(p.mnorm_w + j * MV) + F.lane); const uint2 o = og[64 * j];
            yo[64 * j] = make_uint2(pk2(h.x * rstd * nw.x * sigmoidf_(bflo(o.x)), h.y * rstd * nw.y * sigmoidf_(bfhi(o.x))), pk2(h.z * rstd * nw.z * sigmoidf_(bflo(o.y)), h.w * rstd * nw.w * sigmoidf_(bfhi(o.y)))); }
    }
}
struct EpiZ {
    static constexpr bool PERM = false, AFTER_DRAIN = false;
    const float* x; const float* mod; bf16_t* out;
    __device__ __forceinline__ void operator()(const pg8::f32x4 (&acc)[2][2][4][2], const pg8::Unit& u, int wr, int wc, int fr, int fq) const {
        const int col0 = u.pn * 256 + wc * 32 + 4 * fq;
#pragma unroll
        for (int ai = 0; ai < 2; ++ai)
#pragma unroll
            for (int m = 0; m < 4; ++m) { const int row = u.pm * 256 + ai * 128 + wr * 64 + m * 16 + fr; const float* g1 = mod + (size_t)(row / S) * D6 + 2 * D; const size_t off = (size_t)row * D + col0;
#pragma unroll
                for (int bj = 0; bj < 2; ++bj)
#pragma unroll
                    for (int n = 0; n < 2; ++n) { const int c = bj * 128 + n * 16; const pg8::f32x4 xv = *(const pg8::f32x4*)(x + off + c), gv = *(const pg8::f32x4*)(g1 + col0 + c);
                        const pg8::f32x4 z = xv * ALPHA + gv * acc[ai][bj][m][n]; *(uint2*)(out + off + c) = make_uint2(pk2(z[0], z[1]), pk2(z[2], z[3])); } }
    }
};

struct EpiF32 {
    static constexpr bool PERM = false, AFTER_DRAIN = false;
    float* out; int ldc;
    __device__ __forceinline__ void operator()(const pg8::f32x4 (&acc)[2][2][4][2], const pg8::Unit& u, int wr, int wc, int fr, int fq) const {
        const int col0 = u.pn * 256 + wc * 32 + 4 * fq;
#pragma unroll
        for (int ai = 0; ai < 2; ++ai)
#pragma unroll
            for (int m = 0; m < 4; ++m) { float* rowp = out + (size_t)(u.pm * 256 + ai * 128 + wr * 64 + m * 16 + fr) * ldc + col0;
#pragma unroll
                for (int bj = 0; bj < 2; ++bj)
#pragma unroll
                    for (int n = 0; n < 2; ++n) *(pg8::f32x4*)(rowp + bj * 128 + n * 16) = acc[ai][bj][m][n]; }
    }
};
__device__ __forceinline__ unsigned skey(float f) { const unsigned u = f_as_u(f); return (u & 0x80000000u) ? ~u : (u | 0x80000000u); }
__device__ __forceinline__ float unskey(unsigned k) { return u_as_f((k & 0x80000000u) ? (k & 0x7fffffffu) : ~k); }
__device__ __forceinline__ void tk_cx(unsigned& a, unsigned& b) { const unsigned hi = a > b ? a : b, lo = a > b ? b : a; a = hi; b = lo; }
__device__ __forceinline__ void tk_sort16(unsigned (&v)[16]) {
#pragma unroll
    for (int k = 2; k <= 16; k <<= 1)
#pragma unroll
        for (int j = k >> 1; j >= 1; j >>= 1)
#pragma unroll
            for (int i = 0; i < 16; ++i) { const int l = i ^ j; if (l > i) { if ((i & k) == 0) tk_cx(v[i], v[l]); else tk_cx(v[l], v[i]); } }
}
__device__ __forceinline__ void tk_merge16(unsigned (&L)[16], const unsigned (&C)[16]) {
#pragma unroll
    for (int i = 0; i < 16; ++i) L[i] = L[i] > C[15 - i] ? L[i] : C[15 - i];
#pragma unroll
    for (int j = 8; j >= 1; j >>= 1)
#pragma unroll
        for (int i = 0; i < 16; ++i) { const int l = i ^ j; if (l > i) tk_cx(L[i], L[l]); }
}
__device__ __forceinline__ void tk_top16(const float* sc, unsigned (&L)[16]) {
#pragma unroll 1
    for (int ch = 0; ch < NK / 16; ++ch) { unsigned C[16];
#pragma unroll
        for (int q4 = 0; q4 < 4; ++q4) { const float4 v = ((const float4*)sc)[4 * ch + q4]; const unsigned b = 127u - 16u * ch - 4u * q4;
            C[4 * q4] = (skey(v.x) & ~0x7fu) | b; C[4 * q4 + 1] = (skey(v.y) & ~0x7fu) | (b - 1); C[4 * q4 + 2] = (skey(v.z) & ~0x7fu) | (b - 2); C[4 * q4 + 3] = (skey(v.w) & ~0x7fu) | (b - 3); }
        tk_sort16(C);
        if (ch == 0) {
#pragma unroll
            for (int i = 0; i < 16; ++i) L[i] = C[i]; }
        else tk_merge16(L, C); }
}
__device__ __forceinline__ void phase8(const Prm& p, const Frame& F) {
    static_assert(NK == 128 && TOPK == 16, "top-k phase is specialised");
    const long gt = (long)F.bid * NTHR + F.tid, GT = (long)F.G * NTHR;
    LAS unsigned* ix = (LAS unsigned*)F.lds + F.tid;
    for (long i = gt; i < (long)T * PH; i += GT) {
        unsigned A[16], B[16];
        tk_top16(p.SC() + (size_t)i * 2 * NK, A); tk_top16(p.SC() + (size_t)i * 2 * NK + NK, B);
        float sa[16], sb[16];
#pragma unroll
        for (int k = 0; k < 16; ++k) { sa[k] = unskey(A[k] & ~0x7fu); sb[k] = unskey(B[k] & ~0x7fu); ix[NTHR * k] = 127u - (A[k] & 0x7fu); ix[NTHR * (16 + k)] = 127u - (B[k] & 0x7fu); }
        unsigned L[16], C[16]; int n = 0;
#pragma unroll
        for (int a = 0; a < 16; ++a)
#pragma unroll
            for (int b = 0; b < 16; ++b) if ((a + 1) * (b + 1) <= 16) { const unsigned key = (skey(sa[a] + sb[b]) & ~0xffu) | (unsigned)(255 - (16 * a + b));
                C[n & 15] = key; ++n;
                if ((n & 15) == 0 || n == 50) { if (n == 50) {
#pragma unroll
                        for (int z = 2; z < 16; ++z) C[z] = 0u; }
                    tk_sort16(C);
                    if (n == 16) {
#pragma unroll
                        for (int z = 0; z < 16; ++z) L[z] = C[z]; }
                    else tk_merge16(L, C); } }
        float V[16]; float sum = 0.f; const float vmax = unskey(L[0] & ~0xffu);
#pragma unroll
        for (int r = 0; r < 16; ++r) { V[r] = __expf(unskey(L[r] & ~0xffu) - vmax); sum += V[r]; }
        const float inv = 1.f / sum; int E[16];
#pragma unroll
        for (int r = 0; r < 16; ++r) { const unsigned fl = 255u - (L[r] & 0xffu); E[r] = (int)(ix[NTHR * (fl >> 4)] * NK + ix[NTHR * (16 + (fl & 15u))]); }
#pragma unroll
        for (int r = 0; r < 16; r += 4) { *(int4*)(p.EIDX() + (size_t)i * TOPK + r) = make_int4(E[r], E[r + 1], E[r + 2], E[r + 3]);
            *(float4*)(p.EW() + (size_t)i * TOPK + r) = make_float4(V[r] * inv, V[r + 1] * inv, V[r + 2] * inv, V[r + 3] * inv); }
    }
}
__device__ __forceinline__ void phase6(const Prm& p, const Frame& F) {
    LAS float* PW = (LAS float*)F.lds; LAS float* PB = PW + D; LAS float* PSH = PW + 2 * D; LAS float* PSC = PW + 3 * D;
    const int rows_per = T / F.G, r_begin = F.bid * rows_per, r_end = r_begin + rows_per;
    int cur_b = -1;
    for (int i = F.tid; i < D; i += NTHR) { PW[i] = p.ln1_w[i]; PB[i] = p.ln1_b[i]; }
    float4 v[8]; uint2 zb[8], zn[8];
    { const uint2* z0 = (const uint2*)((const bf16_t*)p.out + (size_t)(r_begin + F.wave) * D) + F.lane;
#pragma unroll
      for (int j = 0; j < 8; ++j) zb[j] = z0[64 * j]; }
    for (int r0 = r_begin; r0 < r_end; r0 += NWAVES) {
        const int row = r0 + F.wave, b = r0 / S;
        if (b != cur_b) { __syncthreads(); const float* mod = p.MOD() + (size_t)b * D6;
            for (int i = F.tid; i < D; i += NTHR) { PSH[i] = mod[3 * D + i]; PSC[i] = 1.f + mod[4 * D + i]; }
            cur_b = b; __syncthreads(); }
        uint2* x1r = (uint2*)(p.X1B() + (size_t)row * D) + F.lane;
        float s = 0.f;
        if (r0 + NWAVES < r_end) { const uint2* zp = (const uint2*)((const bf16_t*)p.out + (size_t)(row + NWAVES) * D) + F.lane;
#pragma unroll
            for (int j = 0; j < 8; ++j) zn[j] = zp[64 * j]; }
#pragma unroll
        for (int j = 0; j < 8; ++j) { v[j] = make_float4(bflo(zb[j].x), bfhi(zb[j].x), bflo(zb[j].y), bfhi(zb[j].y)); s += (v[j].x + v[j].y) + (v[j].z + v[j].w); }
        float mean = wave_sum(s) * (1.f / D), s2 = 0.f;
#pragma unroll
        for (int j = 0; j < 8; ++j) { v[j].x -= mean; v[j].y -= mean; v[j].z -= mean; v[j].w -= mean; s2 += (v[j].x * v[j].x + v[j].y * v[j].y) + (v[j].z * v[j].z + v[j].w * v[j].w); }
        float rstd = 1.f / sqrtf(wave_sum(s2) * (1.f / D) + LN_EPS); s = 0.f;
#pragma unroll
        for (int j = 0; j < 8; ++j) { const f4v w = *(const LAS f4v*)(PW + 4 * F.lane + 256 * j), bb = *(const LAS f4v*)(PB + 4 * F.lane + 256 * j);
            v[j].x = v[j].x * rstd * w[0] + bb[0]; v[j].y = v[j].y * rstd * w[1] + bb[1]; v[j].z = v[j].z * rstd * w[2] + bb[2]; v[j].w = v[j].w * rstd * w[3] + bb[3];
            x1r[64 * j] = make_uint2(pk2(v[j].x, v[j].y), pk2(v[j].z, v[j].w)); s += (v[j].x + v[j].y) + (v[j].z + v[j].w); }
        mean = wave_sum(s) * (1.f / D); s2 = 0.f;
#pragma unroll
        for (int j = 0; j < 8; ++j) { v[j].x -= mean; v[j].y -= mean; v[j].z -= mean; v[j].w -= mean; s2 += (v[j].x * v[j].x + v[j].y * v[j].y) + (v[j].z * v[j].z + v[j].w * v[j].w); }
        rstd = 1.f / sqrtf(wave_sum(s2) * (1.f / D) + LN_EPS);
        uint2* o8 = (uint2*)(p.U() + (size_t)row * D) + F.lane;
#pragma unroll
        for (int j = 0; j < 8; ++j) { const f4v sh = *(const LAS f4v*)(PSH + 4 * F.lane + 256 * j), sc = *(const LAS f4v*)(PSC + 4 * F.lane + 256 * j);
            o8[64 * j] = make_uint2(pk2(v[j].x * rstd * sc[0] + sh[0], v[j].y * rstd * sc[1] + sh[1]), pk2(v[j].z * rstd * sc[2] + sh[2], v[j].w * rstd * sc[3] + sh[3])); }
#pragma unroll
        for (int j = 0; j < 8; ++j) zb[j] = zn[j];
    }
}
struct XW { int vx, nx, rank, nloc; };
constexpr int NDS = 16, DSW = D / NDS;
typedef float f2v __attribute__((ext_vector_type(2)));
struct Row8 { uint4 r[8]; };
__device__ __forceinline__ void gather8(Row8& g, const unsigned char* tbu, unsigned loff, int ereg, int pg) {
#pragma unroll
    for (int k = 0; k < 8; ++k) { const unsigned e = (unsigned)__shfl(ereg, 8 * k + pg); g.r[k] = *(const uint4*)(tbu + (((size_t)e << 11) | loff)); }
}
#define PEER_CVT8(a) const f2v c0 = __builtin_amdgcn_cvt_pk_f32_fp8((a).x, false), c1 = __builtin_amdgcn_cvt_pk_f32_fp8((a).x, true), c2 = __builtin_amdgcn_cvt_pk_f32_fp8((a).y, false), c3 = __builtin_amdgcn_cvt_pk_f32_fp8((a).y, true), \
    c4 = __builtin_amdgcn_cvt_pk_f32_fp8((a).z, false), c5 = __builtin_amdgcn_cvt_pk_f32_fp8((a).z, true), c6 = __builtin_amdgcn_cvt_pk_f32_fp8((a).w, false), c7 = __builtin_amdgcn_cvt_pk_f32_fp8((a).w, true)
typedef _Float16 h2t __attribute__((ext_vector_type(2)));
__device__ __forceinline__ float peer_dot16h(const uint4 a, const h2t* u) {
    float acc = __builtin_amdgcn_fdot2(__builtin_amdgcn_cvt_scalef32_pk_f16_fp8(a.x, 1.0f, false), u[0], 0.f, false);
    acc = __builtin_amdgcn_fdot2(__builtin_amdgcn_cvt_scalef32_pk_f16_fp8(a.x, 1.0f, true), u[1], acc, false);
    acc = __builtin_amdgcn_fdot2(__builtin_amdgcn_cvt_scalef32_pk_f16_fp8(a.y, 1.0f, false), u[2], acc, false);
    acc = __builtin_amdgcn_fdot2(__builtin_amdgcn_cvt_scalef32_pk_f16_fp8(a.y, 1.0f, true), u[3], acc, false);
    acc = __builtin_amdgcn_fdot2(__builtin_amdgcn_cvt_scalef32_pk_f16_fp8(a.z, 1.0f, false), u[4], acc, false);
    acc = __builtin_amdgcn_fdot2(__builtin_amdgcn_cvt_scalef32_pk_f16_fp8(a.z, 1.0f, true), u[5], acc, false);
    acc = __builtin_amdgcn_fdot2(__builtin_amdgcn_cvt_scalef32_pk_f16_fp8(a.w, 1.0f, false), u[6], acc, false);
    acc = __builtin_amdgcn_fdot2(__builtin_amdgcn_cvt_scalef32_pk_f16_fp8(a.w, 1.0f, true), u[7], acc, false);
    return acc;
}
__device__ __forceinline__ f2v rscatter16(const float* v, bool b0, bool b1, bool b2, int m0, int m1, int m2) {
    float r8[8], r4[4]; f2v r2;
#pragma unroll
    for (int i = 0; i < 8; ++i) { const float keep = b0 ? v[8 + i] : v[i], send = b0 ? v[i] : v[8 + i]; r8[i] = keep + __shfl_xor(send, m0); }
#pragma unroll
    for (int i = 0; i < 4; ++i) { const float keep = b1 ? r8[4 + i] : r8[i], send = b1 ? r8[i] : r8[4 + i]; r4[i] = keep + __shfl_xor(send, m1); }
    { const float k0 = b2 ? r4[2] : r4[0], s0 = b2 ? r4[0] : r4[2], k1 = b2 ? r4[3] : r4[1], s1 = b2 ? r4[1] : r4[3]; r2.x = k0 + __shfl_xor(s0, m2); r2.y = k1 + __shfl_xor(s1, m2); }
    return r2;
}
__device__ __forceinline__ void phase9(const Prm& p, const Frame& F, const XW& xw) {
    static_assert(DSW == 128 && NSLOT == 128 && D == 2048, "slice row = 8 lanes x 16 bytes");
    const int pg = F.lane >> 3, part = F.lane & 7; const bool p0 = part & 1, p1 = part & 2, p2 = part & 4;
    const int tstep = xw.nloc * NWAVES, t0 = xw.rank * NWAVES + F.wave; const int nt = t0 < T ? (T - t0 + tstep - 1) / tstep : 0;
    const unsigned loff = (unsigned)part * 16u; const int k0 = (p0 ? 8 : 0) + (p1 ? 4 : 0) + (p2 ? 2 : 0);
    for (int ds = xw.vx; ds < NDS; ds += xw.nx) {
        if (nt == 0) continue;
        const unsigned char* tbu = p.PU8() + ds * DSW; _Float16* part_out = (_Float16*)p.SC() + (size_t)ds * T * NSLOT + pg + 8 * k0;
#define UP_TOK(i) (t0 + ((i) < nt ? (i) : nt - 1) * tstep)
#define UP_LOADE(i, ea, eb) do { const int* ep_ = p.EIDX() + (size_t)UP_TOK(i) * NSLOT + F.lane; ea = ep_[0]; eb = ep_[64]; } while (0)
#define UP_LOADU(i, ua_, ub_) do { const uint4* up_ = (const uint4*)(p.U() + (size_t)UP_TOK(i) * D + ds * DSW + part * 16); ua_ = up_[0]; ub_ = up_[1]; } while (0)
        int e0a, e0b, e1a, e1b, e2a, e2b; uint4 ua, ub, una, unb;
        UP_LOADE(0, e0a, e0b); UP_LOADE(1, e1a, e1b); UP_LOADE(2, e2a, e2b); UP_LOADU(0, ua, ub);
        Row8 G0, G1, G2, G3;
        gather8(G0, tbu, loff, e0a, pg); gather8(G1, tbu, loff, e0b, pg); gather8(G2, tbu, loff, e1a, pg);
#define UP_BODY(i, GA, GB, GC, GD) do { \
            gather8(GD, tbu, loff, e1b, pg); UP_LOADU((i) + 1, una, unb); int e3a, e3b; UP_LOADE((i) + 3, e3a, e3b); \
            h2t u[8]; u[0] = (h2t){(_Float16)bflo(ua.x), (_Float16)bfhi(ua.x)}; u[1] = (h2t){(_Float16)bflo(ua.y), (_Float16)bfhi(ua.y)}; u[2] = (h2t){(_Float16)bflo(ua.z), (_Float16)bfhi(ua.z)}; u[3] = (h2t){(_Float16)bflo(ua.w), (_Float16)bfhi(ua.w)}; \
            u[4] = (h2t){(_Float16)bflo(ub.x), (_Float16)bfhi(ub.x)}; u[5] = (h2t){(_Float16)bflo(ub.y), (_Float16)bfhi(ub.y)}; u[6] = (h2t){(_Float16)bflo(ub.z), (_Float16)bfhi(ub.z)}; u[7] = (h2t){(_Float16)bflo(ub.w), (_Float16)bfhi(ub.w)}; \
            float dv[16]; \
            _Pragma("unroll") for (int k = 0; k < 8; ++k) dv[k] = peer_dot16h(GA.r[k], u); \
            gather8(GA, tbu, loff, e2a, pg); \
            _Pragma("unroll") for (int k = 0; k < 8; ++k) dv[8 + k] = peer_dot16h(GB.r[k], u); \
            const f2v r2 = rscatter16(dv, p0, p1, p2, 1, 2, 4);                          \
            if ((i) < nt) { _Float16* po = part_out + (size_t)UP_TOK(i) * NSLOT; po[0] = (_Float16)(r2.x * 0.0625f); po[8] = (_Float16)(r2.y * 0.0625f); } \
            e1a = e2a; e1b = e2b; e2a = e3a; e2b = e3b; ua = una; ub = unb; } while (0)
        for (int i = 0; i < nt; i += 2) { UP_BODY(i, G0, G1, G2, G3); UP_BODY(i + 1, G2, G3, G0, G1); }
#undef UP_BODY
#undef UP_LOADU
#undef UP_LOADE
#undef UP_TOK
    }
}
__device__ __forceinline__ void phase10(const Prm& p, const Frame& F) {
    static_assert(NE <= 16384 && NSLOT == 128 && T % 64 == 0, "14-bit expert id, 64-token groups");
    LAS unsigned* tile = (LAS unsigned*)F.lds;
    for (int tg = F.bid; tg < T / 64; tg += F.G) {
        __syncthreads();
#pragma unroll
        for (int k = 0; k < 2; ++k) { const int idx = F.tid + NTHR * k, tl = idx >> 4, so = idx & 15; const size_t i0 = ((size_t)tg * 64 + tl) * NSLOT + 8 * so;
            float sm[8];
#pragma unroll
            for (int j = 0; j < 8; ++j) sm[j] = 0.f;
#pragma unroll
            for (int ds = 0; ds < NDS; ++ds) { const uint4 q4 = *(const uint4*)((const _Float16*)p.SC() + (size_t)ds * T * NSLOT + i0);
                typedef _Float16 h2c __attribute__((ext_vector_type(2)));
                const unsigned qq[4] = {q4.x, q4.y, q4.z, q4.w};
#pragma unroll
                for (int j = 0; j < 4; ++j) { const h2c hv = __builtin_bit_cast(h2c, qq[j]); sm[2 * j] += (float)hv[0]; sm[2 * j + 1] += (float)hv[1]; } }
            const int4 ea = *(const int4*)(p.EIDX() + i0), eb = *(const int4*)(p.EIDX() + i0 + 4); const float4 ga = *(const float4*)(p.EW() + i0), gb = *(const float4*)(p.EW() + i0 + 4);
            const int ee[8] = {ea.x, ea.y, ea.z, ea.w, eb.x, eb.y, eb.z, eb.w}; const float gg[8] = {ga.x, ga.y, ga.z, ga.w, gb.x, gb.y, gb.z, gb.w};
#pragma unroll
            for (int j = 0; j < 8; ++j) { const int e = ee[j]; const _Float16 w = (_Float16)(gg[j] * gelu_exact(sm[j] * 16.f * p.RSU()[e]) * p.RSV()[e] * 256.f);
                tile[tl * 129 + 8 * so + j] = (((unsigned)__builtin_bit_cast(unsigned short, w) << 16) & 0xFFFE0000u) | ((unsigned)e << 3); } }
        __syncthreads();
        uint4* pk = (uint4*)p.EW() + (size_t)tg * 64 * (NSLOT / 4);
#pragma unroll
        for (int k = 0; k < 4; ++k) { const int j = F.tid + NTHR * k, sq = j >> 6, tl = j & 63; const LAS unsigned* tp = tile + tl * 129 + 4 * sq; pk[j] = make_uint4(tp[0], tp[1], tp[2], tp[3]); }
    }
}
__device__ __forceinline__ void phase11(const Prm& p, const Frame& F) {
    static_assert(NE * 8 <= RING_BYTES && D % 8 == 0 && NE <= 65536, "table slice fits the LDS ring");
    typedef _Float16 h2v __attribute__((ext_vector_type(2)));
    const int c0 = (F.G % 8 == 0) ? (F.bid % 8) * (F.G / 8) + F.bid / 8 : F.bid;
    for (int sidx = c0; sidx < D / 8; sidx += F.G) {
        __syncthreads();
        { const uint4* src = (const uint4*)(p.PV8S() + (size_t)sidx * NE * 8);
          for (int i = F.tid; i < NE / 2; i += NTHR) *(LAS u32x4_t*)(F.lds + 16 * i) = __builtin_bit_cast(u32x4_t, src[i]); }
        __syncthreads();
        const int ntg = (T / 64 - F.wave + NWAVES - 1) / NWAVES, nb = 8 * ntg;
        uint4 b0[4], b1[4], b2[4], b3[4];
        const int kx = (F.G % 8 == 0) ? F.bid >> 3 : F.bid, rot = kx & 3, rotb = (kx >> 2) & 7;
#define DN_TG(bi) (F.wave + ((((bi) >> 3) + rot) % ntg) * NWAVES)
#define DN_PTR(bi) ((const uint4*)p.EW() + (size_t)DN_TG(bi) * 64 * (NSLOT / 4) + ((((bi) & 7) + rotb) & 7) * 4 * 64 + F.lane)
#define DN_LOAD(B, bi) do { const int bc_ = (bi) < nb ? (bi) : nb - 1; const uint4* pk_ = DN_PTR(bc_); _Pragma("unroll") for (int k = 0; k < 4; ++k) B[k] = pk_[k * 64]; } while (0)
#define DN_ONE(v_) do { const unsigned vv_ = (v_); const _Float16 w = __builtin_bit_cast(_Float16, (unsigned short)(vv_ >> 16)); const h2v w2 = {w, w}; \
                const u2v t = *(const LAS u2v*)(F.lds + (vv_ & 0x1FFF8u)); const unsigned tx_ = t.x, ty_ = t.y; \
                a0 += __builtin_amdgcn_cvt_scalef32_pk_f16_fp8(tx_, 1.0f, false) * w2; a1 += __builtin_amdgcn_cvt_scalef32_pk_f16_fp8(tx_, 1.0f, true) * w2; \
                a2 += __builtin_amdgcn_cvt_scalef32_pk_f16_fp8(ty_, 1.0f, false) * w2; a3 += __builtin_amdgcn_cvt_scalef32_pk_f16_fp8(ty_, 1.0f, true) * w2; } while (0)
#ifndef DN_REP
#define DN_REP 0
#endif
#define DN_ACC(B) do { _Pragma("unroll") for (int k = 0; k < 4; ++k) { DN_ONE(B[k].x); DN_ONE(B[k].y); DN_ONE(B[k].z); DN_ONE(B[k].w); } asm volatile("" ::: "memory"); \
            if (DN_REP) { const h2v s0_ = a0, s1_ = a1, s2_ = a2, s3_ = a3; for (int rep_ = 0; rep_ < DN_REP; ++rep_) { _Pragma("unroll") for (int k = 0; k < 4; ++k) { DN_ONE(B[k].x); DN_ONE(B[k].y); DN_ONE(B[k].z); DN_ONE(B[k].w); } \
                asm volatile("" :: "v"(a0), "v"(a1), "v"(a2), "v"(a3) : "memory"); } a0 = s0_; a1 = s1_; a2 = s2_; a3 = s3_; } } while (0)
        DN_LOAD(b0, 0); DN_LOAD(b1, 1); DN_LOAD(b2, 2);
        for (int bi = 0; bi < nb; bi += 8) {
            h2v a0 = {0, 0}, a1 = {0, 0}, a2 = {0, 0}, a3 = {0, 0};
            DN_LOAD(b3, bi + 3); DN_ACC(b0);
            DN_LOAD(b0, bi + 4); DN_ACC(b1);
            DN_LOAD(b1, bi + 5); DN_ACC(b2);
            DN_LOAD(b2, bi + 6); DN_ACC(b3);
            DN_LOAD(b3, bi + 7); DN_ACC(b0);
            DN_LOAD(b0, bi + 8); DN_ACC(b1);
            DN_LOAD(b1, bi + 9); DN_ACC(b2);
            DN_LOAD(b2, bi + 10); DN_ACC(b3);
            const int tg = DN_TG(bi); const float us = 1.f / 256.f;
            const uint4 yv = make_uint4(pk2((float)a0[0] * us, (float)a0[1] * us), pk2((float)a1[0] * us, (float)a1[1] * us), pk2((float)a2[0] * us, (float)a2[1] * us), pk2((float)a3[0] * us, (float)a3[1] * us));
            *(uint4*)(p.Y() + ((size_t)tg * 64 + F.lane) * D + 8 * sidx) = yv;
#if defined(DN_STORE_REP)
            for (int rep_ = 0; rep_ < DN_STORE_REP; ++rep_) { asm volatile("" ::: "memory"); __builtin_nontemporal_store(__builtin_bit_cast(u32x4_t, yv), (u32x4_t*)(p.Y() + ((size_t)tg * 64 + F.lane) * D + 8 * sidx)); }
#endif
        }
#undef DN_ACC
#undef DN_ONE
#undef DN_LOAD
#undef DN_PTR
#undef DN_TG
    }
}
__device__ __forceinline__ void phase12(const Prm& p, const Frame& F) {
    LAS float* PW = (LAS float*)F.lds; LAS float* PB = PW + D; LAS float* PG = PW + 2 * D;
    const int rows_per = T / F.G, r_begin = F.bid * rows_per, r_end = r_begin + rows_per;
    int cur_b = -1;
    for (int i = F.tid; i < D; i += NTHR) { PW[i] = p.ln2_w[i]; PB[i] = p.ln2_b[i]; }
    float4 v[8]; uint2 xb[8], xn[8], yb[8], yn[8];
    { const uint2* xr = (const uint2*)(p.X1B() + (size_t)(r_begin + F.wave) * D) + F.lane; const uint2* yr = (const uint2*)(p.Y() + (size_t)(r_begin + F.wave) * D) + F.lane;
#pragma unroll
      for (int j = 0; j < 8; ++j) { xb[j] = xr[64 * j]; yb[j] = yr[64 * j]; } }
    for (int r0 = r_begin; r0 < r_end; r0 += NWAVES) {
        const int row = r0 + F.wave, b = r0 / S;
        if (b != cur_b) { __syncthreads(); const float* g2 = p.MOD() + (size_t)b * D6 + 5 * D;
            for (int i = F.tid; i < D; i += NTHR) PG[i] = g2[i];
            cur_b = b; __syncthreads(); }
        float4* zr = (float4*)(p.out + (size_t)row * D) + F.lane; float s = 0.f;
        if (r0 + NWAVES < r_end) { const uint2* xp = (const uint2*)(p.X1B() + (size_t)(row + NWAVES) * D) + F.lane; const uint2* yp = (const uint2*)(p.Y() + (size_t)(row + NWAVES) * D) + F.lane;
#pragma unroll
            for (int j = 0; j < 8; ++j) { xn[j] = xp[64 * j]; yn[j] = yp[64 * j]; } }
#pragma unroll
        for (int j = 0; j < 8; ++j) { const f4v g = *(const LAS f4v*)(PG + 4 * F.lane + 256 * j);
            v[j].x = ALPHA * bflo(xb[j].x) + g[0] * bflo(yb[j].x); v[j].y = ALPHA * bfhi(xb[j].x) + g[1] * bfhi(yb[j].x); v[j].z = ALPHA * bflo(xb[j].y) + g[2] * bflo(yb[j].y); v[j].w = ALPHA * bfhi(xb[j].y) + g[3] * bfhi(yb[j].y);
            s += (v[j].x + v[j].y) + (v[j].z + v[j].w); }
        const float mean = wave_sum(s) * (1.f / D); float s2 = 0.f;
#pragma unroll
        for (int j = 0; j < 8; ++j) { v[j].x -= mean; v[j].y -= mean; v[j].z -= mean; v[j].w -= mean; s2 += (v[j].x * v[j].x + v[j].y * v[j].y) + (v[j].z * v[j].z + v[j].w * v[j].w); }
        const float rstd = 1.f / sqrtf(wave_sum(s2) * (1.f / D) + LN_EPS);
#pragma unroll
        for (int j = 0; j < 8; ++j) { const f4v w = *(const LAS f4v*)(PW + 4 * F.lane + 256 * j), bb = *(const LAS f4v*)(PB + 4 * F.lane + 256 * j);
            zr[64 * j] = make_float4(v[j].x * rstd * w[0] + bb[0], v[j].y * rstd * w[1] + bb[1], v[j].z * rstd * w[2] + bb[2], v[j].w * rstd * w[3] + bb[3]); }
#pragma unroll
        for (int j = 0; j < 8; ++j) { xb[j] = xn[j]; yb[j] = yn[j]; }
    }
}

struct Args { const float* in[18]; float* out; unsigned char* ws; int ph_lo, ph_hi, li, pad; };
__global__ void __launch_bounds__(NTHR, 2) mk_fwd(Args args) {
    extern __shared__ __attribute__((aligned(16))) unsigned char lds_raw[];
    Frame F; F.lds = (LAS unsigned char*)lds_raw; F.tid = threadIdx.x; F.lane = F.tid & 63; F.wave = __builtin_amdgcn_readfirstlane(F.tid >> 6); F.G = gridDim.x; F.bid = blockIdx.x;
    Prm p; p.x = args.in[0]; p.c = args.in[1]; p.w_ada = args.in[2]; p.b_ada = args.in[3]; p.w_in = args.in[4]; p.b_in = args.in[5]; p.conv_w = args.in[6]; p.conv_b = args.in[7]; p.mnorm_w = args.in[8];
    p.w_out = args.in[9]; p.ln1_w = args.in[10]; p.ln1_b = args.in[11]; p.wq = args.in[12]; p.subkeys = args.in[13]; p.peer_u = args.in[14]; p.peer_v = args.in[15]; p.ln2_w = args.in[16]; p.ln2_b = args.in[17];
    p.out = args.out; p.ws = args.ws;
    volatile LAS unsigned* MISC = (volatile LAS unsigned*)(F.lds + MISC_OFF);
    for (int u = F.tid; u < (LDS_BYTES - LDSCTL_OFF) / 4; u += NTHR) ((LAS unsigned*)(F.lds + LDSCTL_OFF))[u] = 0u;
    __syncthreads();
    const int lo = args.ph_lo, hi = args.ph_hi;
    XcdBarrier bar; bar.bar = (unsigned*)(p.ws + WS_CTL) + CW_BAR + args.li * XCD_BAR_WORDS; bar.x = 0; bar.st = nullptr;
    if (hi - lo > 1) bar = xcd_barrier_post((unsigned*)(p.ws + WS_CTL) + CW_BAR + args.li * XCD_BAR_WORDS, MISC + 8);
#define IN(k) (lo <= (k) && (k) < hi)
#define SEAM(k) do { if (IN(k) && IN((k) + 1)) xcd_barrier(bar); } while (0)
    XW xw; xw.nx = (F.G % 8 == 0) ? 8 : 1; xw.vx = F.bid % xw.nx; xw.rank = F.bid / xw.nx; xw.nloc = F.G / xw.nx;
#define XW_FROM_CENSUS() do { if (hi - lo > 1) { if (F.tid == 0) { unsigned vx_ = 0u; for (unsigned j = 0; j < bar.x; ++j) vx_ += xb_ld(&bar.bar[XB_XCNT(j)]) > 0u ? 1u : 0u; MISC[11] = vx_; } __syncthreads(); \
        xw.vx = (int)MISC[11]; xw.nx = (int)MISC[9]; xw.rank = (int)MISC[10] - 1; xw.nloc = (int)MISC[8]; } } while (0)
    if (IN(0)) { phase0(p, F); deferred_prep<false, true, true>(p, F, 0, F.G); } SEAM(0);
    if (IN(1)) { phase1(p, F); } SEAM(1);
    if (IN(2)) { pg8::Gemm g{p.U(), p.WIN_T(), T, INM, D}; pg8::StaticOrder So; So.init(T, INM, F.G, F.bid);
        pg8::EpiBf16<0> E{p.PJ(), INM, p.b_in, 0, 0, 1.f};
        pg8::gemm_phase<pg8::EpiBf16<0>, pg8::StaticOrder, true, true>(F.lds, g, So, E); } SEAM(2);
    if (IN(3)) { const int nmb = F.G >= 2 ? F.G / 2 : 1;
#ifndef P3_REP_ML
#define P3_REP_ML 1
#define P3_REP_CONV 1
#endif
        if (F.bid < nmb) { for (int rep_ = 0; rep_ < P3_REP_ML; ++rep_) for (int u = F.bid; u < 2 * NB * MH * 2; u += nmb) ml::unit(p, F, u); if (F.G < 2) phase3a(p, F, 0, 1); }
        else { phase3a(p, F, nmb, F.G - nmb); deferred_prep<true, false, false>(p, F, nmb, F.G - nmb); }
        if (F.G < 2) deferred_prep<true, false, false>(p, F, 0, 1); } SEAM(3);
    if (IN(4)) { phase4(p, F); } SEAM(4);
    if (IN(5)) { pg8::Gemm g{p.Y(), p.WOUT_T(), T, D, D}; pg8::StaticOrder So; So.init(T, D, F.G, F.bid);
        EpiZ E{p.x, p.MOD(), (bf16_t*)p.out};
        pg8::gemm_phase<EpiZ, pg8::StaticOrder, true, true>(F.lds, g, So, E); } SEAM(5);
    if (IN(6)) { phase6(p, F); } SEAM(6);
    if (IN(7)) { pg8::Gemm g{p.U(), p.WQ_T(), T, NQ, D}; pg8::StaticOrder So; So.init(T, NQ, F.G, F.bid);
        EpiF32 E{p.SC(), NSC};
        pg8::gemm_phase<EpiF32, pg8::StaticOrder, true, true>(F.lds, g, So, E); } SEAM(7);
    if (IN(8)) { phase8(p, F); } SEAM(8);
    if (IN(9)) { if (lo < 9) XW_FROM_CENSUS(); phase9(p, F, xw); } SEAM(9);
    if (IN(10)) { phase10(p, F); } SEAM(10);
    if (IN(11)) { phase11(p, F); } SEAM(11);
    if (IN(12)) { phase12(p, F); }
#undef IN
#undef SEAM
}

extern "C" void kernel_launch(void* const* d_in, const int* in_sizes, int n_in, void* d_out, int out_size, void* d_ws, size_t ws_size, hipStream_t stream) {
    static int grid = 0;
    if (grid == 0) {
        if (n_in != 18 || out_size != T * D || ws_size < WS_END) { fprintf(stderr, "kernel_launch: unexpected shapes (n_in %d out %d ws %zu, need %zu)\n", n_in, out_size, ws_size, (size_t)WS_END); grid = -1; return; }
        int dev = 0, cus = 0, per_cu = 0;
        if (hipGetDevice(&dev) != hipSuccess || hipDeviceGetAttribute(&cus, hipDeviceAttributeMultiprocessorCount, dev) != hipSuccess) { grid = -1; return; }
        if (hipFuncSetAttribute((const void*)mk_fwd, hipFuncAttributeMaxDynamicSharedMemorySize, LDS_BYTES) != hipSuccess) { fprintf(stderr, "kernel_launch: hipFuncSetAttribute failed\n"); grid = -1; return; }
        if (hipOccupancyMaxActiveBlocksPerMultiprocessor(&per_cu, (const void*)mk_fwd, NTHR, LDS_BYTES) != hipSuccess || per_cu < 1) { fprintf(stderr, "kernel_launch: the occupancy query reports %d workgroups per CU for this kernel + LDS size: the grid barrier would not be legal, not launching\n", per_cu); grid = -1; return; }
        grid = cus;
        if (T % grid != 0 || (T / grid) % (2 * NWAVES) != 0) { fprintf(stderr, "kernel_launch: grid %d does not divide the rows\n", grid); grid = -1; return; }
    }
    if (grid < 0) return;
    (void)hipMemsetAsync((char*)d_ws + WS_CTL, 0, 1u << 20, stream);
    Args a{};
    for (int i = 0; i < 18; ++i) a.in[i] = (const float*)d_in[i];
    a.out = (float*)d_out; a.ws = (unsigned char*)d_ws;
#if defined(PROBE_A)
    a.ph_lo = 0; a.ph_hi = PROBE_B + 1; a.li = 0; hipLaunchKernelGGL(mk_fwd, dim3(grid), dim3(NTHR), LDS_BYTES, stream, a);
    a.ph_lo = PROBE_A; a.ph_hi = NPHASE; a.li = 1; hipLaunchKernelGGL(mk_fwd, dim3(grid), dim3(NTHR), LDS_BYTES, stream, a);
#elif MK_N_LAUNCHES == 1
    a.ph_lo = 0; a.ph_hi = NPHASE;
    hipLaunchKernelGGL(mk_fwd, dim3(grid), dim3(NTHR), LDS_BYTES, stream, a);
#else
    for (int k = 0; k < NPHASE; ++k) { a.ph_lo = k; a.ph_hi = k + 1; hipLaunchKernelGGL(mk_fwd, dim3(grid), dim3(NTHR), LDS_BYTES, stream, a); }
#endif
}
```

```cpp
#define MK_N_LAUNCHES 1
#if defined(HOST_EMU)
#include <cmath>
#include <cstdint>
#include <cstring>
#include <cstddef>
#define HD inline
#define HDF inline
#else
#include <hip/hip_runtime.h>
#define HD __host__ __device__ __forceinline__
#define HDF __host__ __device__ __forceinline__
#endif

#ifndef CFG_D
#define CFG_D 2048
#define CFG_B 8
#define CFG_S 2048
#define CFG_PH 8
#define CFG_NK 128
#define CFG_TOPK 16
#define CFG_KD 256
#endif
constexpr int D = CFG_D, NB = CFG_B, S = CFG_S, T = NB * S;
constexpr int CW = D / 2, MW = D - CW, MH = 4, MV = MW / MH, QK = MV / 2, NG = 16, CHUNK = 64;
constexpr int INC = 3 * CW + 2 * MH * QK + 2 * MW + NG;
constexpr int INM = INC - NG;
constexpr int O_GB = 0, O_GC = CW, O_HIN = 2 * CW, O_Q = 3 * CW, O_K = O_Q + MH * QK, O_V = O_K + MH * QK, O_O = O_V + MW;
constexpr int PH = CFG_PH, NK = CFG_NK, TOPK = CFG_TOPK, KD = CFG_KD, KH = KD / 2, NE = NK * NK, NSLOT = PH * TOPK;
constexpr int NQ = PH * KD;
static_assert(PH * 2 * NK == NQ || true, "");
constexpr int NSC = PH * 2 * NK;
constexpr float LN_EPS = 1e-5f;
constexpr float ALPHA = 1.189207115002721f;
constexpr int D6 = 6 * D;

typedef unsigned short bf16_t;
HDF unsigned f_as_u(float f) { unsigned u; memcpy(&u, &f, 4); return u; }
HDF float u_as_f(unsigned u) { float f; memcpy(&f, &u, 4); return f; }
HDF bf16_t f2bf(float f) { unsigned u = f_as_u(f); return (bf16_t)((u + 0x7fffu + ((u >> 16) & 1u)) >> 16); }
HDF float bf2f(bf16_t h) { return u_as_f((unsigned)h << 16); }

constexpr size_t al(size_t x) { return (x + 1048575) & ~(size_t)1048575; }
constexpr size_t WS_CTL = 0;
constexpr size_t WS_MOD = al(1);
constexpr size_t WS_MODP = WS_MOD + al((size_t)NB * D6 * 4);
constexpr int NKS = 32;
constexpr size_t WS_GATES = WS_MODP + al((size_t)NKS * NB * D6 * 4);
constexpr size_t WS_DEN = WS_GATES + al((size_t)T * NG * 4);
constexpr size_t WS_FLR = WS_DEN + al((size_t)4 * T * MH * 4);
constexpr size_t WS_EIDX = WS_FLR + al((size_t)2 * T * MH * 4);
constexpr size_t WS_EW = WS_EIDX + al((size_t)T * NSLOT * 4);
constexpr size_t WS_WIN_T = WS_EW + al((size_t)T * NSLOT * 4);
constexpr size_t WS_WOUT_T = WS_WIN_T + al((size_t)INM * D * 2);
constexpr size_t WS_WQ_T = WS_WOUT_T + al((size_t)D * D * 2);
constexpr size_t WS_PU16 = WS_WQ_T + al((size_t)NQ * D * 2);
constexpr size_t WS_PV16 = WS_PU16 + al((size_t)NE * D * 2);
constexpr size_t WS_U = WS_PV16 + al((size_t)NE * D * 2);
constexpr size_t WS_Y = WS_U + al((size_t)T * D * 2);
constexpr size_t WS_P = WS_Y + al((size_t)T * D * 2);
constexpr size_t WS_SC = WS_P;
constexpr size_t WS_TS = WS_SC + al((size_t)T * NSC * 4);
constexpr size_t WS_TI = WS_TS + al((size_t)T * PH * 2 * TOPK * 4);
constexpr size_t WS_P_END = WS_P + al((size_t)T * INM * 2);
constexpr size_t WS_TI_END = WS_TI + al((size_t)T * PH * 2 * TOPK * 4);
constexpr size_t WS_END = WS_P_END > WS_TI_END ? WS_P_END : WS_TI_END;

struct Prm {
    const float *x, *c, *w_ada, *b_ada, *w_in, *b_in, *conv_w, *conv_b, *mnorm_w, *w_out, *ln1_w, *ln1_b, *wq, *subkeys, *peer_u, *peer_v, *ln2_w, *ln2_b;
    float* out;
    unsigned char* ws;
    HDF float* MOD() const { return (float*)(ws + WS_MOD); }
    HDF float* MODP() const { return (float*)(ws + WS_MODP); }
    HDF float* BIN256() const { return (float*)(ws + WS_MODP); }
    HDF float* GATES() const { return (float*)(ws + WS_GATES); }
    HDF float* DEN() const { return (float*)(ws + WS_DEN); }
    HDF float* FLR() const { return (float*)(ws + WS_FLR); }
    HDF int* EIDX() const { return (int*)(ws + WS_EIDX); }
    HDF float* EW() const { return (float*)(ws + WS_EW); }
    HDF bf16_t* WIN_T() const { return (bf16_t*)(ws + WS_WIN_T); }
    HDF unsigned char* WIN8() const { return ws + WS_WIN_T; }
    HDF unsigned char* U8() const { return ws + WS_U; }
    HDF bf16_t* WOUT_T() const { return (bf16_t*)(ws + WS_WOUT_T); }
    HDF bf16_t* WQ_T() const { return (bf16_t*)(ws + WS_WQ_T); }
    HDF bf16_t* PU16() const { return (bf16_t*)(ws + WS_PU16); }
    HDF bf16_t* PV16() const { return (bf16_t*)(ws + WS_PV16); }
    HDF unsigned char* PU8() const { return ws + WS_PU16; }
    HDF unsigned char* PV8() const { return ws + WS_PV16; }
    HDF unsigned char* PV8S() const { return ws + WS_PV16; }
    HDF float* RSU() const { return (float*)(ws + WS_PU16 + (size_t)NE * D); }
    HDF float* RSV() const { return (float*)(ws + WS_PU16 + (size_t)NE * D + (size_t)NE * 4); }
    HDF bf16_t* U() const { return (bf16_t*)(ws + WS_U); }
    HDF bf16_t* Y() const { return (bf16_t*)(ws + WS_Y); }
    HDF bf16_t* PJ() const { return (bf16_t*)(ws + WS_P); }
    HDF float* SC() const { return (float*)(ws + WS_SC); }
    HDF bf16_t* X1B() const { return (bf16_t*)(ws + WS_TS); }
    HDF float* TS() const { return (float*)(ws + WS_TS); }
    HDF int* TI() const { return (int*)(ws + WS_TI); }
    HDF float* HF() const { return out; }
    HDF float* HB() const { return out + (size_t)T * MW; }
    HDF bf16_t* HF16() const { return (bf16_t*)out; }
    HDF bf16_t* HB16() const { return (bf16_t*)out + (size_t)T * MW; }
};

HDF float sigmoidf_(float x) { return 1.f / (1.f + expf(-x)); }
HDF float logsigmoidf_(float x) { return fminf(x, 0.f) - log1pf(expf(-fabsf(x))); }
HDF float gelu_exact(float x) { return 0.5f * x * (1.f + erff(x * 0.7071067811865476f)); }

HD void b_ada(const Prm& p, long n) {
    float acc[NB];
#pragma unroll
    for (int b = 0; b < NB; ++b) acc[b] = 0.f;
    for (int k = 0; k < D; ++k) {
        const float w = p.w_ada[(size_t)k * D6 + n];
#pragma unroll
        for (int b = 0; b < NB; ++b) { const float cv = p.c[b * D + k]; acc[b] += cv * sigmoidf_(cv) * w; }
    }
#pragma unroll
    for (int b = 0; b < NB; ++b) p.MOD()[(size_t)b * D6 + n] = acc[b] + p.b_ada[n];
}
HD void b_wt(const float* W, int ldw, int K, bf16_t* WT, long i) { const long n = i / K, k = i % K; WT[i] = f2bf(W[(size_t)k * ldw + n]); }
HD void b_tab(const float* src, bf16_t* dst, long i) { dst[i] = f2bf(src[i]); }
HD void b_ln_mod1(const Prm& p, long row) {
    const float* xr = p.x + (size_t)row * D; const int b = (int)(row / S);
    const float* sh = p.MOD() + (size_t)b * D6; const float* sc = sh + D;
    float s = 0.f; for (int d = 0; d < D; ++d) s += xr[d];
    const float mean = s / D; float q = 0.f; for (int d = 0; d < D; ++d) { const float t = xr[d] - mean; q += t * t; }
    const float rstd = 1.f / sqrtf(q / D + LN_EPS);
    for (int d = 0; d < D; ++d) p.U()[(size_t)row * D + d] = f2bf((xr[d] - mean) * rstd * (1.f + sc[d]) + sh[d]);
}
HD void b_gates(const Prm& p, long i) {
    const long row = i / NG; const int g = (int)(i % NG); float acc = 0.f;
    for (int d = 0; d < D; ++d) acc += bf2f(p.U()[(size_t)row * D + d]) * p.w_in[(size_t)d * INC + INM + g];
    p.GATES()[i] = acc + p.b_in[INM + g];
}
HD float b_dot16(const bf16_t* a, const bf16_t* b, int K) { float acc = 0.f; for (int k = 0; k < K; ++k) acc += bf2f(a[k]) * bf2f(b[k]); return acc; }
HD void b_gemm1(const Prm& p, long i) { const long row = i / INM; const int n = (int)(i % INM);
    p.PJ()[i] = f2bf(b_dot16(p.U() + (size_t)row * D, p.WIN_T() + (size_t)n * D, D) + p.b_in[n]); }
HD void b_conv(const Prm& p, long i) {
    const long row = i / CW; const int ch = (int)(i % CW); const int s = (int)(row % S);
    const bf16_t* pj = p.PJ(); float acc = p.conv_b[ch];
#pragma unroll
    for (int k = 0; k < 3; ++k) { const int s2 = s + k - 1; if (s2 >= 0 && s2 < S) { const size_t r2 = (size_t)(row + k - 1) * INM;
        acc += p.conv_w[k * CW + ch] * (bf2f(pj[r2 + O_GC + ch]) * bf2f(pj[r2 + O_HIN + ch])); } }
    p.Y()[(size_t)row * D + ch] = f2bf(bf2f(pj[(size_t)row * INM + O_GB + ch]) * acc);
}
HDF long ml_tok(int dir, int b, int pos) { return (long)b * S + (dir ? S - 1 - pos : pos); }
HD void b_mscan(const Prm& p, long i) {
    const int v = (int)(i % (MV + 1)), h = (int)((i / (MV + 1)) % MH), b = (int)((i / ((MV + 1) * MH)) % NB), dir = (int)(i / ((MV + 1) * MH * NB));
    float C[QK];
#pragma unroll
    for (int d = 0; d < QK; ++d) C[d] = 0.f;
    float m = 0.f; const float qs = 1.f / sqrtf((float)QK);
    float* H = dir ? p.HB() : p.HF();
    for (int pos = 0; pos < S; ++pos) {
        const long tok = ml_tok(dir, b, pos); const float* g = p.GATES() + tok * NG + dir * 8;
        const float ig = g[h], lf = logsigmoidf_(g[4 + h]);
        const float mn = fmaxf(lf + m, ig), dec = expf(lf + m - mn), wi = expf(ig - mn); m = mn;
        const bf16_t* pj = p.PJ() + (size_t)tok * INM; const float wv = wi * (v < MV ? bf2f(pj[O_V + h * MV + (v < MV ? v : 0)]) : 1.f); float num = 0.f;
#pragma unroll
        for (int d = 0; d < QK; ++d) { C[d] = dec * C[d] + wv * bf2f(pj[O_K + h * QK + d]); num += bf2f(pj[O_Q + h * QK + d]) * qs * C[d]; }
        if (v < MV) H[(size_t)tok * MW + h * MV + v] = num;
        else { p.DEN()[((size_t)dir * T + tok) * MH + h] = num; p.FLR()[((size_t)dir * T + tok) * MH + h] = expf(-mn); }
    }
}
HD void b_headnorm(const Prm& p, long i) {
    const long row = i / MH; const int h = (int)(i % MH);
    const float* hf = p.HF() + (size_t)row * MW + h * MV; const float* hb = p.HB() + (size_t)row * MW + h * MV;
    const float inf_ = 1.f / fmaxf(fabsf(p.DEN()[(size_t)row * MH + h]), p.FLR()[(size_t)row * MH + h]);
    const float inb_ = 1.f / fmaxf(fabsf(p.DEN()[((size_t)T + row) * MH + h]), p.FLR()[((size_t)T + row) * MH + h]);
    float s = 0.f; for (int v = 0; v < MV; ++v) s += hf[v] * inf_ + hb[v] * inb_;
    const float mean = s / MV; float q = 0.f; for (int v = 0; v < MV; ++v) { const float t = hf[v] * inf_ + hb[v] * inb_ - mean; q += t * t; }
    const float rstd = 1.f / sqrtf(q / MV + LN_EPS);
    for (int v = 0; v < MV; ++v) { const float hn = (hf[v] * inf_ + hb[v] * inb_ - mean) * rstd * p.mnorm_w[h * MV + v];
        const float og = sigmoidf_(bf2f(p.PJ()[(size_t)row * INM + O_O + h * MV + v]));
        p.Y()[(size_t)row * D + CW + h * MV + v] = f2bf(og * hn); }
}
HD void b_gemm2(const Prm& p, long i) { const long row = i / D; const int n = (int)(i % D); const int b = (int)(row / S);
    const float acc = b_dot16(p.Y() + (size_t)row * D, p.WOUT_T() + (size_t)n * D, D);
    p.out[i] = ALPHA * p.x[i] + p.MOD()[(size_t)b * D6 + 2 * D + n] * acc; }
HD void b_ln_mid(const Prm& p, long row) {
    float* zr = p.out + (size_t)row * D; const int b = (int)(row / S);
    const float* sh = p.MOD() + (size_t)b * D6 + 3 * D; const float* sc = sh + D;
    float s = 0.f; for (int d = 0; d < D; ++d) s += zr[d];
    float mean = s / D; float q = 0.f; for (int d = 0; d < D; ++d) { const float t = zr[d] - mean; q += t * t; }
    float rstd = 1.f / sqrtf(q / D + LN_EPS);
    s = 0.f; for (int d = 0; d < D; ++d) { const float x1 = (zr[d] - mean) * rstd * p.ln1_w[d] + p.ln1_b[d]; zr[d] = x1; s += x1; }
    mean = s / D; q = 0.f; for (int d = 0; d < D; ++d) { const float t = zr[d] - mean; q += t * t; }
    rstd = 1.f / sqrtf(q / D + LN_EPS);
    for (int d = 0; d < D; ++d) p.U()[(size_t)row * D + d] = f2bf((zr[d] - mean) * rstd * (1.f + sc[d]) + sh[d]);
}
HD void b_gemm3(const Prm& p, long i) { const long row = i / NQ; const int n = (int)(i % NQ);
    p.Y()[i] = f2bf(b_dot16(p.U() + (size_t)row * D, p.WQ_T() + (size_t)n * D, D)); }
HD void b_scores(const Prm& p, long i) { const long tok = i / NSC; const int c = (int)(i % NSC), grp = c / NK, n = c % NK;
    const bf16_t* q = p.Y() + (size_t)tok * NQ + grp * KH; const float* sk = p.subkeys + ((size_t)grp * NK + n) * KH; float acc = 0.f;
    for (int d = 0; d < KH; ++d) acc += bf2f(q[d]) * sk[d];
    p.SC()[i] = acc; }
HD void b_topk1(const Prm& p, long i) {
    const float* sc = p.SC() + (size_t)i * NK; float pv = INFINITY; int pi = -1;
    for (int r = 0; r < TOPK; ++r) { float best = -INFINITY; int bi = -1;
        for (int n = 0; n < NK; ++n) { const float v = sc[n]; const bool ok = (v < pv) || (v == pv && n > pi); if (ok && v > best) { best = v; bi = n; } }
        p.TS()[(size_t)i * TOPK + r] = best; p.TI()[(size_t)i * TOPK + r] = bi; pv = best; pi = bi; }
}
HD void b_topk2(const Prm& p, long i) {
    const float* s0 = p.TS() + (size_t)i * 2 * TOPK; const float* s1 = s0 + TOPK; const int* i0 = p.TI() + (size_t)i * 2 * TOPK; const int* i1 = i0 + TOPK;
    float pv = INFINITY; int pi = -1; float mx = 0.f, sum = 0.f;
    for (int r = 0; r < TOPK; ++r) { float best = -INFINITY; int bi = -1;
        for (int c = 0; c < TOPK * TOPK; ++c) { const float v = s0[c / TOPK] + s1[c % TOPK]; const bool ok = (v < pv) || (v == pv && c > pi); if (ok && v > best) { best = v; bi = c; } }
        if (r == 0) mx = best;
        const float e = expf(best - mx); sum += e;
        p.EIDX()[(size_t)i * TOPK + r] = i0[bi / TOPK] * NK + i1[bi % TOPK]; p.EW()[(size_t)i * TOPK + r] = e; pv = best; pi = bi; }
    for (int r = 0; r < TOPK; ++r) p.EW()[(size_t)i * TOPK + r] /= sum;
}
HD void b_up(const Prm& p, long i) { const long tok = i / NSLOT; const int e = p.EIDX()[i];
    p.EW()[i] *= gelu_exact(b_dot16(p.U() + (size_t)tok * D, p.PU16() + (size_t)e * D, D)); }
HD void b_down(const Prm& p, long i) { const long tok = i / D; const int d = (int)(i % D); const int b = (int)(tok / S); float y = 0.f;
    for (int sl = 0; sl < NSLOT; ++sl) y += p.EW()[tok * NSLOT + sl] * bf2f(p.PV16()[(size_t)p.EIDX()[tok * NSLOT + sl] * D + d]);
    p.out[i] = ALPHA * p.out[i] + p.MOD()[(size_t)b * D6 + 5 * D + d] * y; }
HD void b_ln2(const Prm& p, long row) {
    float* zr = p.out + (size_t)row * D;
    float s = 0.f; for (int d = 0; d < D; ++d) s += zr[d];
    const float mean = s / D; float q = 0.f; for (int d = 0; d < D; ++d) { const float t = zr[d] - mean; q += t * t; }
    const float rstd = 1.f / sqrtf(q / D + LN_EPS);
    for (int d = 0; d < D; ++d) zr[d] = (zr[d] - mean) * rstd * p.ln2_w[d] + p.ln2_b[d];
}
#include <cstdio>
#define LAS __attribute__((address_space(3)))
#define GAS __attribute__((address_space(1)))
namespace pg8 {
#define PG8_LAS __attribute__((address_space(3)))
typedef unsigned short bf16_t;
typedef short bf16x8 __attribute__((ext_vector_type(8)));
typedef float f32x4 __attribute__((ext_vector_type(4)));
typedef unsigned u32x4 __attribute__((ext_vector_type(4)));
constexpr int BM = 256, BK = 64, HALF = 128, HTB = HALF * BK * 2  , STAGE_BYTES = 8 * HTB, NXCD = 8, WGM = 8;

__host__ __device__ __forceinline__ int lds_byte(int r, int c) { const int st = (r >> 4) * 2 + (c >> 5), rr = r & 15, cc = c & 31, ob = rr * 64 + cc * 2; return st * 1024 + (ob ^ (((ob >> 9) & 1) << 5)); }
__host__ __device__ __forceinline__ void stage_rc(int b, int& R, int& C) { const int st = b / 1024, sb = b % 1024, swz = sb ^ (((sb >> 9) & 1) << 5); R = (st >> 1) * 16 + swz / 64; C = (st & 1) * 32 + (swz % 64) / 2; }
__host__ __device__ __forceinline__ int perm32(int rho) { const int n = rho >> 4, i = rho & 15; return 8 * (i >> 2) + 4 * n + (i & 3); }

struct Unit { int pm, pn; };
struct Gemm { const bf16_t* A; const bf16_t* Bt; int M, N, K; };

struct StaticOrder {
    int nM, nN, nwg, G, c;
    __host__ __device__ void init(int M, int N, int G_, int c_) { nM = M / BM; nN = N / BM; nwg = nM * nN; G = G_; c = c_; }
    __host__ __device__ bool next(int i, Unit& u) const {
        const long L = (long)i * G + c; if (L >= nwg) return false;
        int wgid = (int)L; { const int q = nwg / NXCD, r = nwg % NXCD, xcd = wgid % NXCD, off = wgid / NXCD; wgid = (xcd < r ? xcd * (q + 1) : r * (q + 1) + (xcd - r) * q) + off; }
        const int nig = WGM * nN, gid = wgid / nig, fm = gid * WGM, gsz = (nM - fm) < WGM ? (nM - fm) : WGM;
        u.pm = fm + ((wgid % nig) % gsz); u.pn = (wgid % nig) / gsz; return true;
    }
    __device__ __forceinline__ void a_ready(const Unit&) const {}
    __device__ __forceinline__ void done(const Unit&) const {}
};

__device__ __forceinline__ unsigned cvt_pk_bf16(float lo, float hi) { unsigned r; asm volatile("v_cvt_pk_bf16_f32 %0, %1, %2" : "=v"(r) : "v"(lo), "v"(hi)); return r; }
typedef float f32x2 __attribute__((ext_vector_type(2)));
__device__ __forceinline__ f32x2 gelu_pk(f32x2 v) {
    const f32x2 av = __builtin_elementwise_abs(v), d = av * 0.2316418882f + 1.0f;
    f32x2 t; t.x = __builtin_amdgcn_rcpf(d.x); t.y = __builtin_amdgcn_rcpf(d.y);
    f32x2 q = t * 0.5307027145f + (-0.7265760135f); q = q * t + 0.7107068705f; q = q * t + (-0.142248368f); q = q * t + 0.127414796f; q = q * t;
    const f32x2 s = (v * v) * (-0.72134752044f);
    f32x2 e; e.x = __builtin_amdgcn_exp2f(s.x); e.y = __builtin_amdgcn_exp2f(s.y);
    const f32x2 m = v * (q * e), r = v - m;
    f32x2 o; o.x = v.x < 0.f ? m.x : r.x; o.y = v.y < 0.f ? m.y : r.y; return o;
}

template <int ACT  > struct EpiBf16 {
    static constexpr bool PERM = true, AFTER_DRAIN = false; static_assert(ACT == 0 || ACT == 1, "EpiBf16: ACT is 0 (none) or 1 (gelu_pk)");
    bf16_t* O; int ldc; const float* bias; int split_cols; size_t split_stride; float scale0;
    __device__ __forceinline__ void operator()(const f32x4 (&acc)[2][2][4][2], const Unit& u, int wr, int wc, int fr, int fq) const {
        const int row0 = u.pm * BM + wr * 64 + fr; int colt = u.pn * BM; bf16_t* base = O;
        float sc = 1.f; if (split_cols) { const int t = colt / split_cols; base += (size_t)t * split_stride; colt -= t * split_cols; if (t == 0) sc = scale0; }
        const int col0 = colt + wc * 32 + 8 * fq, bcol0 = u.pn * BM + wc * 32 + 8 * fq;
        f32x4 bv[2][2];
#pragma unroll
        for (int bj = 0; bj < 2; ++bj)
#pragma unroll
            for (int n = 0; n < 2; ++n) bv[bj][n] = bias ? *(const f32x4*)(bias + bcol0 + bj * HALF + 4 * n) : (f32x4){0.f, 0.f, 0.f, 0.f};
#pragma unroll
        for (int ai = 0; ai < 2; ++ai)
#pragma unroll
            for (int m = 0; m < 4; ++m) { bf16_t* rowp = base + (size_t)(row0 + ai * HALF + m * 16) * ldc + col0;
#pragma unroll
                for (int bj = 0; bj < 2; ++bj) { f32x4 v0 = acc[ai][bj][m][0] + bv[bj][0], v1 = acc[ai][bj][m][1] + bv[bj][1];
                    if (ACT == 1) { f32x2 a = gelu_pk((f32x2){v0[0], v0[1]}), b = gelu_pk((f32x2){v0[2], v0[3]}), c = gelu_pk((f32x2){v1[0], v1[1]}), d = gelu_pk((f32x2){v1[2], v1[3]});
                        v0 = (f32x4){a.x, a.y, b.x, b.y}; v1 = (f32x4){c.x, c.y, d.x, d.y}; }
                    v0 = v0 * sc; v1 = v1 * sc; u32x4 w; w.x = cvt_pk_bf16(v0[0], v0[1]); w.y = cvt_pk_bf16(v0[2], v0[3]); w.z = cvt_pk_bf16(v1[0], v1[1]); w.w = cvt_pk_bf16(v1[2], v1[3]);
                    *(u32x4*)(rowp + bj * HALF) = w; } }
    }
};
template <class Epi, class Sched, bool ALIGN_EPI = false, bool SP2 = false>
__device__ __forceinline__ void gemm_phase(PG8_LAS unsigned char* lds, const Gemm g, const Sched& S, const Epi& E) {
    const int tid = threadIdx.x, wid = __builtin_amdgcn_readfirstlane(tid >> 6), lane = tid & 63, wr = wid >> 2, wc = wid & 3, fr = lane & 15, fq = lane >> 4;
    const int K = g.K, nt = K / BK;
    unsigned voffA[2], voffB[2];
#pragma unroll
    for (int i = 0; i < 2; ++i) { int R, C; stage_rc(tid * 16 + i * 8192, R, C); const int Rb = Epi::PERM ? ((R & ~31) + perm32(R & 31)) : R;
        voffA[i] = (unsigned)(R * K + C) * 2u; voffB[i] = (unsigned)(Rb * K + C) * 2u; }
    const size_t kstep = (size_t)(BK * 2);
    const size_t hstep = (size_t)HALF * K * 2;
    const size_t tstep = 2 * hstep;
    const unsigned ldsw = (unsigned)wid * 1024u;
    const int aoff = lds_byte(wr * 64 + fr, fq * 8), boff = lds_byte(wc * 32 + fr, fq * 8);
#define PG8_SA(b, h) (((b) * 2 + (h)) * HTB)
#define PG8_SB(b, h) ((4 + (b) * 2 + (h)) * HTB)
#define PG8_STAGE(bufoff, gbase, voff) do { _Pragma("unroll") for (int _i = 0; _i < 2; ++_i) \
        __builtin_amdgcn_global_load_lds((const unsigned*)((const char*)(gbase) + (voff)[_i]), (PG8_LAS unsigned*)(lds + (bufoff) + ldsw + _i * 8192), 16, 0, 0); } while (0)
#define PG8_LDA(dst, b, h) do { _Pragma("unroll") for (int m = 0; m < 4; ++m) _Pragma("unroll") for (int k = 0; k < 2; ++k) dst[m][k] = *(const PG8_LAS bf16x8*)(lds + PG8_SA(b, h) + aoff + m * 2048 + k * 1024); } while (0)
#define PG8_LDB(dst, b, h) do { _Pragma("unroll") for (int n = 0; n < 2; ++n) _Pragma("unroll") for (int k = 0; k < 2; ++k) dst[n][k] = *(const PG8_LAS bf16x8*)(lds + PG8_SB(b, h) + boff + n * 2048 + k * 1024); } while (0)
#define PG8_MMA(ai, bj, At, Bt) do { __builtin_amdgcn_s_setprio(1); _Pragma("unroll") for (int m = 0; m < 4; ++m) _Pragma("unroll") for (int n = 0; n < 2; ++n) _Pragma("unroll") for (int k = 0; k < 2; ++k) \
        acc[ai][bj][m][n] = __builtin_amdgcn_mfma_f32_16x16x32_bf16(Bt[n][k], At[m][k], acc[ai][bj][m][n], 0, 0, 0); __builtin_amdgcn_s_setprio(0); } while (0)
#define PG8_WAIT_V(n) asm volatile("s_waitcnt vmcnt(" #n ")" ::: "memory")
#define PG8_WAIT_L(n) asm volatile("s_waitcnt lgkmcnt(" #n ")" ::: "memory")
#define PG8_BAR __builtin_amdgcn_s_barrier()
#define PG8_SCHED __builtin_amdgcn_sched_barrier(0)
    Unit cur, nxt; int ui = 0;
    if (!S.next(0, cur)) return;
    f32x4 acc[2][2][4][2];
#pragma unroll
    for (int a = 0; a < 2; ++a)
#pragma unroll
        for (int b = 0; b < 2; ++b)
#pragma unroll
            for (int m = 0; m < 4; ++m)
#pragma unroll
                for (int n = 0; n < 2; ++n) acc[a][b][m][n] = (f32x4){0.f, 0.f, 0.f, 0.f};
    bf16x8 At[4][2], B0[2][2], B1[2][2];
    const char* cA = (const char*)g.A + (size_t)cur.pm * tstep; const char* cB = (const char*)g.Bt + (size_t)cur.pn * tstep;
    S.a_ready(cur);
    if constexpr (SP2) {
        PG8_STAGE(PG8_SB(0, 0), cB, voffB); PG8_STAGE(PG8_SB(0, 1), cB + hstep, voffB); PG8_STAGE(PG8_SA(0, 0), cA, voffA); PG8_STAGE(PG8_SA(0, 1), cA + hstep, voffA);
        if (wr == 1) PG8_BAR;
        PG8_WAIT_V(2); PG8_BAR;
        PG8_STAGE(PG8_SB(1, 0), cB + kstep, voffB); PG8_STAGE(PG8_SA(1, 0), cA + kstep, voffA); PG8_STAGE(PG8_SB(1, 1), cB + hstep + kstep, voffB);
        PG8_WAIT_V(6); PG8_BAR;
    } else {
        PG8_STAGE(PG8_SB(0, 0), cB, voffB); PG8_STAGE(PG8_SA(0, 0), cA, voffA); PG8_STAGE(PG8_SB(0, 1), cB + hstep, voffB); PG8_STAGE(PG8_SA(0, 1), cA + hstep, voffA);
        if (wr == 1) PG8_BAR;
        PG8_WAIT_V(4); PG8_BAR;
        PG8_STAGE(PG8_SB(1, 0), cB + kstep, voffB); PG8_STAGE(PG8_SA(1, 0), cA + kstep, voffA); PG8_STAGE(PG8_SB(1, 1), cB + hstep + kstep, voffB);
        PG8_WAIT_V(6); PG8_BAR;
    }
    for (;;) {
        const bool has_next = S.next(ui + 1, nxt);
        const char* nA = has_next ? (const char*)g.A + (size_t)nxt.pm * tstep : cA; const char* nB = has_next ? (const char*)g.Bt + (size_t)nxt.pn * tstep : cB;
        for (int t = 0; t < nt; t += 2) {
            const bool last = (t == nt - 2);
            const char* a1 = cA + (size_t)(t + 1) * kstep;
            const char* a2 = last ? nA : cA + (size_t)(t + 2) * kstep; const char* b2 = last ? nB : cB + (size_t)(t + 2) * kstep;
            const char* a3 = a2 + kstep; const char* b3 = b2 + kstep;
            if (last && has_next) S.a_ready(nxt);
            if constexpr (SP2) {
            PG8_LDB(B0, 0, 0); PG8_LDB(B1, 0, 1); PG8_SCHED; PG8_LDA(At, 0, 0); PG8_STAGE(PG8_SA(1, 1), a1 + hstep, voffA);
            PG8_WAIT_V(8); PG8_WAIT_L(0); PG8_BAR; PG8_MMA(0, 0, At, B0); PG8_MMA(0, 1, At, B1); PG8_BAR; PG8_SCHED;
            PG8_LDA(At, 0, 1); PG8_STAGE(PG8_SB(0, 0), b2, voffB); PG8_STAGE(PG8_SB(0, 1), b2 + hstep, voffB); PG8_STAGE(PG8_SA(0, 0), a2, voffA);
            PG8_WAIT_V(8); PG8_WAIT_L(0); PG8_BAR; PG8_MMA(1, 0, At, B0); PG8_MMA(1, 1, At, B1); PG8_BAR; PG8_SCHED;
            PG8_LDB(B0, 1, 0); PG8_LDB(B1, 1, 1); PG8_SCHED; PG8_LDA(At, 1, 0); PG8_STAGE(PG8_SA(0, 1), a2 + hstep, voffA);
            PG8_WAIT_V(8); PG8_WAIT_L(0); PG8_BAR; PG8_MMA(0, 0, At, B0); PG8_MMA(0, 1, At, B1); PG8_BAR; PG8_SCHED;
            PG8_LDA(At, 1, 1); PG8_STAGE(PG8_SB(1, 0), b3, voffB); PG8_STAGE(PG8_SB(1, 1), b3 + hstep, voffB); PG8_STAGE(PG8_SA(1, 0), a3, voffA);
            PG8_WAIT_V(8); PG8_WAIT_L(0); PG8_BAR; PG8_MMA(1, 0, At, B0); PG8_MMA(1, 1, At, B1); PG8_BAR; PG8_SCHED;
            } else {
            PG8_LDB(B0, 0, 0); PG8_SCHED; PG8_LDA(At, 0, 0); PG8_STAGE(PG8_SA(1, 1), a1 + hstep, voffA);
            PG8_WAIT_L(8); PG8_BAR; PG8_WAIT_L(0); PG8_MMA(0, 0, At, B0); PG8_BAR; PG8_SCHED;
            PG8_LDB(B1, 0, 1); PG8_STAGE(PG8_SB(0, 0), b2, voffB);
            PG8_BAR; PG8_WAIT_L(0); PG8_MMA(0, 1, At, B1); PG8_BAR;
            PG8_LDA(At, 0, 1); PG8_STAGE(PG8_SA(0, 0), a2, voffA);
            PG8_BAR; PG8_WAIT_L(0); PG8_MMA(1, 0, At, B0); PG8_BAR; PG8_SCHED;
            PG8_STAGE(PG8_SB(0, 1), b2 + hstep, voffB);
            PG8_WAIT_V(6); PG8_BAR; PG8_MMA(1, 1, At, B1); PG8_BAR;
            PG8_LDB(B0, 1, 0); PG8_SCHED; PG8_LDA(At, 1, 0); PG8_STAGE(PG8_SA(0, 1), a2 + hstep, voffA);
            PG8_WAIT_L(8); PG8_BAR; PG8_WAIT_L(0); PG8_MMA(0, 0, At, B0); PG8_BAR; PG8_SCHED;
            PG8_LDB(B1, 1, 1); PG8_STAGE(PG8_SB(1, 0), b3, voffB);
            PG8_BAR; PG8_WAIT_L(0); PG8_MMA(0, 1, At, B1); PG8_BAR;
            PG8_LDA(At, 1, 1); PG8_STAGE(PG8_SA(1, 0), a3, voffA);
            PG8_BAR; PG8_WAIT_L(0); PG8_MMA(1, 0, At, B0); PG8_BAR; PG8_SCHED;
            PG8_STAGE(PG8_SB(1, 1), b3 + hstep, voffB);
            PG8_WAIT_V(6); PG8_BAR; PG8_MMA(1, 1, At, B1); PG8_BAR;
            }
        }
        if constexpr (ALIGN_EPI) { if (wr == 0) PG8_BAR; }
        if constexpr (!Epi::AFTER_DRAIN) { E(acc, cur, wr, wc, fr, fq); S.done(cur); }
        if (!has_next) break;
#pragma unroll
        for (int a = 0; a < 2; ++a)
#pragma unroll
            for (int b = 0; b < 2; ++b)
#pragma unroll
                for (int m = 0; m < 4; ++m)
#pragma unroll
                    for (int n = 0; n < 2; ++n) acc[a][b][m][n] = (f32x4){0.f, 0.f, 0.f, 0.f};
        cur = nxt; cA = nA; cB = nB; ++ui;
        if constexpr (ALIGN_EPI) { if (wr == 1) PG8_BAR; }
    }
    PG8_WAIT_V(0);
    if constexpr (!ALIGN_EPI) { if (wr == 0) PG8_BAR; }
    PG8_BAR;
    if constexpr (Epi::AFTER_DRAIN) { E.fused(acc, cur, wr, wc, fr, fq, lds, wid, lane); S.done(cur); }
#undef PG8_SA
#undef PG8_SB
#undef PG8_STAGE
#undef PG8_LDA
#undef PG8_LDB
#undef PG8_MMA
#undef PG8_WAIT_V
#undef PG8_WAIT_L
#undef PG8_BAR
#undef PG8_SCHED
}
}
#define XB_TMO      128
#define XB_XCNT(j)  (256  + 64 * (j))
#define XB_XSUB(j)  (1280 + 64 * (j))
#define XB_XGEN(j)  (2304 + 64 * (j))
#define XB_TOP      3328
#define XB_TOPGEN   3392
#define XCD_BAR_WORDS 3456
#define XB_SPIN_CAP (1u << 18)

__device__ __forceinline__ unsigned xb_ld(unsigned* p)              { return __hip_atomic_load(p, __ATOMIC_RELAXED, __HIP_MEMORY_SCOPE_AGENT); }
__device__ __forceinline__ unsigned xb_add(unsigned* p, unsigned v) { return __hip_atomic_fetch_add(p, v, __ATOMIC_RELAXED, __HIP_MEMORY_SCOPE_AGENT); }
__device__ __forceinline__ unsigned xb_xcc_id() { return (unsigned)__builtin_amdgcn_s_getreg((3 << 11) | 20) & 0xFu; }
#define XB_SPIN(cond, bar) do { unsigned _sp = 0; while (cond) { __builtin_amdgcn_s_sleep(1); \
    if ((++_sp & 255u) == 0u) { if (xb_ld(&(bar)[XB_TMO])) break; if (_sp > XB_SPIN_CAP) { atomicAdd(&(bar)[XB_TMO], 1u); break; } } } } while (0)

struct XcdBarrier {
    unsigned* bar; unsigned x;
    volatile LAS unsigned* st;
};

__device__ __forceinline__ XcdBarrier xcd_barrier_post(unsigned* bar, volatile LAS unsigned* st) {
    XcdBarrier b; b.bar = bar; b.x = xb_xcc_id(); b.st = st;
    if (threadIdx.x == 0) st[2] = xb_add(&bar[XB_XCNT(b.x)], 1u) + 1u;
    return b;
}
__device__ __forceinline__ void xcd_barrier_complete(unsigned* bar, unsigned x, unsigned& nloc, unsigned& nx) {
    const unsigned G = gridDim.x * gridDim.y * gridDim.z;
    unsigned sum, cnt, mine, sp = 0u;
    for (;;) {
        sum = 0u; cnt = 0u; mine = 0u;
#pragma unroll
        for (unsigned j = 0; j < 16; ++j) { const unsigned c = xb_ld(&bar[XB_XCNT(j)]); sum += c; cnt += (c > 0u) ? 1u : 0u; mine = (j == x) ? c : mine; }
        if (sum == G) break;
        __builtin_amdgcn_s_sleep(1);
        if ((++sp & 255u) == 0u) { if (xb_ld(&bar[XB_TMO])) break; if (sp > XB_SPIN_CAP) { atomicAdd(&bar[XB_TMO], 1u); break; } }
    }
    nloc = mine > 0u ? mine : 1u; nx = cnt > 0u ? cnt : 1u;
}

__device__ __forceinline__ void xcd_barrier(const XcdBarrier& b) {
    asm volatile("s_waitcnt vmcnt(0)" ::: "memory");
    __syncthreads();
    if (threadIdx.x == 0) {
        unsigned* bar = b.bar;
        __builtin_amdgcn_s_waitcnt(0);
        unsigned nloc = b.st[0], nx = b.st[1];
        if (nloc == 0u) { xcd_barrier_complete(bar, b.x, nloc, nx); b.st[0] = nloc; b.st[1] = nx; }
        const unsigned old = xb_add(&bar[XB_XSUB(b.x)], 1u);
        const unsigned gen = old / nloc;
        if (old + 1u == (gen + 1u) * nloc) {
            __builtin_amdgcn_fence(__ATOMIC_RELEASE, "agent");
            asm volatile("s_waitcnt vmcnt(0)" ::: "memory");
            const unsigned og = xb_add(&bar[XB_TOP], 1u);
            const unsigned tg = og / nx;
            if (og + 1u == (tg + 1u) * nx) xb_add(&bar[XB_TOPGEN], 1u);
            else XB_SPIN(xb_ld(&bar[XB_TOPGEN]) == tg, bar);
            __builtin_amdgcn_fence(__ATOMIC_ACQUIRE, "agent");
            xb_add(&bar[XB_XGEN(b.x)], 1u);
            asm volatile("s_waitcnt vmcnt(0)" ::: "memory");
        } else {
            XB_SPIN(xb_ld(&bar[XB_XGEN(b.x)]) == gen, bar);
            __builtin_amdgcn_fence(__ATOMIC_ACQUIRE, "agent");
            asm volatile("s_waitcnt vmcnt(0)" ::: "memory");
        }
    }
    __syncthreads();
}
constexpr int NWAVES = 8, NTHR = 512;
constexpr int RING_BYTES = 131072, LDSCTL_OFF = RING_BYTES, MISC_OFF = LDSCTL_OFF + 320, LDS_BYTES = 163840;
constexpr int CW_BAR = 4096;
#ifndef MK_N_LAUNCHES
#define MK_N_LAUNCHES 1
#endif
constexpr int NPHASE = 13;

typedef float f4v __attribute__((ext_vector_type(4)));
typedef unsigned u2v __attribute__((ext_vector_type(2)));
typedef unsigned u32x4_t __attribute__((ext_vector_type(4)));
struct Frame { LAS unsigned char* lds; int tid, lane, wave, G, bid; };
template <int CTRL, int ROWMASK> __device__ __forceinline__ float dppf(float old, float src) {
    return __builtin_bit_cast(float, __builtin_amdgcn_update_dpp(__builtin_bit_cast(int, old), __builtin_bit_cast(int, src), CTRL, ROWMASK, 0xf, false)); }
__device__ __forceinline__ float wave_scan_add(float v) {
    v += dppf<0x111, 0xf>(0.f, v); v += dppf<0x112, 0xf>(0.f, v); v += dppf<0x114, 0xf>(0.f, v); v += dppf<0x118, 0xf>(0.f, v);
    v += dppf<0x142, 0xa>(0.f, v); v += dppf<0x143, 0xc>(0.f, v); return v; }
__device__ __forceinline__ float wave_scan_max(float v) {
    const float NI = -INFINITY;
    v = fmaxf(v, dppf<0x111, 0xf>(NI, v)); v = fmaxf(v, dppf<0x112, 0xf>(NI, v)); v = fmaxf(v, dppf<0x114, 0xf>(NI, v)); v = fmaxf(v, dppf<0x118, 0xf>(NI, v));
    v = fmaxf(v, dppf<0x142, 0xa>(NI, v)); v = fmaxf(v, dppf<0x143, 0xc>(NI, v)); return v; }
__device__ __forceinline__ float lane_bcast(float v, int l) { return __builtin_bit_cast(float, __builtin_amdgcn_readlane(__builtin_bit_cast(int, v), l)); }
__device__ __forceinline__ float wave_sum(float v) { return lane_bcast(wave_scan_add(v), 63); }
__device__ __forceinline__ unsigned pk2(float lo, float hi) { return (unsigned)f2bf(lo) | ((unsigned)f2bf(hi) << 16); }
__device__ __forceinline__ float bflo(unsigned w) { return u_as_f(w << 16); }
__device__ __forceinline__ float bfhi(unsigned w) { return u_as_f(w & 0xffff0000u); }

__device__ __forceinline__ void p0_ada_block(const Prm& p, const Frame& F, int cb) {
    static_assert(D6 % 48 == 0 && NB == 8, "48-column blocks");
    LAS float* sl = (LAS float*)F.lds;
    LAS float* red = sl + NB * D;
    for (int i = F.tid; i < NB * D; i += NTHR) { const float cv = p.c[i]; sl[i] = cv / (1.f + __expf(-cv)); }
    __syncthreads();
    const int c4 = F.tid % 12, kl = F.tid / 12;
    if (kl < 42) {
        f4v acc[NB];
#pragma unroll
        for (int b = 0; b < NB; ++b) acc[b] = (f4v){0.f, 0.f, 0.f, 0.f};
        const float* wp = p.w_ada + (size_t)cb * 48 + 4 * c4;
#pragma unroll 7
        for (int k = kl; k < D; k += 42) { const f4v w = __builtin_nontemporal_load((const f4v*)(wp + (size_t)k * D6));
#pragma unroll
            for (int b = 0; b < NB; ++b) acc[b] += w * sl[b * D + k]; }
#pragma unroll
        for (int b = 0; b < NB; ++b) *(LAS f4v*)(red + (kl * NB + b) * 48 + 4 * c4) = acc[b];
    }
    __syncthreads();
    if (F.tid < NB * 48) { const int b = F.tid / 48, col = F.tid % 48; float s = 0.f;
        for (int k = 0; k < 42; ++k) s += red[(k * NB + b) * 48 + col];
        p.MOD()[(size_t)b * D6 + cb * 48 + col] = s + p.b_ada[cb * 48 + col]; }
    __syncthreads();
}
__device__ __forceinline__ void p0_transpose_item(const float* W, int ldw, int K, int N, bf16_t* WT, LAS float* scr, int item, int lane) {
    const int nblk = N / 32, kb = item / nblk, nb = item % nblk, k0 = 64 * kb, n0 = 32 * nb;
#pragma unroll
    for (int i = 0; i < 32; ++i) { const int kk = 2 * i + (lane >> 5); scr[kk * 33 + (lane & 31)] = W[(size_t)(k0 + kk) * ldw + n0 + (lane & 31)]; }
    asm volatile("s_waitcnt lgkmcnt(0)" ::: "memory");
    const int c = lane & 7;
#pragma unroll
    for (int j = 0; j < 4; ++j) { const int n = (lane >> 3) + 8 * j; const LAS float* s = scr + (8 * c) * 33 + n;
        uint4 o; o.x = pk2(s[0 * 33], s[1 * 33]); o.y = pk2(s[2 * 33], s[3 * 33]); o.z = pk2(s[4 * 33], s[5 * 33]); o.w = pk2(s[6 * 33], s[7 * 33]);
        *(uint4*)(WT + (size_t)(n0 + n) * K + k0 + 8 * c) = o; }
    asm volatile("s_waitcnt lgkmcnt(0)" ::: "memory");
}

__device__ __forceinline__ void p0_fold_item(const Prm& p, int item, int lane) {
    static_assert(NK == 128 && KH == 128 && NQ == 2048, "fold item decomposition");
    const int ks = item & 31, nt = (item >> 5) & 7, g = item >> 8;
    const int r = lane & 15, q = lane >> 4;
    const float* arow = p.subkeys + ((size_t)g * NK + nt * 16 + r) * KH + 4 * q;
    const float* brow = p.wq + (size_t)(ks * 64 + r) * NQ + g * KH + 4 * q;
    pg8::f32x4 acc[4];
#pragma unroll
    for (int c = 0; c < 4; ++c) acc[c] = (pg8::f32x4){0.f, 0.f, 0.f, 0.f};
#pragma unroll 2
    for (int s16 = 0; s16 < KH; s16 += 16) {
        const pg8::f32x4 a = *(const pg8::f32x4*)(arow + s16); pg8::f32x4 bv[4];
#pragma unroll
        for (int c = 0; c < 4; ++c) bv[c] = *(const pg8::f32x4*)(brow + (size_t)(c * 16) * NQ + s16);
#pragma unroll
        for (int i = 0; i < 4; ++i)
#pragma unroll
            for (int c = 0; c < 4; ++c) acc[c] = __builtin_amdgcn_mfma_f32_16x16x4f32(a[i], bv[c][i], acc[c], 0, 0, 0);
    }
#pragma unroll
    for (int c = 0; c < 4; ++c)
#pragma unroll
        for (int i = 0; i < 4; ++i) p.WQ_T()[(size_t)(g * NK + nt * 16 + 4 * q + i) * D + ks * 64 + c * 16 + r] = f2bf(acc[c][i]);
}
__device__ __forceinline__ void phase0(const Prm& p, const Frame& F) {
    for (int cb = F.bid; cb < D6 / 48; cb += F.G) p0_ada_block(p, F, cb);
    LAS float* scr = (LAS float*)(F.lds + F.wave * 16384);
    const int gw = F.bid * NWAVES + F.wave, NGW = F.G * NWAVES;
    constexpr int I_IN = (D / 64) * (INM / 32);
    for (int it = gw; it < I_IN; it += NGW) p0_transpose_item(p.w_in, INC, D, INM, p.WIN_T(), scr, it, F.lane);
}
template <bool PART_A, bool PART_B, bool PART_F>
__device__ __forceinline__ void deferred_prep(const Prm& p, const Frame& F, int b0, int nb) {
    __syncthreads();
    LAS float* scr = (LAS float*)(F.lds + F.wave * 16384);
    const int gw = (F.bid - b0) * NWAVES + F.wave, NGW = nb * NWAVES;
    constexpr int I_O = (D / 64) * (D / 32), I_Q = 32 * 8 * 16;
    if (PART_A) for (int it = gw; it < I_O; it += NGW) p0_transpose_item(p.w_out, D, D, D, p.WOUT_T(), scr, it, F.lane);
    if (PART_F) for (int it = gw; it < I_Q; it += NGW) p0_fold_item(p, it, F.lane);
    if (PART_A) {
        float4 v[8], vn[8]; int rr = gw;
#define P0_ROWSRC(rr_) ((const float4*)(p.peer_u + (size_t)(rr_) * D) + F.lane)
        if (rr < NE) { const float4* src = P0_ROWSRC(rr);
#pragma unroll
            for (int j = 0; j < 8; ++j) { const f4v t_ = __builtin_nontemporal_load((const f4v*)(src + 64 * j)); v[j] = make_float4(t_[0], t_[1], t_[2], t_[3]); } }
        for (; rr < NE; rr += NGW) {
            const int rn = rr + NGW;
            if (rn < NE) { const float4* src = P0_ROWSRC(rn);
#pragma unroll
                for (int j = 0; j < 8; ++j) { const f4v t_ = __builtin_nontemporal_load((const f4v*)(src + 64 * j)); vn[j] = make_float4(t_[0], t_[1], t_[2], t_[3]); } }
            const int e = rr; float am = 0.f;
#pragma unroll
            for (int j = 0; j < 8; ++j) am = fmaxf(am, fmaxf(fmaxf(fabsf(v[j].x), fabsf(v[j].y)), fmaxf(fabsf(v[j].z), fabsf(v[j].w))));
#pragma unroll
            for (int o = 1; o < 64; o <<= 1) am = fmaxf(am, __shfl_xor(am, o));
            const float sc = am > 0.f ? 384.f / am : 1.f;
            unsigned* dst = (unsigned*)(p.PU8() + (size_t)e * D) + F.lane;
#pragma unroll
            for (int j = 0; j < 8; ++j) { unsigned w = 0u; w = __builtin_amdgcn_cvt_pk_fp8_f32(v[j].x * sc, v[j].y * sc, w, false); w = __builtin_amdgcn_cvt_pk_fp8_f32(v[j].z * sc, v[j].w * sc, w, true); dst[64 * j] = w; }
            if (F.lane == 0) p.RSU()[e] = am > 0.f ? am / 384.f : 1.f;
#pragma unroll
            for (int j = 0; j < 8; ++j) v[j] = vn[j];
        }
#undef P0_ROWSRC
    }
    if (PART_B) { LAS unsigned char* tl = F.lds; constexpr int RS_ = 2056;
      for (int tile = F.bid - b0; tile < NE / 16; tile += nb) { const int row = F.tid >> 5, l32 = F.tid & 31, e = tile * 16 + row;
        __syncthreads();
        const f4v* src = (const f4v*)(p.peer_v + (size_t)e * D) + l32; f4v x[16]; float am = 0.f;
#pragma unroll
        for (int j = 0; j < 16; ++j) { x[j] = __builtin_nontemporal_load(src + 32 * j); am = fmaxf(am, fmaxf(fmaxf(fabsf(x[j][0]), fabsf(x[j][1])), fmaxf(fabsf(x[j][2]), fabsf(x[j][3])))); }
#pragma unroll
        for (int o = 1; o < 32; o <<= 1) am = fmaxf(am, __shfl_xor(am, o));
        const float sc = am > 0.f ? 384.f / am : 1.f;
#pragma unroll
        for (int j = 0; j < 16; ++j) { unsigned w = 0u; w = __builtin_amdgcn_cvt_pk_fp8_f32(x[j][0] * sc, x[j][1] * sc, w, false); w = __builtin_amdgcn_cvt_pk_fp8_f32(x[j][2] * sc, x[j][3] * sc, w, true);
            *(LAS unsigned*)(tl + row * RS_ + 4 * (l32 + 32 * j)) = w; }
        if (l32 == 0) p.RSV()[e] = am > 0.f ? am / 384.f : 1.f;
        __syncthreads();
#pragma unroll
        for (int k = 0; k < 8; ++k) { const int idx = F.tid + NTHR * k, r = idx & 15, sl = idx >> 4;
            *(u2v*)(p.PV8S() + ((size_t)sl * NE + tile * 16 + r) * 8) = *(const LAS u2v*)(tl + r * RS_ + 8 * sl); }
      } }
}
__device__ __forceinline__ void phase1(const Prm& p, const Frame& F) {
    static_assert(NG == 16 && D % 32 == 0, "gate tile = one 16-column MFMA tile");
    LAS float* SH = (LAS float*)F.lds; LAS float* SC1 = SH + D;
    constexpr unsigned WGS = 2 * D + 16, WG_OFF = 2 * D * 4, US_OFF = ((WG_OFF + NG * WGS + 255u) / 256u) * 256u;
    constexpr unsigned US_HI = 132096u;
    static_assert(US_OFF + 5 * 2 * D * 2 <= (unsigned)LDSCTL_OFF && US_HI + 3 * 2 * D * 2 <= (unsigned)LDS_BYTES && US_HI >= (unsigned)MISC_OFF + 128u, "P1 LDS map");
    LAS unsigned char* WGb = F.lds + WG_OFF; LAS unsigned char* USb = F.wave < 5 ? F.lds + US_OFF + F.wave * (2 * D * 2) : F.lds + US_HI + (F.wave - 5) * (2 * D * 2);
    const int rows_per = T / F.G;
    { const int st = (F.bid * 37) % (NG * D / NTHR);
      for (int k = 0; k < NG * D / NTHR; ++k) { const int idx = F.tid + NTHR * ((k + st) % (NG * D / NTHR)); const int d = idx / NG, g = idx % NG; *(LAS bf16_t*)(WGb + g * WGS + 2 * d) = f2bf(p.w_in[(size_t)d * INC + INM + g]); } }
    int cur_b = -1;
    float4 xpre[8];
    { const float4* x0 = (const float4*)(p.x + (size_t)(F.bid * rows_per + F.wave) * D) + F.lane;
#pragma unroll
      for (int j = 0; j < 8; ++j) xpre[j] = x0[64 * j]; }
    int it = 0;
    for (int r0 = F.bid * rows_per; r0 < (F.bid + 1) * rows_per; r0 += NWAVES, ++it) {
        const int b = r0 / S;
        if (b != cur_b) { __syncthreads();
            for (int n = F.tid; n < 2 * D; n += NTHR) { const float s = p.MOD()[(size_t)b * D6 + n]; SH[n] = n < D ? s : 1.f + s; }
            cur_b = b; __syncthreads(); }
        const int row = r0 + F.wave;
        float4 v[8]; float s = 0.f;
#pragma unroll
        for (int j = 0; j < 8; ++j) v[j] = xpre[j];
        if (r0 + NWAVES < (F.bid + 1) * rows_per) { const float4* xn = (const float4*)(p.x + (size_t)(row + NWAVES) * D) + F.lane;
#pragma unroll
            for (int j = 0; j < 8; ++j) xpre[j] = xn[64 * j]; }
#pragma unroll
        for (int j = 0; j < 8; ++j) s += (v[j].x + v[j].y) + (v[j].z + v[j].w);
        const float mean = wave_sum(s) * (1.f / D); float s2 = 0.f;
#pragma unroll
        for (int j = 0; j < 8; ++j) { v[j].x -= mean; v[j].y -= mean; v[j].z -= mean; v[j].w -= mean; s2 += (v[j].x * v[j].x + v[j].y * v[j].y) + (v[j].z * v[j].z + v[j].w * v[j].w); }
        const float rstd = 1.f / sqrtf(wave_sum(s2) * (1.f / D) + LN_EPS);
        uint2* o8 = (uint2*)(p.U() + (size_t)row * D) + F.lane; LAS u2v* us = (LAS u2v*)(USb + (it & 1) * (2 * D)) + F.lane;
#pragma unroll
        for (int j = 0; j < 8; ++j) { const int c0 = 4 * F.lane + 256 * j; const f4v sh = *(const LAS f4v*)(SH + c0), sc = *(const LAS f4v*)(SC1 + c0);
            const unsigned w0 = pk2(v[j].x * rstd * sc.x + sh.x, v[j].y * rstd * sc.y + sh.y), w1 = pk2(v[j].z * rstd * sc.z + sh.z, v[j].w * rstd * sc.w + sh.w);
            o8[64 * j] = make_uint2(w0, w1); us[64 * j] = (u2v){w0, w1}; }
        if (it & 1) {
            const unsigned lane = F.lane, r = lane & 15u, q = lane >> 4; pg8::f32x4 acc = {0.f, 0.f, 0.f, 0.f};
            const LAS unsigned char* ap = USb + (r & 1u) * (2 * D) + 16u * q; const LAS unsigned char* bp = WGb + r * WGS + 16u * q;
#pragma unroll 8
            for (int ks = 0; ks < D / 32; ++ks) acc = __builtin_amdgcn_mfma_f32_16x16x32_bf16(*(const LAS pg8::bf16x8*)(ap + 64 * ks), *(const LAS pg8::bf16x8*)(bp + 64 * ks), acc, 0, 0, 0);
            if (lane < NG) { const float bi = p.b_in[INM + lane]; const float g0 = acc[0] + bi, g1 = acc[1] + bi; const bool fg = lane & 4;
                p.GATES()[(size_t)(row - NWAVES) * NG + lane] = fg ? logsigmoidf_(g0) : g0; p.GATES()[(size_t)row * NG + lane] = fg ? logsigmoidf_(g1) : g1; } }
    }
}
__device__ __forceinline__ void phase3a(const Prm& p, const Frame& F, int b0, int nb) {
    const size_t gt = (size_t)(F.bid - b0) * NTHR + F.tid, GT = (size_t)nb * NTHR;
    for (size_t i = gt; i < (size_t)T * (CW / 8); i += GT) {
        const size_t row = i / (CW / 8); const int ch = (int)(i % (CW / 8)) * 8, s = (int)(row % S);
        float acc[8];
#pragma unroll
        for (int e = 0; e < 8; ++e) acc[e] = p.conv_b[ch + e];
#pragma unroll
        for (int k = 0; k < 3; ++k) { const int s2 = s + k - 1; if (s2 < 0 || s2 >= S) continue; const bf16_t* pr = p.PJ() + (size_t)(row + k - 1) * INM;
            const uint4 gc = *(const uint4*)(pr + O_GC + ch), hi = *(const uint4*)(pr + O_HIN + ch); const float* cw = p.conv_w + k * CW + ch;
            acc[0] += cw[0] * (bflo(gc.x) * bflo(hi.x)); acc[1] += cw[1] * (bfhi(gc.x) * bfhi(hi.x)); acc[2] += cw[2] * (bflo(gc.y) * bflo(hi.y)); acc[3] += cw[3] * (bfhi(gc.y) * bfhi(hi.y));
            acc[4] += cw[4] * (bflo(gc.z) * bflo(hi.z)); acc[5] += cw[5] * (bfhi(gc.z) * bfhi(hi.z)); acc[6] += cw[6] * (bflo(gc.w) * bflo(hi.w)); acc[7] += cw[7] * (bfhi(gc.w) * bfhi(hi.w)); }
        const uint4 gb = *(const uint4*)(p.PJ() + row * INM + O_GB + ch); uint4 o;
        o.x = pk2(bflo(gb.x) * acc[0], bfhi(gb.x) * acc[1]); o.y = pk2(bflo(gb.y) * acc[2], bfhi(gb.y) * acc[3]); o.z = pk2(bflo(gb.z) * acc[4], bfhi(gb.z) * acc[5]); o.w = pk2(bflo(gb.w) * acc[6], bfhi(gb.w) * acc[7]);
        *(uint4*)(p.Y() + row * D + ch) = o; }
}
namespace ml {
typedef short bf16x8 __attribute__((ext_vector_type(8)));
typedef short s16x4 __attribute__((ext_vector_type(4)));
typedef float f32x4 __attribute__((ext_vector_type(4)));
typedef float f32x2_t __attribute__((ext_vector_type(2)));
typedef __bf16 bf16x2_t __attribute__((ext_vector_type(2)));
typedef unsigned u32x4 __attribute__((ext_vector_type(4)));
typedef unsigned u32x2 __attribute__((ext_vector_type(2)));
constexpr unsigned IMG = 16384u, BUF = 3u * IMG, PT_OFF = 2u * BUF, PT_BYTES = 8192u, N_OFF = PT_OFF + 2u * PT_BYTES;
constexpr unsigned SCT_OFF = 149504u, SCT_BYTES = 1280u;
constexpr unsigned HT_OFF = 133120u;
static_assert(N_OFF + 1024u <= 131072u && HT_OFF + 16384u <= SCT_OFF && SCT_OFF + 3u * SCT_BYTES <= 163840u, "mLSTM LDS map");
__device__ __forceinline__ unsigned cvtpk(float lo, float hi) { f32x2_t v = {lo, hi}; bf16x2_t b = __builtin_convertvector(v, bf16x2_t); return __builtin_bit_cast(unsigned, b); }
__device__ __forceinline__ unsigned off_a(unsigned row, unsigned ch) { return 2048u * (row >> 3) + 512u * (ch >> 2) + 64u * (row & 7u) + 16u * ((ch & 3u) ^ ((row >> 2) & 3u)); }
__device__ __forceinline__ unsigned off_p(unsigned row, unsigned ch) { return 128u * row + 16u * (ch ^ (row & 7u)); }
typedef short v4i16_t __attribute__((ext_vector_type(4)));
__device__ __forceinline__ s16x4 trr(LAS unsigned char* p) { return __builtin_bit_cast(s16x4, __builtin_amdgcn_ds_read_tr16_b64_v4i16((LAS v4i16_t*)p)); }
__device__ __forceinline__ bf16x8 cat8(s16x4 a, s16x4 b) { return (bf16x8){a[0], a[1], a[2], a[3], b[0], b[1], b[2], b[3]}; }
struct CS { float decay, m_next; };
__device__ __forceinline__ CS chunk_scalars(float ig, float fg, float m, LAS float* tab, bool writer, unsigned lane) {
    const float lf = fg;
    const float bc = wave_scan_add(lf), gg = ig - bc, cm = wave_scan_max(gg);
    const float G = fmaxf(m, cm), G63 = lane_bcast(G, 63), b63 = lane_bcast(bc, 63), qs = 0.08838834764831845f;
    if (writer) { tab[lane] = __expf(fminf(G63 - G, 80.f)) * qs; tab[64 + lane] = __expf(m - G) * qs; tab[128 + lane] = __expf(-(bc + G)); tab[192 + lane] = __expf(gg - G63); }
    CS r; r.decay = __expf(m - G63); r.m_next = b63 + G63; if (writer && lane == 0u) tab[256] = r.decay;
    return r;
}
__device__ __forceinline__ void unit(const Prm& p, const Frame& F, int u) {
    static_assert(QK == 128 && MV == 256 && CHUNK == 64 && S % 64 == 0, "mLSTM unit is specialised");
    const int vhalf = u & 1, h = (u >> 1) & 3, b = (u >> 3) & 7, dir = u >> 6;
    const unsigned lane = F.lane, tid = F.tid; const int wave = F.wave; const unsigned q = lane >> 4, r = lane & 15u;
    LAS unsigned char* L = F.lds;
    const unsigned rx = (r >> 2) & 3u, rlo = 2048u * (r >> 3) + 64u * (r & 7u);
    const unsigned RA = rlo + 16u * (q ^ rx), PB1 = rlo + 16u * ((q >> 1) ^ rx) + 8u * (q & 1u), PB2 = rlo + 16u * ((2u + (q >> 1)) ^ rx) + 8u * (q & 1u);
    const unsigned pp = lane & 3u, tlo = 2048u * q + 64u * rx + 8u * (pp & 1u);
    const unsigned tb00 = tlo + 16u * ((pp >> 1) ^ ((2u * q) & 3u)), tb01 = tlo + 256u + 16u * ((pp >> 1) ^ ((2u * q + 1u) & 3u));
    const unsigned tb10 = tlo + 16u * ((2u + (pp >> 1)) ^ ((2u * q) & 3u)), tb11 = tlo + 256u + 16u * ((2u + (pp >> 1)) ^ ((2u * q + 1u) & 3u));
    const unsigned PP0 = 128u * r + 16u * (q ^ (r & 7u)), PP1 = 128u * r + 16u * ((4u + q) ^ (r & 7u));
#define ML_TRA(c, ks, t) ((((c) & 1) ? ((t) ? tb11 : tb10) : ((t) ? tb01 : tb00)) + 8192u * (ks) + 512u * ((unsigned)(c) >> 1))
    __syncthreads();
    for (unsigned i = tid; i < (2u * PT_BYTES + 1024u) / 16u; i += NTHR) *(LAS u32x4*)(L + PT_OFF + 16u * i) = (u32x4){0u, 0u, 0u, 0u};
    f32x4 C[8];
#pragma unroll
    for (int i = 0; i < 8; ++i) C[i] = (f32x4){0.f, 0.f, 0.f, 0.f};
    float m = 0.f;
    const bf16_t* pj = p.PJ(); bf16_t* H = dir ? p.HB16() : p.HF16();
    const int colq = O_Q + h * QK, colk = O_K + h * QK, colv = O_V + h * MV + vhalf * 128;
    const unsigned srow0 = tid >> 4, sch = tid & 15u;
    u32x4 rq[2], rk[2], rv[2];
    const float* gbase = p.GATES() + dir * 8 + h;
#define ML_GATES(c, ig_, fg_) do { const float* g_ = gbase + (size_t)ml_tok(dir, b, (c) * 64 + (int)lane) * NG; ig_ = g_[0]; fg_ = g_[4]; } while (0)
    float ig0, fg0, ign = 0.f, fgn = 0.f; ML_GATES(0, ig0, fg0); if (S / 64 > 1) ML_GATES(1, ign, fgn);
#define ML_TAB(c) ((LAS float*)(L + SCT_OFF + (unsigned)((c) % 3) * SCT_BYTES))
    CS cs = {0.f, 0.f}, csn = {0.f, 0.f}; if (wave == 0) { cs = chunk_scalars(ig0, fg0, m, ML_TAB(0), true, lane); csn = cs; }
    const long sMW = dir ? -(long)MW : (long)MW;
#define ML_LOAD(c) do { _Pragma("unroll") for (int i_ = 0; i_ < 2; ++i_) { const bf16_t* rp = pj + (size_t)ml_tok(dir, b, (c) * 64 + srow0 + 32 * i_) * INM + 8 * sch; \
        rq[i_] = *(const u32x4*)(rp + colq); rk[i_] = *(const u32x4*)(rp + colk); rv[i_] = *(const u32x4*)(rp + colv); } } while (0)
#define ML_STORE(buf, S_) do { _Pragma("unroll") for (int i_ = 0; i_ < 2; ++i_) { const unsigned row = srow0 + 32u * i_, o = (buf) * BUF + off_a(row, sch); const float w = (S_)[192 + row]; \
        *(LAS u32x4*)(L + o) = rq[i_]; *(LAS u32x4*)(L + IMG + o) = rk[i_]; u32x4 v = rv[i_]; \
        v.x = cvtpk(bflo(v.x) * w, bfhi(v.x) * w); v.y = cvtpk(bflo(v.y) * w, bfhi(v.y) * w); v.z = cvtpk(bflo(v.z) * w, bfhi(v.z) * w); v.w = cvtpk(bflo(v.w) * w, bfhi(v.w) * w); \
        *(LAS u32x4*)(L + 2u * IMG + o) = v; } } while (0)
    __syncthreads();
    ML_LOAD(0); ML_STORE(0u, ML_TAB(0));
    constexpr int NC = S / 64;
    for (int c = 0; c < NC; ++c) {
        const unsigned cur = (unsigned)(c & 1);
        LAS unsigned char* Qi = L + cur * BUF; LAS unsigned char* Ki = Qi + IMG; LAS unsigned char* Vi = Qi + 2u * IMG; LAS unsigned char* Pt = L + PT_OFF + cur * PT_BYTES;
        float ig2 = 0.f, fg2 = 0.f;
        if (c + 1 < NC) { ML_LOAD(c + 1); if (wave == 0) { csn = chunk_scalars(ign, fgn, cs.m_next, ML_TAB(c + 1), true, lane); if (c + 2 < NC) ML_GATES(c + 2, ig2, fg2); } }
        __syncthreads();
#define ML_FLUSH(cprev) do { _Pragma("unroll") for (int i_ = 0; i_ < 2; ++i_) { const unsigned n_ = tid + 512u * i_, row_ = n_ >> 4, ch_ = n_ & 15u;     \
            const u32x4 v_ = *(const LAS u32x4*)(L + HT_OFF + 256u * row_ + 16u * (ch_ ^ (row_ & 15u))); \
            *(u32x4*)(H + (size_t)ml_tok(dir, b, (cprev) * 64 + (int)row_) * MW + h * MV + vhalf * 128 + 8 * (int)ch_) = v_; } } while (0)
        const LAS float* sct = ML_TAB(c); const float dcy = sct[256];
        if (c > 0) ML_FLUSH(c - 1);
#ifndef ML_REP_3B
#define ML_REP_3B 1
#define ML_REP_S 1
#define ML_REP_ST 1
#define ML_REP_3A 1
#define ML_REP_DEN 1
#endif
        f32x4 acc2[4];
#pragma unroll
        for (int tt = 0; tt < 4; ++tt) acc2[tt] = (f32x4){0.f, 0.f, 0.f, 0.f};
#pragma unroll
        for (int ks = 0; ks < 4; ++ks) {
            bf16x8 qa[4];
#pragma unroll
            for (int tt = 0; tt < 4; ++tt) {
                const u32x2 lo = *(const LAS u32x2*)(Qi + PB1 + 4096u * tt + 512u * ks), hi = *(const LAS u32x2*)(Qi + PB2 + 4096u * tt + 512u * ks);
                const u32x4 aw = {lo.x, lo.y, hi.x, hi.y}; qa[tt] = __builtin_bit_cast(bf16x8, aw); }
            const f32x4 c0 = C[2 * ks], c1 = C[2 * ks + 1];
            const u32x4 bw = {cvtpk(c0[0], c0[1]), cvtpk(c0[2], c0[3]), cvtpk(c1[0], c1[1]), cvtpk(c1[2], c1[3])}; const bf16x8 bfr = __builtin_bit_cast(bf16x8, bw);
#pragma unroll
            for (int tt = 0; tt < 4; ++tt) acc2[tt] = __builtin_amdgcn_mfma_f32_16x16x32_bf16(qa[tt], bfr, acc2[tt], 0, 0, 0);
        }
        bf16x8 vB[2];
#pragma unroll
        for (int ks = 0; ks < 2; ++ks) vB[ks] = cat8(trr(Vi + ML_TRA(wave, ks, 0)), trr(Vi + ML_TRA(wave, ks, 1)));
#pragma unroll
        for (int dt = 0; dt < 8; ++dt) C[dt] = C[dt] * dcy;
#pragma unroll
        for (int ks = 0; ks < 2; ++ks)
#pragma unroll
            for (int dh = 0; dh < 2; ++dh) { bf16x8 kA[4];
#pragma unroll
                for (int d4 = 0; d4 < 4; ++d4) kA[d4] = cat8(trr(Ki + ML_TRA(4 * dh + d4, ks, 0)), trr(Ki + ML_TRA(4 * dh + d4, ks, 1)));
#pragma unroll
                for (int d4 = 0; d4 < 4; ++d4) C[4 * dh + d4] = __builtin_amdgcn_mfma_f32_16x16x32_bf16(kA[d4], vB[ks], C[4 * dh + d4], 0, 0, 0); }
#pragma unroll
        for (int rep = 0; rep < 2; ++rep) { const int idx = wave + (rep ? 2 : 0);
            if (rep == 0 || wave >= 6) { const int tt = idx >= 6 ? 3 : (idx >= 3 ? 2 : (idx >= 1 ? 1 : 0)), st = idx - tt * (tt + 1) / 2;
                f32x4 sa = (f32x4){0.f, 0.f, 0.f, 0.f};
#pragma unroll
                for (int kh = 0; kh < 2; ++kh) { bf16x8 af[2], bfk[2];
#pragma unroll
                    for (int k2 = 0; k2 < 2; ++k2) { af[k2] = *(const LAS bf16x8*)(Qi + RA + 4096u * tt + 512u * (2 * kh + k2)); bfk[k2] = *(const LAS bf16x8*)(Ki + RA + 4096u * st + 512u * (2 * kh + k2)); }
#pragma unroll
                    for (int k2 = 0; k2 < 2; ++k2) sa = __builtin_amdgcn_mfma_f32_16x16x32_bf16(af[k2], bfk[k2], sa, 0, 0, 0); }
                const unsigned scol = 16u * st + r;
#pragma unroll
                for (int i = 0; i < 4; ++i) { const unsigned trow = 16u * tt + 4u * q + i; const float v = scol <= trow ? sa[i] : 0.f;
                    *(LAS bf16_t*)(Pt + off_p(trow, scol >> 3) + 2u * (scol & 7u)) = (bf16_t)cvtpk(v, 0.f); } } }
        if (c + 1 < NC) ML_STORE(cur ^ 1u, ML_TAB(c + 1));
        __syncthreads();
        { bf16x8 pf[6];
#pragma unroll
          for (int tt = 0; tt < 4; ++tt) { pf[tt] = *(const LAS bf16x8*)(Pt + PP0 + 2048u * tt); if (tt >= 2) pf[2 + tt] = *(const LAS bf16x8*)(Pt + PP1 + 2048u * tt); }
#pragma unroll
          for (int tt = 0; tt < 4; ++tt) { const f32x4 av4 = *(const LAS f32x4*)(sct + 16 * tt + 4 * q), bv4 = *(const LAS f32x4*)(sct + 64 + 16 * tt + 4 * q); f32x4 a1 = __builtin_amdgcn_mfma_f32_16x16x32_bf16(pf[tt], vB[0], (f32x4){0.f, 0.f, 0.f, 0.f}, 0, 0, 0);
            if (tt >= 2) a1 = __builtin_amdgcn_mfma_f32_16x16x32_bf16(pf[2 + tt], vB[1], a1, 0, 0, 0);
#pragma unroll
            for (int i = 0; i < 4; ++i) { const unsigned t = 16u * tt + 4u * q + i, col = 16u * (unsigned)wave + r;
                *(LAS bf16_t*)(L + HT_OFF + 256u * t + 16u * ((col >> 3) ^ (t & 15u)) + 2u * (col & 7u)) = (bf16_t)cvtpk(av4[i] * a1[i] + bv4[i] * acc2[tt][i], 0.f); } } }
        if (vhalf == 0) {
            const LAS float* n_old = (const LAS float*)(L + N_OFF + cur * 512u); LAS float* n_new = (LAS float*)(L + N_OFF + (cur ^ 1u) * 512u);
            bf16x8 wB[2];
#pragma unroll
            for (int ks = 0; ks < 2; ++ks) { const f32x4 w0 = *(const LAS f32x4*)(sct + 192 + 32 * ks + 8 * q), w1 = *(const LAS f32x4*)(sct + 192 + 32 * ks + 8 * q + 4);
                u32x4 w = {cvtpk(w0[0], w0[1]), cvtpk(w0[2], w0[3]), cvtpk(w1[0], w1[1]), cvtpk(w1[2], w1[3])};
                if (r != 0u) w = (u32x4){0u, 0u, 0u, 0u}; wB[ks] = __builtin_bit_cast(bf16x8, w); }
            const size_t dbase = ((size_t)dir * T) * MH + h;
            if (wave < 4) { const int tt = wave; f32x4 d2 = (f32x4){0.f, 0.f, 0.f, 0.f};
#pragma unroll
                for (int ks = 0; ks < 4; ++ks) { const f32x4 n0 = *(const LAS f32x4*)(n_old + 32 * ks + 4 * q), n1 = *(const LAS f32x4*)(n_old + 32 * ks + 16 + 4 * q);
                    u32x4 bw = {cvtpk(n0[0], n0[1]), cvtpk(n0[2], n0[3]), cvtpk(n1[0], n1[1]), cvtpk(n1[2], n1[3])}; if (r != 0u) bw = (u32x4){0u, 0u, 0u, 0u};
                    const u32x2 lo = *(const LAS u32x2*)(Qi + PB1 + 4096u * tt + 512u * ks), hi = *(const LAS u32x2*)(Qi + PB2 + 4096u * tt + 512u * ks);
                    const u32x4 aw = {lo.x, lo.y, hi.x, hi.y};
                    d2 = __builtin_amdgcn_mfma_f32_16x16x32_bf16(__builtin_bit_cast(bf16x8, aw), __builtin_bit_cast(bf16x8, bw), d2, 0, 0, 0); }
#pragma unroll
                for (int i = 0; i < 4; ++i) { const int t = 16 * tt + 4 * (int)q + i; const float bv = sct[64 + t], fl = sct[128 + t];
                    if (r == 0u) { const size_t di = dbase + (size_t)ml_tok(dir, b, c * 64 + t) * MH; p.DEN()[(size_t)2 * T * MH + di] = bv * d2[i]; p.FLR()[di] = fl; } }
            } else { const int tt = wave - 4; f32x4 d1 = (f32x4){0.f, 0.f, 0.f, 0.f};
#pragma unroll
                for (int ks = 0; ks < 2; ++ks) if (ks == 0 || tt >= 2) { const bf16x8 pf = *(const LAS bf16x8*)(Pt + (ks ? PP1 : PP0) + 2048u * tt);
                    d1 = __builtin_amdgcn_mfma_f32_16x16x32_bf16(pf, wB[ks], d1, 0, 0, 0); }
#pragma unroll
                for (int i = 0; i < 4; ++i) { const int t = 16 * tt + 4 * (int)q + i; const float av = sct[t];
                    if (r == 0u) p.DEN()[dbase + (size_t)ml_tok(dir, b, c * 64 + t) * MH] = av * d1[i]; } }
            { const int dt = wave; f32x4 nn = *(const LAS f32x4*)(n_old + 16 * dt + 4 * q) * dcy; if (r != 0u) nn = (f32x4){0.f, 0.f, 0.f, 0.f};
#pragma unroll
                for (int ks = 0; ks < 2; ++ks) { const bf16x8 kA = cat8(trr(Ki + ML_TRA(dt, ks, 0)), trr(Ki + ML_TRA(dt, ks, 1)));
                    nn = __builtin_amdgcn_mfma_f32_16x16x32_bf16(kA, wB[ks], nn, 0, 0, 0); }
                if (r == 0u) *(LAS f32x4*)(n_new + 16 * dt + 4 * q) = nn; }
        }
        m = cs.m_next; cs = csn; ign = ig2; fgn = fg2;
    }
    __syncthreads(); ML_FLUSH(NC - 1);
#undef ML_FLUSH
#undef ML_TRA
#undef ML_TABLE
#undef ML_LOAD
#undef ML_GATES
#undef ML_STORE
}
}
__device__ __forceinline__ void phase4(const Prm& p, const Frame& F) {
    static_assert(MV == 256 && MH == 4, "head j = float4 slot j of the lane");
    const int gw = F.bid * NWAVES + F.wave, NGW = F.G * NWAVES;
    for (int row = gw; row < T; row += NGW) {
        const uint2* hf = (const uint2*)(p.HF16() + (size_t)row * MW) + F.lane; const uint2* hb = (const uint2*)(p.HB16() + (size_t)row * MW) + F.lane;
        const uint2* og = (const uint2*)(p.PJ() + (size_t)row * INM + O_O) + F.lane; uint2* yo = (uint2*)(p.Y() + (size_t)row * D + CW) + F.lane;
#pragma unroll
        for (int j = 0; j < MH; ++j) {
            const float* d2 = p.DEN() + (size_t)2 * T * MH;
            const float i_f = 1.f / fmaxf(fabsf(p.DEN()[(size_t)row * MH + j] + d2[(size_t)row * MH + j]), p.FLR()[(size_t)row * MH + j]);
            const float i_b = 1.f / fmaxf(fabsf(p.DEN()[((size_t)T + row) * MH + j] + d2[((size_t)T + row) * MH + j]), p.FLR()[((size_t)T + row) * MH + j]);
            const uint2 a = hf[64 * j], b = hb[64 * j]; float4 h = make_float4(bflo(a.x) * i_f + bflo(b.x) * i_b, bfhi(a.x) * i_f + bfhi(b.x) * i_b, bflo(a.y) * i_f + bflo(b.y) * i_b, bfhi(a.y) * i_f + bfhi(b.y) * i_b);
            const float mean = wave_sum((h.x + h.y) + (h.z + h.w)) * (1.f / MV);
            h.x -= mean; h.y -= mean; h.z -= mean; h.w -= mean;
            const float rstd = 1.f / sqrtf(wave_sum((h.x * h.x + h.y * h.y) + (h.z * h.z + h.w * h.w)) * (1.f / MV) + LN_EPS);
            const float4 nw = *((const float4*)(p.mnorm_w + j * MV) + F.lane); const uint2 o = og[64 * j];
            yo[64 * j] = make_uint2(pk2(h.x * rstd * nw.x * sigmoidf_(bflo(o.x)), h.y * rstd * nw.y * sigmoidf_(bfhi(o.x))), pk2(h.z * rstd * nw.z * sigmoidf_(bflo(o.y)), h.w * rstd * nw.w * sigmoidf_(bfhi(o.y)))); }
    }
}
struct EpiZ {
    static constexpr bool PERM = true, AFTER_DRAIN = false;
    const float* x; const float* mod; bf16_t* out;
    __device__ __forceinline__ void operator()(const pg8::f32x4 (&acc)[2][2][4][2], const pg8::Unit& u, int wr, int wc, int fr, int fq) const {
        const int col0 = u.pn * 256 + wc * 32 + 8 * fq;
#pragma unroll
        for (int ai = 0; ai < 2; ++ai)
#pragma unroll
            for (int m = 0; m < 4; ++m) { const int row = u.pm * 256 + ai * 128 + wr * 64 + m * 16 + fr; const float* g1 = mod + (size_t)(row / S) * D6 + 2 * D; const size_t off = (size_t)row * D + col0;
#pragma unroll
                for (int bj = 0; bj < 2; ++bj) { const int c = bj * 128;
                    const pg8::f32x4 x0 = *(const pg8::f32x4*)(x + off + c), x1 = *(const pg8::f32x4*)(x + off + c + 4), g0 = *(const pg8::f32x4*)(g1 + col0 + c), g1v = *(const pg8::f32x4*)(g1 + col0 + c + 4);
                    const pg8::f32x4 z0 = x0 * ALPHA + g0 * acc[ai][bj][m][0], z1 = x1 * ALPHA + g1v * acc[ai][bj][m][1];
                    u32x4_t w = {pk2(z0[0], z0[1]), pk2(z0[2], z0[3]), pk2(z1[0], z1[1]), pk2(z1[2], z1[3])}; *(u32x4_t*)(out + off + c) = w; } }
    }
};

struct EpiF32 {
    static constexpr bool PERM = true, AFTER_DRAIN = false;
    float* out; int ldc;
    __device__ __forceinline__ void operator()(const pg8::f32x4 (&acc)[2][2][4][2], const pg8::Unit& u, int wr, int wc, int fr, int fq) const {
        const int col0 = u.pn * 256 + wc * 32 + 8 * fq;
#pragma unroll
        for (int ai = 0; ai < 2; ++ai)
#pragma unroll
            for (int m = 0; m < 4; ++m) { float* rowp = out + (size_t)(u.pm * 256 + ai * 128 + wr * 64 + m * 16 + fr) * ldc + col0;
#pragma unroll
                for (int bj = 0; bj < 2; ++bj) { *(pg8::f32x4*)(rowp + bj * 128) = acc[ai][bj][m][0]; *(pg8::f32x4*)(rowp + bj * 128 + 4) = acc[ai][bj][m][1]; } }
    }
};
__device__ __forceinline__ unsigned skey(float f) { const unsigned u = f_as_u(f); return (u & 0x80000000u) ? ~u : (u | 0x80000000u); }
__device__ __forceinline__ float unskey(unsigned k) { return u_as_f((k & 0x80000000u) ? (k & 0x7fffffffu) : ~k); }
__device__ __forceinline__ void tk_cx(unsigned& a, unsigned& b) { const unsigned hi = a > b ? a : b, lo = a > b ? b : a; a = hi; b = lo; }
__device__ __forceinline__ void tk_sort16(unsigned (&v)[16]) {
#pragma unroll
    for (int k = 2; k <= 16; k <<= 1)
#pragma unroll
        for (int j = k >> 1; j >= 1; j >>= 1)
#pragma unroll
            for (int i = 0; i < 16; ++i) { const int l = i ^ j; if (l > i) { if ((i & k) == 0) tk_cx(v[i], v[l]); else tk_cx(v[l], v[i]); } }
}
__device__ __forceinline__ void tk_merge16(unsigned (&L)[16], const unsigned (&C)[16]) {
#pragma unroll
    for (int i = 0; i < 16; ++i) L[i] = L[i] > C[15 - i] ? L[i] : C[15 - i];
#pragma unroll
    for (int j = 8; j >= 1; j >>= 1)
#pragma unroll
        for (int i = 0; i < 16; ++i) { const int l = i ^ j; if (l > i) tk_cx(L[i], L[l]); }
}
__device__ __forceinline__ void tk_top16(const float* sc, unsigned (&L)[16]) {
#pragma unroll 1
    for (int ch = 0; ch < NK / 16; ++ch) { unsigned C[16];
#pragma unroll
        for (int q4 = 0; q4 < 4; ++q4) { const float4 v = ((const float4*)sc)[4 * ch + q4]; const unsigned b = 127u - 16u * ch - 4u * q4;
            C[4 * q4] = (skey(v.x) & ~0x7fu) | b; C[4 * q4 + 1] = (skey(v.y) & ~0x7fu) | (b - 1); C[4 * q4 + 2] = (skey(v.z) & ~0x7fu) | (b - 2); C[4 * q4 + 3] = (skey(v.w) & ~0x7fu) | (b - 3); }
        tk_sort16(C);
        if (ch == 0) {
#pragma unroll
            for (int i = 0; i < 16; ++i) L[i] = C[i]; }
        else tk_merge16(L, C); }
}
__device__ __forceinline__ void phase8(const Prm& p, const Frame& F) {
    static_assert(NK == 128 && TOPK == 16, "top-k phase is specialised");
    const long gt = (long)F.bid * NTHR + F.tid, GT = (long)F.G * NTHR;
    LAS unsigned* ix = (LAS unsigned*)F.lds + F.tid;
    for (long i = gt; i < (long)T * PH; i += GT) {
        unsigned A[16], B[16];
        tk_top16(p.SC() + (size_t)i * 2 * NK, A); tk_top16(p.SC() + (size_t)i * 2 * NK + NK, B);
        float sa[16], sb[16];
#pragma unroll
        for (int k = 0; k < 16; ++k) { sa[k] = unskey(A[k] & ~0x7fu); sb[k] = unskey(B[k] & ~0x7fu); ix[NTHR * k] = 127u - (A[k] & 0x7fu); ix[NTHR * (16 + k)] = 127u - (B[k] & 0x7fu); }
        unsigned L[16], C[16]; int n = 0;
#pragma unroll
        for (int a = 0; a < 16; ++a)
#pragma unroll
            for (int b = 0; b < 16; ++b) if ((a + 1) * (b + 1) <= 16) { const unsigned key = (skey(sa[a] + sb[b]) & ~0xffu) | (unsigned)(255 - (16 * a + b));
                C[n & 15] = key; ++n;
                if ((n & 15) == 0 || n == 50) { if (n == 50) {
#pragma unroll
                        for (int z = 2; z < 16; ++z) C[z] = 0u; }
                    tk_sort16(C);
                    if (n == 16) {
#pragma unroll
                        for (int z = 0; z < 16; ++z) L[z] = C[z]; }
                    else tk_merge16(L, C); } }
        float V[16]; float sum = 0.f; const float vmax = unskey(L[0] & ~0xffu);
#pragma unroll
        for (int r = 0; r < 16; ++r) { V[r] = __expf(unskey(L[r] & ~0xffu) - vmax); sum += V[r]; }
        const float inv = 1.f / sum; int E[16];
#pragma unroll
        for (int r = 0; r < 16; ++r) { const unsigned fl = 255u - (L[r] & 0xffu); E[r] = (int)(ix[NTHR * (fl >> 4)] * NK + ix[NTHR * (16 + (fl & 15u))]); }
#pragma unroll
        for (int r = 0; r < 16; r += 4) { *(int4*)(p.EIDX() + (size_t)i * TOPK + r) = make_int4(E[r], E[r + 1], E[r + 2], E[r + 3]);
            *(float4*)(p.EW() + (size_t)i * TOPK + r) = make_float4(V[r] * inv, V[r + 1] * inv, V[r + 2] * inv, V[r + 3] * inv); }
    }
}
__device__ __forceinline__ void phase6(const Prm& p, const Frame& F) {
    LAS float* PW = (LAS float*)F.lds; LAS float* PB = PW + D; LAS float* PSH = PW + 2 * D; LAS float* PSC = PW + 3 * D;
    const int rows_per = T / F.G, r_begin = F.bid * rows_per, r_end = r_begin + rows_per;
    int cur_b = -1;
    for (int i = F.tid; i < D; i += NTHR) { PW[i] = p.ln1_w[i]; PB[i] = p.ln1_b[i]; }
    float4 v[8]; uint2 zb[8], zn[8];
    { const uint2* z0 = (const uint2*)((const bf16_t*)p.out + (size_t)(r_begin + F.wave) * D) + F.lane;
#pragma unroll
      for (int j = 0; j < 8; ++j) zb[j] = z0[64 * j]; }
    for (int r0 = r_begin; r0 < r_end; r0 += NWAVES) {
        const int row = r0 + F.wave, b = r0 / S;
        if (b != cur_b) { __syncthreads(); const float* mod = p.MOD() + (size_t)b * D6;
            for (int i = F.tid; i < D; i += NTHR) { PSH[i] = mod[3 * D + i]; PSC[i] = 1.f + mod[4 * D + i]; }
            cur_b = b; __syncthreads(); }
        uint2* x1r = (uint2*)(p.X1B() + (size_t)row * D) + F.lane;
        float s = 0.f;
        if (r0 + NWAVES < r_end) { const uint2* zp = (const uint2*)((const bf16_t*)p.out + (size_t)(row + NWAVES) * D) + F.lane;
#pragma unroll
            for (int j = 0; j < 8; ++j) zn[j] = zp[64 * j]; }
#pragma unroll
        for (int j = 0; j < 8; ++j) { v[j] = make_float4(bflo(zb[j].x), bfhi(zb[j].x), bflo(zb[j].y), bfhi(zb[j].y)); s += (v[j].x + v[j].y) + (v[j].z + v[j].w); }
        float mean = wave_sum(s) * (1.f / D), s2 = 0.f;
#pragma unroll
        for (int j = 0; j < 8; ++j) { v[j].x -= mean; v[j].y -= mean; v[j].z -= mean; v[j].w -= mean; s2 += (v[j].x * v[j].x + v[j].y * v[j].y) + (v[j].z * v[j].z + v[j].w * v[j].w); }
        float rstd = 1.f / sqrtf(wave_sum(s2) * (1.f / D) + LN_EPS); s = 0.f;
#pragma unroll
        for (int j = 0; j < 8; ++j) { const f4v w = *(const LAS f4v*)(PW + 4 * F.lane + 256 * j), bb = *(const LAS f4v*)(PB + 4 * F.lane + 256 * j);
            v[j].x = v[j].x * rstd * w[0] + bb[0]; v[j].y = v[j].y * rstd * w[1] + bb[1]; v[j].z = v[j].z * rstd * w[2] + bb[2]; v[j].w = v[j].w * rstd * w[3] + bb[3];
            x1r[64 * j] = make_uint2(pk2(v[j].x, v[j].y), pk2(v[j].z, v[j].w)); s += (v[j].x + v[j].y) + (v[j].z + v[j].w); }
        mean = wave_sum(s) * (1.f / D); s2 = 0.f;
#pragma unroll
        for (int j = 0; j < 8; ++j) { v[j].x -= mean; v[j].y -= mean; v[j].z -= mean; v[j].w -= mean; s2 += (v[j].x * v[j].x + v[j].y * v[j].y) + (v[j].z * v[j].z + v[j].w * v[j].w); }
        rstd = 1.f / sqrtf(wave_sum(s2) * (1.f / D) + LN_EPS);
        uint2* o8 = (uint2*)(p.U() + (size_t)row * D) + F.lane;
#pragma unroll
        for (int j = 0; j < 8; ++j) { const f4v sh = *(const LAS f4v*)(PSH + 4 * F.lane + 256 * j), sc = *(const LAS f4v*)(PSC + 4 * F.lane + 256 * j);
            o8[64 * j] = make_uint2(pk2(v[j].x * rstd * sc[0] + sh[0], v[j].y * rstd * sc[1] + sh[1]), pk2(v[j].z * rstd * sc[2] + sh[2], v[j].w * rstd * sc[3] + sh[3])); }
#pragma unroll
        for (int j = 0; j < 8; ++j) zb[j] = zn[j];
    }
}
struct XW { int vx, nx, rank, nloc; };
constexpr int NDS = 16, DSW = D / NDS;
typedef float f2v __attribute__((ext_vector_type(2)));
struct Row8 { uint4 r[8]; };
__device__ __forceinline__ void gather8(Row8& g, const unsigned char* tbu, unsigned loff, int ereg, int pg) {
#pragma unroll
    for (int k = 0; k < 8; ++k) { const unsigned e = (unsigned)__shfl(ereg, 8 * k + pg); g.r[k] = *(const uint4*)(tbu + (((size_t)e << 11) | loff)); }
}
#define PEER_CVT8(a) const f2v c0 = __builtin_amdgcn_cvt_pk_f32_fp8((a).x, false), c1 = __builtin_amdgcn_cvt_pk_f32_fp8((a).x, true), c2 = __builtin_amdgcn_cvt_pk_f32_fp8((a).y, false), c3 = __builtin_amdgcn_cvt_pk_f32_fp8((a).y, true), \
    c4 = __builtin_amdgcn_cvt_pk_f32_fp8((a).z, false), c5 = __builtin_amdgcn_cvt_pk_f32_fp8((a).z, true), c6 = __builtin_amdgcn_cvt_pk_f32_fp8((a).w, false), c7 = __builtin_amdgcn_cvt_pk_f32_fp8((a).w, true)
typedef _Float16 h2t __attribute__((ext_vector_type(2)));
__device__ __forceinline__ float peer_dot16h(const uint4 a, const h2t* u) {
    float acc = __builtin_amdgcn_fdot2(__builtin_amdgcn_cvt_scalef32_pk_f16_fp8(a.x, 1.0f, false), u[0], 0.f, false);
    acc = __builtin_amdgcn_fdot2(__builtin_amdgcn_cvt_scalef32_pk_f16_fp8(a.x, 1.0f, true), u[1], acc, false);
    acc = __builtin_amdgcn_fdot2(__builtin_amdgcn_cvt_scalef32_pk_f16_fp8(a.y, 1.0f, false), u[2], acc, false);
    acc = __builtin_amdgcn_fdot2(__builtin_amdgcn_cvt_scalef32_pk_f16_fp8(a.y, 1.0f, true), u[3], acc, false);
    acc = __builtin_amdgcn_fdot2(__builtin_amdgcn_cvt_scalef32_pk_f16_fp8(a.z, 1.0f, false), u[4], acc, false);
    acc = __builtin_amdgcn_fdot2(__builtin_amdgcn_cvt_scalef32_pk_f16_fp8(a.z, 1.0f, true), u[5], acc, false);
    acc = __builtin_amdgcn_fdot2(__builtin_amdgcn_cvt_scalef32_pk_f16_fp8(a.w, 1.0f, false), u[6], acc, false);
    acc = __builtin_amdgcn_fdot2(__builtin_amdgcn_cvt_scalef32_pk_f16_fp8(a.w, 1.0f, true), u[7], acc, false);
    return acc;
}
__device__ __forceinline__ f2v rscatter16(const float* v, bool b0, bool b1, bool b2, int m0, int m1, int m2) {
    float r8[8], r4[4]; f2v r2;
#pragma unroll
    for (int i = 0; i < 8; ++i) { const float keep = b0 ? v[8 + i] : v[i], send = b0 ? v[i] : v[8 + i]; r8[i] = keep + __shfl_xor(send, m0); }
#pragma unroll
    for (int i = 0; i < 4; ++i) { const float keep = b1 ? r8[4 + i] : r8[i], send = b1 ? r8[i] : r8[4 + i]; r4[i] = keep + __shfl_xor(send, m1); }
    { const float k0 = b2 ? r4[2] : r4[0], s0 = b2 ? r4[0] : r4[2], k1 = b2 ? r4[3] : r4[1], s1 = b2 ? r4[1] : r4[3]; r2.x = k0 + __shfl_xor(s0, m2); r2.y = k1 + __shfl_xor(s1, m2); }
    return r2;
}
__device__ __forceinline__ void phase9(const Prm& p, const Frame& F, const XW& xw) {
    static_assert(DSW == 128 && NSLOT == 128 && D == 2048, "slice row = 8 lanes x 16 bytes");
    const int pg = F.lane >> 3, part = F.lane & 7; const bool p0 = part & 1, p1 = part & 2, p2 = part & 4;
    const int tstep = xw.nloc * NWAVES, t0 = xw.rank * NWAVES + F.wave; const int nt = t0 < T ? (T - t0 + tstep - 1) / tstep : 0;
    const unsigned loff = (unsigned)part * 16u; const int k0 = (p0 ? 8 : 0) + (p1 ? 4 : 0) + (p2 ? 2 : 0);
    for (int ds = xw.vx; ds < NDS; ds += xw.nx) {
        if (nt == 0) continue;
        const unsigned char* tbu = p.PU8() + ds * DSW; _Float16* part_out = (_Float16*)p.SC() + (size_t)ds * T * NSLOT + pg + 8 * k0;
#define UP_TOK(i) (t0 + ((i) < nt ? (i) : nt - 1) * tstep)
#define UP_LOADE(i, ea, eb) do { const int* ep_ = p.EIDX() + (size_t)UP_TOK(i) * NSLOT + F.lane; ea = ep_[0]; eb = ep_[64]; } while (0)
#define UP_LOADU(i, ua_, ub_) do { const uint4* up_ = (const uint4*)(p.U() + (size_t)UP_TOK(i) * D + ds * DSW + part * 16); ua_ = up_[0]; ub_ = up_[1]; } while (0)
        int e0a, e0b, e1a, e1b, e2a, e2b; uint4 ua, ub, una, unb;
        UP_LOADE(0, e0a, e0b); UP_LOADE(1, e1a, e1b); UP_LOADE(2, e2a, e2b); UP_LOADU(0, ua, ub);
        Row8 G0, G1, G2, G3;
        gather8(G0, tbu, loff, e0a, pg); gather8(G1, tbu, loff, e0b, pg); gather8(G2, tbu, loff, e1a, pg);
#define UP_BODY(i, GA, GB, GC, GD) do { \
            gather8(GD, tbu, loff, e1b, pg); UP_LOADU((i) + 1, una, unb); int e3a, e3b; UP_LOADE((i) + 3, e3a, e3b); \
            h2t u[8]; u[0] = (h2t){(_Float16)bflo(ua.x), (_Float16)bfhi(ua.x)}; u[1] = (h2t){(_Float16)bflo(ua.y), (_Float16)bfhi(ua.y)}; u[2] = (h2t){(_Float16)bflo(ua.z), (_Float16)bfhi(ua.z)}; u[3] = (h2t){(_Float16)bflo(ua.w), (_Float16)bfhi(ua.w)}; \
            u[4] = (h2t){(_Float16)bflo(ub.x), (_Float16)bfhi(ub.x)}; u[5] = (h2t){(_Float16)bflo(ub.y), (_Float16)bfhi(ub.y)}; u[6] = (h2t){(_Float16)bflo(ub.z), (_Float16)bfhi(ub.z)}; u[7] = (h2t){(_Float16)bflo(ub.w), (_Float16)bfhi(ub.w)}; \
            float dv[16]; \
            _Pragma("unroll") for (int k = 0; k < 8; ++k) dv[k] = peer_dot16h(GA.r[k], u); \
            gather8(GA, tbu, loff, e2a, pg); \
            _Pragma("unroll") for (int k = 0; k < 8; ++k) dv[8 + k] = peer_dot16h(GB.r[k], u); \
            const f2v r2 = rscatter16(dv, p0, p1, p2, 1, 2, 4);                          \
            if ((i) < nt) { _Float16* po = part_out + (size_t)UP_TOK(i) * NSLOT; po[0] = (_Float16)(r2.x * 0.0625f); po[8] = (_Float16)(r2.y * 0.0625f); } \
            e1a = e2a; e1b = e2b; e2a = e3a; e2b = e3b; ua = una; ub = unb; } while (0)
        for (int i = 0; i < nt; i += 2) { UP_BODY(i, G0, G1, G2, G3); UP_BODY(i + 1, G2, G3, G0, G1); }
#undef UP_BODY
#undef UP_LOADU
#undef UP_LOADE
#undef UP_TOK
    }
}
__device__ __forceinline__ void phase10(const Prm& p, const Frame& F) {
    static_assert(NE <= 16384 && NSLOT == 128 && T % 64 == 0, "14-bit expert id, 64-token groups");
    LAS unsigned* tile = (LAS unsigned*)F.lds;
    for (int tg = F.bid; tg < T / 64; tg += F.G) {
        __syncthreads();
#pragma unroll
        for (int k = 0; k < 2; ++k) { const int idx = F.tid + NTHR * k, tl = idx >> 4, so = idx & 15; const size_t i0 = ((size_t)tg * 64 + tl) * NSLOT + 8 * so;
            float sm[8];
#pragma unroll
            for (int j = 0; j < 8; ++j) sm[j] = 0.f;
#pragma unroll
            for (int ds = 0; ds < NDS; ++ds) { const uint4 q4 = *(const uint4*)((const _Float16*)p.SC() + (size_t)ds * T * NSLOT + i0);
                typedef _Float16 h2c __attribute__((ext_vector_type(2)));
                const unsigned qq[4] = {q4.x, q4.y, q4.z, q4.w};
#pragma unroll
                for (int j = 0; j < 4; ++j) { const h2c hv = __builtin_bit_cast(h2c, qq[j]); sm[2 * j] += (float)hv[0]; sm[2 * j + 1] += (float)hv[1]; } }
            const int4 ea = *(const int4*)(p.EIDX() + i0), eb = *(const int4*)(p.EIDX() + i0 + 4); const float4 ga = *(const float4*)(p.EW() + i0), gb = *(const float4*)(p.EW() + i0 + 4);
            const int ee[8] = {ea.x, ea.y, ea.z, ea.w, eb.x, eb.y, eb.z, eb.w}; const float gg[8] = {ga.x, ga.y, ga.z, ga.w, gb.x, gb.y, gb.z, gb.w};
#pragma unroll
            for (int j = 0; j < 8; ++j) { const int e = ee[j]; const _Float16 w = (_Float16)(gg[j] * gelu_exact(sm[j] * 16.f * p.RSU()[e]) * p.RSV()[e] * 256.f);
                tile[tl * 129 + 8 * so + j] = (((unsigned)__builtin_bit_cast(unsigned short, w) << 16) & 0xFFFE0000u) | ((unsigned)e << 3); } }
        __syncthreads();
        uint4* pk = (uint4*)p.EW() + (size_t)tg * 64 * (NSLOT / 4);
#pragma unroll
        for (int k = 0; k < 4; ++k) { const int j = F.tid + NTHR * k, sq = j >> 6, tl = j & 63; const LAS unsigned* tp = tile + tl * 129 + 4 * sq; pk[j] = make_uint4(tp[0], tp[1], tp[2], tp[3]); }
    }
}
__device__ __forceinline__ void phase11(const Prm& p, const Frame& F) {
    static_assert(NE * 8 <= RING_BYTES && D % 8 == 0 && NE <= 65536, "table slice fits the LDS ring");
    typedef _Float16 h2v __attribute__((ext_vector_type(2)));
    const int c0 = (F.G % 8 == 0) ? (F.bid % 8) * (F.G / 8) + F.bid / 8 : F.bid;
    for (int sidx = c0; sidx < D / 8; sidx += F.G) {
        __syncthreads();
        { const uint4* src = (const uint4*)(p.PV8S() + (size_t)sidx * NE * 8);
          for (int i = F.tid; i < NE / 2; i += NTHR) *(LAS u32x4_t*)(F.lds + 16 * i) = __builtin_bit_cast(u32x4_t, src[i]); }
        __syncthreads();
        const int ntg = (T / 64 - F.wave + NWAVES - 1) / NWAVES, nb = 8 * ntg;
        uint4 b0[4], b1[4], b2[4], b3[4];
        const int kx = (F.G % 8 == 0) ? F.bid >> 3 : F.bid, rot = kx & 3, rotb = (kx >> 2) & 7;
#define DN_TG(bi) (F.wave + ((((bi) >> 3) + rot) % ntg) * NWAVES)
#define DN_PTR(bi) ((const uint4*)p.EW() + (size_t)DN_TG(bi) * 64 * (NSLOT / 4) + ((((bi) & 7) + rotb) & 7) * 4 * 64 + F.lane)
#define DN_LOAD(B, bi) do { const int bc_ = (bi) < nb ? (bi) : nb - 1; const uint4* pk_ = DN_PTR(bc_); _Pragma("unroll") for (int k = 0; k < 4; ++k) B[k] = pk_[k * 64]; } while (0)
#define DN_ONE(v_) do { const unsigned vv_ = (v_); const _Float16 w = __builtin_bit_cast(_Float16, (unsigned short)(vv_ >> 16)); const h2v w2 = {w, w}; \
                const u2v t = *(const LAS u2v*)(F.lds + (vv_ & 0x1FFF8u)); const unsigned tx_ = t.x, ty_ = t.y; \
                a0 += __builtin_amdgcn_cvt_scalef32_pk_f16_fp8(tx_, 1.0f, false) * w2; a1 += __builtin_amdgcn_cvt_scalef32_pk_f16_fp8(tx_, 1.0f, true) * w2; \
                a2 += __builtin_amdgcn_cvt_scalef32_pk_f16_fp8(ty_, 1.0f, false) * w2; a3 += __builtin_amdgcn_cvt_scalef32_pk_f16_fp8(ty_, 1.0f, true) * w2; } while (0)
#ifndef DN_REP
#define DN_REP 0
#endif
#define DN_ACC(B) do { _Pragma("unroll") for (int k = 0; k < 4; ++k) { DN_ONE(B[k].x); DN_ONE(B[k].y); DN_ONE(B[k].z); DN_ONE(B[k].w); } asm volatile("" ::: "memory"); \
            if (DN_REP) { const h2v s0_ = a0, s1_ = a1, s2_ = a2, s3_ = a3; for (int rep_ = 0; rep_ < DN_REP; ++rep_) { _Pragma("unroll") for (int k = 0; k < 4; ++k) { DN_ONE(B[k].x); DN_ONE(B[k].y); DN_ONE(B[k].z); DN_ONE(B[k].w); } \
                asm volatile("" :: "v"(a0), "v"(a1), "v"(a2), "v"(a3) : "memory"); } a0 = s0_; a1 = s1_; a2 = s2_; a3 = s3_; } } while (0)
        DN_LOAD(b0, 0); DN_LOAD(b1, 1); DN_LOAD(b2, 2);
        for (int bi = 0; bi < nb; bi += 8) {
            h2v a0 = {0, 0}, a1 = {0, 0}, a2 = {0, 0}, a3 = {0, 0};
            DN_LOAD(b3, bi + 3); DN_ACC(b0);
            DN_LOAD(b0, bi + 4); DN_ACC(b1);
            DN_LOAD(b1, bi + 5); DN_ACC(b2);
            DN_LOAD(b2, bi + 6); DN_ACC(b3);
            DN_LOAD(b3, bi + 7); DN_ACC(b0);
            DN_LOAD(b0, bi + 8); DN_ACC(b1);
            DN_LOAD(b1, bi + 9); DN_ACC(b2);
            DN_LOAD(b2, bi + 10); DN_ACC(b3);
            const int tg = DN_TG(bi); const float us = 1.f / 256.f;
            const uint4 yv = make_uint4(pk2((float)a0[0] * us, (float)a0[1] * us), pk2((float)a1[0] * us, (float)a1[1] * us), pk2((float)a2[0] * us, (float)a2[1] * us), pk2((float)a3[0] * us, (float)a3[1] * us));
            *(uint4*)(p.Y() + ((size_t)tg * 64 + F.lane) * D + 8 * sidx) = yv;
#if defined(DN_STORE_REP)
            for (int rep_ = 0; rep_ < DN_STORE_REP; ++rep_) { asm volatile("" ::: "memory"); __builtin_nontemporal_store(__builtin_bit_cast(u32x4_t, yv), (u32x4_t*)(p.Y() + ((size_t)tg * 64 + F.lane) * D + 8 * sidx)); }
#endif
        }
#undef DN_ACC
#undef DN_ONE
#undef DN_LOAD
#undef DN_PTR
#undef DN_TG
    }
}
__device__ __forceinline__ void phase12(const Prm& p, const Frame& F) {
    LAS float* PW = (LAS float*)F.lds; LAS float* PB = PW + D; LAS float* PG = PW + 2 * D;
    const int rows_per = T / F.G, r_begin = F.bid * rows_per, r_end = r_begin + rows_per;
    int cur_b = -1;
    for (int i = F.tid; i < D; i += NTHR) { PW[i] = p.ln2_w[i]; PB[i] = p.ln2_b[i]; }
    float4 v[8]; uint2 xb[8], xn[8], yb[8], yn[8];
    { const uint2* xr = (const uint2*)(p.X1B() + (size_t)(r_begin + F.wave) * D) + F.lane; const uint2* yr = (const uint2*)(p.Y() + (size_t)(r_begin + F.wave) * D) + F.lane;
#pragma unroll
      for (int j = 0; j < 8; ++j) { xb[j] = xr[64 * j]; yb[j] = yr[64 * j]; } }
    for (int r0 = r_begin; r0 < r_end; r0 += NWAVES) {
        const int row = r0 + F.wave, b = r0 / S;
        if (b != cur_b) { __syncthreads(); const float* g2 = p.MOD() + (size_t)b * D6 + 5 * D;
            for (int i = F.tid; i < D; i += NTHR) PG[i] = g2[i];
            cur_b = b; __syncthreads(); }
        float4* zr = (float4*)(p.out + (size_t)row * D) + F.lane; float s = 0.f;
        if (r0 + NWAVES < r_end) { const uint2* xp = (const uint2*)(p.X1B() + (size_t)(row + NWAVES) * D) + F.lane; const uint2* yp = (const uint2*)(p.Y() + (size_t)(row + NWAVES) * D) + F.lane;
#pragma unroll
            for (int j = 0; j < 8; ++j) { xn[j] = xp[64 * j]; yn[j] = yp[64 * j]; } }
#pragma unroll
        for (int j = 0; j < 8; ++j) { const f4v g = *(const LAS f4v*)(PG + 4 * F.lane + 256 * j);
            v[j].x = ALPHA * bflo(xb[j].x) + g[0] * bflo(yb[j].x); v[j].y = ALPHA * bfhi(xb[j].x) + g[1] * bfhi(yb[j].x); v[j].z = ALPHA * bflo(xb[j].y) + g[2] * bflo(yb[j].y); v[j].w = ALPHA * bfhi(xb[j].y) + g[3] * bfhi(yb[j].y);
            s += (v[j].x + v[j].y) + (v[j].z + v[j].w); }
        const float mean = wave_sum(s) * (1.f / D); float s2 = 0.f;
#pragma unroll
        for (int j = 0; j < 8; ++j) { v[j].x -= mean; v[j].y -= mean; v[j].z -= mean; v[j].w -= mean; s2 += (v[j].x * v[j].x + v[j].y * v[j].y) + (v[j].z * v[j].z + v[j].w * v[j].w); }
        const float rstd = 1.f / sqrtf(wave_sum(s2) * (1.f / D) + LN_EPS);
#pragma unroll
        for (int j = 0; j < 8; ++j) { const f4v w = *(const LAS f4v*)(PW + 4 * F.lane + 256 * j), bb = *(const LAS f4v*)(PB + 4 * F.lane + 256 * j);
            zr[64 * j] = make_float4(v[j].x * rstd * w[0] + bb[0], v[j].y * rstd * w[1] + bb[1], v[j].z * rstd * w[2] + bb[2], v[j].w * rstd * w[3] + bb[3]); }
#pragma unroll
        for (int j = 0; j < 8; ++j) { xb[j] = xn[j]; yb[j] = yn[j]; }
    }
}

struct Args { const float* in[18]; float* out; unsigned char* ws; int ph_lo, ph_hi, li, pad; };
__global__ void __launch_bounds__(NTHR, 2) mk_fwd(Args args) {
    extern __shared__ __attribute__((aligned(16))) unsigned char lds_raw[];
    Frame F; F.lds = (LAS unsigned char*)lds_raw; F.tid = threadIdx.x; F.lane = F.tid & 63; F.wave = __builtin_amdgcn_readfirstlane(F.tid >> 6); F.G = gridDim.x; F.bid = blockIdx.x;
    Prm p; p.x = args.in[0]; p.c = args.in[1]; p.w_ada = args.in[2]; p.b_ada = args.in[3]; p.w_in = args.in[4]; p.b_in = args.in[5]; p.conv_w = args.in[6]; p.conv_b = args.in[7]; p.mnorm_w = args.in[8];
    p.w_out = args.in[9]; p.ln1_w = args.in[10]; p.ln1_b = args.in[11]; p.wq = args.in[12]; p.subkeys = args.in[13]; p.peer_u = args.in[14]; p.peer_v = args.in[15]; p.ln2_w = args.in[16]; p.ln2_b = args.in[17];
    p.out = args.out; p.ws = args.ws;
    volatile LAS unsigned* MISC = (volatile LAS unsigned*)(F.lds + MISC_OFF);
    for (int u = F.tid; u < (LDS_BYTES - LDSCTL_OFF) / 4; u += NTHR) ((LAS unsigned*)(F.lds + LDSCTL_OFF))[u] = 0u;
    __syncthreads();
    const int lo = args.ph_lo, hi = args.ph_hi;
    XcdBarrier bar; bar.bar = (unsigned*)(p.ws + WS_CTL) + CW_BAR + args.li * XCD_BAR_WORDS; bar.x = 0; bar.st = nullptr;
    if (hi - lo > 1) bar = xcd_barrier_post((unsigned*)(p.ws + WS_CTL) + CW_BAR + args.li * XCD_BAR_WORDS, MISC + 8);
#define IN(k) (lo <= (k) && (k) < hi)
#define SEAM(k) do { if (IN(k) && IN((k) + 1)) xcd_barrier(bar); } while (0)
    XW xw; xw.nx = (F.G % 8 == 0) ? 8 : 1; xw.vx = F.bid % xw.nx; xw.rank = F.bid / xw.nx; xw.nloc = F.G / xw.nx;
#define XW_FROM_CENSUS() do { if (hi - lo > 1) { if (F.tid == 0) { unsigned vx_ = 0u; for (unsigned j = 0; j < bar.x; ++j) vx_ += xb_ld(&bar.bar[XB_XCNT(j)]) > 0u ? 1u : 0u; MISC[11] = vx_; } __syncthreads(); \
        xw.vx = (int)MISC[11]; xw.nx = (int)MISC[9]; xw.rank = (int)MISC[10] - 1; xw.nloc = (int)MISC[8]; } } while (0)
    if (IN(0)) { phase0(p, F); deferred_prep<false, true, true>(p, F, 0, F.G); } SEAM(0);
    if (IN(1)) { phase1(p, F); } SEAM(1);
    if (IN(2)) { pg8::Gemm g{p.U(), p.WIN_T(), T, INM, D}; pg8::StaticOrder So; So.init(T, INM, F.G, F.bid);
        pg8::EpiBf16<0> E{p.PJ(), INM, p.b_in, 0, 0, 1.f};
        pg8::gemm_phase<pg8::EpiBf16<0>, pg8::StaticOrder, true, true>(F.lds, g, So, E); } SEAM(2);
    if (IN(3)) { const int nmb = F.G >= 2 ? F.G / 2 : 1;
#ifndef P3_REP_ML
#define P3_REP_ML 1
#define P3_REP_CONV 1
#endif
        if (F.bid < nmb) { for (int rep_ = 0; rep_ < P3_REP_ML; ++rep_) for (int u = F.bid; u < 2 * NB * MH * 2; u += nmb) ml::unit(p, F, u); if (F.G < 2) phase3a(p, F, 0, 1); }
        else { phase3a(p, F, nmb, F.G - nmb); deferred_prep<true, false, false>(p, F, nmb, F.G - nmb); }
        if (F.G < 2) deferred_prep<true, false, false>(p, F, 0, 1); } SEAM(3);
    if (IN(4)) { phase4(p, F); } SEAM(4);
    if (IN(5)) { pg8::Gemm g{p.Y(), p.WOUT_T(), T, D, D}; pg8::StaticOrder So; So.init(T, D, F.G, F.bid);
        EpiZ E{p.x, p.MOD(), (bf16_t*)p.out};
        pg8::gemm_phase<EpiZ, pg8::StaticOrder, true, true>(F.lds, g, So, E); } SEAM(5);
    if (IN(6)) { phase6(p, F); } SEAM(6);
    if (IN(7)) { pg8::Gemm g{p.U(), p.WQ_T(), T, NQ, D}; pg8::StaticOrder So; So.init(T, NQ, F.G, F.bid);
        EpiF32 E{p.SC(), NSC};
        pg8::gemm_phase<EpiF32, pg8::StaticOrder, true, true>(F.lds, g, So, E); } SEAM(7);
    if (IN(8)) { phase8(p, F); } SEAM(8);
    if (IN(9)) { if (lo < 9) XW_FROM_CENSUS(); phase9(p, F, xw); } SEAM(9);
    if (IN(10)) { phase10(p, F); } SEAM(10);
    if (IN(11)) { phase11(p, F); } SEAM(11);
    if (IN(12)) { phase12(p, F); }
#undef IN
#undef SEAM
}

extern "C" void kernel_launch(void* const* d_in, const int* in_sizes, int n_in, void* d_out, int out_size, void* d_ws, size_t ws_size, hipStream_t stream) {
    static int grid = 0;
    if (grid == 0) {
        if (n_in != 18 || out_size != T * D || ws_size < WS_END) { fprintf(stderr, "kernel_launch: unexpected shapes (n_in %d out %d ws %zu, need %zu)\n", n_in, out_size, ws_size, (size_t)WS_END); grid = -1; return; }
        int dev = 0, cus = 0, per_cu = 0;
        if (hipGetDevice(&dev) != hipSuccess || hipDeviceGetAttribute(&cus, hipDeviceAttributeMultiprocessorCount, dev) != hipSuccess) { grid = -1; return; }
        if (hipFuncSetAttribute((const void*)mk_fwd, hipFuncAttributeMaxDynamicSharedMemorySize, LDS_BYTES) != hipSuccess) { fprintf(stderr, "kernel_launch: hipFuncSetAttribute failed\n"); grid = -1; return; }
        if (hipOccupancyMaxActiveBlocksPerMultiprocessor(&per_cu, (const void*)mk_fwd, NTHR, LDS_BYTES) != hipSuccess || per_cu < 1) { fprintf(stderr, "kernel_launch: the occupancy query reports %d workgroups per CU for this kernel + LDS size: the grid barrier would not be legal, not launching\n", per_cu); grid = -1; return; }
        grid = cus;
        if (T % grid != 0 || (T / grid) % (2 * NWAVES) != 0) { fprintf(stderr, "kernel_launch: grid %d does not divide the rows\n", grid); grid = -1; return; }
    }
    if (grid < 0) return;
    (void)hipMemsetAsync((char*)d_ws + WS_CTL, 0, 1u << 20, stream);
    Args a{};
    for (int i = 0; i < 18; ++i) a.in[i] = (const float*)d_in[i];
    a.out = (float*)d_out; a.ws = (unsigned char*)d_ws;
#if defined(PROBE_A)
    a.ph_lo = 0; a.ph_hi = PROBE_B + 1; a.li = 0; hipLaunchKernelGGL(mk_fwd, dim3(grid), dim3(NTHR), LDS_BYTES, stream, a);
    a.ph_lo = PROBE_A; a.ph_hi = NPHASE; a.li = 1; hipLaunchKernelGGL(mk_fwd, dim3(grid), dim3(NTHR), LDS_BYTES, stream, a);
#elif MK_N_LAUNCHES == 1
    a.ph_lo = 0; a.ph_hi = NPHASE;
    hipLaunchKernelGGL(mk_fwd, dim3(grid), dim3(NTHR), LDS_BYTES, stream, a);
#else
    for (int k = 0; k < NPHASE; ++k) { a.ph_lo = k; a.ph_hi = k + 1; hipLaunchKernelGGL(mk_fwd, dim3(grid), dim3(NTHR), LDS_BYTES, stream, a); }
#endif
}
```

```cpp
#define MK_N_LAUNCHES 1
#if defined(HOST_EMU)
#include <cmath>
#include <cstdint>
#include <cstring>
#include <cstddef>
#define HD inline
#define HDF inline
#else
#include <hip/hip_runtime.h>
#define HD __host__ __device__ __forceinline__
#define HDF __host__ __device__ __forceinline__
#endif

#ifndef CFG_D
#define CFG_D 2048
#define CFG_B 8
#define CFG_S 2048
#define CFG_PH 8
#define CFG_NK 128
#define CFG_TOPK 16
#define CFG_KD 256
#endif
constexpr int D = CFG_D, NB = CFG_B, S = CFG_S, T = NB * S;
constexpr int CW = D / 2, MW = D - CW, MH = 4, MV = MW / MH, QK = MV / 2, NG = 16, CHUNK = 64;
constexpr int INC = 3 * CW + 2 * MH * QK + 2 * MW + NG;
constexpr int INM = INC - NG;
constexpr int O_GB = 0, O_GC = CW, O_HIN = 2 * CW, O_Q = 3 * CW, O_K = O_Q + MH * QK, O_V = O_K + MH * QK, O_O = O_V + MW;
constexpr int PH = CFG_PH, NK = CFG_NK, TOPK = CFG_TOPK, KD = CFG_KD, KH = KD / 2, NE = NK * NK, NSLOT = PH * TOPK;
constexpr int NQ = PH * KD;
static_assert(PH * 2 * NK == NQ || true, "");
constexpr int NSC = PH * 2 * NK;
constexpr float LN_EPS = 1e-5f;
constexpr float ALPHA = 1.189207115002721f;
constexpr int D6 = 6 * D;

typedef unsigned short bf16_t;
HDF unsigned f_as_u(float f) { unsigned u; memcpy(&u, &f, 4); return u; }
HDF float u_as_f(unsigned u) { float f; memcpy(&f, &u, 4); return f; }
HDF bf16_t f2bf(float f) { unsigned u = f_as_u(f); return (bf16_t)((u + 0x7fffu + ((u >> 16) & 1u)) >> 16); }
HDF float bf2f(bf16_t h) { return u_as_f((unsigned)h << 16); }

constexpr size_t al(size_t x) { return (x + 1048575) & ~(size_t)1048575; }
constexpr size_t WS_CTL = 0;
constexpr size_t WS_MOD = al(1);
constexpr size_t WS_MODP = WS_MOD + al((size_t)NB * D6 * 4);
constexpr int NKS = 32;
constexpr size_t WS_GATES = WS_MODP + al((size_t)NKS * NB * D6 * 4);
constexpr size_t WS_DEN = WS_GATES + al((size_t)T * NG * 4);
constexpr size_t WS_FLR = WS_DEN + al((size_t)4 * T * MH * 4);
constexpr size_t WS_EIDX = WS_FLR + al((size_t)2 * T * MH * 4);
constexpr size_t WS_EW = WS_EIDX + al((size_t)T * NSLOT * 4);
constexpr size_t WS_WIN_T = WS_EW + al((size_t)T * NSLOT * 4);
constexpr size_t WS_WOUT_T = WS_WIN_T + al((size_t)INM * D * 2);
constexpr size_t WS_WQ_T = WS_WOUT_T + al((size_t)D * D * 2);
constexpr size_t WS_PU16 = WS_WQ_T + al((size_t)NQ * D * 2);
constexpr size_t WS_PV16 = WS_PU16 + al((size_t)NE * D * 2);
constexpr size_t WS_U = WS_PV16 + al((size_t)NE * D * 2);
constexpr size_t WS_Y = WS_U + al((size_t)T * D * 2);
constexpr size_t WS_P = WS_Y + al((size_t)T * D * 2);
constexpr size_t WS_SC = WS_P;
constexpr size_t WS_TS = WS_SC + al((size_t)T * NSC * 4);
constexpr size_t WS_TI = WS_TS + al((size_t)T * PH * 2 * TOPK * 4);
constexpr size_t WS_P_END = WS_P + al((size_t)T * INM * 2);
constexpr size_t WS_TI_END = WS_TI + al((size_t)T * PH * 2 * TOPK * 4);
constexpr size_t WS_END = WS_P_END > WS_TI_END ? WS_P_END : WS_TI_END;

struct Prm {
    const float *x, *c, *w_ada, *b_ada, *w_in, *b_in, *conv_w, *conv_b, *mnorm_w, *w_out, *ln1_w, *ln1_b, *wq, *subkeys, *peer_u, *peer_v, *ln2_w, *ln2_b;
    float* out;
    unsigned char* ws;
    HDF float* MOD() const { return (float*)(ws + WS_MOD); }
    HDF float* MODP() const { return (float*)(ws + WS_MODP); }
    HDF float* BIN256() const { return (float*)(ws + WS_MODP); }
    HDF float* GATES() const { return (float*)(ws + WS_GATES); }
    HDF float* DEN() const { return (float*)(ws + WS_DEN); }
    HDF float* FLR() const { return (float*)(ws + WS_FLR); }
    HDF int* EIDX() const { return (int*)(ws + WS_EIDX); }
    HDF float* EW() const { return (float*)(ws + WS_EW); }
    HDF bf16_t* WIN_T() const { return (bf16_t*)(ws + WS_WIN_T); }
    HDF unsigned char* WIN8() const { return ws + WS_WIN_T; }
    HDF unsigned char* U8() const { return ws + WS_U; }
    HDF bf16_t* WOUT_T() const { return (bf16_t*)(ws + WS_WOUT_T); }
    HDF bf16_t* WQ_T() const { return (bf16_t*)(ws + WS_WQ_T); }
    HDF bf16_t* PU16() const { return (bf16_t*)(ws + WS_PU16); }
    HDF bf16_t* PV16() const { return (bf16_t*)(ws + WS_PV16); }
    HDF unsigned char* PU8() const { return ws + WS_PU16; }
    HDF unsigned char* PV8() const { return ws + WS_PV16; }
    HDF unsigned char* PU4() const { return ws + WS_PU16; }
    HDF unsigned char* U2F8() const { return ws + WS_PV16 + (size_t)NE * D; }
    HDF unsigned char* PV8S() const { return ws + WS_PV16; }
    HDF float* RSU() const { return (float*)(ws + WS_PU16 + (size_t)NE * D); }
    HDF float* RSV() const { return (float*)(ws + WS_PU16 + (size_t)NE * D + (size_t)NE * 4); }
    HDF bf16_t* U() const { return (bf16_t*)(ws + WS_U); }
    HDF bf16_t* Y() const { return (bf16_t*)(ws + WS_Y); }
    HDF bf16_t* PJ() const { return (bf16_t*)(ws + WS_P); }
    HDF float* SC() const { return (float*)(ws + WS_SC); }
    HDF bf16_t* X1B() const { return (bf16_t*)(ws + WS_TS); }
    HDF float* TS() const { return (float*)(ws + WS_TS); }
    HDF int* TI() const { return (int*)(ws + WS_TI); }
    HDF float* HF() const { return out; }
    HDF float* HB() const { return out + (size_t)T * MW; }
    HDF bf16_t* HF16() const { return (bf16_t*)out; }
    HDF bf16_t* HB16() const { return (bf16_t*)out + (size_t)T * MW; }
};

HDF float sigmoidf_(float x) { return 1.f / (1.f + expf(-x)); }
HDF float logsigmoidf_(float x) { return fminf(x, 0.f) - log1pf(expf(-fabsf(x))); }
HDF float gelu_exact(float x) { return 0.5f * x * (1.f + erff(x * 0.7071067811865476f)); }

HD void b_ada(const Prm& p, long n) {
    float acc[NB];
#pragma unroll
    for (int b = 0; b < NB; ++b) acc[b] = 0.f;
    for (int k = 0; k < D; ++k) {
        const float w = p.w_ada[(size_t)k * D6 + n];
#pragma unroll
        for (int b = 0; b < NB; ++b) { const float cv = p.c[b * D + k]; acc[b] += cv * sigmoidf_(cv) * w; }
    }
#pragma unroll
    for (int b = 0; b < NB; ++b) p.MOD()[(size_t)b * D6 + n] = acc[b] + p.b_ada[n];
}
HD void b_wt(const float* W, int ldw, int K, bf16_t* WT, long i) { const long n = i / K, k = i % K; WT[i] = f2bf(W[(size_t)k * ldw + n]); }
HD void b_tab(const float* src, bf16_t* dst, long i) { dst[i] = f2bf(src[i]); }
HD void b_ln_mod1(const Prm& p, long row) {
    const float* xr = p.x + (size_t)row * D; const int b = (int)(row / S);
    const float* sh = p.MOD() + (size_t)b * D6; const float* sc = sh + D;
    float s = 0.f; for (int d = 0; d < D; ++d) s += xr[d];
    const float mean = s / D; float q = 0.f; for (int d = 0; d < D; ++d) { const float t = xr[d] - mean; q += t * t; }
    const float rstd = 1.f / sqrtf(q / D + LN_EPS);
    for (int d = 0; d < D; ++d) p.U()[(size_t)row * D + d] = f2bf((xr[d] - mean) * rstd * (1.f + sc[d]) + sh[d]);
}
HD void b_gates(const Prm& p, long i) {
    const long row = i / NG; const int g = (int)(i % NG); float acc = 0.f;
    for (int d = 0; d < D; ++d) acc += bf2f(p.U()[(size_t)row * D + d]) * p.w_in[(size_t)d * INC + INM + g];
    p.GATES()[i] = acc + p.b_in[INM + g];
}
HD float b_dot16(const bf16_t* a, const bf16_t* b, int K) { float acc = 0.f; for (int k = 0; k < K; ++k) acc += bf2f(a[k]) * bf2f(b[k]); return acc; }
HD void b_gemm1(const Prm& p, long i) { const long row = i / INM; const int n = (int)(i % INM);
    p.PJ()[i] = f2bf(b_dot16(p.U() + (size_t)row * D, p.WIN_T() + (size_t)n * D, D) + p.b_in[n]); }
HD void b_conv(const Prm& p, long i) {
    const long row = i / CW; const int ch = (int)(i % CW); const int s = (int)(row % S);
    const bf16_t* pj = p.PJ(); float acc = p.conv_b[ch];
#pragma unroll
    for (int k = 0; k < 3; ++k) { const int s2 = s + k - 1; if (s2 >= 0 && s2 < S) { const size_t r2 = (size_t)(row + k - 1) * INM;
        acc += p.conv_w[k * CW + ch] * (bf2f(pj[r2 + O_GC + ch]) * bf2f(pj[r2 + O_HIN + ch])); } }
    p.Y()[(size_t)row * D + ch] = f2bf(bf2f(pj[(size_t)row * INM + O_GB + ch]) * acc);
}
HDF long ml_tok(int dir, int b, int pos) { return (long)b * S + (dir ? S - 1 - pos : pos); }
HD void b_mscan(const Prm& p, long i) {
    const int v = (int)(i % (MV + 1)), h = (int)((i / (MV + 1)) % MH), b = (int)((i / ((MV + 1) * MH)) % NB), dir = (int)(i / ((MV + 1) * MH * NB));
    float C[QK];
#pragma unroll
    for (int d = 0; d < QK; ++d) C[d] = 0.f;
    float m = 0.f; const float qs = 1.f / sqrtf((float)QK);
    float* H = dir ? p.HB() : p.HF();
    for (int pos = 0; pos < S; ++pos) {
        const long tok = ml_tok(dir, b, pos); const float* g = p.GATES() + tok * NG + dir * 8;
        const float ig = g[h], lf = logsigmoidf_(g[4 + h]);
        const float mn = fmaxf(lf + m, ig), dec = expf(lf + m - mn), wi = expf(ig - mn); m = mn;
        const bf16_t* pj = p.PJ() + (size_t)tok * INM; const float wv = wi * (v < MV ? bf2f(pj[O_V + h * MV + (v < MV ? v : 0)]) : 1.f); float num = 0.f;
#pragma unroll
        for (int d = 0; d < QK; ++d) { C[d] = dec * C[d] + wv * bf2f(pj[O_K + h * QK + d]); num += bf2f(pj[O_Q + h * QK + d]) * qs * C[d]; }
        if (v < MV) H[(size_t)tok * MW + h * MV + v] = num;
        else { p.DEN()[((size_t)dir * T + tok) * MH + h] = num; p.FLR()[((size_t)dir * T + tok) * MH + h] = expf(-mn); }
    }
}
HD void b_headnorm(const Prm& p, long i) {
    const long row = i / MH; const int h = (int)(i % MH);
    const float* hf = p.HF() + (size_t)row * MW + h * MV; const float* hb = p.HB() + (size_t)row * MW + h * MV;
    const float inf_ = 1.f / fmaxf(fabsf(p.DEN()[(size_t)row * MH + h]), p.FLR()[(size_t)row * MH + h]);
    const float inb_ = 1.f / fmaxf(fabsf(p.DEN()[((size_t)T + row) * MH + h]), p.FLR()[((size_t)T + row) * MH + h]);
    float s = 0.f; for (int v = 0; v < MV; ++v) s += hf[v] * inf_ + hb[v] * inb_;
    const float mean = s / MV; float q = 0.f; for (int v = 0; v < MV; ++v) { const float t = hf[v] * inf_ + hb[v] * inb_ - mean; q += t * t; }
    const float rstd = 1.f / sqrtf(q / MV + LN_EPS);
    for (int v = 0; v < MV; ++v) { const float hn = (hf[v] * inf_ + hb[v] * inb_ - mean) * rstd * p.mnorm_w[h * MV + v];
        const float og = sigmoidf_(bf2f(p.PJ()[(size_t)row * INM + O_O + h * MV + v]));
        p.Y()[(size_t)row * D + CW + h * MV + v] = f2bf(og * hn); }
}
HD void b_gemm2(const Prm& p, long i) { const long row = i / D; const int n = (int)(i % D); const int b = (int)(row / S);
    const float acc = b_dot16(p.Y() + (size_t)row * D, p.WOUT_T() + (size_t)n * D, D);
    p.out[i] = ALPHA * p.x[i] + p.MOD()[(size_t)b * D6 + 2 * D + n] * acc; }
HD void b_ln_mid(const Prm& p, long row) {
    float* zr = p.out + (size_t)row * D; const int b = (int)(row / S);
    const float* sh = p.MOD() + (size_t)b * D6 + 3 * D; const float* sc = sh + D;
    float s = 0.f; for (int d = 0; d < D; ++d) s += zr[d];
    float mean = s / D; float q = 0.f; for (int d = 0; d < D; ++d) { const float t = zr[d] - mean; q += t * t; }
    float rstd = 1.f / sqrtf(q / D + LN_EPS);
    s = 0.f; for (int d = 0; d < D; ++d) { const float x1 = (zr[d] - mean) * rstd * p.ln1_w[d] + p.ln1_b[d]; zr[d] = x1; s += x1; }
    mean = s / D; q = 0.f; for (int d = 0; d < D; ++d) { const float t = zr[d] - mean; q += t * t; }
    rstd = 1.f / sqrtf(q / D + LN_EPS);
    for (int d = 0; d < D; ++d) p.U()[(size_t)row * D + d] = f2bf((zr[d] - mean) * rstd * (1.f + sc[d]) + sh[d]);
}
HD void b_gemm3(const Prm& p, long i) { const long row = i / NQ; const int n = (int)(i % NQ);
    p.Y()[i] = f2bf(b_dot16(p.U() + (size_t)row * D, p.WQ_T() + (size_t)n * D, D)); }
HD void b_scores(const Prm& p, long i) { const long tok = i / NSC; const int c = (int)(i % NSC), grp = c / NK, n = c % NK;
    const bf16_t* q = p.Y() + (size_t)tok * NQ + grp * KH; const float* sk = p.subkeys + ((size_t)grp * NK + n) * KH; float acc = 0.f;
    for (int d = 0; d < KH; ++d) acc += bf2f(q[d]) * sk[d];
    p.SC()[i] = acc; }
HD void b_topk1(const Prm& p, long i) {
    const float* sc = p.SC() + (size_t)i * NK; float pv = INFINITY; int pi = -1;
    for (int r = 0; r < TOPK; ++r) { float best = -INFINITY; int bi = -1;
        for (int n = 0; n < NK; ++n) { const float v = sc[n]; const bool ok = (v < pv) || (v == pv && n > pi); if (ok && v > best) { best = v; bi = n; } }
        p.TS()[(size_t)i * TOPK + r] = best; p.TI()[(size_t)i * TOPK + r] = bi; pv = best; pi = bi; }
}
HD void b_topk2(const Prm& p, long i) {
    const float* s0 = p.TS() + (size_t)i * 2 * TOPK; const float* s1 = s0 + TOPK; const int* i0 = p.TI() + (size_t)i * 2 * TOPK; const int* i1 = i0 + TOPK;
    float pv = INFINITY; int pi = -1; float mx = 0.f, sum = 0.f;
    for (int r = 0; r < TOPK; ++r) { float best = -INFINITY; int bi = -1;
        for (int c = 0; c < TOPK * TOPK; ++c) { const float v = s0[c / TOPK] + s1[c % TOPK]; const bool ok = (v < pv) || (v == pv && c > pi); if (ok && v > best) { best = v; bi = c; } }
        if (r == 0) mx = best;
        const float e = expf(best - mx); sum += e;
        p.EIDX()[(size_t)i * TOPK + r] = i0[bi / TOPK] * NK + i1[bi % TOPK]; p.EW()[(size_t)i * TOPK + r] = e; pv = best; pi = bi; }
    for (int r = 0; r < TOPK; ++r) p.EW()[(size_t)i * TOPK + r] /= sum;
}
HD void b_up(const Prm& p, long i) { const long tok = i / NSLOT; const int e = p.EIDX()[i];
    p.EW()[i] *= gelu_exact(b_dot16(p.U() + (size_t)tok * D, p.PU16() + (size_t)e * D, D)); }
HD void b_down(const Prm& p, long i) { const long tok = i / D; const int d = (int)(i % D); const int b = (int)(tok / S); float y = 0.f;
    for (int sl = 0; sl < NSLOT; ++sl) y += p.EW()[tok * NSLOT + sl] * bf2f(p.PV16()[(size_t)p.EIDX()[tok * NSLOT + sl] * D + d]);
    p.out[i] = ALPHA * p.out[i] + p.MOD()[(size_t)b * D6 + 5 * D + d] * y; }
HD void b_ln2(const Prm& p, long row) {
    float* zr = p.out + (size_t)row * D;
    float s = 0.f; for (int d = 0; d < D; ++d) s += zr[d];
    const float mean = s / D; float q = 0.f; for (int d = 0; d < D; ++d) { const float t = zr[d] - mean; q += t * t; }
    const float rstd = 1.f / sqrtf(q / D + LN_EPS);
    for (int d = 0; d < D; ++d) zr[d] = (zr[d] - mean) * rstd * p.ln2_w[d] + p.ln2_b[d];
}
#include <cstdio>
#define LAS __attribute__((address_space(3)))
#define GAS __attribute__((address_space(1)))
namespace pg8 {
#define PG8_LAS __attribute__((address_space(3)))
typedef unsigned short bf16_t;
typedef short bf16x8 __attribute__((ext_vector_type(8)));
typedef float f32x4 __attribute__((ext_vector_type(4)));
typedef unsigned u32x4 __attribute__((ext_vector_type(4)));
constexpr int BM = 256, BK = 64, HALF = 128, HTB = HALF * BK * 2  , STAGE_BYTES = 8 * HTB, NXCD = 8, WGM = 8;

__host__ __device__ __forceinline__ int lds_byte(int r, int c) { const int st = (r >> 4) * 2 + (c >> 5), rr = r & 15, cc = c & 31, ob = rr * 64 + cc * 2; return st * 1024 + (ob ^ (((ob >> 9) & 1) << 5)); }
__host__ __device__ __forceinline__ void stage_rc(int b, int& R, int& C) { const int st = b / 1024, sb = b % 1024, swz = sb ^ (((sb >> 9) & 1) << 5); R = (st >> 1) * 16 + swz / 64; C = (st & 1) * 32 + (swz % 64) / 2; }
__host__ __device__ __forceinline__ int perm32(int rho) { const int n = rho >> 4, i = rho & 15; return 8 * (i >> 2) + 4 * n + (i & 3); }

struct Unit { int pm, pn; };
struct Gemm { const bf16_t* A; const bf16_t* Bt; int M, N, K; };

struct StaticOrder {
    int nM, nN, nwg, G, c;
    __host__ __device__ void init(int M, int N, int G_, int c_) { nM = M / BM; nN = N / BM; nwg = nM * nN; G = G_; c = c_; }
    __host__ __device__ bool next(int i, Unit& u) const {
        const long L = (long)i * G + c; if (L >= nwg) return false;
        int wgid = (int)L; { const int q = nwg / NXCD, r = nwg % NXCD, xcd = wgid % NXCD, off = wgid / NXCD; wgid = (xcd < r ? xcd * (q + 1) : r * (q + 1) + (xcd - r) * q) + off; }
        const int nig = WGM * nN, gid = wgid / nig, fm = gid * WGM, gsz = (nM - fm) < WGM ? (nM - fm) : WGM;
        u.pm = fm + ((wgid % nig) % gsz); u.pn = (wgid % nig) / gsz; return true;
    }
    __device__ __forceinline__ void a_ready(const Unit&) const {}
    __device__ __forceinline__ void done(const Unit&) const {}
};

__device__ __forceinline__ unsigned cvt_pk_bf16(float lo, float hi) { unsigned r; asm volatile("v_cvt_pk_bf16_f32 %0, %1, %2" : "=v"(r) : "v"(lo), "v"(hi)); return r; }
typedef float f32x2 __attribute__((ext_vector_type(2)));
__device__ __forceinline__ f32x2 gelu_pk(f32x2 v) {
    const f32x2 av = __builtin_elementwise_abs(v), d = av * 0.2316418882f + 1.0f;
    f32x2 t; t.x = __builtin_amdgcn_rcpf(d.x); t.y = __builtin_amdgcn_rcpf(d.y);
    f32x2 q = t * 0.5307027145f + (-0.7265760135f); q = q * t + 0.7107068705f; q = q * t + (-0.142248368f); q = q * t + 0.127414796f; q = q * t;
    const f32x2 s = (v * v) * (-0.72134752044f);
    f32x2 e; e.x = __builtin_amdgcn_exp2f(s.x); e.y = __builtin_amdgcn_exp2f(s.y);
    const f32x2 m = v * (q * e), r = v - m;
    f32x2 o; o.x = v.x < 0.f ? m.x : r.x; o.y = v.y < 0.f ? m.y : r.y; return o;
}

template <int ACT  > struct EpiBf16 {
    static constexpr bool PERM = true, AFTER_DRAIN = false; static_assert(ACT == 0 || ACT == 1, "EpiBf16: ACT is 0 (none) or 1 (gelu_pk)");
    bf16_t* O; int ldc; const float* bias; int split_cols; size_t split_stride; float scale0;
    __device__ __forceinline__ void operator()(const f32x4 (&acc)[2][2][4][2], const Unit& u, int wr, int wc, int fr, int fq) const {
        const int row0 = u.pm * BM + wr * 64 + fr; int colt = u.pn * BM; bf16_t* base = O;
        float sc = 1.f; if (split_cols) { const int t = colt / split_cols; base += (size_t)t * split_stride; colt -= t * split_cols; if (t == 0) sc = scale0; }
        const int col0 = colt + wc * 32 + 8 * fq, bcol0 = u.pn * BM + wc * 32 + 8 * fq;
        f32x4 bv[2][2];
#pragma unroll
        for (int bj = 0; bj < 2; ++bj)
#pragma unroll
            for (int n = 0; n < 2; ++n) bv[bj][n] = bias ? *(const f32x4*)(bias + bcol0 + bj * HALF + 4 * n) : (f32x4){0.f, 0.f, 0.f, 0.f};
#pragma unroll
        for (int ai = 0; ai < 2; ++ai)
#pragma unroll
            for (int m = 0; m < 4; ++m) { bf16_t* rowp = base + (size_t)(row0 + ai * HALF + m * 16) * ldc + col0;
#pragma unroll
                for (int bj = 0; bj < 2; ++bj) { f32x4 v0 = acc[ai][bj][m][0] + bv[bj][0], v1 = acc[ai][bj][m][1] + bv[bj][1];
                    if (ACT == 1) { f32x2 a = gelu_pk((f32x2){v0[0], v0[1]}), b = gelu_pk((f32x2){v0[2], v0[3]}), c = gelu_pk((f32x2){v1[0], v1[1]}), d = gelu_pk((f32x2){v1[2], v1[3]});
                        v0 = (f32x4){a.x, a.y, b.x, b.y}; v1 = (f32x4){c.x, c.y, d.x, d.y}; }
                    v0 = v0 * sc; v1 = v1 * sc; u32x4 w; w.x = cvt_pk_bf16(v0[0], v0[1]); w.y = cvt_pk_bf16(v0[2], v0[3]); w.z = cvt_pk_bf16(v1[0], v1[1]); w.w = cvt_pk_bf16(v1[2], v1[3]);
                    *(u32x4*)(rowp + bj * HALF) = w; } }
    }
};
template <class Epi, class Sched, bool ALIGN_EPI = false, bool SP2 = false>
__device__ __forceinline__ void gemm_phase(PG8_LAS unsigned char* lds, const Gemm g, const Sched& S, const Epi& E) {
    const int tid = threadIdx.x, wid = __builtin_amdgcn_readfirstlane(tid >> 6), lane = tid & 63, wr = wid >> 2, wc = wid & 3, fr = lane & 15, fq = lane >> 4;
    const int K = g.K, nt = K / BK;
    unsigned voffA[2], voffB[2];
#pragma unroll
    for (int i = 0; i < 2; ++i) { int R, C; stage_rc(tid * 16 + i * 8192, R, C); const int Rb = Epi::PERM ? ((R & ~31) + perm32(R & 31)) : R;
        voffA[i] = (unsigned)(R * K + C) * 2u; voffB[i] = (unsigned)(Rb * K + C) * 2u; }
    const size_t kstep = (size_t)(BK * 2);
    const size_t hstep = (size_t)HALF * K * 2;
    const size_t tstep = 2 * hstep;
    const unsigned ldsw = (unsigned)wid * 1024u;
    const int aoff = lds_byte(wr * 64 + fr, fq * 8), boff = lds_byte(wc * 32 + fr, fq * 8);
#define PG8_SA(b, h) (((b) * 2 + (h)) * HTB)
#define PG8_SB(b, h) ((4 + (b) * 2 + (h)) * HTB)
#define PG8_STAGE(bufoff, gbase, voff) do { _Pragma("unroll") for (int _i = 0; _i < 2; ++_i) \
        __builtin_amdgcn_global_load_lds((const unsigned*)((const char*)(gbase) + (voff)[_i]), (PG8_LAS unsigned*)(lds + (bufoff) + ldsw + _i * 8192), 16, 0, 0); } while (0)
#define PG8_LDA(dst, b, h) do { _Pragma("unroll") for (int m = 0; m < 4; ++m) _Pragma("unroll") for (int k = 0; k < 2; ++k) dst[m][k] = *(const PG8_LAS bf16x8*)(lds + PG8_SA(b, h) + aoff + m * 2048 + k * 1024); } while (0)
#define PG8_LDB(dst, b, h) do { _Pragma("unroll") for (int n = 0; n < 2; ++n) _Pragma("unroll") for (int k = 0; k < 2; ++k) dst[n][k] = *(const PG8_LAS bf16x8*)(lds + PG8_SB(b, h) + boff + n * 2048 + k * 1024); } while (0)
#define PG8_MMA(ai, bj, At, Bt) do { __builtin_amdgcn_s_setprio(1); _Pragma("unroll") for (int m = 0; m < 4; ++m) _Pragma("unroll") for (int n = 0; n < 2; ++n) _Pragma("unroll") for (int k = 0; k < 2; ++k) \
        acc[ai][bj][m][n] = __builtin_amdgcn_mfma_f32_16x16x32_bf16(Bt[n][k], At[m][k], acc[ai][bj][m][n], 0, 0, 0); __builtin_amdgcn_s_setprio(0); } while (0)
#define PG8_WAIT_V(n) asm volatile("s_waitcnt vmcnt(" #n ")" ::: "memory")
#define PG8_WAIT_L(n) asm volatile("s_waitcnt lgkmcnt(" #n ")" ::: "memory")
#define PG8_BAR __builtin_amdgcn_s_barrier()
#define PG8_SCHED __builtin_amdgcn_sched_barrier(0)
    Unit cur, nxt; int ui = 0;
    if (!S.next(0, cur)) return;
    f32x4 acc[2][2][4][2];
#pragma unroll
    for (int a = 0; a < 2; ++a)
#pragma unroll
        for (int b = 0; b < 2; ++b)
#pragma unroll
            for (int m = 0; m < 4; ++m)
#pragma unroll
                for (int n = 0; n < 2; ++n) acc[a][b][m][n] = (f32x4){0.f, 0.f, 0.f, 0.f};
    bf16x8 At[4][2], B0[2][2], B1[2][2];
    const char* cA = (const char*)g.A + (size_t)cur.pm * tstep; const char* cB = (const char*)g.Bt + (size_t)cur.pn * tstep;
    S.a_ready(cur);
    if constexpr (SP2) {
        PG8_STAGE(PG8_SB(0, 0), cB, voffB); PG8_STAGE(PG8_SB(0, 1), cB + hstep, voffB); PG8_STAGE(PG8_SA(0, 0), cA, voffA); PG8_STAGE(PG8_SA(0, 1), cA + hstep, voffA);
        if (wr == 1) PG8_BAR;
        PG8_WAIT_V(2); PG8_BAR;
        PG8_STAGE(PG8_SB(1, 0), cB + kstep, voffB); PG8_STAGE(PG8_SA(1, 0), cA + kstep, voffA); PG8_STAGE(PG8_SB(1, 1), cB + hstep + kstep, voffB);
        PG8_WAIT_V(6); PG8_BAR;
    } else {
        PG8_STAGE(PG8_SB(0, 0), cB, voffB); PG8_STAGE(PG8_SA(0, 0), cA, voffA); PG8_STAGE(PG8_SB(0, 1), cB + hstep, voffB); PG8_STAGE(PG8_SA(0, 1), cA + hstep, voffA);
        if (wr == 1) PG8_BAR;
        PG8_WAIT_V(4); PG8_BAR;
        PG8_STAGE(PG8_SB(1, 0), cB + kstep, voffB); PG8_STAGE(PG8_SA(1, 0), cA + kstep, voffA); PG8_STAGE(PG8_SB(1, 1), cB + hstep + kstep, voffB);
        PG8_WAIT_V(6); PG8_BAR;
    }
    for (;;) {
        const bool has_next = S.next(ui + 1, nxt);
        const char* nA = has_next ? (const char*)g.A + (size_t)nxt.pm * tstep : cA; const char* nB = has_next ? (const char*)g.Bt + (size_t)nxt.pn * tstep : cB;
        for (int t = 0; t < nt; t += 2) {
            const bool last = (t == nt - 2);
            const char* a1 = cA + (size_t)(t + 1) * kstep;
            const char* a2 = last ? nA : cA + (size_t)(t + 2) * kstep; const char* b2 = last ? nB : cB + (size_t)(t + 2) * kstep;
            const char* a3 = a2 + kstep; const char* b3 = b2 + kstep;
            if (last && has_next) S.a_ready(nxt);
            if constexpr (SP2) {
            PG8_LDB(B0, 0, 0); PG8_LDB(B1, 0, 1); PG8_SCHED; PG8_LDA(At, 0, 0); PG8_STAGE(PG8_SA(1, 1), a1 + hstep, voffA);
            PG8_WAIT_V(8); PG8_WAIT_L(0); PG8_BAR; PG8_MMA(0, 0, At, B0); PG8_MMA(0, 1, At, B1); PG8_BAR; PG8_SCHED;
            PG8_LDA(At, 0, 1); PG8_STAGE(PG8_SB(0, 0), b2, voffB); PG8_STAGE(PG8_SB(0, 1), b2 + hstep, voffB); PG8_STAGE(PG8_SA(0, 0), a2, voffA);
            PG8_WAIT_V(8); PG8_WAIT_L(0); PG8_BAR; PG8_MMA(1, 0, At, B0); PG8_MMA(1, 1, At, B1); PG8_BAR; PG8_SCHED;
            PG8_LDB(B0, 1, 0); PG8_LDB(B1, 1, 1); PG8_SCHED; PG8_LDA(At, 1, 0); PG8_STAGE(PG8_SA(0, 1), a2 + hstep, voffA);
            PG8_WAIT_V(8); PG8_WAIT_L(0); PG8_BAR; PG8_MMA(0, 0, At, B0); PG8_MMA(0, 1, At, B1); PG8_BAR; PG8_SCHED;
            PG8_LDA(At, 1, 1); PG8_STAGE(PG8_SB(1, 0), b3, voffB); PG8_STAGE(PG8_SB(1, 1), b3 + hstep, voffB); PG8_STAGE(PG8_SA(1, 0), a3, voffA);
            PG8_WAIT_V(8); PG8_WAIT_L(0); PG8_BAR; PG8_MMA(1, 0, At, B0); PG8_MMA(1, 1, At, B1); PG8_BAR; PG8_SCHED;
            } else {
            PG8_LDB(B0, 0, 0); PG8_SCHED; PG8_LDA(At, 0, 0); PG8_STAGE(PG8_SA(1, 1), a1 + hstep, voffA);
            PG8_WAIT_L(8); PG8_BAR; PG8_WAIT_L(0); PG8_MMA(0, 0, At, B0); PG8_BAR; PG8_SCHED;
            PG8_LDB(B1, 0, 1); PG8_STAGE(PG8_SB(0, 0), b2, voffB);
            PG8_BAR; PG8_WAIT_L(0); PG8_MMA(0, 1, At, B1); PG8_BAR;
            PG8_LDA(At, 0, 1); PG8_STAGE(PG8_SA(0, 0), a2, voffA);
            PG8_BAR; PG8_WAIT_L(0); PG8_MMA(1, 0, At, B0); PG8_BAR; PG8_SCHED;
            PG8_STAGE(PG8_SB(0, 1), b2 + hstep, voffB);
            PG8_WAIT_V(6); PG8_BAR; PG8_MMA(1, 1, At, B1); PG8_BAR;
            PG8_LDB(B0, 1, 0); PG8_SCHED; PG8_LDA(At, 1, 0); PG8_STAGE(PG8_SA(0, 1), a2 + hstep, voffA);
            PG8_WAIT_L(8); PG8_BAR; PG8_WAIT_L(0); PG8_MMA(0, 0, At, B0); PG8_BAR; PG8_SCHED;
            PG8_LDB(B1, 1, 1); PG8_STAGE(PG8_SB(1, 0), b3, voffB);
            PG8_BAR; PG8_WAIT_L(0); PG8_MMA(0, 1, At, B1); PG8_BAR;
            PG8_LDA(At, 1, 1); PG8_STAGE(PG8_SA(1, 0), a3, voffA);
            PG8_BAR; PG8_WAIT_L(0); PG8_MMA(1, 0, At, B0); PG8_BAR; PG8_SCHED;
            PG8_STAGE(PG8_SB(1, 1), b3 + hstep, voffB);
            PG8_WAIT_V(6); PG8_BAR; PG8_MMA(1, 1, At, B1); PG8_BAR;
            }
        }
        if constexpr (ALIGN_EPI) { if (wr == 0) PG8_BAR; }
        if constexpr (!Epi::AFTER_DRAIN) { E(acc, cur, wr, wc, fr, fq); S.done(cur); }
        if (!has_next) break;
#pragma unroll
        for (int a = 0; a < 2; ++a)
#pragma unroll
            for (int b = 0; b < 2; ++b)
#pragma unroll
                for (int m = 0; m < 4; ++m)
#pragma unroll
                    for (int n = 0; n < 2; ++n) acc[a][b][m][n] = (f32x4){0.f, 0.f, 0.f, 0.f};
        cur = nxt; cA = nA; cB = nB; ++ui;
        if constexpr (ALIGN_EPI) { if (wr == 1) PG8_BAR; }
    }
    PG8_WAIT_V(0);
    if constexpr (!ALIGN_EPI) { if (wr == 0) PG8_BAR; }
    PG8_BAR;
    if constexpr (Epi::AFTER_DRAIN) { E.fused(acc, cur, wr, wc, fr, fq, lds, wid, lane); S.done(cur); }
#undef PG8_SA
#undef PG8_SB
#undef PG8_STAGE
#undef PG8_LDA
#undef PG8_LDB
#undef PG8_MMA
#undef PG8_WAIT_V
#undef PG8_WAIT_L
#undef PG8_BAR
#undef PG8_SCHED
}
}
#define XB_TMO      128
#define XB_XCNT(j)  (256  + 64 * (j))
#define XB_XSUB(j)  (1280 + 64 * (j))
#define XB_XGEN(j)  (2304 + 64 * (j))
#define XB_TOP      3328
#define XB_TOPGEN   3392
#define XCD_BAR_WORDS 3456
#define XB_SPIN_CAP (1u << 18)

__device__ __forceinline__ unsigned xb_ld(unsigned* p)              { return __hip_atomic_load(p, __ATOMIC_RELAXED, __HIP_MEMORY_SCOPE_AGENT); }
__device__ __forceinline__ unsigned xb_add(unsigned* p, unsigned v) { return __hip_atomic_fetch_add(p, v, __ATOMIC_RELAXED, __HIP_MEMORY_SCOPE_AGENT); }
__device__ __forceinline__ unsigned xb_xcc_id() { return (unsigned)__builtin_amdgcn_s_getreg((3 << 11) | 20) & 0xFu; }
#define XB_SPIN(cond, bar) do { unsigned _sp = 0; while (cond) { __builtin_amdgcn_s_sleep(1); \
    if ((++_sp & 255u) == 0u) { if (xb_ld(&(bar)[XB_TMO])) break; if (_sp > XB_SPIN_CAP) { atomicAdd(&(bar)[XB_TMO], 1u); break; } } } } while (0)

struct XcdBarrier {
    unsigned* bar; unsigned x;
    volatile LAS unsigned* st;
};

__device__ __forceinline__ XcdBarrier xcd_barrier_post(unsigned* bar, volatile LAS unsigned* st) {
    XcdBarrier b; b.bar = bar; b.x = xb_xcc_id(); b.st = st;
    if (threadIdx.x == 0) st[2] = xb_add(&bar[XB_XCNT(b.x)], 1u) + 1u;
    return b;
}
__device__ __forceinline__ void xcd_barrier_complete(unsigned* bar, unsigned x, unsigned& nloc, unsigned& nx) {
    const unsigned G = gridDim.x * gridDim.y * gridDim.z;
    unsigned sum, cnt, mine, sp = 0u;
    for (;;) {
        sum = 0u; cnt = 0u; mine = 0u;
#pragma unroll
        for (unsigned j = 0; j < 16; ++j) { const unsigned c = xb_ld(&bar[XB_XCNT(j)]); sum += c; cnt += (c > 0u) ? 1u : 0u; mine = (j == x) ? c : mine; }
        if (sum == G) break;
        __builtin_amdgcn_s_sleep(1);
        if ((++sp & 255u) == 0u) { if (xb_ld(&bar[XB_TMO])) break; if (sp > XB_SPIN_CAP) { atomicAdd(&bar[XB_TMO], 1u); break; } }
    }
    nloc = mine > 0u ? mine : 1u; nx = cnt > 0u ? cnt : 1u;
}

__device__ __forceinline__ void xcd_barrier(const XcdBarrier& b) {
    asm volatile("s_waitcnt vmcnt(0)" ::: "memory");
    __syncthreads();
    if (threadIdx.x == 0) {
        unsigned* bar = b.bar;
        __builtin_amdgcn_s_waitcnt(0);
        unsigned nloc = b.st[0], nx = b.st[1];
        if (nloc == 0u) { xcd_barrier_complete(bar, b.x, nloc, nx); b.st[0] = nloc; b.st[1] = nx; }
        const unsigned old = xb_add(&bar[XB_XSUB(b.x)], 1u);
        const unsigned gen = old / nloc;
        if (old + 1u == (gen + 1u) * nloc) {
            __builtin_amdgcn_fence(__ATOMIC_RELEASE, "agent");
            asm volatile("s_waitcnt vmcnt(0)" ::: "memory");
            const unsigned og = xb_add(&bar[XB_TOP], 1u);
            const unsigned tg = og / nx;
            if (og + 1u == (tg + 1u) * nx) xb_add(&bar[XB_TOPGEN], 1u);
            else XB_SPIN(xb_ld(&bar[XB_TOPGEN]) == tg, bar);
            __builtin_amdgcn_fence(__ATOMIC_ACQUIRE, "agent");
            xb_add(&bar[XB_XGEN(b.x)], 1u);
            asm volatile("s_waitcnt vmcnt(0)" ::: "memory");
        } else {
            XB_SPIN(xb_ld(&bar[XB_XGEN(b.x)]) == gen, bar);
            __builtin_amdgcn_fence(__ATOMIC_ACQUIRE, "agent");
            asm volatile("s_waitcnt vmcnt(0)" ::: "memory");
        }
    }
    __syncthreads();
}
constexpr int NWAVES = 8, NTHR = 512;
constexpr int RING_BYTES = 131072, LDSCTL_OFF = RING_BYTES, MISC_OFF = LDSCTL_OFF + 320, LDS_BYTES = 163840;
constexpr int CW_BAR = 4096;
#ifndef MK_N_LAUNCHES
#define MK_N_LAUNCHES 1
#endif
constexpr int NPHASE = 13;

typedef float f4v __attribute__((ext_vector_type(4)));
typedef unsigned u2v __attribute__((ext_vector_type(2)));
typedef unsigned u32x4_t __attribute__((ext_vector_type(4)));
struct Frame { LAS unsigned char* lds; int tid, lane, wave, G, bid; };
template <int CTRL, int ROWMASK> __device__ __forceinline__ float dppf(float old, float src) {
    return __builtin_bit_cast(float, __builtin_amdgcn_update_dpp(__builtin_bit_cast(int, old), __builtin_bit_cast(int, src), CTRL, ROWMASK, 0xf, false)); }
__device__ __forceinline__ float wave_scan_add(float v) {
    v += dppf<0x111, 0xf>(0.f, v); v += dppf<0x112, 0xf>(0.f, v); v += dppf<0x114, 0xf>(0.f, v); v += dppf<0x118, 0xf>(0.f, v);
    v += dppf<0x142, 0xa>(0.f, v); v += dppf<0x143, 0xc>(0.f, v); return v; }
__device__ __forceinline__ float wave_scan_max(float v) {
    const float NI = -INFINITY;
    v = fmaxf(v, dppf<0x111, 0xf>(NI, v)); v = fmaxf(v, dppf<0x112, 0xf>(NI, v)); v = fmaxf(v, dppf<0x114, 0xf>(NI, v)); v = fmaxf(v, dppf<0x118, 0xf>(NI, v));
    v = fmaxf(v, dppf<0x142, 0xa>(NI, v)); v = fmaxf(v, dppf<0x143, 0xc>(NI, v)); return v; }
__device__ __forceinline__ float lane_bcast(float v, int l) { return __builtin_bit_cast(float, __builtin_amdgcn_readlane(__builtin_bit_cast(int, v), l)); }
__device__ __forceinline__ float wave_sum(float v) { return lane_bcast(wave_scan_add(v), 63); }
__device__ __forceinline__ unsigned pk2(float lo, float hi) { return (unsigned)f2bf(lo) | ((unsigned)f2bf(hi) << 16); }
__device__ __forceinline__ float bflo(unsigned w) { return u_as_f(w << 16); }
__device__ __forceinline__ float bfhi(unsigned w) { return u_as_f(w & 0xffff0000u); }

__device__ __forceinline__ void p0_ada_block(const Prm& p, const Frame& F, int cb) {
    static_assert(D6 % 48 == 0 && NB == 8, "48-column blocks");
    LAS float* sl = (LAS float*)F.lds;
    LAS float* red = sl + NB * D;
    for (int i = F.tid; i < NB * D; i += NTHR) { const float cv = p.c[i]; sl[i] = cv / (1.f + __expf(-cv)); }
    __syncthreads();
    const int c4 = F.tid % 12, kl = F.tid / 12;
    if (kl < 42) {
        f4v acc[NB];
#pragma unroll
        for (int b = 0; b < NB; ++b) acc[b] = (f4v){0.f, 0.f, 0.f, 0.f};
        const float* wp = p.w_ada + (size_t)cb * 48 + 4 * c4;
#pragma unroll 7
        for (int k = kl; k < D; k += 42) { const f4v w = __builtin_nontemporal_load((const f4v*)(wp + (size_t)k * D6));
#pragma unroll
            for (int b = 0; b < NB; ++b) acc[b] += w * sl[b * D + k]; }
#pragma unroll
        for (int b = 0; b < NB; ++b) *(LAS f4v*)(red + (kl * NB + b) * 48 + 4 * c4) = acc[b];
    }
    __syncthreads();
    if (F.tid < NB * 48) { const int b = F.tid / 48, col = F.tid % 48; float s = 0.f;
        for (int k = 0; k < 42; ++k) s += red[(k * NB + b) * 48 + col];
        p.MOD()[(size_t)b * D6 + cb * 48 + col] = s + p.b_ada[cb * 48 + col]; }
    __syncthreads();
}
__device__ __forceinline__ void p0_transpose_item(const float* W, int ldw, int K, int N, bf16_t* WT, LAS float* scr, int item, int lane) {
    const int nblk = N / 32, kb = item / nblk, nb = item % nblk, k0 = 64 * kb, n0 = 32 * nb;
#pragma unroll
    for (int i = 0; i < 32; ++i) { const int kk = 2 * i + (lane >> 5); scr[kk * 33 + (lane & 31)] = W[(size_t)(k0 + kk) * ldw + n0 + (lane & 31)]; }
    asm volatile("s_waitcnt lgkmcnt(0)" ::: "memory");
    const int c = lane & 7;
#pragma unroll
    for (int j = 0; j < 4; ++j) { const int n = (lane >> 3) + 8 * j; const LAS float* s = scr + (8 * c) * 33 + n;
        uint4 o; o.x = pk2(s[0 * 33], s[1 * 33]); o.y = pk2(s[2 * 33], s[3 * 33]); o.z = pk2(s[4 * 33], s[5 * 33]); o.w = pk2(s[6 * 33], s[7 * 33]);
        *(uint4*)(WT + (size_t)(n0 + n) * K + k0 + 8 * c) = o; }
    asm volatile("s_waitcnt lgkmcnt(0)" ::: "memory");
}

__device__ __forceinline__ void p0_fold_item(const Prm& p, int item, int lane) {
    static_assert(NK == 128 && KH == 128 && NQ == 2048, "fold item decomposition");
    const int ks = item & 31, nt = (item >> 5) & 7, g = item >> 8;
    const int r = lane & 15, q = lane >> 4;
    const float* arow = p.subkeys + ((size_t)g * NK + nt * 16 + r) * KH + 4 * q;
    const float* brow = p.wq + (size_t)(ks * 64 + r) * NQ + g * KH + 4 * q;
    pg8::f32x4 acc[4];
#pragma unroll
    for (int c = 0; c < 4; ++c) acc[c] = (pg8::f32x4){0.f, 0.f, 0.f, 0.f};
#pragma unroll 2
    for (int s16 = 0; s16 < KH; s16 += 16) {
        const pg8::f32x4 a = *(const pg8::f32x4*)(arow + s16); pg8::f32x4 bv[4];
#pragma unroll
        for (int c = 0; c < 4; ++c) bv[c] = *(const pg8::f32x4*)(brow + (size_t)(c * 16) * NQ + s16);
#pragma unroll
        for (int i = 0; i < 4; ++i)
#pragma unroll
            for (int c = 0; c < 4; ++c) acc[c] = __builtin_amdgcn_mfma_f32_16x16x4f32(a[i], bv[c][i], acc[c], 0, 0, 0);
    }
#pragma unroll
    for (int c = 0; c < 4; ++c)
#pragma unroll
        for (int i = 0; i < 4; ++i) p.WQ_T()[(size_t)(g * NK + nt * 16 + 4 * q + i) * D + ks * 64 + c * 16 + r] = f2bf(acc[c][i]);
}
__device__ __forceinline__ void phase0(const Prm& p, const Frame& F) {
    for (int cb = F.bid; cb < D6 / 48; cb += F.G) p0_ada_block(p, F, cb);
    LAS float* scr = (LAS float*)(F.lds + F.wave * 16384);
    const int gw = F.bid * NWAVES + F.wave, NGW = F.G * NWAVES;
    constexpr int I_IN = (D / 64) * (INM / 32);
    for (int it = gw; it < I_IN; it += NGW) p0_transpose_item(p.w_in, INC, D, INM, p.WIN_T(), scr, it, F.lane);
}
#if defined(EMU_FP4_U) || defined(EMU_FP4_V)
__device__ __forceinline__ float q4emu(float x) { const float a = fminf(fabsf(x), 6.f); const float r = a < 2.f ? rintf(a * 2.f) * 0.5f : (a < 4.f ? rintf(a) : rintf(a * 0.5f) * 2.f); return x < 0.f ? -r : r; }
#endif
template <bool PART_A, bool PART_B, bool PART_F>
__device__ __forceinline__ void deferred_prep(const Prm& p, const Frame& F, int b0, int nb) {
    __syncthreads();
    LAS float* scr = (LAS float*)(F.lds + F.wave * 16384);
    const int gw = (F.bid - b0) * NWAVES + F.wave, NGW = nb * NWAVES;
    constexpr int I_O = (D / 64) * (D / 32), I_Q = 32 * 8 * 16;
    if (PART_A) for (int it = gw; it < I_O; it += NGW) p0_transpose_item(p.w_out, D, D, D, p.WOUT_T(), scr, it, F.lane);
    if (PART_F) for (int it = gw; it < I_Q; it += NGW) p0_fold_item(p, it, F.lane);
    if (PART_A) {
        f4v v[8], vn[8]; int rr = gw;
#define P0_ROWSRC(rr_) ((const f4v*)(p.peer_u + (size_t)(rr_) * D) + 2 * F.lane)
        if (rr < NE) { const f4v* src = P0_ROWSRC(rr);
#pragma unroll
            for (int j = 0; j < 8; ++j) v[j] = __builtin_nontemporal_load(src + 128 * (j >> 1) + (j & 1)); }
        for (; rr < NE; rr += NGW) {
            const int rn = rr + NGW;
            if (rn < NE) { const f4v* src = P0_ROWSRC(rn);
#pragma unroll
                for (int j = 0; j < 8; ++j) vn[j] = __builtin_nontemporal_load(src + 128 * (j >> 1) + (j & 1)); }
            const int e = rr; float am = 0.f;
#pragma unroll
            for (int j = 0; j < 8; ++j) am = fmaxf(am, fmaxf(fmaxf(fabsf(v[j][0]), fabsf(v[j][1])), fmaxf(fabsf(v[j][2]), fabsf(v[j][3]))));
#pragma unroll
            for (int o = 1; o < 64; o <<= 1) am = fmaxf(am, __shfl_xor(am, o));
            am *= 0.8f;
            const float sc = am > 0.f ? 6.f / am : 1.f;
            unsigned char* dst = p.PU4() + (size_t)e * 128 + 4u * (F.lane & 31) + (size_t)(F.lane >> 5) * ((size_t)NE * 128);
#pragma unroll
            for (int j2 = 0; j2 < 4; ++j2) { unsigned w = 0u; const f4v a = v[2 * j2] * sc, b = v[2 * j2 + 1] * sc;
#ifdef FP4_SWAP
                w = __builtin_amdgcn_cvt_scalef32_pk_fp4_f32(w, a[1], a[0], 1.0f, 0); w = __builtin_amdgcn_cvt_scalef32_pk_fp4_f32(w, a[3], a[2], 1.0f, 1);
                w = __builtin_amdgcn_cvt_scalef32_pk_fp4_f32(w, b[1], b[0], 1.0f, 2); w = __builtin_amdgcn_cvt_scalef32_pk_fp4_f32(w, b[3], b[2], 1.0f, 3); *(unsigned*)(dst + (size_t)(2 * j2) * ((size_t)NE * 128)) = w; }
#else
                w = __builtin_amdgcn_cvt_scalef32_pk_fp4_f32(w, a[0], a[1], 1.0f, 0); w = __builtin_amdgcn_cvt_scalef32_pk_fp4_f32(w, a[2], a[3], 1.0f, 1);
                w = __builtin_amdgcn_cvt_scalef32_pk_fp4_f32(w, b[0], b[1], 1.0f, 2); w = __builtin_amdgcn_cvt_scalef32_pk_fp4_f32(w, b[2], b[3], 1.0f, 3); *(unsigned*)(dst + (size_t)(2 * j2) * ((size_t)NE * 128)) = w; }
#endif
            if (F.lane == 0) p.RSU()[e] = am > 0.f ? am / 6.f : 1.f;
#pragma unroll
            for (int j = 0; j < 8; ++j) v[j] = vn[j];
        }
#undef P0_ROWSRC
    }
    if (PART_B) { LAS unsigned char* tl = F.lds; constexpr int RS_ = 2056;
      for (int tile = F.bid - b0; tile < NE / 16; tile += nb) { const int row = F.tid >> 5, l32 = F.tid & 31, e = tile * 16 + row;
        __syncthreads();
        const f4v* src = (const f4v*)(p.peer_v + (size_t)e * D) + l32; f4v x[16]; float am = 0.f;
#pragma unroll
        for (int j = 0; j < 16; ++j) { x[j] = __builtin_nontemporal_load(src + 32 * j); am = fmaxf(am, fmaxf(fmaxf(fabsf(x[j][0]), fabsf(x[j][1])), fmaxf(fabsf(x[j][2]), fabsf(x[j][3])))); }
#pragma unroll
        for (int o = 1; o < 32; o <<= 1) am = fmaxf(am, __shfl_xor(am, o));
#ifdef EMU_FP4_V
        am *= 0.8f;
#endif
        const float sc = am > 0.f ? 384.f / am : 1.f;
#ifdef EMU_FP4_V
        { const float s4 = 6.f / am, i4 = am / 6.f;
#pragma unroll
          for (int j = 0; j < 16; ++j) { x[j][0] = q4emu(x[j][0] * s4) * i4; x[j][1] = q4emu(x[j][1] * s4) * i4; x[j][2] = q4emu(x[j][2] * s4) * i4; x[j][3] = q4emu(x[j][3] * s4) * i4; } }
#endif
#pragma unroll
        for (int j = 0; j < 16; ++j) { unsigned w = 0u; w = __builtin_amdgcn_cvt_pk_fp8_f32(x[j][0] * sc, x[j][1] * sc, w, false); w = __builtin_amdgcn_cvt_pk_fp8_f32(x[j][2] * sc, x[j][3] * sc, w, true);
            *(LAS unsigned*)(tl + row * RS_ + 4 * (l32 + 32 * j)) = w; }
        if (l32 == 0) p.RSV()[e] = am > 0.f ? am / 384.f : 1.f;
        __syncthreads();
#pragma unroll
        for (int k = 0; k < 8; ++k) { const int idx = F.tid + NTHR * k, r = idx & 15, sl = idx >> 4;
            *(u2v*)(p.PV8S() + ((size_t)sl * NE + tile * 16 + r) * 8) = *(const LAS u2v*)(tl + r * RS_ + 8 * sl); }
      } }
}
__device__ __forceinline__ void phase1(const Prm& p, const Frame& F) {
    static_assert(NG == 16 && D % 32 == 0, "gate tile = one 16-column MFMA tile");
    LAS float* SH = (LAS float*)F.lds; LAS float* SC1 = SH + D;
    constexpr unsigned WGS = 2 * D + 16, WG_OFF = 2 * D * 4, US_OFF = ((WG_OFF + NG * WGS + 255u) / 256u) * 256u;
    constexpr unsigned US_HI = 132096u;
    static_assert(US_OFF + 5 * 2 * D * 2 <= (unsigned)LDSCTL_OFF && US_HI + 3 * 2 * D * 2 <= (unsigned)LDS_BYTES && US_HI >= (unsigned)MISC_OFF + 128u, "P1 LDS map");
    LAS unsigned char* WGb = F.lds + WG_OFF; LAS unsigned char* USb = F.wave < 5 ? F.lds + US_OFF + F.wave * (2 * D * 2) : F.lds + US_HI + (F.wave - 5) * (2 * D * 2);
    const int rows_per = T / F.G;
    { const int st = (F.bid * 37) % (NG * D / NTHR);
      for (int k = 0; k < NG * D / NTHR; ++k) { const int idx = F.tid + NTHR * ((k + st) % (NG * D / NTHR)); const int d = idx / NG, g = idx % NG; *(LAS bf16_t*)(WGb + g * WGS + 2 * d) = f2bf(p.w_in[(size_t)d * INC + INM + g]); } }
    int cur_b = -1;
    float4 xpre[8];
    { const float4* x0 = (const float4*)(p.x + (size_t)(F.bid * rows_per + F.wave) * D) + F.lane;
#pragma unroll
      for (int j = 0; j < 8; ++j) xpre[j] = x0[64 * j]; }
    int it = 0;
    for (int r0 = F.bid * rows_per; r0 < (F.bid + 1) * rows_per; r0 += NWAVES, ++it) {
        const int b = r0 / S;
        if (b != cur_b) { __syncthreads();
            for (int n = F.tid; n < 2 * D; n += NTHR) { const float s = p.MOD()[(size_t)b * D6 + n]; SH[n] = n < D ? s : 1.f + s; }
            cur_b = b; __syncthreads(); }
        const int row = r0 + F.wave;
        float4 v[8]; float s = 0.f;
#pragma unroll
        for (int j = 0; j < 8; ++j) v[j] = xpre[j];
        if (r0 + NWAVES < (F.bid + 1) * rows_per) { const float4* xn = (const float4*)(p.x + (size_t)(row + NWAVES) * D) + F.lane;
#pragma unroll
            for (int j = 0; j < 8; ++j) xpre[j] = xn[64 * j]; }
#pragma unroll
        for (int j = 0; j < 8; ++j) s += (v[j].x + v[j].y) + (v[j].z + v[j].w);
        const float mean = wave_sum(s) * (1.f / D); float s2 = 0.f;
#pragma unroll
        for (int j = 0; j < 8; ++j) { v[j].x -= mean; v[j].y -= mean; v[j].z -= mean; v[j].w -= mean; s2 += (v[j].x * v[j].x + v[j].y * v[j].y) + (v[j].z * v[j].z + v[j].w * v[j].w); }
        const float rstd = 1.f / sqrtf(wave_sum(s2) * (1.f / D) + LN_EPS);
        uint2* o8 = (uint2*)(p.U() + (size_t)row * D) + F.lane; LAS u2v* us = (LAS u2v*)(USb + (it & 1) * (2 * D)) + F.lane;
#pragma unroll
        for (int j = 0; j < 8; ++j) { const int c0 = 4 * F.lane + 256 * j; const f4v sh = *(const LAS f4v*)(SH + c0), sc = *(const LAS f4v*)(SC1 + c0);
            const unsigned w0 = pk2(v[j].x * rstd * sc.x + sh.x, v[j].y * rstd * sc.y + sh.y), w1 = pk2(v[j].z * rstd * sc.z + sh.z, v[j].w * rstd * sc.w + sh.w);
            o8[64 * j] = make_uint2(w0, w1); us[64 * j] = (u2v){w0, w1}; }
        if (it & 1) {
            const unsigned lane = F.lane, r = lane & 15u, q = lane >> 4; pg8::f32x4 acc = {0.f, 0.f, 0.f, 0.f};
            const LAS unsigned char* ap = USb + (r & 1u) * (2 * D) + 16u * q; const LAS unsigned char* bp = WGb + r * WGS + 16u * q;
#pragma unroll 8
            for (int ks = 0; ks < D / 32; ++ks) acc = __builtin_amdgcn_mfma_f32_16x16x32_bf16(*(const LAS pg8::bf16x8*)(ap + 64 * ks), *(const LAS pg8::bf16x8*)(bp + 64 * ks), acc, 0, 0, 0);
            if (lane < NG) { const float bi = p.b_in[INM + lane]; const float g0 = acc[0] + bi, g1 = acc[1] + bi; const bool fg = lane & 4;
                p.GATES()[(size_t)(row - NWAVES) * NG + lane] = fg ? logsigmoidf_(g0) : g0; p.GATES()[(size_t)row * NG + lane] = fg ? logsigmoidf_(g1) : g1; } }
    }
}
__device__ __forceinline__ void phase3a(const Prm& p, const Frame& F, int b0, int nb) {
    const size_t gt = (size_t)(F.bid - b0) * NTHR + F.tid, GT = (size_t)nb * NTHR;
    for (size_t i = gt; i < (size_t)T * (CW / 8); i += GT) {
        const size_t row = i / (CW / 8); const int ch = (int)(i % (CW / 8)) * 8, s = (int)(row % S);
        float acc[8];
#pragma unroll
        for (int e = 0; e < 8; ++e) acc[e] = p.conv_b[ch + e];
#pragma unroll
        for (int k = 0; k < 3; ++k) { const int s2 = s + k - 1; if (s2 < 0 || s2 >= S) continue; const bf16_t* pr = p.PJ() + (size_t)(row + k - 1) * INM;
            const uint4 gc = *(const uint4*)(pr + O_GC + ch), hi = *(const uint4*)(pr + O_HIN + ch); const float* cw = p.conv_w + k * CW + ch;
            acc[0] += cw[0] * (bflo(gc.x) * bflo(hi.x)); acc[1] += cw[1] * (bfhi(gc.x) * bfhi(hi.x)); acc[2] += cw[2] * (bflo(gc.y) * bflo(hi.y)); acc[3] += cw[3] * (bfhi(gc.y) * bfhi(hi.y));
            acc[4] += cw[4] * (bflo(gc.z) * bflo(hi.z)); acc[5] += cw[5] * (bfhi(gc.z) * bfhi(hi.z)); acc[6] += cw[6] * (bflo(gc.w) * bflo(hi.w)); acc[7] += cw[7] * (bfhi(gc.w) * bfhi(hi.w)); }
        const uint4 gb = *(const uint4*)(p.PJ() + row * INM + O_GB + ch); uint4 o;
        o.x = pk2(bflo(gb.x) * acc[0], bfhi(gb.x) * acc[1]); o.y = pk2(bflo(gb.y) * acc[2], bfhi(gb.y) * acc[3]); o.z = pk2(bflo(gb.z) * acc[4], bfhi(gb.z) * acc[5]); o.w = pk2(bflo(gb.w) * acc[6], bfhi(gb.w) * acc[7]);
        *(uint4*)(p.Y() + row * D + ch) = o; }
}
namespace ml {
typedef short bf16x8 __attribute__((ext_vector_type(8)));
typedef short s16x4 __attribute__((ext_vector_type(4)));
typedef float f32x4 __attribute__((ext_vector_type(4)));
typedef float f32x2_t __attribute__((ext_vector_type(2)));
typedef __bf16 bf16x2_t __attribute__((ext_vector_type(2)));
typedef unsigned u32x4 __attribute__((ext_vector_type(4)));
typedef unsigned u32x2 __attribute__((ext_vector_type(2)));
constexpr unsigned IMG = 16384u, BUF = 3u * IMG, PT_OFF = 2u * BUF, PT_BYTES = 8192u, N_OFF = PT_OFF + 2u * PT_BYTES;
constexpr unsigned SCT_OFF = 149504u, SCT_BYTES = 1280u;
constexpr unsigned HT_OFF = 133120u;
static_assert(N_OFF + 1024u <= 131072u && HT_OFF + 16384u <= SCT_OFF && SCT_OFF + 3u * SCT_BYTES <= 163840u, "mLSTM LDS map");
__device__ __forceinline__ unsigned cvtpk(float lo, float hi) { f32x2_t v = {lo, hi}; bf16x2_t b = __builtin_convertvector(v, bf16x2_t); return __builtin_bit_cast(unsigned, b); }
__device__ __forceinline__ unsigned off_a(unsigned row, unsigned ch) { return 2048u * (row >> 3) + 512u * (ch >> 2) + 64u * (row & 7u) + 16u * ((ch & 3u) ^ ((row >> 2) & 3u)); }
__device__ __forceinline__ unsigned off_p(unsigned row, unsigned ch) { return 128u * row + 16u * (ch ^ (row & 7u)); }
typedef short v4i16_t __attribute__((ext_vector_type(4)));
__device__ __forceinline__ s16x4 trr(LAS unsigned char* p) { return __builtin_bit_cast(s16x4, __builtin_amdgcn_ds_read_tr16_b64_v4i16((LAS v4i16_t*)p)); }
__device__ __forceinline__ bf16x8 cat8(s16x4 a, s16x4 b) { return (bf16x8){a[0], a[1], a[2], a[3], b[0], b[1], b[2], b[3]}; }
struct CS { float decay, m_next; };
__device__ __forceinline__ CS chunk_scalars(float ig, float fg, float m, LAS float* tab, bool writer, unsigned lane) {
    const float lf = fg;
    const float bc = wave_scan_add(lf), gg = ig - bc, cm = wave_scan_max(gg);
    const float G = fmaxf(m, cm), G63 = lane_bcast(G, 63), b63 = lane_bcast(bc, 63), qs = 0.08838834764831845f;
    if (writer) { tab[lane] = __expf(fminf(G63 - G, 80.f)) * qs; tab[64 + lane] = __expf(m - G) * qs; tab[128 + lane] = __expf(-(bc + G)); tab[192 + lane] = __expf(gg - G63); }
    CS r; r.decay = __expf(m - G63); r.m_next = b63 + G63; if (writer && lane == 0u) tab[256] = r.decay;
    return r;
}
__device__ __forceinline__ void unit(const Prm& p, const Frame& F, int u) {
    static_assert(QK == 128 && MV == 256 && CHUNK == 64 && S % 64 == 0, "mLSTM unit is specialised");
    const int vhalf = u & 1, h = (u >> 1) & 3, b = (u >> 3) & 7, dir = u >> 6;
    const unsigned lane = F.lane, tid = F.tid; const int wave = F.wave; const unsigned q = lane >> 4, r = lane & 15u;
    LAS unsigned char* L = F.lds;
    const unsigned rx = (r >> 2) & 3u, rlo = 2048u * (r >> 3) + 64u * (r & 7u);
    const unsigned RA = rlo + 16u * (q ^ rx), PB1 = rlo + 16u * ((q >> 1) ^ rx) + 8u * (q & 1u), PB2 = rlo + 16u * ((2u + (q >> 1)) ^ rx) + 8u * (q & 1u);
    const unsigned pp = lane & 3u, tlo = 2048u * q + 64u * rx + 8u * (pp & 1u);
    const unsigned tb00 = tlo + 16u * ((pp >> 1) ^ ((2u * q) & 3u)), tb01 = tlo + 256u + 16u * ((pp >> 1) ^ ((2u * q + 1u) & 3u));
    const unsigned tb10 = tlo + 16u * ((2u + (pp >> 1)) ^ ((2u * q) & 3u)), tb11 = tlo + 256u + 16u * ((2u + (pp >> 1)) ^ ((2u * q + 1u) & 3u));
    const unsigned PP0 = 128u * r + 16u * (q ^ (r & 7u)), PP1 = 128u * r + 16u * ((4u + q) ^ (r & 7u));
#define ML_TRA(c, ks, t) ((((c) & 1) ? ((t) ? tb11 : tb10) : ((t) ? tb01 : tb00)) + 8192u * (ks) + 512u * ((unsigned)(c) >> 1))
    __syncthreads();
    for (unsigned i = tid; i < (2u * PT_BYTES + 1024u) / 16u; i += NTHR) *(LAS u32x4*)(L + PT_OFF + 16u * i) = (u32x4){0u, 0u, 0u, 0u};
    f32x4 C[8];
#pragma unroll
    for (int i = 0; i < 8; ++i) C[i] = (f32x4){0.f, 0.f, 0.f, 0.f};
    float m = 0.f;
    const bf16_t* pj = p.PJ(); bf16_t* H = dir ? p.HB16() : p.HF16();
    const int colq = O_Q + h * QK, colk = O_K + h * QK, colv = O_V + h * MV + vhalf * 128;
    const unsigned srow0 = tid >> 4, sch = tid & 15u;
    u32x4 rq[2], rk[2], rv[2];
    const float* gbase = p.GATES() + dir * 8 + h;
#define ML_GATES(c, ig_, fg_) do { const float* g_ = gbase + (size_t)ml_tok(dir, b, (c) * 64 + (int)lane) * NG; ig_ = g_[0]; fg_ = g_[4]; } while (0)
    float ig0, fg0, ign = 0.f, fgn = 0.f; ML_GATES(0, ig0, fg0); if (S / 64 > 1) ML_GATES(1, ign, fgn);
#define ML_TAB(c) ((LAS float*)(L + SCT_OFF + (unsigned)((c) % 3) * SCT_BYTES))
    CS cs = {0.f, 0.f}, csn = {0.f, 0.f}; if (wave == 0) { cs = chunk_scalars(ig0, fg0, m, ML_TAB(0), true, lane); csn = cs; }
    const long sMW = dir ? -(long)MW : (long)MW;
#define ML_LOAD(c) do { _Pragma("unroll") for (int i_ = 0; i_ < 2; ++i_) { const bf16_t* rp = pj + (size_t)ml_tok(dir, b, (c) * 64 + srow0 + 32 * i_) * INM + 8 * sch; \
        rq[i_] = *(const u32x4*)(rp + colq); rk[i_] = *(const u32x4*)(rp + colk); rv[i_] = *(const u32x4*)(rp + colv); } } while (0)
#define ML_STORE(buf, S_) do { _Pragma("unroll") for (int i_ = 0; i_ < 2; ++i_) { const unsigned row = srow0 + 32u * i_, o = (buf) * BUF + off_a(row, sch); const float w = (S_)[192 + row]; \
        *(LAS u32x4*)(L + o) = rq[i_]; *(LAS u32x4*)(L + IMG + o) = rk[i_]; u32x4 v = rv[i_]; \
        v.x = cvtpk(bflo(v.x) * w, bfhi(v.x) * w); v.y = cvtpk(bflo(v.y) * w, bfhi(v.y) * w); v.z = cvtpk(bflo(v.z) * w, bfhi(v.z) * w); v.w = cvtpk(bflo(v.w) * w, bfhi(v.w) * w); \
        *(LAS u32x4*)(L + 2u * IMG + o) = v; } } while (0)
    __syncthreads();
    ML_LOAD(0); ML_STORE(0u, ML_TAB(0));
    constexpr int NC = S / 64;
    for (int c = 0; c < NC; ++c) {
        const unsigned cur = (unsigned)(c & 1);
        LAS unsigned char* Qi = L + cur * BUF; LAS unsigned char* Ki = Qi + IMG; LAS unsigned char* Vi = Qi + 2u * IMG; LAS unsigned char* Pt = L + PT_OFF + cur * PT_BYTES;
        float ig2 = 0.f, fg2 = 0.f;
        if (c + 1 < NC) { ML_LOAD(c + 1); if (wave == 0) { csn = chunk_scalars(ign, fgn, cs.m_next, ML_TAB(c + 1), true, lane); if (c + 2 < NC) ML_GATES(c + 2, ig2, fg2); } }
        __syncthreads();
#define ML_FLUSH(cprev) do { _Pragma("unroll") for (int i_ = 0; i_ < 2; ++i_) { const unsigned n_ = tid + 512u * i_, row_ = n_ >> 4, ch_ = n_ & 15u;     \
            const u32x4 v_ = *(const LAS u32x4*)(L + HT_OFF + 256u * row_ + 16u * (ch_ ^ (row_ & 15u))); \
            *(u32x4*)(H + (size_t)ml_tok(dir, b, (cprev) * 64 + (int)row_) * MW + h * MV + vhalf * 128 + 8 * (int)ch_) = v_; } } while (0)
        const LAS float* sct = ML_TAB(c); const float dcy = sct[256];
        if (c > 0) ML_FLUSH(c - 1);
#ifndef ML_REP_3B
#define ML_REP_3B 1
#define ML_REP_S 1
#define ML_REP_ST 1
#define ML_REP_3A 1
#define ML_REP_DEN 1
#endif
        f32x4 acc2[4];
#pragma unroll
        for (int tt = 0; tt < 4; ++tt) acc2[tt] = (f32x4){0.f, 0.f, 0.f, 0.f};
#pragma unroll
        for (int ks = 0; ks < 4; ++ks) {
            bf16x8 qa[4];
#pragma unroll
            for (int tt = 0; tt < 4; ++tt) {
                const u32x2 lo = *(const LAS u32x2*)(Qi + PB1 + 4096u * tt + 512u * ks), hi = *(const LAS u32x2*)(Qi + PB2 + 4096u * tt + 512u * ks);
                const u32x4 aw = {lo.x, lo.y, hi.x, hi.y}; qa[tt] = __builtin_bit_cast(bf16x8, aw); }
            const f32x4 c0 = C[2 * ks], c1 = C[2 * ks + 1];
            const u32x4 bw = {cvtpk(c0[0], c0[1]), cvtpk(c0[2], c0[3]), cvtpk(c1[0], c1[1]), cvtpk(c1[2], c1[3])}; const bf16x8 bfr = __builtin_bit_cast(bf16x8, bw);
#pragma unroll
            for (int tt = 0; tt < 4; ++tt) acc2[tt] = __builtin_amdgcn_mfma_f32_16x16x32_bf16(qa[tt], bfr, acc2[tt], 0, 0, 0);
        }
        bf16x8 vB[2];
#pragma unroll
        for (int ks = 0; ks < 2; ++ks) vB[ks] = cat8(trr(Vi + ML_TRA(wave, ks, 0)), trr(Vi + ML_TRA(wave, ks, 1)));
#pragma unroll
        for (int dt = 0; dt < 8; ++dt) C[dt] = C[dt] * dcy;
#pragma unroll
        for (int ks = 0; ks < 2; ++ks)
#pragma unroll
            for (int dh = 0; dh < 2; ++dh) { bf16x8 kA[4];
#pragma unroll
                for (int d4 = 0; d4 < 4; ++d4) kA[d4] = cat8(trr(Ki + ML_TRA(4 * dh + d4, ks, 0)), trr(Ki + ML_TRA(4 * dh + d4, ks, 1)));
#pragma unroll
                for (int d4 = 0; d4 < 4; ++d4) C[4 * dh + d4] = __builtin_amdgcn_mfma_f32_16x16x32_bf16(kA[d4], vB[ks], C[4 * dh + d4], 0, 0, 0); }
#pragma unroll
        for (int rep = 0; rep < 2; ++rep) { const int idx = wave + (rep ? 2 : 0);
            if (rep == 0 || wave >= 6) { const int tt = idx >= 6 ? 3 : (idx >= 3 ? 2 : (idx >= 1 ? 1 : 0)), st = idx - tt * (tt + 1) / 2;
                f32x4 sa = (f32x4){0.f, 0.f, 0.f, 0.f};
#pragma unroll
                for (int kh = 0; kh < 2; ++kh) { bf16x8 af[2], bfk[2];
#pragma unroll
                    for (int k2 = 0; k2 < 2; ++k2) { af[k2] = *(const LAS bf16x8*)(Qi + RA + 4096u * tt + 512u * (2 * kh + k2)); bfk[k2] = *(const LAS bf16x8*)(Ki + RA + 4096u * st + 512u * (2 * kh + k2)); }
#pragma unroll
                    for (int k2 = 0; k2 < 2; ++k2) sa = __builtin_amdgcn_mfma_f32_16x16x32_bf16(af[k2], bfk[k2], sa, 0, 0, 0); }
                const unsigned scol = 16u * st + r;
#pragma unroll
                for (int i = 0; i < 4; ++i) { const unsigned trow = 16u * tt + 4u * q + i; const float v = scol <= trow ? sa[i] : 0.f;
                    *(LAS bf16_t*)(Pt + off_p(trow, scol >> 3) + 2u * (scol & 7u)) = (bf16_t)cvtpk(v, 0.f); } } }
        if (c + 1 < NC) ML_STORE(cur ^ 1u, ML_TAB(c + 1));
        __syncthreads();
        { bf16x8 pf[6];
#pragma unroll
          for (int tt = 0; tt < 4; ++tt) { pf[tt] = *(const LAS bf16x8*)(Pt + PP0 + 2048u * tt); if (tt >= 2) pf[2 + tt] = *(const LAS bf16x8*)(Pt + PP1 + 2048u * tt); }
#pragma unroll
          for (int tt = 0; tt < 4; ++tt) { const f32x4 av4 = *(const LAS f32x4*)(sct + 16 * tt + 4 * q), bv4 = *(const LAS f32x4*)(sct + 64 + 16 * tt + 4 * q); f32x4 a1 = __builtin_amdgcn_mfma_f32_16x16x32_bf16(pf[tt], vB[0], (f32x4){0.f, 0.f, 0.f, 0.f}, 0, 0, 0);
            if (tt >= 2) a1 = __builtin_amdgcn_mfma_f32_16x16x32_bf16(pf[2 + tt], vB[1], a1, 0, 0, 0);
#pragma unroll
            for (int i = 0; i < 4; ++i) { const unsigned t = 16u * tt + 4u * q + i, col = 16u * (unsigned)wave + r;
                *(LAS bf16_t*)(L + HT_OFF + 256u * t + 16u * ((col >> 3) ^ (t & 15u)) + 2u * (col & 7u)) = (bf16_t)cvtpk(av4[i] * a1[i] + bv4[i] * acc2[tt][i], 0.f); } } }
        if (vhalf == 0) {
            const LAS float* n_old = (const LAS float*)(L + N_OFF + cur * 512u); LAS float* n_new = (LAS float*)(L + N_OFF + (cur ^ 1u) * 512u);
            bf16x8 wB[2];
#pragma unroll
            for (int ks = 0; ks < 2; ++ks) { const f32x4 w0 = *(const LAS f32x4*)(sct + 192 + 32 * ks + 8 * q), w1 = *(const LAS f32x4*)(sct + 192 + 32 * ks + 8 * q + 4);
                u32x4 w = {cvtpk(w0[0], w0[1]), cvtpk(w0[2], w0[3]), cvtpk(w1[0], w1[1]), cvtpk(w1[2], w1[3])};
                if (r != 0u) w = (u32x4){0u, 0u, 0u, 0u}; wB[ks] = __builtin_bit_cast(bf16x8, w); }
            const size_t dbase = ((size_t)dir * T) * MH + h;
            if (wave < 4) { const int tt = wave; f32x4 d2 = (f32x4){0.f, 0.f, 0.f, 0.f};
#pragma unroll
                for (int ks = 0; ks < 4; ++ks) { const f32x4 n0 = *(const LAS f32x4*)(n_old + 32 * ks + 4 * q), n1 = *(const LAS f32x4*)(n_old + 32 * ks + 16 + 4 * q);
                    u32x4 bw = {cvtpk(n0[0], n0[1]), cvtpk(n0[2], n0[3]), cvtpk(n1[0], n1[1]), cvtpk(n1[2], n1[3])}; if (r != 0u) bw = (u32x4){0u, 0u, 0u, 0u};
                    const u32x2 lo = *(const LAS u32x2*)(Qi + PB1 + 4096u * tt + 512u * ks), hi = *(const LAS u32x2*)(Qi + PB2 + 4096u * tt + 512u * ks);
                    const u32x4 aw = {lo.x, lo.y, hi.x, hi.y};
                    d2 = __builtin_amdgcn_mfma_f32_16x16x32_bf16(__builtin_bit_cast(bf16x8, aw), __builtin_bit_cast(bf16x8, bw), d2, 0, 0, 0); }
#pragma unroll
                for (int i = 0; i < 4; ++i) { const int t = 16 * tt + 4 * (int)q + i; const float bv = sct[64 + t], fl = sct[128 + t];
                    if (r == 0u) { const size_t di = dbase + (size_t)ml_tok(dir, b, c * 64 + t) * MH; p.DEN()[(size_t)2 * T * MH + di] = bv * d2[i]; p.FLR()[di] = fl; } }
            } else { const int tt = wave - 4; f32x4 d1 = (f32x4){0.f, 0.f, 0.f, 0.f};
#pragma unroll
                for (int ks = 0; ks < 2; ++ks) if (ks == 0 || tt >= 2) { const bf16x8 pf = *(const LAS bf16x8*)(Pt + (ks ? PP1 : PP0) + 2048u * tt);
                    d1 = __builtin_amdgcn_mfma_f32_16x16x32_bf16(pf, wB[ks], d1, 0, 0, 0); }
#pragma unroll
                for (int i = 0; i < 4; ++i) { const int t = 16 * tt + 4 * (int)q + i; const float av = sct[t];
                    if (r == 0u) p.DEN()[dbase + (size_t)ml_tok(dir, b, c * 64 + t) * MH] = av * d1[i]; } }
            { const int dt = wave; f32x4 nn = *(const LAS f32x4*)(n_old + 16 * dt + 4 * q) * dcy; if (r != 0u) nn = (f32x4){0.f, 0.f, 0.f, 0.f};
#pragma unroll
                for (int ks = 0; ks < 2; ++ks) { const bf16x8 kA = cat8(trr(Ki + ML_TRA(dt, ks, 0)), trr(Ki + ML_TRA(dt, ks, 1)));
                    nn = __builtin_amdgcn_mfma_f32_16x16x32_bf16(kA, wB[ks], nn, 0, 0, 0); }
                if (r == 0u) *(LAS f32x4*)(n_new + 16 * dt + 4 * q) = nn; }
        }
        m = cs.m_next; cs = csn; ign = ig2; fgn = fg2;
    }
    __syncthreads(); ML_FLUSH(NC - 1);
#undef ML_FLUSH
#undef ML_TRA
#undef ML_TABLE
#undef ML_LOAD
#undef ML_GATES
#undef ML_STORE
}
}
__device__ __forceinline__ void phase4(const Prm& p, const Frame& F) {
    static_assert(MV == 256 && MH == 4, "head j = float4 slot j of the lane");
    const int gw = F.bid * NWAVES + F.wave, NGW = F.G * NWAVES;
    for (int row = gw; row < T; row += NGW) {
        const uint2* hf = (const uint2*)(p.HF16() + (size_t)row * MW) + F.lane; const uint2* hb = (const uint2*)(p.HB16() + (size_t)row * MW) + F.lane;
        const uint2* og = (const uint2*)(p.PJ() + (size_t)row * INM + O_O) + F.lane; uint2* yo = (uint2*)(p.Y() + (size_t)row * D + CW) + F.lane;
#pragma unroll
        for (int j = 0; j < MH; ++j) {
            const float* d2 = p.DEN() + (size_t)2 * T * MH;
            const float i_f = 1.f / fmaxf(fabsf(p.DEN()[(size_t)row * MH + j] + d2[(size_t)row * MH + j]), p.FLR()[(size_t)row * MH + j]);
            const float i_b = 1.f / fmaxf(fabsf(p.DEN()[((size_t)T + row) * MH + j] + d2[((size_t)T + row) * MH + j]), p.FLR()[((size_t)T + row) * MH + j]);
            const uint2 a = hf[64 * j], b = hb[64 * j]; float4 h = make_float4(bflo(a.x) * i_f + bflo(b.x) * i_b, bfhi(a.x) * i_f + bfhi(b.x) * i_b, bflo(a.y) * i_f + bflo(b.y) * i_b, bfhi(a.y) * i_f + bfhi(b.y) * i_b);
            const float mean = wave_sum((h.x + h.y) + (h.z + h.w)) * (1.f / MV);
            h.x -= mean; h.y -= mean; h.z -= mean; h.w -= mean;
            const float rstd = 1.f / sqrtf(wave_sum((h.x * h.x + h.y * h.y) + (h.z * h.z + h.w * h.w)) * (1.f / MV) + LN_EPS);
            const float4 nw = *((const float4*)(p.mnorm_w + j * MV) + F.lane); const uint2 o = og[64 * j];
            yo[64 * j] = make_uint2(pk2(h.x * rstd * nw.x * sigmoidf_(bflo(o.x)), h.y * rstd * nw.y * sigmoidf_(bfhi(o.x))), pk2(h.z * rstd * nw.z * sigmoidf_(bflo(o.y)), h.w * rstd * nw.w * sigmoidf_(bfhi(o.y)))); }
    }
}
struct EpiZ {
    static constexpr bool PERM = true, AFTER_DRAIN = false;
    const float* x; const float* mod; bf16_t* out;
    __device__ __forceinline__ void operator()(const pg8::f32x4 (&acc)[2][2][4][2], const pg8::Unit& u, int wr, int wc, int fr, int fq) const {
        const int col0 = u.pn * 256 + wc * 32 + 8 * fq;
#pragma unroll
        for (int ai = 0; ai < 2; ++ai)
#pragma unroll
            for (int m = 0; m < 4; ++m) { const int row = u.pm * 256 + ai * 128 + wr * 64 + m * 16 + fr; const float* g1 = mod + (size_t)(row / S) * D6 + 2 * D; const size_t off = (size_t)row * D + col0;
#pragma unroll
                for (int bj = 0; bj < 2; ++bj) { const int c = bj * 128;
                    const pg8::f32x4 x0 = *(const pg8::f32x4*)(x + off + c), x1 = *(const pg8::f32x4*)(x + off + c + 4), g0 = *(const pg8::f32x4*)(g1 + col0 + c), g1v = *(const pg8::f32x4*)(g1 + col0 + c + 4);
                    const pg8::f32x4 z0 = x0 * ALPHA + g0 * acc[ai][bj][m][0], z1 = x1 * ALPHA + g1v * acc[ai][bj][m][1];
                    u32x4_t w = {pk2(z0[0], z0[1]), pk2(z0[2], z0[3]), pk2(z1[0], z1[1]), pk2(z1[2], z1[3])}; *(u32x4_t*)(out + off + c) = w; } }
    }
};

struct EpiF32 {
    static constexpr bool PERM = true, AFTER_DRAIN = false;
    float* out; int ldc;
    __device__ __forceinline__ void operator()(const pg8::f32x4 (&acc)[2][2][4][2], const pg8::Unit& u, int wr, int wc, int fr, int fq) const {
        const int col0 = u.pn * 256 + wc * 32 + 8 * fq;
#pragma unroll
        for (int ai = 0; ai < 2; ++ai)
#pragma unroll
            for (int m = 0; m < 4; ++m) { float* rowp = out + (size_t)(u.pm * 256 + ai * 128 + wr * 64 + m * 16 + fr) * ldc + col0;
#pragma unroll
                for (int bj = 0; bj < 2; ++bj) { *(pg8::f32x4*)(rowp + bj * 128) = acc[ai][bj][m][0]; *(pg8::f32x4*)(rowp + bj * 128 + 4) = acc[ai][bj][m][1]; } }
    }
};
__device__ __forceinline__ unsigned skey(float f) { const unsigned u = f_as_u(f); return (u & 0x80000000u) ? ~u : (u | 0x80000000u); }
__device__ __forceinline__ float unskey(unsigned k) { return u_as_f((k & 0x80000000u) ? (k & 0x7fffffffu) : ~k); }
__device__ __forceinline__ void tk_cx(unsigned& a, unsigned& b) { const unsigned hi = a > b ? a : b, lo = a > b ? b : a; a = hi; b = lo; }
__device__ __forceinline__ void tk_sort16(unsigned (&v)[16]) {
#pragma unroll
    for (int k = 2; k <= 16; k <<= 1)
#pragma unroll
        for (int j = k >> 1; j >= 1; j >>= 1)
#pragma unroll
            for (int i = 0; i < 16; ++i) { const int l = i ^ j; if (l > i) { if ((i & k) == 0) tk_cx(v[i], v[l]); else tk_cx(v[l], v[i]); } }
}
__device__ __forceinline__ void tk_merge16(unsigned (&L)[16], const unsigned (&C)[16]) {
#pragma unroll
    for (int i = 0; i < 16; ++i) L[i] = L[i] > C[15 - i] ? L[i] : C[15 - i];
#pragma unroll
    for (int j = 8; j >= 1; j >>= 1)
#pragma unroll
        for (int i = 0; i < 16; ++i) { const int l = i ^ j; if (l > i) tk_cx(L[i], L[l]); }
}
__device__ __forceinline__ void tk_top16(const float* sc, unsigned (&L)[16]) {
#pragma unroll 1
    for (int ch = 0; ch < NK / 16; ++ch) { unsigned C[16];
#pragma unroll
        for (int q4 = 0; q4 < 4; ++q4) { const float4 v = ((const float4*)sc)[4 * ch + q4]; const unsigned b = 127u - 16u * ch - 4u * q4;
            C[4 * q4] = (skey(v.x) & ~0x7fu) | b; C[4 * q4 + 1] = (skey(v.y) & ~0x7fu) | (b - 1); C[4 * q4 + 2] = (skey(v.z) & ~0x7fu) | (b - 2); C[4 * q4 + 3] = (skey(v.w) & ~0x7fu) | (b - 3); }
        tk_sort16(C);
        if (ch == 0) {
#pragma unroll
            for (int i = 0; i < 16; ++i) L[i] = C[i]; }
        else tk_merge16(L, C); }
}
__device__ __forceinline__ void phase8(const Prm& p, const Frame& F) {
    static_assert(NK == 128 && TOPK == 16, "top-k phase is specialised");
    const long gt = (long)F.bid * NTHR + F.tid, GT = (long)F.G * NTHR;
    LAS unsigned* ix = (LAS unsigned*)F.lds + F.tid;
    for (long i = gt; i < (long)T * PH; i += GT) {
        unsigned A[16], B[16];
        tk_top16(p.SC() + (size_t)i * 2 * NK, A); tk_top16(p.SC() + (size_t)i * 2 * NK + NK, B);
        float sa[16], sb[16];
#pragma unroll
        for (int k = 0; k < 16; ++k) { sa[k] = unskey(A[k] & ~0x7fu); sb[k] = unskey(B[k] & ~0x7fu); ix[NTHR * k] = 127u - (A[k] & 0x7fu); ix[NTHR * (16 + k)] = 127u - (B[k] & 0x7fu); }
        unsigned L[16], C[16]; int n = 0;
#pragma unroll
        for (int a = 0; a < 16; ++a)
#pragma unroll
            for (int b = 0; b < 16; ++b) if ((a + 1) * (b + 1) <= 16) { const unsigned key = (skey(sa[a] + sb[b]) & ~0xffu) | (unsigned)(255 - (16 * a + b));
                C[n & 15] = key; ++n;
                if ((n & 15) == 0 || n == 50) { if (n == 50) {
#pragma unroll
                        for (int z = 2; z < 16; ++z) C[z] = 0u; }
                    tk_sort16(C);
                    if (n == 16) {
#pragma unroll
                        for (int z = 0; z < 16; ++z) L[z] = C[z]; }
                    else tk_merge16(L, C); } }
        float V[16]; float sum = 0.f; const float vmax = unskey(L[0] & ~0xffu);
#pragma unroll
        for (int r = 0; r < 16; ++r) { V[r] = __expf(unskey(L[r] & ~0xffu) - vmax); sum += V[r]; }
        const float inv = 1.f / sum; int E[16];
#pragma unroll
        for (int r = 0; r < 16; ++r) { const unsigned fl = 255u - (L[r] & 0xffu); E[r] = (int)(ix[NTHR * (fl >> 4)] * NK + ix[NTHR * (16 + (fl & 15u))]); }
#pragma unroll
        for (int r = 0; r < 16; r += 4) { *(int4*)(p.EIDX() + (size_t)i * TOPK + r) = make_int4(E[r], E[r + 1], E[r + 2], E[r + 3]);
            *(float4*)(p.EW() + (size_t)i * TOPK + r) = make_float4(V[r] * inv, V[r + 1] * inv, V[r + 2] * inv, V[r + 3] * inv); }
    }
}
__device__ __forceinline__ void phase6(const Prm& p, const Frame& F) {
    LAS float* PW = (LAS float*)F.lds; LAS float* PB = PW + D; LAS float* PSH = PW + 2 * D; LAS float* PSC = PW + 3 * D;
    const int rows_per = T / F.G, r_begin = F.bid * rows_per, r_end = r_begin + rows_per;
    int cur_b = -1;
    for (int i = F.tid; i < D; i += NTHR) { PW[i] = p.ln1_w[i]; PB[i] = p.ln1_b[i]; }
    float4 v[8]; uint2 zb[8], zn[8];
    { const uint2* z0 = (const uint2*)((const bf16_t*)p.out + (size_t)(r_begin + F.wave) * D) + F.lane;
#pragma unroll
      for (int j = 0; j < 8; ++j) zb[j] = z0[64 * j]; }
    for (int r0 = r_begin; r0 < r_end; r0 += NWAVES) {
        const int row = r0 + F.wave, b = r0 / S;
        if (b != cur_b) { __syncthreads(); const float* mod = p.MOD() + (size_t)b * D6;
            for (int i = F.tid; i < D; i += NTHR) { PSH[i] = mod[3 * D + i]; PSC[i] = 1.f + mod[4 * D + i]; }
            cur_b = b; __syncthreads(); }
        uint2* x1r = (uint2*)(p.X1B() + (size_t)row * D) + F.lane;
        float s = 0.f;
        if (r0 + NWAVES < r_end) { const uint2* zp = (const uint2*)((const bf16_t*)p.out + (size_t)(row + NWAVES) * D) + F.lane;
#pragma unroll
            for (int j = 0; j < 8; ++j) zn[j] = zp[64 * j]; }
#pragma unroll
        for (int j = 0; j < 8; ++j) { v[j] = make_float4(bflo(zb[j].x), bfhi(zb[j].x), bflo(zb[j].y), bfhi(zb[j].y)); s += (v[j].x + v[j].y) + (v[j].z + v[j].w); }
        float mean = wave_sum(s) * (1.f / D), s2 = 0.f;
#pragma unroll
        for (int j = 0; j < 8; ++j) { v[j].x -= mean; v[j].y -= mean; v[j].z -= mean; v[j].w -= mean; s2 += (v[j].x * v[j].x + v[j].y * v[j].y) + (v[j].z * v[j].z + v[j].w * v[j].w); }
        float rstd = 1.f / sqrtf(wave_sum(s2) * (1.f / D) + LN_EPS); s = 0.f;
#pragma unroll
        for (int j = 0; j < 8; ++j) { const f4v w = *(const LAS f4v*)(PW + 4 * F.lane + 256 * j), bb = *(const LAS f4v*)(PB + 4 * F.lane + 256 * j);
            v[j].x = v[j].x * rstd * w[0] + bb[0]; v[j].y = v[j].y * rstd * w[1] + bb[1]; v[j].z = v[j].z * rstd * w[2] + bb[2]; v[j].w = v[j].w * rstd * w[3] + bb[3];
            x1r[64 * j] = make_uint2(pk2(v[j].x, v[j].y), pk2(v[j].z, v[j].w)); s += (v[j].x + v[j].y) + (v[j].z + v[j].w); }
        mean = wave_sum(s) * (1.f / D); s2 = 0.f;
#pragma unroll
        for (int j = 0; j < 8; ++j) { v[j].x -= mean; v[j].y -= mean; v[j].z -= mean; v[j].w -= mean; s2 += (v[j].x * v[j].x + v[j].y * v[j].y) + (v[j].z * v[j].z + v[j].w * v[j].w); }
        rstd = 1.f / sqrtf(wave_sum(s2) * (1.f / D) + LN_EPS);
        uint2* o8 = (uint2*)(p.U() + (size_t)row * D) + F.lane; unsigned* o4 = (unsigned*)(p.U2F8() + (size_t)row * D) + F.lane;
#pragma unroll
        for (int j = 0; j < 8; ++j) { const f4v sh = *(const LAS f4v*)(PSH + 4 * F.lane + 256 * j), sc = *(const LAS f4v*)(PSC + 4 * F.lane + 256 * j);
            const float u0 = v[j].x * rstd * sc[0] + sh[0], u1 = v[j].y * rstd * sc[1] + sh[1], u2_ = v[j].z * rstd * sc[2] + sh[2], u3 = v[j].w * rstd * sc[3] + sh[3];
            o8[64 * j] = make_uint2(pk2(u0, u1), pk2(u2_, u3));
            unsigned w8 = 0u; w8 = __builtin_amdgcn_cvt_pk_fp8_f32(u0 * 16.f, u1 * 16.f, w8, false); w8 = __builtin_amdgcn_cvt_pk_fp8_f32(u2_ * 16.f, u3 * 16.f, w8, true); o4[64 * j] = w8; }
#pragma unroll
        for (int j = 0; j < 8; ++j) zb[j] = zn[j];
    }
}
struct XW { int vx, nx, rank, nloc; };
constexpr int NDS = 8, DSW = D / NDS;
typedef float f2v __attribute__((ext_vector_type(2)));
typedef int i32x8_t __attribute__((ext_vector_type(8)));
constexpr unsigned P9_UROW = 133120u;
__device__ __forceinline__ void phase9(const Prm& p, const Frame& F, const XW& xw) {
    static_assert(DSW == 256 && NSLOT == 128 && D == 2048 && NWAVES * 16384 <= LDSCTL_OFF, "one 16 KB tile per wave");
    const unsigned q = F.lane >> 4, r = F.lane & 15u, l8 = F.lane >> 3, c8 = F.lane & 7u;
    const int tstep = xw.nloc * NWAVES, t0 = xw.rank * NWAVES + F.wave; const int nt = t0 < T ? (T - t0 + tstep - 1) / tstep : 0;
    LAS unsigned char* W = F.lds + F.wave * 16384; LAS unsigned char* ul = F.lds + P9_UROW + F.wave * 256;
    const unsigned goff = 16u * (c8 ^ l8);
    const unsigned rbase = 1024u * (r >> 3) + 128u * (r & 7u), x0 = rbase + 16u * (q ^ (r & 7u)), x1 = rbase + 16u * ((4u + q) ^ (r & 7u));
    const int sa1 = 0x7f7f7f7f;
    __syncthreads();
    for (int ds = xw.vx; ds < NDS; ds += xw.nx) {
        if (nt == 0) continue;
        const unsigned char* tbu = p.PU4() + (size_t)ds * ((size_t)NE * 128); _Float16* part_out = (_Float16*)p.SC() + (size_t)ds * T * NSLOT + 16u * r + 4u * q;
#define UPT(i) (t0 + ((i) < nt ? (i) : nt - 1) * tstep)
#define UPE(i, ea_, eb_) do { const int* ep_ = p.EIDX() + (size_t)UPT(i) * NSLOT + F.lane; ea_ = ep_[0]; eb_ = ep_[64]; } while (0)
#define UPU(i, U_) do { U_ = *(const unsigned*)(p.U2F8() + (size_t)UPT(i) * D + ds * DSW + 4u * F.lane); } while (0)
#define UPDMA(ea_, eb_) do { _Pragma("unroll") for (int k_ = 0; k_ < 16; ++k_) { const unsigned e_ = (unsigned)__shfl(k_ < 8 ? ea_ : eb_, 8 * (k_ & 7) + (int)l8); \
            __builtin_amdgcn_global_load_lds((const unsigned*)(tbu + ((e_ << 7) | goff)), (LAS unsigned*)(W + 1024 * k_), 16, 0, 0); } } while (0)
        int ea, eb; unsigned uc;
        { int e0a, e0b; UPE(0, e0a, e0b); UPDMA(e0a, e0b); UPE(1, ea, eb); UPU(0, uc); }
        for (int i = 0; i < nt; ++i) {
            asm volatile("s_waitcnt vmcnt(0)" ::: "memory");
            u32x4_t A[16];
#pragma unroll
            for (int g = 0; g < 8; ++g) { A[2 * g] = *(const LAS u32x4_t*)(W + x0 + 2048u * g); A[2 * g + 1] = *(const LAS u32x4_t*)(W + x1 + 2048u * g); }
            *(LAS unsigned*)(ul + 4u * F.lane) = uc;
            const u32x4_t b00 = *(const LAS u32x4_t*)(ul + 16u * q), b01 = *(const LAS u32x4_t*)(ul + 64u + 16u * q), b10 = *(const LAS u32x4_t*)(ul + 128u + 16u * q), b11 = *(const LAS u32x4_t*)(ul + 192u + 16u * q);
            asm volatile("s_waitcnt lgkmcnt(0)" ::: "memory");
            UPDMA(ea, eb); UPE(i + 2, ea, eb); UPU(i + 1, uc);
            const i32x8_t B0 = {(int)b00[0], (int)b00[1], (int)b00[2], (int)b00[3], (int)b01[0], (int)b01[1], (int)b01[2], (int)b01[3]};
            const i32x8_t B1 = {(int)b10[0], (int)b10[1], (int)b10[2], (int)b10[3], (int)b11[0], (int)b11[1], (int)b11[2], (int)b11[3]};
            pg8::f32x4 acc = {0.f, 0.f, 0.f, 0.f};
#pragma unroll
            for (int g = 0; g < 8; ++g) { const int sg = (r == (unsigned)g) ? 0x7f7f7f7f : 0;
                acc = __builtin_amdgcn_mfma_scale_f32_16x16x128_f8f6f4((i32x8_t){(int)A[2 * g][0], (int)A[2 * g][1], (int)A[2 * g][2], (int)A[2 * g][3], 0, 0, 0, 0}, B0, acc, 4, 0, 0, sa1, 0, sg);
                acc = __builtin_amdgcn_mfma_scale_f32_16x16x128_f8f6f4((i32x8_t){(int)A[2 * g + 1][0], (int)A[2 * g + 1][1], (int)A[2 * g + 1][2], (int)A[2 * g + 1][3], 0, 0, 0, 0}, B1, acc, 4, 0, 0, sa1, 0, sg); }
            if (r < 8u) { typedef _Float16 h4t __attribute__((ext_vector_type(4)));
                const h4t o_ = {(_Float16)(acc[0] * 0.0625f), (_Float16)(acc[1] * 0.0625f), (_Float16)(acc[2] * 0.0625f), (_Float16)(acc[3] * 0.0625f)}; *(h4t*)(part_out + (size_t)UPT(i) * NSLOT) = o_; }
        }
        asm volatile("s_waitcnt vmcnt(0)" ::: "memory");
#undef UPDMA
#undef UPU
#undef UPE
#undef UPT
    }
}
__device__ __forceinline__ void phase10(const Prm& p, const Frame& F) {
    static_assert(NE <= 16384 && NSLOT == 128 && T % 64 == 0, "14-bit expert id, 64-token groups");
    LAS unsigned* tile = (LAS unsigned*)F.lds;
    for (int tg = F.bid; tg < T / 64; tg += F.G) {
        __syncthreads();
#pragma unroll
        for (int k = 0; k < 2; ++k) { const int idx = F.tid + NTHR * k, tl = idx >> 4, so = idx & 15; const size_t i0 = ((size_t)tg * 64 + tl) * NSLOT + 8 * so;
            float sm[8];
#pragma unroll
            for (int j = 0; j < 8; ++j) sm[j] = 0.f;
#pragma unroll
            for (int ds = 0; ds < NDS; ++ds) { const uint4 q4 = *(const uint4*)((const _Float16*)p.SC() + (size_t)ds * T * NSLOT + i0);
                typedef _Float16 h2c __attribute__((ext_vector_type(2)));
                const unsigned qq[4] = {q4.x, q4.y, q4.z, q4.w};
#pragma unroll
                for (int j = 0; j < 4; ++j) { const h2c hv = __builtin_bit_cast(h2c, qq[j]); sm[2 * j] += (float)hv[0]; sm[2 * j + 1] += (float)hv[1]; } }
            const int4 ea = *(const int4*)(p.EIDX() + i0), eb = *(const int4*)(p.EIDX() + i0 + 4); const float4 ga = *(const float4*)(p.EW() + i0), gb = *(const float4*)(p.EW() + i0 + 4);
            const int ee[8] = {ea.x, ea.y, ea.z, ea.w, eb.x, eb.y, eb.z, eb.w}; const float gg[8] = {ga.x, ga.y, ga.z, ga.w, gb.x, gb.y, gb.z, gb.w};
#pragma unroll
            for (int j = 0; j < 8; ++j) { const int e = ee[j]; const _Float16 w = (_Float16)(gg[j] * gelu_exact(sm[j] * p.RSU()[e]) * p.RSV()[e] * 256.f);
                tile[tl * 129 + 8 * so + j] = (((unsigned)__builtin_bit_cast(unsigned short, w) << 16) & 0xFFFE0000u) | ((unsigned)e << 3); } }
        __syncthreads();
        uint4* pk = (uint4*)p.EW() + (size_t)tg * 64 * (NSLOT / 4);
#pragma unroll
        for (int k = 0; k < 4; ++k) { const int j = F.tid + NTHR * k, sq = j >> 6, tl = j & 63; const LAS unsigned* tp = tile + tl * 129 + 4 * sq; pk[j] = make_uint4(tp[0], tp[1], tp[2], tp[3]); }
    }
}
__device__ __forceinline__ void phase11(const Prm& p, const Frame& F) {
    static_assert(NE * 8 <= RING_BYTES && D % 8 == 0 && NE <= 65536, "table slice fits the LDS ring");
    typedef _Float16 h2v __attribute__((ext_vector_type(2)));
    const int c0 = (F.G % 8 == 0) ? (F.bid % 8) * (F.G / 8) + F.bid / 8 : F.bid;
    for (int sidx = c0; sidx < D / 8; sidx += F.G) {
        __syncthreads();
        { const uint4* src = (const uint4*)(p.PV8S() + (size_t)sidx * NE * 8);
          for (int i = F.tid; i < NE / 2; i += NTHR) *(LAS u32x4_t*)(F.lds + 16 * i) = __builtin_bit_cast(u32x4_t, src[i]); }
        __syncthreads();
        const int ntg = (T / 64 - F.wave + NWAVES - 1) / NWAVES, nb = 8 * ntg;
        uint4 b0[4], b1[4], b2[4], b3[4];
        const int kx = (F.G % 8 == 0) ? F.bid >> 3 : F.bid, rot = kx & 3, rotb = (kx >> 2) & 7;
#define DN_TG(bi) (F.wave + ((((bi) >> 3) + rot) % ntg) * NWAVES)
#define DN_PTR(bi) ((const uint4*)p.EW() + (size_t)DN_TG(bi) * 64 * (NSLOT / 4) + ((((bi) & 7) + rotb) & 7) * 4 * 64 + F.lane)
#define DN_LOAD(B, bi) do { const int bc_ = (bi) < nb ? (bi) : nb - 1; const uint4* pk_ = DN_PTR(bc_); _Pragma("unroll") for (int k = 0; k < 4; ++k) B[k] = pk_[k * 64]; } while (0)
#define DN_ONE(v_) do { const unsigned vv_ = (v_); const _Float16 w = __builtin_bit_cast(_Float16, (unsigned short)(vv_ >> 16)); const h2v w2 = {w, w}; \
                const u2v t = *(const LAS u2v*)(F.lds + (vv_ & 0x1FFF8u)); const unsigned tx_ = t.x, ty_ = t.y; \
                a0 += __builtin_amdgcn_cvt_scalef32_pk_f16_fp8(tx_, 1.0f, false) * w2; a1 += __builtin_amdgcn_cvt_scalef32_pk_f16_fp8(tx_, 1.0f, true) * w2; \
                a2 += __builtin_amdgcn_cvt_scalef32_pk_f16_fp8(ty_, 1.0f, false) * w2; a3 += __builtin_amdgcn_cvt_scalef32_pk_f16_fp8(ty_, 1.0f, true) * w2; } while (0)
#ifndef DN_REP
#define DN_REP 0
#endif
#define DN_ACC(B) do { _Pragma("unroll") for (int k = 0; k < 4; ++k) { DN_ONE(B[k].x); DN_ONE(B[k].y); DN_ONE(B[k].z); DN_ONE(B[k].w); } asm volatile("" ::: "memory"); \
            if (DN_REP) { const h2v s0_ = a0, s1_ = a1, s2_ = a2, s3_ = a3; for (int rep_ = 0; rep_ < DN_REP; ++rep_) { _Pragma("unroll") for (int k = 0; k < 4; ++k) { DN_ONE(B[k].x); DN_ONE(B[k].y); DN_ONE(B[k].z); DN_ONE(B[k].w); } \
                asm volatile("" :: "v"(a0), "v"(a1), "v"(a2), "v"(a3) : "memory"); } a0 = s0_; a1 = s1_; a2 = s2_; a3 = s3_; } } while (0)
        DN_LOAD(b0, 0); DN_LOAD(b1, 1); DN_LOAD(b2, 2);
        for (int bi = 0; bi < nb; bi += 8) {
            h2v a0 = {0, 0}, a1 = {0, 0}, a2 = {0, 0}, a3 = {0, 0};
            DN_LOAD(b3, bi + 3); DN_ACC(b0);
            DN_LOAD(b0, bi + 4); DN_ACC(b1);
            DN_LOAD(b1, bi + 5); DN_ACC(b2);
            DN_LOAD(b2, bi + 6); DN_ACC(b3);
            DN_LOAD(b3, bi + 7); DN_ACC(b0);
            DN_LOAD(b0, bi + 8); DN_ACC(b1);
            DN_LOAD(b1, bi + 9); DN_ACC(b2);
            DN_LOAD(b2, bi + 10); DN_ACC(b3);
            const int tg = DN_TG(bi); const float us = 1.f / 256.f;
            const uint4 yv = make_uint4(pk2((float)a0[0] * us, (float)a0[1] * us), pk2((float)a1[0] * us, (float)a1[1] * us), pk2((float)a2[0] * us, (float)a2[1] * us), pk2((float)a3[0] * us, (float)a3[1] * us));
            *(uint4*)(p.Y() + ((size_t)tg * 64 + F.lane) * D + 8 * sidx) = yv;
#if defined(DN_STORE_REP)
            for (int rep_ = 0; rep_ < DN_STORE_REP; ++rep_) { asm volatile("" ::: "memory"); __builtin_nontemporal_store(__builtin_bit_cast(u32x4_t, yv), (u32x4_t*)(p.Y() + ((size_t)tg * 64 + F.lane) * D + 8 * sidx)); }
#endif
        }
#undef DN_ACC
#undef DN_ONE
#undef DN_LOAD
#undef DN_PTR
#undef DN_TG
    }
}
__device__ __forceinline__ void phase12(const Prm& p, const Frame& F) {
    LAS float* PW = (LAS float*)F.lds; LAS float* PB = PW + D; LAS float* PG = PW + 2 * D;
    const int rows_per = T / F.G, r_begin = F.bid * rows_per, r_end = r_begin + rows_per;
    int cur_b = -1;
    for (int i = F.tid; i < D; i += NTHR) { PW[i] = p.ln2_w[i]; PB[i] = p.ln2_b[i]; }
    float4 v[8]; uint2 xb[8], xn[8], yb[8], yn[8];
    { const uint2* xr = (const uint2*)(p.X1B() + (size_t)(r_begin + F.wave) * D) + F.lane; const uint2* yr = (const uint2*)(p.Y() + (size_t)(r_begin + F.wave) * D) + F.lane;
#pragma unroll
      for (int j = 0; j < 8; ++j) { xb[j] = xr[64 * j]; yb[j] = yr[64 * j]; } }
    for (int r0 = r_begin; r0 < r_end; r0 += NWAVES) {
        const int row = r0 + F.wave, b = r0 / S;
        if (b != cur_b) { __syncthreads(); const float* g2 = p.MOD() + (size_t)b * D6 + 5 * D;
            for (int i = F.tid; i < D; i += NTHR) PG[i] = g2[i];
            cur_b = b; __syncthreads(); }
        float4* zr = (float4*)(p.out + (size_t)row * D) + F.lane; float s = 0.f;
        if (r0 + NWAVES < r_end) { const uint2* xp = (const uint2*)(p.X1B() + (size_t)(row + NWAVES) * D) + F.lane; const uint2* yp = (const uint2*)(p.Y() + (size_t)(row + NWAVES) * D) + F.lane;
#pragma unroll
            for (int j = 0; j < 8; ++j) { xn[j] = xp[64 * j]; yn[j] = yp[64 * j]; } }
#pragma unroll
        for (int j = 0; j < 8; ++j) { const f4v g = *(const LAS f4v*)(PG + 4 * F.lane + 256 * j);
            v[j].x = ALPHA * bflo(xb[j].x) + g[0] * bflo(yb[j].x); v[j].y = ALPHA * bfhi(xb[j].x) + g[1] * bfhi(yb[j].x); v[j].z = ALPHA * bflo(xb[j].y) + g[2] * bflo(yb[j].y); v[j].w = ALPHA * bfhi(xb[j].y) + g[3] * bfhi(yb[j].y);
            s += (v[j].x + v[j].y) + (v[j].z + v[j].w); }
        const float mean = wave_sum(s) * (1.f / D); float s2 = 0.f;
#pragma unroll
        for (int j = 0; j < 8; ++j) { v[j].x -= mean; v[j].y -= mean; v[j].z -= mean; v[j].w -= mean; s2 += (v[j].x * v[j].x + v[j].y * v[j].y) + (v[j].z * v[j].z + v[j].w * v[j].w); }
        const float rstd = 1.f / sqrtf(wave_sum(s2) * (1.f / D) + LN_EPS);
#pragma unroll
        for (int j = 0; j < 8; ++j) { const f4v w = *(const LAS f4v*)(PW + 4 * F.lane + 256 * j), bb = *(const LAS f4v*)(PB + 4 * F.lane + 256 * j);
            zr[64 * j] = make_float4(v[j].x * rstd * w[0] + bb[0], v[j].y * rstd * w[1] + bb[1], v[j].z * rstd * w[2] + bb[2], v[j].w * rstd * w[3] + bb[3]); }
#pragma unroll
        for (int j = 0; j < 8; ++j) { xb[j] = xn[j]; yb[j] = yn[j]; }
    }
}

struct Args { const float* in[18]; float* out; unsigned char* ws; int ph_lo, ph_hi, li, pad; };
__global__ void __launch_bounds__(NTHR, 2) mk_fwd(Args args) {
    extern __shared__ __attribute__((aligned(16))) unsigned char lds_raw[];
    Frame F; F.lds = (LAS unsigned char*)lds_raw; F.tid = threadIdx.x; F.lane = F.tid & 63; F.wave = __builtin_amdgcn_readfirstlane(F.tid >> 6); F.G = gridDim.x; F.bid = blockIdx.x;
    Prm p; p.x = args.in[0]; p.c = args.in[1]; p.w_ada = args.in[2]; p.b_ada = args.in[3]; p.w_in = args.in[4]; p.b_in = args.in[5]; p.conv_w = args.in[6]; p.conv_b = args.in[7]; p.mnorm_w = args.in[8];
    p.w_out = args.in[9]; p.ln1_w = args.in[10]; p.ln1_b = args.in[11]; p.wq = args.in[12]; p.subkeys = args.in[13]; p.peer_u = args.in[14]; p.peer_v = args.in[15]; p.ln2_w = args.in[16]; p.ln2_b = args.in[17];
    p.out = args.out; p.ws = args.ws;
    volatile LAS unsigned* MISC = (volatile LAS unsigned*)(F.lds + MISC_OFF);
    for (int u = F.tid; u < (LDS_BYTES - LDSCTL_OFF) / 4; u += NTHR) ((LAS unsigned*)(F.lds + LDSCTL_OFF))[u] = 0u;
    __syncthreads();
    const int lo = args.ph_lo, hi = args.ph_hi;
    XcdBarrier bar; bar.bar = (unsigned*)(p.ws + WS_CTL) + CW_BAR + args.li * XCD_BAR_WORDS; bar.x = 0; bar.st = nullptr;
    if (hi - lo > 1) bar = xcd_barrier_post((unsigned*)(p.ws + WS_CTL) + CW_BAR + args.li * XCD_BAR_WORDS, MISC + 8);
#define IN(k) (lo <= (k) && (k) < hi)
#define SEAM(k) do { if (IN(k) && IN((k) + 1)) xcd_barrier(bar); } while (0)
    XW xw; xw.nx = (F.G % 8 == 0) ? 8 : 1; xw.vx = F.bid % xw.nx; xw.rank = F.bid / xw.nx; xw.nloc = F.G / xw.nx;
#define XW_FROM_CENSUS() do { if (hi - lo > 1) { if (F.tid == 0) { unsigned vx_ = 0u; for (unsigned j = 0; j < bar.x; ++j) vx_ += xb_ld(&bar.bar[XB_XCNT(j)]) > 0u ? 1u : 0u; MISC[11] = vx_; } __syncthreads(); \
        xw.vx = (int)MISC[11]; xw.nx = (int)MISC[9]; xw.rank = (int)MISC[10] - 1; xw.nloc = (int)MISC[8]; } } while (0)
    if (IN(0)) { phase0(p, F); deferred_prep<false, true, true>(p, F, 0, F.G); } SEAM(0);
    if (IN(1)) { phase1(p, F); } SEAM(1);
    if (IN(2)) { pg8::Gemm g{p.U(), p.WIN_T(), T, INM, D}; pg8::StaticOrder So; So.init(T, INM, F.G, F.bid);
        pg8::EpiBf16<0> E{p.PJ(), INM, p.b_in, 0, 0, 1.f};
        pg8::gemm_phase<pg8::EpiBf16<0>, pg8::StaticOrder, true, true>(F.lds, g, So, E); } SEAM(2);
    if (IN(3)) { const int nmb = F.G >= 2 ? F.G / 2 : 1;
#ifndef P3_REP_ML
#define P3_REP_ML 1
#define P3_REP_CONV 1
#endif
        if (F.bid < nmb) { for (int rep_ = 0; rep_ < P3_REP_ML; ++rep_) for (int u = F.bid; u < 2 * NB * MH * 2; u += nmb) ml::unit(p, F, u); if (F.G < 2) phase3a(p, F, 0, 1); }
        else { phase3a(p, F, nmb, F.G - nmb); deferred_prep<true, false, false>(p, F, nmb, F.G - nmb); }
        if (F.G < 2) deferred_prep<true, false, false>(p, F, 0, 1); } SEAM(3);
    if (IN(4)) { phase4(p, F); } SEAM(4);
    if (IN(5)) { pg8::Gemm g{p.Y(), p.WOUT_T(), T, D, D}; pg8::StaticOrder So; So.init(T, D, F.G, F.bid);
        EpiZ E{p.x, p.MOD(), (bf16_t*)p.out};
        pg8::gemm_phase<EpiZ, pg8::StaticOrder, true, true>(F.lds, g, So, E); } SEAM(5);
    if (IN(6)) { phase6(p, F); } SEAM(6);
    if (IN(7)) { pg8::Gemm g{p.U(), p.WQ_T(), T, NQ, D}; pg8::StaticOrder So; So.init(T, NQ, F.G, F.bid);
        EpiF32 E{p.SC(), NSC};
        pg8::gemm_phase<EpiF32, pg8::StaticOrder, true, true>(F.lds, g, So, E); } SEAM(7);
    if (IN(8)) { phase8(p, F); } SEAM(8);
    if (IN(9)) { if (lo < 9) XW_FROM_CENSUS(); phase9(p, F, xw); } SEAM(9);
    if (IN(10)) { phase10(p, F); } SEAM(10);
    if (IN(11)) { phase11(p, F); } SEAM(11);
    if (IN(12)) { phase12(p, F); }
#undef IN
#undef SEAM
}

extern "C" void kernel_launch(void* const* d_in, const int* in_sizes, int n_in, void* d_out, int out_size, void* d_ws, size_t ws_size, hipStream_t stream) {
    static int grid = 0;
    if (grid == 0) {
        if (n_in != 18 || out_size != T * D || ws_size < WS_END) { fprintf(stderr, "kernel_launch: unexpected shapes (n_in %d out %d ws %zu, need %zu)\n", n_in, out_size, ws_size, (size_t)WS_END); grid = -1; return; }
        int dev = 0, cus = 0, per_cu = 0;
        if (hipGetDevice(&dev) != hipSuccess || hipDeviceGetAttribute(&cus, hipDeviceAttributeMultiprocessorCount, dev) != hipSuccess) { grid = -1; return; }
        if (hipFuncSetAttribute((const void*)mk_fwd, hipFuncAttributeMaxDynamicSharedMemorySize, LDS_BYTES) != hipSuccess) { fprintf(stderr, "kernel_launch: hipFuncSetAttribute failed\n"); grid = -1; return; }
        if (hipOccupancyMaxActiveBlocksPerMultiprocessor(&per_cu, (const void*)mk_fwd, NTHR, LDS_BYTES) != hipSuccess || per_cu < 1) { fprintf(stderr, "kernel_launch: the occupancy query reports %d workgroups per CU for this kernel + LDS size: the grid barrier would not be legal, not launching\n", per_cu); grid = -1; return; }
        grid = cus;
        if (T % grid != 0 || (T / grid) % (2 * NWAVES) != 0) { fprintf(stderr, "kernel_launch: grid %d does not divide the rows\n", grid); grid = -1; return; }
    }
    if (grid < 0) return;
    (void)hipMemsetAsync((char*)d_ws + WS_CTL, 0, 1u << 20, stream);
    Args a{};
    for (int i = 0; i < 18; ++i) a.in[i] = (const float*)d_in[i];
    a.out = (float*)d_out; a.ws = (unsigned char*)d_ws;
#if defined(PROBE_A)
    a.ph_lo = 0; a.ph_hi = PROBE_B + 1; a.li = 0; hipLaunchKernelGGL(mk_fwd, dim3(grid), dim3(NTHR), LDS_BYTES, stream, a);
    a.ph_lo = PROBE_A; a.ph_hi = NPHASE; a.li = 1; hipLaunchKernelGGL(mk_fwd, dim3(grid), dim3(NTHR), LDS_BYTES, stream, a);
#elif MK_N_LAUNCHES == 1
    a.ph_lo = 0; a.ph_hi = NPHASE;
    hipLaunchKernelGGL(mk_fwd, dim3(grid), dim3(NTHR), LDS_BYTES, stream, a);
#else
    for (int k = 0; k < NPHASE; ++k) { a.ph_lo = k; a.ph_hi = k + 1; hipLaunchKernelGGL(mk_fwd, dim3(grid), dim3(NTHR), LDS_BYTES, stream, a); }
#endif
}
```

```cpp
#define MK_N_LAUNCHES 1
#if defined(HOST_EMU)
#include <cmath>
#include <cstdint>
#include <cstring>
#include <cstddef>
#define HD inline
#define HDF inline
#else
#include <hip/hip_runtime.h>
#define HD __host__ __device__ __forceinline__
#define HDF __host__ __device__ __forceinline__
#endif

#ifndef CFG_D
#define CFG_D 2048
#define CFG_B 8
#define CFG_S 2048
#define CFG_PH 8
#define CFG_NK 128
#define CFG_TOPK 16
#define CFG_KD 256
#endif
constexpr int D = CFG_D, NB = CFG_B, S = CFG_S, T = NB * S;
constexpr int CW = D / 2, MW = D - CW, MH = 4, MV = MW / MH, QK = MV / 2, NG = 16, CHUNK = 64;
constexpr int INC = 3 * CW + 2 * MH * QK + 2 * MW + NG;
constexpr int INM = INC - NG;
constexpr int O_GB = 0, O_GC = CW, O_HIN = 2 * CW, O_Q = 3 * CW, O_K = O_Q + MH * QK, O_V = O_K + MH * QK, O_O = O_V + MW;
constexpr int PH = CFG_PH, NK = CFG_NK, TOPK = CFG_TOPK, KD = CFG_KD, KH = KD / 2, NE = NK * NK, NSLOT = PH * TOPK;
constexpr int NQ = PH * KD;
static_assert(PH * 2 * NK == NQ || true, "");
constexpr int NSC = PH * 2 * NK;
constexpr float LN_EPS = 1e-5f;
constexpr float ALPHA = 1.189207115002721f;
constexpr int D6 = 6 * D;

typedef unsigned short bf16_t;
HDF unsigned f_as_u(float f) { unsigned u; memcpy(&u, &f, 4); return u; }
HDF float u_as_f(unsigned u) { float f; memcpy(&f, &u, 4); return f; }
HDF bf16_t f2bf(float f) { unsigned u = f_as_u(f); return (bf16_t)((u + 0x7fffu + ((u >> 16) & 1u)) >> 16); }
HDF float bf2f(bf16_t h) { return u_as_f((unsigned)h << 16); }

constexpr size_t al(size_t x) { return (x + 1048575) & ~(size_t)1048575; }
constexpr size_t WS_CTL = 0;
constexpr size_t WS_MOD = al(1);
constexpr size_t WS_MODP = WS_MOD + al((size_t)NB * D6 * 4);
constexpr int NKS = 32;
constexpr size_t WS_GATES = WS_MODP + al((size_t)NKS * NB * D6 * 4);
constexpr size_t WS_DEN = WS_GATES + al((size_t)T * NG * 4);
constexpr size_t WS_FLR = WS_DEN + al((size_t)4 * T * MH * 4);
constexpr size_t WS_EIDX = WS_FLR + al((size_t)2 * T * MH * 4);
constexpr size_t WS_EW = WS_EIDX + al((size_t)T * NSLOT * 4);
constexpr size_t WS_WIN_T = WS_EW + al((size_t)T * NSLOT * 4);
constexpr size_t WS_WOUT_T = WS_WIN_T + al((size_t)INM * D * 2);
constexpr size_t WS_WQ_T = WS_WOUT_T + al((size_t)D * D * 2);
constexpr size_t WS_PU16 = WS_WQ_T + al((size_t)NQ * D * 2);
constexpr size_t WS_PV16 = WS_PU16 + al((size_t)NE * D * 2);
constexpr size_t WS_U = WS_PV16 + al((size_t)NE * D * 2);
constexpr size_t WS_Y = WS_U + al((size_t)T * D * 2);
constexpr size_t WS_P = WS_Y + al((size_t)T * D * 2);
constexpr size_t WS_SC = WS_P;
constexpr size_t WS_TS = WS_SC + al((size_t)T * NSC * 4);
constexpr size_t WS_TI = WS_TS + al((size_t)T * PH * 2 * TOPK * 4);
constexpr size_t WS_P_END = WS_P + al((size_t)T * INM * 2);
constexpr size_t WS_TI_END = WS_TI + al((size_t)T * PH * 2 * TOPK * 4);
constexpr size_t WS_END = WS_P_END > WS_TI_END ? WS_P_END : WS_TI_END;

struct Prm {
    const float *x, *c, *w_ada, *b_ada, *w_in, *b_in, *conv_w, *conv_b, *mnorm_w, *w_out, *ln1_w, *ln1_b, *wq, *subkeys, *peer_u, *peer_v, *ln2_w, *ln2_b;
    float* out;
    unsigned char* ws;
    HDF float* MOD() const { return (float*)(ws + WS_MOD); }
    HDF float* MODP() const { return (float*)(ws + WS_MODP); }
    HDF float* BIN256() const { return (float*)(ws + WS_MODP); }
    HDF float* GATES() const { return (float*)(ws + WS_GATES); }
    HDF float* DEN() const { return (float*)(ws + WS_DEN); }
    HDF float* FLR() const { return (float*)(ws + WS_FLR); }
    HDF int* EIDX() const { return (int*)(ws + WS_EIDX); }
    HDF float* EW() const { return (float*)(ws + WS_EW); }
    HDF bf16_t* WIN_T() const { return (bf16_t*)(ws + WS_WIN_T); }
    HDF unsigned char* WIN8() const { return ws + WS_WIN_T; }
    HDF unsigned char* U8() const { return ws + WS_U; }
    HDF bf16_t* WOUT_T() const { return (bf16_t*)(ws + WS_WOUT_T); }
    HDF bf16_t* WQ_T() const { return (bf16_t*)(ws + WS_WQ_T); }
    HDF bf16_t* PU16() const { return (bf16_t*)(ws + WS_PU16); }
    HDF bf16_t* PV16() const { return (bf16_t*)(ws + WS_PV16); }
    HDF unsigned char* PU8() const { return ws + WS_PU16; }
    HDF unsigned char* PV8() const { return ws + WS_PV16; }
    HDF unsigned char* PU4() const { return ws + WS_PU16; }
    HDF unsigned char* U2F8() const { return ws + WS_PV16 + (size_t)NE * D; }
    HDF unsigned char* PV8S() const { return ws + WS_PV16; }
    HDF float* RSU() const { return (float*)(ws + WS_PU16 + (size_t)NE * D); }
    HDF float* RSV() const { return (float*)(ws + WS_PU16 + (size_t)NE * D + (size_t)NE * 4); }
    HDF bf16_t* U() const { return (bf16_t*)(ws + WS_U); }
    HDF bf16_t* Y() const { return (bf16_t*)(ws + WS_Y); }
    HDF bf16_t* PJ() const { return (bf16_t*)(ws + WS_P); }
    HDF float* SC() const { return (float*)(ws + WS_SC); }
    HDF bf16_t* X1B() const { return (bf16_t*)(ws + WS_TS); }
    HDF float* TS() const { return (float*)(ws + WS_TS); }
    HDF int* TI() const { return (int*)(ws + WS_TI); }
    HDF float* HF() const { return out; }
    HDF float* HB() const { return out + (size_t)T * MW; }
    HDF bf16_t* HF16() const { return (bf16_t*)out; }
    HDF bf16_t* HB16() const { return (bf16_t*)out + (size_t)T * MW; }
};

HDF float sigmoidf_(float x) { return 1.f / (1.f + expf(-x)); }
HDF float logsigmoidf_(float x) { return fminf(x, 0.f) - log1pf(expf(-fabsf(x))); }
HDF float gelu_exact(float x) { return 0.5f * x * (1.f + erff(x * 0.7071067811865476f)); }

HD void b_ada(const Prm& p, long n) {
    float acc[NB];
#pragma unroll
    for (int b = 0; b < NB; ++b) acc[b] = 0.f;
    for (int k = 0; k < D; ++k) {
        const float w = p.w_ada[(size_t)k * D6 + n];
#pragma unroll
        for (int b = 0; b < NB; ++b) { const float cv = p.c[b * D + k]; acc[b] += cv * sigmoidf_(cv) * w; }
    }
#pragma unroll
    for (int b = 0; b < NB; ++b) p.MOD()[(size_t)b * D6 + n] = acc[b] + p.b_ada[n];
}
HD void b_wt(const float* W, int ldw, int K, bf16_t* WT, long i) { const long n = i / K, k = i % K; WT[i] = f2bf(W[(size_t)k * ldw + n]); }
HD void b_tab(const float* src, bf16_t* dst, long i) { dst[i] = f2bf(src[i]); }
HD void b_ln_mod1(const Prm& p, long row) {
    const float* xr = p.x + (size_t)row * D; const int b = (int)(row / S);
    const float* sh = p.MOD() + (size_t)b * D6; const float* sc = sh + D;
    float s = 0.f; for (int d = 0; d < D; ++d) s += xr[d];
    const float mean = s / D; float q = 0.f; for (int d = 0; d < D; ++d) { const float t = xr[d] - mean; q += t * t; }
    const float rstd = 1.f / sqrtf(q / D + LN_EPS);
    for (int d = 0; d < D; ++d) p.U()[(size_t)row * D + d] = f2bf((xr[d] - mean) * rstd * (1.f + sc[d]) + sh[d]);
}
HD void b_gates(const Prm& p, long i) {
    const long row = i / NG; const int g = (int)(i % NG); float acc = 0.f;
    for (int d = 0; d < D; ++d) acc += bf2f(p.U()[(size_t)row * D + d]) * p.w_in[(size_t)d * INC + INM + g];
    p.GATES()[i] = acc + p.b_in[INM + g];
}
HD float b_dot16(const bf16_t* a, const bf16_t* b, int K) { float acc = 0.f; for (int k = 0; k < K; ++k) acc += bf2f(a[k]) * bf2f(b[k]); return acc; }
HD void b_gemm1(const Prm& p, long i) { const long row = i / INM; const int n = (int)(i % INM);
    p.PJ()[i] = f2bf(b_dot16(p.U() + (size_t)row * D, p.WIN_T() + (size_t)n * D, D) + p.b_in[n]); }
HD void b_conv(const Prm& p, long i) {
    const long row = i / CW; const int ch = (int)(i % CW); const int s = (int)(row % S);
    const bf16_t* pj = p.PJ(); float acc = p.conv_b[ch];
#pragma unroll
    for (int k = 0; k < 3; ++k) { const int s2 = s + k - 1; if (s2 >= 0 && s2 < S) { const size_t r2 = (size_t)(row + k - 1) * INM;
        acc += p.conv_w[k * CW + ch] * (bf2f(pj[r2 + O_GC + ch]) * bf2f(pj[r2 + O_HIN + ch])); } }
    p.Y()[(size_t)row * D + ch] = f2bf(bf2f(pj[(size_t)row * INM + O_GB + ch]) * acc);
}
HDF long ml_tok(int dir, int b, int pos) { return (long)b * S + (dir ? S - 1 - pos : pos); }
HD void b_mscan(const Prm& p, long i) {
    const int v = (int)(i % (MV + 1)), h = (int)((i / (MV + 1)) % MH), b = (int)((i / ((MV + 1) * MH)) % NB), dir = (int)(i / ((MV + 1) * MH * NB));
    float C[QK];
#pragma unroll
    for (int d = 0; d < QK; ++d) C[d] = 0.f;
    float m = 0.f; const float qs = 1.f / sqrtf((float)QK);
    float* H = dir ? p.HB() : p.HF();
    for (int pos = 0; pos < S; ++pos) {
        const long tok = ml_tok(dir, b, pos); const float* g = p.GATES() + tok * NG + dir * 8;
        const float ig = g[h], lf = logsigmoidf_(g[4 + h]);
        const float mn = fmaxf(lf + m, ig), dec = expf(lf + m - mn), wi = expf(ig - mn); m = mn;
        const bf16_t* pj = p.PJ() + (size_t)tok * INM; const float wv = wi * (v < MV ? bf2f(pj[O_V + h * MV + (v < MV ? v : 0)]) : 1.f); float num = 0.f;
#pragma unroll
        for (int d = 0; d < QK; ++d) { C[d] = dec * C[d] + wv * bf2f(pj[O_K + h * QK + d]); num += bf2f(pj[O_Q + h * QK + d]) * qs * C[d]; }
        if (v < MV) H[(size_t)tok * MW + h * MV + v] = num;
        else { p.DEN()[((size_t)dir * T + tok) * MH + h] = num; p.FLR()[((size_t)dir * T + tok) * MH + h] = expf(-mn); }
    }
}
HD void b_headnorm(const Prm& p, long i) {
    const long row = i / MH; const int h = (int)(i % MH);
    const float* hf = p.HF() + (size_t)row * MW + h * MV; const float* hb = p.HB() + (size_t)row * MW + h * MV;
    const float inf_ = 1.f / fmaxf(fabsf(p.DEN()[(size_t)row * MH + h]), p.FLR()[(size_t)row * MH + h]);
    const float inb_ = 1.f / fmaxf(fabsf(p.DEN()[((size_t)T + row) * MH + h]), p.FLR()[((size_t)T + row) * MH + h]);
    float s = 0.f; for (int v = 0; v < MV; ++v) s += hf[v] * inf_ + hb[v] * inb_;
    const float mean = s / MV; float q = 0.f; for (int v = 0; v < MV; ++v) { const float t = hf[v] * inf_ + hb[v] * inb_ - mean; q += t * t; }
    const float rstd = 1.f / sqrtf(q / MV + LN_EPS);
    for (int v = 0; v < MV; ++v) { const float hn = (hf[v] * inf_ + hb[v] * inb_ - mean) * rstd * p.mnorm_w[h * MV + v];
        const float og = sigmoidf_(bf2f(p.PJ()[(size_t)row * INM + O_O + h * MV + v]));
        p.Y()[(size_t)row * D + CW + h * MV + v] = f2bf(og * hn); }
}
HD void b_gemm2(const Prm& p, long i) { const long row = i / D; const int n = (int)(i % D); const int b = (int)(row / S);
    const float acc = b_dot16(p.Y() + (size_t)row * D, p.WOUT_T() + (size_t)n * D, D);
    p.out[i] = ALPHA * p.x[i] + p.MOD()[(size_t)b * D6 + 2 * D + n] * acc; }
HD void b_ln_mid(const Prm& p, long row) {
    float* zr = p.out + (size_t)row * D; const int b = (int)(row / S);
    const float* sh = p.MOD() + (size_t)b * D6 + 3 * D; const float* sc = sh + D;
    float s = 0.f; for (int d = 0; d < D; ++d) s += zr[d];
    float mean = s / D; float q = 0.f; for (int d = 0; d < D; ++d) { const float t = zr[d] - mean; q += t * t; }
    float rstd = 1.f / sqrtf(q / D + LN_EPS);
    s = 0.f; for (int d = 0; d < D; ++d) { const float x1 = (zr[d] - mean) * rstd * p.ln1_w[d] + p.ln1_b[d]; zr[d] = x1; s += x1; }
    mean = s / D; q = 0.f; for (int d = 0; d < D; ++d) { const float t = zr[d] - mean; q += t * t; }
    rstd = 1.f / sqrtf(q / D + LN_EPS);
    for (int d = 0; d < D; ++d) p.U()[(size_t)row * D + d] = f2bf((zr[d] - mean) * rstd * (1.f + sc[d]) + sh[d]);
}
HD void b_gemm3(const Prm& p, long i) { const long row = i / NQ; const int n = (int)(i % NQ);
    p.Y()[i] = f2bf(b_dot16(p.U() + (size_t)row * D, p.WQ_T() + (size_t)n * D, D)); }
HD void b_scores(const Prm& p, long i) { const long tok = i / NSC; const int c = (int)(i % NSC), grp = c / NK, n = c % NK;
    const bf16_t* q = p.Y() + (size_t)tok * NQ + grp * KH; const float* sk = p.subkeys + ((size_t)grp * NK + n) * KH; float acc = 0.f;
    for (int d = 0; d < KH; ++d) acc += bf2f(q[d]) * sk[d];
    p.SC()[i] = acc; }
HD void b_topk1(const Prm& p, long i) {
    const float* sc = p.SC() + (size_t)i * NK; float pv = INFINITY; int pi = -1;
    for (int r = 0; r < TOPK; ++r) { float best = -INFINITY; int bi = -1;
        for (int n = 0; n < NK; ++n) { const float v = sc[n]; const bool ok = (v < pv) || (v == pv && n > pi); if (ok && v > best) { best = v; bi = n; } }
        p.TS()[(size_t)i * TOPK + r] = best; p.TI()[(size_t)i * TOPK + r] = bi; pv = best; pi = bi; }
}
HD void b_topk2(const Prm& p, long i) {
    const float* s0 = p.TS() + (size_t)i * 2 * TOPK; const float* s1 = s0 + TOPK; const int* i0 = p.TI() + (size_t)i * 2 * TOPK; const int* i1 = i0 + TOPK;
    float pv = INFINITY; int pi = -1; float mx = 0.f, sum = 0.f;
    for (int r = 0; r < TOPK; ++r) { float best = -INFINITY; int bi = -1;
        for (int c = 0; c < TOPK * TOPK; ++c) { const float v = s0[c / TOPK] + s1[c % TOPK]; const bool ok = (v < pv) || (v == pv && c > pi); if (ok && v > best) { best = v; bi = c; } }
        if (r == 0) mx = best;
        const float e = expf(best - mx); sum += e;
        p.EIDX()[(size_t)i * TOPK + r] = i0[bi / TOPK] * NK + i1[bi % TOPK]; p.EW()[(size_t)i * TOPK + r] = e; pv = best; pi = bi; }
    for (int r = 0; r < TOPK; ++r) p.EW()[(size_t)i * TOPK + r] /= sum;
}
HD void b_up(const Prm& p, long i) { const long tok = i / NSLOT; const int e = p.EIDX()[i];
    p.EW()[i] *= gelu_exact(b_dot16(p.U() + (size_t)tok * D, p.PU16() + (size_t)e * D, D)); }
HD void b_down(const Prm& p, long i) { const long tok = i / D; const int d = (int)(i % D); const int b = (int)(tok / S); float y = 0.f;
    for (int sl = 0; sl < NSLOT; ++sl) y += p.EW()[tok * NSLOT + sl] * bf2f(p.PV16()[(size_t)p.EIDX()[tok * NSLOT + sl] * D + d]);
    p.out[i] = ALPHA * p.out[i] + p.MOD()[(size_t)b * D6 + 5 * D + d] * y; }
HD void b_ln2(const Prm& p, long row) {
    float* zr = p.out + (size_t)row * D;
    float s = 0.f; for (int d = 0; d < D; ++d) s += zr[d];
    const float mean = s / D; float q = 0.f; for (int d = 0; d < D; ++d) { const float t = zr[d] - mean; q += t * t; }
    const float rstd = 1.f / sqrtf(q / D + LN_EPS);
    for (int d = 0; d < D; ++d) zr[d] = (zr[d] - mean) * rstd * p.ln2_w[d] + p.ln2_b[d];
}
#include <cstdio>
#define LAS __attribute__((address_space(3)))
#define GAS __attribute__((address_space(1)))
namespace pg8 {
#define PG8_LAS __attribute__((address_space(3)))
typedef unsigned short bf16_t;
typedef short bf16x8 __attribute__((ext_vector_type(8)));
typedef float f32x4 __attribute__((ext_vector_type(4)));
typedef unsigned u32x4 __attribute__((ext_vector_type(4)));
constexpr int BM = 256, BK = 64, HALF = 128, HTB = HALF * BK * 2  , STAGE_BYTES = 8 * HTB, NXCD = 8, WGM = 8;

__host__ __device__ __forceinline__ int lds_byte(int r, int c) { const int st = (r >> 4) * 2 + (c >> 5), rr = r & 15, cc = c & 31, ob = rr * 64 + cc * 2; return st * 1024 + (ob ^ (((ob >> 9) & 1) << 5)); }
__host__ __device__ __forceinline__ void stage_rc(int b, int& R, int& C) { const int st = b / 1024, sb = b % 1024, swz = sb ^ (((sb >> 9) & 1) << 5); R = (st >> 1) * 16 + swz / 64; C = (st & 1) * 32 + (swz % 64) / 2; }
__host__ __device__ __forceinline__ int perm32(int rho) { const int n = rho >> 4, i = rho & 15; return 8 * (i >> 2) + 4 * n + (i & 3); }

struct Unit { int pm, pn; };
struct Gemm { const bf16_t* A; const bf16_t* Bt; int M, N, K; };

struct StaticOrder {
    int nM, nN, nwg, G, c;
    __host__ __device__ void init(int M, int N, int G_, int c_) { nM = M / BM; nN = N / BM; nwg = nM * nN; G = G_; c = c_; }
    __host__ __device__ bool next(int i, Unit& u) const {
        const long L = (long)i * G + c; if (L >= nwg) return false;
        int wgid = (int)L; { const int q = nwg / NXCD, r = nwg % NXCD, xcd = wgid % NXCD, off = wgid / NXCD; wgid = (xcd < r ? xcd * (q + 1) : r * (q + 1) + (xcd - r) * q) + off; }
        const int nig = WGM * nN, gid = wgid / nig, fm = gid * WGM, gsz = (nM - fm) < WGM ? (nM - fm) : WGM;
        u.pm = fm + ((wgid % nig) % gsz); u.pn = (wgid % nig) / gsz; return true;
    }
    __device__ __forceinline__ void a_ready(const Unit&) const {}
    __device__ __forceinline__ void done(const Unit&) const {}
};

__device__ __forceinline__ unsigned cvt_pk_bf16(float lo, float hi) { unsigned r; asm volatile("v_cvt_pk_bf16_f32 %0, %1, %2" : "=v"(r) : "v"(lo), "v"(hi)); return r; }
typedef float f32x2 __attribute__((ext_vector_type(2)));
__device__ __forceinline__ f32x2 gelu_pk(f32x2 v) {
    const f32x2 av = __builtin_elementwise_abs(v), d = av * 0.2316418882f + 1.0f;
    f32x2 t; t.x = __builtin_amdgcn_rcpf(d.x); t.y = __builtin_amdgcn_rcpf(d.y);
    f32x2 q = t * 0.5307027145f + (-0.7265760135f); q = q * t + 0.7107068705f; q = q * t + (-0.142248368f); q = q * t + 0.127414796f; q = q * t;
    const f32x2 s = (v * v) * (-0.72134752044f);
    f32x2 e; e.x = __builtin_amdgcn_exp2f(s.x); e.y = __builtin_amdgcn_exp2f(s.y);
    const f32x2 m = v * (q * e), r = v - m;
    f32x2 o; o.x = v.x < 0.f ? m.x : r.x; o.y = v.y < 0.f ? m.y : r.y; return o;
}

template <int ACT  > struct EpiBf16 {
    static constexpr bool PERM = true, AFTER_DRAIN = false; static_assert(ACT == 0 || ACT == 1, "EpiBf16: ACT is 0 (none) or 1 (gelu_pk)");
    bf16_t* O; int ldc; const float* bias; int split_cols; size_t split_stride; float scale0;
    __device__ __forceinline__ void operator()(const f32x4 (&acc)[2][2][4][2], const Unit& u, int wr, int wc, int fr, int fq) const {
        const int row0 = u.pm * BM + wr * 64 + fr; int colt = u.pn * BM; bf16_t* base = O;
        float sc = 1.f; if (split_cols) { const int t = colt / split_cols; base += (size_t)t * split_stride; colt -= t * split_cols; if (t == 0) sc = scale0; }
        const int col0 = colt + wc * 32 + 8 * fq, bcol0 = u.pn * BM + wc * 32 + 8 * fq;
        f32x4 bv[2][2];
#pragma unroll
        for (int bj = 0; bj < 2; ++bj)
#pragma unroll
            for (int n = 0; n < 2; ++n) bv[bj][n] = bias ? *(const f32x4*)(bias + bcol0 + bj * HALF + 4 * n) : (f32x4){0.f, 0.f, 0.f, 0.f};
#pragma unroll
        for (int ai = 0; ai < 2; ++ai)
#pragma unroll
            for (int m = 0; m < 4; ++m) { bf16_t* rowp = base + (size_t)(row0 + ai * HALF + m * 16) * ldc + col0;
#pragma unroll
                for (int bj = 0; bj < 2; ++bj) { f32x4 v0 = acc[ai][bj][m][0] + bv[bj][0], v1 = acc[ai][bj][m][1] + bv[bj][1];
                    if (ACT == 1) { f32x2 a = gelu_pk((f32x2){v0[0], v0[1]}), b = gelu_pk((f32x2){v0[2], v0[3]}), c = gelu_pk((f32x2){v1[0], v1[1]}), d = gelu_pk((f32x2){v1[2], v1[3]});
                        v0 = (f32x4){a.x, a.y, b.x, b.y}; v1 = (f32x4){c.x, c.y, d.x, d.y}; }
                    v0 = v0 * sc; v1 = v1 * sc; u32x4 w; w.x = cvt_pk_bf16(v0[0], v0[1]); w.y = cvt_pk_bf16(v0[2], v0[3]); w.z = cvt_pk_bf16(v1[0], v1[1]); w.w = cvt_pk_bf16(v1[2], v1[3]);
                    *(u32x4*)(rowp + bj * HALF) = w; } }
    }
};
template <class Epi, class Sched, bool ALIGN_EPI = false, bool SP2 = false>
__device__ __forceinline__ void gemm_phase(PG8_LAS unsigned char* lds, const Gemm g, const Sched& S, const Epi& E) {
    const int tid = threadIdx.x, wid = __builtin_amdgcn_readfirstlane(tid >> 6), lane = tid & 63, wr = wid >> 2, wc = wid & 3, fr = lane & 15, fq = lane >> 4;
    const int K = g.K, nt = K / BK;
    unsigned voffA[2], voffB[2];
#pragma unroll
    for (int i = 0; i < 2; ++i) { int R, C; stage_rc(tid * 16 + i * 8192, R, C); const int Rb = Epi::PERM ? ((R & ~31) + perm32(R & 31)) : R;
        voffA[i] = (unsigned)(R * K + C) * 2u; voffB[i] = (unsigned)(Rb * K + C) * 2u; }
    const size_t kstep = (size_t)(BK * 2);
    const size_t hstep = (size_t)HALF * K * 2;
    const size_t tstep = 2 * hstep;
    const unsigned ldsw = (unsigned)wid * 1024u;
    const int aoff = lds_byte(wr * 64 + fr, fq * 8), boff = lds_byte(wc * 32 + fr, fq * 8);
#define PG8_SA(b, h) (((b) * 2 + (h)) * HTB)
#define PG8_SB(b, h) ((4 + (b) * 2 + (h)) * HTB)
#define PG8_STAGE(bufoff, gbase, voff) do { _Pragma("unroll") for (int _i = 0; _i < 2; ++_i) \
        __builtin_amdgcn_global_load_lds((const unsigned*)((const char*)(gbase) + (voff)[_i]), (PG8_LAS unsigned*)(lds + (bufoff) + ldsw + _i * 8192), 16, 0, 0); } while (0)
#define PG8_LDA(dst, b, h) do { _Pragma("unroll") for (int m = 0; m < 4; ++m) _Pragma("unroll") for (int k = 0; k < 2; ++k) dst[m][k] = *(const PG8_LAS bf16x8*)(lds + PG8_SA(b, h) + aoff + m * 2048 + k * 1024); } while (0)
#define PG8_LDB(dst, b, h) do { _Pragma("unroll") for (int n = 0; n < 2; ++n) _Pragma("unroll") for (int k = 0; k < 2; ++k) dst[n][k] = *(const PG8_LAS bf16x8*)(lds + PG8_SB(b, h) + boff + n * 2048 + k * 1024); } while (0)
#define PG8_MMA(ai, bj, At, Bt) do { __builtin_amdgcn_s_setprio(1); _Pragma("unroll") for (int m = 0; m < 4; ++m) _Pragma("unroll") for (int n = 0; n < 2; ++n) _Pragma("unroll") for (int k = 0; k < 2; ++k) \
        acc[ai][bj][m][n] = __builtin_amdgcn_mfma_f32_16x16x32_bf16(Bt[n][k], At[m][k], acc[ai][bj][m][n], 0, 0, 0); __builtin_amdgcn_s_setprio(0); } while (0)
#define PG8_WAIT_V(n) asm volatile("s_waitcnt vmcnt(" #n ")" ::: "memory")
#define PG8_WAIT_L(n) asm volatile("s_waitcnt lgkmcnt(" #n ")" ::: "memory")
#define PG8_BAR __builtin_amdgcn_s_barrier()
#define PG8_SCHED __builtin_amdgcn_sched_barrier(0)
    Unit cur, nxt; int ui = 0;
    if (!S.next(0, cur)) return;
    f32x4 acc[2][2][4][2];
#pragma unroll
    for (int a = 0; a < 2; ++a)
#pragma unroll
        for (int b = 0; b < 2; ++b)
#pragma unroll
            for (int m = 0; m < 4; ++m)
#pragma unroll
                for (int n = 0; n < 2; ++n) acc[a][b][m][n] = (f32x4){0.f, 0.f, 0.f, 0.f};
    bf16x8 At[4][2], B0[2][2], B1[2][2];
    const char* cA = (const char*)g.A + (size_t)cur.pm * tstep; const char* cB = (const char*)g.Bt + (size_t)cur.pn * tstep;
    S.a_ready(cur);
    if constexpr (SP2) {
        PG8_STAGE(PG8_SB(0, 0), cB, voffB); PG8_STAGE(PG8_SB(0, 1), cB + hstep, voffB); PG8_STAGE(PG8_SA(0, 0), cA, voffA); PG8_STAGE(PG8_SA(0, 1), cA + hstep, voffA);
        if (wr == 1) PG8_BAR;
        PG8_WAIT_V(2); PG8_BAR;
        PG8_STAGE(PG8_SB(1, 0), cB + kstep, voffB); PG8_STAGE(PG8_SA(1, 0), cA + kstep, voffA); PG8_STAGE(PG8_SB(1, 1), cB + hstep + kstep, voffB);
        PG8_WAIT_V(6); PG8_BAR;
    } else {
        PG8_STAGE(PG8_SB(0, 0), cB, voffB); PG8_STAGE(PG8_SA(0, 0), cA, voffA); PG8_STAGE(PG8_SB(0, 1), cB + hstep, voffB); PG8_STAGE(PG8_SA(0, 1), cA + hstep, voffA);
        if (wr == 1) PG8_BAR;
        PG8_WAIT_V(4); PG8_BAR;
        PG8_STAGE(PG8_SB(1, 0), cB + kstep, voffB); PG8_STAGE(PG8_SA(1, 0), cA + kstep, voffA); PG8_STAGE(PG8_SB(1, 1), cB + hstep + kstep, voffB);
        PG8_WAIT_V(6); PG8_BAR;
    }
    for (;;) {
        const bool has_next = S.next(ui + 1, nxt);
        const char* nA = has_next ? (const char*)g.A + (size_t)nxt.pm * tstep : cA; const char* nB = has_next ? (const char*)g.Bt + (size_t)nxt.pn * tstep : cB;
        for (int t = 0; t < nt; t += 2) {
            const bool last = (t == nt - 2);
            const char* a1 = cA + (size_t)(t + 1) * kstep;
            const char* a2 = last ? nA : cA + (size_t)(t + 2) * kstep; const char* b2 = last ? nB : cB + (size_t)(t + 2) * kstep;
            const char* a3 = a2 + kstep; const char* b3 = b2 + kstep;
            if (last && has_next) S.a_ready(nxt);
            if constexpr (SP2) {
            PG8_LDB(B0, 0, 0); PG8_LDB(B1, 0, 1); PG8_SCHED; PG8_LDA(At, 0, 0); PG8_STAGE(PG8_SA(1, 1), a1 + hstep, voffA);
            PG8_WAIT_V(8); PG8_WAIT_L(0); PG8_BAR; PG8_MMA(0, 0, At, B0); PG8_MMA(0, 1, At, B1); PG8_BAR; PG8_SCHED;
            PG8_LDA(At, 0, 1); PG8_STAGE(PG8_SB(0, 0), b2, voffB); PG8_STAGE(PG8_SB(0, 1), b2 + hstep, voffB); PG8_STAGE(PG8_SA(0, 0), a2, voffA);
            PG8_WAIT_V(8); PG8_WAIT_L(0); PG8_BAR; PG8_MMA(1, 0, At, B0); PG8_MMA(1, 1, At, B1); PG8_BAR; PG8_SCHED;
            PG8_LDB(B0, 1, 0); PG8_LDB(B1, 1, 1); PG8_SCHED; PG8_LDA(At, 1, 0); PG8_STAGE(PG8_SA(0, 1), a2 + hstep, voffA);
            PG8_WAIT_V(8); PG8_WAIT_L(0); PG8_BAR; PG8_MMA(0, 0, At, B0); PG8_MMA(0, 1, At, B1); PG8_BAR; PG8_SCHED;
            PG8_LDA(At, 1, 1); PG8_STAGE(PG8_SB(1, 0), b3, voffB); PG8_STAGE(PG8_SB(1, 1), b3 + hstep, voffB); PG8_STAGE(PG8_SA(1, 0), a3, voffA);
            PG8_WAIT_V(8); PG8_WAIT_L(0); PG8_BAR; PG8_MMA(1, 0, At, B0); PG8_MMA(1, 1, At, B1); PG8_BAR; PG8_SCHED;
            } else {
            PG8_LDB(B0, 0, 0); PG8_SCHED; PG8_LDA(At, 0, 0); PG8_STAGE(PG8_SA(1, 1), a1 + hstep, voffA);
            PG8_WAIT_L(8); PG8_BAR; PG8_WAIT_L(0); PG8_MMA(0, 0, At, B0); PG8_BAR; PG8_SCHED;
            PG8_LDB(B1, 0, 1); PG8_STAGE(PG8_SB(0, 0), b2, voffB);
            PG8_BAR; PG8_WAIT_L(0); PG8_MMA(0, 1, At, B1); PG8_BAR;
            PG8_LDA(At, 0, 1); PG8_STAGE(PG8_SA(0, 0), a2, voffA);
            PG8_BAR; PG8_WAIT_L(0); PG8_MMA(1, 0, At, B0); PG8_BAR; PG8_SCHED;
            PG8_STAGE(PG8_SB(0, 1), b2 + hstep, voffB);
            PG8_WAIT_V(6); PG8_BAR; PG8_MMA(1, 1, At, B1); PG8_BAR;
            PG8_LDB(B0, 1, 0); PG8_SCHED; PG8_LDA(At, 1, 0); PG8_STAGE(PG8_SA(0, 1), a2 + hstep, voffA);
            PG8_WAIT_L(8); PG8_BAR; PG8_WAIT_L(0); PG8_MMA(0, 0, At, B0); PG8_BAR; PG8_SCHED;
            PG8_LDB(B1, 1, 1); PG8_STAGE(PG8_SB(1, 0), b3, voffB);
            PG8_BAR; PG8_WAIT_L(0); PG8_MMA(0, 1, At, B1); PG8_BAR;
            PG8_LDA(At, 1, 1); PG8_STAGE(PG8_SA(1, 0), a3, voffA);
            PG8_BAR; PG8_WAIT_L(0); PG8_MMA(1, 0, At, B0); PG8_BAR; PG8_SCHED;
            PG8_STAGE(PG8_SB(1, 1), b3 + hstep, voffB);
            PG8_WAIT_V(6); PG8_BAR; PG8_MMA(1, 1, At, B1); PG8_BAR;
            }
        }
        if constexpr (ALIGN_EPI) { if (wr == 0) PG8_BAR; }
        if constexpr (!Epi::AFTER_DRAIN) { E(acc, cur, wr, wc, fr, fq); S.done(cur); }
        if (!has_next) break;
#pragma unroll
        for (int a = 0; a < 2; ++a)
#pragma unroll
            for (int b = 0; b < 2; ++b)
#pragma unroll
                for (int m = 0; m < 4; ++m)
#pragma unroll
                    for (int n = 0; n < 2; ++n) acc[a][b][m][n] = (f32x4){0.f, 0.f, 0.f, 0.f};
        cur = nxt; cA = nA; cB = nB; ++ui;
        if constexpr (ALIGN_EPI) { if (wr == 1) PG8_BAR; }
    }
    PG8_WAIT_V(0);
    if constexpr (!ALIGN_EPI) { if (wr == 0) PG8_BAR; }
    PG8_BAR;
    if constexpr (Epi::AFTER_DRAIN) { E.fused(acc, cur, wr, wc, fr, fq, lds, wid, lane); S.done(cur); }
#undef PG8_SA
#undef PG8_SB
#undef PG8_STAGE
#undef PG8_LDA
#undef PG8_LDB
#undef PG8_MMA
#undef PG8_WAIT_V
#undef PG8_WAIT_L
#undef PG8_BAR
#undef PG8_SCHED
}
}
#define XB_TMO      128
#define XB_XCNT(j)  (256  + 64 * (j))
#define XB_XSUB(j)  (1280 + 64 * (j))
#define XB_XGEN(j)  (2304 + 64 * (j))
#define XB_TOP      3328
#define XB_TOPGEN   3392
#define XCD_BAR_WORDS 3456
#define XB_SPIN_CAP (1u << 18)

__device__ __forceinline__ unsigned xb_ld(unsigned* p)              { return __hip_atomic_load(p, __ATOMIC_RELAXED, __HIP_MEMORY_SCOPE_AGENT); }
__device__ __forceinline__ unsigned xb_add(unsigned* p, unsigned v) { return __hip_atomic_fetch_add(p, v, __ATOMIC_RELAXED, __HIP_MEMORY_SCOPE_AGENT); }
__device__ __forceinline__ unsigned xb_xcc_id() { return (unsigned)__builtin_amdgcn_s_getreg((3 << 11) | 20) & 0xFu; }
#define XB_SPIN(cond, bar) do { unsigned _sp = 0; while (cond) { __builtin_amdgcn_s_sleep(1); \
    if ((++_sp & 255u) == 0u) { if (xb_ld(&(bar)[XB_TMO])) break; if (_sp > XB_SPIN_CAP) { atomicAdd(&(bar)[XB_TMO], 1u); break; } } } } while (0)

struct XcdBarrier {
    unsigned* bar; unsigned x;
    volatile LAS unsigned* st;
};

__device__ __forceinline__ XcdBarrier xcd_barrier_post(unsigned* bar, volatile LAS unsigned* st) {
    XcdBarrier b; b.bar = bar; b.x = xb_xcc_id(); b.st = st;
    if (threadIdx.x == 0) st[2] = xb_add(&bar[XB_XCNT(b.x)], 1u) + 1u;
    return b;
}
__device__ __forceinline__ void xcd_barrier_complete(unsigned* bar, unsigned x, unsigned& nloc, unsigned& nx) {
    const unsigned G = gridDim.x * gridDim.y * gridDim.z;
    unsigned sum, cnt, mine, sp = 0u;
    for (;;) {
        sum = 0u; cnt = 0u; mine = 0u;
#pragma unroll
        for (unsigned j = 0; j < 16; ++j) { const unsigned c = xb_ld(&bar[XB_XCNT(j)]); sum += c; cnt += (c > 0u) ? 1u : 0u; mine = (j == x) ? c : mine; }
        if (sum == G) break;
        __builtin_amdgcn_s_sleep(1);
        if ((++sp & 255u) == 0u) { if (xb_ld(&bar[XB_TMO])) break; if (sp > XB_SPIN_CAP) { atomicAdd(&bar[XB_TMO], 1u); break; } }
    }
    nloc = mine > 0u ? mine : 1u; nx = cnt > 0u ? cnt : 1u;
}

__device__ __forceinline__ void xcd_barrier(const XcdBarrier& b) {
    asm volatile("s_waitcnt vmcnt(0)" ::: "memory");
    __syncthreads();
    if (threadIdx.x == 0) {
        unsigned* bar = b.bar;
        __builtin_amdgcn_s_waitcnt(0);
        unsigned nloc = b.st[0], nx = b.st[1];
        if (nloc == 0u) { xcd_barrier_complete(bar, b.x, nloc, nx); b.st[0] = nloc; b.st[1] = nx; }
        const unsigned old = xb_add(&bar[XB_XSUB(b.x)], 1u);
        const unsigned gen = old / nloc;
        if (old + 1u == (gen + 1u) * nloc) {
            __builtin_amdgcn_fence(__ATOMIC_RELEASE, "agent");
            asm volatile("s_waitcnt vmcnt(0)" ::: "memory");
            const unsigned og = xb_add(&bar[XB_TOP], 1u);
            const unsigned tg = og / nx;
            if (og + 1u == (tg + 1u) * nx) xb_add(&bar[XB_TOPGEN], 1u);
            else XB_SPIN(xb_ld(&bar[XB_TOPGEN]) == tg, bar);
            __builtin_amdgcn_fence(__ATOMIC_ACQUIRE, "agent");
            xb_add(&bar[XB_XGEN(b.x)], 1u);
            asm volatile("s_waitcnt vmcnt(0)" ::: "memory");
        } else {
            XB_SPIN(xb_ld(&bar[XB_XGEN(b.x)]) == gen, bar);
            __builtin_amdgcn_fence(__ATOMIC_ACQUIRE, "agent");
            asm volatile("s_waitcnt vmcnt(0)" ::: "memory");
        }
    }
    __syncthreads();
}
constexpr int NWAVES = 8, NTHR = 512;
constexpr int RING_BYTES = 131072, LDSCTL_OFF = RING_BYTES, MISC_OFF = LDSCTL_OFF + 320, LDS_BYTES = 163840;
constexpr int CW_BAR = 4096;
#ifndef MK_N_LAUNCHES
#define MK_N_LAUNCHES 1
#endif
constexpr int NPHASE = 13;

typedef float f4v __attribute__((ext_vector_type(4)));
typedef unsigned u2v __attribute__((ext_vector_type(2)));
typedef unsigned u32x4_t __attribute__((ext_vector_type(4)));
struct Frame { LAS unsigned char* lds; int tid, lane, wave, G, bid; };
template <int CTRL, int ROWMASK> __device__ __forceinline__ float dppf(float old, float src) {
    return __builtin_bit_cast(float, __builtin_amdgcn_update_dpp(__builtin_bit_cast(int, old), __builtin_bit_cast(int, src), CTRL, ROWMASK, 0xf, false)); }
__device__ __forceinline__ float wave_scan_add(float v) {
    v += dppf<0x111, 0xf>(0.f, v); v += dppf<0x112, 0xf>(0.f, v); v += dppf<0x114, 0xf>(0.f, v); v += dppf<0x118, 0xf>(0.f, v);
    v += dppf<0x142, 0xa>(0.f, v); v += dppf<0x143, 0xc>(0.f, v); return v; }
__device__ __forceinline__ float wave_scan_max(float v) {
    const float NI = -INFINITY;
    v = fmaxf(v, dppf<0x111, 0xf>(NI, v)); v = fmaxf(v, dppf<0x112, 0xf>(NI, v)); v = fmaxf(v, dppf<0x114, 0xf>(NI, v)); v = fmaxf(v, dppf<0x118, 0xf>(NI, v));
    v = fmaxf(v, dppf<0x142, 0xa>(NI, v)); v = fmaxf(v, dppf<0x143, 0xc>(NI, v)); return v; }
__device__ __forceinline__ float lane_bcast(float v, int l) { return __builtin_bit_cast(float, __builtin_amdgcn_readlane(__builtin_bit_cast(int, v), l)); }
__device__ __forceinline__ float wave_sum(float v) { return lane_bcast(wave_scan_add(v), 63); }
__device__ __forceinline__ unsigned pk2(float lo, float hi) { return (unsigned)f2bf(lo) | ((unsigned)f2bf(hi) << 16); }
__device__ __forceinline__ float bflo(unsigned w) { return u_as_f(w << 16); }
__device__ __forceinline__ float bfhi(unsigned w) { return u_as_f(w & 0xffff0000u); }

__device__ __forceinline__ void p0_ada_block(const Prm& p, const Frame& F, int cb) {
    static_assert(D6 % 48 == 0 && NB == 8, "48-column blocks");
    LAS float* sl = (LAS float*)F.lds;
    LAS float* red = sl + NB * D;
    for (int i = F.tid; i < NB * D; i += NTHR) { const float cv = p.c[i]; sl[i] = cv / (1.f + __expf(-cv)); }
    __syncthreads();
    const int c4 = F.tid % 12, kl = F.tid / 12;
    if (kl < 42) {
        f4v acc[NB];
#pragma unroll
        for (int b = 0; b < NB; ++b) acc[b] = (f4v){0.f, 0.f, 0.f, 0.f};
        const float* wp = p.w_ada + (size_t)cb * 48 + 4 * c4;
#pragma unroll 7
        for (int k = kl; k < D; k += 42) { const f4v w = __builtin_nontemporal_load((const f4v*)(wp + (size_t)k * D6));
#pragma unroll
            for (int b = 0; b < NB; ++b) acc[b] += w * sl[b * D + k]; }
#pragma unroll
        for (int b = 0; b < NB; ++b) *(LAS f4v*)(red + (kl * NB + b) * 48 + 4 * c4) = acc[b];
    }
    __syncthreads();
    if (F.tid < NB * 48) { const int b = F.tid / 48, col = F.tid % 48; float s = 0.f;
        for (int k = 0; k < 42; ++k) s += red[(k * NB + b) * 48 + col];
        p.MOD()[(size_t)b * D6 + cb * 48 + col] = s + p.b_ada[cb * 48 + col]; }
    __syncthreads();
}
__device__ __forceinline__ void p0_transpose_item(const float* W, int ldw, int K, int N, bf16_t* WT, LAS float* scr, int item, int lane) {
    const int nblk = N / 32, kb = item / nblk, nb = item % nblk, k0 = 64 * kb, n0 = 32 * nb;
#pragma unroll
    for (int i = 0; i < 32; ++i) { const int kk = 2 * i + (lane >> 5); scr[kk * 33 + (lane & 31)] = W[(size_t)(k0 + kk) * ldw + n0 + (lane & 31)]; }
    asm volatile("s_waitcnt lgkmcnt(0)" ::: "memory");
    const int c = lane & 7;
#pragma unroll
    for (int j = 0; j < 4; ++j) { const int n = (lane >> 3) + 8 * j; const LAS float* s = scr + (8 * c) * 33 + n;
        uint4 o; o.x = pk2(s[0 * 33], s[1 * 33]); o.y = pk2(s[2 * 33], s[3 * 33]); o.z = pk2(s[4 * 33], s[5 * 33]); o.w = pk2(s[6 * 33], s[7 * 33]);
        *(uint4*)(WT + (size_t)(n0 + n) * K + k0 + 8 * c) = o; }
    asm volatile("s_waitcnt lgkmcnt(0)" ::: "memory");
}

__device__ __forceinline__ void p0_fold_item(const Prm& p, int item, int lane) {
    static_assert(NK == 128 && KH == 128 && NQ == 2048, "fold item decomposition");
    const int ks = item & 31, nt = (item >> 5) & 7, g = item >> 8;
    const int r = lane & 15, q = lane >> 4;
    const float* arow = p.subkeys + ((size_t)g * NK + nt * 16 + r) * KH + 4 * q;
    const float* brow = p.wq + (size_t)(ks * 64 + r) * NQ + g * KH + 4 * q;
    pg8::f32x4 acc[4];
#pragma unroll
    for (int c = 0; c < 4; ++c) acc[c] = (pg8::f32x4){0.f, 0.f, 0.f, 0.f};
#pragma unroll 2
    for (int s16 = 0; s16 < KH; s16 += 16) {
        const pg8::f32x4 a = *(const pg8::f32x4*)(arow + s16); pg8::f32x4 bv[4];
#pragma unroll
        for (int c = 0; c < 4; ++c) bv[c] = *(const pg8::f32x4*)(brow + (size_t)(c * 16) * NQ + s16);
#pragma unroll
        for (int i = 0; i < 4; ++i)
#pragma unroll
            for (int c = 0; c < 4; ++c) acc[c] = __builtin_amdgcn_mfma_f32_16x16x4f32(a[i], bv[c][i], acc[c], 0, 0, 0);
    }
#pragma unroll
    for (int c = 0; c < 4; ++c)
#pragma unroll
        for (int i = 0; i < 4; ++i) p.WQ_T()[(size_t)(g * NK + nt * 16 + 4 * q + i) * D + ks * 64 + c * 16 + r] = f2bf(acc[c][i]);
}
__device__ __forceinline__ void phase0(const Prm& p, const Frame& F) {
    for (int cb = F.bid; cb < D6 / 48; cb += F.G) p0_ada_block(p, F, cb);
    LAS float* scr = (LAS float*)(F.lds + F.wave * 16384);
    const int gw = F.bid * NWAVES + F.wave, NGW = F.G * NWAVES;
    constexpr int I_IN = (D / 64) * (INM / 32);
    for (int it = gw; it < I_IN; it += NGW) p0_transpose_item(p.w_in, INC, D, INM, p.WIN_T(), scr, it, F.lane);
}
#if defined(EMU_FP4_U) || defined(EMU_FP4_V)
__device__ __forceinline__ float q4emu(float x) { const float a = fminf(fabsf(x), 6.f); const float r = a < 2.f ? rintf(a * 2.f) * 0.5f : (a < 4.f ? rintf(a) : rintf(a * 0.5f) * 2.f); return x < 0.f ? -r : r; }
#endif
template <bool PART_A, bool PART_B, bool PART_F>
__device__ __forceinline__ void deferred_prep(const Prm& p, const Frame& F, int b0, int nb) {
    __syncthreads();
    LAS float* scr = (LAS float*)(F.lds + F.wave * 16384);
    const int gw = (F.bid - b0) * NWAVES + F.wave, NGW = nb * NWAVES;
    constexpr int I_O = (D / 64) * (D / 32), I_Q = 32 * 8 * 16;
    if (PART_A) for (int it = gw; it < I_O; it += NGW) p0_transpose_item(p.w_out, D, D, D, p.WOUT_T(), scr, it, F.lane);
    if (PART_F) for (int it = gw; it < I_Q; it += NGW) p0_fold_item(p, it, F.lane);
    if (PART_A) {
        f4v v[8], vn[8]; int rr = gw;
#define P0_ROWSRC(rr_) ((const f4v*)(p.peer_u + (size_t)(rr_) * D) + 2 * F.lane)
        if (rr < NE) { const f4v* src = P0_ROWSRC(rr);
#pragma unroll
            for (int j = 0; j < 8; ++j) v[j] = __builtin_nontemporal_load(src + 128 * (j >> 1) + (j & 1)); }
        for (; rr < NE; rr += NGW) {
            const int rn = rr + NGW;
            if (rn < NE) { const f4v* src = P0_ROWSRC(rn);
#pragma unroll
                for (int j = 0; j < 8; ++j) vn[j] = __builtin_nontemporal_load(src + 128 * (j >> 1) + (j & 1)); }
            const int e = rr; float am = 0.f;
#pragma unroll
            for (int j = 0; j < 8; ++j) am = fmaxf(am, fmaxf(fmaxf(fabsf(v[j][0]), fabsf(v[j][1])), fmaxf(fabsf(v[j][2]), fabsf(v[j][3]))));
#pragma unroll
            for (int o = 1; o < 64; o <<= 1) am = fmaxf(am, __shfl_xor(am, o));
            am *= 0.8f;
            const float sc = am > 0.f ? 6.f / am : 1.f;
            unsigned char* dst = p.PU4() + (size_t)e * 128 + 4u * (F.lane & 31) + (size_t)(F.lane >> 5) * ((size_t)NE * 128);
#pragma unroll
            for (int j2 = 0; j2 < 4; ++j2) { unsigned w = 0u; const f4v a = v[2 * j2] * sc, b = v[2 * j2 + 1] * sc;
#ifdef FP4_SWAP
                w = __builtin_amdgcn_cvt_scalef32_pk_fp4_f32(w, a[1], a[0], 1.0f, 0); w = __builtin_amdgcn_cvt_scalef32_pk_fp4_f32(w, a[3], a[2], 1.0f, 1);
                w = __builtin_amdgcn_cvt_scalef32_pk_fp4_f32(w, b[1], b[0], 1.0f, 2); w = __builtin_amdgcn_cvt_scalef32_pk_fp4_f32(w, b[3], b[2], 1.0f, 3); *(unsigned*)(dst + (size_t)(2 * j2) * ((size_t)NE * 128)) = w; }
#else
                w = __builtin_amdgcn_cvt_scalef32_pk_fp4_f32(w, a[0], a[1], 1.0f, 0); w = __builtin_amdgcn_cvt_scalef32_pk_fp4_f32(w, a[2], a[3], 1.0f, 1);
                w = __builtin_amdgcn_cvt_scalef32_pk_fp4_f32(w, b[0], b[1], 1.0f, 2); w = __builtin_amdgcn_cvt_scalef32_pk_fp4_f32(w, b[2], b[3], 1.0f, 3); *(unsigned*)(dst + (size_t)(2 * j2) * ((size_t)NE * 128)) = w; }
#endif
            if (F.lane == 0) p.RSU()[e] = am > 0.f ? am / 6.f : 1.f;
#pragma unroll
            for (int j = 0; j < 8; ++j) v[j] = vn[j];
        }
#undef P0_ROWSRC
    }
    if (PART_B) { LAS unsigned char* tl = F.lds; constexpr int RS_ = 1032;
      for (int tile = F.bid - b0; tile < NE / 16; tile += nb) { const int row = F.tid >> 5, l32 = F.tid & 31, e = tile * 16 + row;
        __syncthreads();
        const f4v* src = (const f4v*)(p.peer_v + (size_t)e * D) + l32; f4v x[16]; float am = 0.f;
#pragma unroll
        for (int j = 0; j < 16; ++j) { x[j] = __builtin_nontemporal_load(src + 32 * j); am = fmaxf(am, fmaxf(fmaxf(fabsf(x[j][0]), fabsf(x[j][1])), fmaxf(fabsf(x[j][2]), fabsf(x[j][3])))); }
#pragma unroll
        for (int o = 1; o < 32; o <<= 1) am = fmaxf(am, __shfl_xor(am, o));
        am *= 0.8f;
        const float sc = am > 0.f ? 6.f / am : 1.f;
#pragma unroll
        for (int j = 0; j < 16; ++j) { unsigned w = 0u; const f4v y = x[j] * sc; w = __builtin_amdgcn_cvt_scalef32_pk_fp4_f32(w, y[0], y[1], 1.0f, 0); w = __builtin_amdgcn_cvt_scalef32_pk_fp4_f32(w, y[2], y[3], 1.0f, 1);
            *(LAS unsigned short*)(tl + row * RS_ + 2 * (l32 + 32 * j)) = (unsigned short)w; }
        if (l32 == 0) p.RSV()[e] = am > 0.f ? am / 6.f : 1.f;
        __syncthreads();
#pragma unroll
        for (int k = 0; k < 4; ++k) { const int idx = F.tid + NTHR * k, r = idx & 15, sl = idx >> 4;
            *(u2v*)(p.PV8S() + ((size_t)sl * NE + tile * 16 + r) * 8) = *(const LAS u2v*)(tl + r * RS_ + 8 * sl); }
      } }
}
__device__ __forceinline__ void phase1(const Prm& p, const Frame& F) {
    static_assert(NG == 16 && D % 32 == 0, "gate tile = one 16-column MFMA tile");
    LAS float* SH = (LAS float*)F.lds; LAS float* SC1 = SH + D;
    constexpr unsigned WGS = 2 * D + 16, WG_OFF = 2 * D * 4, US_OFF = ((WG_OFF + NG * WGS + 255u) / 256u) * 256u;
    constexpr unsigned US_HI = 132096u;
    static_assert(US_OFF + 5 * 2 * D * 2 <= (unsigned)LDSCTL_OFF && US_HI + 3 * 2 * D * 2 <= (unsigned)LDS_BYTES && US_HI >= (unsigned)MISC_OFF + 128u, "P1 LDS map");
    LAS unsigned char* WGb = F.lds + WG_OFF; LAS unsigned char* USb = F.wave < 5 ? F.lds + US_OFF + F.wave * (2 * D * 2) : F.lds + US_HI + (F.wave - 5) * (2 * D * 2);
    const int rows_per = T / F.G;
    { const int st = (F.bid * 37) % (NG * D / NTHR);
      for (int k = 0; k < NG * D / NTHR; ++k) { const int idx = F.tid + NTHR * ((k + st) % (NG * D / NTHR)); const int d = idx / NG, g = idx % NG; *(LAS bf16_t*)(WGb + g * WGS + 2 * d) = f2bf(p.w_in[(size_t)d * INC + INM + g]); } }
    int cur_b = -1;
    float4 xpre[8];
    { const float4* x0 = (const float4*)(p.x + (size_t)(F.bid * rows_per + F.wave) * D) + F.lane;
#pragma unroll
      for (int j = 0; j < 8; ++j) xpre[j] = x0[64 * j]; }
    int it = 0;
    for (int r0 = F.bid * rows_per; r0 < (F.bid + 1) * rows_per; r0 += NWAVES, ++it) {
        const int b = r0 / S;
        if (b != cur_b) { __syncthreads();
            for (int n = F.tid; n < 2 * D; n += NTHR) { const float s = p.MOD()[(size_t)b * D6 + n]; SH[n] = n < D ? s : 1.f + s; }
            cur_b = b; __syncthreads(); }
        const int row = r0 + F.wave;
        float4 v[8]; float s = 0.f;
#pragma unroll
        for (int j = 0; j < 8; ++j) v[j] = xpre[j];
        if (r0 + NWAVES < (F.bid + 1) * rows_per) { const float4* xn = (const float4*)(p.x + (size_t)(row + NWAVES) * D) + F.lane;
#pragma unroll
            for (int j = 0; j < 8; ++j) xpre[j] = xn[64 * j]; }
#pragma unroll
        for (int j = 0; j < 8; ++j) s += (v[j].x + v[j].y) + (v[j].z + v[j].w);
        const float mean = wave_sum(s) * (1.f / D); float s2 = 0.f;
#pragma unroll
        for (int j = 0; j < 8; ++j) { v[j].x -= mean; v[j].y -= mean; v[j].z -= mean; v[j].w -= mean; s2 += (v[j].x * v[j].x + v[j].y * v[j].y) + (v[j].z * v[j].z + v[j].w * v[j].w); }
        const float rstd = 1.f / sqrtf(wave_sum(s2) * (1.f / D) + LN_EPS);
        uint2* o8 = (uint2*)(p.U() + (size_t)row * D) + F.lane; LAS u2v* us = (LAS u2v*)(USb + (it & 1) * (2 * D)) + F.lane;
#pragma unroll
        for (int j = 0; j < 8; ++j) { const int c0 = 4 * F.lane + 256 * j; const f4v sh = *(const LAS f4v*)(SH + c0), sc = *(const LAS f4v*)(SC1 + c0);
            const unsigned w0 = pk2(v[j].x * rstd * sc.x + sh.x, v[j].y * rstd * sc.y + sh.y), w1 = pk2(v[j].z * rstd * sc.z + sh.z, v[j].w * rstd * sc.w + sh.w);
            o8[64 * j] = make_uint2(w0, w1); us[64 * j] = (u2v){w0, w1}; }
        if (it & 1) {
            const unsigned lane = F.lane, r = lane & 15u, q = lane >> 4; pg8::f32x4 acc = {0.f, 0.f, 0.f, 0.f};
            const LAS unsigned char* ap = USb + (r & 1u) * (2 * D) + 16u * q; const LAS unsigned char* bp = WGb + r * WGS + 16u * q;
#pragma unroll 8
            for (int ks = 0; ks < D / 32; ++ks) acc = __builtin_amdgcn_mfma_f32_16x16x32_bf16(*(const LAS pg8::bf16x8*)(ap + 64 * ks), *(const LAS pg8::bf16x8*)(bp + 64 * ks), acc, 0, 0, 0);
            if (lane < NG) { const float bi = p.b_in[INM + lane]; const float g0 = acc[0] + bi, g1 = acc[1] + bi; const bool fg = lane & 4;
                p.GATES()[(size_t)(row - NWAVES) * NG + lane] = fg ? logsigmoidf_(g0) : g0; p.GATES()[(size_t)row * NG + lane] = fg ? logsigmoidf_(g1) : g1; } }
    }
}
__device__ __forceinline__ void phase3a(const Prm& p, const Frame& F, int b0, int nb) {
    const size_t gt = (size_t)(F.bid - b0) * NTHR + F.tid, GT = (size_t)nb * NTHR;
    for (size_t i = gt; i < (size_t)T * (CW / 8); i += GT) {
        const size_t row = i / (CW / 8); const int ch = (int)(i % (CW / 8)) * 8, s = (int)(row % S);
        float acc[8];
#pragma unroll
        for (int e = 0; e < 8; ++e) acc[e] = p.conv_b[ch + e];
#pragma unroll
        for (int k = 0; k < 3; ++k) { const int s2 = s + k - 1; if (s2 < 0 || s2 >= S) continue; const bf16_t* pr = p.PJ() + (size_t)(row + k - 1) * INM;
            const uint4 gc = *(const uint4*)(pr + O_GC + ch), hi = *(const uint4*)(pr + O_HIN + ch); const float* cw = p.conv_w + k * CW + ch;
            acc[0] += cw[0] * (bflo(gc.x) * bflo(hi.x)); acc[1] += cw[1] * (bfhi(gc.x) * bfhi(hi.x)); acc[2] += cw[2] * (bflo(gc.y) * bflo(hi.y)); acc[3] += cw[3] * (bfhi(gc.y) * bfhi(hi.y));
            acc[4] += cw[4] * (bflo(gc.z) * bflo(hi.z)); acc[5] += cw[5] * (bfhi(gc.z) * bfhi(hi.z)); acc[6] += cw[6] * (bflo(gc.w) * bflo(hi.w)); acc[7] += cw[7] * (bfhi(gc.w) * bfhi(hi.w)); }
        const uint4 gb = *(const uint4*)(p.PJ() + row * INM + O_GB + ch); uint4 o;
        o.x = pk2(bflo(gb.x) * acc[0], bfhi(gb.x) * acc[1]); o.y = pk2(bflo(gb.y) * acc[2], bfhi(gb.y) * acc[3]); o.z = pk2(bflo(gb.z) * acc[4], bfhi(gb.z) * acc[5]); o.w = pk2(bflo(gb.w) * acc[6], bfhi(gb.w) * acc[7]);
        *(uint4*)(p.Y() + row * D + ch) = o; }
}
namespace ml {
typedef short bf16x8 __attribute__((ext_vector_type(8)));
typedef short s16x4 __attribute__((ext_vector_type(4)));
typedef float f32x4 __attribute__((ext_vector_type(4)));
typedef float f32x2_t __attribute__((ext_vector_type(2)));
typedef __bf16 bf16x2_t __attribute__((ext_vector_type(2)));
typedef unsigned u32x4 __attribute__((ext_vector_type(4)));
typedef unsigned u32x2 __attribute__((ext_vector_type(2)));
constexpr unsigned IMG = 16384u, BUF = 3u * IMG, PT_OFF = 2u * BUF, PT_BYTES = 8192u, N_OFF = PT_OFF + 2u * PT_BYTES;
constexpr unsigned SCT_OFF = 149504u, SCT_BYTES = 1280u;
constexpr unsigned HT_OFF = 133120u;
static_assert(N_OFF + 1024u <= 131072u && HT_OFF + 16384u <= SCT_OFF && SCT_OFF + 3u * SCT_BYTES <= 163840u, "mLSTM LDS map");
__device__ __forceinline__ unsigned cvtpk(float lo, float hi) { f32x2_t v = {lo, hi}; bf16x2_t b = __builtin_convertvector(v, bf16x2_t); return __builtin_bit_cast(unsigned, b); }
__device__ __forceinline__ unsigned off_a(unsigned row, unsigned ch) { return 2048u * (row >> 3) + 512u * (ch >> 2) + 64u * (row & 7u) + 16u * ((ch & 3u) ^ ((row >> 2) & 3u)); }
__device__ __forceinline__ unsigned off_p(unsigned row, unsigned ch) { return 128u * row + 16u * (ch ^ (row & 7u)); }
typedef short v4i16_t __attribute__((ext_vector_type(4)));
__device__ __forceinline__ s16x4 trr(LAS unsigned char* p) { return __builtin_bit_cast(s16x4, __builtin_amdgcn_ds_read_tr16_b64_v4i16((LAS v4i16_t*)p)); }
__device__ __forceinline__ bf16x8 cat8(s16x4 a, s16x4 b) { return (bf16x8){a[0], a[1], a[2], a[3], b[0], b[1], b[2], b[3]}; }
struct CS { float decay, m_next; };
__device__ __forceinline__ CS chunk_scalars(float ig, float fg, float m, LAS float* tab, bool writer, unsigned lane) {
    const float lf = fg;
    const float bc = wave_scan_add(lf), gg = ig - bc, cm = wave_scan_max(gg);
    const float G = fmaxf(m, cm), G63 = lane_bcast(G, 63), b63 = lane_bcast(bc, 63), qs = 0.08838834764831845f;
    if (writer) { tab[lane] = __expf(fminf(G63 - G, 80.f)) * qs; tab[64 + lane] = __expf(m - G) * qs; tab[128 + lane] = __expf(-(bc + G)); tab[192 + lane] = __expf(gg - G63); }
    CS r; r.decay = __expf(m - G63); r.m_next = b63 + G63; if (writer && lane == 0u) tab[256] = r.decay;
    return r;
}
__device__ __forceinline__ void unit(const Prm& p, const Frame& F, int u) {
    static_assert(QK == 128 && MV == 256 && CHUNK == 64 && S % 64 == 0, "mLSTM unit is specialised");
    const int vhalf = u & 1, h = (u >> 1) & 3, b = (u >> 3) & 7, dir = u >> 6;
    const unsigned lane = F.lane, tid = F.tid; const int wave = F.wave; const unsigned q = lane >> 4, r = lane & 15u;
    LAS unsigned char* L = F.lds;
    const unsigned rx = (r >> 2) & 3u, rlo = 2048u * (r >> 3) + 64u * (r & 7u);
    const unsigned RA = rlo + 16u * (q ^ rx), PB1 = rlo + 16u * ((q >> 1) ^ rx) + 8u * (q & 1u), PB2 = rlo + 16u * ((2u + (q >> 1)) ^ rx) + 8u * (q & 1u);
    const unsigned pp = lane & 3u, tlo = 2048u * q + 64u * rx + 8u * (pp & 1u);
    const unsigned tb00 = tlo + 16u * ((pp >> 1) ^ ((2u * q) & 3u)), tb01 = tlo + 256u + 16u * ((pp >> 1) ^ ((2u * q + 1u) & 3u));
    const unsigned tb10 = tlo + 16u * ((2u + (pp >> 1)) ^ ((2u * q) & 3u)), tb11 = tlo + 256u + 16u * ((2u + (pp >> 1)) ^ ((2u * q + 1u) & 3u));
    const unsigned PP0 = 128u * r + 16u * (q ^ (r & 7u)), PP1 = 128u * r + 16u * ((4u + q) ^ (r & 7u));
#define ML_TRA(c, ks, t) ((((c) & 1) ? ((t) ? tb11 : tb10) : ((t) ? tb01 : tb00)) + 8192u * (ks) + 512u * ((unsigned)(c) >> 1))
    __syncthreads();
    for (unsigned i = tid; i < (2u * PT_BYTES + 1024u) / 16u; i += NTHR) *(LAS u32x4*)(L + PT_OFF + 16u * i) = (u32x4){0u, 0u, 0u, 0u};
    f32x4 C[8];
#pragma unroll
    for (int i = 0; i < 8; ++i) C[i] = (f32x4){0.f, 0.f, 0.f, 0.f};
    float m = 0.f;
    const bf16_t* pj = p.PJ(); bf16_t* H = dir ? p.HB16() : p.HF16();
    const int colq = O_Q + h * QK, colk = O_K + h * QK, colv = O_V + h * MV + vhalf * 128;
    const unsigned srow0 = tid >> 4, sch = tid & 15u;
    u32x4 rq[2], rk[2], rv[2];
    const float* gbase = p.GATES() + dir * 8 + h;
#define ML_GATES(c, ig_, fg_) do { const float* g_ = gbase + (size_t)ml_tok(dir, b, (c) * 64 + (int)lane) * NG; ig_ = g_[0]; fg_ = g_[4]; } while (0)
    float ig0, fg0, ign = 0.f, fgn = 0.f; ML_GATES(0, ig0, fg0); if (S / 64 > 1) ML_GATES(1, ign, fgn);
#define ML_TAB(c) ((LAS float*)(L + SCT_OFF + (unsigned)((c) % 3) * SCT_BYTES))
    CS cs = {0.f, 0.f}, csn = {0.f, 0.f}; if (wave == 0) { cs = chunk_scalars(ig0, fg0, m, ML_TAB(0), true, lane); csn = cs; }
    const long sMW = dir ? -(long)MW : (long)MW;
#define ML_LOAD(c) do { _Pragma("unroll") for (int i_ = 0; i_ < 2; ++i_) { const bf16_t* rp = pj + (size_t)ml_tok(dir, b, (c) * 64 + srow0 + 32 * i_) * INM + 8 * sch; \
        rq[i_] = *(const u32x4*)(rp + colq); rk[i_] = *(const u32x4*)(rp + colk); rv[i_] = *(const u32x4*)(rp + colv); } } while (0)
#define ML_STORE(buf, S_) do { _Pragma("unroll") for (int i_ = 0; i_ < 2; ++i_) { const unsigned row = srow0 + 32u * i_, o = (buf) * BUF + off_a(row, sch); const float w = (S_)[192 + row]; \
        *(LAS u32x4*)(L + o) = rq[i_]; *(LAS u32x4*)(L + IMG + o) = rk[i_]; u32x4 v = rv[i_]; \
        v.x = cvtpk(bflo(v.x) * w, bfhi(v.x) * w); v.y = cvtpk(bflo(v.y) * w, bfhi(v.y) * w); v.z = cvtpk(bflo(v.z) * w, bfhi(v.z) * w); v.w = cvtpk(bflo(v.w) * w, bfhi(v.w) * w); \
        *(LAS u32x4*)(L + 2u * IMG + o) = v; } } while (0)
    __syncthreads();
    ML_LOAD(0); ML_STORE(0u, ML_TAB(0));
    constexpr int NC = S / 64;
    for (int c = 0; c < NC; ++c) {
        const unsigned cur = (unsigned)(c & 1);
        LAS unsigned char* Qi = L + cur * BUF; LAS unsigned char* Ki = Qi + IMG; LAS unsigned char* Vi = Qi + 2u * IMG; LAS unsigned char* Pt = L + PT_OFF + cur * PT_BYTES;
        float ig2 = 0.f, fg2 = 0.f;
        if (c + 1 < NC) { ML_LOAD(c + 1); if (wave == 0) { csn = chunk_scalars(ign, fgn, cs.m_next, ML_TAB(c + 1), true, lane); if (c + 2 < NC) ML_GATES(c + 2, ig2, fg2); } }
        __syncthreads();
#define ML_FLUSH(cprev) do { _Pragma("unroll") for (int i_ = 0; i_ < 2; ++i_) { const unsigned n_ = tid + 512u * i_, row_ = n_ >> 4, ch_ = n_ & 15u;     \
            const u32x4 v_ = *(const LAS u32x4*)(L + HT_OFF + 256u * row_ + 16u * (ch_ ^ (row_ & 15u))); \
            *(u32x4*)(H + (size_t)ml_tok(dir, b, (cprev) * 64 + (int)row_) * MW + h * MV + vhalf * 128 + 8 * (int)ch_) = v_; } } while (0)
        const LAS float* sct = ML_TAB(c); const float dcy = sct[256];
        if (c > 0) ML_FLUSH(c - 1);
#ifndef ML_REP_3B
#define ML_REP_3B 1
#define ML_REP_S 1
#define ML_REP_ST 1
#define ML_REP_3A 1
#define ML_REP_DEN 1
#endif
        f32x4 acc2[4];
#pragma unroll
        for (int tt = 0; tt < 4; ++tt) acc2[tt] = (f32x4){0.f, 0.f, 0.f, 0.f};
#pragma unroll
        for (int ks = 0; ks < 4; ++ks) {
            bf16x8 qa[4];
#pragma unroll
            for (int tt = 0; tt < 4; ++tt) {
                const u32x2 lo = *(const LAS u32x2*)(Qi + PB1 + 4096u * tt + 512u * ks), hi = *(const LAS u32x2*)(Qi + PB2 + 4096u * tt + 512u * ks);
                const u32x4 aw = {lo.x, lo.y, hi.x, hi.y}; qa[tt] = __builtin_bit_cast(bf16x8, aw); }
            const f32x4 c0 = C[2 * ks], c1 = C[2 * ks + 1];
            const u32x4 bw = {cvtpk(c0[0], c0[1]), cvtpk(c0[2], c0[3]), cvtpk(c1[0], c1[1]), cvtpk(c1[2], c1[3])}; const bf16x8 bfr = __builtin_bit_cast(bf16x8, bw);
#pragma unroll
            for (int tt = 0; tt < 4; ++tt) acc2[tt] = __builtin_amdgcn_mfma_f32_16x16x32_bf16(qa[tt], bfr, acc2[tt], 0, 0, 0);
        }
        bf16x8 vB[2];
#pragma unroll
        for (int ks = 0; ks < 2; ++ks) vB[ks] = cat8(trr(Vi + ML_TRA(wave, ks, 0)), trr(Vi + ML_TRA(wave, ks, 1)));
#pragma unroll
        for (int dt = 0; dt < 8; ++dt) C[dt] = C[dt] * dcy;
#pragma unroll
        for (int ks = 0; ks < 2; ++ks)
#pragma unroll
            for (int dh = 0; dh < 2; ++dh) { bf16x8 kA[4];
#pragma unroll
                for (int d4 = 0; d4 < 4; ++d4) kA[d4] = cat8(trr(Ki + ML_TRA(4 * dh + d4, ks, 0)), trr(Ki + ML_TRA(4 * dh + d4, ks, 1)));
#pragma unroll
                for (int d4 = 0; d4 < 4; ++d4) C[4 * dh + d4] = __builtin_amdgcn_mfma_f32_16x16x32_bf16(kA[d4], vB[ks], C[4 * dh + d4], 0, 0, 0); }
#pragma unroll
        for (int rep = 0; rep < 2; ++rep) { const int idx = wave + (rep ? 2 : 0);
            if (rep == 0 || wave >= 6) { const int tt = idx >= 6 ? 3 : (idx >= 3 ? 2 : (idx >= 1 ? 1 : 0)), st = idx - tt * (tt + 1) / 2;
                f32x4 sa = (f32x4){0.f, 0.f, 0.f, 0.f};
#pragma unroll
                for (int kh = 0; kh < 2; ++kh) { bf16x8 af[2], bfk[2];
#pragma unroll
                    for (int k2 = 0; k2 < 2; ++k2) { af[k2] = *(const LAS bf16x8*)(Qi + RA + 4096u * tt + 512u * (2 * kh + k2)); bfk[k2] = *(const LAS bf16x8*)(Ki + RA + 4096u * st + 512u * (2 * kh + k2)); }
#pragma unroll
                    for (int k2 = 0; k2 < 2; ++k2) sa = __builtin_amdgcn_mfma_f32_16x16x32_bf16(af[k2], bfk[k2], sa, 0, 0, 0); }
                const unsigned scol = 16u * st + r;
#pragma unroll
                for (int i = 0; i < 4; ++i) { const unsigned trow = 16u * tt + 4u * q + i; const float v = scol <= trow ? sa[i] : 0.f;
                    *(LAS bf16_t*)(Pt + off_p(trow, scol >> 3) + 2u * (scol & 7u)) = (bf16_t)cvtpk(v, 0.f); } } }
        if (c + 1 < NC) ML_STORE(cur ^ 1u, ML_TAB(c + 1));
        __syncthreads();
        { bf16x8 pf[6];
#pragma unroll
          for (int tt = 0; tt < 4; ++tt) { pf[tt] = *(const LAS bf16x8*)(Pt + PP0 + 2048u * tt); if (tt >= 2) pf[2 + tt] = *(const LAS bf16x8*)(Pt + PP1 + 2048u * tt); }
#pragma unroll
          for (int tt = 0; tt < 4; ++tt) { const f32x4 av4 = *(const LAS f32x4*)(sct + 16 * tt + 4 * q), bv4 = *(const LAS f32x4*)(sct + 64 + 16 * tt + 4 * q); f32x4 a1 = __builtin_amdgcn_mfma_f32_16x16x32_bf16(pf[tt], vB[0], (f32x4){0.f, 0.f, 0.f, 0.f}, 0, 0, 0);
            if (tt >= 2) a1 = __builtin_amdgcn_mfma_f32_16x16x32_bf16(pf[2 + tt], vB[1], a1, 0, 0, 0);
#pragma unroll
            for (int i = 0; i < 4; ++i) { const unsigned t = 16u * tt + 4u * q + i, col = 16u * (unsigned)wave + r;
                *(LAS bf16_t*)(L + HT_OFF + 256u * t + 16u * ((col >> 3) ^ (t & 15u)) + 2u * (col & 7u)) = (bf16_t)cvtpk(av4[i] * a1[i] + bv4[i] * acc2[tt][i], 0.f); } } }
        if (vhalf == 0) {
            const LAS float* n_old = (const LAS float*)(L + N_OFF + cur * 512u); LAS float* n_new = (LAS float*)(L + N_OFF + (cur ^ 1u) * 512u);
            bf16x8 wB[2];
#pragma unroll
            for (int ks = 0; ks < 2; ++ks) { const f32x4 w0 = *(const LAS f32x4*)(sct + 192 + 32 * ks + 8 * q), w1 = *(const LAS f32x4*)(sct + 192 + 32 * ks + 8 * q + 4);
                u32x4 w = {cvtpk(w0[0], w0[1]), cvtpk(w0[2], w0[3]), cvtpk(w1[0], w1[1]), cvtpk(w1[2], w1[3])};
                if (r != 0u) w = (u32x4){0u, 0u, 0u, 0u}; wB[ks] = __builtin_bit_cast(bf16x8, w); }
            const size_t dbase = ((size_t)dir * T) * MH + h;
            if (wave < 4) { const int tt = wave; f32x4 d2 = (f32x4){0.f, 0.f, 0.f, 0.f};
#pragma unroll
                for (int ks = 0; ks < 4; ++ks) { const f32x4 n0 = *(const LAS f32x4*)(n_old + 32 * ks + 4 * q), n1 = *(const LAS f32x4*)(n_old + 32 * ks + 16 + 4 * q);
                    u32x4 bw = {cvtpk(n0[0], n0[1]), cvtpk(n0[2], n0[3]), cvtpk(n1[0], n1[1]), cvtpk(n1[2], n1[3])}; if (r != 0u) bw = (u32x4){0u, 0u, 0u, 0u};
                    const u32x2 lo = *(const LAS u32x2*)(Qi + PB1 + 4096u * tt + 512u * ks), hi = *(const LAS u32x2*)(Qi + PB2 + 4096u * tt + 512u * ks);
                    const u32x4 aw = {lo.x, lo.y, hi.x, hi.y};
                    d2 = __builtin_amdgcn_mfma_f32_16x16x32_bf16(__builtin_bit_cast(bf16x8, aw), __builtin_bit_cast(bf16x8, bw), d2, 0, 0, 0); }
#pragma unroll
                for (int i = 0; i < 4; ++i) { const int t = 16 * tt + 4 * (int)q + i; const float bv = sct[64 + t], fl = sct[128 + t];
                    if (r == 0u) { const size_t di = dbase + (size_t)ml_tok(dir, b, c * 64 + t) * MH; p.DEN()[(size_t)2 * T * MH + di] = bv * d2[i]; p.FLR()[di] = fl; } }
            } else { const int tt = wave - 4; f32x4 d1 = (f32x4){0.f, 0.f, 0.f, 0.f};
#pragma unroll
                for (int ks = 0; ks < 2; ++ks) if (ks == 0 || tt >= 2) { const bf16x8 pf = *(const LAS bf16x8*)(Pt + (ks ? PP1 : PP0) + 2048u * tt);
                    d1 = __builtin_amdgcn_mfma_f32_16x16x32_bf16(pf, wB[ks], d1, 0, 0, 0); }
#pragma unroll
                for (int i = 0; i < 4; ++i) { const int t = 16 * tt + 4 * (int)q + i; const float av = sct[t];
                    if (r == 0u) p.DEN()[dbase + (size_t)ml_tok(dir, b, c * 64 + t) * MH] = av * d1[i]; } }
            { const int dt = wave; f32x4 nn = *(const LAS f32x4*)(n_old + 16 * dt + 4 * q) * dcy; if (r != 0u) nn = (f32x4){0.f, 0.f, 0.f, 0.f};
#pragma unroll
                for (int ks = 0; ks < 2; ++ks) { const bf16x8 kA = cat8(trr(Ki + ML_TRA(dt, ks, 0)), trr(Ki + ML_TRA(dt, ks, 1)));
                    nn = __builtin_amdgcn_mfma_f32_16x16x32_bf16(kA, wB[ks], nn, 0, 0, 0); }
                if (r == 0u) *(LAS f32x4*)(n_new + 16 * dt + 4 * q) = nn; }
        }
        m = cs.m_next; cs = csn; ign = ig2; fgn = fg2;
    }
    __syncthreads(); ML_FLUSH(NC - 1);
#undef ML_FLUSH
#undef ML_TRA
#undef ML_TABLE
#undef ML_LOAD
#undef ML_GATES
#undef ML_STORE
}
}
__device__ __forceinline__ void phase4(const Prm& p, const Frame& F) {
    static_assert(MV == 256 && MH == 4, "head j = float4 slot j of the lane");
    const int gw = F.bid * NWAVES + F.wave, NGW = F.G * NWAVES;
    for (int row = gw; row < T; row += NGW) {
        const uint2* hf = (const uint2*)(p.HF16() + (size_t)row * MW) + F.lane; const uint2* hb = (const uint2*)(p.HB16() + (size_t)row * MW) + F.lane;
        const uint2* og = (const uint2*)(p.PJ() + (size_t)row * INM + O_O) + F.lane; uint2* yo = (uint2*)(p.Y() + (size_t)row * D + CW) + F.lane;
#pragma unroll
        for (int j = 0; j < MH; ++j) {
            const float* d2 = p.DEN() + (size_t)2 * T * MH;
            const float i_f = 1.f / fmaxf(fabsf(p.DEN()[(size_t)row * MH + j] + d2[(size_t)row * MH + j]), p.FLR()[(size_t)row * MH + j]);
            const float i_b = 1.f / fmaxf(fabsf(p.DEN()[((size_t)T + row) * MH + j] + d2[((size_t)T + row) * MH + j]), p.FLR()[((size_t)T + row) * MH + j]);
            const uint2 a = hf[64 * j], b = hb[64 * j]; float4 h = make_float4(bflo(a.x) * i_f + bflo(b.x) * i_b, bfhi(a.x) * i_f + bfhi(b.x) * i_b, bflo(a.y) * i_f + bflo(b.y) * i_b, bfhi(a.y) * i_f + bfhi(b.y) * i_b);
            const float mean = wave_sum((h.x + h.y) + (h.z + h.w)) * (1.f / MV);
            h.x -= mean; h.y -= mean; h.z -= mean; h.w -= mean;
            const float rstd = 1.f / sqrtf(wave_sum((h.x * h.x + h.y * h.y) + (h.z * h.z + h.w * h.w)) * (1.f / MV) + LN_EPS);
            const float4 nw = *((const float4*)(p.mnorm_w + j * MV) + F.lane); const uint2 o = og[64 * j];
            yo[64 * j] = make_uint2(pk2(h.x * rstd * nw.x * sigmoidf_(bflo(o.x)), h.y * rstd * nw.y * sigmoidf_(bfhi(o.x))), pk2(h.z * rstd * nw.z * sigmoidf_(bflo(o.y)), h.w * rstd * nw.w * sigmoidf_(bfhi(o.y)))); }
    }
}
struct EpiZ {
    static constexpr bool PERM = true, AFTER_DRAIN = false;
    const float* x; const float* mod; bf16_t* out;
    __device__ __forceinline__ void operator()(const pg8::f32x4 (&acc)[2][2][4][2], const pg8::Unit& u, int wr, int wc, int fr, int fq) const {
        const int col0 = u.pn * 256 + wc * 32 + 8 * fq;
#pragma unroll
        for (int ai = 0; ai < 2; ++ai)
#pragma unroll
            for (int m = 0; m < 4; ++m) { const int row = u.pm * 256 + ai * 128 + wr * 64 + m * 16 + fr; const float* g1 = mod + (size_t)(row / S) * D6 + 2 * D; const size_t off = (size_t)row * D + col0;
#pragma unroll
                for (int bj = 0; bj < 2; ++bj) { const int c = bj * 128;
                    const pg8::f32x4 x0 = *(const pg8::f32x4*)(x + off + c), x1 = *(const pg8::f32x4*)(x + off + c + 4), g0 = *(const pg8::f32x4*)(g1 + col0 + c), g1v = *(const pg8::f32x4*)(g1 + col0 + c + 4);
                    const pg8::f32x4 z0 = x0 * ALPHA + g0 * acc[ai][bj][m][0], z1 = x1 * ALPHA + g1v * acc[ai][bj][m][1];
                    u32x4_t w = {pk2(z0[0], z0[1]), pk2(z0[2], z0[3]), pk2(z1[0], z1[1]), pk2(z1[2], z1[3])}; *(u32x4_t*)(out + off + c) = w; } }
    }
};

struct EpiF32 {
    static constexpr bool PERM = true, AFTER_DRAIN = false;
    float* out; int ldc;
    __device__ __forceinline__ void operator()(const pg8::f32x4 (&acc)[2][2][4][2], const pg8::Unit& u, int wr, int wc, int fr, int fq) const {
        const int col0 = u.pn * 256 + wc * 32 + 8 * fq;
#pragma unroll
        for (int ai = 0; ai < 2; ++ai)
#pragma unroll
            for (int m = 0; m < 4; ++m) { float* rowp = out + (size_t)(u.pm * 256 + ai * 128 + wr * 64 + m * 16 + fr) * ldc + col0;
#pragma unroll
                for (int bj = 0; bj < 2; ++bj) { *(pg8::f32x4*)(rowp + bj * 128) = acc[ai][bj][m][0]; *(pg8::f32x4*)(rowp + bj * 128 + 4) = acc[ai][bj][m][1]; } }
    }
};
__device__ __forceinline__ unsigned skey(float f) { const unsigned u = f_as_u(f); return (u & 0x80000000u) ? ~u : (u | 0x80000000u); }
__device__ __forceinline__ float unskey(unsigned k) { return u_as_f((k & 0x80000000u) ? (k & 0x7fffffffu) : ~k); }
__device__ __forceinline__ void tk_cx(unsigned& a, unsigned& b) { const unsigned hi = a > b ? a : b, lo = a > b ? b : a; a = hi; b = lo; }
__device__ __forceinline__ void tk_sort16(unsigned (&v)[16]) {
#pragma unroll
    for (int k = 2; k <= 16; k <<= 1)
#pragma unroll
        for (int j = k >> 1; j >= 1; j >>= 1)
#pragma unroll
            for (int i = 0; i < 16; ++i) { const int l = i ^ j; if (l > i) { if ((i & k) == 0) tk_cx(v[i], v[l]); else tk_cx(v[l], v[i]); } }
}
__device__ __forceinline__ void tk_merge16(unsigned (&L)[16], const unsigned (&C)[16]) {
#pragma unroll
    for (int i = 0; i < 16; ++i) L[i] = L[i] > C[15 - i] ? L[i] : C[15 - i];
#pragma unroll
    for (int j = 8; j >= 1; j >>= 1)
#pragma unroll
        for (int i = 0; i < 16; ++i) { const int l = i ^ j; if (l > i) tk_cx(L[i], L[l]); }
}
__device__ __forceinline__ void tk_top16(const float* sc, unsigned (&L)[16]) {
#pragma unroll 1
    for (int ch = 0; ch < NK / 16; ++ch) { unsigned C[16];
#pragma unroll
        for (int q4 = 0; q4 < 4; ++q4) { const float4 v = ((const float4*)sc)[4 * ch + q4]; const unsigned b = 127u - 16u * ch - 4u * q4;
            C[4 * q4] = (skey(v.x) & ~0x7fu) | b; C[4 * q4 + 1] = (skey(v.y) & ~0x7fu) | (b - 1); C[4 * q4 + 2] = (skey(v.z) & ~0x7fu) | (b - 2); C[4 * q4 + 3] = (skey(v.w) & ~0x7fu) | (b - 3); }
        tk_sort16(C);
        if (ch == 0) {
#pragma unroll
            for (int i = 0; i < 16; ++i) L[i] = C[i]; }
        else tk_merge16(L, C); }
}
__device__ __forceinline__ void phase8(const Prm& p, const Frame& F) {
    static_assert(NK == 128 && TOPK == 16, "top-k phase is specialised");
    const long gt = (long)F.bid * NTHR + F.tid, GT = (long)F.G * NTHR;
    LAS unsigned* ix = (LAS unsigned*)F.lds + F.tid;
    for (long i = gt; i < (long)T * PH; i += GT) {
        unsigned A[16], B[16];
        tk_top16(p.SC() + (size_t)i * 2 * NK, A); tk_top16(p.SC() + (size_t)i * 2 * NK + NK, B);
        float sa[16], sb[16];
#pragma unroll
        for (int k = 0; k < 16; ++k) { sa[k] = unskey(A[k] & ~0x7fu); sb[k] = unskey(B[k] & ~0x7fu); ix[NTHR * k] = 127u - (A[k] & 0x7fu); ix[NTHR * (16 + k)] = 127u - (B[k] & 0x7fu); }
        unsigned L[16], C[16]; int n = 0;
#pragma unroll
        for (int a = 0; a < 16; ++a)
#pragma unroll
            for (int b = 0; b < 16; ++b) if ((a + 1) * (b + 1) <= 16) { const unsigned key = (skey(sa[a] + sb[b]) & ~0xffu) | (unsigned)(255 - (16 * a + b));
                C[n & 15] = key; ++n;
                if ((n & 15) == 0 || n == 50) { if (n == 50) {
#pragma unroll
                        for (int z = 2; z < 16; ++z) C[z] = 0u; }
                    tk_sort16(C);
                    if (n == 16) {
#pragma unroll
                        for (int z = 0; z < 16; ++z) L[z] = C[z]; }
                    else tk_merge16(L, C); } }
        float V[16]; float sum = 0.f; const float vmax = unskey(L[0] & ~0xffu);
#pragma unroll
        for (int r = 0; r < 16; ++r) { V[r] = __expf(unskey(L[r] & ~0xffu) - vmax); sum += V[r]; }
        const float inv = 1.f / sum; int E[16];
#pragma unroll
        for (int r = 0; r < 16; ++r) { const unsigned fl = 255u - (L[r] & 0xffu); E[r] = (int)(ix[NTHR * (fl >> 4)] * NK + ix[NTHR * (16 + (fl & 15u))]); }
#pragma unroll
        for (int r = 0; r < 16; r += 4) { *(int4*)(p.EIDX() + (size_t)i * TOPK + r) = make_int4(E[r], E[r + 1], E[r + 2], E[r + 3]);
            *(float4*)(p.EW() + (size_t)i * TOPK + r) = make_float4(V[r] * inv, V[r + 1] * inv, V[r + 2] * inv, V[r + 3] * inv); }
    }
}
__device__ __forceinline__ void phase6(const Prm& p, const Frame& F) {
    LAS float* PW = (LAS float*)F.lds; LAS float* PB = PW + D; LAS float* PSH = PW + 2 * D; LAS float* PSC = PW + 3 * D;
    const int rows_per = T / F.G, r_begin = F.bid * rows_per, r_end = r_begin + rows_per;
    int cur_b = -1;
    for (int i = F.tid; i < D; i += NTHR) { PW[i] = p.ln1_w[i]; PB[i] = p.ln1_b[i]; }
    float4 v[8]; uint2 zb[8], zn[8];
    { const uint2* z0 = (const uint2*)((const bf16_t*)p.out + (size_t)(r_begin + F.wave) * D) + F.lane;
#pragma unroll
      for (int j = 0; j < 8; ++j) zb[j] = z0[64 * j]; }
    for (int r0 = r_begin; r0 < r_end; r0 += NWAVES) {
        const int row = r0 + F.wave, b = r0 / S;
        if (b != cur_b) { __syncthreads(); const float* mod = p.MOD() + (size_t)b * D6;
            for (int i = F.tid; i < D; i += NTHR) { PSH[i] = mod[3 * D + i]; PSC[i] = 1.f + mod[4 * D + i]; }
            cur_b = b; __syncthreads(); }
        uint2* x1r = (uint2*)(p.X1B() + (size_t)row * D) + F.lane;
        float s = 0.f;
        if (r0 + NWAVES < r_end) { const uint2* zp = (const uint2*)((const bf16_t*)p.out + (size_t)(row + NWAVES) * D) + F.lane;
#pragma unroll
            for (int j = 0; j < 8; ++j) zn[j] = zp[64 * j]; }
#pragma unroll
        for (int j = 0; j < 8; ++j) { v[j] = make_float4(bflo(zb[j].x), bfhi(zb[j].x), bflo(zb[j].y), bfhi(zb[j].y)); s += (v[j].x + v[j].y) + (v[j].z + v[j].w); }
        float mean = wave_sum(s) * (1.f / D), s2 = 0.f;
#pragma unroll
        for (int j = 0; j < 8; ++j) { v[j].x -= mean; v[j].y -= mean; v[j].z -= mean; v[j].w -= mean; s2 += (v[j].x * v[j].x + v[j].y * v[j].y) + (v[j].z * v[j].z + v[j].w * v[j].w); }
        float rstd = 1.f / sqrtf(wave_sum(s2) * (1.f / D) + LN_EPS); s = 0.f;
#pragma unroll
        for (int j = 0; j < 8; ++j) { const f4v w = *(const LAS f4v*)(PW + 4 * F.lane + 256 * j), bb = *(const LAS f4v*)(PB + 4 * F.lane + 256 * j);
            v[j].x = v[j].x * rstd * w[0] + bb[0]; v[j].y = v[j].y * rstd * w[1] + bb[1]; v[j].z = v[j].z * rstd * w[2] + bb[2]; v[j].w = v[j].w * rstd * w[3] + bb[3];
            x1r[64 * j] = make_uint2(pk2(v[j].x, v[j].y), pk2(v[j].z, v[j].w)); s += (v[j].x + v[j].y) + (v[j].z + v[j].w); }
        mean = wave_sum(s) * (1.f / D); s2 = 0.f;
#pragma unroll
        for (int j = 0; j < 8; ++j) { v[j].x -= mean; v[j].y -= mean; v[j].z -= mean; v[j].w -= mean; s2 += (v[j].x * v[j].x + v[j].y * v[j].y) + (v[j].z * v[j].z + v[j].w * v[j].w); }
        rstd = 1.f / sqrtf(wave_sum(s2) * (1.f / D) + LN_EPS);
        uint2* o8 = (uint2*)(p.U() + (size_t)row * D) + F.lane; unsigned* o4 = (unsigned*)(p.U2F8() + (size_t)row * D) + F.lane;
#pragma unroll
        for (int j = 0; j < 8; ++j) { const f4v sh = *(const LAS f4v*)(PSH + 4 * F.lane + 256 * j), sc = *(const LAS f4v*)(PSC + 4 * F.lane + 256 * j);
            const float u0 = v[j].x * rstd * sc[0] + sh[0], u1 = v[j].y * rstd * sc[1] + sh[1], u2_ = v[j].z * rstd * sc[2] + sh[2], u3 = v[j].w * rstd * sc[3] + sh[3];
            o8[64 * j] = make_uint2(pk2(u0, u1), pk2(u2_, u3));
            unsigned w8 = 0u; w8 = __builtin_amdgcn_cvt_pk_fp8_f32(u0 * 16.f, u1 * 16.f, w8, false); w8 = __builtin_amdgcn_cvt_pk_fp8_f32(u2_ * 16.f, u3 * 16.f, w8, true); o4[64 * j] = w8; }
#pragma unroll
        for (int j = 0; j < 8; ++j) zb[j] = zn[j];
    }
}
struct XW { int vx, nx, rank, nloc; };
constexpr int NDS = 8, DSW = D / NDS;
typedef float f2v __attribute__((ext_vector_type(2)));
typedef int i32x8_t __attribute__((ext_vector_type(8)));
constexpr unsigned P9_UROW = 133120u;
__device__ __forceinline__ void phase9(const Prm& p, const Frame& F, const XW& xw) {
    static_assert(DSW == 256 && NSLOT == 128 && D == 2048 && NWAVES * 16384 <= LDSCTL_OFF, "one 16 KB tile per wave");
    const unsigned q = F.lane >> 4, r = F.lane & 15u, l8 = F.lane >> 3, c8 = F.lane & 7u;
    const int tstep = xw.nloc * NWAVES, t0 = xw.rank * NWAVES + F.wave; const int nt = t0 < T ? (T - t0 + tstep - 1) / tstep : 0;
    LAS unsigned char* W = F.lds + F.wave * 16384; LAS unsigned char* ul = F.lds + P9_UROW + F.wave * 256;
    const unsigned goff = 16u * (c8 ^ l8);
    const unsigned rbase = 1024u * (r >> 3) + 128u * (r & 7u), x0 = rbase + 16u * (q ^ (r & 7u)), x1 = rbase + 16u * ((4u + q) ^ (r & 7u));
    const int sa1 = 0x7f7f7f7f;
    __syncthreads();
    for (int ds = xw.vx; ds < NDS; ds += xw.nx) {
        if (nt == 0) continue;
        const unsigned char* tbu = p.PU4() + (size_t)ds * ((size_t)NE * 128); _Float16* part_out = (_Float16*)p.SC() + (size_t)ds * T * NSLOT + 16u * r + 4u * q;
#define UPT(i) (t0 + ((i) < nt ? (i) : nt - 1) * tstep)
#define UPE(i, ea_, eb_) do { const int* ep_ = p.EIDX() + (size_t)UPT(i) * NSLOT + F.lane; ea_ = ep_[0]; eb_ = ep_[64]; } while (0)
#define UPU(i, U_) do { U_ = *(const unsigned*)(p.U2F8() + (size_t)UPT(i) * D + ds * DSW + 4u * F.lane); } while (0)
#define UPDMA(ea_, eb_) do { _Pragma("unroll") for (int k_ = 0; k_ < 16; ++k_) { const unsigned e_ = (unsigned)__shfl(k_ < 8 ? ea_ : eb_, 8 * (k_ & 7) + (int)l8); \
            __builtin_amdgcn_global_load_lds((const unsigned*)(tbu + ((e_ << 7) | goff)), (LAS unsigned*)(W + 1024 * k_), 16, 0, 0); } } while (0)
        int ea, eb; unsigned uc;
        { int e0a, e0b; UPE(0, e0a, e0b); UPDMA(e0a, e0b); UPE(1, ea, eb); UPU(0, uc); }
        for (int i = 0; i < nt; ++i) {
            asm volatile("s_waitcnt vmcnt(0)" ::: "memory");
            u32x4_t A[16];
#pragma unroll
            for (int g = 0; g < 8; ++g) { A[2 * g] = *(const LAS u32x4_t*)(W + x0 + 2048u * g); A[2 * g + 1] = *(const LAS u32x4_t*)(W + x1 + 2048u * g); }
            *(LAS unsigned*)(ul + 4u * F.lane) = uc;
            const u32x4_t b00 = *(const LAS u32x4_t*)(ul + 16u * q), b01 = *(const LAS u32x4_t*)(ul + 64u + 16u * q), b10 = *(const LAS u32x4_t*)(ul + 128u + 16u * q), b11 = *(const LAS u32x4_t*)(ul + 192u + 16u * q);
            asm volatile("s_waitcnt lgkmcnt(0)" ::: "memory");
            UPDMA(ea, eb); UPE(i + 2, ea, eb); UPU(i + 1, uc);
            const i32x8_t B0 = {(int)b00[0], (int)b00[1], (int)b00[2], (int)b00[3], (int)b01[0], (int)b01[1], (int)b01[2], (int)b01[3]};
            const i32x8_t B1 = {(int)b10[0], (int)b10[1], (int)b10[2], (int)b10[3], (int)b11[0], (int)b11[1], (int)b11[2], (int)b11[3]};
            pg8::f32x4 acc = {0.f, 0.f, 0.f, 0.f};
#pragma unroll
            for (int g = 0; g < 8; ++g) { const int sg = (r == (unsigned)g) ? 0x7f7f7f7f : 0;
                acc = __builtin_amdgcn_mfma_scale_f32_16x16x128_f8f6f4((i32x8_t){(int)A[2 * g][0], (int)A[2 * g][1], (int)A[2 * g][2], (int)A[2 * g][3], 0, 0, 0, 0}, B0, acc, 4, 0, 0, sa1, 0, sg);
                acc = __builtin_amdgcn_mfma_scale_f32_16x16x128_f8f6f4((i32x8_t){(int)A[2 * g + 1][0], (int)A[2 * g + 1][1], (int)A[2 * g + 1][2], (int)A[2 * g + 1][3], 0, 0, 0, 0}, B1, acc, 4, 0, 0, sa1, 0, sg); }
            if (r < 8u) { typedef _Float16 h4t __attribute__((ext_vector_type(4)));
                const h4t o_ = {(_Float16)(acc[0] * 0.0625f), (_Float16)(acc[1] * 0.0625f), (_Float16)(acc[2] * 0.0625f), (_Float16)(acc[3] * 0.0625f)}; *(h4t*)(part_out + (size_t)UPT(i) * NSLOT) = o_; }
        }
        asm volatile("s_waitcnt vmcnt(0)" ::: "memory");
#undef UPDMA
#undef UPU
#undef UPE
#undef UPT
    }
}
__device__ __forceinline__ void phase10(const Prm& p, const Frame& F) {
    static_assert(NE <= 16384 && NSLOT == 128 && T % 64 == 0, "14-bit expert id, 64-token groups");
    LAS unsigned* tile = (LAS unsigned*)F.lds;
    for (int tg = F.bid; tg < T / 64; tg += F.G) {
        __syncthreads();
#pragma unroll
        for (int k = 0; k < 2; ++k) { const int idx = F.tid + NTHR * k, tl = idx >> 4, so = idx & 15; const size_t i0 = ((size_t)tg * 64 + tl) * NSLOT + 8 * so;
            float sm[8];
#pragma unroll
            for (int j = 0; j < 8; ++j) sm[j] = 0.f;
#pragma unroll
            for (int ds = 0; ds < NDS; ++ds) { const uint4 q4 = *(const uint4*)((const _Float16*)p.SC() + (size_t)ds * T * NSLOT + i0);
                typedef _Float16 h2c __attribute__((ext_vector_type(2)));
                const unsigned qq[4] = {q4.x, q4.y, q4.z, q4.w};
#pragma unroll
                for (int j = 0; j < 4; ++j) { const h2c hv = __builtin_bit_cast(h2c, qq[j]); sm[2 * j] += (float)hv[0]; sm[2 * j + 1] += (float)hv[1]; } }
            const int4 ea = *(const int4*)(p.EIDX() + i0), eb = *(const int4*)(p.EIDX() + i0 + 4); const float4 ga = *(const float4*)(p.EW() + i0), gb = *(const float4*)(p.EW() + i0 + 4);
            const int ee[8] = {ea.x, ea.y, ea.z, ea.w, eb.x, eb.y, eb.z, eb.w}; const float gg[8] = {ga.x, ga.y, ga.z, ga.w, gb.x, gb.y, gb.z, gb.w};
#pragma unroll
            for (int j = 0; j < 8; ++j) { const int e = ee[j]; const _Float16 w = (_Float16)(gg[j] * gelu_exact(sm[j] * p.RSU()[e]) * p.RSV()[e] * 256.f);
                tile[tl * 129 + 8 * so + j] = (((unsigned)__builtin_bit_cast(unsigned short, w) << 16) & 0xFFFE0000u) | ((unsigned)e << 3); } }
        __syncthreads();
        uint4* pk = (uint4*)p.EW() + (size_t)tg * 64 * (NSLOT / 4);
#pragma unroll
        for (int k = 0; k < 4; ++k) { const int j = F.tid + NTHR * k, sq = j >> 6, tl = j & 63; const LAS unsigned* tp = tile + tl * 129 + 4 * sq; pk[j] = make_uint4(tp[0], tp[1], tp[2], tp[3]); }
    }
}
__device__ __forceinline__ void phase11(const Prm& p, const Frame& F) {
    static_assert(NE * 8 <= RING_BYTES && D % 16 == 0 && NE <= 65536 && (T / 64) % (2 * NWAVES) == 0, "table slice fits the LDS ring");
    typedef _Float16 h2v __attribute__((ext_vector_type(2)));
    constexpr int NSL = D / 16;
    const int c0 = (F.G % 8 == 0) ? (F.bid % 8) * (F.G / 8) + F.bid / 8 : F.bid;
    const int nhalf = F.G >= 2 * NSL ? 2 : 1;
    for (int item = c0; item < NSL * nhalf; item += F.G) { const int sidx = item % NSL, th = item / NSL;
        __syncthreads();
        { const uint4* src = (const uint4*)(p.PV8S() + (size_t)sidx * NE * 8);
          for (int i = F.tid; i < NE / 2; i += NTHR) *(LAS u32x4_t*)(F.lds + 16 * i) = __builtin_bit_cast(u32x4_t, src[i]); }
        __syncthreads();
        const int ntgall = T / 64 / nhalf, tg0 = th * ntgall;
        const int ntg = ntgall / NWAVES, nb = 16 * ntg;
        uint4 b0[2], b1[2], b2[2], b3[2];
        const int kx = (F.G % 8 == 0) ? F.bid >> 3 : F.bid, rot = kx & 3, rotb = (kx >> 2) & 15;
#define DN_TG(bi) (tg0 + F.wave + ((((bi) >> 4) + rot) % ntg) * NWAVES)
#define DN_PTR(bi) ((const uint4*)p.EW() + (size_t)DN_TG(bi) * 64 * (NSLOT / 4) + ((((bi) & 15) + rotb) & 15) * 2 * 64 + F.lane)
#define DN_LOAD(B, bi) do { const int bc_ = (bi) < nb ? (bi) : nb - 1; const uint4* pk_ = DN_PTR(bc_); B[0] = pk_[0]; B[1] = pk_[64]; } while (0)
#define DN_ONE(v_) do { const unsigned vv_ = (v_); const _Float16 w = __builtin_bit_cast(_Float16, (unsigned short)(vv_ >> 16)); const h2v w2 = {w, w}; \
                const u2v t = *(const LAS u2v*)(F.lds + (vv_ & 0x1FFF8u)); const unsigned tx_ = t.x, ty_ = t.y; \
                a0 += __builtin_amdgcn_cvt_scalef32_pk_f16_fp4(tx_, 1.0f, 0) * w2; a1 += __builtin_amdgcn_cvt_scalef32_pk_f16_fp4(tx_, 1.0f, 1) * w2; \
                a2 += __builtin_amdgcn_cvt_scalef32_pk_f16_fp4(tx_, 1.0f, 2) * w2; a3 += __builtin_amdgcn_cvt_scalef32_pk_f16_fp4(tx_, 1.0f, 3) * w2; \
                a4 += __builtin_amdgcn_cvt_scalef32_pk_f16_fp4(ty_, 1.0f, 0) * w2; a5 += __builtin_amdgcn_cvt_scalef32_pk_f16_fp4(ty_, 1.0f, 1) * w2; \
                a6 += __builtin_amdgcn_cvt_scalef32_pk_f16_fp4(ty_, 1.0f, 2) * w2; a7 += __builtin_amdgcn_cvt_scalef32_pk_f16_fp4(ty_, 1.0f, 3) * w2; } while (0)
#define DN_ACC(B) do { _Pragma("unroll") for (int k = 0; k < 2; ++k) { DN_ONE(B[k].x); DN_ONE(B[k].y); DN_ONE(B[k].z); DN_ONE(B[k].w); } asm volatile("" ::: "memory"); } while (0)
        DN_LOAD(b0, 0); DN_LOAD(b1, 1); DN_LOAD(b2, 2);
        for (int bi = 0; bi < nb; bi += 16) {
            h2v a0 = {0, 0}, a1 = {0, 0}, a2 = {0, 0}, a3 = {0, 0}, a4 = {0, 0}, a5 = {0, 0}, a6 = {0, 0}, a7 = {0, 0};
#pragma unroll
            for (int u4 = 0; u4 < 16; u4 += 4) {
                DN_LOAD(b3, bi + u4 + 3); DN_ACC(b0);
                DN_LOAD(b0, bi + u4 + 4); DN_ACC(b1);
                DN_LOAD(b1, bi + u4 + 5); DN_ACC(b2);
                DN_LOAD(b2, bi + u4 + 6); DN_ACC(b3); }
            const int tg = DN_TG(bi); const float us = 1.f / 256.f;
            uint4* yo = (uint4*)(p.Y() + ((size_t)tg * 64 + F.lane) * D + 16 * sidx);
            yo[0] = make_uint4(pk2((float)a0[0] * us, (float)a0[1] * us), pk2((float)a1[0] * us, (float)a1[1] * us), pk2((float)a2[0] * us, (float)a2[1] * us), pk2((float)a3[0] * us, (float)a3[1] * us));
            yo[1] = make_uint4(pk2((float)a4[0] * us, (float)a4[1] * us), pk2((float)a5[0] * us, (float)a5[1] * us), pk2((float)a6[0] * us, (float)a6[1] * us), pk2((float)a7[0] * us, (float)a7[1] * us));
        }
#undef DN_ACC
#undef DN_ONE
#undef DN_LOAD
#undef DN_PTR
#undef DN_TG
    }
}
__device__ __forceinline__ void phase12(const Prm& p, const Frame& F) {
    LAS float* PW = (LAS float*)F.lds; LAS float* PB = PW + D; LAS float* PG = PW + 2 * D;
    const int rows_per = T / F.G, r_begin = F.bid * rows_per, r_end = r_begin + rows_per;
    int cur_b = -1;
    for (int i = F.tid; i < D; i += NTHR) { PW[i] = p.ln2_w[i]; PB[i] = p.ln2_b[i]; }
    float4 v[8]; uint2 xb[8], xn[8], yb[8], yn[8];
    { const uint2* xr = (const uint2*)(p.X1B() + (size_t)(r_begin + F.wave) * D) + F.lane; const uint2* yr = (const uint2*)(p.Y() + (size_t)(r_begin + F.wave) * D) + F.lane;
#pragma unroll
      for (int j = 0; j < 8; ++j) { xb[j] = xr[64 * j]; yb[j] = yr[64 * j]; } }
    for (int r0 = r_begin; r0 < r_end; r0 += NWAVES) {
        const int row = r0 + F.wave, b = r0 / S;
        if (b != cur_b) { __syncthreads(); const float* g2 = p.MOD() + (size_t)b * D6 + 5 * D;
            for (int i = F.tid; i < D; i += NTHR) PG[i] = g2[i];
            cur_b = b; __syncthreads(); }
        float4* zr = (float4*)(p.out + (size_t)row * D) + F.lane; float s = 0.f;
        if (r0 + NWAVES < r_end) { const uint2* xp = (const uint2*)(p.X1B() + (size_t)(row + NWAVES) * D) + F.lane; const uint2* yp = (const uint2*)(p.Y() + (size_t)(row + NWAVES) * D) + F.lane;
#pragma unroll
            for (int j = 0; j < 8; ++j) { xn[j] = xp[64 * j]; yn[j] = yp[64 * j]; } }
#pragma unroll
        for (int j = 0; j < 8; ++j) { const f4v g = *(const LAS f4v*)(PG + 4 * F.lane + 256 * j);
            v[j].x = ALPHA * bflo(xb[j].x) + g[0] * bflo(yb[j].x); v[j].y = ALPHA * bfhi(xb[j].x) + g[1] * bfhi(yb[j].x); v[j].z = ALPHA * bflo(xb[j].y) + g[2] * bflo(yb[j].y); v[j].w = ALPHA * bfhi(xb[j].y) + g[3] * bfhi(yb[j].y);
            s += (v[j].x + v[j].y) + (v[j].z + v[j].w); }
        const float mean = wave_sum(s) * (1.f / D); float s2 = 0.f;
#pragma unroll
        for (int j = 0; j < 8; ++j) { v[j].x -= mean; v[j].y -= mean; v[j].z -= mean; v[j].w -= mean; s2 += (v[j].x * v[j].x + v[j].y * v[j].y) + (v[j].z * v[j].z + v[j].w * v[j].w); }
        const float rstd = 1.f / sqrtf(wave_sum(s2) * (1.f / D) + LN_EPS);
#pragma unroll
        for (int j = 0; j < 8; ++j) { const f4v w = *(const LAS f4v*)(PW + 4 * F.lane + 256 * j), bb = *(const LAS f4v*)(PB + 4 * F.lane + 256 * j);
            zr[64 * j] = make_float4(v[j].x * rstd * w[0] + bb[0], v[j].y * rstd * w[1] + bb[1], v[j].z * rstd * w[2] + bb[2], v[j].w * rstd * w[3] + bb[3]); }
#pragma unroll
        for (int j = 0; j < 8; ++j) { xb[j] = xn[j]; yb[j] = yn[j]; }
    }
}

struct Args { const float* in[18]; float* out; unsigned char* ws; int ph_lo, ph_hi, li, pad; };
__global__ void __launch_bounds__(NTHR, 2) mk_fwd(Args args) {
    extern __shared__ __attribute__((aligned(16))) unsigned char lds_raw[];
    Frame F; F.lds = (LAS unsigned char*)lds_raw; F.tid = threadIdx.x; F.lane = F.tid & 63; F.wave = __builtin_amdgcn_readfirstlane(F.tid >> 6); F.G = gridDim.x; F.bid = blockIdx.x;
    Prm p; p.x = args.in[0]; p.c = args.in[1]; p.w_ada = args.in[2]; p.b_ada = args.in[3]; p.w_in = args.in[4]; p.b_in = args.in[5]; p.conv_w = args.in[6]; p.conv_b = args.in[7]; p.mnorm_w = args.in[8];
    p.w_out = args.in[9]; p.ln1_w = args.in[10]; p.ln1_b = args.in[11]; p.wq = args.in[12]; p.subkeys = args.in[13]; p.peer_u = args.in[14]; p.peer_v = args.in[15]; p.ln2_w = args.in[16]; p.ln2_b = args.in[17];
    p.out = args.out; p.ws = args.ws;
    volatile LAS unsigned* MISC = (volatile LAS unsigned*)(F.lds + MISC_OFF);
    for (int u = F.tid; u < (LDS_BYTES - LDSCTL_OFF) / 4; u += NTHR) ((LAS unsigned*)(F.lds + LDSCTL_OFF))[u] = 0u;
    __syncthreads();
    const int lo = args.ph_lo, hi = args.ph_hi;
    XcdBarrier bar; bar.bar = (unsigned*)(p.ws + WS_CTL) + CW_BAR + args.li * XCD_BAR_WORDS; bar.x = 0; bar.st = nullptr;
    if (hi - lo > 1) bar = xcd_barrier_post((unsigned*)(p.ws + WS_CTL) + CW_BAR + args.li * XCD_BAR_WORDS, MISC + 8);
#define IN(k) (lo <= (k) && (k) < hi)
#define SEAM(k) do { if (IN(k) && IN((k) + 1)) xcd_barrier(bar); } while (0)
    XW xw; xw.nx = (F.G % 8 == 0) ? 8 : 1; xw.vx = F.bid % xw.nx; xw.rank = F.bid / xw.nx; xw.nloc = F.G / xw.nx;
#define XW_FROM_CENSUS() do { if (hi - lo > 1) { if (F.tid == 0) { unsigned vx_ = 0u; for (unsigned j = 0; j < bar.x; ++j) vx_ += xb_ld(&bar.bar[XB_XCNT(j)]) > 0u ? 1u : 0u; MISC[11] = vx_; } __syncthreads(); \
        xw.vx = (int)MISC[11]; xw.nx = (int)MISC[9]; xw.rank = (int)MISC[10] - 1; xw.nloc = (int)MISC[8]; } } while (0)
    if (IN(0)) { phase0(p, F); deferred_prep<false, true, true>(p, F, 0, F.G); } SEAM(0);
    if (IN(1)) { phase1(p, F); } SEAM(1);
    if (IN(2)) { pg8::Gemm g{p.U(), p.WIN_T(), T, INM, D}; pg8::StaticOrder So; So.init(T, INM, F.G, F.bid);
        pg8::EpiBf16<0> E{p.PJ(), INM, p.b_in, 0, 0, 1.f};
        pg8::gemm_phase<pg8::EpiBf16<0>, pg8::StaticOrder, true, true>(F.lds, g, So, E); } SEAM(2);
    if (IN(3)) { const int nmb = F.G >= 2 ? F.G / 2 : 1;
#ifndef P3_REP_ML
#define P3_REP_ML 1
#define P3_REP_CONV 1
#endif
        if (F.bid < nmb) { for (int rep_ = 0; rep_ < P3_REP_ML; ++rep_) for (int u = F.bid; u < 2 * NB * MH * 2; u += nmb) ml::unit(p, F, u); if (F.G < 2) phase3a(p, F, 0, 1); }
        else { phase3a(p, F, nmb, F.G - nmb); deferred_prep<true, false, false>(p, F, nmb, F.G - nmb); }
        if (F.G < 2) deferred_prep<true, false, false>(p, F, 0, 1); } SEAM(3);
    if (IN(4)) { phase4(p, F); } SEAM(4);
    if (IN(5)) { pg8::Gemm g{p.Y(), p.WOUT_T(), T, D, D}; pg8::StaticOrder So; So.init(T, D, F.G, F.bid);
        EpiZ E{p.x, p.MOD(), (bf16_t*)p.out};
        pg8::gemm_phase<EpiZ, pg8::StaticOrder, true, true>(F.lds, g, So, E); } SEAM(5);
    if (IN(6)) { phase6(p, F); } SEAM(6);
    if (IN(7)) { pg8::Gemm g{p.U(), p.WQ_T(), T, NQ, D}; pg8::StaticOrder So; So.init(T, NQ, F.G, F.bid);
        EpiF32 E{p.SC(), NSC};
        pg8::gemm_phase<EpiF32, pg8::StaticOrder, true, true>(F.lds, g, So, E); } SEAM(7);
    if (IN(8)) { phase8(p, F); } SEAM(8);
    if (IN(9)) { if (lo < 9) XW_FROM_CENSUS(); phase9(p, F, xw); } SEAM(9);
    if (IN(10)) { phase10(p, F); } SEAM(10);
    if (IN(11)) { phase11(p, F); } SEAM(11);
    if (IN(12)) { phase12(p, F); }
#undef IN
#undef SEAM
}

extern "C" void kernel_launch(void* const* d_in, const int* in_sizes, int n_in, void* d_out, int out_size, void* d_ws, size_t ws_size, hipStream_t stream) {
    static int grid = 0;
    if (grid == 0) {
        if (n_in != 18 || out_size != T * D || ws_size < WS_END) { fprintf(stderr, "kernel_launch: unexpected shapes (n_in %d out %d ws %zu, need %zu)\n", n_in, out_size, ws_size, (size_t)WS_END); grid = -1; return; }
        int dev = 0, cus = 0, per_cu = 0;
        if (hipGetDevice(&dev) != hipSuccess || hipDeviceGetAttribute(&cus, hipDeviceAttributeMultiprocessorCount, dev) != hipSuccess) { grid = -1; return; }
        if (hipFuncSetAttribute((const void*)mk_fwd, hipFuncAttributeMaxDynamicSharedMemorySize, LDS_BYTES) != hipSuccess) { fprintf(stderr, "kernel_launch: hipFuncSetAttribute failed\n"); grid = -1; return; }
        if (hipOccupancyMaxActiveBlocksPerMultiprocessor(&per_cu, (const void*)mk_fwd, NTHR, LDS_BYTES) != hipSuccess || per_cu < 1) { fprintf(stderr, "kernel_launch: the occupancy query reports %d workgroups per CU for this kernel + LDS size: the grid barrier would not be legal, not launching\n", per_cu); grid = -1; return; }
        grid = cus;
        if (T % grid != 0 || (T / grid) % (2 * NWAVES) != 0) { fprintf(stderr, "kernel_launch: grid %d does not divide the rows\n", grid); grid = -1; return; }
    }
    if (grid < 0) return;
    (void)hipMemsetAsync((char*)d_ws + WS_CTL, 0, 1u << 20, stream);
    Args a{};
    for (int i = 0; i < 18; ++i) a.in[i] = (const float*)d_in[i];
    a.out = (float*)d_out; a.ws = (unsigned char*)d_ws;
#if defined(PROBE_A)
    a.ph_lo = 0; a.ph_hi = PROBE_B + 1; a.li = 0; hipLaunchKernelGGL(mk_fwd, dim3(grid), dim3(NTHR), LDS_BYTES, stream, a);
    a.ph_lo = PROBE_A; a.ph_hi = NPHASE; a.li = 1; hipLaunchKernelGGL(mk_fwd, dim3(grid), dim3(NTHR), LDS_BYTES, stream, a);
#elif MK_N_LAUNCHES == 1
    a.ph_lo = 0; a.ph_hi = NPHASE;
    hipLaunchKernelGGL(mk_fwd, dim3(grid), dim3(NTHR), LDS_BYTES, stream, a);
#else
    for (int k = 0; k < NPHASE; ++k) { a.ph_lo = k; a.ph_hi = k + 1; hipLaunchKernelGGL(mk_fwd, dim3(grid), dim3(NTHR), LDS_BYTES, stream, a); }
#endif
}
```

```cpp
#define MK_N_LAUNCHES 1
#if defined(HOST_EMU)
#include <cmath>
#include <cstdint>
#include <cstring>
#include <cstddef>
#define HD inline
#define HDF inline
#else
#include <hip/hip_runtime.h>
#define HD __host__ __device__ __forceinline__
#define HDF __host__ __device__ __forceinline__
#endif

#ifndef CFG_D
#define CFG_D 2048
#define CFG_B 8
#define CFG_S 2048
#define CFG_PH 8
#define CFG_NK 128
#define CFG_TOPK 16
#define CFG_KD 256
#endif
constexpr int D = CFG_D, NB = CFG_B, S = CFG_S, T = NB * S;
constexpr int CW = D / 2, MW = D - CW, MH = 4, MV = MW / MH, QK = MV / 2, NG = 16, CHUNK = 64;
constexpr int INC = 3 * CW + 2 * MH * QK + 2 * MW + NG;
constexpr int INM = INC - NG;
constexpr int O_GB = 0, O_GC = CW, O_HIN = 2 * CW, O_Q = 3 * CW, O_K = O_Q + MH * QK, O_V = O_K + MH * QK, O_O = O_V + MW;
constexpr int PH = CFG_PH, NK = CFG_NK, TOPK = CFG_TOPK, KD = CFG_KD, KH = KD / 2, NE = NK * NK, NSLOT = PH * TOPK;
constexpr int NQ = PH * KD;
static_assert(PH * 2 * NK == NQ || true, "");
constexpr int NSC = PH * 2 * NK;
constexpr float LN_EPS = 1e-5f;
constexpr float ALPHA = 1.189207115002721f;
constexpr int D6 = 6 * D;

typedef unsigned short bf16_t;
HDF unsigned f_as_u(float f) { unsigned u; memcpy(&u, &f, 4); return u; }
HDF float u_as_f(unsigned u) { float f; memcpy(&f, &u, 4); return f; }
HDF bf16_t f2bf(float f) { unsigned u = f_as_u(f); return (bf16_t)((u + 0x7fffu + ((u >> 16) & 1u)) >> 16); }
HDF float bf2f(bf16_t h) { return u_as_f((unsigned)h << 16); }

constexpr size_t al(size_t x) { return (x + 1048575) & ~(size_t)1048575; }
constexpr size_t WS_CTL = 0;
constexpr size_t WS_MOD = al(1);
constexpr size_t WS_MODP = WS_MOD + al((size_t)NB * D6 * 4);
constexpr int NKS = 32;
constexpr size_t WS_GATES = WS_MODP + al((size_t)NKS * NB * D6 * 4);
constexpr size_t WS_DEN = WS_GATES + al((size_t)T * NG * 4);
constexpr size_t WS_FLR = WS_DEN + al((size_t)4 * T * MH * 4);
constexpr size_t WS_EIDX = WS_FLR + al((size_t)2 * T * MH * 4);
constexpr size_t WS_EW = WS_EIDX + al((size_t)T * NSLOT * 4);
constexpr size_t WS_WIN_T = WS_EW + al((size_t)T * NSLOT * 4);
constexpr size_t WS_WOUT_T = WS_WIN_T + al((size_t)INM * D * 2);
constexpr size_t WS_WQ_T = WS_WOUT_T + al((size_t)D * D * 2);
constexpr size_t WS_PU16 = WS_WQ_T + al((size_t)NQ * D * 2);
constexpr size_t WS_PV16 = WS_PU16 + al((size_t)NE * D * 2);
constexpr size_t WS_U = WS_PV16 + al((size_t)NE * D * 2);
constexpr size_t WS_Y = WS_U + al((size_t)T * D * 2);
constexpr size_t WS_P = WS_Y + al((size_t)T * D * 2);
constexpr size_t WS_SC = WS_P;
constexpr size_t WS_TS = WS_SC + al((size_t)T * NSC * 4);
constexpr size_t WS_TI = WS_TS + al((size_t)T * PH * 2 * TOPK * 4);
constexpr size_t WS_P_END = WS_P + al((size_t)T * INM * 2);
constexpr size_t WS_TI_END = WS_TI + al((size_t)T * PH * 2 * TOPK * 4);
constexpr size_t WS_END = WS_P_END > WS_TI_END ? WS_P_END : WS_TI_END;

struct Prm {
    const float *x, *c, *w_ada, *b_ada, *w_in, *b_in, *conv_w, *conv_b, *mnorm_w, *w_out, *ln1_w, *ln1_b, *wq, *subkeys, *peer_u, *peer_v, *ln2_w, *ln2_b;
    float* out;
    unsigned char* ws;
    HDF float* MOD() const { return (float*)(ws + WS_MOD); }
    HDF float* MODP() const { return (float*)(ws + WS_MODP); }
    HDF float* BIN256() const { return (float*)(ws + WS_MODP); }
    HDF float* GATES() const { return (float*)(ws + WS_GATES); }
    HDF float* DEN() const { return (float*)(ws + WS_DEN); }
    HDF float* FLR() const { return (float*)(ws + WS_FLR); }
    HDF int* EIDX() const { return (int*)(ws + WS_EIDX); }
    HDF float* EW() const { return (float*)(ws + WS_EW); }
    HDF bf16_t* WIN_T() const { return (bf16_t*)(ws + WS_WIN_T); }
    HDF unsigned char* WIN8() const { return ws + WS_WIN_T; }
    HDF unsigned char* U8() const { return ws + WS_U; }
    HDF bf16_t* WOUT_T() const { return (bf16_t*)(ws + WS_WOUT_T); }
    HDF bf16_t* WQ_T() const { return (bf16_t*)(ws + WS_WQ_T); }
    HDF bf16_t* PU16() const { return (bf16_t*)(ws + WS_PU16); }
    HDF bf16_t* PV16() const { return (bf16_t*)(ws + WS_PV16); }
    HDF unsigned char* PU8() const { return ws + WS_PU16; }
    HDF unsigned char* PV8() const { return ws + WS_PV16; }
    HDF unsigned char* PU4() const { return ws + WS_PU16; }
    HDF unsigned char* U2F8() const { return ws + WS_PV16 + (size_t)NE * D; }
    HDF unsigned char* PV8S() const { return ws + WS_PV16; }
    HDF float* RSU() const { return (float*)(ws + WS_PU16 + (size_t)NE * D); }
    HDF float* RSV() const { return (float*)(ws + WS_PU16 + (size_t)NE * D + (size_t)NE * 4); }
    HDF bf16_t* U() const { return (bf16_t*)(ws + WS_U); }
    HDF bf16_t* Y() const { return (bf16_t*)(ws + WS_Y); }
    HDF bf16_t* PJ() const { return (bf16_t*)(ws + WS_P); }
    HDF float* SC() const { return (float*)(ws + WS_SC); }
    HDF bf16_t* X1B() const { return (bf16_t*)(ws + WS_TS); }
    HDF float* TS() const { return (float*)(ws + WS_TS); }
    HDF int* TI() const { return (int*)(ws + WS_TI); }
    HDF float* HF() const { return out; }
    HDF float* HB() const { return out + (size_t)T * MW; }
    HDF bf16_t* HF16() const { return (bf16_t*)out; }
    HDF bf16_t* HB16() const { return (bf16_t*)out + (size_t)T * MW; }
};

HDF float sigmoidf_(float x) { return 1.f / (1.f + expf(-x)); }
HDF float logsigmoidf_(float x) { return fminf(x, 0.f) - log1pf(expf(-fabsf(x))); }
HDF float gelu_exact(float x) { return 0.5f * x * (1.f + erff(x * 0.7071067811865476f)); }

HD void b_ada(const Prm& p, long n) {
    float acc[NB];
#pragma unroll
    for (int b = 0; b < NB; ++b) acc[b] = 0.f;
    for (int k = 0; k < D; ++k) {
        const float w = p.w_ada[(size_t)k * D6 + n];
#pragma unroll
        for (int b = 0; b < NB; ++b) { const float cv = p.c[b * D + k]; acc[b] += cv * sigmoidf_(cv) * w; }
    }
#pragma unroll
    for (int b = 0; b < NB; ++b) p.MOD()[(size_t)b * D6 + n] = acc[b] + p.b_ada[n];
}
HD void b_wt(const float* W, int ldw, int K, bf16_t* WT, long i) { const long n = i / K, k = i % K; WT[i] = f2bf(W[(size_t)k * ldw + n]); }
HD void b_tab(const float* src, bf16_t* dst, long i) { dst[i] = f2bf(src[i]); }
HD void b_ln_mod1(const Prm& p, long row) {
    const float* xr = p.x + (size_t)row * D; const int b = (int)(row / S);
    const float* sh = p.MOD() + (size_t)b * D6; const float* sc = sh + D;
    float s = 0.f; for (int d = 0; d < D; ++d) s += xr[d];
    const float mean = s / D; float q = 0.f; for (int d = 0; d < D; ++d) { const float t = xr[d] - mean; q += t * t; }
    const float rstd = 1.f / sqrtf(q / D + LN_EPS);
    for (int d = 0; d < D; ++d) p.U()[(size_t)row * D + d] = f2bf((xr[d] - mean) * rstd * (1.f + sc[d]) + sh[d]);
}
HD void b_gates(const Prm& p, long i) {
    const long row = i / NG; const int g = (int)(i % NG); float acc = 0.f;
    for (int d = 0; d < D; ++d) acc += bf2f(p.U()[(size_t)row * D + d]) * p.w_in[(size_t)d * INC + INM + g];
    p.GATES()[i] = acc + p.b_in[INM + g];
}
HD float b_dot16(const bf16_t* a, const bf16_t* b, int K) { float acc = 0.f; for (int k = 0; k < K; ++k) acc += bf2f(a[k]) * bf2f(b[k]); return acc; }
HD void b_gemm1(const Prm& p, long i) { const long row = i / INM; const int n = (int)(i % INM);
    p.PJ()[i] = f2bf(b_dot16(p.U() + (size_t)row * D, p.WIN_T() + (size_t)n * D, D) + p.b_in[n]); }
HD void b_conv(const Prm& p, long i) {
    const long row = i / CW; const int ch = (int)(i % CW); const int s = (int)(row % S);
    const bf16_t* pj = p.PJ(); float acc = p.conv_b[ch];
#pragma unroll
    for (int k = 0; k < 3; ++k) { const int s2 = s + k - 1; if (s2 >= 0 && s2 < S) { const size_t r2 = (size_t)(row + k - 1) * INM;
        acc += p.conv_w[k * CW + ch] * (bf2f(pj[r2 + O_GC + ch]) * bf2f(pj[r2 + O_HIN + ch])); } }
    p.Y()[(size_t)row * D + ch] = f2bf(bf2f(pj[(size_t)row * INM + O_GB + ch]) * acc);
}
HDF long ml_tok(int dir, int b, int pos) { return (long)b * S + (dir ? S - 1 - pos : pos); }
HD void b_mscan(const Prm& p, long i) {
    const int v = (int)(i % (MV + 1)), h = (int)((i / (MV + 1)) % MH), b = (int)((i / ((MV + 1) * MH)) % NB), dir = (int)(i / ((MV + 1) * MH * NB));
    float C[QK];
#pragma unroll
    for (int d = 0; d < QK; ++d) C[d] = 0.f;
    float m = 0.f; const float qs = 1.f / sqrtf((float)QK);
    float* H = dir ? p.HB() : p.HF();
    for (int pos = 0; pos < S; ++pos) {
        const long tok = ml_tok(dir, b, pos); const float* g = p.GATES() + tok * NG + dir * 8;
        const float ig = g[h], lf = logsigmoidf_(g[4 + h]);
        const float mn = fmaxf(lf + m, ig), dec = expf(lf + m - mn), wi = expf(ig - mn); m = mn;
        const bf16_t* pj = p.PJ() + (size_t)tok * INM; const float wv = wi * (v < MV ? bf2f(pj[O_V + h * MV + (v < MV ? v : 0)]) : 1.f); float num = 0.f;
#pragma unroll
        for (int d = 0; d < QK; ++d) { C[d] = dec * C[d] + wv * bf2f(pj[O_K + h * QK + d]); num += bf2f(pj[O_Q + h * QK + d]) * qs * C[d]; }
        if (v < MV) H[(size_t)tok * MW + h * MV + v] = num;
        else { p.DEN()[((size_t)dir * T + tok) * MH + h] = num; p.FLR()[((size_t)dir * T + tok) * MH + h] = expf(-mn); }
    }
}
HD void b_headnorm(const Prm& p, long i) {
    const long row = i / MH; const int h = (int)(i % MH);
    const float* hf = p.HF() + (size_t)row * MW + h * MV; const float* hb = p.HB() + (size_t)row * MW + h * MV;
    const float inf_ = 1.f / fmaxf(fabsf(p.DEN()[(size_t)row * MH + h]), p.FLR()[(size_t)row * MH + h]);
    const float inb_ = 1.f / fmaxf(fabsf(p.DEN()[((size_t)T + row) * MH + h]), p.FLR()[((size_t)T + row) * MH + h]);
    float s = 0.f; for (int v = 0; v < MV; ++v) s += hf[v] * inf_ + hb[v] * inb_;
    const float mean = s / MV; float q = 0.f; for (int v = 0; v < MV; ++v) { const float t = hf[v] * inf_ + hb[v] * inb_ - mean; q += t * t; }
    const float rstd = 1.f / sqrtf(q / MV + LN_EPS);
    for (int v = 0; v < MV; ++v) { const float hn = (hf[v] * inf_ + hb[v] * inb_ - mean) * rstd * p.mnorm_w[h * MV + v];
        const float og = sigmoidf_(bf2f(p.PJ()[(size_t)row * INM + O_O + h * MV + v]));
        p.Y()[(size_t)row * D + CW + h * MV + v] = f2bf(og * hn); }
}
HD void b_gemm2(const Prm& p, long i) { const long row = i / D; const int n = (int)(i % D); const int b = (int)(row / S);
    const float acc = b_dot16(p.Y() + (size_t)row * D, p.WOUT_T() + (size_t)n * D, D);
    p.out[i] = ALPHA * p.x[i] + p.MOD()[(size_t)b * D6 + 2 * D + n] * acc; }
HD void b_ln_mid(const Prm& p, long row) {
    float* zr = p.out + (size_t)row * D; const int b = (int)(row / S);
    const float* sh = p.MOD() + (size_t)b * D6 + 3 * D; const float* sc = sh + D;
    float s = 0.f; for (int d = 0; d < D; ++d) s += zr[d];
    float mean = s / D; float q = 0.f; for (int d = 0; d < D; ++d) { const float t = zr[d] - mean; q += t * t; }
    float rstd = 1.f / sqrtf(q / D + LN_EPS);
    s = 0.f; for (int d = 0; d < D; ++d) { const float x1 = (zr[d] - mean) * rstd * p.ln1_w[d] + p.ln1_b[d]; zr[d] = x1; s += x1; }
    mean = s / D; q = 0.f; for (int d = 0; d < D; ++d) { const float t = zr[d] - mean; q += t * t; }
    rstd = 1.f / sqrtf(q / D + LN_EPS);
    for (int d = 0; d < D; ++d) p.U()[(size_t)row * D + d] = f2bf((zr[d] - mean) * rstd * (1.f + sc[d]) + sh[d]);
}
HD void b_gemm3(const Prm& p, long i) { const long row = i / NQ; const int n = (int)(i % NQ);
    p.Y()[i] = f2bf(b_dot16(p.U() + (size_t)row * D, p.WQ_T() + (size_t)n * D, D)); }
HD void b_scores(const Prm& p, long i) { const long tok = i / NSC; const int c = (int)(i % NSC), grp = c / NK, n = c % NK;
    const bf16_t* q = p.Y() + (size_t)tok * NQ + grp * KH; const float* sk = p.subkeys + ((size_t)grp * NK + n) * KH; float acc = 0.f;
    for (int d = 0; d < KH; ++d) acc += bf2f(q[d]) * sk[d];
    p.SC()[i] = acc; }
HD void b_topk1(const Prm& p, long i) {
    const float* sc = p.SC() + (size_t)i * NK; float pv = INFINITY; int pi = -1;
    for (int r = 0; r < TOPK; ++r) { float best = -INFINITY; int bi = -1;
        for (int n = 0; n < NK; ++n) { const float v = sc[n]; const bool ok = (v < pv) || (v == pv && n > pi); if (ok && v > best) { best = v; bi = n; } }
        p.TS()[(size_t)i * TOPK + r] = best; p.TI()[(size_t)i * TOPK + r] = bi; pv = best; pi = bi; }
}
HD void b_topk2(const Prm& p, long i) {
    const float* s0 = p.TS() + (size_t)i * 2 * TOPK; const float* s1 = s0 + TOPK; const int* i0 = p.TI() + (size_t)i * 2 * TOPK; const int* i1 = i0 + TOPK;
    float pv = INFINITY; int pi = -1; float mx = 0.f, sum = 0.f;
    for (int r = 0; r < TOPK; ++r) { float best = -INFINITY; int bi = -1;
        for (int c = 0; c < TOPK * TOPK; ++c) { const float v = s0[c / TOPK] + s1[c % TOPK]; const bool ok = (v < pv) || (v == pv && c > pi); if (ok && v > best) { best = v; bi = c; } }
        if (r == 0) mx = best;
        const float e = expf(best - mx); sum += e;
        p.EIDX()[(size_t)i * TOPK + r] = i0[bi / TOPK] * NK + i1[bi % TOPK]; p.EW()[(size_t)i * TOPK + r] = e; pv = best; pi = bi; }
    for (int r = 0; r < TOPK; ++r) p.EW()[(size_t)i * TOPK + r] /= sum;
}
HD void b_up(const Prm& p, long i) { const long tok = i / NSLOT; const int e = p.EIDX()[i];
    p.EW()[i] *= gelu_exact(b_dot16(p.U() + (size_t)tok * D, p.PU16() + (size_t)e * D, D)); }
HD void b_down(const Prm& p, long i) { const long tok = i / D; const int d = (int)(i % D); const int b = (int)(tok / S); float y = 0.f;
    for (int sl = 0; sl < NSLOT; ++sl) y += p.EW()[tok * NSLOT + sl] * bf2f(p.PV16()[(size_t)p.EIDX()[tok * NSLOT + sl] * D + d]);
    p.out[i] = ALPHA * p.out[i] + p.MOD()[(size_t)b * D6 + 5 * D + d] * y; }
HD void b_ln2(const Prm& p, long row) {
    float* zr = p.out + (size_t)row * D;
    float s = 0.f; for (int d = 0; d < D; ++d) s += zr[d];
    const float mean = s / D; float q = 0.f; for (int d = 0; d < D; ++d) { const float t = zr[d] - mean; q += t * t; }
    const float rstd = 1.f / sqrtf(q / D + LN_EPS);
    for (int d = 0; d < D; ++d) zr[d] = (zr[d] - mean) * rstd * p.ln2_w[d] + p.ln2_b[d];
}
#include <cstdio>
#define LAS __attribute__((address_space(3)))
#define GAS __attribute__((address_space(1)))
namespace pg8 {
#define PG8_LAS __attribute__((address_space(3)))
typedef unsigned short bf16_t;
typedef short bf16x8 __attribute__((ext_vector_type(8)));
typedef float f32x4 __attribute__((ext_vector_type(4)));
typedef unsigned u32x4 __attribute__((ext_vector_type(4)));
constexpr int BM = 256, BK = 64, HALF = 128, HTB = HALF * BK * 2  , STAGE_BYTES = 8 * HTB, NXCD = 8, WGM = 8;

__host__ __device__ __forceinline__ int lds_byte(int r, int c) { const int st = (r >> 4) * 2 + (c >> 5), rr = r & 15, cc = c & 31, ob = rr * 64 + cc * 2; return st * 1024 + (ob ^ (((ob >> 9) & 1) << 5)); }
__host__ __device__ __forceinline__ void stage_rc(int b, int& R, int& C) { const int st = b / 1024, sb = b % 1024, swz = sb ^ (((sb >> 9) & 1) << 5); R = (st >> 1) * 16 + swz / 64; C = (st & 1) * 32 + (swz % 64) / 2; }
__host__ __device__ __forceinline__ int perm32(int rho) { const int n = rho >> 4, i = rho & 15; return 8 * (i >> 2) + 4 * n + (i & 3); }

struct Unit { int pm, pn; };
struct Gemm { const bf16_t* A; const bf16_t* Bt; int M, N, K; };

struct StaticOrder {
    int nM, nN, nwg, G, c;
    __host__ __device__ void init(int M, int N, int G_, int c_) { nM = M / BM; nN = N / BM; nwg = nM * nN; G = G_; c = c_; }
    __host__ __device__ bool next(int i, Unit& u) const {
        const long L = (long)i * G + c; if (L >= nwg) return false;
        int wgid = (int)L; { const int q = nwg / NXCD, r = nwg % NXCD, xcd = wgid % NXCD, off = wgid / NXCD; wgid = (xcd < r ? xcd * (q + 1) : r * (q + 1) + (xcd - r) * q) + off; }
        const int nig = WGM * nN, gid = wgid / nig, fm = gid * WGM, gsz = (nM - fm) < WGM ? (nM - fm) : WGM;
        u.pm = fm + ((wgid % nig) % gsz); u.pn = (wgid % nig) / gsz; return true;
    }
    __device__ __forceinline__ void a_ready(const Unit&) const {}
    __device__ __forceinline__ void done(const Unit&) const {}
};

__device__ __forceinline__ unsigned cvt_pk_bf16(float lo, float hi) { unsigned r; asm volatile("v_cvt_pk_bf16_f32 %0, %1, %2" : "=v"(r) : "v"(lo), "v"(hi)); return r; }
typedef float f32x2 __attribute__((ext_vector_type(2)));
__device__ __forceinline__ f32x2 gelu_pk(f32x2 v) {
    const f32x2 av = __builtin_elementwise_abs(v), d = av * 0.2316418882f + 1.0f;
    f32x2 t; t.x = __builtin_amdgcn_rcpf(d.x); t.y = __builtin_amdgcn_rcpf(d.y);
    f32x2 q = t * 0.5307027145f + (-0.7265760135f); q = q * t + 0.7107068705f; q = q * t + (-0.142248368f); q = q * t + 0.127414796f; q = q * t;
    const f32x2 s = (v * v) * (-0.72134752044f);
    f32x2 e; e.x = __builtin_amdgcn_exp2f(s.x); e.y = __builtin_amdgcn_exp2f(s.y);
    const f32x2 m = v * (q * e), r = v - m;
    f32x2 o; o.x = v.x < 0.f ? m.x : r.x; o.y = v.y < 0.f ? m.y : r.y; return o;
}

template <int ACT  > struct EpiBf16 {
    static constexpr bool PERM = true, AFTER_DRAIN = false; static_assert(ACT == 0 || ACT == 1, "EpiBf16: ACT is 0 (none) or 1 (gelu_pk)");
    bf16_t* O; int ldc; const float* bias; int split_cols; size_t split_stride; float scale0;
    __device__ __forceinline__ void operator()(const f32x4 (&acc)[2][2][4][2], const Unit& u, int wr, int wc, int fr, int fq) const {
        const int row0 = u.pm * BM + wr * 64 + fr; int colt = u.pn * BM; bf16_t* base = O;
        float sc = 1.f; if (split_cols) { const int t = colt / split_cols; base += (size_t)t * split_stride; colt -= t * split_cols; if (t == 0) sc = scale0; }
        const int col0 = colt + wc * 32 + 8 * fq, bcol0 = u.pn * BM + wc * 32 + 8 * fq;
        f32x4 bv[2][2];
#pragma unroll
        for (int bj = 0; bj < 2; ++bj)
#pragma unroll
            for (int n = 0; n < 2; ++n) bv[bj][n] = bias ? *(const f32x4*)(bias + bcol0 + bj * HALF + 4 * n) : (f32x4){0.f, 0.f, 0.f, 0.f};
#pragma unroll
        for (int ai = 0; ai < 2; ++ai)
#pragma unroll
            for (int m = 0; m < 4; ++m) { bf16_t* rowp = base + (size_t)(row0 + ai * HALF + m * 16) * ldc + col0;
#pragma unroll
                for (int bj = 0; bj < 2; ++bj) { f32x4 v0 = acc[ai][bj][m][0] + bv[bj][0], v1 = acc[ai][bj][m][1] + bv[bj][1];
                    if (ACT == 1) { f32x2 a = gelu_pk((f32x2){v0[0], v0[1]}), b = gelu_pk((f32x2){v0[2], v0[3]}), c = gelu_pk((f32x2){v1[0], v1[1]}), d = gelu_pk((f32x2){v1[2], v1[3]});
                        v0 = (f32x4){a.x, a.y, b.x, b.y}; v1 = (f32x4){c.x, c.y, d.x, d.y}; }
                    v0 = v0 * sc; v1 = v1 * sc; u32x4 w; w.x = cvt_pk_bf16(v0[0], v0[1]); w.y = cvt_pk_bf16(v0[2], v0[3]); w.z = cvt_pk_bf16(v1[0], v1[1]); w.w = cvt_pk_bf16(v1[2], v1[3]);
                    *(u32x4*)(rowp + bj * HALF) = w; } }
    }
};
template <class Epi, class Sched, bool ALIGN_EPI = false, bool SP2 = false>
__device__ __forceinline__ void gemm_phase(PG8_LAS unsigned char* lds, const Gemm g, const Sched& S, const Epi& E) {
    const int tid = threadIdx.x, wid = __builtin_amdgcn_readfirstlane(tid >> 6), lane = tid & 63, wr = wid >> 2, wc = wid & 3, fr = lane & 15, fq = lane >> 4;
    const int K = g.K, nt = K / BK;
    unsigned voffA[2], voffB[2];
#pragma unroll
    for (int i = 0; i < 2; ++i) { int R, C; stage_rc(tid * 16 + i * 8192, R, C); const int Rb = Epi::PERM ? ((R & ~31) + perm32(R & 31)) : R;
        voffA[i] = (unsigned)(R * K + C) * 2u; voffB[i] = (unsigned)(Rb * K + C) * 2u; }
    const size_t kstep = (size_t)(BK * 2);
    const size_t hstep = (size_t)HALF * K * 2;
    const size_t tstep = 2 * hstep;
    const unsigned ldsw = (unsigned)wid * 1024u;
    const int aoff = lds_byte(wr * 64 + fr, fq * 8), boff = lds_byte(wc * 32 + fr, fq * 8);
#define PG8_SA(b, h) (((b) * 2 + (h)) * HTB)
#define PG8_SB(b, h) ((4 + (b) * 2 + (h)) * HTB)
#define PG8_STAGE(bufoff, gbase, voff) do { _Pragma("unroll") for (int _i = 0; _i < 2; ++_i) \
        __builtin_amdgcn_global_load_lds((const unsigned*)((const char*)(gbase) + (voff)[_i]), (PG8_LAS unsigned*)(lds + (bufoff) + ldsw + _i * 8192), 16, 0, 0); } while (0)
#define PG8_LDA(dst, b, h) do { _Pragma("unroll") for (int m = 0; m < 4; ++m) _Pragma("unroll") for (int k = 0; k < 2; ++k) dst[m][k] = *(const PG8_LAS bf16x8*)(lds + PG8_SA(b, h) + aoff + m * 2048 + k * 1024); } while (0)
#define PG8_LDB(dst, b, h) do { _Pragma("unroll") for (int n = 0; n < 2; ++n) _Pragma("unroll") for (int k = 0; k < 2; ++k) dst[n][k] = *(const PG8_LAS bf16x8*)(lds + PG8_SB(b, h) + boff + n * 2048 + k * 1024); } while (0)
#define PG8_MMA(ai, bj, At, Bt) do { __builtin_amdgcn_s_setprio(1); _Pragma("unroll") for (int m = 0; m < 4; ++m) _Pragma("unroll") for (int n = 0; n < 2; ++n) _Pragma("unroll") for (int k = 0; k < 2; ++k) \
        acc[ai][bj][m][n] = __builtin_amdgcn_mfma_f32_16x16x32_bf16(Bt[n][k], At[m][k], acc[ai][bj][m][n], 0, 0, 0); __builtin_amdgcn_s_setprio(0); } while (0)
#define PG8_WAIT_V(n) asm volatile("s_waitcnt vmcnt(" #n ")" ::: "memory")
#define PG8_WAIT_L(n) asm volatile("s_waitcnt lgkmcnt(" #n ")" ::: "memory")
#define PG8_BAR __builtin_amdgcn_s_barrier()
#define PG8_SCHED __builtin_amdgcn_sched_barrier(0)
    Unit cur, nxt; int ui = 0;
    if (!S.next(0, cur)) return;
    f32x4 acc[2][2][4][2];
#pragma unroll
    for (int a = 0; a < 2; ++a)
#pragma unroll
        for (int b = 0; b < 2; ++b)
#pragma unroll
            for (int m = 0; m < 4; ++m)
#pragma unroll
                for (int n = 0; n < 2; ++n) acc[a][b][m][n] = (f32x4){0.f, 0.f, 0.f, 0.f};
    bf16x8 At[4][2], B0[2][2], B1[2][2];
    const char* cA = (const char*)g.A + (size_t)cur.pm * tstep; const char* cB = (const char*)g.Bt + (size_t)cur.pn * tstep;
    S.a_ready(cur);
    if constexpr (SP2) {
        PG8_STAGE(PG8_SB(0, 0), cB, voffB); PG8_STAGE(PG8_SB(0, 1), cB + hstep, voffB); PG8_STAGE(PG8_SA(0, 0), cA, voffA); PG8_STAGE(PG8_SA(0, 1), cA + hstep, voffA);
        if (wr == 1) PG8_BAR;
        PG8_WAIT_V(2); PG8_BAR;
        PG8_STAGE(PG8_SB(1, 0), cB + kstep, voffB); PG8_STAGE(PG8_SA(1, 0), cA + kstep, voffA); PG8_STAGE(PG8_SB(1, 1), cB + hstep + kstep, voffB);
        PG8_WAIT_V(6); PG8_BAR;
    } else {
        PG8_STAGE(PG8_SB(0, 0), cB, voffB); PG8_STAGE(PG8_SA(0, 0), cA, voffA); PG8_STAGE(PG8_SB(0, 1), cB + hstep, voffB); PG8_STAGE(PG8_SA(0, 1), cA + hstep, voffA);
        if (wr == 1) PG8_BAR;
        PG8_WAIT_V(4); PG8_BAR;
        PG8_STAGE(PG8_SB(1, 0), cB + kstep, voffB); PG8_STAGE(PG8_SA(1, 0), cA + kstep, voffA); PG8_STAGE(PG8_SB(1, 1), cB + hstep + kstep, voffB);
        PG8_WAIT_V(6); PG8_BAR;
    }
    for (;;) {
        const bool has_next = S.next(ui + 1, nxt);
        const char* nA = has_next ? (const char*)g.A + (size_t)nxt.pm * tstep : cA; const char* nB = has_next ? (const char*)g.Bt + (size_t)nxt.pn * tstep : cB;
        for (int t = 0; t < nt; t += 2) {
            const bool last = (t == nt - 2);
            const char* a1 = cA + (size_t)(t + 1) * kstep;
            const char* a2 = last ? nA : cA + (size_t)(t + 2) * kstep; const char* b2 = last ? nB : cB + (size_t)(t + 2) * kstep;
            const char* a3 = a2 + kstep; const char* b3 = b2 + kstep;
            if (last && has_next) S.a_ready(nxt);
            if constexpr (SP2) {
            PG8_LDB(B0, 0, 0); PG8_LDB(B1, 0, 1); PG8_SCHED; PG8_LDA(At, 0, 0); PG8_STAGE(PG8_SA(1, 1), a1 + hstep, voffA);
            PG8_WAIT_V(8); PG8_WAIT_L(0); PG8_BAR; PG8_MMA(0, 0, At, B0); PG8_MMA(0, 1, At, B1); PG8_BAR; PG8_SCHED;
            PG8_LDA(At, 0, 1); PG8_STAGE(PG8_SB(0, 0), b2, voffB); PG8_STAGE(PG8_SB(0, 1), b2 + hstep, voffB); PG8_STAGE(PG8_SA(0, 0), a2, voffA);
            PG8_WAIT_V(8); PG8_WAIT_L(0); PG8_BAR; PG8_MMA(1, 0, At, B0); PG8_MMA(1, 1, At, B1); PG8_BAR; PG8_SCHED;
            PG8_LDB(B0, 1, 0); PG8_LDB(B1, 1, 1); PG8_SCHED; PG8_LDA(At, 1, 0); PG8_STAGE(PG8_SA(0, 1), a2 + hstep, voffA);
            PG8_WAIT_V(8); PG8_WAIT_L(0); PG8_BAR; PG8_MMA(0, 0, At, B0); PG8_MMA(0, 1, At, B1); PG8_BAR; PG8_SCHED;
            PG8_LDA(At, 1, 1); PG8_STAGE(PG8_SB(1, 0), b3, voffB); PG8_STAGE(PG8_SB(1, 1), b3 + hstep, voffB); PG8_STAGE(PG8_SA(1, 0), a3, voffA);
            PG8_WAIT_V(8); PG8_WAIT_L(0); PG8_BAR; PG8_MMA(1, 0, At, B0); PG8_MMA(1, 1, At, B1); PG8_BAR; PG8_SCHED;
            } else {
            PG8_LDB(B0, 0, 0); PG8_SCHED; PG8_LDA(At, 0, 0); PG8_STAGE(PG8_SA(1, 1), a1 + hstep, voffA);
            PG8_WAIT_L(8); PG8_BAR; PG8_WAIT_L(0); PG8_MMA(0, 0, At, B0); PG8_BAR; PG8_SCHED;
            PG8_LDB(B1, 0, 1); PG8_STAGE(PG8_SB(0, 0), b2, voffB);
            PG8_BAR; PG8_WAIT_L(0); PG8_MMA(0, 1, At, B1); PG8_BAR;
            PG8_LDA(At, 0, 1); PG8_STAGE(PG8_SA(0, 0), a2, voffA);
            PG8_BAR; PG8_WAIT_L(0); PG8_MMA(1, 0, At, B0); PG8_BAR; PG8_SCHED;
            PG8_STAGE(PG8_SB(0, 1), b2 + hstep, voffB);
            PG8_WAIT_V(6); PG8_BAR; PG8_MMA(1, 1, At, B1); PG8_BAR;
            PG8_LDB(B0, 1, 0); PG8_SCHED; PG8_LDA(At, 1, 0); PG8_STAGE(PG8_SA(0, 1), a2 + hstep, voffA);
            PG8_WAIT_L(8); PG8_BAR; PG8_WAIT_L(0); PG8_MMA(0, 0, At, B0); PG8_BAR; PG8_SCHED;
            PG8_LDB(B1, 1, 1); PG8_STAGE(PG8_SB(1, 0), b3, voffB);
            PG8_BAR; PG8_WAIT_L(0); PG8_MMA(0, 1, At, B1); PG8_BAR;
            PG8_LDA(At, 1, 1); PG8_STAGE(PG8_SA(1, 0), a3, voffA);
            PG8_BAR; PG8_WAIT_L(0); PG8_MMA(1, 0, At, B0); PG8_BAR; PG8_SCHED;
            PG8_STAGE(PG8_SB(1, 1), b3 + hstep, voffB);
            PG8_WAIT_V(6); PG8_BAR; PG8_MMA(1, 1, At, B1); PG8_BAR;
            }
        }
        if constexpr (ALIGN_EPI) { if (wr == 0) PG8_BAR; }
        if constexpr (!Epi::AFTER_DRAIN) { E(acc, cur, wr, wc, fr, fq); S.done(cur); }
        if (!has_next) break;
#pragma unroll
        for (int a = 0; a < 2; ++a)
#pragma unroll
            for (int b = 0; b < 2; ++b)
#pragma unroll
                for (int m = 0; m < 4; ++m)
#pragma unroll
                    for (int n = 0; n < 2; ++n) acc[a][b][m][n] = (f32x4){0.f, 0.f, 0.f, 0.f};
        cur = nxt; cA = nA; cB = nB; ++ui;
        if constexpr (ALIGN_EPI) { if (wr == 1) PG8_BAR; }
    }
    PG8_WAIT_V(0);
    if constexpr (!ALIGN_EPI) { if (wr == 0) PG8_BAR; }
    PG8_BAR;
    if constexpr (Epi::AFTER_DRAIN) { E.fused(acc, cur, wr, wc, fr, fq, lds, wid, lane); S.done(cur); }
#undef PG8_SA
#undef PG8_SB
#undef PG8_STAGE
#undef PG8_LDA
#undef PG8_LDB
#undef PG8_MMA
#undef PG8_WAIT_V
#undef PG8_WAIT_L
#undef PG8_BAR
#undef PG8_SCHED
}
}
#define XB_TMO      128
#define XB_XCNT(j)  (256  + 64 * (j))
#define XB_XSUB(j)  (1280 + 64 * (j))
#define XB_XGEN(j)  (2304 + 64 * (j))
#define XB_TOP      3328
#define XB_TOPGEN   3392
#define XCD_BAR_WORDS 3456
#define XB_SPIN_CAP (1u << 18)

__device__ __forceinline__ unsigned xb_ld(unsigned* p)              { return __hip_atomic_load(p, __ATOMIC_RELAXED, __HIP_MEMORY_SCOPE_AGENT); }
__device__ __forceinline__ unsigned xb_add(unsigned* p, unsigned v) { return __hip_atomic_fetch_add(p, v, __ATOMIC_RELAXED, __HIP_MEMORY_SCOPE_AGENT); }
__device__ __forceinline__ unsigned xb_xcc_id() { return (unsigned)__builtin_amdgcn_s_getreg((3 << 11) | 20) & 0xFu; }
#define XB_SPIN(cond, bar) do { unsigned _sp = 0; while (cond) { __builtin_amdgcn_s_sleep(1); \
    if ((++_sp & 255u) == 0u) { if (xb_ld(&(bar)[XB_TMO])) break; if (_sp > XB_SPIN_CAP) { atomicAdd(&(bar)[XB_TMO], 1u); break; } } } } while (0)

struct XcdBarrier {
    unsigned* bar; unsigned x;
    volatile LAS unsigned* st;
};

__device__ __forceinline__ XcdBarrier xcd_barrier_post(unsigned* bar, volatile LAS unsigned* st) {
    XcdBarrier b; b.bar = bar; b.x = xb_xcc_id(); b.st = st;
    if (threadIdx.x == 0) st[2] = xb_add(&bar[XB_XCNT(b.x)], 1u) + 1u;
    return b;
}
__device__ __forceinline__ void xcd_barrier_complete(unsigned* bar, unsigned x, unsigned& nloc, unsigned& nx) {
    const unsigned G = gridDim.x * gridDim.y * gridDim.z;
    unsigned sum, cnt, mine, sp = 0u;
    for (;;) {
        sum = 0u; cnt = 0u; mine = 0u;
#pragma unroll
        for (unsigned j = 0; j < 16; ++j) { const unsigned c = xb_ld(&bar[XB_XCNT(j)]); sum += c; cnt += (c > 0u) ? 1u : 0u; mine = (j == x) ? c : mine; }
        if (sum == G) break;
        __builtin_amdgcn_s_sleep(1);
        if ((++sp & 255u) == 0u) { if (xb_ld(&bar[XB_TMO])) break; if (sp > XB_SPIN_CAP) { atomicAdd(&bar[XB_TMO], 1u); break; } }
    }
    nloc = mine > 0u ? mine : 1u; nx = cnt > 0u ? cnt : 1u;
}

__device__ __forceinline__ void xcd_barrier(const XcdBarrier& b) {
    asm volatile("s_waitcnt vmcnt(0)" ::: "memory");
    __syncthreads();
    if (threadIdx.x == 0) {
        unsigned* bar = b.bar;
        __builtin_amdgcn_s_waitcnt(0);
        unsigned nloc = b.st[0], nx = b.st[1];
        if (nloc == 0u) { xcd_barrier_complete(bar, b.x, nloc, nx); b.st[0] = nloc; b.st[1] = nx; }
        const unsigned old = xb_add(&bar[XB_XSUB(b.x)], 1u);
        const unsigned gen = old / nloc;
        if (old + 1u == (gen + 1u) * nloc) {
            __builtin_amdgcn_fence(__ATOMIC_RELEASE, "agent");
            asm volatile("s_waitcnt vmcnt(0)" ::: "memory");
            const unsigned og = xb_add(&bar[XB_TOP], 1u);
            const unsigned tg = og / nx;
            if (og + 1u == (tg + 1u) * nx) xb_add(&bar[XB_TOPGEN], 1u);
            else XB_SPIN(xb_ld(&bar[XB_TOPGEN]) == tg, bar);
            __builtin_amdgcn_fence(__ATOMIC_ACQUIRE, "agent");
            xb_add(&bar[XB_XGEN(b.x)], 1u);
            asm volatile("s_waitcnt vmcnt(0)" ::: "memory");
        } else {
            XB_SPIN(xb_ld(&bar[XB_XGEN(b.x)]) == gen, bar);
            __builtin_amdgcn_fence(__ATOMIC_ACQUIRE, "agent");
            asm volatile("s_waitcnt vmcnt(0)" ::: "memory");
        }
    }
    __syncthreads();
}
constexpr int NWAVES = 8, NTHR = 512;
constexpr int RING_BYTES = 131072, LDSCTL_OFF = RING_BYTES, MISC_OFF = LDSCTL_OFF + 320, LDS_BYTES = 163840;
constexpr int CW_BAR = 4096;
#ifndef MK_N_LAUNCHES
#define MK_N_LAUNCHES 1
#endif
constexpr int NPHASE = 13;

typedef float f4v __attribute__((ext_vector_type(4)));
typedef unsigned u2v __attribute__((ext_vector_type(2)));
typedef unsigned u32x4_t __attribute__((ext_vector_type(4)));
struct Frame { LAS unsigned char* lds; int tid, lane, wave, G, bid; };
template <int CTRL, int ROWMASK> __device__ __forceinline__ float dppf(float old, float src) {
    return __builtin_bit_cast(float, __builtin_amdgcn_update_dpp(__builtin_bit_cast(int, old), __builtin_bit_cast(int, src), CTRL, ROWMASK, 0xf, false)); }
__device__ __forceinline__ float wave_scan_add(float v) {
    v += dppf<0x111, 0xf>(0.f, v); v += dppf<0x112, 0xf>(0.f, v); v += dppf<0x114, 0xf>(0.f, v); v += dppf<0x118, 0xf>(0.f, v);
    v += dppf<0x142, 0xa>(0.f, v); v += dppf<0x143, 0xc>(0.f, v); return v; }
__device__ __forceinline__ float wave_scan_max(float v) {
    const float NI = -INFINITY;
    v = fmaxf(v, dppf<0x111, 0xf>(NI, v)); v = fmaxf(v, dppf<0x112, 0xf>(NI, v)); v = fmaxf(v, dppf<0x114, 0xf>(NI, v)); v = fmaxf(v, dppf<0x118, 0xf>(NI, v));
    v = fmaxf(v, dppf<0x142, 0xa>(NI, v)); v = fmaxf(v, dppf<0x143, 0xc>(NI, v)); return v; }
__device__ __forceinline__ float lane_bcast(float v, int l) { return __builtin_bit_cast(float, __builtin_amdgcn_readlane(__builtin_bit_cast(int, v), l)); }
__device__ __forceinline__ float wave_sum(float v) { return lane_bcast(wave_scan_add(v), 63); }
__device__ __forceinline__ unsigned pk2(float lo, float hi) { return (unsigned)f2bf(lo) | ((unsigned)f2bf(hi) << 16); }
__device__ __forceinline__ float bflo(unsigned w) { return u_as_f(w << 16); }
__device__ __forceinline__ float bfhi(unsigned w) { return u_as_f(w & 0xffff0000u); }

__device__ __forceinline__ void p0_ada_block(const Prm& p, const Frame& F, int cb) {
    static_assert(D6 % 48 == 0 && NB == 8, "48-column blocks");
    LAS float* sl = (LAS float*)F.lds;
    LAS float* red = sl + NB * D;
    { static_assert(NB * D == 8 * 4 * NTHR, "silu staging: 8 float4 per thread"); f4v cv[8];
#pragma unroll
      for (int j = 0; j < 8; ++j) cv[j] = *((const f4v*)p.c + F.tid + NTHR * j);
#pragma unroll
      for (int j = 0; j < 8; ++j) { f4v o; o[0] = cv[j][0] / (1.f + __expf(-cv[j][0])); o[1] = cv[j][1] / (1.f + __expf(-cv[j][1])); o[2] = cv[j][2] / (1.f + __expf(-cv[j][2])); o[3] = cv[j][3] / (1.f + __expf(-cv[j][3]));
          *(LAS f4v*)(sl + 4 * (F.tid + NTHR * j)) = o; } }
    __syncthreads();
    const int c4 = F.tid % 12, kl = F.tid / 12;
    if (kl < 42) {
        f4v acc[NB];
#pragma unroll
        for (int b = 0; b < NB; ++b) acc[b] = (f4v){0.f, 0.f, 0.f, 0.f};
        const float* wp = p.w_ada + (size_t)cb * 48 + 4 * c4;
#pragma unroll 7
        for (int k = kl; k < D; k += 42) { const f4v w = __builtin_nontemporal_load((const f4v*)(wp + (size_t)k * D6));
#pragma unroll
            for (int b = 0; b < NB; ++b) acc[b] += w * sl[b * D + k]; }
#pragma unroll
        for (int b = 0; b < NB; ++b) *(LAS f4v*)(red + (kl * NB + b) * 48 + 4 * c4) = acc[b];
    }
    __syncthreads();
    if (F.tid < NB * 48) { const int b = F.tid / 48, col = F.tid % 48; float s = 0.f;
        for (int k = 0; k < 42; ++k) s += red[(k * NB + b) * 48 + col];
        p.MOD()[(size_t)b * D6 + cb * 48 + col] = s + p.b_ada[cb * 48 + col]; }
    __syncthreads();
}
__device__ __forceinline__ void p0_transpose_item(const float* W, int ldw, int K, int N, bf16_t* WT, LAS float* scr, int item, int lane) {
    const int nblk = N / 32, kb = item / nblk, nb = item % nblk, k0 = 64 * kb, n0 = 32 * nb;
#pragma unroll
    for (int i = 0; i < 32; ++i) { const int kk = 2 * i + (lane >> 5); scr[kk * 33 + (lane & 31)] = W[(size_t)(k0 + kk) * ldw + n0 + (lane & 31)]; }
    asm volatile("s_waitcnt lgkmcnt(0)" ::: "memory");
    const int c = lane & 7;
#pragma unroll
    for (int j = 0; j < 4; ++j) { const int n = (lane >> 3) + 8 * j; const LAS float* s = scr + (8 * c) * 33 + n;
        uint4 o; o.x = pk2(s[0 * 33], s[1 * 33]); o.y = pk2(s[2 * 33], s[3 * 33]); o.z = pk2(s[4 * 33], s[5 * 33]); o.w = pk2(s[6 * 33], s[7 * 33]);
        *(uint4*)(WT + (size_t)(n0 + n) * K + k0 + 8 * c) = o; }
    asm volatile("s_waitcnt lgkmcnt(0)" ::: "memory");
}

__device__ __forceinline__ void p0_fold_item(const Prm& p, int item, int lane) {
    static_assert(NK == 128 && KH == 128 && NQ == 2048, "fold item decomposition");
    const int ks = item & 31, nt = (item >> 5) & 7, g = item >> 8;
    const int r = lane & 15, q = lane >> 4;
    const float* arow = p.subkeys + ((size_t)g * NK + nt * 16 + r) * KH + 4 * q;
    const float* brow = p.wq + (size_t)(ks * 64 + r) * NQ + g * KH + 4 * q;
    pg8::f32x4 acc[4];
#pragma unroll
    for (int c = 0; c < 4; ++c) acc[c] = (pg8::f32x4){0.f, 0.f, 0.f, 0.f};
#pragma unroll 2
    for (int s16 = 0; s16 < KH; s16 += 16) {
        const pg8::f32x4 a = *(const pg8::f32x4*)(arow + s16); pg8::f32x4 bv[4];
#pragma unroll
        for (int c = 0; c < 4; ++c) bv[c] = *(const pg8::f32x4*)(brow + (size_t)(c * 16) * NQ + s16);
#pragma unroll
        for (int i = 0; i < 4; ++i)
#pragma unroll
            for (int c = 0; c < 4; ++c) acc[c] = __builtin_amdgcn_mfma_f32_16x16x4f32(a[i], bv[c][i], acc[c], 0, 0, 0);
    }
#pragma unroll
    for (int c = 0; c < 4; ++c)
#pragma unroll
        for (int i = 0; i < 4; ++i) p.WQ_T()[(size_t)(g * NK + nt * 16 + 4 * q + i) * D + ks * 64 + c * 16 + r] = f2bf(acc[c][i]);
}
__device__ __forceinline__ void phase0(const Prm& p, const Frame& F) {
    for (int cb = F.bid; cb < D6 / 48; cb += F.G) p0_ada_block(p, F, cb);
    LAS float* scr = (LAS float*)(F.lds + F.wave * 16384);
    const int gw = F.bid * NWAVES + F.wave, NGW = F.G * NWAVES;
    constexpr int I_IN = (D / 64) * (INM / 32);
    for (int it = gw; it < I_IN; it += NGW) p0_transpose_item(p.w_in, INC, D, INM, p.WIN_T(), scr, it, F.lane);
}
__device__ __forceinline__ f4v f4clamp(f4v x) { f4v y; y[0] = fminf(fmaxf(x[0], -6.f), 6.f); y[1] = fminf(fmaxf(x[1], -6.f), 6.f); y[2] = fminf(fmaxf(x[2], -6.f), 6.f); y[3] = fminf(fmaxf(x[3], -6.f), 6.f); return y; }
template <bool PART_A, bool PART_B, bool PART_F>
__device__ __forceinline__ void deferred_prep(const Prm& p, const Frame& F, int b0, int nb) {
    __syncthreads();
    LAS float* scr = (LAS float*)(F.lds + F.wave * 16384);
    const int gw = (F.bid - b0) * NWAVES + F.wave, NGW = nb * NWAVES;
    constexpr int I_O = (D / 64) * (D / 32), I_Q = 32 * 8 * 16;
    if (PART_A) for (int it = gw; it < I_O; it += NGW) p0_transpose_item(p.w_out, D, D, D, p.WOUT_T(), scr, it, F.lane);
    if (PART_F) for (int it = gw; it < I_Q; it += NGW) p0_fold_item(p, it, F.lane);
    if (PART_A) {
        f4v v[8], vn[8]; int rr = gw;
#define P0_ROWSRC(rr_) ((const f4v*)(p.peer_u + (size_t)(rr_) * D) + 2 * F.lane)
        if (rr < NE) { const f4v* src = P0_ROWSRC(rr);
#pragma unroll
            for (int j = 0; j < 8; ++j) v[j] = __builtin_nontemporal_load(src + 128 * (j >> 1) + (j & 1)); }
        for (; rr < NE; rr += NGW) {
            const int rn = rr + NGW;
            if (rn < NE) { const f4v* src = P0_ROWSRC(rn);
#pragma unroll
                for (int j = 0; j < 8; ++j) vn[j] = __builtin_nontemporal_load(src + 128 * (j >> 1) + (j & 1)); }
            const int e = rr; float am = 0.f;
#pragma unroll
            for (int j = 0; j < 8; ++j) am = fmaxf(am, fmaxf(fmaxf(fabsf(v[j][0]), fabsf(v[j][1])), fmaxf(fabsf(v[j][2]), fabsf(v[j][3]))));
#pragma unroll
            for (int o = 1; o < 64; o <<= 1) am = fmaxf(am, __shfl_xor(am, o));
            am *= 0.8f;
            const float sc = am > 0.f ? 6.f / am : 1.f;
            unsigned char* dst = p.PU4() + (size_t)e * 128 + 4u * (F.lane & 31) + (size_t)(F.lane >> 5) * ((size_t)NE * 128);
#pragma unroll
            for (int j2 = 0; j2 < 4; ++j2) { unsigned w = 0u; const f4v a = f4clamp(v[2 * j2] * sc), b = f4clamp(v[2 * j2 + 1] * sc);
                w = __builtin_amdgcn_cvt_scalef32_pk_fp4_f32(w, a[0], a[1], 1.0f, 0); w = __builtin_amdgcn_cvt_scalef32_pk_fp4_f32(w, a[2], a[3], 1.0f, 1);
                w = __builtin_amdgcn_cvt_scalef32_pk_fp4_f32(w, b[0], b[1], 1.0f, 2); w = __builtin_amdgcn_cvt_scalef32_pk_fp4_f32(w, b[2], b[3], 1.0f, 3); *(unsigned*)(dst + (size_t)(2 * j2) * ((size_t)NE * 128)) = w; }
            if (F.lane == 0) p.RSU()[e] = am > 0.f ? am / 6.f : 1.f;
#pragma unroll
            for (int j = 0; j < 8; ++j) v[j] = vn[j];
        }
#undef P0_ROWSRC
    }
    if (PART_B) { LAS unsigned char* tl = F.lds; constexpr int RS_ = 1032;
      const int row = F.tid >> 5, l32 = F.tid & 31; f4v x[16], xn[16];
      if (F.bid - b0 < NE / 16) { const f4v* src = (const f4v*)(p.peer_v + (size_t)((F.bid - b0) * 16 + row) * D) + l32;
#pragma unroll
        for (int j = 0; j < 16; ++j) x[j] = __builtin_nontemporal_load(src + 32 * j); }
      for (int tile = F.bid - b0; tile < NE / 16; tile += nb) { const int e = tile * 16 + row;
        __syncthreads();
        if (tile + nb < NE / 16) { const f4v* srcn = (const f4v*)(p.peer_v + (size_t)((tile + nb) * 16 + row) * D) + l32;
#pragma unroll
            for (int j = 0; j < 16; ++j) xn[j] = __builtin_nontemporal_load(srcn + 32 * j); }
        float am = 0.f;
#pragma unroll
        for (int j = 0; j < 16; ++j) am = fmaxf(am, fmaxf(fmaxf(fabsf(x[j][0]), fabsf(x[j][1])), fmaxf(fabsf(x[j][2]), fabsf(x[j][3]))));
#pragma unroll
        for (int o = 1; o < 32; o <<= 1) am = fmaxf(am, __shfl_xor(am, o));
        am *= 0.8f;
        const float sc = am > 0.f ? 6.f / am : 1.f;
#pragma unroll
        for (int j = 0; j < 16; ++j) { unsigned w = 0u; const f4v y = f4clamp(x[j] * sc); w = __builtin_amdgcn_cvt_scalef32_pk_fp4_f32(w, y[0], y[1], 1.0f, 0); w = __builtin_amdgcn_cvt_scalef32_pk_fp4_f32(w, y[2], y[3], 1.0f, 1);
            *(LAS unsigned short*)(tl + row * RS_ + 2 * (l32 + 32 * j)) = (unsigned short)w; }
        if (l32 == 0) p.RSV()[e] = am > 0.f ? am / 6.f : 1.f;
        __syncthreads();
#pragma unroll
        for (int k = 0; k < 4; ++k) { const int idx = F.tid + NTHR * k, r = idx & 15, sl = idx >> 4;
            *(u2v*)(p.PV8S() + ((size_t)sl * NE + tile * 16 + r) * 8) = *(const LAS u2v*)(tl + r * RS_ + 8 * sl); }
#pragma unroll
        for (int j = 0; j < 16; ++j) x[j] = xn[j];
      } }
}
__device__ __forceinline__ void phase1(const Prm& p, const Frame& F) {
    static_assert(NG == 16 && D % 32 == 0, "gate tile = one 16-column MFMA tile");
    LAS float* SH = (LAS float*)F.lds; LAS float* SC1 = SH + D;
    constexpr unsigned WGS = 2 * D + 16, WG_OFF = 2 * D * 4, US_OFF = ((WG_OFF + NG * WGS + 255u) / 256u) * 256u;
    constexpr unsigned US_HI = 132096u;
    static_assert(US_OFF + 5 * 2 * D * 2 <= (unsigned)LDSCTL_OFF && US_HI + 3 * 2 * D * 2 <= (unsigned)LDS_BYTES && US_HI >= (unsigned)MISC_OFF + 128u, "P1 LDS map");
    LAS unsigned char* WGb = F.lds + WG_OFF; LAS unsigned char* USb = F.wave < 5 ? F.lds + US_OFF + F.wave * (2 * D * 2) : F.lds + US_HI + (F.wave - 5) * (2 * D * 2);
    const int rows_per = T / F.G;
    int cur_b = -1;
    float4 xpre[8];
    { const float4* x0 = (const float4*)(p.x + (size_t)(F.bid * rows_per + F.wave) * D) + F.lane;
#pragma unroll
      for (int j = 0; j < 8; ++j) xpre[j] = x0[64 * j]; }
    { static_assert(NG * D / NTHR == 64, "gate weight image: 64 values per thread");
      const int st = (F.bid * 37) % 4;
#pragma unroll 1
      for (int kb = 0; kb < 4; ++kb) { float wv[16]; const int k0 = 16 * ((kb + st) & 3);
#pragma unroll
          for (int k = 0; k < 16; ++k) { const int idx = F.tid + NTHR * (k0 + k); wv[k] = p.w_in[(size_t)(idx / NG) * INC + INM + (idx % NG)]; }
#pragma unroll
          for (int k = 0; k < 16; ++k) { const int idx = F.tid + NTHR * (k0 + k); *(LAS bf16_t*)(WGb + (idx % NG) * WGS + 2 * (idx / NG)) = f2bf(wv[k]); } } }
    int it = 0;
    for (int r0 = F.bid * rows_per; r0 < (F.bid + 1) * rows_per; r0 += NWAVES, ++it) {
        const int b = r0 / S;
        if (b != cur_b) { __syncthreads();
            { const f4v s4 = *((const f4v*)(p.MOD() + (size_t)b * D6) + F.tid), c4 = *((const f4v*)(p.MOD() + (size_t)b * D6 + D) + F.tid); *(LAS f4v*)(SH + 4 * F.tid) = s4; *(LAS f4v*)(SC1 + 4 * F.tid) = c4 + 1.f; }
            cur_b = b; __syncthreads(); }
        const int row = r0 + F.wave;
        float4 v[8]; float s = 0.f;
#pragma unroll
        for (int j = 0; j < 8; ++j) v[j] = xpre[j];
        if (r0 + NWAVES < (F.bid + 1) * rows_per) { const float4* xn = (const float4*)(p.x + (size_t)(row + NWAVES) * D) + F.lane;
#pragma unroll
            for (int j = 0; j < 8; ++j) xpre[j] = xn[64 * j]; }
#pragma unroll
        for (int j = 0; j < 8; ++j) s += (v[j].x + v[j].y) + (v[j].z + v[j].w);
        const float mean = wave_sum(s) * (1.f / D); float s2 = 0.f;
#pragma unroll
        for (int j = 0; j < 8; ++j) { v[j].x -= mean; v[j].y -= mean; v[j].z -= mean; v[j].w -= mean; s2 += (v[j].x * v[j].x + v[j].y * v[j].y) + (v[j].z * v[j].z + v[j].w * v[j].w); }
        const float rstd = 1.f / sqrtf(wave_sum(s2) * (1.f / D) + LN_EPS);
        uint2* o8 = (uint2*)(p.U() + (size_t)row * D) + F.lane; LAS u2v* us = (LAS u2v*)(USb + (it & 1) * (2 * D)) + F.lane;
#pragma unroll
        for (int j = 0; j < 8; ++j) { const int c0 = 4 * F.lane + 256 * j; const f4v sh = *(const LAS f4v*)(SH + c0), sc = *(const LAS f4v*)(SC1 + c0);
            const unsigned w0 = pk2(v[j].x * rstd * sc.x + sh.x, v[j].y * rstd * sc.y + sh.y), w1 = pk2(v[j].z * rstd * sc.z + sh.z, v[j].w * rstd * sc.w + sh.w);
            o8[64 * j] = make_uint2(w0, w1); us[64 * j] = (u2v){w0, w1}; }
        if (it & 1) {
            const unsigned lane = F.lane, r = lane & 15u, q = lane >> 4; pg8::f32x4 acc = {0.f, 0.f, 0.f, 0.f};
            const LAS unsigned char* ap = USb + (r & 1u) * (2 * D) + 16u * q; const LAS unsigned char* bp = WGb + r * WGS + 16u * q;
#pragma unroll 8
            for (int ks = 0; ks < D / 32; ++ks) acc = __builtin_amdgcn_mfma_f32_16x16x32_bf16(*(const LAS pg8::bf16x8*)(ap + 64 * ks), *(const LAS pg8::bf16x8*)(bp + 64 * ks), acc, 0, 0, 0);
            if (lane < NG) { const float bi = p.b_in[INM + lane]; const float g0 = acc[0] + bi, g1 = acc[1] + bi; const bool fg = lane & 4;
                p.GATES()[(size_t)(row - NWAVES) * NG + lane] = fg ? logsigmoidf_(g0) : g0; p.GATES()[(size_t)row * NG + lane] = fg ? logsigmoidf_(g1) : g1; } }
    }
}
__device__ __forceinline__ void phase3a(const Prm& p, const Frame& F, int b0, int nb) {
    static_assert(S % 32 == 0 && CW == 1024, "segments of 32 rows inside one batch, 128 channel groups");
    const int nwv = nb * NWAVES, wv = (F.bid - b0) * NWAVES + F.wave;
    for (int u = wv; u < (T / 32) * 2; u += nwv) {
        const int row0 = (u >> 1) * 32, ch = ((u & 1) * 64 + F.lane) * 8, s0 = row0 % S;
        float cw[3][8], cb[8];
#pragma unroll
        for (int k = 0; k < 3; ++k) { const f4v w0 = *(const f4v*)(p.conv_w + k * CW + ch), w1 = *(const f4v*)(p.conv_w + k * CW + ch + 4);
            cw[k][0] = w0[0]; cw[k][1] = w0[1]; cw[k][2] = w0[2]; cw[k][3] = w0[3]; cw[k][4] = w1[0]; cw[k][5] = w1[1]; cw[k][6] = w1[2]; cw[k][7] = w1[3]; }
        { const f4v c0 = *(const f4v*)(p.conv_b + ch), c1 = *(const f4v*)(p.conv_b + ch + 4); cb[0] = c0[0]; cb[1] = c0[1]; cb[2] = c0[2]; cb[3] = c0[3]; cb[4] = c1[0]; cb[5] = c1[1]; cb[6] = c1[2]; cb[7] = c1[3]; }
        const bf16_t* pj = p.PJ() + ch;
#define C3_Z(z_, gc_, hi_, m_) do { z_[0] = (m_) * (bflo(gc_.x) * bflo(hi_.x)); z_[1] = (m_) * (bfhi(gc_.x) * bfhi(hi_.x)); z_[2] = (m_) * (bflo(gc_.y) * bflo(hi_.y)); z_[3] = (m_) * (bfhi(gc_.y) * bfhi(hi_.y)); \
            z_[4] = (m_) * (bflo(gc_.z) * bflo(hi_.z)); z_[5] = (m_) * (bfhi(gc_.z) * bfhi(hi_.z)); z_[6] = (m_) * (bflo(gc_.w) * bflo(hi_.w)); z_[7] = (m_) * (bfhi(gc_.w) * bfhi(hi_.w)); } while (0)
        float zp[8], zc[8];
        { const int rp = s0 > 0 ? row0 - 1 : row0; const uint4 g0 = *(const uint4*)(pj + (size_t)rp * INM + O_GC), h0 = *(const uint4*)(pj + (size_t)rp * INM + O_HIN);
          const uint4 g1 = *(const uint4*)(pj + (size_t)row0 * INM + O_GC), h1 = *(const uint4*)(pj + (size_t)row0 * INM + O_HIN);
          const float m0 = s0 > 0 ? 1.f : 0.f; C3_Z(zp, g0, h0, m0); C3_Z(zc, g1, h1, 1.f); }
#pragma unroll 1
        for (int rb = 0; rb < 32; rb += 8) {
            uint4 gc[8], hi[8], gb[8];
#pragma unroll
            for (int j = 0; j < 8; ++j) { const int rn = row0 + rb + j + 1, rl = (s0 + rb + j + 1 < S) ? rn : rn - 1;
                gc[j] = *(const uint4*)(pj + (size_t)rl * INM + O_GC); hi[j] = *(const uint4*)(pj + (size_t)rl * INM + O_HIN); gb[j] = *(const uint4*)(pj + (size_t)(row0 + rb + j) * INM + O_GB); }
#pragma unroll
            for (int j = 0; j < 8; ++j) { float zn[8]; const float mn = (s0 + rb + j + 1 < S) ? 1.f : 0.f; C3_Z(zn, gc[j], hi[j], mn);
                float acc[8];
#pragma unroll
                for (int e = 0; e < 8; ++e) acc[e] = cb[e] + cw[0][e] * zp[e] + cw[1][e] * zc[e] + cw[2][e] * zn[e];
                uint4 o; o.x = pk2(bflo(gb[j].x) * acc[0], bfhi(gb[j].x) * acc[1]); o.y = pk2(bflo(gb[j].y) * acc[2], bfhi(gb[j].y) * acc[3]); o.z = pk2(bflo(gb[j].z) * acc[4], bfhi(gb[j].z) * acc[5]); o.w = pk2(bflo(gb[j].w) * acc[6], bfhi(gb[j].w) * acc[7]);
                *(uint4*)(p.Y() + (size_t)(row0 + rb + j) * D + ch) = o;
#pragma unroll
                for (int e = 0; e < 8; ++e) { zp[e] = zc[e]; zc[e] = zn[e]; } }
        }
#undef C3_Z
    }
}
namespace ml {
typedef short bf16x8 __attribute__((ext_vector_type(8)));
typedef short s16x4 __attribute__((ext_vector_type(4)));
typedef float f32x4 __attribute__((ext_vector_type(4)));
typedef float f32x2_t __attribute__((ext_vector_type(2)));
typedef __bf16 bf16x2_t __attribute__((ext_vector_type(2)));
typedef unsigned u32x4 __attribute__((ext_vector_type(4)));
typedef unsigned u32x2 __attribute__((ext_vector_type(2)));
constexpr unsigned IMG = 16384u, BUF = 3u * IMG, PT_OFF = 2u * BUF, PT_BYTES = 8192u, N_OFF = PT_OFF + 2u * PT_BYTES;
constexpr unsigned SCT_OFF = 149504u, SCT_BYTES = 1280u;
constexpr unsigned HT_OFF = 133120u;
static_assert(N_OFF + 1024u <= 131072u && HT_OFF + 16384u <= SCT_OFF && SCT_OFF + 3u * SCT_BYTES <= 163840u, "mLSTM LDS map");
__device__ __forceinline__ unsigned cvtpk(float lo, float hi) { f32x2_t v = {lo, hi}; bf16x2_t b = __builtin_convertvector(v, bf16x2_t); return __builtin_bit_cast(unsigned, b); }
__device__ __forceinline__ unsigned off_a(unsigned row, unsigned ch) { return 2048u * (row >> 3) + 512u * (ch >> 2) + 64u * (row & 7u) + 16u * ((ch & 3u) ^ ((row >> 2) & 3u)); }
__device__ __forceinline__ unsigned off_p(unsigned row, unsigned ch) { return 128u * row + 16u * (ch ^ (row & 7u)); }
typedef short v4i16_t __attribute__((ext_vector_type(4)));
__device__ __forceinline__ s16x4 trr(LAS unsigned char* p) { return __builtin_bit_cast(s16x4, __builtin_amdgcn_ds_read_tr16_b64_v4i16((LAS v4i16_t*)p)); }
__device__ __forceinline__ bf16x8 cat8(s16x4 a, s16x4 b) { return (bf16x8){a[0], a[1], a[2], a[3], b[0], b[1], b[2], b[3]}; }
struct CS { float decay, m_next; };
__device__ __forceinline__ CS chunk_scalars(float ig, float fg, float m, LAS float* tab, bool writer, unsigned lane) {
    const float lf = fg;
    const float bc = wave_scan_add(lf), gg = ig - bc, cm = wave_scan_max(gg);
    const float G = fmaxf(m, cm), G63 = lane_bcast(G, 63), b63 = lane_bcast(bc, 63), qs = 0.08838834764831845f;
    if (writer) { tab[lane] = __expf(fminf(G63 - G, 80.f)) * qs; tab[64 + lane] = __expf(m - G) * qs; tab[128 + lane] = __expf(-(bc + G)); tab[192 + lane] = __expf(gg - G63); }
    CS r; r.decay = __expf(m - G63); r.m_next = b63 + G63; if (writer && lane == 0u) tab[256] = r.decay;
    return r;
}
__device__ __forceinline__ void unit(const Prm& p, const Frame& F, int u) {
    static_assert(QK == 128 && MV == 256 && CHUNK == 64 && S % 64 == 0, "mLSTM unit is specialised");
    const int vhalf = u & 1, h = (u >> 1) & 3, b = (u >> 3) & 7, dir = u >> 6;
    const unsigned lane = F.lane, tid = F.tid; const int wave = F.wave; const unsigned q = lane >> 4, r = lane & 15u;
    LAS unsigned char* L = F.lds;
    const unsigned rx = (r >> 2) & 3u, rlo = 2048u * (r >> 3) + 64u * (r & 7u);
    const unsigned RA = rlo + 16u * (q ^ rx), PB1 = rlo + 16u * ((q >> 1) ^ rx) + 8u * (q & 1u), PB2 = rlo + 16u * ((2u + (q >> 1)) ^ rx) + 8u * (q & 1u);
    const unsigned pp = lane & 3u, tlo = 2048u * q + 64u * rx + 8u * (pp & 1u);
    const unsigned tb00 = tlo + 16u * ((pp >> 1) ^ ((2u * q) & 3u)), tb01 = tlo + 256u + 16u * ((pp >> 1) ^ ((2u * q + 1u) & 3u));
    const unsigned tb10 = tlo + 16u * ((2u + (pp >> 1)) ^ ((2u * q) & 3u)), tb11 = tlo + 256u + 16u * ((2u + (pp >> 1)) ^ ((2u * q + 1u) & 3u));
    const unsigned PP0 = 128u * r + 16u * (q ^ (r & 7u)), PP1 = 128u * r + 16u * ((4u + q) ^ (r & 7u));
#define ML_TRA(c, ks, t) ((((c) & 1) ? ((t) ? tb11 : tb10) : ((t) ? tb01 : tb00)) + 8192u * (ks) + 512u * ((unsigned)(c) >> 1))
    __syncthreads();
    for (unsigned i = tid; i < (2u * PT_BYTES + 1024u) / 16u; i += NTHR) *(LAS u32x4*)(L + PT_OFF + 16u * i) = (u32x4){0u, 0u, 0u, 0u};
    f32x4 C[8];
#pragma unroll
    for (int i = 0; i < 8; ++i) C[i] = (f32x4){0.f, 0.f, 0.f, 0.f};
    float m = 0.f;
    const bf16_t* pj = p.PJ(); bf16_t* H = dir ? p.HB16() : p.HF16();
    const int colq = O_Q + h * QK, colk = O_K + h * QK, colv = O_V + h * MV + vhalf * 128;
    const unsigned srow0 = tid >> 4, sch = tid & 15u;
    u32x4 rq[2], rk[2], rv[2];
    const float* gbase = p.GATES() + dir * 8 + h;
#define ML_GATES(c, ig_, fg_) do { const float* g_ = gbase + (size_t)ml_tok(dir, b, (c) * 64 + (int)lane) * NG; ig_ = g_[0]; fg_ = g_[4]; } while (0)
    float ig0, fg0, ign = 0.f, fgn = 0.f; ML_GATES(0, ig0, fg0); if (S / 64 > 1) ML_GATES(1, ign, fgn);
#define ML_TAB(c) ((LAS float*)(L + SCT_OFF + (unsigned)((c) % 3) * SCT_BYTES))
    CS cs = {0.f, 0.f}, csn = {0.f, 0.f}; if (wave == 0) { cs = chunk_scalars(ig0, fg0, m, ML_TAB(0), true, lane); csn = cs; }
    const long sMW = dir ? -(long)MW : (long)MW;
#define ML_LOAD(c) do { _Pragma("unroll") for (int i_ = 0; i_ < 2; ++i_) { const bf16_t* rp = pj + (size_t)ml_tok(dir, b, (c) * 64 + srow0 + 32 * i_) * INM + 8 * sch; \
        rq[i_] = *(const u32x4*)(rp + colq); rk[i_] = *(const u32x4*)(rp + colk); rv[i_] = *(const u32x4*)(rp + colv); } } while (0)
#define ML_STORE(buf, S_) do { _Pragma("unroll") for (int i_ = 0; i_ < 2; ++i_) { const unsigned row = srow0 + 32u * i_, o = (buf) * BUF + off_a(row, sch); const float w = (S_)[192 + row]; \
        *(LAS u32x4*)(L + o) = rq[i_]; *(LAS u32x4*)(L + IMG + o) = rk[i_]; u32x4 v = rv[i_]; \
        v.x = cvtpk(bflo(v.x) * w, bfhi(v.x) * w); v.y = cvtpk(bflo(v.y) * w, bfhi(v.y) * w); v.z = cvtpk(bflo(v.z) * w, bfhi(v.z) * w); v.w = cvtpk(bflo(v.w) * w, bfhi(v.w) * w); \
        *(LAS u32x4*)(L + 2u * IMG + o) = v; } } while (0)
    __syncthreads();
    ML_LOAD(0); ML_STORE(0u, ML_TAB(0));
    constexpr int NC = S / 64;
    for (int c = 0; c < NC; ++c) {
        const unsigned cur = (unsigned)(c & 1);
        LAS unsigned char* Qi = L + cur * BUF; LAS unsigned char* Ki = Qi + IMG; LAS unsigned char* Vi = Qi + 2u * IMG; LAS unsigned char* Pt = L + PT_OFF + cur * PT_BYTES;
        float ig2 = 0.f, fg2 = 0.f;
        if (c + 1 < NC) { ML_LOAD(c + 1); if (wave == 0) { csn = chunk_scalars(ign, fgn, cs.m_next, ML_TAB(c + 1), true, lane); if (c + 2 < NC) ML_GATES(c + 2, ig2, fg2); } }
        __syncthreads();
#define ML_FLUSH(cprev) do { _Pragma("unroll") for (int i_ = 0; i_ < 2; ++i_) { const unsigned n_ = tid + 512u * i_, row_ = n_ >> 4, ch_ = n_ & 15u;     \
            const u32x4 v_ = *(const LAS u32x4*)(L + HT_OFF + 256u * row_ + 16u * (ch_ ^ (row_ & 15u))); \
            *(u32x4*)(H + (size_t)ml_tok(dir, b, (cprev) * 64 + (int)row_) * MW + h * MV + vhalf * 128 + 8 * (int)ch_) = v_; } } while (0)
        const LAS float* sct = ML_TAB(c); const float dcy = sct[256];
        if (c > 0) ML_FLUSH(c - 1);
#ifndef ML_REP_3B
#define ML_REP_3B 1
#define ML_REP_S 1
#define ML_REP_ST 1
#define ML_REP_3A 1
#define ML_REP_DEN 1
#endif
        f32x4 acc2[4];
#pragma unroll
        for (int tt = 0; tt < 4; ++tt) acc2[tt] = (f32x4){0.f, 0.f, 0.f, 0.f};
#pragma unroll
        for (int ks = 0; ks < 4; ++ks) {
            bf16x8 qa[4];
#pragma unroll
            for (int tt = 0; tt < 4; ++tt) {
                const u32x2 lo = *(const LAS u32x2*)(Qi + PB1 + 4096u * tt + 512u * ks), hi = *(const LAS u32x2*)(Qi + PB2 + 4096u * tt + 512u * ks);
                const u32x4 aw = {lo.x, lo.y, hi.x, hi.y}; qa[tt] = __builtin_bit_cast(bf16x8, aw); }
            const f32x4 c0 = C[2 * ks], c1 = C[2 * ks + 1];
            const u32x4 bw = {cvtpk(c0[0], c0[1]), cvtpk(c0[2], c0[3]), cvtpk(c1[0], c1[1]), cvtpk(c1[2], c1[3])}; const bf16x8 bfr = __builtin_bit_cast(bf16x8, bw);
#pragma unroll
            for (int tt = 0; tt < 4; ++tt) acc2[tt] = __builtin_amdgcn_mfma_f32_16x16x32_bf16(qa[tt], bfr, acc2[tt], 0, 0, 0);
        }
        bf16x8 vB[2];
#pragma unroll
        for (int ks = 0; ks < 2; ++ks) vB[ks] = cat8(trr(Vi + ML_TRA(wave, ks, 0)), trr(Vi + ML_TRA(wave, ks, 1)));
#pragma unroll
        for (int dt = 0; dt < 8; ++dt) C[dt] = C[dt] * dcy;
#pragma unroll
        for (int ks = 0; ks < 2; ++ks)
#pragma unroll
            for (int dh = 0; dh < 2; ++dh) { bf16x8 kA[4];
#pragma unroll
                for (int d4 = 0; d4 < 4; ++d4) kA[d4] = cat8(trr(Ki + ML_TRA(4 * dh + d4, ks, 0)), trr(Ki + ML_TRA(4 * dh + d4, ks, 1)));
#pragma unroll
                for (int d4 = 0; d4 < 4; ++d4) C[4 * dh + d4] = __builtin_amdgcn_mfma_f32_16x16x32_bf16(kA[d4], vB[ks], C[4 * dh + d4], 0, 0, 0); }
#pragma unroll
        for (int rep = 0; rep < 2; ++rep) { const int idx = wave + (rep ? 2 : 0);
            if (rep == 0 || wave >= 6) { const int tt = idx >= 6 ? 3 : (idx >= 3 ? 2 : (idx >= 1 ? 1 : 0)), st = idx - tt * (tt + 1) / 2;
                f32x4 sa = (f32x4){0.f, 0.f, 0.f, 0.f};
#pragma unroll
                for (int kh = 0; kh < 2; ++kh) { bf16x8 af[2], bfk[2];
#pragma unroll
                    for (int k2 = 0; k2 < 2; ++k2) { af[k2] = *(const LAS bf16x8*)(Qi + RA + 4096u * tt + 512u * (2 * kh + k2)); bfk[k2] = *(const LAS bf16x8*)(Ki + RA + 4096u * st + 512u * (2 * kh + k2)); }
#pragma unroll
                    for (int k2 = 0; k2 < 2; ++k2) sa = __builtin_amdgcn_mfma_f32_16x16x32_bf16(af[k2], bfk[k2], sa, 0, 0, 0); }
                const unsigned scol = 16u * st + r;
#pragma unroll
                for (int i = 0; i < 4; ++i) { const unsigned trow = 16u * tt + 4u * q + i; const float v = scol <= trow ? sa[i] : 0.f;
                    *(LAS bf16_t*)(Pt + off_p(trow, scol >> 3) + 2u * (scol & 7u)) = (bf16_t)cvtpk(v, 0.f); } } }
        if (c + 1 < NC) ML_STORE(cur ^ 1u, ML_TAB(c + 1));
        __syncthreads();
        { bf16x8 pf[6];
#pragma unroll
          for (int tt = 0; tt < 4; ++tt) { pf[tt] = *(const LAS bf16x8*)(Pt + PP0 + 2048u * tt); if (tt >= 2) pf[2 + tt] = *(const LAS bf16x8*)(Pt + PP1 + 2048u * tt); }
#pragma unroll
          for (int tt = 0; tt < 4; ++tt) { const f32x4 av4 = *(const LAS f32x4*)(sct + 16 * tt + 4 * q), bv4 = *(const LAS f32x4*)(sct + 64 + 16 * tt + 4 * q); f32x4 a1 = __builtin_amdgcn_mfma_f32_16x16x32_bf16(pf[tt], vB[0], (f32x4){0.f, 0.f, 0.f, 0.f}, 0, 0, 0);
            if (tt >= 2) a1 = __builtin_amdgcn_mfma_f32_16x16x32_bf16(pf[2 + tt], vB[1], a1, 0, 0, 0);
#pragma unroll
            for (int i = 0; i < 4; ++i) { const unsigned t = 16u * tt + 4u * q + i, col = 16u * (unsigned)wave + r;
                *(LAS bf16_t*)(L + HT_OFF + 256u * t + 16u * ((col >> 3) ^ (t & 15u)) + 2u * (col & 7u)) = (bf16_t)cvtpk(av4[i] * a1[i] + bv4[i] * acc2[tt][i], 0.f); } } }
        asm volatile("" : "+v"(ig2), "+v"(fg2));
        if (vhalf == 0) {
            const LAS float* n_old = (const LAS float*)(L + N_OFF + cur * 512u); LAS float* n_new = (LAS float*)(L + N_OFF + (cur ^ 1u) * 512u);
            bf16x8 wB[2];
#pragma unroll
            for (int ks = 0; ks < 2; ++ks) { const f32x4 w0 = *(const LAS f32x4*)(sct + 192 + 32 * ks + 8 * q), w1 = *(const LAS f32x4*)(sct + 192 + 32 * ks + 8 * q + 4);
                u32x4 w = {cvtpk(w0[0], w0[1]), cvtpk(w0[2], w0[3]), cvtpk(w1[0], w1[1]), cvtpk(w1[2], w1[3])};
                if (r != 0u) w = (u32x4){0u, 0u, 0u, 0u}; wB[ks] = __builtin_bit_cast(bf16x8, w); }
            const size_t dbase = ((size_t)dir * T) * MH + h;
            if (wave < 4) { const int tt = wave; f32x4 d2 = (f32x4){0.f, 0.f, 0.f, 0.f};
#pragma unroll
                for (int ks = 0; ks < 4; ++ks) { const f32x4 n0 = *(const LAS f32x4*)(n_old + 32 * ks + 4 * q), n1 = *(const LAS f32x4*)(n_old + 32 * ks + 16 + 4 * q);
                    u32x4 bw = {cvtpk(n0[0], n0[1]), cvtpk(n0[2], n0[3]), cvtpk(n1[0], n1[1]), cvtpk(n1[2], n1[3])}; if (r != 0u) bw = (u32x4){0u, 0u, 0u, 0u};
                    const u32x2 lo = *(const LAS u32x2*)(Qi + PB1 + 4096u * tt + 512u * ks), hi = *(const LAS u32x2*)(Qi + PB2 + 4096u * tt + 512u * ks);
                    const u32x4 aw = {lo.x, lo.y, hi.x, hi.y};
                    d2 = __builtin_amdgcn_mfma_f32_16x16x32_bf16(__builtin_bit_cast(bf16x8, aw), __builtin_bit_cast(bf16x8, bw), d2, 0, 0, 0); }
#pragma unroll
                for (int i = 0; i < 4; ++i) { const int t = 16 * tt + 4 * (int)q + i; const float bv = sct[64 + t], fl = sct[128 + t];
                    if (r == 0u) { const size_t di = dbase + (size_t)ml_tok(dir, b, c * 64 + t) * MH; p.DEN()[(size_t)2 * T * MH + di] = bv * d2[i]; p.FLR()[di] = fl; } }
            } else { const int tt = wave - 4; f32x4 d1 = (f32x4){0.f, 0.f, 0.f, 0.f};
#pragma unroll
                for (int ks = 0; ks < 2; ++ks) if (ks == 0 || tt >= 2) { const bf16x8 pf = *(const LAS bf16x8*)(Pt + (ks ? PP1 : PP0) + 2048u * tt);
                    d1 = __builtin_amdgcn_mfma_f32_16x16x32_bf16(pf, wB[ks], d1, 0, 0, 0); }
#pragma unroll
                for (int i = 0; i < 4; ++i) { const int t = 16 * tt + 4 * (int)q + i; const float av = sct[t];
                    if (r == 0u) p.DEN()[dbase + (size_t)ml_tok(dir, b, c * 64 + t) * MH] = av * d1[i]; } }
            { const int dt = wave; f32x4 nn = *(const LAS f32x4*)(n_old + 16 * dt + 4 * q) * dcy; if (r != 0u) nn = (f32x4){0.f, 0.f, 0.f, 0.f};
#pragma unroll
                for (int ks = 0; ks < 2; ++ks) { const bf16x8 kA = cat8(trr(Ki + ML_TRA(dt, ks, 0)), trr(Ki + ML_TRA(dt, ks, 1)));
                    nn = __builtin_amdgcn_mfma_f32_16x16x32_bf16(kA, wB[ks], nn, 0, 0, 0); }
                if (r == 0u) *(LAS f32x4*)(n_new + 16 * dt + 4 * q) = nn; }
        }
        m = cs.m_next; cs = csn; ign = ig2; fgn = fg2;
    }
    __syncthreads(); ML_FLUSH(NC - 1);
#undef ML_FLUSH
#undef ML_TRA
#undef ML_TABLE
#undef ML_LOAD
#undef ML_GATES
#undef ML_STORE
}
}
__device__ __forceinline__ void phase4(const Prm& p, const Frame& F) {
    static_assert(MV == 256 && MH == 4, "head j = float4 slot j of the lane");
    const int gw = F.bid * NWAVES + F.wave, NGW = F.G * NWAVES;
    struct RowIn { uint2 a[MH], b[MH], o[MH]; f4v d1f, d2f, flf, d1b, d2b, flb; };
#define P4_LOAD(R_, row_) do { const size_t r_ = (size_t)(row_); const uint2* hf_ = (const uint2*)(p.HF16() + r_ * MW) + F.lane; const uint2* hb_ = (const uint2*)(p.HB16() + r_ * MW) + F.lane; const uint2* og_ = (const uint2*)(p.PJ() + r_ * INM + O_O) + F.lane; \
        _Pragma("unroll") for (int j_ = 0; j_ < MH; ++j_) { R_.a[j_] = hf_[64 * j_]; R_.b[j_] = hb_[64 * j_]; R_.o[j_] = og_[64 * j_]; } \
        const float* d1_ = p.DEN(); const float* d2_ = p.DEN() + (size_t)2 * T * MH; const float* fl_ = p.FLR(); \
        R_.d1f = *(const f4v*)(d1_ + r_ * MH); R_.d2f = *(const f4v*)(d2_ + r_ * MH); R_.flf = *(const f4v*)(fl_ + r_ * MH); \
        R_.d1b = *(const f4v*)(d1_ + ((size_t)T + r_) * MH); R_.d2b = *(const f4v*)(d2_ + ((size_t)T + r_) * MH); R_.flb = *(const f4v*)(fl_ + ((size_t)T + r_) * MH); } while (0)
    f4v nw[MH];
#pragma unroll
    for (int j = 0; j < MH; ++j) nw[j] = *((const f4v*)(p.mnorm_w + j * MV) + F.lane);
    RowIn cur, nxt;
    if (gw < T) P4_LOAD(cur, gw);
    for (int row = gw; row < T; row += NGW) {
        if (row + NGW < T) P4_LOAD(nxt, row + NGW);
        uint2* yo = (uint2*)(p.Y() + (size_t)row * D + CW) + F.lane;
#pragma unroll
        for (int j = 0; j < MH; ++j) {
            const float i_f = 1.f / fmaxf(fabsf(cur.d1f[j] + cur.d2f[j]), cur.flf[j]), i_b = 1.f / fmaxf(fabsf(cur.d1b[j] + cur.d2b[j]), cur.flb[j]);
            const uint2 a = cur.a[j], b = cur.b[j]; float4 h = make_float4(bflo(a.x) * i_f + bflo(b.x) * i_b, bfhi(a.x) * i_f + bfhi(b.x) * i_b, bflo(a.y) * i_f + bflo(b.y) * i_b, bfhi(a.y) * i_f + bfhi(b.y) * i_b);
            const float mean = wave_sum((h.x + h.y) + (h.z + h.w)) * (1.f / MV);
            h.x -= mean; h.y -= mean; h.z -= mean; h.w -= mean;
            const float rstd = 1.f / sqrtf(wave_sum((h.x * h.x + h.y * h.y) + (h.z * h.z + h.w * h.w)) * (1.f / MV) + LN_EPS);
            const uint2 o = cur.o[j];
            yo[64 * j] = make_uint2(pk2(h.x * rstd * nw[j][0] * sigmoidf_(bflo(o.x)), h.y * rstd * nw[j][1] * sigmoidf_(bfhi(o.x))), pk2(h.z * rstd * nw[j][2] * sigmoidf_(bflo(o.y)), h.w * rstd * nw[j][3] * sigmoidf_(bfhi(o.y)))); }
        cur = nxt;
    }
#undef P4_LOAD
}
struct EpiZ {
    static constexpr bool PERM = true, AFTER_DRAIN = false;
    const float* x; const float* mod; bf16_t* out;
    __device__ __forceinline__ void operator()(const pg8::f32x4 (&acc)[2][2][4][2], const pg8::Unit& u, int wr, int wc, int fr, int fq) const {
        const int col0 = u.pn * 256 + wc * 32 + 8 * fq, row0 = u.pm * 256 + wr * 64 + fr;
        const float* g1 = mod + (size_t)((u.pm * 256) / S) * D6 + 2 * D + col0;
        const pg8::f32x4 g00 = *(const pg8::f32x4*)(g1), g01 = *(const pg8::f32x4*)(g1 + 4), g10 = *(const pg8::f32x4*)(g1 + 128), g11 = *(const pg8::f32x4*)(g1 + 132);
#define EZ_ROW(s_) (row0 + 128 * ((s_) >> 2) + 16 * ((s_) & 3))
#define EZ_LOAD(X_, s_) do { const float* xp_ = x + (size_t)EZ_ROW(s_) * D + col0; X_[0] = *(const pg8::f32x4*)(xp_); X_[1] = *(const pg8::f32x4*)(xp_ + 4); X_[2] = *(const pg8::f32x4*)(xp_ + 128); X_[3] = *(const pg8::f32x4*)(xp_ + 132); } while (0)
#define EZ_STEP(X_, s_) do { const int ai_ = (s_) >> 2, m_ = (s_) & 3; bf16_t* op_ = out + (size_t)EZ_ROW(s_) * D + col0; \
            const pg8::f32x4 z0 = X_[0] * ALPHA + g00 * acc[ai_][0][m_][0], z1 = X_[1] * ALPHA + g01 * acc[ai_][0][m_][1], z2 = X_[2] * ALPHA + g10 * acc[ai_][1][m_][0], z3 = X_[3] * ALPHA + g11 * acc[ai_][1][m_][1]; \
            const u32x4_t w0 = {pk2(z0[0], z0[1]), pk2(z0[2], z0[3]), pk2(z1[0], z1[1]), pk2(z1[2], z1[3])}, w1 = {pk2(z2[0], z2[1]), pk2(z2[2], z2[3]), pk2(z3[0], z3[1]), pk2(z3[2], z3[3])}; \
            *(u32x4_t*)(op_) = w0; *(u32x4_t*)(op_ + 128) = w1; } while (0)
        pg8::f32x4 XA[4], XB[4];
        EZ_LOAD(XA, 0);
        EZ_LOAD(XB, 1); EZ_STEP(XA, 0); EZ_LOAD(XA, 2); EZ_STEP(XB, 1); EZ_LOAD(XB, 3); EZ_STEP(XA, 2); EZ_LOAD(XA, 4); EZ_STEP(XB, 3);
        EZ_LOAD(XB, 5); EZ_STEP(XA, 4); EZ_LOAD(XA, 6); EZ_STEP(XB, 5); EZ_LOAD(XB, 7); EZ_STEP(XA, 6); EZ_STEP(XB, 7);
#undef EZ_STEP
#undef EZ_LOAD
#undef EZ_ROW
    }
};

struct EpiF32 {
    static constexpr bool PERM = true, AFTER_DRAIN = false;
    float* out; int ldc;
    __device__ __forceinline__ void operator()(const pg8::f32x4 (&acc)[2][2][4][2], const pg8::Unit& u, int wr, int wc, int fr, int fq) const {
        const int col0 = u.pn * 256 + wc * 32 + 8 * fq;
#pragma unroll
        for (int ai = 0; ai < 2; ++ai)
#pragma unroll
            for (int m = 0; m < 4; ++m) { float* rowp = out + (size_t)(u.pm * 256 + ai * 128 + wr * 64 + m * 16 + fr) * ldc + col0;
#pragma unroll
                for (int bj = 0; bj < 2; ++bj) { *(pg8::f32x4*)(rowp + bj * 128) = acc[ai][bj][m][0]; *(pg8::f32x4*)(rowp + bj * 128 + 4) = acc[ai][bj][m][1]; } }
    }
};
__device__ __forceinline__ unsigned skey(float f) { const unsigned u = f_as_u(f); return (u & 0x80000000u) ? ~u : (u | 0x80000000u); }
__device__ __forceinline__ float unskey(unsigned k) { return u_as_f((k & 0x80000000u) ? (k & 0x7fffffffu) : ~k); }
__device__ __forceinline__ void tk_cx(unsigned& a, unsigned& b) { const unsigned hi = a > b ? a : b, lo = a > b ? b : a; a = hi; b = lo; }
__device__ __forceinline__ void tk_sort16(unsigned (&v)[16]) {
#pragma unroll
    for (int k = 2; k <= 16; k <<= 1)
#pragma unroll
        for (int j = k >> 1; j >= 1; j >>= 1)
#pragma unroll
            for (int i = 0; i < 16; ++i) { const int l = i ^ j; if (l > i) { if ((i & k) == 0) tk_cx(v[i], v[l]); else tk_cx(v[l], v[i]); } }
}
__device__ __forceinline__ void tk_merge16(unsigned (&L)[16], const unsigned (&C)[16]) {
#pragma unroll
    for (int i = 0; i < 16; ++i) L[i] = L[i] > C[15 - i] ? L[i] : C[15 - i];
#pragma unroll
    for (int j = 8; j >= 1; j >>= 1)
#pragma unroll
        for (int i = 0; i < 16; ++i) { const int l = i ^ j; if (l > i) tk_cx(L[i], L[l]); }
}
__device__ __forceinline__ void tk_top16(const float* sc, unsigned (&L)[16]) {
#pragma unroll 1
    for (int ch = 0; ch < NK / 16; ++ch) { unsigned C[16];
#pragma unroll
        for (int q4 = 0; q4 < 4; ++q4) { const float4 v = ((const float4*)sc)[4 * ch + q4]; const unsigned b = 127u - 16u * ch - 4u * q4;
            C[4 * q4] = (skey(v.x) & ~0x7fu) | b; C[4 * q4 + 1] = (skey(v.y) & ~0x7fu) | (b - 1); C[4 * q4 + 2] = (skey(v.z) & ~0x7fu) | (b - 2); C[4 * q4 + 3] = (skey(v.w) & ~0x7fu) | (b - 3); }
        tk_sort16(C);
        if (ch == 0) {
#pragma unroll
            for (int i = 0; i < 16; ++i) L[i] = C[i]; }
        else tk_merge16(L, C); }
}
__device__ __forceinline__ void phase8(const Prm& p, const Frame& F) {
    static_assert(NK == 128 && TOPK == 16, "top-k phase is specialised");
    const long gt = (long)F.bid * NTHR + F.tid, GT = (long)F.G * NTHR;
    LAS unsigned* ix = (LAS unsigned*)F.lds + F.tid;
    static_assert(((long)T * PH) % 64 == 0 && 2 * NK * 4 == 1024, "a wave's 64 items are 64 KB of contiguous scores");
    LAS unsigned char* W8 = F.lds + 65536 + F.wave * 8192; const unsigned l8 = F.lane >> 3, c8 = F.lane & 7u;
    static_assert(NQ == PH * 256 && T % 256 == 0, "one head per 256-column score tile");
    pg8::StaticOrder So; So.init(T, NQ, F.G, F.bid);
    for (int k0 = 0; ; k0 += 2) {
        pg8::Unit u0, u; if (!So.next(k0, u0)) break;
        if (!So.next(k0 + (F.tid >> 8), u)) continue;
        const int tok = u.pm * 256 + (F.tid & 255); const long i = (long)tok * PH + u.pn;
        unsigned A[16], B[16];
        const unsigned char* gsrc = (const unsigned char*)p.SC() + ((size_t)(tok - (int)F.lane) + l8) * ((size_t)NSC * 4) + (size_t)u.pn * 1024 + 16u * (c8 ^ l8);
#define P8_DMA(st) do { _Pragma("unroll") for (int j_ = 0; j_ < 8; ++j_) __builtin_amdgcn_global_load_lds((const unsigned*)(gsrc + (size_t)j_ * 8 * ((size_t)NSC * 4) + 128 * (st)), (LAS unsigned*)(W8 + 1024 * j_), 16, 0, 0); } while (0)
        P8_DMA(0);
#pragma unroll
        for (int st = 0; st < 8; ++st) {
            asm volatile("s_waitcnt vmcnt(0)" ::: "memory");
            f4v v[8];
#pragma unroll
            for (int c = 0; c < 8; ++c) v[c] = *(const LAS f4v*)(W8 + 128u * F.lane + 16u * ((unsigned)c ^ (F.lane & 7u)));
            asm volatile("s_waitcnt lgkmcnt(0)" ::: "memory");
            if (st < 7) P8_DMA(st + 1);
#pragma unroll
            for (int hc = 0; hc < 2; ++hc) { const int ch = 2 * (st & 3) + hc; unsigned C[16];
#pragma unroll
                for (int q4 = 0; q4 < 4; ++q4) { const f4v x = v[4 * hc + q4]; const unsigned b = 127u - 16u * ch - 4u * q4;
                    C[4 * q4] = (skey(x[0]) & ~0x7fu) | b; C[4 * q4 + 1] = (skey(x[1]) & ~0x7fu) | (b - 1); C[4 * q4 + 2] = (skey(x[2]) & ~0x7fu) | (b - 2); C[4 * q4 + 3] = (skey(x[3]) & ~0x7fu) | (b - 3); }
                tk_sort16(C);
                if (st < 4) { if (ch == 0) {
#pragma unroll
                        for (int z = 0; z < 16; ++z) A[z] = C[z]; } else tk_merge16(A, C); }
                else { if (ch == 0) {
#pragma unroll
                        for (int z = 0; z < 16; ++z) B[z] = C[z]; } else tk_merge16(B, C); } }
        }
#undef P8_DMA
        float sa[16], sb[16];
#pragma unroll
        for (int k = 0; k < 16; ++k) { sa[k] = unskey(A[k] & ~0x7fu); sb[k] = unskey(B[k] & ~0x7fu); ix[NTHR * k] = 127u - (A[k] & 0x7fu); ix[NTHR * (16 + k)] = 127u - (B[k] & 0x7fu); }
        unsigned L[16], C[16]; int n = 0;
#pragma unroll
        for (int a = 0; a < 16; ++a)
#pragma unroll
            for (int b = 0; b < 16; ++b) if ((a + 1) * (b + 1) <= 16) { const unsigned key = (skey(sa[a] + sb[b]) & ~0xffu) | (unsigned)(255 - (16 * a + b));
                C[n & 15] = key; ++n;
                if ((n & 15) == 0 || n == 50) { if (n == 50) {
#pragma unroll
                        for (int z = 2; z < 16; ++z) C[z] = 0u; }
                    tk_sort16(C);
                    if (n == 16) {
#pragma unroll
                        for (int z = 0; z < 16; ++z) L[z] = C[z]; }
                    else tk_merge16(L, C); } }
        float V[16]; float sum = 0.f; const float vmax = unskey(L[0] & ~0xffu);
#pragma unroll
        for (int r = 0; r < 16; ++r) { V[r] = __expf(unskey(L[r] & ~0xffu) - vmax); sum += V[r]; }
        const float inv = 1.f / sum; int E[16];
#pragma unroll
        for (int r = 0; r < 16; ++r) { const unsigned fl = 255u - (L[r] & 0xffu); E[r] = (int)(ix[NTHR * (fl >> 4)] * NK + ix[NTHR * (16 + (fl & 15u))]); }
#pragma unroll
        for (int r = 0; r < 16; r += 4) { *(int4*)(p.EIDX() + (size_t)i * TOPK + r) = make_int4(E[r], E[r + 1], E[r + 2], E[r + 3]);
            *(float4*)(p.EW() + (size_t)i * TOPK + r) = make_float4(V[r] * inv, V[r + 1] * inv, V[r + 2] * inv, V[r + 3] * inv); }
    }
}
__device__ __forceinline__ float f8c(float u) { return fminf(fmaxf(u * 8.f, -448.f), 448.f); }
__device__ __forceinline__ void phase6(const Prm& p, const Frame& F) {
    LAS float* PW = (LAS float*)F.lds; LAS float* PB = PW + D; LAS float* PSH = PW + 2 * D; LAS float* PSC = PW + 3 * D;
    const int rows_per = T / F.G, r_begin = F.bid * rows_per, r_end = r_begin + rows_per;
    int cur_b = -1;
    { const f4v w4 = *((const f4v*)p.ln1_w + F.tid), b4 = *((const f4v*)p.ln1_b + F.tid); *(LAS f4v*)(PW + 4 * F.tid) = w4; *(LAS f4v*)(PB + 4 * F.tid) = b4; }
    float4 v[8]; uint2 zb[8], zn[8];
    { const uint2* z0 = (const uint2*)(p.X1B() + (size_t)(r_begin + F.wave) * D) + F.lane;
#pragma unroll
      for (int j = 0; j < 8; ++j) zb[j] = z0[64 * j]; }
    for (int r0 = r_begin; r0 < r_end; r0 += NWAVES) {
        const int row = r0 + F.wave, b = r0 / S;
        if (b != cur_b) { __syncthreads(); const float* mod = p.MOD() + (size_t)b * D6;
            { const f4v s4 = *((const f4v*)(mod + 3 * D) + F.tid), c4 = *((const f4v*)(mod + 4 * D) + F.tid); *(LAS f4v*)(PSH + 4 * F.tid) = s4; *(LAS f4v*)(PSC + 4 * F.tid) = c4 + 1.f; }
            cur_b = b; __syncthreads(); }
        float s = 0.f;
        if (r0 + NWAVES < r_end) { const uint2* zp = (const uint2*)(p.X1B() + (size_t)(row + NWAVES) * D) + F.lane;
#pragma unroll
            for (int j = 0; j < 8; ++j) zn[j] = zp[64 * j]; }
#pragma unroll
        for (int j = 0; j < 8; ++j) { v[j] = make_float4(bflo(zb[j].x), bfhi(zb[j].x), bflo(zb[j].y), bfhi(zb[j].y)); s += (v[j].x + v[j].y) + (v[j].z + v[j].w); }
        float mean = wave_sum(s) * (1.f / D), s2 = 0.f;
#pragma unroll
        for (int j = 0; j < 8; ++j) { v[j].x -= mean; v[j].y -= mean; v[j].z -= mean; v[j].w -= mean; s2 += (v[j].x * v[j].x + v[j].y * v[j].y) + (v[j].z * v[j].z + v[j].w * v[j].w); }
        float rstd = 1.f / sqrtf(wave_sum(s2) * (1.f / D) + LN_EPS); s = 0.f;
#pragma unroll
        for (int j = 0; j < 8; ++j) { const f4v w = *(const LAS f4v*)(PW + 4 * F.lane + 256 * j), bb = *(const LAS f4v*)(PB + 4 * F.lane + 256 * j);
            v[j].x = v[j].x * rstd * w[0] + bb[0]; v[j].y = v[j].y * rstd * w[1] + bb[1]; v[j].z = v[j].z * rstd * w[2] + bb[2]; v[j].w = v[j].w * rstd * w[3] + bb[3];
            s += (v[j].x + v[j].y) + (v[j].z + v[j].w); }
        mean = wave_sum(s) * (1.f / D); s2 = 0.f;
#pragma unroll
        for (int j = 0; j < 8; ++j) { v[j].x -= mean; v[j].y -= mean; v[j].z -= mean; v[j].w -= mean; s2 += (v[j].x * v[j].x + v[j].y * v[j].y) + (v[j].z * v[j].z + v[j].w * v[j].w); }
        rstd = 1.f / sqrtf(wave_sum(s2) * (1.f / D) + LN_EPS);
        uint2* o8 = (uint2*)(p.U() + (size_t)row * D) + F.lane;
#pragma unroll
        for (int j = 0; j < 8; ++j) { const f4v sh = *(const LAS f4v*)(PSH + 4 * F.lane + 256 * j), sc = *(const LAS f4v*)(PSC + 4 * F.lane + 256 * j);
            const float u0 = v[j].x * rstd * sc[0] + sh[0], u1 = v[j].y * rstd * sc[1] + sh[1], u2_ = v[j].z * rstd * sc[2] + sh[2], u3 = v[j].w * rstd * sc[3] + sh[3];
            o8[64 * j] = make_uint2(pk2(u0, u1), pk2(u2_, u3)); }
#pragma unroll
        for (int j = 0; j < 8; ++j) zb[j] = zn[j];
    }
}
struct XW { int vx, nx, rank, nloc; };
constexpr int NDS = 8, DSW = D / NDS;
typedef float f2v __attribute__((ext_vector_type(2)));
typedef int i32x8_t __attribute__((ext_vector_type(8)));
constexpr unsigned P9_UROW = 133120u;
__device__ __forceinline__ void phase9(const Prm& p, const Frame& F, const XW& xw) {
    static_assert(DSW == 256 && NSLOT == 128 && D == 2048 && NWAVES * 16384 <= LDSCTL_OFF, "one 16 KB tile per wave");
    const unsigned q = F.lane >> 4, r = F.lane & 15u, l8 = F.lane >> 3, c8 = F.lane & 7u;
    const int tstep = xw.nloc * NWAVES, t0 = xw.rank * NWAVES + F.wave; const int nt = t0 < T ? (T - t0 + tstep - 1) / tstep : 0;
    LAS unsigned char* W = F.lds + F.wave * 16384; LAS unsigned char* ul = F.lds + P9_UROW + F.wave * 256;
    const unsigned goff = 16u * (c8 ^ l8);
    const unsigned rbase = 1024u * (r >> 3) + 128u * (r & 7u), x0 = rbase + 16u * (q ^ (r & 7u)), x1 = rbase + 16u * ((4u + q) ^ (r & 7u));
    const int sa1 = 0x7f7f7f7f;
    __syncthreads();
    for (int ds = xw.vx; ds < NDS; ds += xw.nx) {
        if (nt == 0) continue;
        const unsigned char* tbu = p.PU4() + (size_t)ds * ((size_t)NE * 128); _Float16* part_out = (_Float16*)p.SC() + (size_t)ds * T * NSLOT + 16u * r + 4u * q;
#define UPT(i) (t0 + ((i) < nt ? (i) : nt - 1) * tstep)
#define UPE(i, ea_, eb_) do { const int* ep_ = p.EIDX() + (size_t)UPT(i) * NSLOT + F.lane; ea_ = ep_[0]; eb_ = ep_[64]; } while (0)
#define UPU(i, U_) do { U_ = *(const u2v*)(p.U() + (size_t)UPT(i) * D + ds * DSW + 4u * F.lane); } while (0)
#define UPDMA(ea_, eb_) do { _Pragma("unroll") for (int k_ = 0; k_ < 16; ++k_) { const unsigned e_ = (unsigned)__shfl(k_ < 8 ? ea_ : eb_, 8 * (k_ & 7) + (int)l8); \
            __builtin_amdgcn_global_load_lds((const unsigned*)(tbu + ((e_ << 7) | goff)), (LAS unsigned*)(W + 1024 * k_), 16, 0, 0); } } while (0)
        int ea, eb; u2v uc;
        { int e0a, e0b; UPE(0, e0a, e0b); UPDMA(e0a, e0b); UPE(1, ea, eb); UPU(0, uc); }
        for (int i = 0; i < nt; ++i) {
            asm volatile("s_waitcnt vmcnt(0)" ::: "memory");
            u32x4_t A[16];
#pragma unroll
            for (int g = 0; g < 8; ++g) { A[2 * g] = *(const LAS u32x4_t*)(W + x0 + 2048u * g); A[2 * g + 1] = *(const LAS u32x4_t*)(W + x1 + 2048u * g); }
            { unsigned w8 = 0u; w8 = __builtin_amdgcn_cvt_pk_fp8_f32(f8c(bflo(uc.x)), f8c(bfhi(uc.x)), w8, false); w8 = __builtin_amdgcn_cvt_pk_fp8_f32(f8c(bflo(uc.y)), f8c(bfhi(uc.y)), w8, true);
              *(LAS unsigned*)(ul + 4u * F.lane) = w8; }
            const u32x4_t b00 = *(const LAS u32x4_t*)(ul + 16u * q), b01 = *(const LAS u32x4_t*)(ul + 64u + 16u * q), b10 = *(const LAS u32x4_t*)(ul + 128u + 16u * q), b11 = *(const LAS u32x4_t*)(ul + 192u + 16u * q);
            asm volatile("s_waitcnt lgkmcnt(0)" ::: "memory");
            UPDMA(ea, eb); UPE(i + 2, ea, eb); UPU(i + 1, uc);
            const i32x8_t B0 = {(int)b00[0], (int)b00[1], (int)b00[2], (int)b00[3], (int)b01[0], (int)b01[1], (int)b01[2], (int)b01[3]};
            const i32x8_t B1 = {(int)b10[0], (int)b10[1], (int)b10[2], (int)b10[3], (int)b11[0], (int)b11[1], (int)b11[2], (int)b11[3]};
            pg8::f32x4 acc = {0.f, 0.f, 0.f, 0.f};
#pragma unroll
            for (int g = 0; g < 8; ++g) { const int sg = (r == (unsigned)g) ? 0x7f7f7f7f : 0;
                acc = __builtin_amdgcn_mfma_scale_f32_16x16x128_f8f6f4((i32x8_t){(int)A[2 * g][0], (int)A[2 * g][1], (int)A[2 * g][2], (int)A[2 * g][3], 0, 0, 0, 0}, B0, acc, 4, 0, 0, sa1, 0, sg);
                acc = __builtin_amdgcn_mfma_scale_f32_16x16x128_f8f6f4((i32x8_t){(int)A[2 * g + 1][0], (int)A[2 * g + 1][1], (int)A[2 * g + 1][2], (int)A[2 * g + 1][3], 0, 0, 0, 0}, B1, acc, 4, 0, 0, sa1, 0, sg); }
            if (r < 8u) { typedef _Float16 h4t __attribute__((ext_vector_type(4)));
                const h4t o_ = {(_Float16)(acc[0] * 0.125f), (_Float16)(acc[1] * 0.125f), (_Float16)(acc[2] * 0.125f), (_Float16)(acc[3] * 0.125f)}; *(h4t*)(part_out + (size_t)UPT(i) * NSLOT) = o_; }
        }
        asm volatile("s_waitcnt vmcnt(0)" ::: "memory");
#undef UPDMA
#undef UPU
#undef UPE
#undef UPT
    }
}
__device__ __forceinline__ void phase10(const Prm& p, const Frame& F) {
    static_assert(NE <= 16384 && NSLOT == 128 && T % 64 == 0, "14-bit expert id, 64-token groups");
    LAS unsigned* tile = (LAS unsigned*)F.lds;
    LAS unsigned* rs = (LAS unsigned*)(F.lds + 65536);
    bool first = true;
    __syncthreads();
    for (int tg = F.bid; tg < T / 64; tg += F.G) {
        uint4 q4[2][NDS]; int4 ea[2], eb[2]; float4 ga[2], gb[2];
#pragma unroll
        for (int k = 0; k < 2; ++k) { const int idx = F.tid + NTHR * k, tl = idx >> 4, so = idx & 15; const size_t i0 = ((size_t)tg * 64 + tl) * NSLOT + 8 * so;
#pragma unroll
            for (int ds = 0; ds < NDS; ++ds) q4[k][ds] = *(const uint4*)((const _Float16*)p.SC() + (size_t)ds * T * NSLOT + i0);
            ea[k] = *(const int4*)(p.EIDX() + i0); eb[k] = *(const int4*)(p.EIDX() + i0 + 4); ga[k] = *(const float4*)(p.EW() + i0); gb[k] = *(const float4*)(p.EW() + i0 + 4); }
        if (first) { first = false; static_assert(NE == 8 * 4 * NTHR, "scale table: 8 float4 per thread and table"); f4v su[8], sv[8];
#pragma unroll
            for (int j = 0; j < 8; ++j) { su[j] = *((const f4v*)p.RSU() + F.tid + NTHR * j); sv[j] = *((const f4v*)p.RSV() + F.tid + NTHR * j); }
#pragma unroll
            for (int j = 0; j < 8; ++j) { u32x4_t o;
#pragma unroll
                for (int k = 0; k < 4; ++k) o[k] = (unsigned)__builtin_bit_cast(unsigned short, (_Float16)su[j][k]) | ((unsigned)__builtin_bit_cast(unsigned short, (_Float16)sv[j][k]) << 16);
                *(LAS u32x4_t*)(rs + 4 * (F.tid + NTHR * j)) = o; } }
        __syncthreads();
#pragma unroll
        for (int k = 0; k < 2; ++k) { const int idx = F.tid + NTHR * k, tl = idx >> 4, so = idx & 15;
            float sm[8];
#pragma unroll
            for (int j = 0; j < 8; ++j) sm[j] = 0.f;
#pragma unroll
            for (int ds = 0; ds < NDS; ++ds) { typedef _Float16 h2c __attribute__((ext_vector_type(2)));
                const unsigned qq[4] = {q4[k][ds].x, q4[k][ds].y, q4[k][ds].z, q4[k][ds].w};
#pragma unroll
                for (int j = 0; j < 4; ++j) { const h2c hv = __builtin_bit_cast(h2c, qq[j]); sm[2 * j] += (float)hv[0]; sm[2 * j + 1] += (float)hv[1]; } }
            const int ee[8] = {ea[k].x, ea[k].y, ea[k].z, ea[k].w, eb[k].x, eb[k].y, eb[k].z, eb[k].w}; const float gg[8] = {ga[k].x, ga[k].y, ga[k].z, ga[k].w, gb[k].x, gb[k].y, gb[k].z, gb[k].w};
#pragma unroll
            for (int j = 0; j < 8; ++j) { const int e = ee[j]; const unsigned rse = rs[e]; const float rsu = (float)__builtin_bit_cast(_Float16, (unsigned short)(rse & 0xffffu)), rsv = (float)__builtin_bit_cast(_Float16, (unsigned short)(rse >> 16));
                const _Float16 w = (_Float16)(gg[j] * gelu_exact(sm[j] * rsu) * rsv * 256.f);
                tile[tl * 129 + 8 * so + j] = (((unsigned)__builtin_bit_cast(unsigned short, w) << 16) & 0xFFFE0000u) | ((unsigned)e << 3); } }
        __syncthreads();
        uint4* pk = (uint4*)p.EW() + (size_t)tg * 64 * (NSLOT / 4);
#pragma unroll
        for (int k = 0; k < 4; ++k) { const int j = F.tid + NTHR * k, sq = j >> 6, tl = j & 63; const LAS unsigned* tp = tile + tl * 129 + 4 * sq; pk[j] = make_uint4(tp[0], tp[1], tp[2], tp[3]); }
    }
}
__device__ __forceinline__ void phase11(const Prm& p, const Frame& F) {
    static_assert(NE * 8 <= RING_BYTES && D % 16 == 0 && NE <= 65536 && (T / 64) % (2 * NWAVES) == 0, "table slice fits the LDS ring");
    typedef _Float16 h2v __attribute__((ext_vector_type(2)));
    constexpr int NSL = D / 16;
    const int c0 = (F.G % 8 == 0) ? (F.bid % 8) * (F.G / 8) + F.bid / 8 : F.bid;
    const int nhalf = F.G >= 2 * NSL ? 2 : 1;
    for (int item = c0; item < NSL * nhalf; item += F.G) { const int sidx = item % NSL, th = item / NSL;
        __syncthreads();
        { const uint4* src = (const uint4*)(p.PV8S() + (size_t)sidx * NE * 8);
          static_assert(NE / 2 == 16 * NTHR, "table slice: 16 x 16 bytes per thread"); u32x4_t tv[16];
#pragma unroll
          for (int j = 0; j < 16; ++j) tv[j] = __builtin_bit_cast(u32x4_t, src[F.tid + NTHR * j]);
#pragma unroll
          for (int j = 0; j < 16; ++j) *(LAS u32x4_t*)(F.lds + 16 * (F.tid + NTHR * j)) = tv[j]; }
        __syncthreads();
        const int ntgall = T / 64 / nhalf, tg0 = th * ntgall;
        const int ntg = ntgall / NWAVES, nb = 16 * ntg;
        uint4 b0[2], b1[2], b2[2], b3[2];
        const int kx = (F.G % 8 == 0) ? F.bid >> 3 : F.bid, rot = kx & 3, rotb = (kx >> 2) & 15;
#define DN_TG(bi) (tg0 + F.wave + ((((bi) >> 4) + rot) % ntg) * NWAVES)
#define DN_PTR(bi) ((const uint4*)p.EW() + (size_t)DN_TG(bi) * 64 * (NSLOT / 4) + ((((bi) & 15) + rotb) & 15) * 2 * 64 + F.lane)
#define DN_LOAD(B, bi) do { const int bc_ = (bi) < nb ? (bi) : nb - 1; const uint4* pk_ = DN_PTR(bc_); B[0] = pk_[0]; B[1] = pk_[64]; } while (0)
#define DN_RD1(v_, t_) do { t_ = *(const LAS u2v*)(unsigned)((v_) & 0x1FFF8u); } while (0)
#define DN_RD(B, Tq) do { _Pragma("unroll") for (int k = 0; k < 2; ++k) { DN_RD1(B[k].x, Tq[4 * k]); DN_RD1(B[k].y, Tq[4 * k + 1]); DN_RD1(B[k].z, Tq[4 * k + 2]); DN_RD1(B[k].w, Tq[4 * k + 3]); } } while (0)
#define DN_MA1(v_, t_) do { const unsigned vv_ = (v_); const _Float16 w = __builtin_bit_cast(_Float16, (unsigned short)(vv_ >> 16)); const h2v w2 = {w, w}; const unsigned tx_ = t_.x, ty_ = t_.y; \
                a0 += __builtin_amdgcn_cvt_scalef32_pk_f16_fp4(tx_, 1.0f, 0) * w2; a1 += __builtin_amdgcn_cvt_scalef32_pk_f16_fp4(tx_, 1.0f, 1) * w2; \
                a2 += __builtin_amdgcn_cvt_scalef32_pk_f16_fp4(tx_, 1.0f, 2) * w2; a3 += __builtin_amdgcn_cvt_scalef32_pk_f16_fp4(tx_, 1.0f, 3) * w2; \
                a4 += __builtin_amdgcn_cvt_scalef32_pk_f16_fp4(ty_, 1.0f, 0) * w2; a5 += __builtin_amdgcn_cvt_scalef32_pk_f16_fp4(ty_, 1.0f, 1) * w2; \
                a6 += __builtin_amdgcn_cvt_scalef32_pk_f16_fp4(ty_, 1.0f, 2) * w2; a7 += __builtin_amdgcn_cvt_scalef32_pk_f16_fp4(ty_, 1.0f, 3) * w2; } while (0)
#define DN_MA(B, Tq) do { _Pragma("unroll") for (int k = 0; k < 2; ++k) { DN_MA1(B[k].x, Tq[4 * k]); DN_MA1(B[k].y, Tq[4 * k + 1]); DN_MA1(B[k].z, Tq[4 * k + 2]); DN_MA1(B[k].w, Tq[4 * k + 3]); } asm volatile("" ::: "memory"); } while (0)
        u2v T0[8], T1[8];
        DN_LOAD(b0, 0); DN_LOAD(b1, 1); DN_LOAD(b2, 2); DN_RD(b0, T0);
        for (int bi = 0; bi < nb; bi += 16) {
            h2v a0 = {0, 0}, a1 = {0, 0}, a2 = {0, 0}, a3 = {0, 0}, a4 = {0, 0}, a5 = {0, 0}, a6 = {0, 0}, a7 = {0, 0};
#pragma unroll
            for (int u4 = 0; u4 < 16; u4 += 4) {
                DN_LOAD(b3, bi + u4 + 3); DN_RD(b1, T1); DN_MA(b0, T0);
                DN_LOAD(b0, bi + u4 + 4); DN_RD(b2, T0); DN_MA(b1, T1);
                DN_LOAD(b1, bi + u4 + 5); DN_RD(b3, T1); DN_MA(b2, T0);
                DN_LOAD(b2, bi + u4 + 6); DN_RD(b0, T0); DN_MA(b3, T1); }
            const int tg = DN_TG(bi); const float us = 1.f / 256.f;
            const float ys = 32.f / 256.f;
#define DN_Y8(lo_, hi_) __builtin_amdgcn_cvt_pk_fp8_f32(fminf(fmaxf((float)(hi_)[0] * ys, -448.f), 448.f), fminf(fmaxf((float)(hi_)[1] * ys, -448.f), 448.f), \
                          __builtin_amdgcn_cvt_pk_fp8_f32(fminf(fmaxf((float)(lo_)[0] * ys, -448.f), 448.f), fminf(fmaxf((float)(lo_)[1] * ys, -448.f), 448.f), 0u, false), true)
            const u32x4_t y8 = {(unsigned)DN_Y8(a0, a1), (unsigned)DN_Y8(a2, a3), (unsigned)DN_Y8(a4, a5), (unsigned)DN_Y8(a6, a7)};
#undef DN_Y8
            *(u32x4_t*)((unsigned char*)p.Y() + ((size_t)tg * 64 + F.lane) * D + 16 * sidx) = y8;
        }
#undef DN_MA
#undef DN_MA1
#undef DN_RD
#undef DN_RD1
#undef DN_LOAD
#undef DN_PTR
#undef DN_TG
    }
}
__device__ __forceinline__ void phase12(const Prm& p, const Frame& F) {
    LAS float* PW = (LAS float*)F.lds; LAS float* PB = PW + D; LAS float* PG = PW + 2 * D; LAS float* PW1 = PW + 3 * D; LAS float* PB1 = PW + 4 * D;
    const int rows_per = T / F.G, r_begin = F.bid * rows_per, r_end = r_begin + rows_per;
    int cur_b = -1;
    { const f4v w4 = *((const f4v*)p.ln2_w + F.tid), b4 = *((const f4v*)p.ln2_b + F.tid), w1 = *((const f4v*)p.ln1_w + F.tid), b1 = *((const f4v*)p.ln1_b + F.tid);
      *(LAS f4v*)(PW + 4 * F.tid) = w4; *(LAS f4v*)(PB + 4 * F.tid) = b4; *(LAS f4v*)(PW1 + 4 * F.tid) = w1; *(LAS f4v*)(PB1 + 4 * F.tid) = b1; }
    float4 v[8]; uint2 xb[8], xn[8]; unsigned yb[8], yn[8];
    { const uint2* xr = (const uint2*)(p.X1B() + (size_t)(r_begin + F.wave) * D) + F.lane; const unsigned* yr = (const unsigned*)((const unsigned char*)p.Y() + (size_t)(r_begin + F.wave) * D) + F.lane;
#pragma unroll
      for (int j = 0; j < 8; ++j) { xb[j] = xr[64 * j]; yb[j] = yr[64 * j]; } }
    for (int r0 = r_begin; r0 < r_end; r0 += NWAVES) {
        const int row = r0 + F.wave, b = r0 / S;
        if (b != cur_b) { __syncthreads(); const float* g2 = p.MOD() + (size_t)b * D6 + 5 * D;
            *(LAS f4v*)(PG + 4 * F.tid) = *((const f4v*)g2 + F.tid);
            cur_b = b; __syncthreads(); }
        float4* zr = (float4*)(p.out + (size_t)row * D) + F.lane; float s = 0.f;
        if (r0 + NWAVES < r_end) { const uint2* xp = (const uint2*)(p.X1B() + (size_t)(row + NWAVES) * D) + F.lane; const unsigned* yp = (const unsigned*)((const unsigned char*)p.Y() + (size_t)(row + NWAVES) * D) + F.lane;
#pragma unroll
            for (int j = 0; j < 8; ++j) { xn[j] = xp[64 * j]; yn[j] = yp[64 * j]; } }
#pragma unroll
        for (int j = 0; j < 8; ++j) { v[j] = make_float4(bflo(xb[j].x), bfhi(xb[j].x), bflo(xb[j].y), bfhi(xb[j].y)); s += (v[j].x + v[j].y) + (v[j].z + v[j].w); }
        const float mean1 = wave_sum(s) * (1.f / D); float q1 = 0.f;
#pragma unroll
        for (int j = 0; j < 8; ++j) { v[j].x -= mean1; v[j].y -= mean1; v[j].z -= mean1; v[j].w -= mean1; q1 += (v[j].x * v[j].x + v[j].y * v[j].y) + (v[j].z * v[j].z + v[j].w * v[j].w); }
        const float rstd1 = 1.f / sqrtf(wave_sum(q1) * (1.f / D) + LN_EPS); s = 0.f;
#pragma unroll
        for (int j = 0; j < 8; ++j) { const f4v g = *(const LAS f4v*)(PG + 4 * F.lane + 256 * j), w1 = *(const LAS f4v*)(PW1 + 4 * F.lane + 256 * j), b1 = *(const LAS f4v*)(PB1 + 4 * F.lane + 256 * j);
            const f2v y01 = __builtin_amdgcn_cvt_pk_f32_fp8(yb[j], false) * (1.f / 32.f), y23 = __builtin_amdgcn_cvt_pk_f32_fp8(yb[j], true) * (1.f / 32.f);
            v[j].x = ALPHA * (v[j].x * rstd1 * w1[0] + b1[0]) + g[0] * y01[0]; v[j].y = ALPHA * (v[j].y * rstd1 * w1[1] + b1[1]) + g[1] * y01[1];
            v[j].z = ALPHA * (v[j].z * rstd1 * w1[2] + b1[2]) + g[2] * y23[0]; v[j].w = ALPHA * (v[j].w * rstd1 * w1[3] + b1[3]) + g[3] * y23[1];
            s += (v[j].x + v[j].y) + (v[j].z + v[j].w); }
        const float mean = wave_sum(s) * (1.f / D); float s2 = 0.f;
#pragma unroll
        for (int j = 0; j < 8; ++j) { v[j].x -= mean; v[j].y -= mean; v[j].z -= mean; v[j].w -= mean; s2 += (v[j].x * v[j].x + v[j].y * v[j].y) + (v[j].z * v[j].z + v[j].w * v[j].w); }
        const float rstd = 1.f / sqrtf(wave_sum(s2) * (1.f / D) + LN_EPS);
#pragma unroll
        for (int j = 0; j < 8; ++j) { const f4v w = *(const LAS f4v*)(PW + 4 * F.lane + 256 * j), bb = *(const LAS f4v*)(PB + 4 * F.lane + 256 * j);
            zr[64 * j] = make_float4(v[j].x * rstd * w[0] + bb[0], v[j].y * rstd * w[1] + bb[1], v[j].z * rstd * w[2] + bb[2], v[j].w * rstd * w[3] + bb[3]); }
#pragma unroll
        for (int j = 0; j < 8; ++j) { xb[j] = xn[j]; yb[j] = yn[j]; }
    }
}

struct Args { const float* in[18]; float* out; unsigned char* ws; int ph_lo, ph_hi, li, pad; };
__global__ void __launch_bounds__(NTHR, 2) mk_fwd(Args args) {
    extern __shared__ __attribute__((aligned(16))) unsigned char lds_raw[];
    if ((unsigned)(size_t)(LAS unsigned char*)lds_raw != 0u) return;
    Frame F; F.lds = (LAS unsigned char*)lds_raw; F.tid = threadIdx.x; F.lane = F.tid & 63; F.wave = __builtin_amdgcn_readfirstlane(F.tid >> 6); F.G = gridDim.x; F.bid = blockIdx.x;
    Prm p; p.x = args.in[0]; p.c = args.in[1]; p.w_ada = args.in[2]; p.b_ada = args.in[3]; p.w_in = args.in[4]; p.b_in = args.in[5]; p.conv_w = args.in[6]; p.conv_b = args.in[7]; p.mnorm_w = args.in[8];
    p.w_out = args.in[9]; p.ln1_w = args.in[10]; p.ln1_b = args.in[11]; p.wq = args.in[12]; p.subkeys = args.in[13]; p.peer_u = args.in[14]; p.peer_v = args.in[15]; p.ln2_w = args.in[16]; p.ln2_b = args.in[17];
    p.out = args.out; p.ws = args.ws;
    volatile LAS unsigned* MISC = (volatile LAS unsigned*)(F.lds + MISC_OFF);
    for (int u = F.tid; u < (LDS_BYTES - LDSCTL_OFF) / 4; u += NTHR) ((LAS unsigned*)(F.lds + LDSCTL_OFF))[u] = 0u;
    __syncthreads();
    const int lo = args.ph_lo, hi = args.ph_hi;
    XcdBarrier bar; bar.bar = (unsigned*)(p.ws + WS_CTL) + CW_BAR + args.li * XCD_BAR_WORDS; bar.x = 0; bar.st = nullptr;
    if (hi - lo > 1) bar = xcd_barrier_post((unsigned*)(p.ws + WS_CTL) + CW_BAR + args.li * XCD_BAR_WORDS, MISC + 8);
#define IN(k) (lo <= (k) && (k) < hi)
#define SEAM(k) do { if (IN(k) && IN((k) + 1)) xcd_barrier(bar); } while (0)
    XW xw; xw.nx = (F.G % 8 == 0) ? 8 : 1; xw.vx = F.bid % xw.nx; xw.rank = F.bid / xw.nx; xw.nloc = F.G / xw.nx;
#define XW_FROM_CENSUS() do { if (hi - lo > 1) { if (F.tid == 0) { unsigned vx_ = 0u; for (unsigned j = 0; j < bar.x; ++j) vx_ += xb_ld(&bar.bar[XB_XCNT(j)]) > 0u ? 1u : 0u; MISC[11] = vx_; } __syncthreads(); \
        xw.vx = (int)MISC[11]; xw.nx = (int)MISC[9]; xw.rank = (int)MISC[10] - 1; xw.nloc = (int)MISC[8]; } } while (0)
    if (IN(0)) { phase0(p, F); deferred_prep<false, false, true>(p, F, 0, F.G); } SEAM(0);
    if (IN(1)) { phase1(p, F); } SEAM(1);
    if (IN(2)) { pg8::Gemm g{p.U(), p.WIN_T(), T, INM, D}; pg8::StaticOrder So; So.init(T, INM, F.G, F.bid);
        pg8::EpiBf16<0> E{p.PJ(), INM, p.b_in, 0, 0, 1.f};
        pg8::gemm_phase<pg8::EpiBf16<0>, pg8::StaticOrder, true, true>(F.lds, g, So, E); } SEAM(2);
    if (IN(3)) { const int nmb = F.G >= 2 ? F.G / 2 : 1;
#ifndef P3_REP_ML
#define P3_REP_ML 1
#define P3_REP_CONV 1
#endif
        if (F.bid < nmb) { for (int rep_ = 0; rep_ < P3_REP_ML; ++rep_) for (int u = F.bid; u < 2 * NB * MH * 2; u += nmb) ml::unit(p, F, u); if (F.G < 2) phase3a(p, F, 0, 1); }
        else { phase3a(p, F, nmb, F.G - nmb); deferred_prep<true, true, false>(p, F, nmb, F.G - nmb); }
        if (F.G < 2) deferred_prep<true, true, false>(p, F, 0, 1); } SEAM(3);
    if (IN(4)) { phase4(p, F); } SEAM(4);
    if (IN(5)) { pg8::Gemm g{p.Y(), p.WOUT_T(), T, D, D}; pg8::StaticOrder So; So.init(T, D, F.G, F.bid);
        EpiZ E{p.x, p.MOD(), p.X1B()};
        pg8::gemm_phase<EpiZ, pg8::StaticOrder, true, true>(F.lds, g, So, E); } SEAM(5);
    if (IN(6)) { phase6(p, F); } SEAM(6);
    if (IN(7)) { pg8::Gemm g{p.U(), p.WQ_T(), T, NQ, D}; pg8::StaticOrder So; So.init(T, NQ, F.G, F.bid);
        EpiF32 E{p.SC(), NSC};
        pg8::gemm_phase<EpiF32, pg8::StaticOrder, true, true>(F.lds, g, So, E); }
    if (IN(7) && IN(8)) { asm volatile("s_waitcnt vmcnt(0)" ::: "memory"); __syncthreads(); }
    if (IN(8)) { phase8(p, F); } SEAM(8);
    if (IN(9)) { if (lo < 9) XW_FROM_CENSUS(); phase9(p, F, xw); } SEAM(9);
    if (IN(10)) { phase10(p, F); } SEAM(10);
    if (IN(11)) { phase11(p, F); } SEAM(11);
    if (IN(12)) { phase12(p, F); }
#undef IN
#undef SEAM
}

extern "C" void kernel_launch(void* const* d_in, const int* in_sizes, int n_in, void* d_out, int out_size, void* d_ws, size_t ws_size, hipStream_t stream) {
    static int grid = 0;
    if (grid == 0) {
        if (n_in != 18 || out_size != T * D || ws_size < WS_END) { fprintf(stderr, "kernel_launch: unexpected shapes (n_in %d out %d ws %zu, need %zu)\n", n_in, out_size, ws_size, (size_t)WS_END); grid = -1; return; }
        int dev = 0, cus = 0, per_cu = 0;
        if (hipGetDevice(&dev) != hipSuccess || hipDeviceGetAttribute(&cus, hipDeviceAttributeMultiprocessorCount, dev) != hipSuccess) { grid = -1; return; }
        if (hipFuncSetAttribute((const void*)mk_fwd, hipFuncAttributeMaxDynamicSharedMemorySize, LDS_BYTES) != hipSuccess) { fprintf(stderr, "kernel_launch: hipFuncSetAttribute failed\n"); grid = -1; return; }
        if (hipOccupancyMaxActiveBlocksPerMultiprocessor(&per_cu, (const void*)mk_fwd, NTHR, LDS_BYTES) != hipSuccess || per_cu < 1) { fprintf(stderr, "kernel_launch: the occupancy query reports %d workgroups per CU for this kernel + LDS size: the grid barrier would not be legal, not launching\n", per_cu); grid = -1; return; }
        grid = cus;
        if (T % grid != 0 || (T / grid) % (2 * NWAVES) != 0) { fprintf(stderr, "kernel_launch: grid %d does not divide the rows\n", grid); grid = -1; return; }
    }
    if (grid < 0) return;
    static_assert((CW_BAR + 2 * XCD_BAR_WORDS) * 4 <= (64 << 10), "control words inside the zeroed span");
    (void)hipMemsetAsync((char*)d_ws + WS_CTL, 0, 64u << 10, stream);
    Args a{};
    for (int i = 0; i < 18; ++i) a.in[i] = (const float*)d_in[i];
    a.out = (float*)d_out; a.ws = (unsigned char*)d_ws;
#if defined(PROBE_A)
    a.ph_lo = 0; a.ph_hi = PROBE_B + 1; a.li = 0; hipLaunchKernelGGL(mk_fwd, dim3(grid), dim3(NTHR), LDS_BYTES, stream, a);
    a.ph_lo = PROBE_A; a.ph_hi = NPHASE; a.li = 1; hipLaunchKernelGGL(mk_fwd, dim3(grid), dim3(NTHR), LDS_BYTES, stream, a);
#elif MK_N_LAUNCHES == 1
    a.ph_lo = 0; a.ph_hi = NPHASE;
    hipLaunchKernelGGL(mk_fwd, dim3(grid), dim3(NTHR), LDS_BYTES, stream, a);
#else
    for (int k = 0; k < NPHASE; ++k) { a.ph_lo = k; a.ph_hi = k + 1; hipLaunchKernelGGL(mk_fwd, dim3(grid), dim3(NTHR), LDS_BYTES, stream, a); }
#endif
}
```
